# Optimizing an MI355X kernel written in HIP

```python
import math
import jax, jax.numpy as jnp
from jax import lax
import numpy as np

D_MODEL = 1024
BATCH = 2
SEQ = 8192
DEPTH = 1

N_DIFF_HEADS = 4
DIFF_HEAD_DIM = 64
DIFF_V_DIM = 2 * DIFF_HEAD_DIM
N_MOBA_HEADS = 8
MOBA_HEAD_DIM = 64
MOBA_BLOCK = 256
MOBA_TOPK = 3
Q_BLOCK = 128
N_HEADS_TOTAL = N_DIFF_HEADS + N_MOBA_HEADS
N_BUCKETS = 32
MAX_DISTANCE = 128
N_EXPERTS = 32
TOP_K = 4
D_FF = D_MODEL
SWIGLU_LIMIT = 7.0
SWIGLU_ALPHA = 1.702
RMS_EPS = 1e-5

DIFF_QK_WIDTH = N_DIFF_HEADS * 2 * DIFF_HEAD_DIM
DIFF_V_WIDTH = N_DIFF_HEADS * DIFF_V_DIM
MOBA_WIDTH = N_MOBA_HEADS * MOBA_HEAD_DIM
SPLIT_WIDTHS = (DIFF_QK_WIDTH, DIFF_QK_WIDTH, DIFF_V_WIDTH,
                MOBA_WIDTH, MOBA_WIDTH, MOBA_WIDTH, D_MODEL, D_MODEL)
IN_WIDTH = sum(SPLIT_WIDTHS)
SPLIT_POINTS = tuple(int(v) for v in np.cumsum(SPLIT_WIDTHS)[:-1])

kernel_name = "hybrid_diffattn_moba_moe_adaln"


def rmsnorm(x, g):
    xf = x.astype(jnp.float32)
    y = xf * lax.rsqrt(jnp.mean(xf * xf, axis=-1, keepdims=True) + RMS_EPS)
    return y.astype(x.dtype) * g


def t5_bucket(dist):
    n = jnp.maximum(dist, 0)
    max_exact = N_BUCKETS // 2
    nf = jnp.maximum(n, max_exact).astype(jnp.float32)
    large = max_exact + (jnp.log(nf / max_exact) / math.log(MAX_DISTANCE / max_exact)
                         * (N_BUCKETS - max_exact)).astype(jnp.int32)
    large = jnp.minimum(large, N_BUCKETS - 1)
    return jnp.where(n < max_exact, n, large)


def diff_attention(q, k, v, bias_tab, lam, lam_init, subln_g):
    B, H, _, S, d = q.shape
    dv = v.shape[-1]
    nq = S // Q_BLOCK
    scale = d ** -0.5
    k_pos = jnp.arange(S)

    def one_block(i):
        q0 = i * Q_BLOCK
        qb = lax.dynamic_slice_in_dim(q, q0, Q_BLOCK, axis=3)
        s = jnp.einsum('bhmqd,bhmkd->bhmqk', qb, k).astype(jnp.float32) * scale
        dist = (q0 + jnp.arange(Q_BLOCK))[:, None] - k_pos[None, :]
        bias = jnp.transpose(bias_tab[t5_bucket(dist)], (2, 0, 1)).astype(jnp.float32)
        s = jnp.where(dist >= 0, s + bias[None, :, None], -jnp.inf)
        p = jax.nn.softmax(s, axis=-1)
        p = p[:, :, 0] - lam * p[:, :, 1]
        return jnp.einsum('bhqk,bhkd->bhqd', p.astype(v.dtype), v)

    o = lax.map(one_block, jnp.arange(nq))
    o = jnp.transpose(o, (1, 0, 3, 2, 4)).reshape(B, S, H, dv)
    o = rmsnorm(o, subln_g) * (1.0 - lam_init)
    return o.reshape(B, S, H * dv)


def moba_attention(q, k, v, bias_tab):
    B, H, S, d = q.shape
    nb = -(-S // MOBA_BLOCK)
    pad = nb * MOBA_BLOCK - S
    k_pad = jnp.pad(k, ((0, 0), (0, 0), (0, pad), (0, 0)))
    v_pad = jnp.pad(v, ((0, 0), (0, 0), (0, pad), (0, 0)))
    k_blocks = k_pad.reshape(B, H, nb, MOBA_BLOCK, d)
    v_blocks = v_pad.reshape(B, H, nb, MOBA_BLOCK, d)
    k_mean = jnp.mean(k_blocks.astype(jnp.float32), axis=3).astype(k.dtype)
    k_sel = min(MOBA_TOPK, nb)
    scale = d ** -0.5
    bi = jnp.arange(B)[:, None, None, None]
    hi = jnp.arange(H)[None, :, None, None]
    hi5 = jnp.arange(H)[None, :, None, None, None]
    blk_ar = jnp.arange(MOBA_BLOCK)
    nq = S // Q_BLOCK

    def one_block(i):
        q0 = i * Q_BLOCK
        own = q0 // MOBA_BLOCK
        qb = lax.dynamic_slice_in_dim(q, q0, Q_BLOCK, axis=2)
        q_pos = q0 + jnp.arange(Q_BLOCK)
        gs = jnp.einsum('bhqd,bhnd->bhqn', qb, k_mean).astype(jnp.float32)
        gs = jnp.where(jnp.arange(nb) < own, gs, -jnp.inf)
        _, sel = lax.top_k(gs, k_sel)
        sel_valid = jnp.arange(k_sel) < own
        ks = k_blocks[bi, hi, sel]
        vs = v_blocks[bi, hi, sel]
        s_sel = jnp.einsum('bhqd,bhqjkd->bhqjk', qb, ks).astype(jnp.float32) * scale
        sel_pos = sel[..., None] * MOBA_BLOCK + blk_ar
        dist_sel = q_pos[:, None, None] - sel_pos
        s_sel = s_sel + bias_tab[t5_bucket(dist_sel), hi5].astype(jnp.float32)
        s_sel = jnp.where(sel_valid[:, None], s_sel, -jnp.inf)
        s_sel = s_sel.reshape(B, H, Q_BLOCK, k_sel * MOBA_BLOCK)
        k_own = lax.dynamic_slice_in_dim(k_pad, own * MOBA_BLOCK, MOBA_BLOCK, axis=2)
        v_own = lax.dynamic_slice_in_dim(v_pad, own * MOBA_BLOCK, MOBA_BLOCK, axis=2)
        s_own = jnp.einsum('bhqd,bhkd->bhqk', qb, k_own).astype(jnp.float32) * scale
        dist_own = q_pos[:, None] - (own * MOBA_BLOCK + blk_ar)[None, :]
        bias_own = jnp.transpose(bias_tab[t5_bucket(dist_own)], (2, 0, 1)).astype(jnp.float32)
        s_own = jnp.where(dist_own >= 0, s_own + bias_own[None], -jnp.inf)
        p = jax.nn.softmax(jnp.concatenate([s_sel, s_own], axis=-1), axis=-1).astype(v.dtype)
        p_sel = p[..., :k_sel * MOBA_BLOCK].reshape(B, H, Q_BLOCK, k_sel, MOBA_BLOCK)
        p_own = p[..., k_sel * MOBA_BLOCK:]
        return (jnp.einsum('bhqjk,bhqjkd->bhqd', p_sel, vs)
                + jnp.einsum('bhqk,bhkd->bhqd', p_own, v_own))

    o = lax.map(one_block, jnp.arange(nq))
    return jnp.transpose(o, (1, 0, 3, 2, 4)).reshape(B, S, H * d)


def moe_ffn(h, w_router, b_router, w_gate_up, b_gate_up, w_down, b_down):
    B, S, D = h.shape
    t = h.reshape(B * S, D)
    logits = (t @ w_router + b_router).astype(jnp.float32)
    top_val, top_idx = lax.top_k(logits, TOP_K)
    top_w = jax.nn.softmax(top_val, axis=-1)
    combine = jnp.sum(jax.nn.one_hot(top_idx, N_EXPERTS, dtype=jnp.float32)
                      * top_w[..., None], axis=1).astype(t.dtype)
    out = jnp.zeros_like(t)
    for e in range(N_EXPERTS):
        gu = t @ w_gate_up[e] + b_gate_up[e]
        gate = jnp.minimum(gu[:, :D_FF], SWIGLU_LIMIT)
        up = jnp.clip(gu[:, D_FF:], -SWIGLU_LIMIT, SWIGLU_LIMIT)
        act = (up + 1.0) * gate * jax.nn.sigmoid(SWIGLU_ALPHA * gate)
        out = out + combine[:, e:e + 1] * (act @ w_down[e] + b_down[e])
    return out.reshape(B, S, D)


def setup_inputs(seed: int = 0) -> dict:
    key = jax.random.key(seed)
    ks = jax.random.split(key, 24)
    f32 = jnp.float32
    nrm = lambda k, shape, s: jax.random.normal(k, shape, f32) * s
    L, D, E = DEPTH, D_MODEL, N_EXPERTS
    return {
        "x": nrm(ks[0], (BATCH, SEQ, D), 1.0),
        "c": nrm(ks[1], (BATCH, D), 1.0),
        "rel_bias": nrm(ks[2], (N_BUCKETS, N_HEADS_TOTAL), 0.5),
        "w_ada": nrm(ks[3], (L, D, 6 * D), 0.5 * D ** -0.5),
        "b_ada": nrm(ks[4], (L, 6 * D), 0.02),
        "g_mix": 1.0 + nrm(ks[5], (L, D), 0.02),
        "w_in": nrm(ks[6], (L, D, IN_WIDTH), D ** -0.5),
        "lambda_q1": nrm(ks[7], (L, DIFF_HEAD_DIM), 0.1),
        "lambda_k1": nrm(ks[8], (L, DIFF_HEAD_DIM), 0.1),
        "lambda_q2": nrm(ks[9], (L, DIFF_HEAD_DIM), 0.1),
        "lambda_k2": nrm(ks[10], (L, DIFF_HEAD_DIM), 0.1),
        "subln_g": 1.0 + nrm(ks[11], (L, DIFF_V_DIM), 0.02),
        "w_br_a": nrm(ks[12], (L, DIFF_V_WIDTH, D), DIFF_V_WIDTH ** -0.5),
        "w_br_b": nrm(ks[13], (L, MOBA_WIDTH, D), MOBA_WIDTH ** -0.5),
        "w_out": nrm(ks[14], (L, D, D), D ** -0.5),
        "g_ffn": 1.0 + nrm(ks[15], (L, D), 0.02),
        "w_router": nrm(ks[16], (L, D, E), D ** -0.5),
        "b_router": nrm(ks[17], (L, E), 0.01),
        "w_gate_up": nrm(ks[18], (L, E, D, 2 * D_FF), D ** -0.5),
        "b_gate_up": nrm(ks[19], (L, E, 2 * D_FF), 0.01),
        "w_down": nrm(ks[20], (L, E, D_FF, D), D_FF ** -0.5),
        "b_down": nrm(ks[21], (L, E, D), 0.01),
        "g_final": 1.0 + nrm(ks[22], (D,), 0.02),
    }


def reference(x, c, rel_bias, w_ada, b_ada, g_mix, w_in, lambda_q1, lambda_k1,
              lambda_q2, lambda_k2, subln_g, w_br_a, w_br_b, w_out, g_ffn,
              w_router, b_router, w_gate_up, b_gate_up, w_down, b_down, g_final):
    B, S, D = x.shape
    bias_a = rel_bias[:, :N_DIFF_HEADS]
    bias_b = rel_bias[:, N_DIFF_HEADS:]
    for l in range(DEPTH):
        ada = c @ w_ada[l] + b_ada[l]
        sh_m, sc_m, gt_m, sh_f, sc_f, gt_f = [a[:, None, :] for a in jnp.split(ada, 6, axis=-1)]

        h = rmsnorm(x, g_mix[l]) * (1.0 + sc_m) + sh_m
        proj = h @ w_in[l]
        q_a, k_a, v_a, q_b, k_b, v_b, gl_a, gl_b = jnp.split(proj, SPLIT_POINTS, axis=-1)
        q_a = q_a.reshape(B, S, N_DIFF_HEADS, 2, DIFF_HEAD_DIM).transpose(0, 2, 3, 1, 4)
        k_a = k_a.reshape(B, S, N_DIFF_HEADS, 2, DIFF_HEAD_DIM).transpose(0, 2, 3, 1, 4)
        v_a = v_a.reshape(B, S, N_DIFF_HEADS, DIFF_V_DIM).transpose(0, 2, 1, 3)
        q_b = q_b.reshape(B, S, N_MOBA_HEADS, MOBA_HEAD_DIM).transpose(0, 2, 1, 3)
        k_b = k_b.reshape(B, S, N_MOBA_HEADS, MOBA_HEAD_DIM).transpose(0, 2, 1, 3)
        v_b = v_b.reshape(B, S, N_MOBA_HEADS, MOBA_HEAD_DIM).transpose(0, 2, 1, 3)

        lam_init = 0.8 - 0.6 * math.exp(-0.3 * l)
        lam = (jnp.exp(jnp.sum(lambda_q1[l].astype(jnp.float32) * lambda_k1[l].astype(jnp.float32)))
               - jnp.exp(jnp.sum(lambda_q2[l].astype(jnp.float32) * lambda_k2[l].astype(jnp.float32)))
               + lam_init)
        y_a = diff_attention(q_a, k_a, v_a, bias_a, lam, lam_init, subln_g[l])
        y_b = moba_attention(q_b, k_b, v_b, bias_b)

        merged = (jax.nn.sigmoid(gl_a) * (y_a @ w_br_a[l])
                  + jax.nn.sigmoid(gl_b) * (y_b @ w_br_b[l]))
        x = x + gt_m * (merged @ w_out[l])

        h = rmsnorm(x, g_ffn[l]) * (1.0 + sc_f) + sh_f
        x = x + gt_f * moe_ffn(h, w_router[l], b_router[l], w_gate_up[l],
                               b_gate_up[l], w_down[l], b_down[l])
    return rmsnorm(x, g_final)
```

```cpp
#include <hip/hip_runtime.h>
#include <cstdio>
#include <cstdint>

#define GAS __attribute__((address_space(1)))
#define LAS __attribute__((address_space(3)))
typedef unsigned short bf16_t;
typedef short bf16x8 __attribute__((ext_vector_type(8)));
typedef short s16x4 __attribute__((ext_vector_type(4)));
typedef float f32x4 __attribute__((ext_vector_type(4)));
typedef float f32x2 __attribute__((ext_vector_type(2)));
typedef unsigned u32x4 __attribute__((ext_vector_type(4)));
typedef unsigned u32x2 __attribute__((ext_vector_type(2)));
#define RLX_AGENT __ATOMIC_RELAXED, __HIP_MEMORY_SCOPE_AGENT
#define LDS_WAIT() asm volatile("s_waitcnt lgkmcnt(0)" ::: "memory")
#define VM_WAIT() asm volatile("s_waitcnt vmcnt(0)" ::: "memory")

constexpr int BATCH = 2, SEQ = 8192, M = BATCH * SEQ, D = 1024, INW = 5120;
constexpr int NE = 32, TOPK = 4;
constexpr int NWAVES = 8;
constexpr float RMS_EPS = 1e-5f;
constexpr float LOG2E = 1.4426950408889634f;
constexpr float C2 = 0.125f * LOG2E;
constexpr int SLOT_ROWS = M * TOPK + NE * 256;

constexpr size_t MiB = 1u << 20, KiB = 1u << 10;
constexpr size_t WS_CTL = 0, CTL_ZERO_BYTES = 1 * MiB;
constexpr size_t WS_ADAP = 1 * MiB;
constexpr size_t WS_ADAF = 1 * MiB + 512 * KiB;
constexpr size_t WS_KMEAN = 2 * MiB;
constexpr size_t WS_TOPI = 2 * MiB + 256 * KiB;
constexpr size_t WS_TOPW = 2 * MiB + 512 * KiB;
constexpr size_t WS_TOKSLOT = 2 * MiB + 768 * KiB;
constexpr size_t WS_SLOTTOK = 3 * MiB;
constexpr size_t WS_SLOTW = 3 * MiB + 512 * KiB;
constexpr size_t WS_HIST = 4 * MiB;
constexpr size_t WS_EOFF = 4 * MiB + 64 * KiB;
constexpr size_t WS_LIST = 6 * MiB;
constexpr size_t WS_PML = 14 * MiB;
constexpr size_t WS_WIN = 18 * MiB, WS_WBRA = 28 * MiB, WS_WBRB = 29 * MiB, WS_WOUT = 30 * MiB, WS_WGU = 32 * MiB, WS_WD = 160 * MiB;
constexpr size_t WS_H = 224 * MiB;
constexpr size_t WS_PROJ = 256 * MiB;
constexpr size_t PROJ_STRIDE = 32 * MiB;
constexpr size_t WS_Y = 416 * MiB;
constexpr size_t WS_PO = 448 * MiB;
constexpr size_t WS_T1 = 512 * MiB;
constexpr size_t WS_MERGED = 576 * MiB;
constexpr size_t WS_X1 = 608 * MiB;
constexpr size_t WS_ACT = 672 * MiB;
constexpr size_t WS_SOUT = 816 * MiB;
constexpr size_t WS_END = 960 * MiB;
constexpr int LIST_PER_BH = 126976;
constexpr int CW_TMO = 0, CW_CODE = 1, CW_BAR = 4096, CW_MCNT = 65536;

constexpr int RING_BYTES = 131072, LDSCTL_OFF = RING_BYTES, MISC_OFF = LDSCTL_OFF + 320, LDS_BYTES = 147456;

__device__ __forceinline__ unsigned f2bf(float f) { unsigned u = __builtin_bit_cast(unsigned, f); return (u + 0x7fffu + ((u >> 16) & 1u)) >> 16; }
__device__ __forceinline__ unsigned pk2(float lo, float hi) { return f2bf(lo) | (f2bf(hi) << 16); }
__device__ __forceinline__ unsigned cvt_pk_bf16(float lo, float hi) { unsigned r; asm volatile("v_cvt_pk_bf16_f32 %0, %1, %2" : "=v"(r) : "v"(lo), "v"(hi)); return r; }
__device__ __forceinline__ float bf_lo(unsigned u) { return __builtin_bit_cast(float, u << 16); }
__device__ __forceinline__ float bf_hi(unsigned u) { return __builtin_bit_cast(float, u & 0xffff0000u); }
__device__ __forceinline__ float sigmoidf_fast(float v) { return __builtin_amdgcn_rcpf(1.0f + __builtin_amdgcn_exp2f(-v * LOG2E)); }
__device__ __forceinline__ float wave_sum(float v) {
#pragma unroll
    for (int o = 1; o < 64; o <<= 1) v += __shfl_xor(v, o);
    return v;
}

namespace pg8 {
constexpr int BM = 256, BK = 64, HALF = 128, HTB = HALF * BK * 2, STAGE_BYTES = 8 * HTB, NXCD = 8, WGM = 8;
__device__ __forceinline__ int lds_byte(int r, int c) { const int st = (r >> 4) * 2 + (c >> 5), rr = r & 15, cc = c & 31, ob = rr * 64 + cc * 2; return st * 1024 + (ob ^ (((ob >> 9) & 1) << 5)); }
__device__ __forceinline__ void stage_rc(int b, int& R, int& C) { const int st = b / 1024, sb = b % 1024, swz = sb ^ (((sb >> 9) & 1) << 5); R = (st >> 1) * 16 + swz / 64; C = (st & 1) * 32 + (swz % 64) / 2; }
__device__ __forceinline__ int perm32(int rho) { const int n = rho >> 4, i = rho & 15; return 8 * (i >> 2) + 4 * n + (i & 3); }

struct Unit { int row0; int pm, pn, e; const char* bptr; };

struct DenseSched {
    int nM, nN, nwg, G, c; const char* Bt; size_t btile;
    __device__ __forceinline__ void init(int M_, int N_, int G_, int c_, const void* Bt_, int ldb) { nM = M_ / BM; nN = N_ / BM; nwg = nM * nN; G = G_; c = c_; Bt = (const char*)Bt_; btile = (size_t)BM * ldb * 2; }
    __device__ __forceinline__ bool next(int i, Unit& u) const {
        const long L = (long)i * G + c; if (L >= nwg) return false;
        int wgid = (int)L; { const int q = nwg / NXCD, r = nwg % NXCD, xcd = wgid % NXCD, off = wgid / NXCD; wgid = (xcd < r ? xcd * (q + 1) : r * (q + 1) + (xcd - r) * q) + off; }
        const int nig = WGM * nN, gid = wgid / nig, fm = gid * WGM, gsz = (nM - fm) < WGM ? (nM - fm) : WGM;
        u.pm = fm + ((wgid % nig) % gsz); u.pn = (wgid % nig) / gsz; u.row0 = u.pm * BM; u.e = 0; u.bptr = Bt + (size_t)u.pn * btile; return true;
    }
    __device__ __forceinline__ int arow(const Unit& u, int r) const { return u.row0 + r; }
};

template <class Epi, class Sched, bool ALIGN_EPI>
__device__ __forceinline__ void gemm_phase(LAS unsigned char* lds, const void* Abase_, int lda, int ldb, int K, const Sched& S, const Epi& E) {
    const int tid = threadIdx.x, wid = __builtin_amdgcn_readfirstlane(tid >> 6), lane = tid & 63, wr = wid >> 2, wc = wid & 3, fr = lane & 15, fq = lane >> 4;
    const int nt = K / BK;
    const char* Abase = (const char*)Abase_;
    int Rr[2], Cc[2]; unsigned voffB[2];
#pragma unroll
    for (int i = 0; i < 2; ++i) { stage_rc(tid * 16 + i * 8192, Rr[i], Cc[i]); const int Rb = Epi::PERM ? ((Rr[i] & ~31) + perm32(Rr[i] & 31)) : Rr[i]; voffB[i] = (unsigned)(Rb * ldb + Cc[i]) * 2u; }
    const size_t kstep = (size_t)(BK * 2);
    const size_t hstepB = (size_t)HALF * ldb * 2;
    const unsigned ldsw = (unsigned)wid * 1024u;
    const int aoff = lds_byte(wr * 64 + fr, fq * 8), boff = lds_byte(wc * 32 + fr, fq * 8);
#define PG8_SA(b, h) (((b) * 2 + (h)) * HTB)
#define PG8_SB(b, h) ((4 + (b) * 2 + (h)) * HTB)
#define PG8_STAGE(bufoff, gbase, voff) do { _Pragma("unroll") for (int _i = 0; _i < 2; ++_i) \
        __builtin_amdgcn_global_load_lds((const unsigned*)((const char*)(gbase) + (voff)[_i]), (LAS unsigned*)(lds + (bufoff) + ldsw + _i * 8192), 16, 0, 0); } while (0)
#define PG8_LDA(dst, b, h) do { _Pragma("unroll") for (int m = 0; m < 4; ++m) _Pragma("unroll") for (int k = 0; k < 2; ++k) dst[m][k] = *(const LAS bf16x8*)(lds + PG8_SA(b, h) + aoff + m * 2048 + k * 1024); } while (0)
#define PG8_LDB(dst, b, h) do { _Pragma("unroll") for (int n = 0; n < 2; ++n) _Pragma("unroll") for (int k = 0; k < 2; ++k) dst[n][k] = *(const LAS bf16x8*)(lds + PG8_SB(b, h) + boff + n * 2048 + k * 1024); } while (0)
#define PG8_MMA(ai, bj, At, Bt) do { __builtin_amdgcn_s_setprio(1); _Pragma("unroll") for (int m = 0; m < 4; ++m) _Pragma("unroll") for (int n = 0; n < 2; ++n) _Pragma("unroll") for (int k = 0; k < 2; ++k) \
        acc[ai][bj][m][n] = __builtin_amdgcn_mfma_f32_16x16x32_bf16(Bt[n][k], At[m][k], acc[ai][bj][m][n], 0, 0, 0); __builtin_amdgcn_s_setprio(0); } while (0)
#define PG8_WAIT_V(n) asm volatile("s_waitcnt vmcnt(" #n ")" ::: "memory")
#define PG8_WAIT_L(n) asm volatile("s_waitcnt lgkmcnt(" #n ")" ::: "memory")
#define PG8_BAR __builtin_amdgcn_s_barrier()
#define PG8_SCHED __builtin_amdgcn_sched_barrier(0)
#define PG8_ROWS(u, va) do { _Pragma("unroll") for (int _h = 0; _h < 2; ++_h) _Pragma("unroll") for (int _i = 0; _i < 2; ++_i) \
        va[_h][_i] = (unsigned)(S.arow(u, _h * HALF + Rr[_i]) * lda + Cc[_i]) * 2u; } while (0)
    Unit cur, nxt; int ui = 0;
    if (!S.next(0, cur)) return;
    unsigned vaC[2][2], vaN[2][2];
    PG8_ROWS(cur, vaC);
    f32x4 acc[2][2][4][2];
#pragma unroll
    for (int a = 0; a < 2; ++a)
#pragma unroll
        for (int b = 0; b < 2; ++b)
#pragma unroll
            for (int m = 0; m < 4; ++m)
#pragma unroll
                for (int n = 0; n < 2; ++n) acc[a][b][m][n] = (f32x4){0.f, 0.f, 0.f, 0.f};
    bf16x8 At[4][2], B0[2][2], B1[2][2];
    const char* cB = cur.bptr;
    PG8_STAGE(PG8_SB(0, 0), cB, voffB); PG8_STAGE(PG8_SB(0, 1), cB + hstepB, voffB); PG8_STAGE(PG8_SA(0, 0), Abase, vaC[0]); PG8_STAGE(PG8_SA(0, 1), Abase, vaC[1]);
    if (wr == 1) PG8_BAR;
    PG8_WAIT_V(2); PG8_BAR;
    PG8_STAGE(PG8_SB(1, 0), cB + kstep, voffB); PG8_STAGE(PG8_SA(1, 0), Abase + kstep, vaC[0]); PG8_STAGE(PG8_SB(1, 1), cB + hstepB + kstep, voffB);
    PG8_WAIT_V(6); PG8_BAR;
    for (;;) {
        const bool has_next = S.next(ui + 1, nxt);
        if (has_next) { PG8_ROWS(nxt, vaN); } else { nxt = cur;
#pragma unroll
            for (int h = 0; h < 2; ++h)
#pragma unroll
                for (int i = 0; i < 2; ++i) vaN[h][i] = vaC[h][i]; }
        const char* nB = nxt.bptr;
        for (int t = 0; t < nt; t += 2) {
            const bool last = (t == nt - 2);
            const char* a1 = Abase + (size_t)(t + 1) * kstep;
            const char* a2 = last ? Abase : Abase + (size_t)(t + 2) * kstep; const char* b2 = last ? nB : cB + (size_t)(t + 2) * kstep;
            const char* a3 = a2 + kstep; const char* b3 = b2 + kstep;
            unsigned v2[2][2];
#pragma unroll
            for (int h = 0; h < 2; ++h)
#pragma unroll
                for (int i = 0; i < 2; ++i) v2[h][i] = last ? vaN[h][i] : vaC[h][i];
            PG8_LDB(B0, 0, 0); PG8_LDB(B1, 0, 1); PG8_SCHED; PG8_LDA(At, 0, 0); PG8_STAGE(PG8_SA(1, 1), a1, vaC[1]);
            PG8_WAIT_V(8); PG8_WAIT_L(0); PG8_BAR; PG8_MMA(0, 0, At, B0); PG8_MMA(0, 1, At, B1); PG8_BAR; PG8_SCHED;
            PG8_LDA(At, 0, 1); PG8_STAGE(PG8_SB(0, 0), b2, voffB); PG8_STAGE(PG8_SB(0, 1), b2 + hstepB, voffB); PG8_STAGE(PG8_SA(0, 0), a2, v2[0]);
            PG8_WAIT_V(8); PG8_WAIT_L(0); PG8_BAR; PG8_MMA(1, 0, At, B0); PG8_MMA(1, 1, At, B1); PG8_BAR; PG8_SCHED;
            PG8_LDB(B0, 1, 0); PG8_LDB(B1, 1, 1); PG8_SCHED; PG8_LDA(At, 1, 0); PG8_STAGE(PG8_SA(0, 1), a2, v2[1]);
            PG8_WAIT_V(8); PG8_WAIT_L(0); PG8_BAR; PG8_MMA(0, 0, At, B0); PG8_MMA(0, 1, At, B1); PG8_BAR; PG8_SCHED;
            PG8_LDA(At, 1, 1); PG8_STAGE(PG8_SB(1, 0), b3, voffB); PG8_STAGE(PG8_SB(1, 1), b3 + hstepB, voffB); PG8_STAGE(PG8_SA(1, 0), a3, v2[0]);
            PG8_WAIT_V(8); PG8_WAIT_L(0); PG8_BAR; PG8_MMA(1, 0, At, B0); PG8_MMA(1, 1, At, B1); PG8_BAR; PG8_SCHED;
        }
        if constexpr (ALIGN_EPI) { if (wr == 0) PG8_BAR; }
        E(acc, cur, wr, wc, fr, fq);
        if (!has_next) break;
#pragma unroll
        for (int a = 0; a < 2; ++a)
#pragma unroll
            for (int b = 0; b < 2; ++b)
#pragma unroll
                for (int m = 0; m < 4; ++m)
#pragma unroll
                    for (int n = 0; n < 2; ++n) acc[a][b][m][n] = (f32x4){0.f, 0.f, 0.f, 0.f};
        cur = nxt; cB = nB; ++ui;
#pragma unroll
        for (int h = 0; h < 2; ++h)
#pragma unroll
            for (int i = 0; i < 2; ++i) vaC[h][i] = vaN[h][i];
        if constexpr (ALIGN_EPI) { if (wr == 1) PG8_BAR; }
    }
    PG8_WAIT_V(0);
    if constexpr (!ALIGN_EPI) { if (wr == 0) PG8_BAR; }
    PG8_BAR;
#undef PG8_SA
#undef PG8_SB
#undef PG8_STAGE
#undef PG8_LDA
#undef PG8_LDB
#undef PG8_MMA
#undef PG8_WAIT_V
#undef PG8_WAIT_L
#undef PG8_BAR
#undef PG8_SCHED
#undef PG8_ROWS
}
}
#define XB_TMO      128
#define XB_XCNT(j)  (256  + 64 * (j))
#define XB_XSUB(j)  (1280 + 64 * (j))
#define XB_XGEN(j)  (2304 + 64 * (j))
#define XB_TOP      3328
#define XB_TOPGEN   3392
#define XCD_BAR_WORDS 3456
#define XB_SPIN_CAP (1u << 18)

__device__ __forceinline__ unsigned xb_ld(unsigned* p)              { return __hip_atomic_load(p, __ATOMIC_RELAXED, __HIP_MEMORY_SCOPE_AGENT); }
__device__ __forceinline__ unsigned xb_add(unsigned* p, unsigned v) { return __hip_atomic_fetch_add(p, v, __ATOMIC_RELAXED, __HIP_MEMORY_SCOPE_AGENT); }
__device__ __forceinline__ unsigned xb_xcc_id() { return (unsigned)__builtin_amdgcn_s_getreg((3 << 11) | 20) & 0xFu; }
#define XB_SPIN(cond, bar) do { unsigned _sp = 0; while (cond) { __builtin_amdgcn_s_sleep(1); \
    if ((++_sp & 255u) == 0u) { if (xb_ld(&(bar)[XB_TMO])) break; if (_sp > XB_SPIN_CAP) { atomicAdd(&(bar)[XB_TMO], 1u); break; } } } } while (0)

struct XcdBarrier {
    unsigned* bar; unsigned x;
    volatile LAS unsigned* st;
};

__device__ __forceinline__ XcdBarrier xcd_barrier_post(unsigned* bar, volatile LAS unsigned* st) {
    XcdBarrier b; b.bar = bar; b.x = xb_xcc_id(); b.st = st;
    if (threadIdx.x == 0) (void)xb_add(&bar[XB_XCNT(b.x)], 1u);
    return b;
}
__device__ __forceinline__ void xcd_barrier_complete(unsigned* bar, unsigned x, unsigned& nloc, unsigned& nx) {
    const unsigned G = gridDim.x * gridDim.y * gridDim.z;
    unsigned sum, cnt, mine, sp = 0u;
    for (;;) {
        sum = 0u; cnt = 0u; mine = 0u;
#pragma unroll
        for (unsigned j = 0; j < 16; ++j) { const unsigned c = xb_ld(&bar[XB_XCNT(j)]); sum += c; cnt += (c > 0u) ? 1u : 0u; mine = (j == x) ? c : mine; }
        if (sum == G) break;
        __builtin_amdgcn_s_sleep(1);
        if ((++sp & 255u) == 0u) { if (xb_ld(&bar[XB_TMO])) break; if (sp > XB_SPIN_CAP) { atomicAdd(&bar[XB_TMO], 1u); break; } }
    }
    nloc = mine > 0u ? mine : 1u; nx = cnt > 0u ? cnt : 1u;
}

__device__ __forceinline__ void xcd_barrier(const XcdBarrier& b) {
    asm volatile("s_waitcnt vmcnt(0)" ::: "memory");
    __syncthreads();
    if (threadIdx.x == 0) {
        unsigned* bar = b.bar;
        __builtin_amdgcn_s_waitcnt(0);
        unsigned nloc = b.st[0], nx = b.st[1];
        if (nloc == 0u) { xcd_barrier_complete(bar, b.x, nloc, nx); b.st[0] = nloc; b.st[1] = nx; }
        const unsigned old = xb_add(&bar[XB_XSUB(b.x)], 1u);
        const unsigned gen = old / nloc;
        if (old + 1u == (gen + 1u) * nloc) {
            __builtin_amdgcn_fence(__ATOMIC_RELEASE, "agent");
            asm volatile("s_waitcnt vmcnt(0)" ::: "memory");
            const unsigned og = xb_add(&bar[XB_TOP], 1u);
            const unsigned tg = og / nx;
            if (og + 1u == (tg + 1u) * nx) xb_add(&bar[XB_TOPGEN], 1u);
            else XB_SPIN(xb_ld(&bar[XB_TOPGEN]) == tg, bar);
            __builtin_amdgcn_fence(__ATOMIC_ACQUIRE, "agent");
            xb_add(&bar[XB_XGEN(b.x)], 1u);
            asm volatile("s_waitcnt vmcnt(0)" ::: "memory");
        } else {
            XB_SPIN(xb_ld(&bar[XB_XGEN(b.x)]) == gen, bar);
            __builtin_amdgcn_fence(__ATOMIC_ACQUIRE, "agent");
            asm volatile("s_waitcnt vmcnt(0)" ::: "memory");
        }
    }
    __syncthreads();
}
namespace pg8 {
struct EpiProj {
    static constexpr bool PERM = true;
    bf16_t* base;
    __device__ __forceinline__ void operator()(const f32x4 (&acc)[2][2][4][2], const Unit& u, int wr, int wc, int fr, int fq) const {
        const int buf = u.pn >> 2, colt = (u.pn & 3) * 256;
        const float sc = (u.pn < 2 || u.pn == 6 || u.pn == 7) ? C2 : 1.0f;
        bf16_t* dst = base + (size_t)buf * (PROJ_STRIDE / 2);
        const int row0 = u.row0 + wr * 64 + fr, col0 = colt + wc * 32 + 8 * fq;
#pragma unroll
        for (int ai = 0; ai < 2; ++ai)
#pragma unroll
            for (int m = 0; m < 4; ++m) { bf16_t* rowp = dst + (size_t)(row0 + ai * HALF + m * 16) * 1024 + col0;
#pragma unroll
                for (int bj = 0; bj < 2; ++bj) { const f32x4 v0 = acc[ai][bj][m][0] * sc, v1 = acc[ai][bj][m][1] * sc;
                    u32x4 w; w.x = cvt_pk_bf16(v0[0], v0[1]); w.y = cvt_pk_bf16(v0[2], v0[3]); w.z = cvt_pk_bf16(v1[0], v1[1]); w.w = cvt_pk_bf16(v1[2], v1[3]);
                    *(u32x4*)(rowp + bj * HALF) = w; } }
    }
};
struct EpiBrA {
    static constexpr bool PERM = true;
    const bf16_t* gl; float* t1;
    __device__ __forceinline__ void operator()(const f32x4 (&acc)[2][2][4][2], const Unit& u, int wr, int wc, int fr, int fq) const {
        const int row0 = u.row0 + wr * 64 + fr, col0 = u.pn * 256 + wc * 32 + 8 * fq;
#pragma unroll
        for (int ai = 0; ai < 2; ++ai)
#pragma unroll
            for (int m = 0; m < 4; ++m) { const size_t ro = (size_t)(row0 + ai * HALF + m * 16) * 1024 + col0;
#pragma unroll
                for (int bj = 0; bj < 2; ++bj) { const u32x4 g = *(const u32x4*)(gl + ro + bj * HALF); const f32x4 v0 = acc[ai][bj][m][0], v1 = acc[ai][bj][m][1];
                    f32x4 a, b;
                    a[0] = sigmoidf_fast(bf_lo(g.x)) * v0[0]; a[1] = sigmoidf_fast(bf_hi(g.x)) * v0[1]; a[2] = sigmoidf_fast(bf_lo(g.y)) * v0[2]; a[3] = sigmoidf_fast(bf_hi(g.y)) * v0[3];
                    b[0] = sigmoidf_fast(bf_lo(g.z)) * v1[0]; b[1] = sigmoidf_fast(bf_hi(g.z)) * v1[1]; b[2] = sigmoidf_fast(bf_lo(g.w)) * v1[2]; b[3] = sigmoidf_fast(bf_hi(g.w)) * v1[3];
                    *(f32x4*)(t1 + ro + bj * HALF) = a; *(f32x4*)(t1 + ro + bj * HALF + 4) = b; } }
    }
};
struct EpiBrB {
    static constexpr bool PERM = true;
    const bf16_t* gl; const float* t1; bf16_t* out;
    __device__ __forceinline__ void operator()(const f32x4 (&acc)[2][2][4][2], const Unit& u, int wr, int wc, int fr, int fq) const {
        const int row0 = u.row0 + wr * 64 + fr, col0 = u.pn * 256 + wc * 32 + 8 * fq;
#pragma unroll
        for (int ai = 0; ai < 2; ++ai)
#pragma unroll
            for (int m = 0; m < 4; ++m) { const size_t ro = (size_t)(row0 + ai * HALF + m * 16) * 1024 + col0;
#pragma unroll
                for (int bj = 0; bj < 2; ++bj) { const u32x4 g = *(const u32x4*)(gl + ro + bj * HALF); const f32x4 v0 = acc[ai][bj][m][0], v1 = acc[ai][bj][m][1];
                    const f32x4 ta = *(const f32x4*)(t1 + ro + bj * HALF), tb = *(const f32x4*)(t1 + ro + bj * HALF + 4);
                    f32x4 a, b;
                    a[0] = ta[0] + sigmoidf_fast(bf_lo(g.x)) * v0[0]; a[1] = ta[1] + sigmoidf_fast(bf_hi(g.x)) * v0[1]; a[2] = ta[2] + sigmoidf_fast(bf_lo(g.y)) * v0[2]; a[3] = ta[3] + sigmoidf_fast(bf_hi(g.y)) * v0[3];
                    b[0] = tb[0] + sigmoidf_fast(bf_lo(g.z)) * v1[0]; b[1] = tb[1] + sigmoidf_fast(bf_hi(g.z)) * v1[1]; b[2] = tb[2] + sigmoidf_fast(bf_lo(g.w)) * v1[2]; b[3] = tb[3] + sigmoidf_fast(bf_hi(g.w)) * v1[3];
                    u32x4 w; w.x = cvt_pk_bf16(a[0], a[1]); w.y = cvt_pk_bf16(a[2], a[3]); w.z = cvt_pk_bf16(b[0], b[1]); w.w = cvt_pk_bf16(b[2], b[3]);
                    *(u32x4*)(out + ro + bj * HALF) = w; } }
    }
};
struct EpiOut {
    static constexpr bool PERM = false;
    const float* x; const float* adaf; float* x1;
    __device__ __forceinline__ void operator()(const f32x4 (&acc)[2][2][4][2], const Unit& u, int wr, int wc, int fr, int fq) const {
        const int row0 = u.row0 + wr * 64 + fr, col0 = u.pn * 256 + wc * 32 + 4 * fq;
        const float* gt = adaf + (u.row0 >= SEQ ? 6144 : 0) + 2048;
        f32x4 gv[2][2];
#pragma unroll
        for (int bj = 0; bj < 2; ++bj)
#pragma unroll
            for (int n = 0; n < 2; ++n) gv[bj][n] = *(const f32x4*)(gt + col0 + bj * HALF + n * 16);
#pragma unroll
        for (int ai = 0; ai < 2; ++ai)
#pragma unroll
            for (int m = 0; m < 4; ++m) { const size_t ro = (size_t)(row0 + ai * HALF + m * 16) * 1024 + col0;
#pragma unroll
                for (int bj = 0; bj < 2; ++bj)
#pragma unroll
                    for (int n = 0; n < 2; ++n) { const f32x4 xv = *(const f32x4*)(x + ro + bj * HALF + n * 16); *(f32x4*)(x1 + ro + bj * HALF + n * 16) = xv + gv[bj][n] * acc[ai][bj][m][n]; } }
    }
};
struct EpiGU {
    static constexpr bool PERM = true;
    const float* bgu; bf16_t* act;
    __device__ __forceinline__ void operator()(const f32x4 (&acc)[2][2][4][2], const Unit& u, int wr, int wc, int fr, int fq) const {
        const int row0 = u.row0 + wr * 64 + fr, col0 = u.pn * 128 + wc * 32 + 8 * fq;
        const float* bg = bgu + (size_t)u.e * 2048 + col0;
        f32x4 bgv[2], buv[2];
#pragma unroll
        for (int n = 0; n < 2; ++n) { bgv[n] = *(const f32x4*)(bg + 4 * n); buv[n] = *(const f32x4*)(bg + 1024 + 4 * n); }
#pragma unroll
        for (int ai = 0; ai < 2; ++ai)
#pragma unroll
            for (int m = 0; m < 4; ++m) { float r[8];
#pragma unroll
                for (int n = 0; n < 2; ++n)
#pragma unroll
                    for (int j = 0; j < 4; ++j) { const float gte = fminf(acc[ai][0][m][n][j] + bgv[n][j], 7.0f); const float up = fminf(fmaxf(acc[ai][1][m][n][j] + buv[n][j], -7.0f), 7.0f);
                        r[4 * n + j] = (up + 1.0f) * gte * sigmoidf_fast(1.702f * gte); }
                u32x4 w; w.x = cvt_pk_bf16(r[0], r[1]); w.y = cvt_pk_bf16(r[2], r[3]); w.z = cvt_pk_bf16(r[4], r[5]); w.w = cvt_pk_bf16(r[6], r[7]);
                *(u32x4*)(act + (size_t)(row0 + ai * HALF + m * 16) * 1024 + col0) = w; }
    }
};
struct EpiDown {
    static constexpr bool PERM = true;
    const float* bd; const float* slotw; bf16_t* out;
    __device__ __forceinline__ void operator()(const f32x4 (&acc)[2][2][4][2], const Unit& u, int wr, int wc, int fr, int fq) const {
        const int row0 = u.row0 + wr * 64 + fr, col0 = u.pn * 256 + wc * 32 + 8 * fq;
        const float* bp = bd + (size_t)u.e * 1024 + col0;
        f32x4 bv[2][2];
#pragma unroll
        for (int bj = 0; bj < 2; ++bj)
#pragma unroll
            for (int n = 0; n < 2; ++n) bv[bj][n] = *(const f32x4*)(bp + bj * HALF + 4 * n);
#pragma unroll
        for (int ai = 0; ai < 2; ++ai)
#pragma unroll
            for (int m = 0; m < 4; ++m) { const int row = row0 + ai * HALF + m * 16; const float w8 = slotw[row]; bf16_t* rowp = out + (size_t)row * 1024 + col0;
#pragma unroll
                for (int bj = 0; bj < 2; ++bj) { const f32x4 v0 = (acc[ai][bj][m][0] + bv[bj][0]) * w8, v1 = (acc[ai][bj][m][1] + bv[bj][1]) * w8;
                    u32x4 w; w.x = cvt_pk_bf16(v0[0], v0[1]); w.y = cvt_pk_bf16(v0[2], v0[3]); w.z = cvt_pk_bf16(v1[0], v1[1]); w.w = cvt_pk_bf16(v1[2], v1[3]);
                    *(u32x4*)(rowp + bj * HALF) = w; } }
    }
};
template <bool GATHER> struct MoeSched {
    const LAS int* te; int NP, G, c; const int* slot_tok; const char* W; size_t wstride, btile;
    __device__ __forceinline__ bool next(int i, Unit& u) const {
        const int ntl = te[32], nwg = ntl * NP; const long L = (long)i * G + c; if (L >= nwg) return false;
        int wgid = (int)L; { const int q = nwg / NXCD, r = nwg % NXCD, xcd = wgid % NXCD, off = wgid / NXCD; wgid = (xcd < r ? xcd * (q + 1) : r * (q + 1) + (xcd - r) * q) + off; }
        int e = 0;
        for (int k = 1; k < NE; ++k) e += (wgid >= te[k] * NP) ? 1 : 0;
        const int t0 = te[e], nte = te[e + 1] - t0, r = wgid - t0 * NP; const int pn = r / nte, t = t0 + r % nte;
        u.row0 = t * 256; u.pn = pn; u.pm = t; u.e = e; u.bptr = W + (size_t)e * wstride + (size_t)pn * btile; return true;
    }
    __device__ __forceinline__ int arow(const Unit& u, int r) const { if constexpr (GATHER) return slot_tok[u.row0 + r]; else return u.row0 + r; }
};
}

constexpr int AT_BT = 0, AT_K = 6144, AT_V = AT_K + 64 * 72 * 2, AT_MISC = 32768;
typedef short v4i16_t __attribute__((ext_vector_type(4)));
__device__ __forceinline__ s16x4 tr16(const LAS unsigned char* p) { return __builtin_bit_cast(s16x4, __builtin_amdgcn_ds_read_tr16_b64_v4i16((LAS v4i16_t*)p)); }

template <int NDT>
__device__ __forceinline__ void attn_tile(const LAS unsigned char* lds, int lane, const bf16x8 (&qf)[2], f32x4 (&o)[NDT], float& m_run, float& l_run,
                                          int qpos, int kbase, bool causal, const LAS float* bt) {
    constexpr int VSTR = NDT * 16 + 8;
    const int c = lane & 15, g = lane >> 4;
    f32x4 s[4];
#pragma unroll
    for (int kt = 0; kt < 4; ++kt) { s[kt] = (f32x4){0.f, 0.f, 0.f, 0.f};
#pragma unroll
        for (int ks = 0; ks < 2; ++ks) { const bf16x8 a = *(const LAS bf16x8*)(lds + AT_K + ((16 * kt + c) * 72 + 32 * ks + 8 * g) * 2);
            s[kt] = __builtin_amdgcn_mfma_f32_16x16x32_bf16(a, qf[ks], s[kt], 0, 0, 0); } }
    if (__any((qpos - (kbase + 63)) < 128)) {
#pragma unroll
        for (int kt = 0; kt < 4; ++kt)
#pragma unroll
            for (int i = 0; i < 4; ++i) { const int dist = qpos - (kbase + 16 * kt + 4 * g + i); const int di = dist < 0 ? 0 : (dist > 127 ? 127 : dist);
                const float bv = bt[di]; float v = s[kt][i];
                if (dist >= 0 && dist < 128) v += bv;
                if (causal && dist < 0) v = -INFINITY;
                s[kt][i] = v; }
    }
    float mx = fmaxf(fmaxf(s[0][0], s[0][1]), fmaxf(s[0][2], s[0][3]));
#pragma unroll
    for (int kt = 1; kt < 4; ++kt) mx = fmaxf(mx, fmaxf(fmaxf(s[kt][0], s[kt][1]), fmaxf(s[kt][2], s[kt][3])));
    mx = fmaxf(mx, __shfl_xor(mx, 16)); mx = fmaxf(mx, __shfl_xor(mx, 32));
    const float m_new = fmaxf(m_run, mx), alpha = __builtin_amdgcn_exp2f(m_run - m_new);
    float psum = 0.f;
#pragma unroll
    for (int kt = 0; kt < 4; ++kt)
#pragma unroll
        for (int i = 0; i < 4; ++i) { const float p = __builtin_amdgcn_exp2f(s[kt][i] - m_new); s[kt][i] = p; psum += p; }
    l_run = l_run * alpha + psum; m_run = m_new;
#pragma unroll
    for (int i = 0; i < 4; ++i) { const float ai = __shfl(alpha, 4 * g + i);
#pragma unroll
        for (int dt = 0; dt < NDT; ++dt) o[dt][i] *= ai; }
    bf16x8 pa[2];
#pragma unroll
    for (int kk = 0; kk < 2; ++kk) { u32x4 w; w.x = cvt_pk_bf16(s[2 * kk][0], s[2 * kk][1]); w.y = cvt_pk_bf16(s[2 * kk][2], s[2 * kk][3]);
        w.z = cvt_pk_bf16(s[2 * kk + 1][0], s[2 * kk + 1][1]); w.w = cvt_pk_bf16(s[2 * kk + 1][2], s[2 * kk + 1][3]); pa[kk] = __builtin_bit_cast(bf16x8, w); }
    const LAS unsigned char* vb = lds + AT_V + ((4 * g + (c >> 2)) * VSTR + 4 * (c & 3)) * 2;
#pragma unroll
    for (int dt = 0; dt < NDT; ++dt)
#pragma unroll
        for (int kk = 0; kk < 2; ++kk) { const s16x4 lo = tr16(vb + (32 * kk * VSTR + 16 * dt) * 2), hi = tr16(vb + ((32 * kk + 16) * VSTR + 16 * dt) * 2);
            const bf16x8 b = (bf16x8){lo[0], lo[1], lo[2], lo[3], hi[0], hi[1], hi[2], hi[3]};
            o[dt] = __builtin_amdgcn_mfma_f32_16x16x32_bf16(pa[kk], b, o[dt], 0, 0, 0); }
}

template <int NV> struct TileRegs { u32x4 k; u32x4 v[NV]; };
template <int NV> __device__ __forceinline__ void tile_fetch(TileRegs<NV>& r, const bf16_t* kg, const bf16_t* vg, int tid) {
    const int row = tid >> 3, ch = tid & 7;
    r.k = *(const u32x4*)(kg + (size_t)row * 1024 + ch * 8);
#pragma unroll
    for (int i = 0; i < NV; ++i) r.v[i] = *(const u32x4*)(vg + (size_t)row * 1024 + (ch + 8 * i) * 8);
}
template <int NV> __device__ __forceinline__ void tile_store(const TileRegs<NV>& r, LAS unsigned char* lds, int tid) {
    constexpr int VSTR = NV * 64 + 8;
    const int row = tid >> 3, ch = tid & 7;
    *(LAS u32x4*)(lds + AT_K + (row * 72 + ch * 8) * 2) = r.k;
#pragma unroll
    for (int i = 0; i < NV; ++i) *(LAS u32x4*)(lds + AT_V + (row * VSTR + (ch + 8 * i) * 8) * 2) = r.v[i];
}
struct Ctx {
    LAS unsigned char* lds; int tid, lane, wave, G, vcu;
    const float* in[23]; float* out; unsigned char* ws;
};
#define WSP(T, off) ((T*)(C.ws + (off)))

__device__ __forceinline__ void conv_item(const float* W, int K, int N, bf16_t* WT, int out_row0, LAS float* scr, int kb, int nb, int lane) {
    const int k0 = 64 * kb, n0 = 32 * nb;
    const int kr = lane >> 3, nc = lane & 7;
    f32x4 v[8];
#pragma unroll
    for (int i = 0; i < 8; ++i) v[i] = *(const f32x4*)(W + (size_t)(k0 + 8 * i + kr) * N + n0 + 4 * nc);
#pragma unroll
    for (int i = 0; i < 8; ++i) { LAS float* s = scr + (8 * i + kr) * 33 + 4 * nc; s[0] = v[i][0]; s[1] = v[i][1]; s[2] = v[i][2]; s[3] = v[i][3]; }
    LDS_WAIT(); asm volatile("" ::: "memory");
    const int c = lane & 7;
#pragma unroll
    for (int j = 0; j < 4; ++j) { const int n = (lane >> 3) + 8 * j; const LAS float* s = scr + (8 * c) * 33 + n;
        u32x4 o; o.x = pk2(s[0 * 33], s[1 * 33]); o.y = pk2(s[2 * 33], s[3 * 33]); o.z = pk2(s[4 * 33], s[5 * 33]); o.w = pk2(s[6 * 33], s[7 * 33]);
        *(u32x4*)(WT + (size_t)(out_row0 + n) * K + k0 + 8 * c) = o; }
    LDS_WAIT(); asm volatile("" ::: "memory");
}
__device__ __forceinline__ void p0_prologue(const Ctx& C) {
    LAS float* scr = (LAS float*)(C.lds + C.wave * 8448);
    const int gw = C.vcu * NWAVES + C.wave, NGW = C.G * NWAVES;
    constexpr int I_IN = 16 * 160, I_BR = 8 * 32, I_OUT = 16 * 32, I_GU1 = 16 * 64, I_GU = NE * I_GU1, I_D1 = 16 * 32, I_D = NE * I_D1;
    constexpr int NITEMS = I_IN + 2 * I_BR + I_OUT + I_GU + I_D;
    for (int it = gw; it < NITEMS; it += NGW) {
        int r = it;
        if (r < I_GU) { const int e = r / I_GU1, q = r % I_GU1, kb = q / 64, nb = q % 64; const int n0 = 32 * nb, half = n0 >> 10, rem = n0 & 1023;
            conv_item(C.in[18] + (size_t)e * 1024 * 2048, 1024, 2048, WSP(bf16_t, WS_WGU) + (size_t)e * 2048 * 1024, (rem >> 7) * 256 + half * 128 + (rem & 127), scr, kb, nb, C.lane); continue; } r -= I_GU;
        if (r < I_D) { const int e = r / I_D1, q = r % I_D1, kb = q / 32, nb = q % 32;
            conv_item(C.in[20] + (size_t)e * 1024 * 1024, 1024, 1024, WSP(bf16_t, WS_WD) + (size_t)e * 1024 * 1024, 32 * nb, scr, kb, nb, C.lane); continue; } r -= I_D;
        if (r < I_IN) { conv_item(C.in[6], 1024, INW, WSP(bf16_t, WS_WIN), 32 * (r % 160), scr, r / 160, r % 160, C.lane); continue; } r -= I_IN;
        if (r < I_BR) { conv_item(C.in[12], 512, 1024, WSP(bf16_t, WS_WBRA), 32 * (r % 32), scr, r / 32, r % 32, C.lane); continue; } r -= I_BR;
        if (r < I_BR) { conv_item(C.in[13], 512, 1024, WSP(bf16_t, WS_WBRB), 32 * (r % 32), scr, r / 32, r % 32, C.lane); continue; } r -= I_BR;
        conv_item(C.in[14], 1024, 1024, WSP(bf16_t, WS_WOUT), 32 * (r % 32), scr, r / 32, r % 32, C.lane);
    }
    const float* cvec = C.in[1]; const float* wada = C.in[3]; float* adap = WSP(float, WS_ADAP);
    for (int it = gw; it < 96 * 8; it += NGW) { const int cc = it % 96, ks = it / 96; const int n = 64 * cc + C.lane; float a0 = 0.f, a1 = 0.f;
#pragma unroll 8
        for (int k = 0; k < 128; ++k) { const int kk = 128 * ks + k; const float w = wada[(size_t)kk * 6144 + n]; a0 += cvec[kk] * w; a1 += cvec[1024 + kk] * w; }
        adap[(ks * 2 + 0) * 6144 + n] = a0; adap[(ks * 2 + 1) * 6144 + n] = a1; }
}
__device__ __forceinline__ float ada_val(const Ctx& C, int b, int n) {
    const float* adap = WSP(const float, WS_ADAP); float s = C.in[4][n];
#pragma unroll
    for (int ks = 0; ks < 8; ++ks) s += adap[(ks * 2 + b) * 6144 + n];
    return s;
}
__device__ __forceinline__ void rms_mod_row(const float* xrow, bf16_t* orow, const LAS float* MA, const LAS float* MB, int lane) {
    const f32x4* xr = (const f32x4*)xrow + lane;
    f32x4 v[4]; float s = 0.f;
#pragma unroll
    for (int j = 0; j < 4; ++j) { v[j] = xr[64 * j]; s += (v[j][0] * v[j][0] + v[j][1] * v[j][1]) + (v[j][2] * v[j][2] + v[j][3] * v[j][3]); }
    const float rstd = 1.0f / sqrtf(wave_sum(s) * (1.0f / D) + RMS_EPS);
    u32x2* o8 = (u32x2*)orow + lane;
#pragma unroll
    for (int j = 0; j < 4; ++j) { const f32x4 a = *(const LAS f32x4*)(MA + 4 * lane + 256 * j), b = *(const LAS f32x4*)(MB + 4 * lane + 256 * j);
        const f32x4 h = v[j] * rstd * a + b; u32x2 w; w.x = pk2(h[0], h[1]); w.y = pk2(h[2], h[3]); o8[64 * j] = w; }
}
__device__ __forceinline__ void p1_h1(const Ctx& C) {
    LAS float* MA = (LAS float*)C.lds;
    LAS float* MB = MA + 2048;
    for (int idx = C.tid; idx < 2048; idx += 512) { const int b = idx >> 10, col = idx & 1023;
        const float sh = ada_val(C, b, col), sc = ada_val(C, b, 1024 + col);
        MA[idx] = C.in[5][col] * (1.0f + sc); MB[idx] = sh; }
    {
        const int per = (2 * 6144 + C.G - 1) / C.G;
        for (int i = C.tid; i < per; i += 512) { const int idx = blockIdx.x * per + i; if (idx < 2 * 6144) WSP(float, WS_ADAF)[idx] = ada_val(C, idx / 6144, idx % 6144); }
    }
    __syncthreads();
    const int gw = C.vcu * NWAVES + C.wave, NGW = C.G * NWAVES;
    for (int m = gw; m < M; m += NGW) { const int b = m >= SEQ; rms_mod_row(C.in[0] + (size_t)m * D, WSP(bf16_t, WS_H) + (size_t)m * D, MA + b * 1024, MB + b * 1024, C.lane); }
    __syncthreads();
}
__device__ __forceinline__ void p3a_kmean(const Ctx& C) {
    LAS float* red = (LAS float*)C.lds;
    const bf16_t* kb = WSP(const bf16_t, WS_PROJ + 2 * PROJ_STRIDE);
    for (int it = blockIdx.x; it < 64; it += C.G) { const int b = it >> 5, n = it & 31;
        float a[8];
#pragma unroll
        for (int j = 0; j < 8; ++j) a[j] = 0.f;
        const bf16_t* src = kb + (size_t)(b * SEQ + 256 * n + 32 * C.wave) * 1024 + 8 * C.lane;
#pragma unroll 8
        for (int r = 0; r < 32; ++r) { const u32x4 v = *(const u32x4*)(src + (size_t)r * 1024);
            a[0] += bf_lo(v.x); a[1] += bf_hi(v.x); a[2] += bf_lo(v.y); a[3] += bf_hi(v.y); a[4] += bf_lo(v.z); a[5] += bf_hi(v.z); a[6] += bf_lo(v.w); a[7] += bf_hi(v.w); }
        __syncthreads();
#pragma unroll
        for (int j = 0; j < 8; ++j) red[C.wave * 512 + 8 * C.lane + j] = a[j];
        __syncthreads();
        { const int col = C.tid; float s = 0.f;
#pragma unroll
            for (int w = 0; w < 8; ++w) s += red[w * 512 + col];
            const int h = col >> 6, d = col & 63; WSP(float, WS_KMEAN)[((b * 8 + h) * 32 + n) * 64 + d] = s * (1.0f / 256.0f); }
    }
    __syncthreads();
}
__device__ __forceinline__ void p3b_gate(const Ctx& C) {
    LAS float* km = (LAS float*)C.lds;
    const bf16_t* qb = WSP(const bf16_t, WS_PROJ + 1 * PROJ_STRIDE) + 512;
    unsigned* cnt = WSP(unsigned, WS_CTL) + CW_MCNT; unsigned* list = WSP(unsigned, WS_LIST);
    for (int it = blockIdx.x; it < 256; it += C.G) { const int bh = it >> 4, qc = it & 15, b = bh >> 3, h = bh & 7;
        __syncthreads();
        for (int i = C.tid; i < 2048; i += 512) km[i] = WSP(const float, WS_KMEAN)[bh * 2048 + i];
        __syncthreads();
        const int q = 512 * qc + C.tid, own = q >> 8;
        u32x4 qv[8];
        { const u32x4* qp = (const u32x4*)(qb + (size_t)(b * SEQ + q) * 1024 + h * 64);
#pragma unroll
            for (int j = 0; j < 8; ++j) qv[j] = qp[j]; }
        float v0 = -INFINITY, v1 = -INFINITY, v2 = -INFINITY; int i0 = 0, i1 = 0, i2 = 0;
        const int nmax = ((512 * qc + 511) >> 8);
        for (int n = 0; n < nmax; ++n) { const LAS f32x4* kr = (const LAS f32x4*)(km + n * 64); float s = 0.f;
#pragma unroll
            for (int j = 0; j < 8; ++j) { const f32x4 ka = kr[2 * j], kb2 = kr[2 * j + 1];
                s += bf_lo(qv[j].x) * ka[0] + bf_hi(qv[j].x) * ka[1] + bf_lo(qv[j].y) * ka[2] + bf_hi(qv[j].y) * ka[3]
                   + bf_lo(qv[j].z) * kb2[0] + bf_hi(qv[j].z) * kb2[1] + bf_lo(qv[j].w) * kb2[2] + bf_hi(qv[j].w) * kb2[3]; }
            if (n < own) {
                if (s > v0) { v2 = v1; i2 = i1; v1 = v0; i1 = i0; v0 = s; i0 = n; }
                else if (s > v1) { v2 = v1; i2 = i1; v1 = s; i1 = n; }
                else if (s > v2) { v2 = s; i2 = n; }
            } }
        const int nsel = own < 3 ? own : 3;
#pragma unroll
        for (int j = 0; j < 3; ++j) if (j < nsel) { const int n = j == 0 ? i0 : (j == 1 ? i1 : i2);
            const unsigned pos = atomicAdd(cnt + bh * 32 + n, 1u);
            list[(size_t)bh * LIST_PER_BH + 256 * (31 * n - (n * (n - 1)) / 2) + pos] = (unsigned)q | ((unsigned)j << 13); }
    }
    __syncthreads();
}
__device__ __forceinline__ void build_bias_tables(const Ctx& C) {
    LAS float* bt = (LAS float*)(C.lds + AT_BT);
    for (int idx = C.tid; idx < 12 * 128; idx += 512) { const int hd = idx >> 7, n = idx & 127;
        int bk;
        if (n < 16) bk = n; else { const float nf = (float)n; int lg = 16 + (int)(logf(nf / 16.0f) / logf(8.0f) * 16.0f); bk = lg < 31 ? lg : 31; }
        bt[idx] = (C.in[2][bk * 12 + hd] - C.in[2][31 * 12 + hd]) * LOG2E; }
}
__device__ __forceinline__ void diff_unit(const Ctx& C, int b, int h, int qblk, float lam) {
    const int lane = C.lane, c = lane & 15, g = lane >> 4, wid = C.wave;
    const bf16_t* qka = WSP(const bf16_t, WS_PROJ);
    const bf16_t* va = WSP(const bf16_t, WS_PROJ + PROJ_STRIDE);
    const int q0 = qblk * 128, q = q0 + wid * 16 + c, NT = 2 * qblk + 2;
    const LAS float* bt = (const LAS float*)(C.lds + AT_BT) + h * 128;
    f32x4 o0[8];
    for (int map = 0; map < 2; ++map) {
        bf16x8 qf[2];
#pragma unroll
        for (int ks = 0; ks < 2; ++ks) qf[ks] = *(const bf16x8*)(qka + (size_t)(b * SEQ + q) * 1024 + h * 128 + map * 64 + 32 * ks + 8 * g);
        const bf16_t* kg = qka + (size_t)(b * SEQ) * 1024 + 512 + h * 128 + map * 64;
        const bf16_t* vg = va + (size_t)(b * SEQ) * 1024 + h * 128;
        float m_run = -1e30f, l_run = 0.f; f32x4 o[8];
#pragma unroll
        for (int dt = 0; dt < 8; ++dt) o[dt] = (f32x4){0.f, 0.f, 0.f, 0.f};
        TileRegs<2> tr; tile_fetch<2>(tr, kg, vg, C.tid);
        for (int t = 0; t < NT; ++t) {
            __syncthreads();
            tile_store<2>(tr, C.lds, C.tid);
            __syncthreads();
            if (t + 1 < NT) tile_fetch<2>(tr, kg + (size_t)(t + 1) * 64 * 1024, vg + (size_t)(t + 1) * 64 * 1024, C.tid);
            attn_tile<8>(C.lds, lane, qf, o, m_run, l_run, q, 64 * t, true, bt);
        }
        float lt = l_run; lt += __shfl_xor(lt, 16); lt += __shfl_xor(lt, 32);
        const float rl = 1.0f / lt;
#pragma unroll
        for (int i = 0; i < 4; ++i) { const float ri = __shfl(rl, 4 * g + i);
#pragma unroll
            for (int dt = 0; dt < 8; ++dt) { if (map == 0) o0[dt][i] = o[dt][i] * ri; else o0[dt][i] = o0[dt][i] - lam * (o[dt][i] * ri); } }
    }
    bf16_t* y = WSP(bf16_t, WS_Y);
#pragma unroll
    for (int i = 0; i < 4; ++i) { float ss = 0.f;
#pragma unroll
        for (int dt = 0; dt < 8; ++dt) ss += o0[dt][i] * o0[dt][i];
        ss += __shfl_xor(ss, 1); ss += __shfl_xor(ss, 2); ss += __shfl_xor(ss, 4); ss += __shfl_xor(ss, 8);
        const float rstd = 1.0f / sqrtf(ss * (1.0f / 128.0f) + RMS_EPS);
        bf16_t* yr = y + (size_t)(b * SEQ + q0 + wid * 16 + 4 * g + i) * 1024 + h * 128 + c;
#pragma unroll
        for (int dt = 0; dt < 8; ++dt) yr[16 * dt] = (bf16_t)f2bf(o0[dt][i] * rstd * C.in[11][16 * dt + c] * 0.8f); }
}
__device__ __forceinline__ void moba_item(const Ctx& C, int b, int h, int n, bool own, int half, const unsigned* lst, int lcnt, int chunk) {
    const int lane = C.lane, c = lane & 15, g = lane >> 4, wid = C.wave;
    const bf16_t* qb = WSP(const bf16_t, WS_PROJ + PROJ_STRIDE) + 512;
    const bf16_t* kv = WSP(const bf16_t, WS_PROJ + 2 * PROJ_STRIDE);
    int qtok, jslot; bool valid;
    if (own) { qtok = 256 * n + 128 * half + wid * 16 + c; jslot = 3; valid = true; }
    else { const int idx = chunk * 128 + wid * 16 + c; valid = idx < lcnt; const unsigned e = lst[valid ? idx : 0]; qtok = (int)(e & 8191u); jslot = (int)(e >> 13); }
    bf16x8 qf[2];
#pragma unroll
    for (int ks = 0; ks < 2; ++ks) qf[ks] = *(const bf16x8*)(qb + (size_t)(b * SEQ + qtok) * 1024 + h * 64 + 32 * ks + 8 * g);
    const bf16_t* kg = kv + (size_t)(b * SEQ + 256 * n) * 1024 + h * 64;
    const bf16_t* vg = kg + 512;
    const LAS float* bt = (const LAS float*)(C.lds + AT_BT) + (4 + h) * 128;
    const int NT = own ? 2 * (half + 1) : 4;
    float m_run = -1e30f, l_run = 0.f; f32x4 o[4];
#pragma unroll
    for (int dt = 0; dt < 4; ++dt) o[dt] = (f32x4){0.f, 0.f, 0.f, 0.f};
    TileRegs<1> tr; tile_fetch<1>(tr, kg, vg, C.tid);
    for (int t = 0; t < NT; ++t) {
        __syncthreads();
        tile_store<1>(tr, C.lds, C.tid);
        __syncthreads();
        if (t + 1 < NT) tile_fetch<1>(tr, kg + (size_t)(t + 1) * 64 * 1024, vg + (size_t)(t + 1) * 64 * 1024, C.tid);
        attn_tile<4>(C.lds, lane, qf, o, m_run, l_run, qtok, 256 * n + 64 * t, own, bt);
    }
    float lt = l_run; lt += __shfl_xor(lt, 16); lt += __shfl_xor(lt, 32);
    const int slot = ((b * SEQ + qtok) * 8 + h) * 4 + jslot;
    if (g == 0 && valid) { f32x2 ml; ml[0] = m_run; ml[1] = lt; *(f32x2*)(WSP(float, WS_PML) + (size_t)slot * 2) = ml; }
    bf16_t* po = WSP(bf16_t, WS_PO);
#pragma unroll
    for (int i = 0; i < 4; ++i) { const int sl = __shfl(slot, 4 * g + i); const int vl = __shfl((int)valid, 4 * g + i);
        if (vl) {
#pragma unroll
            for (int dt = 0; dt < 4; ++dt) po[(size_t)sl * 64 + 16 * dt + c] = (bf16_t)f2bf(o[dt][i]); } }
}
__device__ __forceinline__ void p4_attention(const Ctx& C) {
    __syncthreads();
    build_bias_tables(C);
    float lam;
    { const float a = wave_sum(C.in[7][C.lane] * C.in[8][C.lane]), b2 = wave_sum(C.in[9][C.lane] * C.in[10][C.lane]); lam = expf(a) - expf(b2) + 0.2f; }
    __syncthreads();
    for (int p = blockIdx.x; p < 256; p += C.G) { const int bh = p >> 5, qa = p & 31;
        diff_unit(C, bh >> 2, bh & 3, qa, lam); diff_unit(C, bh >> 2, bh & 3, 63 - qa, lam); }
    LAS int* pre = (LAS int*)(C.lds + AT_MISC);
    LAS int* wtot = pre + 520;
    const unsigned* cnt = WSP(const unsigned, WS_CTL) + CW_MCNT;
    __syncthreads();
    { const int L = C.tid; const int nch = ((int)__hip_atomic_load(cnt + L, RLX_AGENT) + 127) >> 7;
        int inc = nch;
#pragma unroll
        for (int o = 1; o < 64; o <<= 1) { const int t = __shfl_up(inc, o); if (C.lane >= o) inc += t; }
        if (C.lane == 63) wtot[C.wave] = inc;
        __syncthreads();
        int base = 0;
        for (int w = 0; w < C.wave; ++w) base += wtot[w];
        pre[L] = base + inc - nch;
        if (L == 511) pre[512] = base + inc;
    }
    __syncthreads();
    const int ngath = pre[512];
    for (int it = blockIdx.x; it < 1024 + ngath; it += C.G) {
        if (it < 1024) { const int bh = it >> 6, r = it & 63; moba_item(C, bh >> 3, bh & 7, r >> 1, true, r & 1, nullptr, 0, 0); }
        else { const int gi = it - 1024; int lo = 0, hi = 511;
            while (lo < hi) { const int mid = (lo + hi + 1) >> 1; if (pre[mid] <= gi) lo = mid; else hi = mid - 1; }
            const int L = lo, bh = L >> 5, n = L & 31;
            const int lcnt = (int)__hip_atomic_load(cnt + L, RLX_AGENT);
            moba_item(C, bh >> 3, bh & 7, n, false, 0, WSP(const unsigned, WS_LIST) + (size_t)bh * LIST_PER_BH + 256 * (31 * n - (n * (n - 1)) / 2), lcnt, gi - pre[L]); }
    }
    __syncthreads();
}
__device__ __forceinline__ void p5_ycombine(const Ctx& C) {
    const int gw = C.vcu * NWAVES + C.wave, NGW = C.G * NWAVES;
    const bf16_t* po = WSP(const bf16_t, WS_PO); const float* pml = WSP(const float, WS_PML); bf16_t* y = WSP(bf16_t, WS_Y);
    for (int m = gw; m < M; m += NGW) { const int h = C.lane >> 3, dch = C.lane & 7; const int own = (m & (SEQ - 1)) >> 8, nsel = own < 3 ? own : 3;
        const size_t s0 = ((size_t)m * 8 + h) * 4;
        float mm[4], ll[4]; u32x4 ov[4];
#pragma unroll
        for (int j = 0; j < 4; ++j) { const bool use = (j == 3) || (j < nsel);
            if (use) { const f32x2 ml = *(const f32x2*)(pml + (s0 + j) * 2); mm[j] = ml[0]; ll[j] = ml[1]; ov[j] = *(const u32x4*)(po + (s0 + j) * 64 + 8 * dch); }
            else { mm[j] = -INFINITY; ll[j] = 0.f; ov[j] = (u32x4){0u, 0u, 0u, 0u}; } }
        const float mx = fmaxf(fmaxf(mm[0], mm[1]), fmaxf(mm[2], mm[3]));
        float den = 0.f; float acc[8];
#pragma unroll
        for (int k = 0; k < 8; ++k) acc[k] = 0.f;
#pragma unroll
        for (int j = 0; j < 4; ++j) { const float w = __builtin_amdgcn_exp2f(mm[j] - mx); den += w * ll[j];
            acc[0] += w * bf_lo(ov[j].x); acc[1] += w * bf_hi(ov[j].x); acc[2] += w * bf_lo(ov[j].y); acc[3] += w * bf_hi(ov[j].y);
            acc[4] += w * bf_lo(ov[j].z); acc[5] += w * bf_hi(ov[j].z); acc[6] += w * bf_lo(ov[j].w); acc[7] += w * bf_hi(ov[j].w); }
        const float r = 1.0f / den;
        u32x4 w; w.x = pk2(acc[0] * r, acc[1] * r); w.y = pk2(acc[2] * r, acc[3] * r); w.z = pk2(acc[4] * r, acc[5] * r); w.w = pk2(acc[6] * r, acc[7] * r);
        *(u32x4*)(y + (size_t)m * 1024 + 512 + h * 64 + 8 * dch) = w; }
}
__device__ __forceinline__ void p8_router(const Ctx& C) {
    LAS float* MA = (LAS float*)C.lds; LAS float* MB = MA + 2048;
    LAS int* hist = (LAS int*)(C.lds + 16384);
    for (int idx = C.tid; idx < 2048; idx += 512) { const int b = idx >> 10, col = idx & 1023; const float* af = WSP(const float, WS_ADAF) + b * 6144;
        MA[idx] = C.in[15][col] * (1.0f + af[4096 + col]); MB[idx] = af[3072 + col]; }
    if (C.tid < 32) hist[C.tid] = 0;
    __syncthreads();
    bf16_t* h2 = WSP(bf16_t, WS_H);
    for (int blk = blockIdx.x; blk < M / 64; blk += C.G) {
        const int r0 = 64 * blk, b = r0 >= SEQ;
        for (int r = 0; r < 8; ++r) { const int m = r0 + 8 * C.wave + r; rms_mod_row(WSP(const float, WS_X1) + (size_t)m * D, h2 + (size_t)m * D, MA + b * 1024, MB + b * 1024, C.lane); }
        VM_WAIT(); __syncthreads();
        if (C.wave < 4) { const int lane = C.lane, c = lane & 15, g = lane >> 4; const int rb = r0 + 16 * C.wave;
            f32x4 lg[2]; lg[0] = (f32x4){0.f, 0.f, 0.f, 0.f}; lg[1] = lg[0];
            const bf16_t* ar = h2 + (size_t)(rb + c) * D + 8 * g; const float* wr = C.in[16];
            for (int ks = 0; ks < 32; ++ks) { const bf16x8 a = *(const bf16x8*)(ar + 32 * ks);
#pragma unroll
                for (int nt = 0; nt < 2; ++nt) { const float* wp = wr + (size_t)(32 * ks + 8 * g) * 32 + 16 * nt + c; u32x4 w;
                    w.x = pk2(wp[0], wp[32]); w.y = pk2(wp[64], wp[96]); w.z = pk2(wp[128], wp[160]); w.w = pk2(wp[192], wp[224]);
                    lg[nt] = __builtin_amdgcn_mfma_f32_16x16x32_bf16(a, __builtin_bit_cast(bf16x8, w), lg[nt], 0, 0, 0); } }
            const float br0 = C.in[17][c], br1 = C.in[17][16 + c];
#pragma unroll
            for (int i = 0; i < 4; ++i) { float a0 = lg[0][i] + br0, a1 = lg[1][i] + br1; float tv[4]; int ti[4];
#pragma unroll
                for (int k = 0; k < 4; ++k) { float bv; int bi; if (a1 > a0) { bv = a1; bi = 16 + c; } else { bv = a0; bi = c; }
#pragma unroll
                    for (int o = 1; o < 16; o <<= 1) { const float ov = __shfl_xor(bv, o); const int oi = __shfl_xor(bi, o); if (ov > bv || (ov == bv && oi < bi)) { bv = ov; bi = oi; } }
                    tv[k] = bv; ti[k] = bi; if (bi == c) a0 = -INFINITY; if (bi == 16 + c) a1 = -INFINITY; }
                if (c == 0) { const int row = rb + 4 * g + i; const float e1 = __expf(tv[1] - tv[0]), e2 = __expf(tv[2] - tv[0]), e3 = __expf(tv[3] - tv[0]); const float inv = 1.0f / (1.0f + e1 + e2 + e3);
                    *(int4*)(WSP(int, WS_TOPI) + (size_t)row * 4) = make_int4(ti[0], ti[1], ti[2], ti[3]);
                    *(f32x4*)(WSP(float, WS_TOPW) + (size_t)row * 4) = (f32x4){inv, e1 * inv, e2 * inv, e3 * inv};
                    atomicAdd((int*)(hist + ti[0]), 1); atomicAdd((int*)(hist + ti[1]), 1); atomicAdd((int*)(hist + ti[2]), 1); atomicAdd((int*)(hist + ti[3]), 1); } }
        }
        __syncthreads();
        if (C.tid < 32) { WSP(int, WS_HIST)[blk * 32 + C.tid] = hist[C.tid]; hist[C.tid] = 0; }
        __syncthreads();
    }
}
__device__ __forceinline__ void p9_slots(const Ctx& C) {
    LAS int* tot = (LAS int*)C.lds;
    LAS int* off = tot + 32;
    LAS int* cur = off + 40;
    const int* hist = WSP(const int, WS_HIST);
    for (int blk = blockIdx.x; blk < M / 64; blk += C.G) {
        __syncthreads();
        if (C.tid < 32) { int t = 0, p = 0; for (int w = 0; w < M / 64; ++w) { const int v = hist[w * 32 + C.tid]; t += v; p += (w < blk) ? v : 0; } tot[C.tid] = t; cur[C.tid] = p; }
        __syncthreads();
        if (C.tid == 0) { int o = 0; for (int e = 0; e < 32; ++e) { off[e] = o; o += (tot[e] + 255) & ~255; } off[32] = o; }
        __syncthreads();
        if (C.tid < 32) cur[C.tid] += off[C.tid];
        __syncthreads();
        if (C.tid < 256) { const int token = 64 * blk + (C.tid >> 2), k = C.tid & 3; const int e = WSP(const int, WS_TOPI)[token * 4 + k];
            const int slot = atomicAdd((int*)(cur + e), 1);
            WSP(int, WS_SLOTTOK)[slot] = token; WSP(float, WS_SLOTW)[slot] = WSP(const float, WS_TOPW)[token * 4 + k]; WSP(int, WS_TOKSLOT)[token * 4 + k] = slot; }
        if (blk < 32) { const int e = blk; for (int s = off[e] + tot[e] + C.tid; s < off[e + 1]; s += 512) { WSP(int, WS_SLOTTOK)[s] = 0; WSP(float, WS_SLOTW)[s] = 0.f; } }
        if (blk == 0 && C.tid < 33) WSP(int, WS_EOFF)[C.tid] = off[C.tid];
    }
    __syncthreads();
}
__device__ __forceinline__ void p12_final(const Ctx& C) {
    const int gw = C.vcu * NWAVES + C.wave, NGW = C.G * NWAVES;
    const bf16_t* so = WSP(const bf16_t, WS_SOUT); const float* x1 = WSP(const float, WS_X1); const int* ts = WSP(const int, WS_TOKSLOT);
    for (int m = gw; m < M; m += NGW) { const float* gt = WSP(const float, WS_ADAF) + (m >= SEQ ? 6144 : 0) + 5120;
        const int4 sl = *(const int4*)(ts + (size_t)m * 4);
        f32x4 v[4]; float s = 0.f;
#pragma unroll
        for (int j = 0; j < 4; ++j) { const int col = 4 * C.lane + 256 * j; f32x4 a = (f32x4){0.f, 0.f, 0.f, 0.f};
            { const u32x2 w = *(const u32x2*)(so + (size_t)sl.x * 1024 + col); a[0] += bf_lo(w.x); a[1] += bf_hi(w.x); a[2] += bf_lo(w.y); a[3] += bf_hi(w.y); }
            { const u32x2 w = *(const u32x2*)(so + (size_t)sl.y * 1024 + col); a[0] += bf_lo(w.x); a[1] += bf_hi(w.x); a[2] += bf_lo(w.y); a[3] += bf_hi(w.y); }
            { const u32x2 w = *(const u32x2*)(so + (size_t)sl.z * 1024 + col); a[0] += bf_lo(w.x); a[1] += bf_hi(w.x); a[2] += bf_lo(w.y); a[3] += bf_hi(w.y); }
            { const u32x2 w = *(const u32x2*)(so + (size_t)sl.w * 1024 + col); a[0] += bf_lo(w.x); a[1] += bf_hi(w.x); a[2] += bf_lo(w.y); a[3] += bf_hi(w.y); }
            v[j] = *(const f32x4*)(x1 + (size_t)m * D + col) + *(const f32x4*)(gt + col) * a;
            s += (v[j][0] * v[j][0] + v[j][1] * v[j][1]) + (v[j][2] * v[j][2] + v[j][3] * v[j][3]); }
        const float rstd = 1.0f / sqrtf(wave_sum(s) * (1.0f / D) + RMS_EPS);
#pragma unroll
        for (int j = 0; j < 4; ++j) { const int col = 4 * C.lane + 256 * j; *(f32x4*)(C.out + (size_t)m * D + col) = v[j] * rstd * *(const f32x4*)(C.in[22] + col); } }
}
struct Args { const float* in[23]; float* out; unsigned char* ws; int ph_lo, ph_hi, li, pad; };
constexpr int N_PHASES = 13;
#ifndef MK_N_LAUNCHES
#define MK_N_LAUNCHES 1
#endif

__global__ void __launch_bounds__(NWAVES * 64, 2) mega_fwd(Args args) {
    extern __shared__ __attribute__((aligned(16))) unsigned char lds_raw[];
    Ctx C;
    C.lds = (LAS unsigned char*)lds_raw;
    C.tid = threadIdx.x; C.lane = C.tid & 63; C.wave = __builtin_amdgcn_readfirstlane(C.tid >> 6);
    C.G = gridDim.x; { const int bx = blockIdx.x; C.vcu = (C.G % 8 == 0) ? (bx % 8) * (C.G / 8) + bx / 8 : bx; }
#pragma unroll
    for (int i = 0; i < 23; ++i) C.in[i] = args.in[i];
    C.out = args.out; C.ws = args.ws;
    volatile LAS unsigned* MISC = (volatile LAS unsigned*)(C.lds + MISC_OFF);
    for (int u = C.tid; u < (LDS_BYTES - LDSCTL_OFF) / 4; u += NWAVES * 64) ((LAS unsigned*)(C.lds + LDSCTL_OFF))[u] = 0u;
    __syncthreads();
    unsigned* ctl = (unsigned*)(C.ws + WS_CTL);
    XcdBarrier bar = xcd_barrier_post(ctl + CW_BAR + args.li * XCD_BAR_WORDS, MISC + 8);
    const int lo = args.ph_lo, hi = args.ph_hi;
#define IN(k) (lo <= (k) && (k) < hi)
#define SEAM(k) do { if (IN(k) && IN((k) + 1)) xcd_barrier(bar); } while (0)

    if (IN(0)) { p0_prologue(C); } SEAM(0);
    if (IN(1)) { p1_h1(C); } SEAM(1);
    if (IN(2)) { pg8::DenseSched S; S.init(M, INW, C.G, (int)blockIdx.x, WSP(bf16_t, WS_WIN), 1024); pg8::EpiProj E{WSP(bf16_t, WS_PROJ)};
        pg8::gemm_phase<pg8::EpiProj, pg8::DenseSched, true>(C.lds, WSP(bf16_t, WS_H), 1024, 1024, 1024, S, E); } SEAM(2);
    if (IN(3)) { p3a_kmean(C); } SEAM(3);
    if (IN(4)) { p3b_gate(C); } SEAM(4);
    if (IN(5)) { p4_attention(C); } SEAM(5);
    if (IN(6)) { p5_ycombine(C); } SEAM(6);
    if (IN(7)) { pg8::DenseSched S; S.init(M, D, C.G, (int)blockIdx.x, WSP(bf16_t, WS_WBRA), 512); pg8::EpiBrA E{WSP(const bf16_t, WS_PROJ + 3 * PROJ_STRIDE), WSP(float, WS_T1)};
        pg8::gemm_phase<pg8::EpiBrA, pg8::DenseSched, true>(C.lds, WSP(bf16_t, WS_Y), 1024, 512, 512, S, E); } SEAM(7);
    if (IN(8)) { pg8::DenseSched S; S.init(M, D, C.G, (int)blockIdx.x, WSP(bf16_t, WS_WBRB), 512); pg8::EpiBrB E{WSP(const bf16_t, WS_PROJ + 4 * PROJ_STRIDE), WSP(const float, WS_T1), WSP(bf16_t, WS_MERGED)};
        pg8::gemm_phase<pg8::EpiBrB, pg8::DenseSched, true>(C.lds, WSP(bf16_t, WS_Y) + 512, 1024, 512, 512, S, E); } SEAM(8);
    if (IN(9)) { pg8::DenseSched S; S.init(M, D, C.G, (int)blockIdx.x, WSP(bf16_t, WS_WOUT), 1024); pg8::EpiOut E{C.in[0], WSP(const float, WS_ADAF), WSP(float, WS_X1)};
        pg8::gemm_phase<pg8::EpiOut, pg8::DenseSched, true>(C.lds, WSP(bf16_t, WS_MERGED), 1024, 1024, 1024, S, E); } SEAM(9);
    if (IN(10)) { p8_router(C); } SEAM(10);
    if (IN(11)) { p9_slots(C); } SEAM(11);
    if (IN(12)) {
        LAS int* te = (LAS int*)(C.lds + RING_BYTES + 64);
        if (C.tid < 33) te[C.tid] = WSP(const int, WS_EOFF)[C.tid] >> 8;
        __syncthreads();
        { pg8::MoeSched<true> S{te, 8, C.G, (int)blockIdx.x, WSP(const int, WS_SLOTTOK), (const char*)WSP(bf16_t, WS_WGU), (size_t)2048 * 1024 * 2, (size_t)256 * 1024 * 2};
          pg8::EpiGU E{C.in[19], WSP(bf16_t, WS_ACT)};
          pg8::gemm_phase<pg8::EpiGU, pg8::MoeSched<true>, true>(C.lds, WSP(bf16_t, WS_H), 1024, 1024, 1024, S, E); }
        xcd_barrier(bar);
        { pg8::MoeSched<false> S{te, 4, C.G, (int)blockIdx.x, nullptr, (const char*)WSP(bf16_t, WS_WD), (size_t)1024 * 1024 * 2, (size_t)256 * 1024 * 2};
          pg8::EpiDown E{C.in[21], WSP(const float, WS_SLOTW), WSP(bf16_t, WS_SOUT)};
          pg8::gemm_phase<pg8::EpiDown, pg8::MoeSched<false>, true>(C.lds, WSP(bf16_t, WS_ACT), 1024, 1024, 1024, S, E); }
        xcd_barrier(bar);
        p12_final(C);
    }
#undef IN
#undef SEAM
}

extern "C" void kernel_launch(void* const* d_in, const int* in_sizes, int n_in, void* d_out, int out_size, void* d_ws, size_t ws_size, hipStream_t stream) {
    static int grid = 0;
    if (grid == 0) {
        if (n_in != 23 || in_sizes[0] != M * D || out_size != M * D || ws_size < WS_END) { fprintf(stderr, "kernel_launch: unexpected shapes (n_in %d, in0 %d, out %d, ws %zu); nothing launched\n", n_in, n_in > 0 ? in_sizes[0] : -1, out_size, ws_size); grid = -1; return; }
        int dev = 0, cus = 0, per_cu = 0;
        if (hipGetDevice(&dev) != hipSuccess || hipDeviceGetAttribute(&cus, hipDeviceAttributeMultiprocessorCount, dev) != hipSuccess) { grid = -1; return; }
        if (hipFuncSetAttribute((const void*)mega_fwd, hipFuncAttributeMaxDynamicSharedMemorySize, LDS_BYTES) != hipSuccess) { fprintf(stderr, "kernel_launch: hipFuncSetAttribute failed\n"); grid = -1; return; }
        if (hipOccupancyMaxActiveBlocksPerMultiprocessor(&per_cu, (const void*)mega_fwd, NWAVES * 64, LDS_BYTES) != hipSuccess || per_cu < 1) { fprintf(stderr, "kernel_launch: occupancy query reports %d workgroups per CU\n", per_cu); }
        (void)hipGetLastError();
        grid = cus;
    }
    if (grid < 0) return;
    if (hipMemsetAsync((char*)d_ws + WS_CTL, 0, CTL_ZERO_BYTES, stream) != hipSuccess) { fprintf(stderr, "kernel_launch: memset failed\n"); return; }
    Args a{};
    for (int i = 0; i < 23; ++i) a.in[i] = (const float*)d_in[i];
    a.out = (float*)d_out; a.ws = (unsigned char*)d_ws;
    constexpr int NL = MK_N_LAUNCHES;
    for (int li = 0; li < NL; ++li) {
        a.ph_lo = (NL == 1) ? 0 : li; a.ph_hi = (NL == 1) ? N_PHASES : li + 1; a.li = (NL == 1) ? 0 : li; a.pad = 0;
        hipLaunchKernelGGL(mega_fwd, dim3(grid), dim3(NWAVES * 64), LDS_BYTES, stream, a);
        const hipError_t le = hipPeekAtLastError();
        if (le != hipSuccess) { fprintf(stderr, "kernel_launch: launch %d failed: %s\n", li, hipGetErrorName(le)); break; }
    }
}
```

```cpp
#include <hip/hip_runtime.h>
#include <cstdio>
#include <cstdint>
#ifndef SIMPLE_DIFF
#define SIMPLE_DIFF 0
#endif

#define GAS __attribute__((address_space(1)))
#define LAS __attribute__((address_space(3)))
typedef unsigned short bf16_t;
typedef short bf16x8 __attribute__((ext_vector_type(8)));
typedef short s16x4 __attribute__((ext_vector_type(4)));
typedef float f32x4 __attribute__((ext_vector_type(4)));
typedef float f32x2 __attribute__((ext_vector_type(2)));
typedef unsigned u32x4 __attribute__((ext_vector_type(4)));
typedef unsigned u32x2 __attribute__((ext_vector_type(2)));
#define RLX_AGENT __ATOMIC_RELAXED, __HIP_MEMORY_SCOPE_AGENT
#define LDS_WAIT() asm volatile("s_waitcnt lgkmcnt(0)" ::: "memory")
#define VM_WAIT() asm volatile("s_waitcnt vmcnt(0)" ::: "memory")

constexpr int BATCH = 2, SEQ = 8192, M = BATCH * SEQ, D = 1024, INW = 5120;
constexpr int NE = 32, TOPK = 4;
constexpr int NWAVES = 8;
constexpr float RMS_EPS = 1e-5f;
constexpr float LOG2E = 1.4426950408889634f;
constexpr float C2 = 0.125f * LOG2E;
constexpr int SLOT_ROWS = M * TOPK + NE * 256;

constexpr size_t MiB = 1u << 20, KiB = 1u << 10;
constexpr size_t WS_CTL = 0, CTL_ZERO_BYTES = 1 * MiB;
constexpr size_t WS_ADAP = 1 * MiB;
constexpr size_t WS_ADAF = 1 * MiB + 512 * KiB;
constexpr size_t WS_KMEAN = 2 * MiB;
constexpr size_t WS_TOPI = 2 * MiB + 256 * KiB;
constexpr size_t WS_TOPW = 2 * MiB + 512 * KiB;
constexpr size_t WS_TOKSLOT = 2 * MiB + 768 * KiB;
constexpr size_t WS_SLOTTOK = 3 * MiB;
constexpr size_t WS_SLOTW = 3 * MiB + 512 * KiB;
constexpr size_t WS_HIST = 4 * MiB;
constexpr size_t WS_EOFF = 4 * MiB + 64 * KiB;
constexpr size_t WS_LIST = 6 * MiB;
constexpr size_t WS_PML = 14 * MiB;
constexpr size_t WS_WIN = 18 * MiB, WS_WBRA = 28 * MiB, WS_WBRB = 29 * MiB, WS_WOUT = 30 * MiB, WS_WGU = 32 * MiB, WS_WD = 160 * MiB;
constexpr size_t WS_H = 224 * MiB;
constexpr size_t WS_PROJ = 256 * MiB;
constexpr size_t PROJ_STRIDE = 32 * MiB;
constexpr size_t WS_Y = 416 * MiB;
constexpr size_t WS_PO = 448 * MiB;
constexpr size_t WS_T1 = 512 * MiB;
constexpr size_t WS_MERGED = 576 * MiB;
constexpr size_t WS_X1 = 608 * MiB;
constexpr size_t WS_ACT = 672 * MiB;
constexpr size_t WS_SOUT = 816 * MiB;
constexpr size_t WS_OA = 960 * MiB;
constexpr size_t WS_END = 992 * MiB;
constexpr int LIST_PER_BH = 126976;
constexpr int CW_TMO = 0, CW_CODE = 1, CW_BAR = 4096, CW_MCNT = 65536;

constexpr int RING_BYTES = 131072, LDSCTL_OFF = RING_BYTES, MISC_OFF = LDSCTL_OFF + 320, LDS_BYTES = 147456;

__device__ __forceinline__ unsigned f2bf(float f) { unsigned u = __builtin_bit_cast(unsigned, f); return (u + 0x7fffu + ((u >> 16) & 1u)) >> 16; }
__device__ __forceinline__ unsigned pk2(float lo, float hi) { return f2bf(lo) | (f2bf(hi) << 16); }
__device__ __forceinline__ unsigned cvt_pk_bf16(float lo, float hi) { unsigned r; asm volatile("v_cvt_pk_bf16_f32 %0, %1, %2" : "=v"(r) : "v"(lo), "v"(hi)); return r; }
__device__ __forceinline__ float bf_lo(unsigned u) { return __builtin_bit_cast(float, u << 16); }
__device__ __forceinline__ float bf_hi(unsigned u) { return __builtin_bit_cast(float, u & 0xffff0000u); }
__device__ __forceinline__ float sigmoidf_fast(float v) { return __builtin_amdgcn_rcpf(1.0f + __builtin_amdgcn_exp2f(-v * LOG2E)); }
__device__ __forceinline__ float wave_sum(float v) {
#pragma unroll
    for (int o = 1; o < 64; o <<= 1) v += __shfl_xor(v, o);
    return v;
}

namespace pg8 {
constexpr int BM = 256, BK = 64, HALF = 128, HTB = HALF * BK * 2, STAGE_BYTES = 8 * HTB, NXCD = 8, WGM = 8;
__device__ __forceinline__ int lds_byte(int r, int c) { const int st = (r >> 4) * 2 + (c >> 5), rr = r & 15, cc = c & 31, ob = rr * 64 + cc * 2; return st * 1024 + (ob ^ (((ob >> 9) & 1) << 5)); }
__device__ __forceinline__ void stage_rc(int b, int& R, int& C) { const int st = b / 1024, sb = b % 1024, swz = sb ^ (((sb >> 9) & 1) << 5); R = (st >> 1) * 16 + swz / 64; C = (st & 1) * 32 + (swz % 64) / 2; }
__device__ __forceinline__ int perm32(int rho) { const int n = rho >> 4, i = rho & 15; return 8 * (i >> 2) + 4 * n + (i & 3); }

struct Unit { int row0; int pm, pn, e; const char* bptr; };

struct DenseSched {
    int nM, nN, nwg, G, c; const char* Bt; size_t btile;
    __device__ __forceinline__ void init(int M_, int N_, int G_, int c_, const void* Bt_, int ldb) { nM = M_ / BM; nN = N_ / BM; nwg = nM * nN; G = G_; c = c_; Bt = (const char*)Bt_; btile = (size_t)BM * ldb * 2; }
    __device__ __forceinline__ bool next(int i, Unit& u) const {
        const long L = (long)i * G + c; if (L >= nwg) return false;
        int wgid = (int)L; { const int q = nwg / NXCD, r = nwg % NXCD, xcd = wgid % NXCD, off = wgid / NXCD; wgid = (xcd < r ? xcd * (q + 1) : r * (q + 1) + (xcd - r) * q) + off; }
        const int nig = WGM * nN, gid = wgid / nig, fm = gid * WGM, gsz = (nM - fm) < WGM ? (nM - fm) : WGM;
        u.pm = fm + ((wgid % nig) % gsz); u.pn = (wgid % nig) / gsz; u.row0 = u.pm * BM; u.e = 0; u.bptr = Bt + (size_t)u.pn * btile; return true;
    }
    __device__ __forceinline__ int arow(const Unit& u, int r) const { return u.row0 + r; }
};

template <class Epi, class Sched, bool ALIGN_EPI>
__device__ __forceinline__ void gemm_phase(LAS unsigned char* lds, const void* Abase_, int lda, int ldb, int K, const Sched& S, const Epi& E) {
    int tid_ = threadIdx.x; asm volatile("" : "+v"(tid_));
    const int tid = tid_, wid = __builtin_amdgcn_readfirstlane(tid >> 6), lane = tid & 63, wr = wid >> 2, wc = wid & 3, fr = lane & 15, fq = lane >> 4;
    const int nt = K / BK;
    const char* Abase = (const char*)Abase_;
    int Rr[2], Cc[2]; unsigned voffB[2];
#pragma unroll
    for (int i = 0; i < 2; ++i) { stage_rc(tid * 16 + i * 8192, Rr[i], Cc[i]); const int Rb = Epi::PERM ? ((Rr[i] & ~31) + perm32(Rr[i] & 31)) : Rr[i]; voffB[i] = (unsigned)(Rb * ldb + Cc[i]) * 2u; }
    const size_t kstep = (size_t)(BK * 2);
    const size_t hstepB = (size_t)HALF * ldb * 2;
    const unsigned ldsw = (unsigned)wid * 1024u;
    const int aoff = lds_byte(wr * 64 + fr, fq * 8), boff = lds_byte(wc * 32 + fr, fq * 8);
#define PG8_SA(b, h) (((b) * 2 + (h)) * HTB)
#define PG8_SB(b, h) ((4 + (b) * 2 + (h)) * HTB)
#define PG8_STAGE(bufoff, gbase, voff) do { _Pragma("unroll") for (int _i = 0; _i < 2; ++_i) \
        __builtin_amdgcn_global_load_lds((const unsigned*)((const char*)(gbase) + (voff)[_i]), (LAS unsigned*)(lds + (bufoff) + ldsw + _i * 8192), 16, 0, 0); } while (0)
#define PG8_LDA(dst, b, h) do { _Pragma("unroll") for (int m = 0; m < 4; ++m) _Pragma("unroll") for (int k = 0; k < 2; ++k) dst[m][k] = *(const LAS bf16x8*)(lds + PG8_SA(b, h) + aoff + m * 2048 + k * 1024); } while (0)
#define PG8_LDB(dst, b, h) do { _Pragma("unroll") for (int n = 0; n < 2; ++n) _Pragma("unroll") for (int k = 0; k < 2; ++k) dst[n][k] = *(const LAS bf16x8*)(lds + PG8_SB(b, h) + boff + n * 2048 + k * 1024); } while (0)
#define PG8_MMA(ai, bj, At, Bt) do { __builtin_amdgcn_s_setprio(1); _Pragma("unroll") for (int m = 0; m < 4; ++m) _Pragma("unroll") for (int n = 0; n < 2; ++n) _Pragma("unroll") for (int k = 0; k < 2; ++k) \
        acc[ai][bj][m][n] = __builtin_amdgcn_mfma_f32_16x16x32_bf16(Bt[n][k], At[m][k], acc[ai][bj][m][n], 0, 0, 0); __builtin_amdgcn_s_setprio(0); } while (0)
#define PG8_WAIT_V(n) asm volatile("s_waitcnt vmcnt(" #n ")" ::: "memory")
#define PG8_WAIT_L(n) asm volatile("s_waitcnt lgkmcnt(" #n ")" ::: "memory")
#define PG8_BAR __builtin_amdgcn_s_barrier()
#define PG8_SCHED __builtin_amdgcn_sched_barrier(0)
#define PG8_ROWS(u, va) do { _Pragma("unroll") for (int _h = 0; _h < 2; ++_h) _Pragma("unroll") for (int _i = 0; _i < 2; ++_i) \
        va[_h][_i] = (unsigned)(S.arow(u, _h * HALF + Rr[_i]) * lda + Cc[_i]) * 2u; } while (0)
    Unit cur, nxt; int ui = 0;
    if (!S.next(0, cur)) return;
    unsigned vaC[2][2], vaN[2][2];
    PG8_ROWS(cur, vaC);
    f32x4 acc[2][2][4][2];
#pragma unroll
    for (int a = 0; a < 2; ++a)
#pragma unroll
        for (int b = 0; b < 2; ++b)
#pragma unroll
            for (int m = 0; m < 4; ++m)
#pragma unroll
                for (int n = 0; n < 2; ++n) acc[a][b][m][n] = (f32x4){0.f, 0.f, 0.f, 0.f};
    bf16x8 At[4][2], B0[2][2], B1[2][2];
    const char* cB = cur.bptr;
    PG8_STAGE(PG8_SB(0, 0), cB, voffB); PG8_STAGE(PG8_SB(0, 1), cB + hstepB, voffB); PG8_STAGE(PG8_SA(0, 0), Abase, vaC[0]); PG8_STAGE(PG8_SA(0, 1), Abase, vaC[1]);
    if (wr == 1) PG8_BAR;
    PG8_WAIT_V(2); PG8_BAR;
    PG8_STAGE(PG8_SB(1, 0), cB + kstep, voffB); PG8_STAGE(PG8_SA(1, 0), Abase + kstep, vaC[0]); PG8_STAGE(PG8_SB(1, 1), cB + hstepB + kstep, voffB);
    PG8_WAIT_V(6); PG8_BAR;
    for (;;) {
        const bool has_next = S.next(ui + 1, nxt);
        if (has_next) { PG8_ROWS(nxt, vaN); } else { nxt = cur;
#pragma unroll
            for (int h = 0; h < 2; ++h)
#pragma unroll
                for (int i = 0; i < 2; ++i) vaN[h][i] = vaC[h][i]; }
        const char* nB = nxt.bptr;
        for (int t = 0; t < nt; t += 2) {
            const bool last = (t == nt - 2);
            const char* a1 = Abase + (size_t)(t + 1) * kstep;
            const char* a2 = last ? Abase : Abase + (size_t)(t + 2) * kstep; const char* b2 = last ? nB : cB + (size_t)(t + 2) * kstep;
            const char* a3 = a2 + kstep; const char* b3 = b2 + kstep;
            unsigned v2[2][2];
#pragma unroll
            for (int h = 0; h < 2; ++h)
#pragma unroll
                for (int i = 0; i < 2; ++i) v2[h][i] = last ? vaN[h][i] : vaC[h][i];
            PG8_LDB(B0, 0, 0); PG8_LDB(B1, 0, 1); PG8_SCHED; PG8_LDA(At, 0, 0); PG8_STAGE(PG8_SA(1, 1), a1, vaC[1]);
            PG8_WAIT_V(8); PG8_WAIT_L(0); PG8_BAR; PG8_MMA(0, 0, At, B0); PG8_MMA(0, 1, At, B1); PG8_BAR; PG8_SCHED;
            PG8_LDA(At, 0, 1); PG8_STAGE(PG8_SB(0, 0), b2, voffB); PG8_STAGE(PG8_SB(0, 1), b2 + hstepB, voffB); PG8_STAGE(PG8_SA(0, 0), a2, v2[0]);
            PG8_WAIT_V(8); PG8_WAIT_L(0); PG8_BAR; PG8_MMA(1, 0, At, B0); PG8_MMA(1, 1, At, B1); PG8_BAR; PG8_SCHED;
            PG8_LDB(B0, 1, 0); PG8_LDB(B1, 1, 1); PG8_SCHED; PG8_LDA(At, 1, 0); PG8_STAGE(PG8_SA(0, 1), a2, v2[1]);
            PG8_WAIT_V(8); PG8_WAIT_L(0); PG8_BAR; PG8_MMA(0, 0, At, B0); PG8_MMA(0, 1, At, B1); PG8_BAR; PG8_SCHED;
            PG8_LDA(At, 1, 1); PG8_STAGE(PG8_SB(1, 0), b3, voffB); PG8_STAGE(PG8_SB(1, 1), b3 + hstepB, voffB); PG8_STAGE(PG8_SA(1, 0), a3, v2[0]);
            PG8_WAIT_V(8); PG8_WAIT_L(0); PG8_BAR; PG8_MMA(1, 0, At, B0); PG8_MMA(1, 1, At, B1); PG8_BAR; PG8_SCHED;
        }
        if constexpr (ALIGN_EPI) { if (wr == 0) PG8_BAR; }
        E(acc, cur, wr, wc, fr, fq);
        if (!has_next) break;
#pragma unroll
        for (int a = 0; a < 2; ++a)
#pragma unroll
            for (int b = 0; b < 2; ++b)
#pragma unroll
                for (int m = 0; m < 4; ++m)
#pragma unroll
                    for (int n = 0; n < 2; ++n) acc[a][b][m][n] = (f32x4){0.f, 0.f, 0.f, 0.f};
        cur = nxt; cB = nB; ++ui;
#pragma unroll
        for (int h = 0; h < 2; ++h)
#pragma unroll
            for (int i = 0; i < 2; ++i) vaC[h][i] = vaN[h][i];
        if constexpr (ALIGN_EPI) { if (wr == 1) PG8_BAR; }
    }
    PG8_WAIT_V(0);
    if constexpr (!ALIGN_EPI) { if (wr == 0) PG8_BAR; }
    PG8_BAR;
#undef PG8_SA
#undef PG8_SB
#undef PG8_STAGE
#undef PG8_LDA
#undef PG8_LDB
#undef PG8_MMA
#undef PG8_WAIT_V
#undef PG8_WAIT_L
#undef PG8_BAR
#undef PG8_SCHED
#undef PG8_ROWS
}
}
#define XB_TMO      128
#define XB_XCNT(j)  (256  + 64 * (j))
#define XB_XSUB(j)  (1280 + 64 * (j))
#define XB_XGEN(j)  (2304 + 64 * (j))
#define XB_TOP      3328
#define XB_TOPGEN   3392
#define XCD_BAR_WORDS 3456
#define XB_SPIN_CAP (1u << 18)

__device__ __forceinline__ unsigned xb_ld(unsigned* p)              { return __hip_atomic_load(p, __ATOMIC_RELAXED, __HIP_MEMORY_SCOPE_AGENT); }
__device__ __forceinline__ unsigned xb_add(unsigned* p, unsigned v) { return __hip_atomic_fetch_add(p, v, __ATOMIC_RELAXED, __HIP_MEMORY_SCOPE_AGENT); }
__device__ __forceinline__ unsigned xb_xcc_id() { return (unsigned)__builtin_amdgcn_s_getreg((3 << 11) | 20) & 0xFu; }
#define XB_SPIN(cond, bar) do { unsigned _sp = 0; while (cond) { __builtin_amdgcn_s_sleep(1); \
    if ((++_sp & 255u) == 0u) { if (xb_ld(&(bar)[XB_TMO])) break; if (_sp > XB_SPIN_CAP) { atomicAdd(&(bar)[XB_TMO], 1u); break; } } } } while (0)

struct XcdBarrier {
    unsigned* bar; unsigned x;
    volatile LAS unsigned* st;
};

__device__ __forceinline__ XcdBarrier xcd_barrier_post(unsigned* bar, volatile LAS unsigned* st) {
    XcdBarrier b; b.bar = bar; b.x = xb_xcc_id(); b.st = st;
    if (threadIdx.x == 0) (void)xb_add(&bar[XB_XCNT(b.x)], 1u);
    return b;
}
__device__ __forceinline__ void xcd_barrier_complete(unsigned* bar, unsigned x, unsigned& nloc, unsigned& nx) {
    const unsigned G = gridDim.x * gridDim.y * gridDim.z;
    unsigned sum, cnt, mine, sp = 0u;
    for (;;) {
        sum = 0u; cnt = 0u; mine = 0u;
#pragma unroll
        for (unsigned j = 0; j < 16; ++j) { const unsigned c = xb_ld(&bar[XB_XCNT(j)]); sum += c; cnt += (c > 0u) ? 1u : 0u; mine = (j == x) ? c : mine; }
        if (sum == G) break;
        __builtin_amdgcn_s_sleep(1);
        if ((++sp & 255u) == 0u) { if (xb_ld(&bar[XB_TMO])) break; if (sp > XB_SPIN_CAP) { atomicAdd(&bar[XB_TMO], 1u); break; } }
    }
    nloc = mine > 0u ? mine : 1u; nx = cnt > 0u ? cnt : 1u;
}

__device__ __forceinline__ void xcd_barrier(const XcdBarrier& b) {
    asm volatile("s_waitcnt vmcnt(0)" ::: "memory");
    __syncthreads();
    if (threadIdx.x == 0) {
        unsigned* bar = b.bar;
        __builtin_amdgcn_s_waitcnt(0);
        unsigned nloc = b.st[0], nx = b.st[1];
        if (nloc == 0u) { xcd_barrier_complete(bar, b.x, nloc, nx); b.st[0] = nloc; b.st[1] = nx; }
        const unsigned old = xb_add(&bar[XB_XSUB(b.x)], 1u);
        const unsigned gen = old / nloc;
        if (old + 1u == (gen + 1u) * nloc) {
            __builtin_amdgcn_fence(__ATOMIC_RELEASE, "agent");
            asm volatile("s_waitcnt vmcnt(0)" ::: "memory");
            const unsigned og = xb_add(&bar[XB_TOP], 1u);
            const unsigned tg = og / nx;
            if (og + 1u == (tg + 1u) * nx) xb_add(&bar[XB_TOPGEN], 1u);
            else XB_SPIN(xb_ld(&bar[XB_TOPGEN]) == tg, bar);
            __builtin_amdgcn_fence(__ATOMIC_ACQUIRE, "agent");
            xb_add(&bar[XB_XGEN(b.x)], 1u);
            asm volatile("s_waitcnt vmcnt(0)" ::: "memory");
        } else {
            XB_SPIN(xb_ld(&bar[XB_XGEN(b.x)]) == gen, bar);
            __builtin_amdgcn_fence(__ATOMIC_ACQUIRE, "agent");
            asm volatile("s_waitcnt vmcnt(0)" ::: "memory");
        }
    }
    __syncthreads();
}
namespace pg8 {
struct EpiProj {
    static constexpr bool PERM = true;
    bf16_t* base;
    __device__ __forceinline__ void operator()(const f32x4 (&acc)[2][2][4][2], const Unit& u, int wr, int wc, int fr, int fq) const {
        const int buf = u.pn >> 2, colt = (u.pn & 3) * 256;
        const float sc = (u.pn < 2 || u.pn == 6 || u.pn == 7) ? C2 : 1.0f;
        bf16_t* dst = base + (size_t)buf * (PROJ_STRIDE / 2);
        const int row0 = u.row0 + wr * 64 + fr, col0 = colt + wc * 32 + 8 * fq;
#pragma unroll
        for (int ai = 0; ai < 2; ++ai)
#pragma unroll
            for (int m = 0; m < 4; ++m) { bf16_t* rowp = dst + (size_t)(row0 + ai * HALF + m * 16) * 1024 + col0;
#pragma unroll
                for (int bj = 0; bj < 2; ++bj) { const f32x4 v0 = acc[ai][bj][m][0] * sc, v1 = acc[ai][bj][m][1] * sc;
                    u32x4 w; w.x = cvt_pk_bf16(v0[0], v0[1]); w.y = cvt_pk_bf16(v0[2], v0[3]); w.z = cvt_pk_bf16(v1[0], v1[1]); w.w = cvt_pk_bf16(v1[2], v1[3]);
                    *(u32x4*)(rowp + bj * HALF) = w; } }
    }
};
struct EpiBrA {
    static constexpr bool PERM = true;
    const bf16_t* gl; float* t1;
    __device__ __forceinline__ void operator()(const f32x4 (&acc)[2][2][4][2], const Unit& u, int wr, int wc, int fr, int fq) const {
        const int row0 = u.row0 + wr * 64 + fr, col0 = u.pn * 256 + wc * 32 + 8 * fq;
#pragma unroll
        for (int ai = 0; ai < 2; ++ai)
#pragma unroll
            for (int m = 0; m < 4; ++m) { const size_t ro = (size_t)(row0 + ai * HALF + m * 16) * 1024 + col0;
#pragma unroll
                for (int bj = 0; bj < 2; ++bj) { const u32x4 g = *(const u32x4*)(gl + ro + bj * HALF); const f32x4 v0 = acc[ai][bj][m][0], v1 = acc[ai][bj][m][1];
                    f32x4 a, b;
                    a[0] = sigmoidf_fast(bf_lo(g.x)) * v0[0]; a[1] = sigmoidf_fast(bf_hi(g.x)) * v0[1]; a[2] = sigmoidf_fast(bf_lo(g.y)) * v0[2]; a[3] = sigmoidf_fast(bf_hi(g.y)) * v0[3];
                    b[0] = sigmoidf_fast(bf_lo(g.z)) * v1[0]; b[1] = sigmoidf_fast(bf_hi(g.z)) * v1[1]; b[2] = sigmoidf_fast(bf_lo(g.w)) * v1[2]; b[3] = sigmoidf_fast(bf_hi(g.w)) * v1[3];
                    *(f32x4*)(t1 + ro + bj * HALF) = a; *(f32x4*)(t1 + ro + bj * HALF + 4) = b; } }
    }
};
struct EpiBrB {
    static constexpr bool PERM = true;
    const bf16_t* gl; const float* t1; bf16_t* out;
    __device__ __forceinline__ void operator()(const f32x4 (&acc)[2][2][4][2], const Unit& u, int wr, int wc, int fr, int fq) const {
        const int row0 = u.row0 + wr * 64 + fr, col0 = u.pn * 256 + wc * 32 + 8 * fq;
#pragma unroll
        for (int ai = 0; ai < 2; ++ai)
#pragma unroll
            for (int m = 0; m < 4; ++m) { const size_t ro = (size_t)(row0 + ai * HALF + m * 16) * 1024 + col0;
#pragma unroll
                for (int bj = 0; bj < 2; ++bj) { const u32x4 g = *(const u32x4*)(gl + ro + bj * HALF); const f32x4 v0 = acc[ai][bj][m][0], v1 = acc[ai][bj][m][1];
                    const f32x4 ta = *(const f32x4*)(t1 + ro + bj * HALF), tb = *(const f32x4*)(t1 + ro + bj * HALF + 4);
                    f32x4 a, b;
                    a[0] = ta[0] + sigmoidf_fast(bf_lo(g.x)) * v0[0]; a[1] = ta[1] + sigmoidf_fast(bf_hi(g.x)) * v0[1]; a[2] = ta[2] + sigmoidf_fast(bf_lo(g.y)) * v0[2]; a[3] = ta[3] + sigmoidf_fast(bf_hi(g.y)) * v0[3];
                    b[0] = tb[0] + sigmoidf_fast(bf_lo(g.z)) * v1[0]; b[1] = tb[1] + sigmoidf_fast(bf_hi(g.z)) * v1[1]; b[2] = tb[2] + sigmoidf_fast(bf_lo(g.w)) * v1[2]; b[3] = tb[3] + sigmoidf_fast(bf_hi(g.w)) * v1[3];
                    u32x4 w; w.x = cvt_pk_bf16(a[0], a[1]); w.y = cvt_pk_bf16(a[2], a[3]); w.z = cvt_pk_bf16(b[0], b[1]); w.w = cvt_pk_bf16(b[2], b[3]);
                    *(u32x4*)(out + ro + bj * HALF) = w; } }
    }
};
struct EpiOut {
    static constexpr bool PERM = false;
    const float* x; const float* adaf; float* x1;
    __device__ __forceinline__ void operator()(const f32x4 (&acc)[2][2][4][2], const Unit& u, int wr, int wc, int fr, int fq) const {
        const int row0 = u.row0 + wr * 64 + fr, col0 = u.pn * 256 + wc * 32 + 4 * fq;
        const float* gt = adaf + (u.row0 >= SEQ ? 6144 : 0) + 2048;
        f32x4 gv[2][2];
#pragma unroll
        for (int bj = 0; bj < 2; ++bj)
#pragma unroll
            for (int n = 0; n < 2; ++n) gv[bj][n] = *(const f32x4*)(gt + col0 + bj * HALF + n * 16);
#pragma unroll
        for (int ai = 0; ai < 2; ++ai)
#pragma unroll
            for (int m = 0; m < 4; ++m) { const size_t ro = (size_t)(row0 + ai * HALF + m * 16) * 1024 + col0;
#pragma unroll
                for (int bj = 0; bj < 2; ++bj)
#pragma unroll
                    for (int n = 0; n < 2; ++n) { const f32x4 xv = *(const f32x4*)(x + ro + bj * HALF + n * 16); *(f32x4*)(x1 + ro + bj * HALF + n * 16) = xv + gv[bj][n] * acc[ai][bj][m][n]; } }
    }
};
struct EpiGU {
    static constexpr bool PERM = true;
    const float* bgu; bf16_t* act;
    __device__ __forceinline__ void operator()(const f32x4 (&acc)[2][2][4][2], const Unit& u, int wr, int wc, int fr, int fq) const {
        const int row0 = u.row0 + wr * 64 + fr, col0 = u.pn * 128 + wc * 32 + 8 * fq;
        const float* bg = bgu + (size_t)u.e * 2048 + col0;
        f32x4 bgv[2], buv[2];
#pragma unroll
        for (int n = 0; n < 2; ++n) { bgv[n] = *(const f32x4*)(bg + 4 * n); buv[n] = *(const f32x4*)(bg + 1024 + 4 * n); }
#pragma unroll
        for (int ai = 0; ai < 2; ++ai)
#pragma unroll
            for (int m = 0; m < 4; ++m) { float r[8];
#pragma unroll
                for (int n = 0; n < 2; ++n)
#pragma unroll
                    for (int j = 0; j < 4; ++j) { const float gte = fminf(acc[ai][0][m][n][j] + bgv[n][j], 7.0f); const float up = fminf(fmaxf(acc[ai][1][m][n][j] + buv[n][j], -7.0f), 7.0f);
                        r[4 * n + j] = (up + 1.0f) * gte * sigmoidf_fast(1.702f * gte); }
                u32x4 w; w.x = cvt_pk_bf16(r[0], r[1]); w.y = cvt_pk_bf16(r[2], r[3]); w.z = cvt_pk_bf16(r[4], r[5]); w.w = cvt_pk_bf16(r[6], r[7]);
                *(u32x4*)(act + (size_t)(row0 + ai * HALF + m * 16) * 1024 + col0) = w; }
    }
};
struct EpiDown {
    static constexpr bool PERM = true;
    const float* bd; const float* slotw; bf16_t* out;
    __device__ __forceinline__ void operator()(const f32x4 (&acc)[2][2][4][2], const Unit& u, int wr, int wc, int fr, int fq) const {
        const int row0 = u.row0 + wr * 64 + fr, col0 = u.pn * 256 + wc * 32 + 8 * fq;
        const float* bp = bd + (size_t)u.e * 1024 + col0;
        f32x4 bv[2][2];
#pragma unroll
        for (int bj = 0; bj < 2; ++bj)
#pragma unroll
            for (int n = 0; n < 2; ++n) bv[bj][n] = *(const f32x4*)(bp + bj * HALF + 4 * n);
#pragma unroll
        for (int ai = 0; ai < 2; ++ai)
#pragma unroll
            for (int m = 0; m < 4; ++m) { const int row = row0 + ai * HALF + m * 16; const float w8 = slotw[row]; bf16_t* rowp = out + (size_t)row * 1024 + col0;
#pragma unroll
                for (int bj = 0; bj < 2; ++bj) { const f32x4 v0 = (acc[ai][bj][m][0] + bv[bj][0]) * w8, v1 = (acc[ai][bj][m][1] + bv[bj][1]) * w8;
                    u32x4 w; w.x = cvt_pk_bf16(v0[0], v0[1]); w.y = cvt_pk_bf16(v0[2], v0[3]); w.z = cvt_pk_bf16(v1[0], v1[1]); w.w = cvt_pk_bf16(v1[2], v1[3]);
                    *(u32x4*)(rowp + bj * HALF) = w; } }
    }
};
template <bool GATHER> struct MoeSched {
    const LAS int* te; int NP, G, c; const int* slot_tok; const char* W; size_t wstride, btile;
    __device__ __forceinline__ bool next(int i, Unit& u) const {
        const int ntl = te[32], nwg = ntl * NP; const long L = (long)i * G + c; if (L >= nwg) return false;
        int wgid = (int)L; { const int q = nwg / NXCD, r = nwg % NXCD, xcd = wgid % NXCD, off = wgid / NXCD; wgid = (xcd < r ? xcd * (q + 1) : r * (q + 1) + (xcd - r) * q) + off; }
        int e = 0;
        for (int k = 1; k < NE; ++k) e += (wgid >= te[k] * NP) ? 1 : 0;
        const int t0 = te[e], nte = te[e + 1] - t0, r = wgid - t0 * NP; const int pn = r / nte, t = t0 + r % nte;
        u.row0 = t * 256; u.pn = pn; u.pm = t; u.e = e; u.bptr = W + (size_t)e * wstride + (size_t)pn * btile; return true;
    }
    __device__ __forceinline__ int arow(const Unit& u, int r) const { if constexpr (GATHER) return slot_tok[u.row0 + r]; else return u.row0 + r; }
};
}

constexpr int AT_BT = 98304, AT_K = 0, AT_V = AT_K + 64 * 72 * 2, AT_MISC = 32768;
typedef short v4i16_t __attribute__((ext_vector_type(4)));
__device__ __forceinline__ s16x4 tr16(const LAS unsigned char* p) { return __builtin_bit_cast(s16x4, __builtin_amdgcn_ds_read_tr16_b64_v4i16((LAS v4i16_t*)p)); }

template <int NDT>
__device__ __forceinline__ void attn_tile(const LAS unsigned char* lds, int lane, const bf16x8 (&qf)[2], f32x4 (&o)[NDT], float& m_run, float& l_run,
                                          int qpos, int kbase, bool causal, const LAS float* bt) {
    constexpr int VSTR = NDT * 16 + 8;
    const int c = lane & 15, g = lane >> 4;
    f32x4 s[4];
#pragma unroll
    for (int kt = 0; kt < 4; ++kt) { s[kt] = (f32x4){0.f, 0.f, 0.f, 0.f};
#pragma unroll
        for (int ks = 0; ks < 2; ++ks) { const bf16x8 a = *(const LAS bf16x8*)(lds + AT_K + ((16 * kt + c) * 72 + 32 * ks + 8 * g) * 2);
            s[kt] = __builtin_amdgcn_mfma_f32_16x16x32_bf16(a, qf[ks], s[kt], 0, 0, 0); } }
    if (__any((qpos - (kbase + 63)) < 128)) {
#pragma unroll
        for (int kt = 0; kt < 4; ++kt)
#pragma unroll
            for (int i = 0; i < 4; ++i) { const int dist = qpos - (kbase + 16 * kt + 4 * g + i); const int di = dist < 0 ? 0 : (dist > 127 ? 127 : dist);
                const float bv = bt[di]; float v = s[kt][i];
                if (dist >= 0 && dist < 128) v += bv;
                if (causal && dist < 0) v = -INFINITY;
                s[kt][i] = v; }
    }
    float mx = fmaxf(fmaxf(s[0][0], s[0][1]), fmaxf(s[0][2], s[0][3]));
#pragma unroll
    for (int kt = 1; kt < 4; ++kt) mx = fmaxf(mx, fmaxf(fmaxf(s[kt][0], s[kt][1]), fmaxf(s[kt][2], s[kt][3])));
    mx = fmaxf(mx, __shfl_xor(mx, 16)); mx = fmaxf(mx, __shfl_xor(mx, 32));
    const float m_new = fmaxf(m_run, mx), alpha = __builtin_amdgcn_exp2f(m_run - m_new);
    float psum = 0.f;
#pragma unroll
    for (int kt = 0; kt < 4; ++kt)
#pragma unroll
        for (int i = 0; i < 4; ++i) { const float p = __builtin_amdgcn_exp2f(s[kt][i] - m_new); s[kt][i] = p; psum += p; }
    l_run = l_run * alpha + psum; m_run = m_new;
#pragma unroll
    for (int i = 0; i < 4; ++i) { const float ai = __shfl(alpha, 4 * g + i);
#pragma unroll
        for (int dt = 0; dt < NDT; ++dt) o[dt][i] *= ai; }
    bf16x8 pa[2];
#pragma unroll
    for (int kk = 0; kk < 2; ++kk) { u32x4 w; w.x = cvt_pk_bf16(s[2 * kk][0], s[2 * kk][1]); w.y = cvt_pk_bf16(s[2 * kk][2], s[2 * kk][3]);
        w.z = cvt_pk_bf16(s[2 * kk + 1][0], s[2 * kk + 1][1]); w.w = cvt_pk_bf16(s[2 * kk + 1][2], s[2 * kk + 1][3]); pa[kk] = __builtin_bit_cast(bf16x8, w); }
    const LAS unsigned char* vb = lds + AT_V + ((4 * g + (c >> 2)) * VSTR + 4 * (c & 3)) * 2;
#pragma unroll
    for (int dt = 0; dt < NDT; ++dt)
#pragma unroll
        for (int kk = 0; kk < 2; ++kk) { const s16x4 lo = tr16(vb + (32 * kk * VSTR + 16 * dt) * 2), hi = tr16(vb + ((32 * kk + 16) * VSTR + 16 * dt) * 2);
            const bf16x8 b = (bf16x8){lo[0], lo[1], lo[2], lo[3], hi[0], hi[1], hi[2], hi[3]};
            o[dt] = __builtin_amdgcn_mfma_f32_16x16x32_bf16(pa[kk], b, o[dt], 0, 0, 0); }
}

template <int NV> struct TileRegs { u32x4 k; u32x4 v[NV]; };
template <int NV> __device__ __forceinline__ void tile_fetch(TileRegs<NV>& r, const bf16_t* kg, const bf16_t* vg, int tid) {
    const int row = tid >> 3, ch = tid & 7;
    r.k = *(const u32x4*)(kg + (size_t)row * 1024 + ch * 8);
#pragma unroll
    for (int i = 0; i < NV; ++i) r.v[i] = *(const u32x4*)(vg + (size_t)row * 1024 + (ch + 8 * i) * 8);
}
template <int NV> __device__ __forceinline__ void tile_store(const TileRegs<NV>& r, LAS unsigned char* lds, int tid) {
    constexpr int VSTR = NV * 64 + 8;
    const int row = tid >> 3, ch = tid & 7;
    *(LAS u32x4*)(lds + AT_K + (row * 72 + ch * 8) * 2) = r.k;
#pragma unroll
    for (int i = 0; i < NV; ++i) *(LAS u32x4*)(lds + AT_V + (row * VSTR + (ch + 8 * i) * 8) * 2) = r.v[i];
}
#include <hip/hip_bf16.h>
#include <cmath>
namespace attn_body {
using bf16=__hip_bfloat16;
using bf16x8=__attribute__((ext_vector_type(8)))short;
using s16x4=__attribute__((ext_vector_type(4)))short;
using f32x16=__attribute__((ext_vector_type(16)))float;
using u32x4=__attribute__((ext_vector_type(4)))unsigned;
constexpr int BATCH=2,NHEAD=16,SEQ=8192,D=64,DM=NHEAD*D;
constexpr int NW=8,QBLK=32,QB=QBLK*NW,KVBLK=64,NQB=SEQ/QB;
constexpr int ATTN_PITCH=DM, ATTN_UNIT_ROWS=QB;
__device__ __forceinline__ int crow(int r,int hi){return (r&3)+8*(r>>2)+4*hi;}
#define SBAR() __builtin_amdgcn_sched_barrier(0)
typedef const __attribute__((address_space(3))) float* lds_cfptr;
__device__ __forceinline__ void cbias(f32x16&p0,f32x16&p1,int jb,int qrel,int hi,lds_cfptr bt){
  const float NEG=-INFINITY; const int kb=64*jb+4*hi;
  #pragma unroll
  for(int r=0;r<16;++r){const int d0=qrel-(kb+(r&3)+8*(r>>2)),d1=d0-32;
    const int c0=d0<0?0:(d0>127?127:d0),c1=d1<0?0:(d1>127?127:d1);
    const float b0=bt[c0],b1=bt[c1];
    p0[r]=d0<0?NEG:(d0<128?p0[r]+b0:p0[r]); p1[r]=d1<0?NEG:(d1<128?p1[r]+b1:p1[r]);}
}
constexpr int NSLOT=3, SLOTB=8192;
constexpr int LDS_K=0, LDS_V=NSLOT*SLOTB, LDS_WS=2*NSLOT*SLOTB, LDS_OST=LDS_WS+NW*64*4, LDS_BYTES=LDS_OST+NW*4096;
constexpr float C2=0.125f*1.4426950408889634f;
__device__ __forceinline__ void glds16(const void*gsrc,unsigned lds_dst){unsigned keep;
  asm volatile("s_mov_b32 %0, m0\n\ts_mov_b32 m0, %2\n\ts_nop 0\n\tglobal_load_lds_dwordx4 %1, off\n\ts_mov_b32 m0, %0":"=&s"(keep):"v"(gsrc),"s"(lds_dst):"memory");}
__device__ __forceinline__ float max3f(float a,float b,float c){float r;asm("v_max3_f32 %0, %1, %2, %3":"=v"(r):"v"(a),"v"(b),"v"(c));return r;}
__device__ __forceinline__ float max2f(float a,float b){float r;asm("v_max_f32_e32 %0, %1, %2":"=v"(r):"v"(a),"v"(b));return r;}
__device__ __forceinline__ float fadd_s(float a,float b){float r;asm("v_add_f32_e32 %0, %1, %2":"=v"(r):"v"(a),"v"(b));return r;}
__device__ __forceinline__ float fsub_s(float a,float b){float r;asm("v_sub_f32_e32 %0, %1, %2":"=v"(r):"v"(a),"v"(b));return r;}
typedef float f32x2_t __attribute__((ext_vector_type(2))); typedef __bf16 bf16x2_t __attribute__((ext_vector_type(2)));
__device__ __forceinline__ unsigned cvtpk_s(float lo,float hi){f32x2_t v={lo,hi};bf16x2_t b=__builtin_convertvector(v,bf16x2_t);return __builtin_bit_cast(unsigned,b);}
#define WAIT_BAR(N) asm volatile("s_waitcnt vmcnt(" #N ") lgkmcnt(0)\n\ts_barrier":::"memory")

__device__ __forceinline__ void qkt(f32x16&p0,f32x16&p1,const char*Kslot,const bf16x8*qr,const f32x16&negm,int r32,int hi){
  const char*kb=Kslot+hi*1024+r32*16;
  #pragma unroll
  for(int d0=0;d0<4;++d0){
    const bf16x8 b0=*reinterpret_cast<const bf16x8*>(kb+d0*2048);
    const bf16x8 b1=*reinterpret_cast<const bf16x8*>(kb+d0*2048+512);
    if(d0==0){p0=__builtin_amdgcn_mfma_f32_32x32x16_bf16(b0,qr[0],negm,0,0,0);p1=__builtin_amdgcn_mfma_f32_32x32x16_bf16(b1,qr[0],negm,0,0,0);}
    else{p0=__builtin_amdgcn_mfma_f32_32x32x16_bf16(b0,qr[d0],p0,0,0,0);p1=__builtin_amdgcn_mfma_f32_32x32x16_bf16(b1,qr[d0],p1,0,0,0);}}
}
typedef __attribute__((address_space(3))) const char* lds_cptr;
typedef short v4i16_t __attribute__((ext_vector_type(4)));
__device__ __forceinline__ void kload8(bf16x8*kf,lds_cptr kp){
  kf[0]=*(const __attribute__((address_space(3))) bf16x8*)(kp);      kf[1]=*(const __attribute__((address_space(3))) bf16x8*)(kp+512);
  kf[2]=*(const __attribute__((address_space(3))) bf16x8*)(kp+2048); kf[3]=*(const __attribute__((address_space(3))) bf16x8*)(kp+2560);
  kf[4]=*(const __attribute__((address_space(3))) bf16x8*)(kp+4096); kf[5]=*(const __attribute__((address_space(3))) bf16x8*)(kp+4608);
  kf[6]=*(const __attribute__((address_space(3))) bf16x8*)(kp+6144); kf[7]=*(const __attribute__((address_space(3))) bf16x8*)(kp+6656);
}
__device__ __forceinline__ void kload2(bf16x8*kf,lds_cptr kp,int j){ kf[2*j]=*(const __attribute__((address_space(3))) bf16x8*)(kp+j*2048); kf[2*j+1]=*(const __attribute__((address_space(3))) bf16x8*)(kp+j*2048+512); }
__device__ __forceinline__ s16x4 vtr(lds_cptr p){ return __builtin_bit_cast(s16x4,__builtin_amdgcn_ds_read_tr16_b64_v4i16((__attribute__((address_space(3))) v4i16_t*)p)); }
__device__ __forceinline__ float rowmax(const f32x16&p0,const f32x16&p1){
  float a=max3f(p0[0],p0[1],p1[0]),b=max3f(p0[2],p0[3],p1[1]);a=max3f(a,p1[2],p1[3]);
  #pragma unroll
  for(int r=4;r<16;r+=4){a=max3f(a,p0[r],p0[r+1]);b=max3f(b,p0[r+2],p0[r+3]);a=max3f(a,p1[r],p1[r+1]);b=max3f(b,p1[r+2],p1[r+3]);}
  const float m=max2f(a,b);
  auto rr=__builtin_amdgcn_permlane32_swap(__float_as_uint(m),__float_as_uint(m),false,false);
  return max2f(__uint_as_float(rr[0]),__uint_as_float(rr[1]));
}
__device__ __forceinline__ void pv(f32x16*o,int vb,bf16x8 pa0,bf16x8 pa1,bf16x8 pa2,bf16x8 pa3){
  #pragma unroll
  for(int d0=0;d0<2;++d0){s16x4 lo[4],hi[4];
    #pragma unroll
    for(int ks=0;ks<4;++ks){
      asm volatile("ds_read_b64_tr_b16 %0,%1 offset:%c2":"=&v"(lo[ks]):"v"(vb),"i"(d0*4096+ks*1024):"memory");
      asm volatile("ds_read_b64_tr_b16 %0,%1 offset:%c2":"=&v"(hi[ks]):"v"(vb),"i"(d0*4096+ks*1024+512):"memory");}
    asm volatile("s_waitcnt lgkmcnt(0)":::"memory");SBAR();
    #define PK(k) (bf16x8){lo[k][0],lo[k][1],lo[k][2],lo[k][3],hi[k][0],hi[k][1],hi[k][2],hi[k][3]}
    o[d0]=__builtin_amdgcn_mfma_f32_32x32x16_bf16(pa0,PK(0),o[d0],0,0,0);
    o[d0]=__builtin_amdgcn_mfma_f32_32x32x16_bf16(pa1,PK(1),o[d0],0,0,0);
    o[d0]=__builtin_amdgcn_mfma_f32_32x32x16_bf16(pa2,PK(2),o[d0],0,0,0);
    o[d0]=__builtin_amdgcn_mfma_f32_32x32x16_bf16(pa3,PK(3),o[d0],0,0,0);
    #undef PK
  }
}

#ifndef ATTN_STORE16
#define ATTN_STORE16(p,v) (*(u32x4*)(p)=(v))
#endif
template<int THRL> __device__ __forceinline__ void attn_unit(int b,int qb,const bf16*Q,const bf16*__restrict__ K,const bf16*__restrict__ V,bf16*O,int qc,int kc,int vc,int oc,lds_cfptr bt,char*shm){
  int tid_=threadIdx.x; asm volatile("":"+v"(tid_)); const int tid=tid_,lane=tid&63,r32=lane&31,hi=lane>>5; const int wid=__builtin_amdgcn_readfirstlane(tid>>6);
  const long rowbase=(long)b*SEQ; const int q0=qb*QB;
  const bf16*Qw=Q+(rowbase+q0+wid*QBLK)*DM+qc;
  const bf16*Kh=K+rowbase*DM+kc,*Vh=V+rowbase*DM+vc;
  const unsigned lds0=(unsigned)(uintptr_t)shm;
  float*wsf=(float*)(shm+LDS_WS)+wid*64;
  const bf16*ksrc=Kh+(long)lane*DM+wid*8;
  const bf16*vsrc=Vh+(long)(16*(wid&3)+(lane>>2))*DM+(wid>>2)*32+(lane&3)*8;
  const unsigned kdst=lds0+LDS_K+wid*1024, vdst=lds0+LDS_V+wid*1024;
  #define DMA_K(t,slot) glds16(ksrc+(long)(t)*KVBLK*DM,(unsigned)__builtin_amdgcn_readfirstlane(kdst+(slot)))
  #define DMA_V(t,slot) glds16(vsrc+(long)(t)*KVBLK*DM,(unsigned)__builtin_amdgcn_readfirstlane(vdst+(slot)))
  const int vb0=(int)(lds0+LDS_V)+((lane>>4)&1)*32+(lane&3)*8+(4*hi+((lane&15)>>2))*64;
  const char*Kbase=shm+LDS_K; bf16x8 kf[8];
  const lds_cptr shm3=(lds_cptr)shm; const lds_cptr kp0=shm3+LDS_K+hi*1024+r32*16; const lds_cptr vp0=shm3+LDS_V+((lane>>4)&1)*32+(lane&3)*8+(4*hi+((lane&15)>>2))*64;
  const int NT=(q0+QB)/KVBLK;
  DMA_K(0,0);DMA_V(0,0);DMA_K(1,SLOTB);
  bf16x8 qr[4];
  #pragma unroll
  for(int d0=0;d0<4;++d0)qr[d0]=*reinterpret_cast<const bf16x8*>(&Qw[(long)r32*DM+d0*16+hi*8]);
  float mhat=0.f,l_reg=0.f;f32x16 o[2],negm; { float z_=0.f; asm volatile("":"+v"(z_));
    _Pragma("unroll") for(int r=0;r<16;++r){o[0][r]=z_;o[1][r]=z_;negm[r]=z_;} } asm volatile("":"+v"(negm));
  const int qrel=wid*QBLK+r32;
  #define CMASK(P0,P1,t) do{int jb_=(t)-(NT-4); if(jb_>=-2 && (wid*QBLK-(64*jb_+63))<128)cbias(P0,P1,jb_,qrel,hi,bt);}while(0)
  bool resc=false;
  #define START(P0,P1) do{ const float rm=rowmax(P0,P1); resc=false; \
    { const float dl=rm; mhat=fadd_s(mhat,dl); \
      _Pragma("unroll") for(int r=0;r<16;++r){P0[r]=fsub_s(P0[r],dl);P1[r]=fsub_s(P1[r],dl);} \
      _Pragma("unroll") for(int r=0;r<16;++r)negm[r]=-mhat; asm volatile("":"+v"(negm)); } \
    _Pragma("unroll") for(int r=0;r<16;++r)P0[r]=__builtin_amdgcn_exp2f(P0[r]); }while(0)
  #define RESC() do{ if(resc){ asm volatile("s_waitcnt lgkmcnt(0)":::"memory"); \
      _Pragma("unroll") for(int d_=0;d_<2;++d_) _Pragma("unroll") for(int r=0;r<16;++r)o[d_][r]*=wsf[crow(r,hi)]; } }while(0)
  f32x16 pA0,pA1,pB0,pB1;
  int sl_prev=0,sl_cur=0,sl_next=SLOTB;
  #define ROT() do{sl_prev=sl_cur;sl_cur=sl_next;sl_next=(sl_next==(NSLOT-1)*SLOTB)?0:sl_next+SLOTB;}while(0)
  DMA_K(2,2*SLOTB);
  WAIT_BAR(3);
  qkt(pA0,pA1,Kbase,qr,negm,r32,hi);asm volatile("s_nop 15\n\ts_nop 7":"+v"(pA0),"+v"(pA1));CMASK(pA0,pA1,0);
  START(pA0,pA1);
  _Pragma("unroll") for(int r=0;r<16;++r)pA1[r]=__builtin_amdgcn_exp2f(pA1[r]);
  WAIT_BAR(0);
  DMA_K(3,0);DMA_V(1,SLOTB);
  ROT();
  kload8(kf,kp0+sl_cur);
  WAIT_BAR(2);
  s16x4 vlo[8],vhi[8]; u32x4 pw0,pw1,pw2,pw3;
  #define PKW(P,B) cvtpk_s(P[B],P[B+1])
  #define PAF(k) __builtin_bit_cast(bf16x8,pw##k)
  #define VFR(i) (bf16x8){vlo[i][0],vlo[i][1],vlo[i][2],vlo[i][3],vhi[i][0],vhi[i][1],vhi[i][2],vhi[i][3]}
  #define PIN(x) asm volatile("":"+v"(x))
  #define MX3(a,b,c) __builtin_fmaxf(__builtin_fmaxf((a),(b)),(c))
  #define GAPA(MF,A0,A1,A2,A3,W0,W1,PW) do{ MF; sacc+=A0; sacc+=A1; sacc+=A2; sacc+=A3; PIN(sacc); W0; W1; PIN(PW); SBAR(); }while(0)
  #define EX(v) __builtin_amdgcn_exp2f(v)
  #define GAPB(MF,X,B) do{ MF; X[B]=EX(X[B]); X[B+1]=EX(X[B+1]); X[B+2]=EX(X[B+2]); X[B+3]=EX(X[B+3]); PIN(X); SBAR(); }while(0)
  #define VRD(i) do{ vlo[i]=vtr(vp_+(((i)>>2)*4096+((i)&3)*1024)); vhi[i]=vtr(vp_+(((i)>>2)*4096+((i)&3)*1024+512)); }while(0)
  #define KRD(G,j) do{ if(G){ kload2(kf,kp0+sl_next,j); SBAR(); } }while(0)
  #define STEP(C0,C1,P0,P1,t,GK,GV,GL) do{ SBAR(); \
    const lds_cptr vp_=vp0+sl_prev; \
    VRD(0); SBAR(); float sacc=(P0[0]+P0[1]); \
    GAPA(C0=__builtin_amdgcn_mfma_f32_32x32x16_bf16(kf[0],qr[0],negm,0,0,0), P0[2],P0[3],P0[4],P0[5],     pw0[0]=PKW(P0,0), pw0[1]=PKW(P0,2), pw0); \
    VRD(4); SBAR(); GAPA(C1=__builtin_amdgcn_mfma_f32_32x32x16_bf16(kf[1],qr[0],negm,0,0,0), P0[6],P0[7],P0[8],P0[9],     pw0[2]=PKW(P0,4), pw0[3]=PKW(P0,6), pw0); \
    VRD(1); SBAR(); GAPA(C0=__builtin_amdgcn_mfma_f32_32x32x16_bf16(kf[2],qr[1],C0,0,0,0),   P0[10],P0[11],P0[12],P0[13], pw1[0]=PKW(P0,8), pw1[1]=PKW(P0,10), pw1); \
    VRD(5); SBAR(); GAPA(C1=__builtin_amdgcn_mfma_f32_32x32x16_bf16(kf[3],qr[1],C1,0,0,0),   P0[14],P0[15],P1[0],P1[1],   pw1[2]=PKW(P0,12),pw1[3]=PKW(P0,14), pw1); \
    VRD(2); SBAR(); GAPA(C0=__builtin_amdgcn_mfma_f32_32x32x16_bf16(kf[4],qr[2],C0,0,0,0),   P1[2],P1[3],P1[4],P1[5],     pw2[0]=PKW(P1,0), pw2[1]=PKW(P1,2), pw2); \
    VRD(6); SBAR(); GAPA(C1=__builtin_amdgcn_mfma_f32_32x32x16_bf16(kf[5],qr[2],C1,0,0,0),   P1[6],P1[7],P1[8],P1[9],     pw2[2]=PKW(P1,4), pw2[3]=PKW(P1,6), pw2); \
    VRD(3); SBAR(); GAPA(C0=__builtin_amdgcn_mfma_f32_32x32x16_bf16(kf[6],qr[3],C0,0,0,0),   P1[10],P1[11],P1[12],P1[13], pw3[0]=PKW(P1,8), pw3[1]=PKW(P1,10), pw3); \
    VRD(7); SBAR(); GAPA(C1=__builtin_amdgcn_mfma_f32_32x32x16_bf16(kf[7],qr[3],C1,0,0,0),   P1[14],P1[15],0.f,0.f,       pw3[2]=PKW(P1,12),pw3[3]=PKW(P1,14), pw3); \
    l_reg+=sacc; \
    if(GK){DMA_K((t)+3,sl_cur);} if(GV){DMA_V((t)+1,sl_next);} \
    CMASK(C0,C1,t); \
    { float a=MX3(C0[0],C0[1],C1[0]),b=MX3(C0[2],C0[3],C1[1]); a=MX3(a,C1[2],C1[3]); \
      _Pragma("unroll") for(int r=4;r<16;r+=4){a=MX3(a,C0[r],C0[r+1]);b=MX3(b,C0[r+2],C0[r+3]);a=MX3(a,C1[r],C1[r+1]);b=MX3(b,C1[r+2],C1[r+3]);} \
      float rm=__builtin_fmaxf(a,b); { auto rr=__builtin_amdgcn_permlane32_swap(__float_as_uint(rm),__float_as_uint(rm),false,false); rm=__builtin_fmaxf(__uint_as_float(rr[0]),__uint_as_float(rr[1])); } \
      resc=false; \
      if(__builtin_expect(__any(rm>(float)THRL),0)){ const float dl=__builtin_fmaxf(rm,0.f); mhat+=dl; \
        _Pragma("unroll") for(int r=0;r<16;++r){C0[r]-=dl;C1[r]-=dl;} \
        _Pragma("unroll") for(int r=0;r<16;++r)negm[r]=-mhat; asm volatile("":"+v"(negm)); \
        const float f=__builtin_amdgcn_exp2f(-dl); l_reg*=f; if(hi==0)wsf[r32]=f; resc=true; } } \
    SBAR(); \
    GAPB(o[0]=__builtin_amdgcn_mfma_f32_32x32x16_bf16(PAF(0),VFR(0),o[0],0,0,0), C0,0); \
    GAPB(o[1]=__builtin_amdgcn_mfma_f32_32x32x16_bf16(PAF(0),VFR(4),o[1],0,0,0), C0,4); \
    KRD(GL,0); GAPB(o[0]=__builtin_amdgcn_mfma_f32_32x32x16_bf16(PAF(1),VFR(1),o[0],0,0,0), C0,8); \
    KRD(GL,1); GAPB(o[1]=__builtin_amdgcn_mfma_f32_32x32x16_bf16(PAF(1),VFR(5),o[1],0,0,0), C0,12); \
    KRD(GL,2); GAPB(o[0]=__builtin_amdgcn_mfma_f32_32x32x16_bf16(PAF(2),VFR(2),o[0],0,0,0), C1,0); \
    KRD(GL,3); GAPB(o[1]=__builtin_amdgcn_mfma_f32_32x32x16_bf16(PAF(2),VFR(6),o[1],0,0,0), C1,4); \
    GAPB(o[0]=__builtin_amdgcn_mfma_f32_32x32x16_bf16(PAF(3),VFR(3),o[0],0,0,0), C1,8); \
    GAPB(o[1]=__builtin_amdgcn_mfma_f32_32x32x16_bf16(PAF(3),VFR(7),o[1],0,0,0), C1,12); \
    }while(0)
  int t=1;
  #undef CMASK
  #define CMASK(P0,P1,t) do{}while(0)
  for(;t+7<NT;t+=2){
    STEP(pB0,pB1,pA0,pA1,t,true,true,true);     WAIT_BAR(2); RESC(); ROT();
    STEP(pA0,pA1,pB0,pB1,t+1,true,true,true);   WAIT_BAR(2); RESC(); ROT();
  }
  #undef CMASK
  #define CMASK(P0,P1,t) do{int jb_=(t)-(NT-4); if(jb_>=-2 && (wid*QBLK-(64*jb_+63))<128)cbias(P0,P1,jb_,qrel,hi,bt);}while(0)
  #define ENDW(tt) do{ if((tt)+3<NT){WAIT_BAR(2);} else if((tt)+2<NT){WAIT_BAR(1);} else {WAIT_BAR(0);} }while(0)
  for(;t+1<NT;t+=2){
    STEP(pB0,pB1,pA0,pA1,t,(t+3<NT),(t+1<NT),(t+1<NT));       ENDW(t);   RESC(); ROT();
    STEP(pA0,pA1,pB0,pB1,t+1,(t+4<NT),(t+2<NT),(t+2<NT));     ENDW(t+1); RESC(); ROT();
  }
  STEP(pB0,pB1,pA0,pA1,NT-1,false,false,false); RESC();
  { float sacc=pB0[0]+pB0[1]; _Pragma("unroll") for(int r=2;r<16;++r)sacc+=pB0[r]; _Pragma("unroll") for(int r=0;r<16;++r)sacc+=pB1[r]; l_reg+=sacc;
    pw0=(u32x4){PKW(pB0,0),PKW(pB0,2),PKW(pB0,4),PKW(pB0,6)};pw1=(u32x4){PKW(pB0,8),PKW(pB0,10),PKW(pB0,12),PKW(pB0,14)};pw2=(u32x4){PKW(pB1,0),PKW(pB1,2),PKW(pB1,4),PKW(pB1,6)};pw3=(u32x4){PKW(pB1,8),PKW(pB1,10),PKW(pB1,12),PKW(pB1,14)};
    SBAR(); pv(o,vb0+sl_cur,PAF(0),PAF(1),PAF(2),PAF(3)); }
  #undef PKW
  #undef PAF
  #undef VFR
  #undef PIN
  #undef MX3
  #undef GAPA
  #undef GAPB
  #undef EX
  #undef VRD
  #undef KRD
  #undef STEP
  #undef ENDW
  {auto rr=__builtin_amdgcn_permlane32_swap(__float_as_uint(l_reg),__float_as_uint(l_reg),false,false);l_reg=__uint_as_float(rr[0])+__uint_as_float(rr[1]);}
  if(hi==0)wsf[32+r32]=l_reg;asm volatile("s_waitcnt lgkmcnt(0)":::"memory");
  float rli[16];
  #pragma unroll
  for(int r=0;r<16;++r)rli[r]=__builtin_amdgcn_rcpf(wsf[32+crow(r,hi)]);
  bf16*Ow=O+(rowbase+q0+wid*QBLK)*DM+oc;
  { bf16*stg=(bf16*)(shm+LDS_OST)+wid*2048;
    #pragma unroll
    for(int r=0;r<16;++r){const int orow=crow(r,hi);
      #pragma unroll
      for(int d0=0;d0<2;++d0)stg[orow*64+d0*32+r32]=__float2bfloat16(o[d0][r]*rli[r]);}
    asm volatile("s_waitcnt lgkmcnt(0)":::"memory");
    #pragma unroll
    for(int i=0;i<4;++i){const int row=i*8+(lane>>3),ch=lane&7; const u32x4 v=*(const u32x4*)(stg+row*64+ch*8); ATTN_STORE16(Ow+(long)row*DM+ch*8,v);} }
  asm volatile("s_waitcnt lgkmcnt(0)\n\ts_barrier":::"memory");
  #undef DMA_K
  #undef DMA_V
  #undef CMASK
  #undef START
  #undef RESC
  #undef ROT
}
constexpr int ATTN_LDS_BYTES=LDS_BYTES;
#undef SBAR
#undef WAIT_BAR
}
struct Ctx {
    LAS unsigned char* lds; char* ldsg; int tid, lane, wave, G, vcu;
    const float* in[23]; float* out; unsigned char* ws;
};
#define WSP(T, off) ((T*)(C.ws + (off)))
#define PHASE_IDS() Ctx C = C0; { int t_ = threadIdx.x; asm volatile("" : "+v"(t_)); C.tid = t_; C.lane = t_ & 63; C.wave = __builtin_amdgcn_readfirstlane(t_ >> 6); }

__device__ __forceinline__ void conv_item(const float* W, int K, int N, bf16_t* WT, int out_row0, LAS float* scr, int kb, int nb, int lane) {
    const int k0 = 64 * kb, n0 = 32 * nb;
    const int kr = lane >> 3, nc = lane & 7;
    f32x4 v[8];
#pragma unroll
    for (int i = 0; i < 8; ++i) v[i] = *(const f32x4*)(W + (size_t)(k0 + 8 * i + kr) * N + n0 + 4 * nc);
#pragma unroll
    for (int i = 0; i < 8; ++i) { LAS float* s = scr + (8 * i + kr) * 33 + 4 * nc; s[0] = v[i][0]; s[1] = v[i][1]; s[2] = v[i][2]; s[3] = v[i][3]; }
    LDS_WAIT(); asm volatile("" ::: "memory");
    const int c = lane & 7;
#pragma unroll
    for (int j = 0; j < 4; ++j) { const int n = (lane >> 3) + 8 * j; const LAS float* s = scr + (8 * c) * 33 + n;
        u32x4 o; o.x = pk2(s[0 * 33], s[1 * 33]); o.y = pk2(s[2 * 33], s[3 * 33]); o.z = pk2(s[4 * 33], s[5 * 33]); o.w = pk2(s[6 * 33], s[7 * 33]);
        *(u32x4*)(WT + (size_t)(out_row0 + n) * K + k0 + 8 * c) = o; }
    LDS_WAIT(); asm volatile("" ::: "memory");
}
__device__ __forceinline__ void p0_prologue(const Ctx& C0) {
    PHASE_IDS();
    LAS float* scr = (LAS float*)(C.lds + C.wave * 8448);
    const int gw = C.vcu * NWAVES + C.wave, NGW = C.G * NWAVES;
    constexpr int I_IN = 16 * 160, I_BR = 8 * 32, I_OUT = 16 * 32, I_GU1 = 16 * 64, I_GU = NE * I_GU1, I_D1 = 16 * 32, I_D = NE * I_D1;
    constexpr int NITEMS = I_IN + 2 * I_BR + I_OUT + I_GU + I_D;
    for (int it = gw; it < NITEMS; it += NGW) {
        int r = it;
        if (r < I_GU) { const int e = r / I_GU1, q = r % I_GU1, kb = q / 64, nb = q % 64; const int n0 = 32 * nb, half = n0 >> 10, rem = n0 & 1023;
            conv_item(C.in[18] + (size_t)e * 1024 * 2048, 1024, 2048, WSP(bf16_t, WS_WGU) + (size_t)e * 2048 * 1024, (rem >> 7) * 256 + half * 128 + (rem & 127), scr, kb, nb, C.lane); continue; } r -= I_GU;
        if (r < I_D) { const int e = r / I_D1, q = r % I_D1, kb = q / 32, nb = q % 32;
            conv_item(C.in[20] + (size_t)e * 1024 * 1024, 1024, 1024, WSP(bf16_t, WS_WD) + (size_t)e * 1024 * 1024, 32 * nb, scr, kb, nb, C.lane); continue; } r -= I_D;
        if (r < I_IN) { conv_item(C.in[6], 1024, INW, WSP(bf16_t, WS_WIN), 32 * (r % 160), scr, r / 160, r % 160, C.lane); continue; } r -= I_IN;
        if (r < I_BR) { conv_item(C.in[12], 512, 1024, WSP(bf16_t, WS_WBRA), 32 * (r % 32), scr, r / 32, r % 32, C.lane); continue; } r -= I_BR;
        if (r < I_BR) { conv_item(C.in[13], 512, 1024, WSP(bf16_t, WS_WBRB), 32 * (r % 32), scr, r / 32, r % 32, C.lane); continue; } r -= I_BR;
        conv_item(C.in[14], 1024, 1024, WSP(bf16_t, WS_WOUT), 32 * (r % 32), scr, r / 32, r % 32, C.lane);
    }
    const float* cvec = C.in[1]; const float* wada = C.in[3]; float* adap = WSP(float, WS_ADAP);
    for (int it = gw; it < 96 * 8; it += NGW) { const int cc = it % 96, ks = it / 96; const int n = 64 * cc + C.lane; float a0 = 0.f, a1 = 0.f;
#pragma unroll 8
        for (int k = 0; k < 128; ++k) { const int kk = 128 * ks + k; const float w = wada[(size_t)kk * 6144 + n]; a0 += cvec[kk] * w; a1 += cvec[1024 + kk] * w; }
        adap[(ks * 2 + 0) * 6144 + n] = a0; adap[(ks * 2 + 1) * 6144 + n] = a1; }
}
__device__ __forceinline__ float ada_val(const Ctx& C, int b, int n) {
    const float* adap = WSP(const float, WS_ADAP); float s = C.in[4][n];
#pragma unroll
    for (int ks = 0; ks < 8; ++ks) s += adap[(ks * 2 + b) * 6144 + n];
    return s;
}
__device__ __forceinline__ void rms_mod_row(const float* xrow, bf16_t* orow, const LAS float* MA, const LAS float* MB, int lane) {
    const f32x4* xr = (const f32x4*)xrow + lane;
    f32x4 v[4]; float s = 0.f;
#pragma unroll
    for (int j = 0; j < 4; ++j) { v[j] = xr[64 * j]; s += (v[j][0] * v[j][0] + v[j][1] * v[j][1]) + (v[j][2] * v[j][2] + v[j][3] * v[j][3]); }
    const float rstd = 1.0f / sqrtf(wave_sum(s) * (1.0f / D) + RMS_EPS);
    u32x2* o8 = (u32x2*)orow + lane;
#pragma unroll
    for (int j = 0; j < 4; ++j) { const f32x4 a = *(const LAS f32x4*)(MA + 4 * lane + 256 * j), b = *(const LAS f32x4*)(MB + 4 * lane + 256 * j);
        const f32x4 h = v[j] * rstd * a + b; u32x2 w; w.x = pk2(h[0], h[1]); w.y = pk2(h[2], h[3]); o8[64 * j] = w; }
}
__device__ __forceinline__ void p1_h1(const Ctx& C0) {
    PHASE_IDS();
    LAS float* MA = (LAS float*)C.lds;
    LAS float* MB = MA + 2048;
    for (int idx = C.tid; idx < 2048; idx += 512) { const int b = idx >> 10, col = idx & 1023;
        const float sh = ada_val(C, b, col), sc = ada_val(C, b, 1024 + col);
        MA[idx] = C.in[5][col] * (1.0f + sc); MB[idx] = sh; }
    {
        const int per = (2 * 6144 + C.G - 1) / C.G;
        for (int i = C.tid; i < per; i += 512) { const int idx = blockIdx.x * per + i; if (idx < 2 * 6144) WSP(float, WS_ADAF)[idx] = ada_val(C, idx / 6144, idx % 6144); }
    }
    __syncthreads();
    const int gw = C.vcu * NWAVES + C.wave, NGW = C.G * NWAVES;
    for (int m = gw; m < M; m += NGW) { const int b = m >= SEQ; rms_mod_row(C.in[0] + (size_t)m * D, WSP(bf16_t, WS_H) + (size_t)m * D, MA + b * 1024, MB + b * 1024, C.lane); }
    __syncthreads();
}
__device__ __forceinline__ void p3a_kmean(const Ctx& C0) {
    PHASE_IDS();
    LAS float* red = (LAS float*)C.lds;
    const bf16_t* kb = WSP(const bf16_t, WS_PROJ + 2 * PROJ_STRIDE);
    for (int it = blockIdx.x; it < 64; it += C.G) { const int b = it >> 5, n = it & 31;
        float a[8];
#pragma unroll
        for (int j = 0; j < 8; ++j) a[j] = 0.f;
        const bf16_t* src = kb + (size_t)(b * SEQ + 256 * n + 32 * C.wave) * 1024 + 8 * C.lane;
#pragma unroll 8
        for (int r = 0; r < 32; ++r) { const u32x4 v = *(const u32x4*)(src + (size_t)r * 1024);
            a[0] += bf_lo(v.x); a[1] += bf_hi(v.x); a[2] += bf_lo(v.y); a[3] += bf_hi(v.y); a[4] += bf_lo(v.z); a[5] += bf_hi(v.z); a[6] += bf_lo(v.w); a[7] += bf_hi(v.w); }
        __syncthreads();
#pragma unroll
        for (int j = 0; j < 8; ++j) red[C.wave * 512 + 8 * C.lane + j] = a[j];
        __syncthreads();
        { const int col = C.tid; float s = 0.f;
#pragma unroll
            for (int w = 0; w < 8; ++w) s += red[w * 512 + col];
            const int h = col >> 6, d = col & 63; WSP(float, WS_KMEAN)[((b * 8 + h) * 32 + n) * 64 + d] = s * (1.0f / 256.0f); }
    }
    __syncthreads();
}
__device__ __forceinline__ void p3b_gate(const Ctx& C0) {
    PHASE_IDS();
    LAS float* km = (LAS float*)C.lds;
    const bf16_t* qb = WSP(const bf16_t, WS_PROJ + 1 * PROJ_STRIDE) + 512;
    unsigned* cnt = WSP(unsigned, WS_CTL) + CW_MCNT; unsigned* list = WSP(unsigned, WS_LIST);
    for (int it = blockIdx.x; it < 256; it += C.G) { const int bh = it >> 4, qc = it & 15, b = bh >> 3, h = bh & 7;
        __syncthreads();
        for (int i = C.tid; i < 2048; i += 512) km[i] = WSP(const float, WS_KMEAN)[bh * 2048 + i];
        __syncthreads();
        const int q = 512 * qc + C.tid, own = q >> 8;
        u32x4 qv[8];
        { const u32x4* qp = (const u32x4*)(qb + (size_t)(b * SEQ + q) * 1024 + h * 64);
#pragma unroll
            for (int j = 0; j < 8; ++j) qv[j] = qp[j]; }
        float v0 = -INFINITY, v1 = -INFINITY, v2 = -INFINITY; int i0 = 0, i1 = 0, i2 = 0;
        const int nmax = ((512 * qc + 511) >> 8);
        for (int n = 0; n < nmax; ++n) { const LAS f32x4* kr = (const LAS f32x4*)(km + n * 64); float s = 0.f;
#pragma unroll
            for (int j = 0; j < 8; ++j) { const f32x4 ka = kr[2 * j], kb2 = kr[2 * j + 1];
                s += bf_lo(qv[j].x) * ka[0] + bf_hi(qv[j].x) * ka[1] + bf_lo(qv[j].y) * ka[2] + bf_hi(qv[j].y) * ka[3]
                   + bf_lo(qv[j].z) * kb2[0] + bf_hi(qv[j].z) * kb2[1] + bf_lo(qv[j].w) * kb2[2] + bf_hi(qv[j].w) * kb2[3]; }
            if (n < own) {
                if (s > v0) { v2 = v1; i2 = i1; v1 = v0; i1 = i0; v0 = s; i0 = n; }
                else if (s > v1) { v2 = v1; i2 = i1; v1 = s; i1 = n; }
                else if (s > v2) { v2 = s; i2 = n; }
            } }
        const int nsel = own < 3 ? own : 3;
        LAS unsigned* lc = (LAS unsigned*)(C.lds + 8192);
        if (C.tid < 64) lc[C.tid] = 0u;
        __syncthreads();
        unsigned lp0 = 0u, lp1 = 0u, lp2 = 0u;
        if (nsel > 0) lp0 = atomicAdd((unsigned*)(lc + i0), 1u);
        if (nsel > 1) lp1 = atomicAdd((unsigned*)(lc + i1), 1u);
        if (nsel > 2) lp2 = atomicAdd((unsigned*)(lc + i2), 1u);
        __syncthreads();
        if (C.tid < 32) { const unsigned c = lc[C.tid]; lc[32 + C.tid] = c ? atomicAdd(cnt + bh * 32 + C.tid, c) : 0u; }
        __syncthreads();
#pragma unroll
        for (int j = 0; j < 3; ++j) if (j < nsel) { const int n = j == 0 ? i0 : (j == 1 ? i1 : i2); const unsigned pos = lc[32 + n] + (j == 0 ? lp0 : (j == 1 ? lp1 : lp2));
            list[(size_t)bh * LIST_PER_BH + 256 * (31 * n - (n * (n - 1)) / 2) + pos] = (unsigned)q | ((unsigned)j << 13); }
    }
    __syncthreads();
}
__device__ __forceinline__ void build_bias_tables(const Ctx& C) {
    LAS float* bt = (LAS float*)(C.lds + AT_BT);
    for (int idx = C.tid; idx < 12 * 128; idx += 512) { const int hd = idx >> 7, n = idx & 127;
        int bk;
        if (n < 16) bk = n; else { const float nf = (float)n; int lg = 16 + (int)(logf(nf / 16.0f) / logf(8.0f) * 16.0f); bk = lg < 31 ? lg : 31; }
        bt[idx] = (C.in[2][bk * 12 + hd] - C.in[2][31 * 12 + hd]) * LOG2E; }
}
#if SIMPLE_DIFF
__device__ __forceinline__ void diff_unit(const Ctx& C, int b, int h, int qblk, float lam) {
    const int lane = C.lane, c = lane & 15, g = lane >> 4, wid = C.wave;
    const bf16_t* qka = WSP(const bf16_t, WS_PROJ);
    const bf16_t* va = WSP(const bf16_t, WS_PROJ + PROJ_STRIDE);
    const int q0 = qblk * 128, q = q0 + wid * 16 + c, NT = 2 * qblk + 2;
    const LAS float* bt = (const LAS float*)(C.lds + AT_BT) + h * 128;
    f32x4 o0[8];
    for (int map = 0; map < 2; ++map) {
        bf16x8 qf[2];
#pragma unroll
        for (int ks = 0; ks < 2; ++ks) qf[ks] = *(const bf16x8*)(qka + (size_t)(b * SEQ + q) * 1024 + h * 128 + map * 64 + 32 * ks + 8 * g);
        const bf16_t* kg = qka + (size_t)(b * SEQ) * 1024 + 512 + h * 128 + map * 64;
        const bf16_t* vg = va + (size_t)(b * SEQ) * 1024 + h * 128;
        float m_run = -1e30f, l_run = 0.f; f32x4 o[8];
#pragma unroll
        for (int dt = 0; dt < 8; ++dt) o[dt] = (f32x4){0.f, 0.f, 0.f, 0.f};
        TileRegs<2> tr; tile_fetch<2>(tr, kg, vg, C.tid);
        for (int t = 0; t < NT; ++t) {
            __syncthreads();
            tile_store<2>(tr, C.lds, C.tid);
            __syncthreads();
            if (t + 1 < NT) tile_fetch<2>(tr, kg + (size_t)(t + 1) * 64 * 1024, vg + (size_t)(t + 1) * 64 * 1024, C.tid);
            attn_tile<8>(C.lds, lane, qf, o, m_run, l_run, q, 64 * t, true, bt);
        }
        float lt = l_run; lt += __shfl_xor(lt, 16); lt += __shfl_xor(lt, 32);
        const float rl = 1.0f / lt;
#pragma unroll
        for (int i = 0; i < 4; ++i) { const float ri = __shfl(rl, 4 * g + i);
#pragma unroll
            for (int dt = 0; dt < 8; ++dt) { if (map == 0) o0[dt][i] = o[dt][i] * ri; else o0[dt][i] = o0[dt][i] - lam * (o[dt][i] * ri); } }
    }
    bf16_t* y = WSP(bf16_t, WS_Y);
#pragma unroll
    for (int i = 0; i < 4; ++i) { float ss = 0.f;
#pragma unroll
        for (int dt = 0; dt < 8; ++dt) ss += o0[dt][i] * o0[dt][i];
        ss += __shfl_xor(ss, 1); ss += __shfl_xor(ss, 2); ss += __shfl_xor(ss, 4); ss += __shfl_xor(ss, 8);
        const float rstd = 1.0f / sqrtf(ss * (1.0f / 128.0f) + RMS_EPS);
        bf16_t* yr = y + (size_t)(b * SEQ + q0 + wid * 16 + 4 * g + i) * 1024 + h * 128 + c;
#pragma unroll
        for (int dt = 0; dt < 8; ++dt) yr[16 * dt] = (bf16_t)f2bf(o0[dt][i] * rstd * C.in[11][16 * dt + c] * 0.8f); }
}
#endif
__device__ __forceinline__ void moba_item(const Ctx& C, int b, int h, int n, bool own, int half, const unsigned* lst, int lcnt, int chunk) {
    const int lane = C.lane, c = lane & 15, g = lane >> 4, wid = C.wave;
    const bf16_t* qb = WSP(const bf16_t, WS_PROJ + PROJ_STRIDE) + 512;
    const bf16_t* kv = WSP(const bf16_t, WS_PROJ + 2 * PROJ_STRIDE);
    int qtok, jslot; bool valid;
    if (own) { qtok = 256 * n + 128 * half + wid * 16 + c; jslot = 3; valid = true; }
    else { const int idx = chunk * 128 + wid * 16 + c; valid = idx < lcnt; const unsigned e = lst[valid ? idx : 0]; qtok = (int)(e & 8191u); jslot = (int)(e >> 13); }
    bf16x8 qf[2];
#pragma unroll
    for (int ks = 0; ks < 2; ++ks) qf[ks] = *(const bf16x8*)(qb + (size_t)(b * SEQ + qtok) * 1024 + h * 64 + 32 * ks + 8 * g);
    const bf16_t* kg = kv + (size_t)(b * SEQ + 256 * n) * 1024 + h * 64;
    const bf16_t* vg = kg + 512;
    const LAS float* bt = (const LAS float*)(C.lds + AT_BT) + (4 + h) * 128;
    const int NT = own ? 2 * (half + 1) : 4;
    float m_run = -1e30f, l_run = 0.f; f32x4 o[4];
#pragma unroll
    for (int dt = 0; dt < 4; ++dt) o[dt] = (f32x4){0.f, 0.f, 0.f, 0.f};
    TileRegs<1> tr; tile_fetch<1>(tr, kg, vg, C.tid);
    for (int t = 0; t < NT; ++t) {
        __syncthreads();
        tile_store<1>(tr, C.lds, C.tid);
        __syncthreads();
        if (t + 1 < NT) tile_fetch<1>(tr, kg + (size_t)(t + 1) * 64 * 1024, vg + (size_t)(t + 1) * 64 * 1024, C.tid);
        attn_tile<4>(C.lds, lane, qf, o, m_run, l_run, qtok, 256 * n + 64 * t, own, bt);
    }
    float lt = l_run; lt += __shfl_xor(lt, 16); lt += __shfl_xor(lt, 32);
    const int slot = ((b * SEQ + qtok) * 8 + h) * 4 + jslot;
    if (g == 0 && valid) { f32x2 ml; ml[0] = m_run; ml[1] = lt; *(f32x2*)(WSP(float, WS_PML) + (size_t)slot * 2) = ml; }
    bf16_t* po = WSP(bf16_t, WS_PO);
#pragma unroll
    for (int i = 0; i < 4; ++i) { const int sl = __shfl(slot, 4 * g + i); const int vl = __shfl((int)valid, 4 * g + i);
        if (vl) {
#pragma unroll
            for (int dt = 0; dt < 4; ++dt) po[(size_t)sl * 64 + 16 * dt + c] = (bf16_t)f2bf(o[dt][i]); } }
}
#ifndef PROBE_SUB
#define PROBE_SUB 3
#endif
__device__ __forceinline__ void p4_attention(const Ctx& C0, int sub) {
    PHASE_IDS();
    __syncthreads();
    build_bias_tables(C);
    float lam;
    { const float a = wave_sum(C.in[7][C.lane] * C.in[8][C.lane]), b2 = wave_sum(C.in[9][C.lane] * C.in[10][C.lane]); lam = expf(a) - expf(b2) + 0.2f; }
    __syncthreads();
#if SIMPLE_DIFF
    if (sub & 1) for (int p = blockIdx.x; p < 256; p += C.G) { const int bh = p >> 5, qa = p & 31;
        diff_unit(C, bh >> 2, bh & 3, qa, lam); diff_unit(C, bh >> 2, bh & 3, 63 - qa, lam); }
#else
    if (sub & 1) for (int v = C.vcu; v < 256; v += C.G) { const int bvh = v >> 3, s = v & 7, b = bvh >> 4, vh = bvh & 15, h = vh >> 2, mp = (vh >> 1) & 1, vhf = vh & 1;
        const attn_body::bf16* qk = (const attn_body::bf16*)WSP(const bf16_t, WS_PROJ); const attn_body::bf16* vv = (const attn_body::bf16*)WSP(const bf16_t, WS_PROJ + PROJ_STRIDE);
        attn_body::bf16* oa = (attn_body::bf16*)WSP(bf16_t, WS_OA);
        const LAS float* bth = (const LAS float*)(C.lds + AT_BT) + h * 128;
#pragma unroll 1
        for (int i = 0; i < 4; ++i) { const int qb = (i == 0) ? s : (i == 1) ? 15 - s : (i == 2) ? 16 + s : 31 - s;
            attn_body::attn_unit<8>(b, qb, qk, qk, vv, oa, h * 128 + mp * 64, 512 + h * 128 + mp * 64, h * 128 + vhf * 64, mp * 512 + h * 128 + vhf * 64, bth, C.ldsg); } }
#endif
    LAS int* pre = (LAS int*)(C.lds + AT_MISC);
    LAS int* wtot = pre + 520;
    const unsigned* cnt = WSP(const unsigned, WS_CTL) + CW_MCNT;
    __syncthreads();
    { const int L = C.tid; const int nch = ((int)__hip_atomic_load(cnt + L, RLX_AGENT) + 127) >> 7;
        int inc = nch;
#pragma unroll
        for (int o = 1; o < 64; o <<= 1) { const int t = __shfl_up(inc, o); if (C.lane >= o) inc += t; }
        if (C.lane == 63) wtot[C.wave] = inc;
        __syncthreads();
        int base = 0;
        for (int w = 0; w < C.wave; ++w) base += wtot[w];
        pre[L] = base + inc - nch;
        if (L == 511) pre[512] = base + inc;
    }
    __syncthreads();
    const int ngath = pre[512];
    if (sub & 2) for (int it = blockIdx.x; it < 1024 + ngath; it += C.G) {
        if (it < 1024) { const int bh = it >> 6, r = it & 63; moba_item(C, bh >> 3, bh & 7, r >> 1, true, r & 1, nullptr, 0, 0); }
        else { const int gi = it - 1024; int lo = 0, hi = 511;
            while (lo < hi) { const int mid = (lo + hi + 1) >> 1; if (pre[mid] <= gi) lo = mid; else hi = mid - 1; }
            const int L = lo, bh = L >> 5, n = L & 31;
            const int lcnt = (int)__hip_atomic_load(cnt + L, RLX_AGENT);
            moba_item(C, bh >> 3, bh & 7, n, false, 0, WSP(const unsigned, WS_LIST) + (size_t)bh * LIST_PER_BH + 256 * (31 * n - (n * (n - 1)) / 2), lcnt, gi - pre[L]); }
    }
    __syncthreads();
}
__device__ __forceinline__ void p5_ycombine(const Ctx& C0) {
    PHASE_IDS();
    const int gw = C.vcu * NWAVES + C.wave, NGW = C.G * NWAVES;
    const bf16_t* po = WSP(const bf16_t, WS_PO); const float* pml = WSP(const float, WS_PML); bf16_t* y = WSP(bf16_t, WS_Y);
#if !SIMPLE_DIFF
    {
        const float lam = expf(wave_sum(C.in[7][C.lane] * C.in[8][C.lane])) - expf(wave_sum(C.in[9][C.lane] * C.in[10][C.lane])) + 0.2f;
        const bf16_t* oa = WSP(const bf16_t, WS_OA);
        const f32x4 g0 = *(const f32x4*)(C.in[11] + 8 * (C.lane & 15)), g1 = *(const f32x4*)(C.in[11] + 8 * (C.lane & 15) + 4);
        for (int m = gw; m < M; m += NGW) { const u32x4 a = *(const u32x4*)(oa + (size_t)m * 1024 + 8 * C.lane), b2 = *(const u32x4*)(oa + (size_t)m * 1024 + 512 + 8 * C.lane);
            float v[8];
            v[0] = bf_lo(a.x) - lam * bf_lo(b2.x); v[1] = bf_hi(a.x) - lam * bf_hi(b2.x); v[2] = bf_lo(a.y) - lam * bf_lo(b2.y); v[3] = bf_hi(a.y) - lam * bf_hi(b2.y);
            v[4] = bf_lo(a.z) - lam * bf_lo(b2.z); v[5] = bf_hi(a.z) - lam * bf_hi(b2.z); v[6] = bf_lo(a.w) - lam * bf_lo(b2.w); v[7] = bf_hi(a.w) - lam * bf_hi(b2.w);
            float ss = 0.f;
#pragma unroll
            for (int k = 0; k < 8; ++k) ss += v[k] * v[k];
            ss += __shfl_xor(ss, 1); ss += __shfl_xor(ss, 2); ss += __shfl_xor(ss, 4); ss += __shfl_xor(ss, 8);
            const float r = 0.8f / sqrtf(ss * (1.0f / 128.0f) + RMS_EPS);
            u32x4 w; w.x = pk2(v[0] * r * g0[0], v[1] * r * g0[1]); w.y = pk2(v[2] * r * g0[2], v[3] * r * g0[3]); w.z = pk2(v[4] * r * g1[0], v[5] * r * g1[1]); w.w = pk2(v[6] * r * g1[2], v[7] * r * g1[3]);
            *(u32x4*)(y + (size_t)m * 1024 + 8 * C.lane) = w; }
    }
#endif
    for (int m = gw; m < M; m += NGW) { const int h = C.lane >> 3, dch = C.lane & 7; const int own = (m & (SEQ - 1)) >> 8, nsel = own < 3 ? own : 3;
        const size_t s0 = ((size_t)m * 8 + h) * 4;
        float mm[4], ll[4]; u32x4 ov[4];
#pragma unroll
        for (int j = 0; j < 4; ++j) { const bool use = (j == 3) || (j < nsel);
            if (use) { const f32x2 ml = *(const f32x2*)(pml + (s0 + j) * 2); mm[j] = ml[0]; ll[j] = ml[1]; ov[j] = *(const u32x4*)(po + (s0 + j) * 64 + 8 * dch); }
            else { mm[j] = -INFINITY; ll[j] = 0.f; ov[j] = (u32x4){0u, 0u, 0u, 0u}; } }
        const float mx = fmaxf(fmaxf(mm[0], mm[1]), fmaxf(mm[2], mm[3]));
        float den = 0.f; float acc[8];
#pragma unroll
        for (int k = 0; k < 8; ++k) acc[k] = 0.f;
#pragma unroll
        for (int j = 0; j < 4; ++j) { const float w = __builtin_amdgcn_exp2f(mm[j] - mx); den += w * ll[j];
            acc[0] += w * bf_lo(ov[j].x); acc[1] += w * bf_hi(ov[j].x); acc[2] += w * bf_lo(ov[j].y); acc[3] += w * bf_hi(ov[j].y);
            acc[4] += w * bf_lo(ov[j].z); acc[5] += w * bf_hi(ov[j].z); acc[6] += w * bf_lo(ov[j].w); acc[7] += w * bf_hi(ov[j].w); }
        const float r = 1.0f / den;
        u32x4 w; w.x = pk2(acc[0] * r, acc[1] * r); w.y = pk2(acc[2] * r, acc[3] * r); w.z = pk2(acc[4] * r, acc[5] * r); w.w = pk2(acc[6] * r, acc[7] * r);
        *(u32x4*)(y + (size_t)m * 1024 + 512 + h * 64 + 8 * dch) = w; }
}
__device__ __forceinline__ void p8_router(const Ctx& C0) {
    PHASE_IDS();
    LAS float* MA = (LAS float*)C.lds; LAS float* MB = MA + 2048;
    LAS int* hist = (LAS int*)(C.lds + 16384);
    for (int idx = C.tid; idx < 2048; idx += 512) { const int b = idx >> 10, col = idx & 1023; const float* af = WSP(const float, WS_ADAF) + b * 6144;
        MA[idx] = C.in[15][col] * (1.0f + af[4096 + col]); MB[idx] = af[3072 + col]; }
    if (C.tid < 32) hist[C.tid] = 0;
    __syncthreads();
    bf16_t* h2 = WSP(bf16_t, WS_H);
    for (int blk = blockIdx.x; blk < M / 64; blk += C.G) {
        const int r0 = 64 * blk, b = r0 >= SEQ;
        for (int r = 0; r < 8; ++r) { const int m = r0 + 8 * C.wave + r; rms_mod_row(WSP(const float, WS_X1) + (size_t)m * D, h2 + (size_t)m * D, MA + b * 1024, MB + b * 1024, C.lane); }
        VM_WAIT(); __syncthreads();
        if (C.wave < 4) { const int lane = C.lane, c = lane & 15, g = lane >> 4; const int rb = r0 + 16 * C.wave;
            f32x4 lg[2]; lg[0] = (f32x4){0.f, 0.f, 0.f, 0.f}; lg[1] = lg[0];
            const bf16_t* ar = h2 + (size_t)(rb + c) * D + 8 * g; const float* wr = C.in[16];
            for (int ks = 0; ks < 32; ++ks) { const bf16x8 a = *(const bf16x8*)(ar + 32 * ks);
#pragma unroll
                for (int nt = 0; nt < 2; ++nt) { const float* wp = wr + (size_t)(32 * ks + 8 * g) * 32 + 16 * nt + c; u32x4 w;
                    w.x = pk2(wp[0], wp[32]); w.y = pk2(wp[64], wp[96]); w.z = pk2(wp[128], wp[160]); w.w = pk2(wp[192], wp[224]);
                    lg[nt] = __builtin_amdgcn_mfma_f32_16x16x32_bf16(a, __builtin_bit_cast(bf16x8, w), lg[nt], 0, 0, 0); } }
            const float br0 = C.in[17][c], br1 = C.in[17][16 + c];
#pragma unroll
            for (int i = 0; i < 4; ++i) { float a0 = lg[0][i] + br0, a1 = lg[1][i] + br1; float tv[4]; int ti[4];
#pragma unroll
                for (int k = 0; k < 4; ++k) { float bv; int bi; if (a1 > a0) { bv = a1; bi = 16 + c; } else { bv = a0; bi = c; }
#pragma unroll
                    for (int o = 1; o < 16; o <<= 1) { const float ov = __shfl_xor(bv, o); const int oi = __shfl_xor(bi, o); if (ov > bv || (ov == bv && oi < bi)) { bv = ov; bi = oi; } }
                    tv[k] = bv; ti[k] = bi; if (bi == c) a0 = -INFINITY; if (bi == 16 + c) a1 = -INFINITY; }
                if (c == 0) { const int row = rb + 4 * g + i; const float e1 = __expf(tv[1] - tv[0]), e2 = __expf(tv[2] - tv[0]), e3 = __expf(tv[3] - tv[0]); const float inv = 1.0f / (1.0f + e1 + e2 + e3);
                    *(int4*)(WSP(int, WS_TOPI) + (size_t)row * 4) = make_int4(ti[0], ti[1], ti[2], ti[3]);
                    *(f32x4*)(WSP(float, WS_TOPW) + (size_t)row * 4) = (f32x4){inv, e1 * inv, e2 * inv, e3 * inv};
                    atomicAdd((int*)(hist + ti[0]), 1); atomicAdd((int*)(hist + ti[1]), 1); atomicAdd((int*)(hist + ti[2]), 1); atomicAdd((int*)(hist + ti[3]), 1); } }
        }
        __syncthreads();
        if (C.tid < 32) { WSP(int, WS_HIST)[blk * 32 + C.tid] = hist[C.tid]; hist[C.tid] = 0; }
        __syncthreads();
    }
}
__device__ __forceinline__ void p9_slots(const Ctx& C0) {
    PHASE_IDS();
    LAS int* tot = (LAS int*)C.lds;
    LAS int* off = tot + 32;
    LAS int* cur = off + 40;
    const int* hist = WSP(const int, WS_HIST);
    for (int blk = blockIdx.x; blk < M / 64; blk += C.G) {
        __syncthreads();
        if (C.tid < 32) { int t = 0, p = 0; for (int w = 0; w < M / 64; ++w) { const int v = hist[w * 32 + C.tid]; t += v; p += (w < blk) ? v : 0; } tot[C.tid] = t; cur[C.tid] = p; }
        __syncthreads();
        if (C.tid == 0) { int o = 0; for (int e = 0; e < 32; ++e) { off[e] = o; o += (tot[e] + 255) & ~255; } off[32] = o; }
        __syncthreads();
        if (C.tid < 32) cur[C.tid] += off[C.tid];
        __syncthreads();
        if (C.tid < 256) { const int token = 64 * blk + (C.tid >> 2), k = C.tid & 3; const int e = WSP(const int, WS_TOPI)[token * 4 + k];
            const int slot = atomicAdd((int*)(cur + e), 1);
            WSP(int, WS_SLOTTOK)[slot] = token; WSP(float, WS_SLOTW)[slot] = WSP(const float, WS_TOPW)[token * 4 + k]; WSP(int, WS_TOKSLOT)[token * 4 + k] = slot; }
        if (blk < 32) { const int e = blk; for (int s = off[e] + tot[e] + C.tid; s < off[e + 1]; s += 512) { WSP(int, WS_SLOTTOK)[s] = 0; WSP(float, WS_SLOTW)[s] = 0.f; } }
        if (blk == 0 && C.tid < 33) WSP(int, WS_EOFF)[C.tid] = off[C.tid];
    }
    __syncthreads();
}
__device__ __forceinline__ void p12_final(const Ctx& C0) {
    PHASE_IDS();
    const int gw = C.vcu * NWAVES + C.wave, NGW = C.G * NWAVES;
    const bf16_t* so = WSP(const bf16_t, WS_SOUT); const float* x1 = WSP(const float, WS_X1); const int* ts = WSP(const int, WS_TOKSLOT);
    for (int m = gw; m < M; m += NGW) { const float* gt = WSP(const float, WS_ADAF) + (m >= SEQ ? 6144 : 0) + 5120;
        const int4 sl = *(const int4*)(ts + (size_t)m * 4);
        f32x4 v[4]; float s = 0.f;
#pragma unroll
        for (int j = 0; j < 4; ++j) { const int col = 4 * C.lane + 256 * j; f32x4 a = (f32x4){0.f, 0.f, 0.f, 0.f};
            { const u32x2 w = *(const u32x2*)(so + (size_t)sl.x * 1024 + col); a[0] += bf_lo(w.x); a[1] += bf_hi(w.x); a[2] += bf_lo(w.y); a[3] += bf_hi(w.y); }
            { const u32x2 w = *(const u32x2*)(so + (size_t)sl.y * 1024 + col); a[0] += bf_lo(w.x); a[1] += bf_hi(w.x); a[2] += bf_lo(w.y); a[3] += bf_hi(w.y); }
            { const u32x2 w = *(const u32x2*)(so + (size_t)sl.z * 1024 + col); a[0] += bf_lo(w.x); a[1] += bf_hi(w.x); a[2] += bf_lo(w.y); a[3] += bf_hi(w.y); }
            { const u32x2 w = *(const u32x2*)(so + (size_t)sl.w * 1024 + col); a[0] += bf_lo(w.x); a[1] += bf_hi(w.x); a[2] += bf_lo(w.y); a[3] += bf_hi(w.y); }
            v[j] = *(const f32x4*)(x1 + (size_t)m * D + col) + *(const f32x4*)(gt + col) * a;
            s += (v[j][0] * v[j][0] + v[j][1] * v[j][1]) + (v[j][2] * v[j][2] + v[j][3] * v[j][3]); }
        const float rstd = 1.0f / sqrtf(wave_sum(s) * (1.0f / D) + RMS_EPS);
#pragma unroll
        for (int j = 0; j < 4; ++j) { const int col = 4 * C.lane + 256 * j; *(f32x4*)(C.out + (size_t)m * D + col) = v[j] * rstd * *(const f32x4*)(C.in[22] + col); } }
}
struct Args { const float* in[23]; float* out; unsigned char* ws; int ph_lo, ph_hi, li, pad; };
constexpr int N_PHASES = 13;
#ifndef MK_N_LAUNCHES
#define MK_N_LAUNCHES 1
#endif

__global__ void __launch_bounds__(NWAVES * 64, 2) mega_fwd(Args args) {
    extern __shared__ __attribute__((aligned(16))) unsigned char lds_raw[];
    Ctx C;
    C.lds = (LAS unsigned char*)lds_raw; C.ldsg = (char*)lds_raw;
    C.tid = threadIdx.x; C.lane = C.tid & 63; C.wave = __builtin_amdgcn_readfirstlane(C.tid >> 6);
    C.G = gridDim.x; { const int bx = blockIdx.x; C.vcu = (C.G % 8 == 0) ? (bx % 8) * (C.G / 8) + bx / 8 : bx; }
#pragma unroll
    for (int i = 0; i < 23; ++i) C.in[i] = args.in[i];
    C.out = args.out; C.ws = args.ws;
    volatile LAS unsigned* MISC = (volatile LAS unsigned*)(C.lds + MISC_OFF);
    for (int u = C.tid; u < (LDS_BYTES - LDSCTL_OFF) / 4; u += NWAVES * 64) ((LAS unsigned*)(C.lds + LDSCTL_OFF))[u] = 0u;
    __syncthreads();
    unsigned* ctl = (unsigned*)(C.ws + WS_CTL);
    XcdBarrier bar = xcd_barrier_post(ctl + CW_BAR + args.li * XCD_BAR_WORDS, MISC + 8);
    const int lo = args.ph_lo, hi = args.ph_hi;
#define IN(k) (lo <= (k) && (k) < hi)
#define SEAM(k) do { if (IN(k) && IN((k) + 1)) xcd_barrier(bar); } while (0)
#ifndef PROBE_REP
#define PROBE_REP -1
#endif
#define REPS(k) (((k) == PROBE_REP) ? 2 : 1)
#define DUP(k, ...) do { __VA_ARGS__; if (REPS(k) == 2) { __VA_ARGS__; } } while (0)

    if (IN(0)) { DUP(0, p0_prologue(C)); } SEAM(0);
    if (IN(1)) { DUP(30, p1_h1(C)); } SEAM(1);
    if (IN(2)) { pg8::DenseSched S; S.init(M, INW, C.G, (int)blockIdx.x, WSP(bf16_t, WS_WIN), 1024); pg8::EpiProj E{WSP(bf16_t, WS_PROJ)};
        DUP(2, pg8::gemm_phase<pg8::EpiProj, pg8::DenseSched, true>(C.lds, WSP(bf16_t, WS_H), 1024, 1024, 1024, S, E)); } SEAM(2);
    if (IN(3)) { DUP(33, p3a_kmean(C)); } SEAM(3);
    if (IN(4)) { p3b_gate(C); } SEAM(4);
    if (IN(5)) { p4_attention(C, 3); if (REPS(5) == 2) p4_attention(C, PROBE_SUB); } SEAM(5);
    if (IN(6)) { DUP(30, p5_ycombine(C)); } SEAM(6);
    if (IN(7)) { pg8::DenseSched S; S.init(M, D, C.G, (int)blockIdx.x, WSP(bf16_t, WS_WBRA), 512); pg8::EpiBrA E{WSP(const bf16_t, WS_PROJ + 3 * PROJ_STRIDE), WSP(float, WS_T1)};
        DUP(31, pg8::gemm_phase<pg8::EpiBrA, pg8::DenseSched, true>(C.lds, WSP(bf16_t, WS_Y), 1024, 512, 512, S, E)); } SEAM(7);
    if (IN(8)) { pg8::DenseSched S; S.init(M, D, C.G, (int)blockIdx.x, WSP(bf16_t, WS_WBRB), 512); pg8::EpiBrB E{WSP(const bf16_t, WS_PROJ + 4 * PROJ_STRIDE), WSP(const float, WS_T1), WSP(bf16_t, WS_MERGED)};
        DUP(31, pg8::gemm_phase<pg8::EpiBrB, pg8::DenseSched, true>(C.lds, WSP(bf16_t, WS_Y) + 512, 1024, 512, 512, S, E)); } SEAM(8);
    if (IN(9)) { pg8::DenseSched S; S.init(M, D, C.G, (int)blockIdx.x, WSP(bf16_t, WS_WOUT), 1024); pg8::EpiOut E{C.in[0], WSP(const float, WS_ADAF), WSP(float, WS_X1)};
        DUP(32, pg8::gemm_phase<pg8::EpiOut, pg8::DenseSched, true>(C.lds, WSP(bf16_t, WS_MERGED), 1024, 1024, 1024, S, E)); } SEAM(9);
    if (IN(10)) { DUP(30, p8_router(C)); } SEAM(10);
    if (IN(11)) { DUP(33, p9_slots(C)); } SEAM(11);
    if (IN(12)) {
        LAS int* te = (LAS int*)(C.lds + RING_BYTES + 64);
        if (C.tid < 33) te[C.tid] = WSP(const int, WS_EOFF)[C.tid] >> 8;
        __syncthreads();
        { pg8::MoeSched<true> S{te, 8, C.G, (int)blockIdx.x, WSP(const int, WS_SLOTTOK), (const char*)WSP(bf16_t, WS_WGU), (size_t)2048 * 1024 * 2, (size_t)256 * 1024 * 2};
          pg8::EpiGU E{C.in[19], WSP(bf16_t, WS_ACT)};
          DUP(20, pg8::gemm_phase<pg8::EpiGU, pg8::MoeSched<true>, true>(C.lds, WSP(bf16_t, WS_H), 1024, 1024, 1024, S, E)); }
        xcd_barrier(bar);
        { pg8::MoeSched<false> S{te, 4, C.G, (int)blockIdx.x, nullptr, (const char*)WSP(bf16_t, WS_WD), (size_t)1024 * 1024 * 2, (size_t)256 * 1024 * 2};
          pg8::EpiDown E{C.in[21], WSP(const float, WS_SLOTW), WSP(bf16_t, WS_SOUT)};
          DUP(21, pg8::gemm_phase<pg8::EpiDown, pg8::MoeSched<false>, true>(C.lds, WSP(bf16_t, WS_ACT), 1024, 1024, 1024, S, E)); }
        xcd_barrier(bar);
        DUP(30, p12_final(C));
    }
#undef IN
#undef SEAM
}

extern "C" void kernel_launch(void* const* d_in, const int* in_sizes, int n_in, void* d_out, int out_size, void* d_ws, size_t ws_size, hipStream_t stream) {
    static int grid = 0;
    if (grid == 0) {
        if (n_in != 23 || in_sizes[0] != M * D || out_size != M * D || ws_size < WS_END) { fprintf(stderr, "kernel_launch: unexpected shapes (n_in %d, in0 %d, out %d, ws %zu); nothing launched\n", n_in, n_in > 0 ? in_sizes[0] : -1, out_size, ws_size); grid = -1; return; }
        int dev = 0, cus = 0, per_cu = 0;
        if (hipGetDevice(&dev) != hipSuccess || hipDeviceGetAttribute(&cus, hipDeviceAttributeMultiprocessorCount, dev) != hipSuccess) { grid = -1; return; }
        if (hipFuncSetAttribute((const void*)mega_fwd, hipFuncAttributeMaxDynamicSharedMemorySize, LDS_BYTES) != hipSuccess) { fprintf(stderr, "kernel_launch: hipFuncSetAttribute failed\n"); grid = -1; return; }
        if (hipOccupancyMaxActiveBlocksPerMultiprocessor(&per_cu, (const void*)mega_fwd, NWAVES * 64, LDS_BYTES) != hipSuccess || per_cu < 1) { fprintf(stderr, "kernel_launch: occupancy query reports %d workgroups per CU\n", per_cu); }
        (void)hipGetLastError();
        grid = cus;
    }
    if (grid < 0) return;
    if (hipMemsetAsync((char*)d_ws + WS_CTL, 0, CTL_ZERO_BYTES, stream) != hipSuccess) { fprintf(stderr, "kernel_launch: memset failed\n"); return; }
    Args a{};
    for (int i = 0; i < 23; ++i) a.in[i] = (const float*)d_in[i];
    a.out = (float*)d_out; a.ws = (unsigned char*)d_ws;
    constexpr int NL = MK_N_LAUNCHES;
    for (int li = 0; li < NL; ++li) {
        a.ph_lo = (NL == 1) ? 0 : li; a.ph_hi = (NL == 1) ? N_PHASES : li + 1; a.li = (NL == 1) ? 0 : li; a.pad = 0;
        hipLaunchKernelGGL(mega_fwd, dim3(grid), dim3(NWAVES * 64), LDS_BYTES, stream, a);
        const hipError_t le = hipPeekAtLastError();
        if (le != hipSuccess) { fprintf(stderr, "kernel_launch: launch %d failed: %s\n", li, hipGetErrorName(le)); break; }
    }
}
```

```cpp
#include <hip/hip_runtime.h>
#include <cstdio>
#include <cstdint>
#ifndef SIMPLE_DIFF
#define SIMPLE_DIFF 0
#endif

#define GAS __attribute__((address_space(1)))
#define LAS __attribute__((address_space(3)))
typedef unsigned short bf16_t;
typedef short bf16x8 __attribute__((ext_vector_type(8)));
typedef short s16x4 __attribute__((ext_vector_type(4)));
typedef float f32x4 __attribute__((ext_vector_type(4)));
typedef float f32x2 __attribute__((ext_vector_type(2)));
typedef unsigned u32x4 __attribute__((ext_vector_type(4)));
typedef unsigned u32x2 __attribute__((ext_vector_type(2)));
#define RLX_AGENT __ATOMIC_RELAXED, __HIP_MEMORY_SCOPE_AGENT
#define LDS_WAIT() asm volatile("s_waitcnt lgkmcnt(0)" ::: "memory")
#define VM_WAIT() asm volatile("s_waitcnt vmcnt(0)" ::: "memory")

constexpr int BATCH = 2, SEQ = 8192, M = BATCH * SEQ, D = 1024, INW = 5120;
constexpr int NE = 32, TOPK = 4;
constexpr int NWAVES = 8;
constexpr float RMS_EPS = 1e-5f;
constexpr float LOG2E = 1.4426950408889634f;
constexpr float C2 = 0.125f * LOG2E;
constexpr int SLOT_ROWS = M * TOPK + NE * 256;

constexpr size_t MiB = 1u << 20, KiB = 1u << 10;
constexpr size_t WS_CTL = 0, CTL_ZERO_BYTES = 1 * MiB;
constexpr size_t WS_ADAP = 1 * MiB;
constexpr size_t WS_ADAF = 1 * MiB + 512 * KiB;
constexpr size_t WS_KMEAN = 512 * KiB;
constexpr size_t WS_TOPI = 2 * MiB + 256 * KiB;
constexpr size_t WS_TOPW = 2 * MiB + 512 * KiB;
constexpr size_t WS_TOKSLOT = 2 * MiB + 768 * KiB;
constexpr size_t WS_SLOTTOK = 3 * MiB;
constexpr size_t WS_SLOTW = 3 * MiB + 512 * KiB;
constexpr size_t WS_HIST = 4 * MiB;
constexpr size_t WS_EOFF = 4 * MiB + 64 * KiB;
constexpr size_t WS_LIST = 6 * MiB;
constexpr size_t WS_PML = 14 * MiB;
constexpr size_t WS_WIN = 18 * MiB, WS_WBR = 28 * MiB, WS_WOUT = 30 * MiB, WS_WGU = 32 * MiB, WS_WD = 160 * MiB;
constexpr size_t WS_H = 224 * MiB;
constexpr size_t WS_PROJ = 256 * MiB;
constexpr size_t PROJ_STRIDE = 32 * MiB;
constexpr size_t WS_Y = 416 * MiB;
constexpr size_t WS_PO = 448 * MiB;
constexpr size_t WS_T1 = 512 * MiB;
constexpr size_t WS_MERGED = 576 * MiB;
constexpr size_t WS_X1 = 608 * MiB;
constexpr size_t WS_ACT = 672 * MiB;
constexpr size_t WS_SOUT = 816 * MiB;
constexpr size_t WS_OA = 960 * MiB;
constexpr size_t WS_END = 992 * MiB;
constexpr int LIST_PER_BH = 126976;
constexpr int CW_TMO = 0, CW_CODE = 1, CW_BAR = 4096, CW_MCNT = 65536;

constexpr int RING_BYTES = 131072, LDSCTL_OFF = RING_BYTES, MISC_OFF = LDSCTL_OFF + 320, LDS_BYTES = 163840;

__device__ __forceinline__ unsigned f2bf(float f) { unsigned u = __builtin_bit_cast(unsigned, f); return (u + 0x7fffu + ((u >> 16) & 1u)) >> 16; }
__device__ __forceinline__ unsigned pk2(float lo, float hi) { return f2bf(lo) | (f2bf(hi) << 16); }
__device__ __forceinline__ unsigned cvt_pk_bf16(float lo, float hi) { unsigned r; asm volatile("v_cvt_pk_bf16_f32 %0, %1, %2" : "=v"(r) : "v"(lo), "v"(hi)); return r; }
__device__ __forceinline__ float bf_lo(unsigned u) { return __builtin_bit_cast(float, u << 16); }
__device__ __forceinline__ float bf_hi(unsigned u) { return __builtin_bit_cast(float, u & 0xffff0000u); }
__device__ __forceinline__ float sigmoidf_fast(float v) { return __builtin_amdgcn_rcpf(1.0f + __builtin_amdgcn_exp2f(-v * LOG2E)); }
__device__ __forceinline__ float wave_sum(float v) {
#pragma unroll
    for (int o = 1; o < 64; o <<= 1) v += __shfl_xor(v, o);
    return v;
}

namespace pg8 {
constexpr int BM = 256, BK = 64, HALF = 128, HTB = HALF * BK * 2, STAGE_BYTES = 8 * HTB, NXCD = 8, WGM = 8;
__device__ __forceinline__ int lds_byte(int r, int c) { const int st = (r >> 4) * 2 + (c >> 5), rr = r & 15, cc = c & 31, ob = rr * 64 + cc * 2; return st * 1024 + (ob ^ (((ob >> 9) & 1) << 5)); }
__device__ __forceinline__ void stage_rc(int b, int& R, int& C) { const int st = b / 1024, sb = b % 1024, swz = sb ^ (((sb >> 9) & 1) << 5); R = (st >> 1) * 16 + swz / 64; C = (st & 1) * 32 + (swz % 64) / 2; }
__device__ __forceinline__ int perm32(int rho) { const int n = rho >> 4, i = rho & 15; return 8 * (i >> 2) + 4 * n + (i & 3); }

struct Unit { int row0; int pm, pn, e; const char* bptr; };

struct DenseSched {
    int nM, nN, nwg, G, c; const char* Bt; size_t btile;
    __device__ __forceinline__ void init(int M_, int N_, int G_, int c_, const void* Bt_, int ldb) { nM = M_ / BM; nN = N_ / BM; nwg = nM * nN; G = G_; c = c_; Bt = (const char*)Bt_; btile = (size_t)BM * ldb * 2; }
    __device__ __forceinline__ bool next(int i, Unit& u) const {
        const long L = (long)i * G + c; if (L >= nwg) return false;
        int wgid = (int)L; { const int q = nwg / NXCD, r = nwg % NXCD, xcd = wgid % NXCD, off = wgid / NXCD; wgid = (xcd < r ? xcd * (q + 1) : r * (q + 1) + (xcd - r) * q) + off; }
        const int nig = WGM * nN, gid = wgid / nig, fm = gid * WGM, gsz = (nM - fm) < WGM ? (nM - fm) : WGM;
        u.pm = fm + ((wgid % nig) % gsz); u.pn = (wgid % nig) / gsz; u.row0 = u.pm * BM; u.e = 0; u.bptr = Bt + (size_t)u.pn * btile; return true;
    }
    __device__ __forceinline__ int arow(const Unit& u, int r) const { return u.row0 + r; }
};

template <class Epi, class Sched, bool ALIGN_EPI>
__device__ __forceinline__ void gemm_phase(LAS unsigned char* lds, const void* Abase_, int lda, int ldb, int K, const Sched& S, const Epi& E) {
    int tid_ = threadIdx.x; asm volatile("" : "+v"(tid_));
    const int tid = tid_, wid = __builtin_amdgcn_readfirstlane(tid >> 6), lane = tid & 63, wr = wid >> 2, wc = wid & 3, fr = lane & 15, fq = lane >> 4;
    const int nt = K / BK;
    const char* Abase = (const char*)Abase_;
    int Rr[2], Cc[2]; unsigned voffB[2];
#pragma unroll
    for (int i = 0; i < 2; ++i) { stage_rc(tid * 16 + i * 8192, Rr[i], Cc[i]); const int Rb = Epi::PERM ? ((Rr[i] & ~31) + perm32(Rr[i] & 31)) : Rr[i]; voffB[i] = (unsigned)(Rb * ldb + Cc[i]) * 2u; }
    const size_t kstep = (size_t)(BK * 2);
    const size_t hstepB = (size_t)HALF * ldb * 2;
    const unsigned ldsw = (unsigned)wid * 1024u;
    const int aoff = lds_byte(wr * 64 + fr, fq * 8), boff = lds_byte(wc * 32 + fr, fq * 8);
#define PG8_SA(b, h) (((b) * 2 + (h)) * HTB)
#define PG8_SB(b, h) ((4 + (b) * 2 + (h)) * HTB)
#define PG8_STAGE(bufoff, gbase, voff) do { _Pragma("unroll") for (int _i = 0; _i < 2; ++_i) \
        __builtin_amdgcn_global_load_lds((const unsigned*)((const char*)(gbase) + (voff)[_i]), (LAS unsigned*)(lds + (bufoff) + ldsw + _i * 8192), 16, 0, 0); } while (0)
#define PG8_LDA(dst, b, h) do { _Pragma("unroll") for (int m = 0; m < 4; ++m) _Pragma("unroll") for (int k = 0; k < 2; ++k) dst[m][k] = *(const LAS bf16x8*)(lds + PG8_SA(b, h) + aoff + m * 2048 + k * 1024); } while (0)
#define PG8_LDB(dst, b, h) do { _Pragma("unroll") for (int n = 0; n < 2; ++n) _Pragma("unroll") for (int k = 0; k < 2; ++k) dst[n][k] = *(const LAS bf16x8*)(lds + PG8_SB(b, h) + boff + n * 2048 + k * 1024); } while (0)
#define PG8_MMA(ai, bj, At, Bt) do { __builtin_amdgcn_s_setprio(1); _Pragma("unroll") for (int m = 0; m < 4; ++m) _Pragma("unroll") for (int n = 0; n < 2; ++n) _Pragma("unroll") for (int k = 0; k < 2; ++k) \
        acc[ai][bj][m][n] = __builtin_amdgcn_mfma_f32_16x16x32_bf16(Bt[n][k], At[m][k], acc[ai][bj][m][n], 0, 0, 0); __builtin_amdgcn_s_setprio(0); } while (0)
#define PG8_WAIT_V(n) asm volatile("s_waitcnt vmcnt(" #n ")" ::: "memory")
#define PG8_WAIT_L(n) asm volatile("s_waitcnt lgkmcnt(" #n ")" ::: "memory")
#define PG8_BAR __builtin_amdgcn_s_barrier()
#define PG8_SCHED __builtin_amdgcn_sched_barrier(0)
#define PG8_ROWS(u, va) do { _Pragma("unroll") for (int _h = 0; _h < 2; ++_h) _Pragma("unroll") for (int _i = 0; _i < 2; ++_i) \
        va[_h][_i] = (unsigned)(S.arow(u, _h * HALF + Rr[_i]) * lda + Cc[_i]) * 2u; } while (0)
    Unit cur, nxt; int ui = 0;
    if (!S.next(0, cur)) return;
    unsigned vaC[2][2], vaN[2][2];
    PG8_ROWS(cur, vaC);
    f32x4 acc[2][2][4][2];
#pragma unroll
    for (int a = 0; a < 2; ++a)
#pragma unroll
        for (int b = 0; b < 2; ++b)
#pragma unroll
            for (int m = 0; m < 4; ++m)
#pragma unroll
                for (int n = 0; n < 2; ++n) acc[a][b][m][n] = (f32x4){0.f, 0.f, 0.f, 0.f};
    bf16x8 At[4][2], B0[2][2], B1[2][2];
    const char* cB = cur.bptr;
    PG8_STAGE(PG8_SB(0, 0), cB, voffB); PG8_STAGE(PG8_SB(0, 1), cB + hstepB, voffB); PG8_STAGE(PG8_SA(0, 0), Abase, vaC[0]); PG8_STAGE(PG8_SA(0, 1), Abase, vaC[1]);
    if (wr == 1) PG8_BAR;
    PG8_WAIT_V(2); PG8_BAR;
    PG8_STAGE(PG8_SB(1, 0), cB + kstep, voffB); PG8_STAGE(PG8_SA(1, 0), Abase + kstep, vaC[0]); PG8_STAGE(PG8_SB(1, 1), cB + hstepB + kstep, voffB);
    PG8_WAIT_V(6); PG8_BAR;
    for (;;) {
        const bool has_next = S.next(ui + 1, nxt);
        if (has_next) { PG8_ROWS(nxt, vaN); } else { nxt = cur;
#pragma unroll
            for (int h = 0; h < 2; ++h)
#pragma unroll
                for (int i = 0; i < 2; ++i) vaN[h][i] = vaC[h][i]; }
        const char* nB = nxt.bptr;
        for (int t = 0; t < nt; t += 2) {
            if constexpr (Epi::HAS_MID) { if (t == (nt >> 1)) E.mid(acc, cur, wr, wc, fr, fq); }
            const bool last = (t == nt - 2);
            const char* a1 = Abase + (size_t)(t + 1) * kstep;
            const char* a2 = last ? Abase : Abase + (size_t)(t + 2) * kstep; const char* b2 = last ? nB : cB + (size_t)(t + 2) * kstep;
            const char* a3 = a2 + kstep; const char* b3 = b2 + kstep;
            unsigned v2[2][2];
#pragma unroll
            for (int h = 0; h < 2; ++h)
#pragma unroll
                for (int i = 0; i < 2; ++i) v2[h][i] = last ? vaN[h][i] : vaC[h][i];
            PG8_LDB(B0, 0, 0); PG8_LDB(B1, 0, 1); PG8_SCHED; PG8_LDA(At, 0, 0); PG8_STAGE(PG8_SA(1, 1), a1, vaC[1]);
            PG8_WAIT_V(8); PG8_WAIT_L(0); PG8_BAR; PG8_MMA(0, 0, At, B0); PG8_MMA(0, 1, At, B1); PG8_BAR; PG8_SCHED;
            PG8_LDA(At, 0, 1); PG8_STAGE(PG8_SB(0, 0), b2, voffB); PG8_STAGE(PG8_SB(0, 1), b2 + hstepB, voffB); PG8_STAGE(PG8_SA(0, 0), a2, v2[0]);
            PG8_WAIT_V(8); PG8_WAIT_L(0); PG8_BAR; PG8_MMA(1, 0, At, B0); PG8_MMA(1, 1, At, B1); PG8_BAR; PG8_SCHED;
            PG8_LDB(B0, 1, 0); PG8_LDB(B1, 1, 1); PG8_SCHED; PG8_LDA(At, 1, 0); PG8_STAGE(PG8_SA(0, 1), a2, v2[1]);
            PG8_WAIT_V(8); PG8_WAIT_L(0); PG8_BAR; PG8_MMA(0, 0, At, B0); PG8_MMA(0, 1, At, B1); PG8_BAR; PG8_SCHED;
            PG8_LDA(At, 1, 1); PG8_STAGE(PG8_SB(1, 0), b3, voffB); PG8_STAGE(PG8_SB(1, 1), b3 + hstepB, voffB); PG8_STAGE(PG8_SA(1, 0), a3, v2[0]);
            PG8_WAIT_V(8); PG8_WAIT_L(0); PG8_BAR; PG8_MMA(1, 0, At, B0); PG8_MMA(1, 1, At, B1); PG8_BAR; PG8_SCHED;
        }
        if constexpr (ALIGN_EPI) { if (wr == 0) PG8_BAR; }
        E(acc, cur, wr, wc, fr, fq);
        if (!has_next) break;
#pragma unroll
        for (int a = 0; a < 2; ++a)
#pragma unroll
            for (int b = 0; b < 2; ++b)
#pragma unroll
                for (int m = 0; m < 4; ++m)
#pragma unroll
                    for (int n = 0; n < 2; ++n) acc[a][b][m][n] = (f32x4){0.f, 0.f, 0.f, 0.f};
        cur = nxt; cB = nB; ++ui;
#pragma unroll
        for (int h = 0; h < 2; ++h)
#pragma unroll
            for (int i = 0; i < 2; ++i) vaC[h][i] = vaN[h][i];
        if constexpr (ALIGN_EPI) { if (wr == 1) PG8_BAR; }
    }
    PG8_WAIT_V(0);
    if constexpr (!ALIGN_EPI) { if (wr == 0) PG8_BAR; }
    PG8_BAR;
#undef PG8_SA
#undef PG8_SB
#undef PG8_STAGE
#undef PG8_LDA
#undef PG8_LDB
#undef PG8_MMA
#undef PG8_WAIT_V
#undef PG8_WAIT_L
#undef PG8_BAR
#undef PG8_SCHED
#undef PG8_ROWS
}
}
#define XB_TMO      128
#define XB_XCNT(j)  (256  + 64 * (j))
#define XB_XSUB(j)  (1280 + 64 * (j))
#define XB_XGEN(j)  (2304 + 64 * (j))
#define XB_TOP      3328
#define XB_TOPGEN   3392
#define XCD_BAR_WORDS 3456
#define XB_SPIN_CAP (1u << 18)

__device__ __forceinline__ unsigned xb_ld(unsigned* p)              { return __hip_atomic_load(p, __ATOMIC_RELAXED, __HIP_MEMORY_SCOPE_AGENT); }
__device__ __forceinline__ unsigned xb_add(unsigned* p, unsigned v) { return __hip_atomic_fetch_add(p, v, __ATOMIC_RELAXED, __HIP_MEMORY_SCOPE_AGENT); }
__device__ __forceinline__ unsigned xb_xcc_id() { return (unsigned)__builtin_amdgcn_s_getreg((3 << 11) | 20) & 0xFu; }
#define XB_SPIN(cond, bar) do { unsigned _sp = 0; while (cond) { __builtin_amdgcn_s_sleep(1); \
    if ((++_sp & 255u) == 0u) { if (xb_ld(&(bar)[XB_TMO])) break; if (_sp > XB_SPIN_CAP) { atomicAdd(&(bar)[XB_TMO], 1u); break; } } } } while (0)

struct XcdBarrier {
    unsigned* bar; unsigned x;
    volatile LAS unsigned* st;
};

__device__ __forceinline__ XcdBarrier xcd_barrier_post(unsigned* bar, volatile LAS unsigned* st) {
    XcdBarrier b; b.bar = bar; b.x = xb_xcc_id(); b.st = st;
    if (threadIdx.x == 0) (void)xb_add(&bar[XB_XCNT(b.x)], 1u);
    return b;
}
__device__ __forceinline__ void xcd_barrier_complete(unsigned* bar, unsigned x, unsigned& nloc, unsigned& nx) {
    const unsigned G = gridDim.x * gridDim.y * gridDim.z;
    unsigned sum, cnt, mine, sp = 0u;
    for (;;) {
        sum = 0u; cnt = 0u; mine = 0u;
#pragma unroll
        for (unsigned j = 0; j < 16; ++j) { const unsigned c = xb_ld(&bar[XB_XCNT(j)]); sum += c; cnt += (c > 0u) ? 1u : 0u; mine = (j == x) ? c : mine; }
        if (sum == G) break;
        __builtin_amdgcn_s_sleep(1);
        if ((++sp & 255u) == 0u) { if (xb_ld(&bar[XB_TMO])) break; if (sp > XB_SPIN_CAP) { atomicAdd(&bar[XB_TMO], 1u); break; } }
    }
    nloc = mine > 0u ? mine : 1u; nx = cnt > 0u ? cnt : 1u;
}

__device__ __forceinline__ void xcd_barrier(const XcdBarrier& b) {
    asm volatile("s_waitcnt vmcnt(0)" ::: "memory");
    __syncthreads();
    if (threadIdx.x == 0) {
        unsigned* bar = b.bar;
        __builtin_amdgcn_s_waitcnt(0);
        unsigned nloc = b.st[0], nx = b.st[1];
        if (nloc == 0u) { xcd_barrier_complete(bar, b.x, nloc, nx); b.st[0] = nloc; b.st[1] = nx; }
        const unsigned old = xb_add(&bar[XB_XSUB(b.x)], 1u);
        const unsigned gen = old / nloc;
        if (old + 1u == (gen + 1u) * nloc) {
            __builtin_amdgcn_fence(__ATOMIC_RELEASE, "agent");
            asm volatile("s_waitcnt vmcnt(0)" ::: "memory");
            const unsigned og = xb_add(&bar[XB_TOP], 1u);
            const unsigned tg = og / nx;
            if (og + 1u == (tg + 1u) * nx) xb_add(&bar[XB_TOPGEN], 1u);
            else XB_SPIN(xb_ld(&bar[XB_TOPGEN]) == tg, bar);
            __builtin_amdgcn_fence(__ATOMIC_ACQUIRE, "agent");
            xb_add(&bar[XB_XGEN(b.x)], 1u);
            asm volatile("s_waitcnt vmcnt(0)" ::: "memory");
        } else {
            XB_SPIN(xb_ld(&bar[XB_XGEN(b.x)]) == gen, bar);
            __builtin_amdgcn_fence(__ATOMIC_ACQUIRE, "agent");
            asm volatile("s_waitcnt vmcnt(0)" ::: "memory");
        }
    }
    __syncthreads();
}
namespace pg8 {
struct EpiProj {
    static constexpr bool PERM = true, HAS_MID = false;
    bf16_t* base; float* kmean;
    __device__ __forceinline__ void operator()(const f32x4 (&acc)[2][2][4][2], const Unit& u, int wr, int wc, int fr, int fq) const {
        if (u.pn == 8 || u.pn == 9) {
            const int b = u.pm >> 5, nblk = u.pm & 31;
#pragma unroll
            for (int bj = 0; bj < 2; ++bj)
#pragma unroll
                for (int n = 0; n < 2; ++n) { f32x4 s = (f32x4){0.f, 0.f, 0.f, 0.f};
#pragma unroll
                    for (int ai = 0; ai < 2; ++ai)
#pragma unroll
                        for (int m = 0; m < 4; ++m) s += acc[ai][bj][m][n];
#pragma unroll
                    for (int j = 0; j < 4; ++j) { float v = s[j]; v += __shfl_xor(v, 1); v += __shfl_xor(v, 2); v += __shfl_xor(v, 4); v += __shfl_xor(v, 8); s[j] = v; }
                    if (fr == 0) { const int col = (u.pn - 8) * 256 + bj * HALF + wc * 32 + 8 * fq + 4 * n; const int h = col >> 6, d = col & 63; float* kp = kmean + ((size_t)((b * 8 + h) * 32 + nblk)) * 64 + d;
#pragma unroll
                        for (int j = 0; j < 4; ++j) atomicAdd(kp + j, s[j] * (1.0f / 256.0f)); } }
        }
        const int buf = u.pn >> 2, colt = (u.pn & 3) * 256;
        const float sc = (u.pn < 2 || u.pn == 6 || u.pn == 7) ? C2 : 1.0f;
        bf16_t* dst = base + (size_t)buf * (PROJ_STRIDE / 2);
        const int row0 = u.row0 + wr * 64 + fr, col0 = colt + wc * 32 + 8 * fq;
#pragma unroll
        for (int ai = 0; ai < 2; ++ai)
#pragma unroll
            for (int m = 0; m < 4; ++m) { bf16_t* rowp = dst + (size_t)(row0 + ai * HALF + m * 16) * 1024 + col0;
#pragma unroll
                for (int bj = 0; bj < 2; ++bj) { const f32x4 v0 = acc[ai][bj][m][0] * sc, v1 = acc[ai][bj][m][1] * sc;
                    u32x4 w; w.x = cvt_pk_bf16(v0[0], v0[1]); w.y = cvt_pk_bf16(v0[2], v0[3]); w.z = cvt_pk_bf16(v1[0], v1[1]); w.w = cvt_pk_bf16(v1[2], v1[3]);
                    *(u32x4*)(rowp + bj * HALF) = w; } }
    }
};
struct EpiBr {
    static constexpr bool PERM = true, HAS_MID = true;
    const bf16_t* gla; const bf16_t* glb; bf16_t* out;
    __device__ __forceinline__ void mid(f32x4 (&acc)[2][2][4][2], const Unit& u, int wr, int wc, int fr, int fq) const {
        int row0 = u.row0 + wr * 64 + fr, col0 = u.pn * 256 + wc * 32 + 8 * fq; asm volatile("" : "+v"(row0), "+v"(col0));
#pragma unroll
        for (int ai = 0; ai < 2; ++ai)
#pragma unroll
            for (int m = 0; m < 4; ++m) { const size_t ro = (size_t)(row0 + ai * HALF + m * 16) * 1024 + col0;
#pragma unroll
                for (int bj = 0; bj < 2; ++bj) { const u32x4 ga = *(const u32x4*)(gla + ro + bj * HALF), gb = *(const u32x4*)(glb + ro + bj * HALF);
#define RT(A, B) ((1.0f + __builtin_amdgcn_exp2f(-(B) * LOG2E)) * __builtin_amdgcn_rcpf(1.0f + __builtin_amdgcn_exp2f(-(A) * LOG2E)))
                    f32x4 r0, r1;
                    r0[0] = RT(bf_lo(ga.x), bf_lo(gb.x)); r0[1] = RT(bf_hi(ga.x), bf_hi(gb.x)); r0[2] = RT(bf_lo(ga.y), bf_lo(gb.y)); r0[3] = RT(bf_hi(ga.y), bf_hi(gb.y));
                    r1[0] = RT(bf_lo(ga.z), bf_lo(gb.z)); r1[1] = RT(bf_hi(ga.z), bf_hi(gb.z)); r1[2] = RT(bf_lo(ga.w), bf_lo(gb.w)); r1[3] = RT(bf_hi(ga.w), bf_hi(gb.w));
#undef RT
                    acc[ai][bj][m][0] *= r0; acc[ai][bj][m][1] *= r1; } }
    }
    __device__ __forceinline__ void operator()(const f32x4 (&acc)[2][2][4][2], const Unit& u, int wr, int wc, int fr, int fq) const {
        int row0 = u.row0 + wr * 64 + fr, col0 = u.pn * 256 + wc * 32 + 8 * fq; asm volatile("" : "+v"(row0), "+v"(col0));
#pragma unroll
        for (int ai = 0; ai < 2; ++ai)
#pragma unroll
            for (int m = 0; m < 4; ++m) { const size_t ro = (size_t)(row0 + ai * HALF + m * 16) * 1024 + col0;
#pragma unroll
                for (int bj = 0; bj < 2; ++bj) { const u32x4 g = *(const u32x4*)(glb + ro + bj * HALF); const f32x4 v0 = acc[ai][bj][m][0], v1 = acc[ai][bj][m][1];
                    u32x4 w; w.x = cvt_pk_bf16(sigmoidf_fast(bf_lo(g.x)) * v0[0], sigmoidf_fast(bf_hi(g.x)) * v0[1]); w.y = cvt_pk_bf16(sigmoidf_fast(bf_lo(g.y)) * v0[2], sigmoidf_fast(bf_hi(g.y)) * v0[3]);
                    w.z = cvt_pk_bf16(sigmoidf_fast(bf_lo(g.z)) * v1[0], sigmoidf_fast(bf_hi(g.z)) * v1[1]); w.w = cvt_pk_bf16(sigmoidf_fast(bf_lo(g.w)) * v1[2], sigmoidf_fast(bf_hi(g.w)) * v1[3]);
                    *(u32x4*)(out + ro + bj * HALF) = w; } }
    }
};
struct EpiOut {
    static constexpr bool PERM = false, HAS_MID = false;
    const float* x; const float* adaf; float* x1;
    __device__ __forceinline__ void operator()(const f32x4 (&acc)[2][2][4][2], const Unit& u, int wr, int wc, int fr, int fq) const {
        const int row0 = u.row0 + wr * 64 + fr, col0 = u.pn * 256 + wc * 32 + 4 * fq;
        const float* gt = adaf + (u.row0 >= SEQ ? 6144 : 0) + 2048;
        f32x4 gv[2][2];
#pragma unroll
        for (int bj = 0; bj < 2; ++bj)
#pragma unroll
            for (int n = 0; n < 2; ++n) gv[bj][n] = *(const f32x4*)(gt + col0 + bj * HALF + n * 16);
#pragma unroll
        for (int ai = 0; ai < 2; ++ai)
#pragma unroll
            for (int m = 0; m < 4; ++m) { const size_t ro = (size_t)(row0 + ai * HALF + m * 16) * 1024 + col0;
#pragma unroll
                for (int bj = 0; bj < 2; ++bj)
#pragma unroll
                    for (int n = 0; n < 2; ++n) { const f32x4 xv = *(const f32x4*)(x + ro + bj * HALF + n * 16); *(f32x4*)(x1 + ro + bj * HALF + n * 16) = xv + gv[bj][n] * acc[ai][bj][m][n]; } }
    }
};
struct EpiGU {
    static constexpr bool PERM = true, HAS_MID = false;
    const float* bgu; bf16_t* act;
    __device__ __forceinline__ void operator()(const f32x4 (&acc)[2][2][4][2], const Unit& u, int wr, int wc, int fr, int fq) const {
        const int row0 = u.row0 + wr * 64 + fr, col0 = u.pn * 128 + wc * 32 + 8 * fq;
        const float* bg = bgu + (size_t)u.e * 2048 + col0;
        f32x4 bgv[2], buv[2];
#pragma unroll
        for (int n = 0; n < 2; ++n) { bgv[n] = *(const f32x4*)(bg + 4 * n); buv[n] = *(const f32x4*)(bg + 1024 + 4 * n); }
#pragma unroll
        for (int ai = 0; ai < 2; ++ai)
#pragma unroll
            for (int m = 0; m < 4; ++m) { float r[8];
#pragma unroll
                for (int n = 0; n < 2; ++n)
#pragma unroll
                    for (int j = 0; j < 4; ++j) { const float gte = fminf(acc[ai][0][m][n][j] + bgv[n][j], 7.0f); const float up = fminf(fmaxf(acc[ai][1][m][n][j] + buv[n][j], -7.0f), 7.0f);
                        r[4 * n + j] = (up + 1.0f) * gte * sigmoidf_fast(1.702f * gte); }
                u32x4 w; w.x = cvt_pk_bf16(r[0], r[1]); w.y = cvt_pk_bf16(r[2], r[3]); w.z = cvt_pk_bf16(r[4], r[5]); w.w = cvt_pk_bf16(r[6], r[7]);
                *(u32x4*)(act + (size_t)(row0 + ai * HALF + m * 16) * 1024 + col0) = w; }
    }
};
struct EpiDown {
    static constexpr bool PERM = true, HAS_MID = false;
    const float* bd; const float* slotw; bf16_t* out;
    __device__ __forceinline__ void operator()(const f32x4 (&acc)[2][2][4][2], const Unit& u, int wr, int wc, int fr, int fq) const {
        const int row0 = u.row0 + wr * 64 + fr, col0 = u.pn * 256 + wc * 32 + 8 * fq;
        const float* bp = bd + (size_t)u.e * 1024 + col0;
        f32x4 bv[2][2];
#pragma unroll
        for (int bj = 0; bj < 2; ++bj)
#pragma unroll
            for (int n = 0; n < 2; ++n) bv[bj][n] = *(const f32x4*)(bp + bj * HALF + 4 * n);
#pragma unroll
        for (int ai = 0; ai < 2; ++ai)
#pragma unroll
            for (int m = 0; m < 4; ++m) { const int row = row0 + ai * HALF + m * 16; const float w8 = slotw[row]; bf16_t* rowp = out + (size_t)row * 1024 + col0;
#pragma unroll
                for (int bj = 0; bj < 2; ++bj) { const f32x4 v0 = (acc[ai][bj][m][0] + bv[bj][0]) * w8, v1 = (acc[ai][bj][m][1] + bv[bj][1]) * w8;
                    u32x4 w; w.x = cvt_pk_bf16(v0[0], v0[1]); w.y = cvt_pk_bf16(v0[2], v0[3]); w.z = cvt_pk_bf16(v1[0], v1[1]); w.w = cvt_pk_bf16(v1[2], v1[3]);
                    *(u32x4*)(rowp + bj * HALF) = w; } }
    }
};
template <bool GATHER> struct MoeSched {
    const LAS int* te; int NP, G, c; const int* slot_tok; const char* W; size_t wstride, btile;
    __device__ __forceinline__ bool next(int i, Unit& u) const {
        const int ntl = te[32], nwg = ntl * NP; const long L = (long)i * G + c; if (L >= nwg) return false;
        int wgid = (int)L; { const int q = nwg / NXCD, r = nwg % NXCD, xcd = wgid % NXCD, off = wgid / NXCD; wgid = (xcd < r ? xcd * (q + 1) : r * (q + 1) + (xcd - r) * q) + off; }
        int e = 0;
        for (int k = 1; k < NE; ++k) e += (wgid >= te[k] * NP) ? 1 : 0;
        const int t0 = te[e], nte = te[e + 1] - t0, r = wgid - t0 * NP; const int pn = r / nte, t = t0 + r % nte;
        u.row0 = t * 256; u.pn = pn; u.pm = t; u.e = e; u.bptr = W + (size_t)e * wstride + (size_t)pn * btile; return true;
    }
    __device__ __forceinline__ int arow(const Unit& u, int r) const { if constexpr (GATHER) return slot_tok[u.row0 + r]; else return u.row0 + r; }
};
}

constexpr int BT_STR = 132;
constexpr int AT_BT = LDSCTL_OFF + 1024, AT_K = 0, AT_V = AT_K + 64 * 72 * 2, AT_MISC = LDSCTL_OFF + 8192;
typedef short v4i16_t __attribute__((ext_vector_type(4)));
__device__ __forceinline__ s16x4 tr16(const LAS unsigned char* p) { return __builtin_bit_cast(s16x4, __builtin_amdgcn_ds_read_tr16_b64_v4i16((LAS v4i16_t*)p)); }

template <int NDT>
__device__ __forceinline__ void attn_tile(const LAS unsigned char* lds, int lane, const bf16x8 (&qf)[2], f32x4 (&o)[NDT], float& m_run, float& l_run,
                                          int qpos, int kbase, bool causal, const LAS float* bt) {
    constexpr int VSTR = NDT * 16 + 8;
    const int c = lane & 15, g = lane >> 4;
    f32x4 s[4];
#pragma unroll
    for (int kt = 0; kt < 4; ++kt) { s[kt] = (f32x4){0.f, 0.f, 0.f, 0.f};
#pragma unroll
        for (int ks = 0; ks < 2; ++ks) { const bf16x8 a = *(const LAS bf16x8*)(lds + AT_K + ((16 * kt + c) * 72 + 32 * ks + 8 * g) * 2);
            s[kt] = __builtin_amdgcn_mfma_f32_16x16x32_bf16(a, qf[ks], s[kt], 0, 0, 0); } }
    if (__any((qpos - (kbase + 63)) < 128)) {
#pragma unroll
        for (int kt = 0; kt < 4; ++kt)
#pragma unroll
            for (int i = 0; i < 4; ++i) { const int dist = qpos - (kbase + 16 * kt + 4 * g + i); const int di = dist < 0 ? 0 : (dist > 127 ? 127 : dist);
                const float bv = bt[di]; float v = s[kt][i];
                if (dist >= 0 && dist < 128) v += bv;
                if (causal && dist < 0) v = -INFINITY;
                s[kt][i] = v; }
    }
    float mx = fmaxf(fmaxf(s[0][0], s[0][1]), fmaxf(s[0][2], s[0][3]));
#pragma unroll
    for (int kt = 1; kt < 4; ++kt) mx = fmaxf(mx, fmaxf(fmaxf(s[kt][0], s[kt][1]), fmaxf(s[kt][2], s[kt][3])));
    mx = fmaxf(mx, __shfl_xor(mx, 16)); mx = fmaxf(mx, __shfl_xor(mx, 32));
    const float m_new = fmaxf(m_run, mx), alpha = __builtin_amdgcn_exp2f(m_run - m_new);
    float psum = 0.f;
#pragma unroll
    for (int kt = 0; kt < 4; ++kt)
#pragma unroll
        for (int i = 0; i < 4; ++i) { const float p = __builtin_amdgcn_exp2f(s[kt][i] - m_new); s[kt][i] = p; psum += p; }
    l_run = l_run * alpha + psum; m_run = m_new;
#pragma unroll
    for (int i = 0; i < 4; ++i) { const float ai = __shfl(alpha, 4 * g + i);
#pragma unroll
        for (int dt = 0; dt < NDT; ++dt) o[dt][i] *= ai; }
    bf16x8 pa[2];
#pragma unroll
    for (int kk = 0; kk < 2; ++kk) { u32x4 w; w.x = cvt_pk_bf16(s[2 * kk][0], s[2 * kk][1]); w.y = cvt_pk_bf16(s[2 * kk][2], s[2 * kk][3]);
        w.z = cvt_pk_bf16(s[2 * kk + 1][0], s[2 * kk + 1][1]); w.w = cvt_pk_bf16(s[2 * kk + 1][2], s[2 * kk + 1][3]); pa[kk] = __builtin_bit_cast(bf16x8, w); }
    const LAS unsigned char* vb = lds + AT_V + ((4 * g + (c >> 2)) * VSTR + 4 * (c & 3)) * 2;
#pragma unroll
    for (int dt = 0; dt < NDT; ++dt)
#pragma unroll
        for (int kk = 0; kk < 2; ++kk) { const s16x4 lo = tr16(vb + (32 * kk * VSTR + 16 * dt) * 2), hi = tr16(vb + ((32 * kk + 16) * VSTR + 16 * dt) * 2);
            const bf16x8 b = (bf16x8){lo[0], lo[1], lo[2], lo[3], hi[0], hi[1], hi[2], hi[3]};
            o[dt] = __builtin_amdgcn_mfma_f32_16x16x32_bf16(pa[kk], b, o[dt], 0, 0, 0); }
}

template <int NV> struct TileRegs { u32x4 k; u32x4 v[NV]; };
template <int NV> __device__ __forceinline__ void tile_fetch(TileRegs<NV>& r, const bf16_t* kg, const bf16_t* vg, int tid) {
    const int row = tid >> 3, ch = tid & 7;
    r.k = *(const u32x4*)(kg + (size_t)row * 1024 + ch * 8);
#pragma unroll
    for (int i = 0; i < NV; ++i) r.v[i] = *(const u32x4*)(vg + (size_t)row * 1024 + (ch + 8 * i) * 8);
}
template <int NV> __device__ __forceinline__ void tile_store(const TileRegs<NV>& r, LAS unsigned char* lds, int tid) {
    constexpr int VSTR = NV * 64 + 8;
    const int row = tid >> 3, ch = tid & 7;
    *(LAS u32x4*)(lds + AT_K + (row * 72 + ch * 8) * 2) = r.k;
#pragma unroll
    for (int i = 0; i < NV; ++i) *(LAS u32x4*)(lds + AT_V + (row * VSTR + (ch + 8 * i) * 8) * 2) = r.v[i];
}
#include <hip/hip_bf16.h>
#include <cmath>
namespace attn_body {
using bf16=__hip_bfloat16;
using bf16x8=__attribute__((ext_vector_type(8)))short;
using s16x4=__attribute__((ext_vector_type(4)))short;
using f32x16=__attribute__((ext_vector_type(16)))float;
using u32x4=__attribute__((ext_vector_type(4)))unsigned;
constexpr int BATCH=2,NHEAD=16,SEQ=8192,D=64,DM=NHEAD*D;
constexpr int NW=8,QBLK=32,QB=QBLK*NW,KVBLK=64,NQB=SEQ/QB;
constexpr int ATTN_PITCH=DM, ATTN_UNIT_ROWS=QB;
__device__ __forceinline__ int crow(int r,int hi){return (r&3)+8*(r>>2)+4*hi;}
#define SBAR() __builtin_amdgcn_sched_barrier(0)
typedef const __attribute__((address_space(3))) float* lds_cfptr;
__device__ __forceinline__ void cbias(f32x16&p0,f32x16&p1,int jb,int qrel,int hi,lds_cfptr bt){
  const float NEG=-INFINITY; const int kb=64*jb+4*hi;
  #pragma unroll
  for(int r=0;r<16;++r){const int d0=qrel-(kb+(r&3)+8*(r>>2)),d1=d0-32;
    const unsigned c0=(unsigned)d0<128u?(unsigned)d0:128u,c1=(unsigned)d1<128u?(unsigned)d1:128u;
    const float v0=p0[r]+bt[c0],v1=p1[r]+bt[c1];
    p0[r]=d0<0?NEG:v0; p1[r]=d1<0?NEG:v1;}
}
constexpr int NSLOT=3, SLOTB=8192;
constexpr int LDS_K=0, LDS_V=NSLOT*SLOTB, LDS_WS=2*NSLOT*SLOTB, LDS_OST=LDS_WS+NW*64*4, LDS_BYTES=LDS_OST+NW*4096;
constexpr float C2=0.125f*1.4426950408889634f;
__device__ __forceinline__ void glds16(const void*gsrc,unsigned lds_dst){unsigned keep;
  asm volatile("s_mov_b32 %0, m0\n\ts_mov_b32 m0, %2\n\ts_nop 0\n\tglobal_load_lds_dwordx4 %1, off\n\ts_mov_b32 m0, %0":"=&s"(keep):"v"(gsrc),"s"(lds_dst):"memory");}
__device__ __forceinline__ float max3f(float a,float b,float c){float r;asm("v_max3_f32 %0, %1, %2, %3":"=v"(r):"v"(a),"v"(b),"v"(c));return r;}
__device__ __forceinline__ float max2f(float a,float b){float r;asm("v_max_f32_e32 %0, %1, %2":"=v"(r):"v"(a),"v"(b));return r;}
__device__ __forceinline__ float fadd_s(float a,float b){float r;asm("v_add_f32_e32 %0, %1, %2":"=v"(r):"v"(a),"v"(b));return r;}
__device__ __forceinline__ float fsub_s(float a,float b){float r;asm("v_sub_f32_e32 %0, %1, %2":"=v"(r):"v"(a),"v"(b));return r;}
typedef float f32x2_t __attribute__((ext_vector_type(2))); typedef __bf16 bf16x2_t __attribute__((ext_vector_type(2)));
__device__ __forceinline__ unsigned cvtpk_s(float lo,float hi){f32x2_t v={lo,hi};bf16x2_t b=__builtin_convertvector(v,bf16x2_t);return __builtin_bit_cast(unsigned,b);}
#define WAIT_BAR(N) asm volatile("s_waitcnt vmcnt(" #N ") lgkmcnt(0)\n\ts_barrier":::"memory")

__device__ __forceinline__ void qkt(f32x16&p0,f32x16&p1,const char*Kslot,const bf16x8*qr,const f32x16&negm,int r32,int hi){
  const char*kb=Kslot+hi*1024+r32*16;
  #pragma unroll
  for(int d0=0;d0<4;++d0){
    const bf16x8 b0=*reinterpret_cast<const bf16x8*>(kb+d0*2048);
    const bf16x8 b1=*reinterpret_cast<const bf16x8*>(kb+d0*2048+512);
    if(d0==0){p0=__builtin_amdgcn_mfma_f32_32x32x16_bf16(b0,qr[0],negm,0,0,0);p1=__builtin_amdgcn_mfma_f32_32x32x16_bf16(b1,qr[0],negm,0,0,0);}
    else{p0=__builtin_amdgcn_mfma_f32_32x32x16_bf16(b0,qr[d0],p0,0,0,0);p1=__builtin_amdgcn_mfma_f32_32x32x16_bf16(b1,qr[d0],p1,0,0,0);}}
}
typedef __attribute__((address_space(3))) const char* lds_cptr;
typedef short v4i16_t __attribute__((ext_vector_type(4)));
__device__ __forceinline__ void kload8(bf16x8*kf,lds_cptr kp){
  kf[0]=*(const __attribute__((address_space(3))) bf16x8*)(kp);      kf[1]=*(const __attribute__((address_space(3))) bf16x8*)(kp+512);
  kf[2]=*(const __attribute__((address_space(3))) bf16x8*)(kp+2048); kf[3]=*(const __attribute__((address_space(3))) bf16x8*)(kp+2560);
  kf[4]=*(const __attribute__((address_space(3))) bf16x8*)(kp+4096); kf[5]=*(const __attribute__((address_space(3))) bf16x8*)(kp+4608);
  kf[6]=*(const __attribute__((address_space(3))) bf16x8*)(kp+6144); kf[7]=*(const __attribute__((address_space(3))) bf16x8*)(kp+6656);
}
__device__ __forceinline__ void kload2(bf16x8*kf,lds_cptr kp,int j){ kf[2*j]=*(const __attribute__((address_space(3))) bf16x8*)(kp+j*2048); kf[2*j+1]=*(const __attribute__((address_space(3))) bf16x8*)(kp+j*2048+512); }
__device__ __forceinline__ s16x4 vtr(lds_cptr p){ return __builtin_bit_cast(s16x4,__builtin_amdgcn_ds_read_tr16_b64_v4i16((__attribute__((address_space(3))) v4i16_t*)p)); }
__device__ __forceinline__ float rowmax(const f32x16&p0,const f32x16&p1){
  float a=max3f(p0[0],p0[1],p1[0]),b=max3f(p0[2],p0[3],p1[1]);a=max3f(a,p1[2],p1[3]);
  #pragma unroll
  for(int r=4;r<16;r+=4){a=max3f(a,p0[r],p0[r+1]);b=max3f(b,p0[r+2],p0[r+3]);a=max3f(a,p1[r],p1[r+1]);b=max3f(b,p1[r+2],p1[r+3]);}
  const float m=max2f(a,b);
  auto rr=__builtin_amdgcn_permlane32_swap(__float_as_uint(m),__float_as_uint(m),false,false);
  return max2f(__uint_as_float(rr[0]),__uint_as_float(rr[1]));
}
__device__ __forceinline__ void pv(f32x16*o,int vb,bf16x8 pa0,bf16x8 pa1,bf16x8 pa2,bf16x8 pa3){
  #pragma unroll
  for(int d0=0;d0<2;++d0){s16x4 lo[4],hi[4];
    #pragma unroll
    for(int ks=0;ks<4;++ks){
      asm volatile("ds_read_b64_tr_b16 %0,%1 offset:%c2":"=&v"(lo[ks]):"v"(vb),"i"(d0*4096+ks*1024):"memory");
      asm volatile("ds_read_b64_tr_b16 %0,%1 offset:%c2":"=&v"(hi[ks]):"v"(vb),"i"(d0*4096+ks*1024+512):"memory");}
    asm volatile("s_waitcnt lgkmcnt(0)":::"memory");SBAR();
    #define PK(k) (bf16x8){lo[k][0],lo[k][1],lo[k][2],lo[k][3],hi[k][0],hi[k][1],hi[k][2],hi[k][3]}
    o[d0]=__builtin_amdgcn_mfma_f32_32x32x16_bf16(pa0,PK(0),o[d0],0,0,0);
    o[d0]=__builtin_amdgcn_mfma_f32_32x32x16_bf16(pa1,PK(1),o[d0],0,0,0);
    o[d0]=__builtin_amdgcn_mfma_f32_32x32x16_bf16(pa2,PK(2),o[d0],0,0,0);
    o[d0]=__builtin_amdgcn_mfma_f32_32x32x16_bf16(pa3,PK(3),o[d0],0,0,0);
    #undef PK
  }
}

#ifndef ATTN_STORE16
#define ATTN_STORE16(p,v) (*(u32x4*)(p)=(v))
#endif
template<int THRL> __device__ __forceinline__ void attn_unit(int b,int qb,const bf16*Q,const bf16*__restrict__ K,const bf16*__restrict__ V,bf16*O,int qc,int kc,int vc,int oc,lds_cfptr bt,char*shm){
  int tid_=threadIdx.x; asm volatile("":"+v"(tid_)); const int tid=tid_,lane=tid&63,r32=lane&31,hi=lane>>5; const int wid=__builtin_amdgcn_readfirstlane(tid>>6);
  const long rowbase=(long)b*SEQ; const int q0=qb*QB;
  const bf16*Qw=Q+(rowbase+q0+wid*QBLK)*DM+qc;
  const bf16*Kh=K+rowbase*DM+kc,*Vh=V+rowbase*DM+vc;
  const unsigned lds0=(unsigned)(uintptr_t)shm;
  float*wsf=(float*)(shm+LDS_WS)+wid*64;
  const bf16*ksrc=Kh+(long)lane*DM+wid*8;
  const bf16*vsrc=Vh+(long)(16*(wid&3)+(lane>>2))*DM+(wid>>2)*32+(lane&3)*8;
  const unsigned kdst=lds0+LDS_K+wid*1024, vdst=lds0+LDS_V+wid*1024;
  #define DMA_K(t,slot) glds16(ksrc+(long)(t)*KVBLK*DM,(unsigned)__builtin_amdgcn_readfirstlane(kdst+(slot)))
  #define DMA_V(t,slot) glds16(vsrc+(long)(t)*KVBLK*DM,(unsigned)__builtin_amdgcn_readfirstlane(vdst+(slot)))
  const int vb0=(int)(lds0+LDS_V)+((lane>>4)&1)*32+(lane&3)*8+(4*hi+((lane&15)>>2))*64;
  const char*Kbase=shm+LDS_K; bf16x8 kf[8];
  const lds_cptr shm3=(lds_cptr)shm; const lds_cptr kp0=shm3+LDS_K+hi*1024+r32*16; const lds_cptr vp0=shm3+LDS_V+((lane>>4)&1)*32+(lane&3)*8+(4*hi+((lane&15)>>2))*64;
  const int NT=(q0+QB)/KVBLK;
  DMA_K(0,0);DMA_V(0,0);DMA_K(1,SLOTB);
  bf16x8 qr[4];
  #pragma unroll
  for(int d0=0;d0<4;++d0)qr[d0]=*reinterpret_cast<const bf16x8*>(&Qw[(long)r32*DM+d0*16+hi*8]);
  float mhat=0.f,l_reg=0.f;f32x16 o[2],negm; { float z_=0.f; asm volatile("":"+v"(z_));
    _Pragma("unroll") for(int r=0;r<16;++r){o[0][r]=z_;o[1][r]=z_;negm[r]=z_;} } asm volatile("":"+v"(negm));
  const int qrel=wid*QBLK+r32;
  #define CMASK(P0,P1,t) do{int jb_=(t)-(NT-4); if(jb_>=-2 && (wid*QBLK-(64*jb_+63))<128)cbias(P0,P1,jb_,qrel,hi,bt);}while(0)
  bool resc=false;
  #define START(P0,P1) do{ const float rm=rowmax(P0,P1); resc=false; \
    { const float dl=rm; mhat=fadd_s(mhat,dl); \
      _Pragma("unroll") for(int r=0;r<16;++r){P0[r]=fsub_s(P0[r],dl);P1[r]=fsub_s(P1[r],dl);} \
      _Pragma("unroll") for(int r=0;r<16;++r)negm[r]=-mhat; asm volatile("":"+v"(negm)); } \
    _Pragma("unroll") for(int r=0;r<16;++r)P0[r]=__builtin_amdgcn_exp2f(P0[r]); }while(0)
  #define RESC() do{ if(resc){ asm volatile("s_waitcnt lgkmcnt(0)":::"memory"); \
      _Pragma("unroll") for(int d_=0;d_<2;++d_) _Pragma("unroll") for(int r=0;r<16;++r)o[d_][r]*=wsf[crow(r,hi)]; } }while(0)
  f32x16 pA0,pA1,pB0,pB1;
  int sl_prev=0,sl_cur=0,sl_next=SLOTB;
  #define ROT() do{sl_prev=sl_cur;sl_cur=sl_next;sl_next=(sl_next==(NSLOT-1)*SLOTB)?0:sl_next+SLOTB;}while(0)
  DMA_K(2,2*SLOTB);
  WAIT_BAR(3);
  qkt(pA0,pA1,Kbase,qr,negm,r32,hi);asm volatile("s_nop 15\n\ts_nop 7":"+v"(pA0),"+v"(pA1));CMASK(pA0,pA1,0);
  START(pA0,pA1);
  _Pragma("unroll") for(int r=0;r<16;++r)pA1[r]=__builtin_amdgcn_exp2f(pA1[r]);
  WAIT_BAR(0);
  DMA_K(3,0);DMA_V(1,SLOTB);
  ROT();
  kload8(kf,kp0+sl_cur);
  WAIT_BAR(2);
  s16x4 vlo[8],vhi[8]; u32x4 pw0,pw1,pw2,pw3;
  #define PKW(P,B) cvtpk_s(P[B],P[B+1])
  #define PAF(k) __builtin_bit_cast(bf16x8,pw##k)
  #define VFR(i) (bf16x8){vlo[i][0],vlo[i][1],vlo[i][2],vlo[i][3],vhi[i][0],vhi[i][1],vhi[i][2],vhi[i][3]}
  #define PIN(x) asm volatile("":"+v"(x))
  #define MX3(a,b,c) __builtin_fmaxf(__builtin_fmaxf((a),(b)),(c))
  #define GAPA(MF,A0,A1,A2,A3,W0,W1,PW) do{ MF; sacc+=A0; sacc+=A1; sacc+=A2; sacc+=A3; PIN(sacc); W0; W1; PIN(PW); SBAR(); }while(0)
  #define EX(v) __builtin_amdgcn_exp2f(v)
  #define GAPB(MF,X,B) do{ MF; X[B]=EX(X[B]); X[B+1]=EX(X[B+1]); X[B+2]=EX(X[B+2]); X[B+3]=EX(X[B+3]); PIN(X); SBAR(); }while(0)
  #define VRD(i) do{ vlo[i]=vtr(vp_+(((i)>>2)*4096+((i)&3)*1024)); vhi[i]=vtr(vp_+(((i)>>2)*4096+((i)&3)*1024+512)); }while(0)
  #define KRD(G,j) do{ if(G){ kload2(kf,kp0+sl_next,j); SBAR(); } }while(0)
  #define STEP(C0,C1,P0,P1,t,GK,GV,GL) do{ SBAR(); \
    const lds_cptr vp_=vp0+sl_prev; \
    VRD(0); SBAR(); float sacc=(P0[0]+P0[1]); \
    GAPA(C0=__builtin_amdgcn_mfma_f32_32x32x16_bf16(kf[0],qr[0],negm,0,0,0), P0[2],P0[3],P0[4],P0[5],     pw0[0]=PKW(P0,0), pw0[1]=PKW(P0,2), pw0); \
    VRD(4); SBAR(); GAPA(C1=__builtin_amdgcn_mfma_f32_32x32x16_bf16(kf[1],qr[0],negm,0,0,0), P0[6],P0[7],P0[8],P0[9],     pw0[2]=PKW(P0,4), pw0[3]=PKW(P0,6), pw0); \
    VRD(1); SBAR(); GAPA(C0=__builtin_amdgcn_mfma_f32_32x32x16_bf16(kf[2],qr[1],C0,0,0,0),   P0[10],P0[11],P0[12],P0[13], pw1[0]=PKW(P0,8), pw1[1]=PKW(P0,10), pw1); \
    VRD(5); SBAR(); GAPA(C1=__builtin_amdgcn_mfma_f32_32x32x16_bf16(kf[3],qr[1],C1,0,0,0),   P0[14],P0[15],P1[0],P1[1],   pw1[2]=PKW(P0,12),pw1[3]=PKW(P0,14), pw1); \
    VRD(2); SBAR(); GAPA(C0=__builtin_amdgcn_mfma_f32_32x32x16_bf16(kf[4],qr[2],C0,0,0,0),   P1[2],P1[3],P1[4],P1[5],     pw2[0]=PKW(P1,0), pw2[1]=PKW(P1,2), pw2); \
    VRD(6); SBAR(); GAPA(C1=__builtin_amdgcn_mfma_f32_32x32x16_bf16(kf[5],qr[2],C1,0,0,0),   P1[6],P1[7],P1[8],P1[9],     pw2[2]=PKW(P1,4), pw2[3]=PKW(P1,6), pw2); \
    VRD(3); SBAR(); GAPA(C0=__builtin_amdgcn_mfma_f32_32x32x16_bf16(kf[6],qr[3],C0,0,0,0),   P1[10],P1[11],P1[12],P1[13], pw3[0]=PKW(P1,8), pw3[1]=PKW(P1,10), pw3); \
    VRD(7); SBAR(); GAPA(C1=__builtin_amdgcn_mfma_f32_32x32x16_bf16(kf[7],qr[3],C1,0,0,0),   P1[14],P1[15],0.f,0.f,       pw3[2]=PKW(P1,12),pw3[3]=PKW(P1,14), pw3); \
    l_reg+=sacc; \
    if(GK){DMA_K((t)+3,sl_cur);} if(GV){DMA_V((t)+1,sl_next);} \
    CMASK(C0,C1,t); \
    { float a=MX3(C0[0],C0[1],C1[0]),b=MX3(C0[2],C0[3],C1[1]); a=MX3(a,C1[2],C1[3]); \
      _Pragma("unroll") for(int r=4;r<16;r+=4){a=MX3(a,C0[r],C0[r+1]);b=MX3(b,C0[r+2],C0[r+3]);a=MX3(a,C1[r],C1[r+1]);b=MX3(b,C1[r+2],C1[r+3]);} \
      float rm=__builtin_fmaxf(a,b); { auto rr=__builtin_amdgcn_permlane32_swap(__float_as_uint(rm),__float_as_uint(rm),false,false); rm=__builtin_fmaxf(__uint_as_float(rr[0]),__uint_as_float(rr[1])); } \
      resc=false; \
      if(__builtin_expect(__any(rm>(float)THRL),0)){ const float dl=__builtin_fmaxf(rm,0.f); mhat+=dl; \
        _Pragma("unroll") for(int r=0;r<16;++r){C0[r]-=dl;C1[r]-=dl;} \
        _Pragma("unroll") for(int r=0;r<16;++r)negm[r]=-mhat; asm volatile("":"+v"(negm)); \
        const float f=__builtin_amdgcn_exp2f(-dl); l_reg*=f; if(hi==0)wsf[r32]=f; resc=true; } } \
    SBAR(); \
    GAPB(o[0]=__builtin_amdgcn_mfma_f32_32x32x16_bf16(PAF(0),VFR(0),o[0],0,0,0), C0,0); \
    GAPB(o[1]=__builtin_amdgcn_mfma_f32_32x32x16_bf16(PAF(0),VFR(4),o[1],0,0,0), C0,4); \
    KRD(GL,0); GAPB(o[0]=__builtin_amdgcn_mfma_f32_32x32x16_bf16(PAF(1),VFR(1),o[0],0,0,0), C0,8); \
    KRD(GL,1); GAPB(o[1]=__builtin_amdgcn_mfma_f32_32x32x16_bf16(PAF(1),VFR(5),o[1],0,0,0), C0,12); \
    KRD(GL,2); GAPB(o[0]=__builtin_amdgcn_mfma_f32_32x32x16_bf16(PAF(2),VFR(2),o[0],0,0,0), C1,0); \
    KRD(GL,3); GAPB(o[1]=__builtin_amdgcn_mfma_f32_32x32x16_bf16(PAF(2),VFR(6),o[1],0,0,0), C1,4); \
    GAPB(o[0]=__builtin_amdgcn_mfma_f32_32x32x16_bf16(PAF(3),VFR(3),o[0],0,0,0), C1,8); \
    GAPB(o[1]=__builtin_amdgcn_mfma_f32_32x32x16_bf16(PAF(3),VFR(7),o[1],0,0,0), C1,12); \
    }while(0)
  int t=1;
  #undef CMASK
  #define CMASK(P0,P1,t) do{}while(0)
  for(;t+7<NT;t+=2){
    STEP(pB0,pB1,pA0,pA1,t,true,true,true);     WAIT_BAR(2); RESC(); ROT();
    STEP(pA0,pA1,pB0,pB1,t+1,true,true,true);   WAIT_BAR(2); RESC(); ROT();
  }
  #undef CMASK
  #define CMASK(P0,P1,t) do{int jb_=(t)-(NT-4); if(jb_>=-2 && (wid*QBLK-(64*jb_+63))<128)cbias(P0,P1,jb_,qrel,hi,bt);}while(0)
  #define ENDW(tt) do{ if((tt)+3<NT){WAIT_BAR(2);} else if((tt)+2<NT){WAIT_BAR(1);} else {WAIT_BAR(0);} }while(0)
  for(;t+1<NT;t+=2){
    STEP(pB0,pB1,pA0,pA1,t,(t+3<NT),(t+1<NT),(t+1<NT));       ENDW(t);   RESC(); ROT();
    STEP(pA0,pA1,pB0,pB1,t+1,(t+4<NT),(t+2<NT),(t+2<NT));     ENDW(t+1); RESC(); ROT();
  }
  STEP(pB0,pB1,pA0,pA1,NT-1,false,false,false); RESC();
  { float sacc=pB0[0]+pB0[1]; _Pragma("unroll") for(int r=2;r<16;++r)sacc+=pB0[r]; _Pragma("unroll") for(int r=0;r<16;++r)sacc+=pB1[r]; l_reg+=sacc;
    pw0=(u32x4){PKW(pB0,0),PKW(pB0,2),PKW(pB0,4),PKW(pB0,6)};pw1=(u32x4){PKW(pB0,8),PKW(pB0,10),PKW(pB0,12),PKW(pB0,14)};pw2=(u32x4){PKW(pB1,0),PKW(pB1,2),PKW(pB1,4),PKW(pB1,6)};pw3=(u32x4){PKW(pB1,8),PKW(pB1,10),PKW(pB1,12),PKW(pB1,14)};
    SBAR(); pv(o,vb0+sl_cur,PAF(0),PAF(1),PAF(2),PAF(3)); }
  #undef PKW
  #undef PAF
  #undef VFR
  #undef PIN
  #undef MX3
  #undef GAPA
  #undef GAPB
  #undef EX
  #undef VRD
  #undef KRD
  #undef STEP
  #undef ENDW
  {auto rr=__builtin_amdgcn_permlane32_swap(__float_as_uint(l_reg),__float_as_uint(l_reg),false,false);l_reg=__uint_as_float(rr[0])+__uint_as_float(rr[1]);}
  if(hi==0)wsf[32+r32]=l_reg;asm volatile("s_waitcnt lgkmcnt(0)":::"memory");
  float rli[16];
  #pragma unroll
  for(int r=0;r<16;++r)rli[r]=__builtin_amdgcn_rcpf(wsf[32+crow(r,hi)]);
  bf16*Ow=O+(rowbase+q0+wid*QBLK)*DM+oc;
  { bf16*stg=(bf16*)(shm+LDS_OST)+wid*2048;
    #pragma unroll
    for(int r=0;r<16;++r){const int orow=crow(r,hi);
      #pragma unroll
      for(int d0=0;d0<2;++d0)stg[orow*64+d0*32+r32]=__float2bfloat16(o[d0][r]*rli[r]);}
    asm volatile("s_waitcnt lgkmcnt(0)":::"memory");
    #pragma unroll
    for(int i=0;i<4;++i){const int row=i*8+(lane>>3),ch=lane&7; const u32x4 v=*(const u32x4*)(stg+row*64+ch*8); ATTN_STORE16(Ow+(long)row*DM+ch*8,v);} }
  asm volatile("s_waitcnt lgkmcnt(0)\n\ts_barrier":::"memory");
  #undef DMA_K
  #undef DMA_V
  #undef CMASK
  #undef START
  #undef RESC
  #undef ROT
}
constexpr int ATTN_LDS_BYTES=LDS_BYTES;
#undef SBAR
#undef WAIT_BAR
}
struct Ctx {
    LAS unsigned char* lds; char* ldsg; int tid, lane, wave, G, vcu;
    const float* in[23]; float* out; unsigned char* ws;
};
#define WSP(T, off) ((T*)(C.ws + (off)))
#define PHASE_IDS() Ctx C = C0; { int t_ = threadIdx.x; asm volatile("" : "+v"(t_)); C.tid = t_; C.lane = t_ & 63; C.wave = __builtin_amdgcn_readfirstlane(t_ >> 6); }

struct ConvDesc { const float* src; bf16_t* dst; int N, K; };
__device__ __forceinline__ ConvDesc conv_desc(const Ctx& C, int it) {
    constexpr int I_IN = 16 * 160, I_BR = 8 * 32, I_GU1 = 16 * 64, I_GU = NE * I_GU1, I_D1 = 16 * 32, I_D = NE * I_D1;
    const float* W; bf16_t* WT; int K, N, kb, nb, orow; int r = it;
    if (r < I_GU) { const int e = r / I_GU1, q = r % I_GU1; kb = q / 64; nb = q % 64; const int n0 = 32 * nb, half = n0 >> 10, rem = n0 & 1023;
        W = C.in[18] + (size_t)e * 1024 * 2048; WT = WSP(bf16_t, WS_WGU) + (size_t)e * 2048 * 1024; K = 1024; N = 2048; orow = (rem >> 7) * 256 + half * 128 + (rem & 127); }
    else if ((r -= I_GU) < I_D) { const int e = r / I_D1, q = r % I_D1; kb = q / 32; nb = q % 32; W = C.in[20] + (size_t)e * 1024 * 1024; WT = WSP(bf16_t, WS_WD) + (size_t)e * 1024 * 1024; K = 1024; N = 1024; orow = 32 * nb; }
    else if ((r -= I_D) < I_IN) { kb = r / 160; nb = r % 160; W = C.in[6]; WT = WSP(bf16_t, WS_WIN); K = 1024; N = INW; orow = 32 * nb; }
    else if ((r -= I_IN) < I_BR) { kb = r / 32; nb = r % 32; W = C.in[12]; WT = WSP(bf16_t, WS_WBR); K = 1024; N = 1024; orow = 32 * nb; }
    else if ((r -= I_BR) < I_BR) { kb = r / 32; nb = r % 32; W = C.in[13]; WT = WSP(bf16_t, WS_WBR) + 512; K = 1024; N = 1024; orow = 32 * nb; }
    else { r -= I_BR; kb = r / 32; nb = r % 32; W = C.in[14]; WT = WSP(bf16_t, WS_WOUT); K = 1024; N = 1024; orow = 32 * nb; }
    ConvDesc d; d.src = W + (size_t)(64 * kb) * N + 32 * nb; d.dst = WT + (size_t)orow * K + 64 * kb; d.N = N; d.K = K; return d;
}
__device__ __forceinline__ void conv_load(const ConvDesc& d, f32x4 (&v)[8], int lane) {
    const int kr = lane >> 3, nc = lane & 7;
#pragma unroll
    for (int i = 0; i < 8; ++i) v[i] = *(const f32x4*)(d.src + (size_t)(8 * i + kr) * d.N + 4 * nc);
}
__device__ __forceinline__ void conv_finish(const ConvDesc& d, const f32x4 (&v)[8], LAS float* scr, int lane) {
    const int kr = lane >> 3, nc = lane & 7;
#pragma unroll
    for (int i = 0; i < 8; ++i) { LAS float* s = scr + (8 * i + kr) * 33 + 4 * nc; s[0] = v[i][0]; s[1] = v[i][1]; s[2] = v[i][2]; s[3] = v[i][3]; }
    LDS_WAIT(); asm volatile("" ::: "memory");
    const int c = lane & 7;
#pragma unroll
    for (int j = 0; j < 4; ++j) { const int n = (lane >> 3) + 8 * j; const LAS float* s = scr + (8 * c) * 33 + n;
        u32x4 o; o.x = pk2(s[0 * 33], s[1 * 33]); o.y = pk2(s[2 * 33], s[3 * 33]); o.z = pk2(s[4 * 33], s[5 * 33]); o.w = pk2(s[6 * 33], s[7 * 33]);
        *(u32x4*)(d.dst + (size_t)n * d.K + 8 * c) = o; }
    LDS_WAIT(); asm volatile("" ::: "memory");
}
__device__ __forceinline__ void p0_prologue(const Ctx& C0) {
    PHASE_IDS();
    LAS float* scr = (LAS float*)(C.lds + C.wave * 8448);
    const int gw = C.vcu * NWAVES + C.wave, NGW = C.G * NWAVES;
    constexpr int NITEMS = NE * 16 * 64 + NE * 16 * 32 + 16 * 160 + 2 * 8 * 32 + 16 * 32;
    if (gw < NITEMS) {
        ConvDesc d0 = conv_desc(C, gw); f32x4 v0[8]; conv_load(d0, v0, C.lane);
        for (int it = gw; it < NITEMS; it += NGW) {
            const int nx = it + NGW; ConvDesc d1 = d0; f32x4 v1[8];
            if (nx < NITEMS) { d1 = conv_desc(C, nx); conv_load(d1, v1, C.lane); }
            conv_finish(d0, v0, scr, C.lane);
            d0 = d1;
#pragma unroll
            for (int i = 0; i < 8; ++i) v0[i] = v1[i];
        }
    }
    const float* cvec = C.in[1]; const float* wada = C.in[3]; float* adap = WSP(float, WS_ADAP);
    for (int it = gw; it < 96 * 8; it += NGW) { const int cc = it % 96, ks = it / 96; const int n = 64 * cc + C.lane; float a0 = 0.f, a1 = 0.f;
#pragma unroll 8
        for (int k = 0; k < 128; ++k) { const int kk = 128 * ks + k; const float w = wada[(size_t)kk * 6144 + n]; a0 += cvec[kk] * w; a1 += cvec[1024 + kk] * w; }
        adap[(ks * 2 + 0) * 6144 + n] = a0; adap[(ks * 2 + 1) * 6144 + n] = a1; }
}
__device__ __forceinline__ float ada_val(const Ctx& C, int b, int n) {
    const float* adap = WSP(const float, WS_ADAP); float s = C.in[4][n];
#pragma unroll
    for (int ks = 0; ks < 8; ++ks) s += adap[(ks * 2 + b) * 6144 + n];
    return s;
}
__device__ __forceinline__ void rms_mod_row(const float* xrow, bf16_t* orow, const LAS float* MA, const LAS float* MB, int lane) {
    const f32x4* xr = (const f32x4*)xrow + lane;
    f32x4 v[4]; float s = 0.f;
#pragma unroll
    for (int j = 0; j < 4; ++j) { v[j] = xr[64 * j]; s += (v[j][0] * v[j][0] + v[j][1] * v[j][1]) + (v[j][2] * v[j][2] + v[j][3] * v[j][3]); }
    const float rstd = 1.0f / sqrtf(wave_sum(s) * (1.0f / D) + RMS_EPS);
    u32x2* o8 = (u32x2*)orow + lane;
#pragma unroll
    for (int j = 0; j < 4; ++j) { const f32x4 a = *(const LAS f32x4*)(MA + 4 * lane + 256 * j), b = *(const LAS f32x4*)(MB + 4 * lane + 256 * j);
        const f32x4 h = v[j] * rstd * a + b; u32x2 w; w.x = pk2(h[0], h[1]); w.y = pk2(h[2], h[3]); o8[64 * j] = w; }
}
__device__ __forceinline__ void p1_h1(const Ctx& C0) {
    PHASE_IDS();
    LAS float* MA = (LAS float*)C.lds;
    LAS float* MB = MA + 2048;
    for (int idx = C.tid; idx < 2048; idx += 512) { const int b = idx >> 10, col = idx & 1023;
        const float sh = ada_val(C, b, col), sc = ada_val(C, b, 1024 + col);
        MA[idx] = C.in[5][col] * (1.0f + sc); MB[idx] = sh; }
    {
        const int per = (2 * 6144 + C.G - 1) / C.G;
        for (int i = C.tid; i < per; i += 512) { const int idx = blockIdx.x * per + i; if (idx < 2 * 6144) WSP(float, WS_ADAF)[idx] = ada_val(C, idx / 6144, idx % 6144); }
    }
    __syncthreads();
    const int gw = C.vcu * NWAVES + C.wave, NGW = C.G * NWAVES;
    for (int m = gw; m < M; m += NGW) { const int b = m >= SEQ; rms_mod_row(C.in[0] + (size_t)m * D, WSP(bf16_t, WS_H) + (size_t)m * D, MA + b * 1024, MB + b * 1024, C.lane); }
    __syncthreads();
}
__device__ __forceinline__ void p3a_kmean(const Ctx& C0) {
    PHASE_IDS();
    LAS float* red = (LAS float*)C.lds;
    const bf16_t* kb = WSP(const bf16_t, WS_PROJ + 2 * PROJ_STRIDE);
    for (int it = blockIdx.x; it < 64; it += C.G) { const int b = it >> 5, n = it & 31;
        float a[8];
#pragma unroll
        for (int j = 0; j < 8; ++j) a[j] = 0.f;
        const bf16_t* src = kb + (size_t)(b * SEQ + 256 * n + 32 * C.wave) * 1024 + 8 * C.lane;
#pragma unroll 8
        for (int r = 0; r < 32; ++r) { const u32x4 v = *(const u32x4*)(src + (size_t)r * 1024);
            a[0] += bf_lo(v.x); a[1] += bf_hi(v.x); a[2] += bf_lo(v.y); a[3] += bf_hi(v.y); a[4] += bf_lo(v.z); a[5] += bf_hi(v.z); a[6] += bf_lo(v.w); a[7] += bf_hi(v.w); }
        __syncthreads();
#pragma unroll
        for (int j = 0; j < 8; ++j) red[C.wave * 512 + 8 * C.lane + j] = a[j];
        __syncthreads();
        { const int col = C.tid; float s = 0.f;
#pragma unroll
            for (int w = 0; w < 8; ++w) s += red[w * 512 + col];
            const int h = col >> 6, d = col & 63; WSP(float, WS_KMEAN)[((b * 8 + h) * 32 + n) * 64 + d] = s * (1.0f / 256.0f); }
    }
    __syncthreads();
}
__device__ __forceinline__ void p3b_gate(const Ctx& C0) {
    PHASE_IDS();
    LAS float* km = (LAS float*)C.lds;
    const bf16_t* qb = WSP(const bf16_t, WS_PROJ + 1 * PROJ_STRIDE) + 512;
    unsigned* cnt = WSP(unsigned, WS_CTL) + CW_MCNT; unsigned* list = WSP(unsigned, WS_LIST);
    for (int it = blockIdx.x; it < 256; it += C.G) { const int bh = it >> 4, qc = it & 15, b = bh >> 3, h = bh & 7;
        __syncthreads();
        for (int i = C.tid; i < 2048; i += 512) km[i] = WSP(const float, WS_KMEAN)[bh * 2048 + i];
        __syncthreads();
        const int q = 512 * qc + C.tid, own = q >> 8;
        u32x4 qv[8];
        { const u32x4* qp = (const u32x4*)(qb + (size_t)(b * SEQ + q) * 1024 + h * 64);
#pragma unroll
            for (int j = 0; j < 8; ++j) qv[j] = qp[j]; }
        float v0 = -INFINITY, v1 = -INFINITY, v2 = -INFINITY; int i0 = 0, i1 = 0, i2 = 0;
        const int nmax = ((512 * qc + 511) >> 8);
        for (int n = 0; n < nmax; ++n) { const LAS f32x4* kr = (const LAS f32x4*)(km + n * 64); float s = 0.f;
#pragma unroll
            for (int j = 0; j < 8; ++j) { const f32x4 ka = kr[2 * j], kb2 = kr[2 * j + 1];
                s += bf_lo(qv[j].x) * ka[0] + bf_hi(qv[j].x) * ka[1] + bf_lo(qv[j].y) * ka[2] + bf_hi(qv[j].y) * ka[3]
                   + bf_lo(qv[j].z) * kb2[0] + bf_hi(qv[j].z) * kb2[1] + bf_lo(qv[j].w) * kb2[2] + bf_hi(qv[j].w) * kb2[3]; }
            if (n < own) {
                if (s > v0) { v2 = v1; i2 = i1; v1 = v0; i1 = i0; v0 = s; i0 = n; }
                else if (s > v1) { v2 = v1; i2 = i1; v1 = s; i1 = n; }
                else if (s > v2) { v2 = s; i2 = n; }
            } }
        const int nsel = own < 3 ? own : 3;
        LAS unsigned* lc = (LAS unsigned*)(C.lds + 8192);
        if (C.tid < 128) lc[C.tid] = 0u;
        __syncthreads();
        const int l0 = 2 * i0 + (i0 == own - 1 ? 1 : 0), l1 = 2 * i1 + (i1 == own - 1 ? 1 : 0), l2 = 2 * i2 + (i2 == own - 1 ? 1 : 0);
        unsigned lp0 = 0u, lp1 = 0u, lp2 = 0u;
        if (nsel > 0) lp0 = atomicAdd((unsigned*)(lc + l0), 1u);
        if (nsel > 1) lp1 = atomicAdd((unsigned*)(lc + l1), 1u);
        if (nsel > 2) lp2 = atomicAdd((unsigned*)(lc + l2), 1u);
        __syncthreads();
        if (C.tid < 64) { const unsigned c = lc[C.tid]; lc[64 + C.tid] = c ? atomicAdd(cnt + bh * 64 + C.tid, c) : 0u; }
        __syncthreads();
#pragma unroll
        for (int j = 0; j < 3; ++j) if (j < nsel) { const int n = j == 0 ? i0 : (j == 1 ? i1 : i2); const int l = j == 0 ? l0 : (j == 1 ? l1 : l2); const unsigned pos = lc[64 + l] + (j == 0 ? lp0 : (j == 1 ? lp1 : lp2));
            list[(size_t)bh * LIST_PER_BH + 256 * (31 * n - (n * (n - 1)) / 2) + ((l & 1) ? 0 : 256) + pos] = (unsigned)q | ((unsigned)j << 13); }
    }
    __syncthreads();
}
__device__ __forceinline__ void build_bias_tables(const Ctx& C) {
    LAS float* bt = (LAS float*)(C.lds + AT_BT);
    for (int idx = C.tid; idx < 12 * BT_STR; idx += 512) { const int hd = idx / BT_STR, n = idx % BT_STR;
        if (n >= 128) { bt[idx] = 0.f; continue; }
        int bk;
        if (n < 16) bk = n; else { const float nf = (float)n; int lg = 16 + (int)(logf(nf / 16.0f) / logf(8.0f) * 16.0f); bk = lg < 31 ? lg : 31; }
        bt[idx] = (C.in[2][bk * 12 + hd] - C.in[2][31 * 12 + hd]) * LOG2E; }
}
#if SIMPLE_DIFF
__device__ __forceinline__ void diff_unit(const Ctx& C, int b, int h, int qblk, float lam) {
    const int lane = C.lane, c = lane & 15, g = lane >> 4, wid = C.wave;
    const bf16_t* qka = WSP(const bf16_t, WS_PROJ);
    const bf16_t* va = WSP(const bf16_t, WS_PROJ + PROJ_STRIDE);
    const int q0 = qblk * 128, q = q0 + wid * 16 + c, NT = 2 * qblk + 2;
    const LAS float* bt = (const LAS float*)(C.lds + AT_BT) + h * 128;
    f32x4 o0[8];
    for (int map = 0; map < 2; ++map) {
        bf16x8 qf[2];
#pragma unroll
        for (int ks = 0; ks < 2; ++ks) qf[ks] = *(const bf16x8*)(qka + (size_t)(b * SEQ + q) * 1024 + h * 128 + map * 64 + 32 * ks + 8 * g);
        const bf16_t* kg = qka + (size_t)(b * SEQ) * 1024 + 512 + h * 128 + map * 64;
        const bf16_t* vg = va + (size_t)(b * SEQ) * 1024 + h * 128;
        float m_run = -1e30f, l_run = 0.f; f32x4 o[8];
#pragma unroll
        for (int dt = 0; dt < 8; ++dt) o[dt] = (f32x4){0.f, 0.f, 0.f, 0.f};
        TileRegs<2> tr; tile_fetch<2>(tr, kg, vg, C.tid);
        for (int t = 0; t < NT; ++t) {
            __syncthreads();
            tile_store<2>(tr, C.lds, C.tid);
            __syncthreads();
            if (t + 1 < NT) tile_fetch<2>(tr, kg + (size_t)(t + 1) * 64 * 1024, vg + (size_t)(t + 1) * 64 * 1024, C.tid);
            attn_tile<8>(C.lds, lane, qf, o, m_run, l_run, q, 64 * t, true, bt);
        }
        float lt = l_run; lt += __shfl_xor(lt, 16); lt += __shfl_xor(lt, 32);
        const float rl = 1.0f / lt;
#pragma unroll
        for (int i = 0; i < 4; ++i) { const float ri = __shfl(rl, 4 * g + i);
#pragma unroll
            for (int dt = 0; dt < 8; ++dt) { if (map == 0) o0[dt][i] = o[dt][i] * ri; else o0[dt][i] = o0[dt][i] - lam * (o[dt][i] * ri); } }
    }
    bf16_t* y = WSP(bf16_t, WS_Y);
#pragma unroll
    for (int i = 0; i < 4; ++i) { float ss = 0.f;
#pragma unroll
        for (int dt = 0; dt < 8; ++dt) ss += o0[dt][i] * o0[dt][i];
        ss += __shfl_xor(ss, 1); ss += __shfl_xor(ss, 2); ss += __shfl_xor(ss, 4); ss += __shfl_xor(ss, 8);
        const float rstd = 1.0f / sqrtf(ss * (1.0f / 128.0f) + RMS_EPS);
        bf16_t* yr = y + (size_t)(b * SEQ + q0 + wid * 16 + 4 * g + i) * 1024 + h * 128 + c;
#pragma unroll
        for (int dt = 0; dt < 8; ++dt) yr[16 * dt] = (bf16_t)f2bf(o0[dt][i] * rstd * C.in[11][16 * dt + c] * 0.8f); }
}
#endif
#if 0
__device__ __forceinline__ void moba_item(const Ctx& C, int b, int h, int n, bool own, int half, const unsigned* lst, int lcnt, int chunk) {
    const int lane = C.lane, c = lane & 15, g = lane >> 4, wid = C.wave;
    const bf16_t* qb = WSP(const bf16_t, WS_PROJ + PROJ_STRIDE) + 512;
    const bf16_t* kv = WSP(const bf16_t, WS_PROJ + 2 * PROJ_STRIDE);
    int qtok, jslot; bool valid;
    if (own) { qtok = 256 * n + 128 * half + wid * 16 + c; jslot = 3; valid = true; }
    else { const int idx = chunk * 128 + wid * 16 + c; valid = idx < lcnt; const unsigned e = lst[valid ? idx : 0]; qtok = (int)(e & 8191u); jslot = (int)(e >> 13); }
    bf16x8 qf[2];
#pragma unroll
    for (int ks = 0; ks < 2; ++ks) qf[ks] = *(const bf16x8*)(qb + (size_t)(b * SEQ + qtok) * 1024 + h * 64 + 32 * ks + 8 * g);
    const bf16_t* kg = kv + (size_t)(b * SEQ + 256 * n) * 1024 + h * 64;
    const bf16_t* vg = kg + 512;
    const LAS float* bt = (const LAS float*)(C.lds + AT_BT) + (4 + h) * 128;
    const int NT = own ? 2 * (half + 1) : 4;
    float m_run = -1e30f, l_run = 0.f; f32x4 o[4];
#pragma unroll
    for (int dt = 0; dt < 4; ++dt) o[dt] = (f32x4){0.f, 0.f, 0.f, 0.f};
    TileRegs<1> tr; tile_fetch<1>(tr, kg, vg, C.tid);
    for (int t = 0; t < NT; ++t) {
        __syncthreads();
        tile_store<1>(tr, C.lds, C.tid);
        __syncthreads();
        if (t + 1 < NT) tile_fetch<1>(tr, kg + (size_t)(t + 1) * 64 * 1024, vg + (size_t)(t + 1) * 64 * 1024, C.tid);
        attn_tile<4>(C.lds, lane, qf, o, m_run, l_run, qtok, 256 * n + 64 * t, own, bt);
    }
    float lt = l_run; lt += __shfl_xor(lt, 16); lt += __shfl_xor(lt, 32);
    const int slot = ((b * SEQ + qtok) * 8 + h) * 4 + jslot;
    if (g == 0 && valid) { f32x2 ml; ml[0] = m_run; ml[1] = lt; *(f32x2*)(WSP(float, WS_PML) + (size_t)slot * 2) = ml; }
    bf16_t* po = WSP(bf16_t, WS_PO);
#pragma unroll
    for (int i = 0; i < 4; ++i) { const int sl = __shfl(slot, 4 * g + i); const int vl = __shfl((int)valid, 4 * g + i);
        if (vl) {
#pragma unroll
            for (int dt = 0; dt < 4; ++dt) po[(size_t)sl * 64 + 16 * dt + c] = (bf16_t)f2bf(o[dt][i]); } }
}
#endif
constexpr int MB_BUF = 65536, MB_OST = LDSCTL_OFF + 14336;
struct MItem { int valid, b, h, n, own, half, near, lcnt, chunk, lbase; };
__device__ __forceinline__ MItem moba_decode(int it, int nitems, const LAS int* pre, const unsigned* cnt) {
    MItem m; m.valid = it < nitems ? 1 : 0; if (!m.valid) it = 0;
    if (it < 1024) { const int bh = it >> 6, r = it & 63; m.b = bh >> 3; m.h = bh & 7; m.n = r >> 1; m.own = 1; m.half = r & 1; m.near = 0; m.lcnt = 128; m.chunk = 0; m.lbase = 0; }
    else { const int gi = it - 1024; int lo = 0, hi = 1023;
        while (lo < hi) { const int mid = (lo + hi + 1) >> 1; if (pre[mid] <= gi) lo = mid; else hi = mid - 1; }
        const int L = lo, bh = L >> 6, n = (L >> 1) & 31, near = L & 1;
        m.b = bh >> 3; m.h = bh & 7; m.n = n; m.own = 0; m.half = 0; m.near = near; m.lcnt = (int)__hip_atomic_load(cnt + L, RLX_AGENT); m.chunk = gi - pre[L];
        m.lbase = bh * LIST_PER_BH + 256 * (31 * n - (n * (n - 1)) / 2) + (near ? 0 : 256); }
    return m;
}
__device__ __forceinline__ unsigned moba_entry(const Ctx& C, const MItem& m) {
    const int c = C.lane & 15;
    if (m.own) return (unsigned)(256 * m.n + 128 * m.half + C.wave * 16 + c) | (3u << 13) | (1u << 15);
    const int idx = m.chunk * 128 + C.wave * 16 + c; const bool v = idx < m.lcnt;
    const unsigned e = WSP(const unsigned, WS_LIST)[(size_t)m.lbase + (v ? idx : 0)];
    return (e & 0x7fffu) | (v ? (1u << 15) : 0u);
}
__device__ __forceinline__ void moba_qload(const Ctx& C, const MItem& m, unsigned ent, bf16x8 (&qf)[2]) {
    const bf16_t* qb = WSP(const bf16_t, WS_PROJ + PROJ_STRIDE) + 512; const int g = C.lane >> 4;
#pragma unroll
    for (int ks = 0; ks < 2; ++ks) qf[ks] = *(const bf16x8*)(qb + (size_t)(m.b * SEQ + (int)(ent & 8191u)) * 1024 + m.h * 64 + 32 * ks + 8 * g);
}
__device__ __forceinline__ void moba_dma(const Ctx& C, const MItem& m, int bo) {
    const bf16_t* kg = WSP(const bf16_t, WS_PROJ + 2 * PROJ_STRIDE) + (size_t)(m.b * SEQ + 256 * m.n) * 1024 + m.h * 64;
    const int r8 = C.lane >> 3, sch = (C.lane & 7) ^ r8;
#pragma unroll
    for (int j = 0; j < 4; ++j) { const int p = C.wave * 4 + j; const bf16_t* src = kg + (size_t)(8 * p + r8) * 1024 + sch * 8;
        __builtin_amdgcn_global_load_lds((const unsigned*)src, (LAS unsigned*)(C.lds + bo + p * 1024), 16, 0, 0);
        __builtin_amdgcn_global_load_lds((const unsigned*)(src + 512), (LAS unsigned*)(C.lds + bo + 32768 + p * 1024), 16, 0, 0); }
}
constexpr int MB_STG = 2304;
__device__ __forceinline__ void moba_flush(const Ctx& C) {
    const LAS unsigned char* stg = C.lds + MB_OST + C.wave * MB_STG; const int lane = C.lane;
    const LAS int* sslot = (const LAS int*)(stg + 2176);
    bf16_t* po = WSP(bf16_t, WS_PO);
#pragma unroll
    for (int r = 0; r < 2; ++r) { const int row = (lane >> 3) + 8 * r, ch = lane & 7; const u32x4 v = *(const LAS u32x4*)(stg + row * 128 + ch * 16); const int sl = sslot[row];
        if (sl >= 0) *(u32x4*)(po + (size_t)sl * 64 + ch * 8) = v; }
    if (lane < 16) { const int sl = sslot[lane]; const f32x2 ml = *(const LAS f32x2*)(stg + 2048 + lane * 8); if (sl >= 0) *(f32x2*)(WSP(float, WS_PML) + (size_t)sl * 2) = ml; }
}
__device__ __forceinline__ void moba_compute(const Ctx& C, const MItem& m, unsigned ent, const bf16x8 (&qf)[2], int bo, int mode) {
    if (!(mode & 2)) return;
    const int lane = C.lane, c = lane & 15, g = lane >> 4, cx = c & 7;
    const int qtok = (int)(ent & 8191u), jslot = (int)((ent >> 13) & 3u), valid = (int)((ent >> 15) & 1u);
    const int nkt = m.own ? 8 * (m.half + 1) : 16;
    const LAS float* bt = (const LAS float*)(C.lds + AT_BT) + (4 + m.h) * BT_STR;
    f32x4 s[16];
    const LAS unsigned char* kb = C.lds + bo + c * 128;
    const int kc0 = ((0 + g) ^ cx) << 4, kc1 = ((4 + g) ^ cx) << 4;
#define MB_BIAS(t4) do { if (m.own | m.near) { const int kbase_ = 256 * m.n + 64 * (t4); \
            _Pragma("unroll") for (int k4 = 0; k4 < 4; ++k4) _Pragma("unroll") for (int i = 0; i < 4; ++i) { const int kt_ = 4 * (t4) + k4; const int dist = qtok - (kbase_ + 16 * k4 + 4 * g + i); \
                const unsigned di = (unsigned)dist < 128u ? (unsigned)dist : 128u; const float v = s[kt_][i] + bt[di]; s[kt_][i] = (m.own && dist < 0) ? -INFINITY : v; } } } while (0)
#pragma unroll
    for (int kt = 0; kt < 4; ++kt) { const bf16x8 a0 = *(const LAS bf16x8*)(kb + kt * 2048 + kc0), a1 = *(const LAS bf16x8*)(kb + kt * 2048 + kc1);
        f32x4 z = (f32x4){0.f, 0.f, 0.f, 0.f}; z = __builtin_amdgcn_mfma_f32_16x16x32_bf16(a0, qf[0], z, 0, 0, 0); s[kt] = __builtin_amdgcn_mfma_f32_16x16x32_bf16(a1, qf[1], z, 0, 0, 0); }
    MB_BIAS(0);
    float mx = fmaxf(fmaxf(s[0][0], s[0][1]), fmaxf(s[0][2], s[0][3]));
#pragma unroll
    for (int kt = 1; kt < 4; ++kt) mx = fmaxf(mx, fmaxf(fmaxf(s[kt][0], s[kt][1]), fmaxf(s[kt][2], s[kt][3])));
    mx = fmaxf(mx, __shfl_xor(mx, 16)); mx = fmaxf(mx, __shfl_xor(mx, 32));
    const f32x4 negm = (f32x4){-mx, -mx, -mx, -mx};
#pragma unroll
    for (int kt = 0; kt < 4; ++kt) s[kt] += negm;
#pragma unroll
    for (int kt = 4; kt < 16; ++kt) {
        if (kt < nkt) { const bf16x8 a0 = *(const LAS bf16x8*)(kb + kt * 2048 + kc0), a1 = *(const LAS bf16x8*)(kb + kt * 2048 + kc1);
            f32x4 z = __builtin_amdgcn_mfma_f32_16x16x32_bf16(a0, qf[0], negm, 0, 0, 0); s[kt] = __builtin_amdgcn_mfma_f32_16x16x32_bf16(a1, qf[1], z, 0, 0, 0); }
        else s[kt] = (f32x4){-INFINITY, -INFINITY, -INFINITY, -INFINITY};
    }
    if (4 < nkt) MB_BIAS(1);
    if (8 < nkt) { MB_BIAS(2); MB_BIAS(3); }
#undef MB_BIAS
#pragma unroll
    for (int kt = 0; kt < 16; ++kt)
#pragma unroll
        for (int i = 0; i < 4; ++i) s[kt][i] = __builtin_amdgcn_exp2f(s[kt][i]);
    f32x4 o[4], osum = (f32x4){0.f, 0.f, 0.f, 0.f};
#pragma unroll
    for (int dt = 0; dt < 4; ++dt) o[dt] = (f32x4){0.f, 0.f, 0.f, 0.f};
    const short one = (c == 0) ? (short)0x3F80 : (short)0; const bf16x8 ones = (bf16x8){one, one, one, one, one, one, one, one};
    const int rv = 4 * g + (c >> 2), x7 = rv & 7, hb = (c & 3) >> 1;
    const LAS unsigned char* vb = C.lds + bo + 32768 + rv * 128 + 8 * (c & 1);
    int cv[4];
#pragma unroll
    for (int dt = 0; dt < 4; ++dt) cv[dt] = ((2 * dt + hb) ^ x7) << 4;
#pragma unroll
    for (int kk = 0; kk < 8; ++kk) {
        if (2 * kk < nkt) { u32x4 w; w.x = cvt_pk_bf16(s[2 * kk][0], s[2 * kk][1]); w.y = cvt_pk_bf16(s[2 * kk][2], s[2 * kk][3]);
            w.z = cvt_pk_bf16(s[2 * kk + 1][0], s[2 * kk + 1][1]); w.w = cvt_pk_bf16(s[2 * kk + 1][2], s[2 * kk + 1][3]); const bf16x8 pa = __builtin_bit_cast(bf16x8, w);
            osum = __builtin_amdgcn_mfma_f32_16x16x32_bf16(pa, ones, osum, 0, 0, 0);
#pragma unroll
            for (int dt = 0; dt < 4; ++dt) { const s16x4 lo = tr16(vb + (32 * kk) * 128 + cv[dt]), hi = tr16(vb + (32 * kk + 16) * 128 + cv[dt]);
                const bf16x8 bfr = (bf16x8){lo[0], lo[1], lo[2], lo[3], hi[0], hi[1], hi[2], hi[3]};
                o[dt] = __builtin_amdgcn_mfma_f32_16x16x32_bf16(pa, bfr, o[dt], 0, 0, 0); } }
    }
    if (!(mode & 1)) return;
    LAS unsigned char* stg = C.lds + MB_OST + C.wave * MB_STG;
    LAS bf16_t* so = (LAS bf16_t*)stg;
#pragma unroll
    for (int i = 0; i < 4; ++i)
#pragma unroll
        for (int dt = 0; dt < 4; ++dt) so[(4 * g + i) * 64 + 16 * dt + c] = (bf16_t)f2bf(o[dt][i]);
    const int slot = valid ? ((m.b * SEQ + qtok) * 8 + m.h) * 4 + jslot : -1;
    if (g == 0) { ((LAS int*)(stg + 2176))[c] = slot; ((LAS float*)(stg + 2048))[2 * c] = mx; }
    if (c == 0) {
#pragma unroll
        for (int i = 0; i < 4; ++i) ((LAS float*)(stg + 2048))[2 * (4 * g + i) + 1] = osum[i]; }
}
__device__ __forceinline__ MItem moba_item_at(const LAS int* tab, int j) {
    MItem m; const int w0 = __builtin_amdgcn_readfirstlane(tab[4 * j]), w1 = __builtin_amdgcn_readfirstlane(tab[4 * j + 1]), w2 = __builtin_amdgcn_readfirstlane(tab[4 * j + 2]), w3 = __builtin_amdgcn_readfirstlane(tab[4 * j + 3]);
    m.valid = (j < 32 && w1 >= 0) ? 1 : 0; const int bh = w0 & 255; m.b = bh >> 3; m.h = bh & 7; m.n = (w0 >> 8) & 255; m.own = (w0 >> 16) & 1; m.half = (w0 >> 17) & 1; m.near = (w0 >> 18) & 1; m.lcnt = w1; m.chunk = w2; m.lbase = w3; return m;
}
__device__ __forceinline__ void moba_phase(const Ctx& C, const LAS int* pre, const unsigned* cnt, int mode) {
    const int nitems = 1024 + pre[1024]; const int G = C.G;
    LAS int* tab = (LAS int*)(C.lds + LDSCTL_OFF + 7424);
    if (C.tid < 33) { MItem m = moba_decode(C.vcu + C.tid * G, nitems, pre, cnt); if (C.tid == 32) m.valid = 0;
        tab[4 * C.tid] = (m.b * 8 + m.h) | (m.n << 8) | (m.own << 16) | (m.half << 17) | (m.near << 18); tab[4 * C.tid + 1] = m.valid ? m.lcnt : -1; tab[4 * C.tid + 2] = m.chunk; tab[4 * C.tid + 3] = m.lbase; }
    __syncthreads();
    int j = 0;
    MItem m0 = moba_item_at(tab, 0), m1 = moba_item_at(tab, 1);
    unsigned e0 = 0u, e1 = 0u; bf16x8 qf0[2];
    qf0[0] = (bf16x8){0, 0, 0, 0, 0, 0, 0, 0}; qf0[1] = qf0[0];
    if (m0.valid) { e0 = moba_entry(C, m0); moba_qload(C, m0, e0, qf0); moba_dma(C, m0, 0); }
    if (m1.valid) e1 = moba_entry(C, m1);
    int bo = 0; bool pending = false;
    while (m0.valid) {
        VM_WAIT(); __syncthreads();
        if (pending) moba_flush(C);
        bf16x8 qf1[2]; qf1[0] = qf0[0]; qf1[1] = qf0[1];
        if (m1.valid) moba_qload(C, m1, e1, qf1);
        const MItem m2 = moba_item_at(tab, j + 2 < 32 ? j + 2 : 32);
        unsigned e2 = 0u; if (m2.valid) e2 = moba_entry(C, m2);
        if (m1.valid) moba_dma(C, m1, bo ^ MB_BUF);
        moba_compute(C, m0, e0, qf0, bo, mode); pending = (mode & 3) == 3;
        m0 = m1; m1 = m2; e0 = e1; e1 = e2; qf0[0] = qf1[0]; qf0[1] = qf1[1]; bo ^= MB_BUF; ++j;
    }
    if (pending) { LDS_WAIT(); moba_flush(C); }
    VM_WAIT(); __syncthreads();
}
#ifndef PROBE_SUB
#define PROBE_SUB 3
#endif
__device__ __forceinline__ void p4_attention(const Ctx& C0, int sub) {
    PHASE_IDS();
    __syncthreads();
    build_bias_tables(C);
    float lam;
    { const float a = wave_sum(C.in[7][C.lane] * C.in[8][C.lane]), b2 = wave_sum(C.in[9][C.lane] * C.in[10][C.lane]); lam = expf(a) - expf(b2) + 0.2f; }
    __syncthreads();
#if SIMPLE_DIFF
    if (sub & 1) for (int p = blockIdx.x; p < 256; p += C.G) { const int bh = p >> 5, qa = p & 31;
        diff_unit(C, bh >> 2, bh & 3, qa, lam); diff_unit(C, bh >> 2, bh & 3, 63 - qa, lam); }
#else
    if (sub & 1) for (int v = C.vcu; v < 256; v += C.G) { const int bvh = v >> 3, s = v & 7, b = bvh >> 4, vh = bvh & 15, h = vh >> 2, mp = (vh >> 1) & 1, vhf = vh & 1;
        const attn_body::bf16* qk = (const attn_body::bf16*)WSP(const bf16_t, WS_PROJ); const attn_body::bf16* vv = (const attn_body::bf16*)WSP(const bf16_t, WS_PROJ + PROJ_STRIDE);
        attn_body::bf16* oa = (attn_body::bf16*)WSP(bf16_t, WS_OA);
        const LAS float* bth = (const LAS float*)(C.lds + AT_BT) + h * BT_STR;
#pragma unroll 1
        for (int i = 0; i < 4; ++i) { const int qb = (i == 0) ? s : (i == 1) ? 15 - s : (i == 2) ? 16 + s : 31 - s;
            attn_body::attn_unit<8>(b, qb, qk, qk, vv, oa, h * 128 + mp * 64, 512 + h * 128 + mp * 64, h * 128 + vhf * 64, mp * 512 + h * 128 + vhf * 64, bth, C.ldsg); } }
#endif
    LAS int* pre = (LAS int*)(C.lds + AT_MISC);
    LAS int* wtot = pre + 1032;
    const unsigned* cnt = WSP(const unsigned, WS_CTL) + CW_MCNT;
    __syncthreads();
    { const int L = 2 * C.tid; const int n0_ = ((int)__hip_atomic_load(cnt + L, RLX_AGENT) + 127) >> 7, n1_ = ((int)__hip_atomic_load(cnt + L + 1, RLX_AGENT) + 127) >> 7; const int nch = n0_ + n1_;
        int inc = nch;
#pragma unroll
        for (int o = 1; o < 64; o <<= 1) { const int t = __shfl_up(inc, o); if (C.lane >= o) inc += t; }
        if (C.lane == 63) wtot[C.wave] = inc;
        __syncthreads();
        int base = 0;
        for (int w = 0; w < C.wave; ++w) base += wtot[w];
        pre[L] = base + inc - nch; pre[L + 1] = base + inc - nch + n0_;
        if (C.tid == 511) pre[1024] = base + inc;
    }
    __syncthreads();
    if (sub & 2) moba_phase(C, pre, cnt, sub >> 2);
    __syncthreads();
}
__device__ __forceinline__ void p5_ycombine(const Ctx& C0) {
    PHASE_IDS();
    const int gw = C.vcu * NWAVES + C.wave, NGW = C.G * NWAVES;
    const bf16_t* po = WSP(const bf16_t, WS_PO); const float* pml = WSP(const float, WS_PML); bf16_t* y = WSP(bf16_t, WS_Y);
#if !SIMPLE_DIFF
    {
        const float lam = expf(wave_sum(C.in[7][C.lane] * C.in[8][C.lane])) - expf(wave_sum(C.in[9][C.lane] * C.in[10][C.lane])) + 0.2f;
        const bf16_t* oa = WSP(const bf16_t, WS_OA);
        const f32x4 g0 = *(const f32x4*)(C.in[11] + 8 * (C.lane & 15)), g1 = *(const f32x4*)(C.in[11] + 8 * (C.lane & 15) + 4);
        for (int m = gw; m < M; m += NGW) { const u32x4 a = *(const u32x4*)(oa + (size_t)m * 1024 + 8 * C.lane), b2 = *(const u32x4*)(oa + (size_t)m * 1024 + 512 + 8 * C.lane);
            float v[8];
            v[0] = bf_lo(a.x) - lam * bf_lo(b2.x); v[1] = bf_hi(a.x) - lam * bf_hi(b2.x); v[2] = bf_lo(a.y) - lam * bf_lo(b2.y); v[3] = bf_hi(a.y) - lam * bf_hi(b2.y);
            v[4] = bf_lo(a.z) - lam * bf_lo(b2.z); v[5] = bf_hi(a.z) - lam * bf_hi(b2.z); v[6] = bf_lo(a.w) - lam * bf_lo(b2.w); v[7] = bf_hi(a.w) - lam * bf_hi(b2.w);
            float ss = 0.f;
#pragma unroll
            for (int k = 0; k < 8; ++k) ss += v[k] * v[k];
            ss += __shfl_xor(ss, 1); ss += __shfl_xor(ss, 2); ss += __shfl_xor(ss, 4); ss += __shfl_xor(ss, 8);
            const float r = 0.8f / sqrtf(ss * (1.0f / 128.0f) + RMS_EPS);
            u32x4 w; w.x = pk2(v[0] * r * g0[0], v[1] * r * g0[1]); w.y = pk2(v[2] * r * g0[2], v[3] * r * g0[3]); w.z = pk2(v[4] * r * g1[0], v[5] * r * g1[1]); w.w = pk2(v[6] * r * g1[2], v[7] * r * g1[3]);
            *(u32x4*)(y + (size_t)m * 1024 + 8 * C.lane) = w; }
    }
#endif
    for (int m = gw; m < M; m += NGW) { const int h = C.lane >> 3, dch = C.lane & 7; const int own = (m & (SEQ - 1)) >> 8, nsel = own < 3 ? own : 3;
        const size_t s0 = ((size_t)m * 8 + h) * 4;
        float mm[4], ll[4]; u32x4 ov[4];
#pragma unroll
        for (int j = 0; j < 4; ++j) { const bool use = (j == 3) || (j < nsel);
            if (use) { const f32x2 ml = *(const f32x2*)(pml + (s0 + j) * 2); mm[j] = ml[0]; ll[j] = ml[1]; ov[j] = *(const u32x4*)(po + (s0 + j) * 64 + 8 * dch); }
            else { mm[j] = -INFINITY; ll[j] = 0.f; ov[j] = (u32x4){0u, 0u, 0u, 0u}; } }
        const float mx = fmaxf(fmaxf(mm[0], mm[1]), fmaxf(mm[2], mm[3]));
        float den = 0.f; float acc[8];
#pragma unroll
        for (int k = 0; k < 8; ++k) acc[k] = 0.f;
#pragma unroll
        for (int j = 0; j < 4; ++j) { const float w = __builtin_amdgcn_exp2f(mm[j] - mx); den += w * ll[j];
            acc[0] += w * bf_lo(ov[j].x); acc[1] += w * bf_hi(ov[j].x); acc[2] += w * bf_lo(ov[j].y); acc[3] += w * bf_hi(ov[j].y);
            acc[4] += w * bf_lo(ov[j].z); acc[5] += w * bf_hi(ov[j].z); acc[6] += w * bf_lo(ov[j].w); acc[7] += w * bf_hi(ov[j].w); }
        const float r = 1.0f / den;
        u32x4 w; w.x = pk2(acc[0] * r, acc[1] * r); w.y = pk2(acc[2] * r, acc[3] * r); w.z = pk2(acc[4] * r, acc[5] * r); w.w = pk2(acc[6] * r, acc[7] * r);
        *(u32x4*)(y + (size_t)m * 1024 + 512 + h * 64 + 8 * dch) = w; }
}
__device__ __forceinline__ void p8_router(const Ctx& C0) {
    PHASE_IDS();
    LAS float* MA = (LAS float*)C.lds; LAS float* MB = MA + 2048;
    LAS int* hist = (LAS int*)(C.lds + 16384);
    for (int idx = C.tid; idx < 2048; idx += 512) { const int b = idx >> 10, col = idx & 1023; const float* af = WSP(const float, WS_ADAF) + b * 6144;
        MA[idx] = C.in[15][col] * (1.0f + af[4096 + col]); MB[idx] = af[3072 + col]; }
    if (C.tid < 32) hist[C.tid] = 0;
    __syncthreads();
    bf16_t* h2 = WSP(bf16_t, WS_H);
    for (int blk = blockIdx.x; blk < M / 64; blk += C.G) {
        const int r0 = 64 * blk, b = r0 >= SEQ;
        for (int r = 0; r < 8; ++r) { const int m = r0 + 8 * C.wave + r; rms_mod_row(WSP(const float, WS_X1) + (size_t)m * D, h2 + (size_t)m * D, MA + b * 1024, MB + b * 1024, C.lane); }
        VM_WAIT(); __syncthreads();
        if (C.wave < 4) { const int lane = C.lane, c = lane & 15, g = lane >> 4; const int rb = r0 + 16 * C.wave;
            f32x4 lg[2]; lg[0] = (f32x4){0.f, 0.f, 0.f, 0.f}; lg[1] = lg[0];
            const bf16_t* ar = h2 + (size_t)(rb + c) * D + 8 * g; const float* wr = C.in[16];
            for (int ks = 0; ks < 32; ++ks) { const bf16x8 a = *(const bf16x8*)(ar + 32 * ks);
#pragma unroll
                for (int nt = 0; nt < 2; ++nt) { const float* wp = wr + (size_t)(32 * ks + 8 * g) * 32 + 16 * nt + c; u32x4 w;
                    w.x = pk2(wp[0], wp[32]); w.y = pk2(wp[64], wp[96]); w.z = pk2(wp[128], wp[160]); w.w = pk2(wp[192], wp[224]);
                    lg[nt] = __builtin_amdgcn_mfma_f32_16x16x32_bf16(a, __builtin_bit_cast(bf16x8, w), lg[nt], 0, 0, 0); } }
            const float br0 = C.in[17][c], br1 = C.in[17][16 + c];
#pragma unroll
            for (int i = 0; i < 4; ++i) { float a0 = lg[0][i] + br0, a1 = lg[1][i] + br1; float tv[4]; int ti[4];
#pragma unroll
                for (int k = 0; k < 4; ++k) { float bv; int bi; if (a1 > a0) { bv = a1; bi = 16 + c; } else { bv = a0; bi = c; }
#pragma unroll
                    for (int o = 1; o < 16; o <<= 1) { const float ov = __shfl_xor(bv, o); const int oi = __shfl_xor(bi, o); if (ov > bv || (ov == bv && oi < bi)) { bv = ov; bi = oi; } }
                    tv[k] = bv; ti[k] = bi; if (bi == c) a0 = -INFINITY; if (bi == 16 + c) a1 = -INFINITY; }
                if (c == 0) { const int row = rb + 4 * g + i; const float e1 = __expf(tv[1] - tv[0]), e2 = __expf(tv[2] - tv[0]), e3 = __expf(tv[3] - tv[0]); const float inv = 1.0f / (1.0f + e1 + e2 + e3);
                    *(int4*)(WSP(int, WS_TOPI) + (size_t)row * 4) = make_int4(ti[0], ti[1], ti[2], ti[3]);
                    *(f32x4*)(WSP(float, WS_TOPW) + (size_t)row * 4) = (f32x4){inv, e1 * inv, e2 * inv, e3 * inv};
                    atomicAdd((int*)(hist + ti[0]), 1); atomicAdd((int*)(hist + ti[1]), 1); atomicAdd((int*)(hist + ti[2]), 1); atomicAdd((int*)(hist + ti[3]), 1); } }
        }
        __syncthreads();
        if (C.tid < 32) { WSP(int, WS_HIST)[blk * 32 + C.tid] = hist[C.tid]; hist[C.tid] = 0; }
        __syncthreads();
    }
}
__device__ __forceinline__ void p9_slots(const Ctx& C0) {
    PHASE_IDS();
    LAS int* tot = (LAS int*)C.lds;
    LAS int* off = tot + 32;
    LAS int* cur = off + 40;
    const int* hist = WSP(const int, WS_HIST);
    for (int blk = blockIdx.x; blk < M / 64; blk += C.G) {
        __syncthreads();
        if (C.tid < 32) { int t = 0, p = 0; for (int w = 0; w < M / 64; ++w) { const int v = hist[w * 32 + C.tid]; t += v; p += (w < blk) ? v : 0; } tot[C.tid] = t; cur[C.tid] = p; }
        __syncthreads();
        if (C.tid == 0) { int o = 0; for (int e = 0; e < 32; ++e) { off[e] = o; o += (tot[e] + 255) & ~255; } off[32] = o; }
        __syncthreads();
        if (C.tid < 32) cur[C.tid] += off[C.tid];
        __syncthreads();
        if (C.tid < 256) { const int token = 64 * blk + (C.tid >> 2), k = C.tid & 3; const int e = WSP(const int, WS_TOPI)[token * 4 + k];
            const int slot = atomicAdd((int*)(cur + e), 1);
            WSP(int, WS_SLOTTOK)[slot] = token; WSP(float, WS_SLOTW)[slot] = WSP(const float, WS_TOPW)[token * 4 + k]; WSP(int, WS_TOKSLOT)[token * 4 + k] = slot; }
        if (blk < 32) { const int e = blk; for (int s = off[e] + tot[e] + C.tid; s < off[e + 1]; s += 512) { WSP(int, WS_SLOTTOK)[s] = 0; WSP(float, WS_SLOTW)[s] = 0.f; } }
        if (blk == 0 && C.tid < 33) WSP(int, WS_EOFF)[C.tid] = off[C.tid];
    }
    __syncthreads();
}
__device__ __forceinline__ void p12_final(const Ctx& C0) {
    PHASE_IDS();
    const int gw = C.vcu * NWAVES + C.wave, NGW = C.G * NWAVES;
    const bf16_t* so = WSP(const bf16_t, WS_SOUT); const float* x1 = WSP(const float, WS_X1); const int* ts = WSP(const int, WS_TOKSLOT);
    for (int m = gw; m < M; m += NGW) { const float* gt = WSP(const float, WS_ADAF) + (m >= SEQ ? 6144 : 0) + 5120;
        const int4 sl = *(const int4*)(ts + (size_t)m * 4);
        f32x4 v[4]; float s = 0.f;
#pragma unroll
        for (int j = 0; j < 4; ++j) { const int col = 4 * C.lane + 256 * j; f32x4 a = (f32x4){0.f, 0.f, 0.f, 0.f};
            { const u32x2 w = *(const u32x2*)(so + (size_t)sl.x * 1024 + col); a[0] += bf_lo(w.x); a[1] += bf_hi(w.x); a[2] += bf_lo(w.y); a[3] += bf_hi(w.y); }
            { const u32x2 w = *(const u32x2*)(so + (size_t)sl.y * 1024 + col); a[0] += bf_lo(w.x); a[1] += bf_hi(w.x); a[2] += bf_lo(w.y); a[3] += bf_hi(w.y); }
            { const u32x2 w = *(const u32x2*)(so + (size_t)sl.z * 1024 + col); a[0] += bf_lo(w.x); a[1] += bf_hi(w.x); a[2] += bf_lo(w.y); a[3] += bf_hi(w.y); }
            { const u32x2 w = *(const u32x2*)(so + (size_t)sl.w * 1024 + col); a[0] += bf_lo(w.x); a[1] += bf_hi(w.x); a[2] += bf_lo(w.y); a[3] += bf_hi(w.y); }
            v[j] = *(const f32x4*)(x1 + (size_t)m * D + col) + *(const f32x4*)(gt + col) * a;
            s += (v[j][0] * v[j][0] + v[j][1] * v[j][1]) + (v[j][2] * v[j][2] + v[j][3] * v[j][3]); }
        const float rstd = 1.0f / sqrtf(wave_sum(s) * (1.0f / D) + RMS_EPS);
#pragma unroll
        for (int j = 0; j < 4; ++j) { const int col = 4 * C.lane + 256 * j; *(f32x4*)(C.out + (size_t)m * D + col) = v[j] * rstd * *(const f32x4*)(C.in[22] + col); } }
}
struct Args { const float* in[23]; float* out; unsigned char* ws; int ph_lo, ph_hi, li, pad; };
constexpr int N_PHASES = 13;
#ifndef MK_N_LAUNCHES
#define MK_N_LAUNCHES 1
#endif

__global__ void __launch_bounds__(NWAVES * 64, 2) mega_fwd(Args args) {
    extern __shared__ __attribute__((aligned(16))) unsigned char lds_raw[];
    Ctx C;
    C.lds = (LAS unsigned char*)lds_raw; C.ldsg = (char*)lds_raw;
    C.tid = threadIdx.x; C.lane = C.tid & 63; C.wave = __builtin_amdgcn_readfirstlane(C.tid >> 6);
    C.G = gridDim.x; { const int bx = blockIdx.x; C.vcu = (C.G % 8 == 0) ? (bx % 8) * (C.G / 8) + bx / 8 : bx; }
#pragma unroll
    for (int i = 0; i < 23; ++i) C.in[i] = args.in[i];
    C.out = args.out; C.ws = args.ws;
    volatile LAS unsigned* MISC = (volatile LAS unsigned*)(C.lds + MISC_OFF);
    for (int u = C.tid; u < (LDS_BYTES - LDSCTL_OFF) / 4; u += NWAVES * 64) ((LAS unsigned*)(C.lds + LDSCTL_OFF))[u] = 0u;
    __syncthreads();
    unsigned* ctl = (unsigned*)(C.ws + WS_CTL);
    XcdBarrier bar = xcd_barrier_post(ctl + CW_BAR + args.li * XCD_BAR_WORDS, MISC + 8);
    const int lo = args.ph_lo, hi = args.ph_hi;
#define IN(k) (lo <= (k) && (k) < hi)
#define SEAM(k) do { if (IN(k) && IN((k) + 1)) xcd_barrier(bar); } while (0)
#ifndef PROBE_REP
#define PROBE_REP -1
#endif
#define REPS(k) (((k) == PROBE_REP) ? 2 : 1)
#define DUP(k, ...) do { __VA_ARGS__; if (REPS(k) == 2) { __VA_ARGS__; } } while (0)

    if (IN(0)) { DUP(0, p0_prologue(C)); } SEAM(0);
    if (IN(1)) { DUP(30, p1_h1(C)); } SEAM(1);
    if (IN(2)) { pg8::DenseSched S; S.init(M, INW, C.G, (int)blockIdx.x, WSP(bf16_t, WS_WIN), 1024); pg8::EpiProj E{WSP(bf16_t, WS_PROJ), WSP(float, WS_KMEAN)};
        DUP(2, pg8::gemm_phase<pg8::EpiProj, pg8::DenseSched, true>(C.lds, WSP(bf16_t, WS_H), 1024, 1024, 1024, S, E)); } SEAM(2);
    if (IN(4)) { p3b_gate(C); } SEAM(4);
    if (IN(5)) { p4_attention(C, 3 | (3 << 2)); if (REPS(5) == 2) p4_attention(C, PROBE_SUB); } SEAM(5);
    if (IN(6)) { DUP(30, p5_ycombine(C)); } SEAM(6);
    if (IN(7)) { pg8::DenseSched S; S.init(M, D, C.G, (int)blockIdx.x, WSP(bf16_t, WS_WBR), 1024); pg8::EpiBr E{WSP(const bf16_t, WS_PROJ + 3 * PROJ_STRIDE), WSP(const bf16_t, WS_PROJ + 4 * PROJ_STRIDE), WSP(bf16_t, WS_MERGED)};
        DUP(31, pg8::gemm_phase<pg8::EpiBr, pg8::DenseSched, true>(C.lds, WSP(bf16_t, WS_Y), 1024, 1024, 1024, S, E)); } SEAM(7);
    if (IN(9)) { pg8::DenseSched S; S.init(M, D, C.G, (int)blockIdx.x, WSP(bf16_t, WS_WOUT), 1024); pg8::EpiOut E{C.in[0], WSP(const float, WS_ADAF), WSP(float, WS_X1)};
        DUP(32, pg8::gemm_phase<pg8::EpiOut, pg8::DenseSched, true>(C.lds, WSP(bf16_t, WS_MERGED), 1024, 1024, 1024, S, E)); } SEAM(9);
    if (IN(10)) { DUP(30, p8_router(C)); } SEAM(10);
    if (IN(11)) { DUP(33, p9_slots(C)); } SEAM(11);
    if (IN(12)) {
        LAS int* te = (LAS int*)(C.lds + RING_BYTES + 64);
        if (C.tid < 33) te[C.tid] = WSP(const int, WS_EOFF)[C.tid] >> 8;
        __syncthreads();
        { pg8::MoeSched<true> S{te, 8, C.G, (int)blockIdx.x, WSP(const int, WS_SLOTTOK), (const char*)WSP(bf16_t, WS_WGU), (size_t)2048 * 1024 * 2, (size_t)256 * 1024 * 2};
          pg8::EpiGU E{C.in[19], WSP(bf16_t, WS_ACT)};
          DUP(20, pg8::gemm_phase<pg8::EpiGU, pg8::MoeSched<true>, true>(C.lds, WSP(bf16_t, WS_H), 1024, 1024, 1024, S, E)); }
        xcd_barrier(bar);
        { pg8::MoeSched<false> S{te, 4, C.G, (int)blockIdx.x, nullptr, (const char*)WSP(bf16_t, WS_WD), (size_t)1024 * 1024 * 2, (size_t)256 * 1024 * 2};
          pg8::EpiDown E{C.in[21], WSP(const float, WS_SLOTW), WSP(bf16_t, WS_SOUT)};
          DUP(21, pg8::gemm_phase<pg8::EpiDown, pg8::MoeSched<false>, true>(C.lds, WSP(bf16_t, WS_ACT), 1024, 1024, 1024, S, E)); }
        xcd_barrier(bar);
        DUP(30, p12_final(C));
    }
#undef IN
#undef SEAM
}

extern "C" void kernel_launch(void* const* d_in, const int* in_sizes, int n_in, void* d_out, int out_size, void* d_ws, size_t ws_size, hipStream_t stream) {
    static int grid = 0;
    if (grid == 0) {
        if (n_in != 23 || in_sizes[0] != M * D || out_size != M * D || ws_size < WS_END) { fprintf(stderr, "kernel_launch: unexpected shapes (n_in %d, in0 %d, out %d, ws %zu); nothing launched\n", n_in, n_in > 0 ? in_sizes[0] : -1, out_size, ws_size); grid = -1; return; }
        int dev = 0, cus = 0, per_cu = 0;
        if (hipGetDevice(&dev) != hipSuccess || hipDeviceGetAttribute(&cus, hipDeviceAttributeMultiprocessorCount, dev) != hipSuccess) { grid = -1; return; }
        if (hipFuncSetAttribute((const void*)mega_fwd, hipFuncAttributeMaxDynamicSharedMemorySize, LDS_BYTES) != hipSuccess) { fprintf(stderr, "kernel_launch: hipFuncSetAttribute failed\n"); grid = -1; return; }
        if (hipOccupancyMaxActiveBlocksPerMultiprocessor(&per_cu, (const void*)mega_fwd, NWAVES * 64, LDS_BYTES) != hipSuccess || per_cu < 1) { fprintf(stderr, "kernel_launch: occupancy query reports %d workgroups per CU\n", per_cu); }
        (void)hipGetLastError();
        grid = cus;
    }
    if (grid < 0) return;
    if (hipMemsetAsync((char*)d_ws + WS_CTL, 0, CTL_ZERO_BYTES, stream) != hipSuccess) { fprintf(stderr, "kernel_launch: memset failed\n"); return; }
    Args a{};
    for (int i = 0; i < 23; ++i) a.in[i] = (const float*)d_in[i];
    a.out = (float*)d_out; a.ws = (unsigned char*)d_ws;
    constexpr int NL = MK_N_LAUNCHES;
    for (int li = 0; li < NL; ++li) {
        a.ph_lo = (NL == 1) ? 0 : li; a.ph_hi = (NL == 1) ? N_PHASES : li + 1; a.li = (NL == 1) ? 0 : li; a.pad = 0;
        hipLaunchKernelGGL(mega_fwd, dim3(grid), dim3(NWAVES * 64), LDS_BYTES, stream, a);
        const hipError_t le = hipPeekAtLastError();
        if (le != hipSuccess) { fprintf(stderr, "kernel_launch: launch %d failed: %s\n", li, hipGetErrorName(le)); break; }
    }
}
```

```cpp
#include <hip/hip_runtime.h>
#include <cstdio>
#include <cstdint>
#ifndef SIMPLE_DIFF
#define SIMPLE_DIFF 0
#endif
#ifndef NATIVE_DIFF
#define NATIVE_DIFF 1
#endif

#define GAS __attribute__((address_space(1)))
#define LAS __attribute__((address_space(3)))
typedef unsigned short bf16_t;
typedef short bf16x8 __attribute__((ext_vector_type(8)));
typedef short s16x4 __attribute__((ext_vector_type(4)));
typedef float f32x4 __attribute__((ext_vector_type(4)));
typedef float f32x2 __attribute__((ext_vector_type(2)));
typedef unsigned u32x4 __attribute__((ext_vector_type(4)));
typedef unsigned u32x2 __attribute__((ext_vector_type(2)));
typedef int i32x4 __attribute__((ext_vector_type(4)));
#define RLX_AGENT __ATOMIC_RELAXED, __HIP_MEMORY_SCOPE_AGENT
#define LDS_WAIT() asm volatile("s_waitcnt lgkmcnt(0)" ::: "memory")
#define VM_WAIT() asm volatile("s_waitcnt vmcnt(0)" ::: "memory")

constexpr int BATCH = 2, SEQ = 8192, M = BATCH * SEQ, D = 1024, INW = 5120;
constexpr int NE = 32, TOPK = 4;
constexpr int NWAVES = 8;
constexpr float RMS_EPS = 1e-5f;
constexpr float LOG2E = 1.4426950408889634f;
constexpr float C2 = 0.125f * LOG2E;
constexpr int SLOT_ROWS = M * TOPK + NE * 256;

constexpr size_t MiB = 1u << 20, KiB = 1u << 10;
constexpr size_t WS_CTL = 0, CTL_ZERO_BYTES = 1 * MiB;
constexpr size_t WS_ADAP = 1 * MiB;
constexpr size_t WS_ADAF = 1 * MiB + 896 * KiB;
constexpr size_t WS_KMEAN = 512 * KiB;
constexpr size_t WS_TOPI = 2 * MiB + 256 * KiB;
constexpr size_t WS_TOPW = 2 * MiB + 512 * KiB;
constexpr size_t WS_TOKSLOT = 2 * MiB + 768 * KiB;
constexpr size_t WS_SLOTTOK = 3 * MiB;
constexpr size_t WS_SLOTW = 3 * MiB + 512 * KiB;
constexpr size_t WS_HIST = 4 * MiB;
constexpr size_t WS_EOFF = 4 * MiB + 64 * KiB;
constexpr size_t WS_WRT = 4 * MiB + 128 * KiB;
constexpr size_t WS_SLOTSA = 4 * MiB + 256 * KiB;
constexpr size_t WS_SW = 5 * MiB;
constexpr size_t WS_SWIN = 5 * MiB + 640 * KiB;
constexpr size_t WS_SA = 5 * MiB + 512 * KiB;
constexpr size_t WS_LIST = 6 * MiB;
constexpr size_t WS_PML = 14 * MiB;
constexpr size_t WS_WIN = 18 * MiB, WS_WBR = 28 * MiB, WS_WOUT = 30 * MiB, WS_WGU = 32 * MiB, WS_WD = 160 * MiB;
constexpr size_t WS_H = 224 * MiB;
constexpr size_t WS_PROJ = 256 * MiB;
constexpr size_t PROJ_STRIDE = 32 * MiB;
constexpr size_t WS_Y = 416 * MiB;
constexpr size_t WS_PO = 448 * MiB;
constexpr size_t WS_H2Q = 512 * MiB;
constexpr size_t WS_MERGED = 576 * MiB;
constexpr size_t WS_X1 = 608 * MiB;
constexpr size_t WS_ACT = 672 * MiB;
constexpr size_t WS_SOUT = 816 * MiB;
constexpr size_t WS_OA = 960 * MiB;
constexpr size_t WS_WINQ = 992 * MiB;
constexpr size_t WS_END = 1000 * MiB;
constexpr int LIST_PER_BH = 126976;
constexpr int CW_TMO = 0, CW_CODE = 1, CW_BAR = 4096, CW_MCNT = 65536, CW_TDONE = 80000, CW_AQ = 110000, CW_GDONE = 121000;

constexpr int RING_BYTES = 131072, LDSCTL_OFF = RING_BYTES, MISC_OFF = LDSCTL_OFF + 320, LDS_BYTES = 163840;

__device__ __forceinline__ unsigned f2bf(float f) { unsigned u = __builtin_bit_cast(unsigned, f); return (u + 0x7fffu + ((u >> 16) & 1u)) >> 16; }
__device__ __forceinline__ unsigned pk2(float lo, float hi) { return f2bf(lo) | (f2bf(hi) << 16); }
__device__ __forceinline__ unsigned cvt_pk_bf16(float lo, float hi) { unsigned r; asm volatile("v_cvt_pk_bf16_f32 %0, %1, %2" : "=v"(r) : "v"(lo), "v"(hi)); return r; }
__device__ __forceinline__ float bf_lo(unsigned u) { return __builtin_bit_cast(float, u << 16); }
__device__ __forceinline__ float bf_hi(unsigned u) { return __builtin_bit_cast(float, u & 0xffff0000u); }
__device__ __forceinline__ float sigmoidf_fast(float v) { return __builtin_amdgcn_rcpf(1.0f + __builtin_amdgcn_exp2f(-v * LOG2E)); }
__device__ __forceinline__ float wave_sum(float v) {
#pragma unroll
    for (int o = 1; o < 64; o <<= 1) v += __shfl_xor(v, o);
    return v;
}

namespace pg8 {
constexpr int BM = 256, BK = 64, HALF = 128, HTB = HALF * BK * 2, STAGE_BYTES = 8 * HTB, NXCD = 8, WGM = 8;
__device__ __forceinline__ int lds_byte(int r, int c) { const int st = (r >> 4) * 2 + (c >> 5), rr = r & 15, cc = c & 31, ob = rr * 64 + cc * 2; return st * 1024 + (ob ^ (((ob >> 9) & 1) << 5)); }
__device__ __forceinline__ void stage_rc(int b, int& R, int& C) { const int st = b / 1024, sb = b % 1024, swz = sb ^ (((sb >> 9) & 1) << 5); R = (st >> 1) * 16 + swz / 64; C = (st & 1) * 32 + (swz % 64) / 2; }
__device__ __forceinline__ int perm32(int rho) { const int n = rho >> 4, i = rho & 15; return 8 * (i >> 2) + 4 * n + (i & 3); }

struct Unit { int row0; int pm, pn, e, half; const char* bptr; };

struct DenseSched {
    static constexpr bool HAS_READY = false, HAS_DONE = false;
    int nM, nN, nwg, G, c; const char* Bt; size_t btile;
    int pn_base = 0, pn_skip_at = 1 << 30, pn_skip = 0;
    __device__ __forceinline__ void init(int M_, int N_, int G_, int c_, const void* Bt_, int ldb) { nM = M_ / BM; nN = N_ / BM; nwg = nM * nN; G = G_; c = c_; Bt = (const char*)Bt_; btile = (size_t)BM * ldb * 2; }
    __device__ __forceinline__ bool next(int i, Unit& u) const {
        const long L = (long)i * G + c; if (L >= nwg) return false;
        int wgid = (int)L; { const int q = nwg / NXCD, r = nwg % NXCD, xcd = wgid % NXCD, off = wgid / NXCD; wgid = (xcd < r ? xcd * (q + 1) : r * (q + 1) + (xcd - r) * q) + off; }
        const int nig = WGM * nN, gid = wgid / nig, fm = gid * WGM, gsz = (nM - fm) < WGM ? (nM - fm) : WGM;
        u.pm = fm + ((wgid % nig) % gsz); { const int pl = (wgid % nig) / gsz; u.pn = pn_base + pl + (pl >= pn_skip_at ? pn_skip : 0); } u.row0 = u.pm * BM; u.e = 0; u.half = 0; u.bptr = Bt + (size_t)u.pn * btile; return true;
    }
    __device__ __forceinline__ int arow(const Unit& u, int r) const { return u.row0 + r; }
    __device__ __forceinline__ void a_ready(const Unit&) const {}
    __device__ __forceinline__ void done(int) const {}
};

template <bool I8> struct AccSel { typedef f32x4 T; };
template <> struct AccSel<true> { typedef i32x4 T; };
template <class Epi, class Sched, bool ALIGN_EPI, bool I8 = false>
__device__ __forceinline__ void gemm_phase(LAS unsigned char* lds, const void* Abase_, int lda, int ldb, int K, const Sched& S, const Epi& E) {
    int tid_ = threadIdx.x; asm volatile("" : "+v"(tid_));
    const int tid = tid_, wid = __builtin_amdgcn_readfirstlane(tid >> 6), lane = tid & 63, wr = wid >> 2, wc = wid & 3, fr = lane & 15, fq = lane >> 4;
    const int nt = K / BK;
    const char* Abase = (const char*)Abase_;
    int Rr[2], Cc[2]; unsigned voffB[2];
#pragma unroll
    for (int i = 0; i < 2; ++i) { stage_rc(tid * 16 + i * 8192, Rr[i], Cc[i]); const int Rb = Epi::PERM ? ((Rr[i] & ~31) + perm32(Rr[i] & 31)) : Rr[i]; voffB[i] = (unsigned)(Rb * ldb + Cc[i]) * 2u; }
    const size_t kstep = (size_t)(BK * 2);
    const size_t hstepB = (size_t)HALF * ldb * 2;
    const unsigned ldsw = (unsigned)wid * 1024u;
    const int aoff = lds_byte(wr * 64 + fr, fq * 8), boff = lds_byte(wc * 32 + fr, fq * 8);
#define PG8_SA(b, h) (((b) * 2 + (h)) * HTB)
#define PG8_SB(b, h) ((4 + (b) * 2 + (h)) * HTB)
#define PG8_STAGE(bufoff, gbase, voff) do { _Pragma("unroll") for (int _i = 0; _i < 2; ++_i) \
        __builtin_amdgcn_global_load_lds((const unsigned*)((const char*)(gbase) + (voff)[_i]), (LAS unsigned*)(lds + (bufoff) + ldsw + _i * 8192), 16, 0, 0); } while (0)
#define PG8_LDA(dst, b, h) do { _Pragma("unroll") for (int m = 0; m < 4; ++m) _Pragma("unroll") for (int k = 0; k < 2; ++k) dst[m][k] = *(const LAS bf16x8*)(lds + PG8_SA(b, h) + aoff + m * 2048 + k * 1024); } while (0)
#define PG8_LDB(dst, b, h) do { _Pragma("unroll") for (int n = 0; n < 2; ++n) _Pragma("unroll") for (int k = 0; k < 2; ++k) dst[n][k] = *(const LAS bf16x8*)(lds + PG8_SB(b, h) + boff + n * 2048 + k * 1024); } while (0)
#define PG8_MMA(ai, bj, At, Bt) do { __builtin_amdgcn_s_setprio(1); _Pragma("unroll") for (int m = 0; m < 4; ++m) _Pragma("unroll") for (int n = 0; n < 2; ++n) _Pragma("unroll") for (int k = 0; k < 2; ++k) { \
        if constexpr (I8) acc[ai][bj][m][n] = __builtin_amdgcn_mfma_i32_16x16x64_i8(__builtin_bit_cast(i32x4, Bt[n][k]), __builtin_bit_cast(i32x4, At[m][k]), acc[ai][bj][m][n], 0, 0, 0); \
        else acc[ai][bj][m][n] = __builtin_amdgcn_mfma_f32_16x16x32_bf16(Bt[n][k], At[m][k], acc[ai][bj][m][n], 0, 0, 0); } __builtin_amdgcn_s_setprio(0); } while (0)
#define PG8_WAIT_V(n) asm volatile("s_waitcnt vmcnt(" #n ")" ::: "memory")
#define PG8_WAIT_L(n) asm volatile("s_waitcnt lgkmcnt(" #n ")" ::: "memory")
#define PG8_BAR __builtin_amdgcn_s_barrier()
#define PG8_SCHED __builtin_amdgcn_sched_barrier(0)
#define PG8_ROWS(u, va) do { _Pragma("unroll") for (int _h = 0; _h < 2; ++_h) _Pragma("unroll") for (int _i = 0; _i < 2; ++_i) \
        va[_h][_i] = (unsigned)(S.arow(u, _h * HALF + Rr[_i]) * lda + Cc[_i]) * 2u; } while (0)
    Unit cur, nxt; int ui = 0; int prev_pm = -1;
    if (!S.next(0, cur)) return;
    unsigned vaC[2][2], vaN[2][2];
    PG8_ROWS(cur, vaC);
    typedef typename AccSel<I8>::T acc_t;
    acc_t acc[2][2][4][2];
#pragma unroll
    for (int a = 0; a < 2; ++a)
#pragma unroll
        for (int b = 0; b < 2; ++b)
#pragma unroll
            for (int m = 0; m < 4; ++m)
#pragma unroll
                for (int n = 0; n < 2; ++n) acc[a][b][m][n] = (acc_t){0, 0, 0, 0};
    bf16x8 At[4][2], B0[2][2], B1[2][2];
    const char* cB = cur.bptr;
    if constexpr (Sched::HAS_READY) S.a_ready(cur);
    PG8_STAGE(PG8_SB(0, 0), cB, voffB); PG8_STAGE(PG8_SB(0, 1), cB + hstepB, voffB); PG8_STAGE(PG8_SA(0, 0), Abase, vaC[0]); PG8_STAGE(PG8_SA(0, 1), Abase, vaC[1]);
    if (wr == 1) PG8_BAR;
    PG8_WAIT_V(2); PG8_BAR;
    PG8_STAGE(PG8_SB(1, 0), cB + kstep, voffB); PG8_STAGE(PG8_SA(1, 0), Abase + kstep, vaC[0]); PG8_STAGE(PG8_SB(1, 1), cB + hstepB + kstep, voffB);
    PG8_WAIT_V(6); PG8_BAR;
    for (;;) {
        const bool has_next = S.next(ui + 1, nxt);
        if (has_next) { PG8_ROWS(nxt, vaN); } else { nxt = cur;
#pragma unroll
            for (int h = 0; h < 2; ++h)
#pragma unroll
                for (int i = 0; i < 2; ++i) vaN[h][i] = vaC[h][i]; }
        const char* nB = nxt.bptr;
        for (int t = 0; t < nt; t += 2) {
            if constexpr (Epi::HAS_MID) { if (t == (nt >> 1)) E.mid(acc, cur, wr, wc, fr, fq); }
            const bool last = (t == nt - 2);
            if constexpr (Sched::HAS_DONE) { if (last && prev_pm >= 0) { S.done(prev_pm); prev_pm = -1; } }
            if constexpr (Sched::HAS_READY) { if (last && has_next) S.a_ready(nxt); }
            const char* a1 = Abase + (size_t)(t + 1) * kstep;
            const char* a2 = last ? Abase : Abase + (size_t)(t + 2) * kstep; const char* b2 = last ? nB : cB + (size_t)(t + 2) * kstep;
            const char* a3 = a2 + kstep; const char* b3 = b2 + kstep;
            unsigned v2[2][2];
#pragma unroll
            for (int h = 0; h < 2; ++h)
#pragma unroll
                for (int i = 0; i < 2; ++i) v2[h][i] = last ? vaN[h][i] : vaC[h][i];
            PG8_LDB(B0, 0, 0); PG8_LDB(B1, 0, 1); PG8_SCHED; PG8_LDA(At, 0, 0); PG8_STAGE(PG8_SA(1, 1), a1, vaC[1]);
            PG8_WAIT_V(8); PG8_WAIT_L(0); PG8_BAR; PG8_MMA(0, 0, At, B0); PG8_MMA(0, 1, At, B1); PG8_BAR; PG8_SCHED;
            PG8_LDA(At, 0, 1); PG8_STAGE(PG8_SB(0, 0), b2, voffB); PG8_STAGE(PG8_SB(0, 1), b2 + hstepB, voffB); PG8_STAGE(PG8_SA(0, 0), a2, v2[0]);
            PG8_WAIT_V(8); PG8_WAIT_L(0); PG8_BAR; if (!cur.half) { PG8_MMA(1, 0, At, B0); PG8_MMA(1, 1, At, B1); } PG8_BAR; PG8_SCHED;
            PG8_LDB(B0, 1, 0); PG8_LDB(B1, 1, 1); PG8_SCHED; PG8_LDA(At, 1, 0); PG8_STAGE(PG8_SA(0, 1), a2, v2[1]);
            PG8_WAIT_V(8); PG8_WAIT_L(0); PG8_BAR; PG8_MMA(0, 0, At, B0); PG8_MMA(0, 1, At, B1); PG8_BAR; PG8_SCHED;
            PG8_LDA(At, 1, 1); PG8_STAGE(PG8_SB(1, 0), b3, voffB); PG8_STAGE(PG8_SB(1, 1), b3 + hstepB, voffB); PG8_STAGE(PG8_SA(1, 0), a3, v2[0]);
            PG8_WAIT_V(8); PG8_WAIT_L(0); PG8_BAR; if (!cur.half) { PG8_MMA(1, 0, At, B0); PG8_MMA(1, 1, At, B1); } PG8_BAR; PG8_SCHED;
        }
        if constexpr (ALIGN_EPI) { if (wr == 0) PG8_BAR; }
        E(acc, cur, wr, wc, fr, fq); if constexpr (Sched::HAS_DONE) prev_pm = cur.pm;
        if (!has_next) break;
#pragma unroll
        for (int a = 0; a < 2; ++a)
#pragma unroll
            for (int b = 0; b < 2; ++b)
#pragma unroll
                for (int m = 0; m < 4; ++m)
#pragma unroll
                    for (int n = 0; n < 2; ++n) acc[a][b][m][n] = (acc_t){0, 0, 0, 0};
        cur = nxt; cB = nB; ++ui;
#pragma unroll
        for (int h = 0; h < 2; ++h)
#pragma unroll
            for (int i = 0; i < 2; ++i) vaC[h][i] = vaN[h][i];
        if constexpr (ALIGN_EPI) { if (wr == 1) PG8_BAR; }
    }
    PG8_WAIT_V(0);
    if constexpr (Sched::HAS_DONE) { if (prev_pm >= 0) S.done(prev_pm); }
    if constexpr (!ALIGN_EPI) { if (wr == 0) PG8_BAR; }
    PG8_BAR;
#undef PG8_SA
#undef PG8_SB
#undef PG8_STAGE
#undef PG8_LDA
#undef PG8_LDB
#undef PG8_MMA
#undef PG8_WAIT_V
#undef PG8_WAIT_L
#undef PG8_BAR
#undef PG8_SCHED
#undef PG8_ROWS
}
}
#define XB_TMO      128
#define XB_XCNT(j)  (256  + 64 * (j))
#define XB_XSUB(j)  (1280 + 64 * (j))
#define XB_XGEN(j)  (2304 + 64 * (j))
#define XB_TOP      3328
#define XB_TOPGEN   3392
#define XCD_BAR_WORDS 3456
#define XB_SPIN_CAP (1u << 18)

__device__ __forceinline__ unsigned xb_ld(unsigned* p)              { return __hip_atomic_load(p, __ATOMIC_RELAXED, __HIP_MEMORY_SCOPE_AGENT); }
__device__ __forceinline__ unsigned xb_add(unsigned* p, unsigned v) { return __hip_atomic_fetch_add(p, v, __ATOMIC_RELAXED, __HIP_MEMORY_SCOPE_AGENT); }
__device__ __forceinline__ unsigned xb_xcc_id() { return (unsigned)__builtin_amdgcn_s_getreg((3 << 11) | 20) & 0xFu; }
#define XB_SPIN(cond, bar) do { unsigned _sp = 0; while (cond) { __builtin_amdgcn_s_sleep(1); \
    if ((++_sp & 255u) == 0u) { if (xb_ld(&(bar)[XB_TMO])) break; if (_sp > XB_SPIN_CAP) { atomicAdd(&(bar)[XB_TMO], 1u); break; } } } } while (0)

struct XcdBarrier {
    unsigned* bar; unsigned x;
    volatile LAS unsigned* st;
};

__device__ __forceinline__ XcdBarrier xcd_barrier_post(unsigned* bar, volatile LAS unsigned* st) {
    XcdBarrier b; b.bar = bar; b.x = xb_xcc_id(); b.st = st;
    if (threadIdx.x == 0) (void)xb_add(&bar[XB_XCNT(b.x)], 1u);
    return b;
}
__device__ __forceinline__ void xcd_barrier_complete(unsigned* bar, unsigned x, unsigned& nloc, unsigned& nx) {
    const unsigned G = gridDim.x * gridDim.y * gridDim.z;
    unsigned sum, cnt, mine, sp = 0u;
    for (;;) {
        sum = 0u; cnt = 0u; mine = 0u;
#pragma unroll
        for (unsigned j = 0; j < 16; ++j) { const unsigned c = xb_ld(&bar[XB_XCNT(j)]); sum += c; cnt += (c > 0u) ? 1u : 0u; mine = (j == x) ? c : mine; }
        if (sum == G) break;
        __builtin_amdgcn_s_sleep(1);
        if ((++sp & 255u) == 0u) { if (xb_ld(&bar[XB_TMO])) break; if (sp > XB_SPIN_CAP) { atomicAdd(&bar[XB_TMO], 1u); break; } }
    }
    nloc = mine > 0u ? mine : 1u; nx = cnt > 0u ? cnt : 1u;
}

__device__ __forceinline__ void xcd_barrier(const XcdBarrier& b) {
    asm volatile("s_waitcnt vmcnt(0)" ::: "memory");
    __syncthreads();
    if (threadIdx.x == 0) {
        unsigned* bar = b.bar;
        __builtin_amdgcn_s_waitcnt(0);
        unsigned nloc = b.st[0], nx = b.st[1];
        if (nloc == 0u) { xcd_barrier_complete(bar, b.x, nloc, nx); b.st[0] = nloc; b.st[1] = nx; }
        const unsigned old = xb_add(&bar[XB_XSUB(b.x)], 1u);
        const unsigned gen = old / nloc;
        if (old + 1u == (gen + 1u) * nloc) {
            __builtin_amdgcn_fence(__ATOMIC_RELEASE, "agent");
            asm volatile("s_waitcnt vmcnt(0)" ::: "memory");
            const unsigned og = xb_add(&bar[XB_TOP], 1u);
            const unsigned tg = og / nx;
            if (og + 1u == (tg + 1u) * nx) xb_add(&bar[XB_TOPGEN], 1u);
            else XB_SPIN(xb_ld(&bar[XB_TOPGEN]) == tg, bar);
            __builtin_amdgcn_fence(__ATOMIC_ACQUIRE, "agent");
            xb_add(&bar[XB_XGEN(b.x)], 1u);
            asm volatile("s_waitcnt vmcnt(0)" ::: "memory");
        } else {
            XB_SPIN(xb_ld(&bar[XB_XGEN(b.x)]) == gen, bar);
            __builtin_amdgcn_fence(__ATOMIC_ACQUIRE, "agent");
            asm volatile("s_waitcnt vmcnt(0)" ::: "memory");
        }
    }
    __syncthreads();
}
namespace pg8 {
struct EpiProj {
    static constexpr bool PERM = true, HAS_MID = false;
    bf16_t* base; float* kmean;
    __device__ __forceinline__ void operator()(const f32x4 (&acc)[2][2][4][2], const Unit& u, int wr, int wc, int fr, int fq) const {
        if (u.pn == 8 || u.pn == 9) {
            const int b = u.pm >> 5, nblk = u.pm & 31;
#pragma unroll
            for (int bj = 0; bj < 2; ++bj)
#pragma unroll
                for (int n = 0; n < 2; ++n) { f32x4 s = (f32x4){0.f, 0.f, 0.f, 0.f};
#pragma unroll
                    for (int ai = 0; ai < 2; ++ai)
#pragma unroll
                        for (int m = 0; m < 4; ++m) s += acc[ai][bj][m][n];
#pragma unroll
                    for (int j = 0; j < 4; ++j) { float v = s[j]; v += __shfl_xor(v, 1); v += __shfl_xor(v, 2); v += __shfl_xor(v, 4); v += __shfl_xor(v, 8); s[j] = v; }
                    if (fr == 0) { const int col = (u.pn - 8) * 256 + bj * HALF + wc * 32 + 8 * fq + 4 * n; const int h = col >> 6, d = col & 63; float* kp = kmean + ((size_t)((b * 8 + h) * 32 + nblk)) * 64 + d;
#pragma unroll
                        for (int j = 0; j < 4; ++j) atomicAdd(kp + j, s[j] * (1.0f / 256.0f)); } }
        }
        const int buf = u.pn >> 2, colt = (u.pn & 3) * 256;
        const float sc = (u.pn < 2 || u.pn == 6 || u.pn == 7) ? C2 : 1.0f;
        bf16_t* dst = base + (size_t)buf * (PROJ_STRIDE / 2);
        const int row0 = u.row0 + wr * 64 + fr, col0 = colt + wc * 32 + 8 * fq;
#pragma unroll
        for (int ai = 0; ai < 2; ++ai)
#pragma unroll
            for (int m = 0; m < 4; ++m) { bf16_t* rowp = dst + (size_t)(row0 + ai * HALF + m * 16) * 1024 + col0;
#pragma unroll
                for (int bj = 0; bj < 2; ++bj) { const f32x4 v0 = acc[ai][bj][m][0] * sc, v1 = acc[ai][bj][m][1] * sc;
                    u32x4 w; w.x = cvt_pk_bf16(v0[0], v0[1]); w.y = cvt_pk_bf16(v0[2], v0[3]); w.z = cvt_pk_bf16(v1[0], v1[1]); w.w = cvt_pk_bf16(v1[2], v1[3]);
                    *(u32x4*)(rowp + bj * HALF) = w; } }
    }
};
struct EpiProjQ {
    static constexpr bool PERM = true, HAS_MID = false;
    bf16_t* base; const float* sa; const float* sw;
    __device__ __forceinline__ void operator()(const i32x4 (&acc)[2][2][4][2], const Unit& u, int wr, int wc, int fr, int fq) const {
        const int buf = u.pn >> 2, colt = (u.pn & 3) * 256;
        const float sc = (u.pn < 2) ? C2 : 1.0f;
        bf16_t* dst = base + (size_t)buf * (PROJ_STRIDE / 2);
        const int row0 = u.row0 + wr * 64 + fr, col0 = colt + wc * 32 + 8 * fq;
        const float* swp = sw + u.pn * 256 + wc * 32 + 8 * fq;
        f32x4 sv[2][2];
#pragma unroll
        for (int bj = 0; bj < 2; ++bj)
#pragma unroll
            for (int n = 0; n < 2; ++n) sv[bj][n] = *(const f32x4*)(swp + bj * HALF + 4 * n) * sc;
#pragma unroll
        for (int ai = 0; ai < 2; ++ai)
#pragma unroll
            for (int m = 0; m < 4; ++m) { const int row = row0 + ai * HALF + m * 16; const float ts = sa[row]; bf16_t* rowp = dst + (size_t)row * 1024 + col0;
#pragma unroll
                for (int bj = 0; bj < 2; ++bj) { f32x4 v0, v1;
#pragma unroll
                    for (int j = 0; j < 4; ++j) { v0[j] = (float)acc[ai][bj][m][0][j] * (ts * sv[bj][0][j]); v1[j] = (float)acc[ai][bj][m][1][j] * (ts * sv[bj][1][j]); }
                    u32x4 w; w.x = cvt_pk_bf16(v0[0], v0[1]); w.y = cvt_pk_bf16(v0[2], v0[3]); w.z = cvt_pk_bf16(v1[0], v1[1]); w.w = cvt_pk_bf16(v1[2], v1[3]);
                    *(u32x4*)(rowp + bj * HALF) = w; } }
    }
};
struct EpiBr {
    static constexpr bool PERM = true, HAS_MID = true;
    const bf16_t* gla; const bf16_t* glb; bf16_t* out;
    __device__ __forceinline__ void mid(f32x4 (&acc)[2][2][4][2], const Unit& u, int wr, int wc, int fr, int fq) const {
        int row0 = u.row0 + wr * 64 + fr, col0 = u.pn * 256 + wc * 32 + 8 * fq; asm volatile("" : "+v"(row0), "+v"(col0));
#pragma unroll
        for (int ai = 0; ai < 2; ++ai)
#pragma unroll
            for (int m = 0; m < 4; ++m) { const size_t ro = (size_t)(row0 + ai * HALF + m * 16) * 1024 + col0;
#pragma unroll
                for (int bj = 0; bj < 2; ++bj) { const u32x4 ga = *(const u32x4*)(gla + ro + bj * HALF), gb = *(const u32x4*)(glb + ro + bj * HALF);
#define RT(A, B) ((1.0f + __builtin_amdgcn_exp2f(-(B) * LOG2E)) * __builtin_amdgcn_rcpf(1.0f + __builtin_amdgcn_exp2f(-(A) * LOG2E)))
                    f32x4 r0, r1;
                    r0[0] = RT(bf_lo(ga.x), bf_lo(gb.x)); r0[1] = RT(bf_hi(ga.x), bf_hi(gb.x)); r0[2] = RT(bf_lo(ga.y), bf_lo(gb.y)); r0[3] = RT(bf_hi(ga.y), bf_hi(gb.y));
                    r1[0] = RT(bf_lo(ga.z), bf_lo(gb.z)); r1[1] = RT(bf_hi(ga.z), bf_hi(gb.z)); r1[2] = RT(bf_lo(ga.w), bf_lo(gb.w)); r1[3] = RT(bf_hi(ga.w), bf_hi(gb.w));
#undef RT
                    acc[ai][bj][m][0] *= r0; acc[ai][bj][m][1] *= r1; } }
    }
    __device__ __forceinline__ void operator()(const f32x4 (&acc)[2][2][4][2], const Unit& u, int wr, int wc, int fr, int fq) const {
        int row0 = u.row0 + wr * 64 + fr, col0 = u.pn * 256 + wc * 32 + 8 * fq; asm volatile("" : "+v"(row0), "+v"(col0));
#pragma unroll
        for (int ai = 0; ai < 2; ++ai)
#pragma unroll
            for (int m = 0; m < 4; ++m) { const size_t ro = (size_t)(row0 + ai * HALF + m * 16) * 1024 + col0;
#pragma unroll
                for (int bj = 0; bj < 2; ++bj) { const u32x4 g = *(const u32x4*)(glb + ro + bj * HALF); const f32x4 v0 = acc[ai][bj][m][0], v1 = acc[ai][bj][m][1];
                    u32x4 w; w.x = cvt_pk_bf16(sigmoidf_fast(bf_lo(g.x)) * v0[0], sigmoidf_fast(bf_hi(g.x)) * v0[1]); w.y = cvt_pk_bf16(sigmoidf_fast(bf_lo(g.y)) * v0[2], sigmoidf_fast(bf_hi(g.y)) * v0[3]);
                    w.z = cvt_pk_bf16(sigmoidf_fast(bf_lo(g.z)) * v1[0], sigmoidf_fast(bf_hi(g.z)) * v1[1]); w.w = cvt_pk_bf16(sigmoidf_fast(bf_lo(g.w)) * v1[2], sigmoidf_fast(bf_hi(g.w)) * v1[3]);
                    *(u32x4*)(out + ro + bj * HALF) = w; } }
    }
};
struct EpiOut {
    static constexpr bool PERM = true, HAS_MID = false;
    const float* x; const float* adaf; bf16_t* x1;
    __device__ __forceinline__ void operator()(const f32x4 (&acc)[2][2][4][2], const Unit& u, int wr, int wc, int fr, int fq) const {
        const int row0 = u.row0 + wr * 64 + fr, col0 = u.pn * 256 + wc * 32 + 8 * fq;
        const float* gt = adaf + (u.row0 >= SEQ ? 6144 : 0) + 2048;
        f32x4 gv[2][2];
#pragma unroll
        for (int bj = 0; bj < 2; ++bj)
#pragma unroll
            for (int n = 0; n < 2; ++n) gv[bj][n] = *(const f32x4*)(gt + col0 + bj * HALF + 4 * n);
#pragma unroll
        for (int ai = 0; ai < 2; ++ai)
#pragma unroll
            for (int m = 0; m < 4; ++m) { const size_t ro = (size_t)(row0 + ai * HALF + m * 16) * 1024 + col0;
#pragma unroll
                for (int bj = 0; bj < 2; ++bj) { const f32x4 x0 = *(const f32x4*)(x + ro + bj * HALF), x4 = *(const f32x4*)(x + ro + bj * HALF + 4);
                    const f32x4 v0 = x0 + gv[bj][0] * acc[ai][bj][m][0], v1 = x4 + gv[bj][1] * acc[ai][bj][m][1];
                    u32x4 w; w.x = cvt_pk_bf16(v0[0], v0[1]); w.y = cvt_pk_bf16(v0[2], v0[3]); w.z = cvt_pk_bf16(v1[0], v1[1]); w.w = cvt_pk_bf16(v1[2], v1[3]);
                    *(u32x4*)(x1 + ro + bj * HALF) = w; } }
    }
};
struct EpiGU {
    static constexpr bool PERM = true, HAS_MID = false;
    const float* bgu; bf16_t* act;
    __device__ __forceinline__ void operator()(const f32x4 (&acc)[2][2][4][2], const Unit& u, int wr, int wc, int fr, int fq) const {
        const int row0 = u.row0 + wr * 64 + fr, col0 = u.pn * 128 + wc * 32 + 8 * fq;
        const float* bg = bgu + (size_t)u.e * 2048 + col0;
        f32x4 bgv[2], buv[2];
#pragma unroll
        for (int n = 0; n < 2; ++n) { bgv[n] = *(const f32x4*)(bg + 4 * n); buv[n] = *(const f32x4*)(bg + 1024 + 4 * n); }
#pragma unroll
        for (int ai = 0; ai < 2; ++ai)
#pragma unroll
            for (int m = 0; m < 4; ++m) { float r[8];
#pragma unroll
                for (int n = 0; n < 2; ++n)
#pragma unroll
                    for (int j = 0; j < 4; ++j) { const float gte = fminf(acc[ai][0][m][n][j] + bgv[n][j], 7.0f); const float up = fminf(fmaxf(acc[ai][1][m][n][j] + buv[n][j], -7.0f), 7.0f);
                        r[4 * n + j] = (up + 1.0f) * gte * sigmoidf_fast(1.702f * gte); }
                u32x4 w; w.x = cvt_pk_bf16(r[0], r[1]); w.y = cvt_pk_bf16(r[2], r[3]); w.z = cvt_pk_bf16(r[4], r[5]); w.w = cvt_pk_bf16(r[6], r[7]);
                *(u32x4*)(act + (size_t)(row0 + ai * HALF + m * 16) * 1024 + col0) = w; }
    }
};
struct EpiGUQ {
    static constexpr bool PERM = true, HAS_MID = false;
    const float* bgu; const float* sw; const float* slot_sa; bf16_t* act;
    __device__ __forceinline__ void operator()(const i32x4 (&acc)[2][2][4][2], const Unit& u, int wr, int wc, int fr, int fq) const {
        const int row0 = u.row0 + wr * 64 + fr, col0 = u.pn * 128 + wc * 32 + 8 * fq;
        const float* bg = bgu + (size_t)u.e * 2048 + col0; const float* sg = sw + (size_t)u.e * 2048 + col0;
        f32x4 bgv[2], buv[2], sgv[2], suv[2];
#pragma unroll
        for (int n = 0; n < 2; ++n) { bgv[n] = *(const f32x4*)(bg + 4 * n); buv[n] = *(const f32x4*)(bg + 1024 + 4 * n); sgv[n] = *(const f32x4*)(sg + 4 * n); suv[n] = *(const f32x4*)(sg + 1024 + 4 * n); }
#pragma unroll
        for (int ai = 0; ai < 2; ++ai)
#pragma unroll
            for (int m = 0; m < 4; ++m) { if (ai == 1 && u.half) continue; const int row = row0 + ai * HALF + m * 16; const float ts = slot_sa[row]; float r[8];
#pragma unroll
                for (int n = 0; n < 2; ++n)
#pragma unroll
                    for (int j = 0; j < 4; ++j) { const float gte = fminf((float)acc[ai][0][m][n][j] * (ts * sgv[n][j]) + bgv[n][j], 7.0f); const float up = fminf(fmaxf((float)acc[ai][1][m][n][j] * (ts * suv[n][j]) + buv[n][j], -7.0f), 7.0f);
                        r[4 * n + j] = (up + 1.0f) * gte * sigmoidf_fast(1.702f * gte); }
                u32x4 w; w.x = cvt_pk_bf16(r[0], r[1]); w.y = cvt_pk_bf16(r[2], r[3]); w.z = cvt_pk_bf16(r[4], r[5]); w.w = cvt_pk_bf16(r[6], r[7]);
                *(u32x4*)(act + (size_t)row * 1024 + col0) = w; }
    }
};
struct EpiDown {
    static constexpr bool PERM = true, HAS_MID = false;
    const float* bd; const float* slotw; bf16_t* out;
    __device__ __forceinline__ void operator()(const f32x4 (&acc)[2][2][4][2], const Unit& u, int wr, int wc, int fr, int fq) const {
        const int row0 = u.row0 + wr * 64 + fr, col0 = u.pn * 256 + wc * 32 + 8 * fq;
        const float* bp = bd + (size_t)u.e * 1024 + col0;
        f32x4 bv[2][2];
#pragma unroll
        for (int bj = 0; bj < 2; ++bj)
#pragma unroll
            for (int n = 0; n < 2; ++n) bv[bj][n] = *(const f32x4*)(bp + bj * HALF + 4 * n);
#pragma unroll
        for (int ai = 0; ai < 2; ++ai)
#pragma unroll
            for (int m = 0; m < 4; ++m) { if (ai == 1 && u.half) continue; const int row = row0 + ai * HALF + m * 16; const float w8 = slotw[row]; bf16_t* rowp = out + (size_t)row * 1024 + col0;
#pragma unroll
                for (int bj = 0; bj < 2; ++bj) { const f32x4 v0 = (acc[ai][bj][m][0] + bv[bj][0]) * w8, v1 = (acc[ai][bj][m][1] + bv[bj][1]) * w8;
                    u32x4 w; w.x = cvt_pk_bf16(v0[0], v0[1]); w.y = cvt_pk_bf16(v0[2], v0[3]); w.z = cvt_pk_bf16(v1[0], v1[1]); w.w = cvt_pk_bf16(v1[2], v1[3]);
                    *(u32x4*)(rowp + bj * HALF) = w; } }
    }
};
template <bool GATHER, bool WAIT, bool SIGNAL, bool SPLIT = false> struct MoeSched {
    static constexpr bool HAS_READY = WAIT, HAS_DONE = SIGNAL;
    const LAS int* te; int NP, G, c; const int* slot_tok; const char* W; size_t wstride, btile; unsigned* tdone; unsigned* tmo;
    __device__ __forceinline__ bool next(int i, Unit& u) const {
        const int ntl = te[32];
        const int g = c & 7, li = c >> 3, GL = G >> 3;
        const int tb0 = (g * ntl) >> 3, tb1 = ((g + 1) * ntl) >> 3, nu = (tb1 - tb0) * NP;
        const int rounds = (nu + GL - 1) / GL, rem = nu - (rounds - 1) * GL; const bool split = SPLIT && 2 * rem <= GL;
        int L = i * GL + li, half = 0, hsel = 0;
        if (split && i == rounds - 1) { if (li >= 2 * rem) return false; L = i * GL + (li >> 1); half = 1; hsel = li & 1; }
        if (L >= nu) return false;
        int e = 0;
        for (int k = 0; k < NE - 1; ++k) { int hi = te[k + 1] < tb1 ? te[k + 1] : tb1; hi = hi > tb0 ? hi - tb0 : 0; e += (L >= hi * NP) ? 1 : 0; }
        const int a = te[e] > tb0 ? te[e] : tb0, b = te[e + 1] < tb1 ? te[e + 1] : tb1, nte = b - a, r_ = L - (a - tb0) * NP; const int pn = r_ / nte, t = a + r_ % nte;
        u.row0 = t * 256 + hsel * 128; u.pn = pn; u.pm = t; u.e = e; u.half = half; u.bptr = W + (size_t)e * wstride + (size_t)pn * btile; return true;
    }
    __device__ __forceinline__ int arow(const Unit& u, int r) const { if (u.half) r &= 127; if constexpr (GATHER) return slot_tok[u.row0 + r]; else return u.row0 + r; }
    __device__ __forceinline__ void a_ready(const Unit& u) const {
        if constexpr (WAIT) {
            if (threadIdx.x < 64) {
                const unsigned long long t0 = __builtin_amdgcn_s_memrealtime(); unsigned polls = 0;
                while ((unsigned)__builtin_amdgcn_readfirstlane(__hip_atomic_load(tdone + 64 * u.pm, __ATOMIC_RELAXED, __HIP_MEMORY_SCOPE_AGENT)) < 64u) {
                    if ((++polls & 255u) == 0u && __builtin_amdgcn_readfirstlane(__hip_atomic_load(tmo, __ATOMIC_RELAXED, __HIP_MEMORY_SCOPE_AGENT)) != 0u) break;
                    if (__builtin_amdgcn_s_memrealtime() - t0 > 2000000ull) { if (threadIdx.x == 0) __hip_atomic_store(tmo, 1u, __ATOMIC_RELAXED, __HIP_MEMORY_SCOPE_AGENT); break; }
                    __builtin_amdgcn_s_sleep(2); }
                __builtin_amdgcn_fence(__ATOMIC_ACQUIRE, "agent");
                asm volatile("s_waitcnt vmcnt(0)" ::: "memory");
            }
            asm volatile("" ::: "memory"); __builtin_amdgcn_s_barrier(); asm volatile("" ::: "memory");
        }
    }
    __device__ __forceinline__ void done(int pm) const {
        if constexpr (SIGNAL) {
            if ((threadIdx.x & 63) == 0) __hip_atomic_fetch_add(tdone + 64 * pm, 1u, __ATOMIC_RELAXED, __HIP_MEMORY_SCOPE_AGENT); }
    }
};
}

constexpr int BT_STR = 132;
constexpr int AT_BT = LDSCTL_OFF + 1024, AT_K = 0, AT_V = AT_K + 64 * 72 * 2, AT_MISC = LDSCTL_OFF + 8192;
typedef short v4i16_t __attribute__((ext_vector_type(4)));
__device__ __forceinline__ s16x4 tr16(const LAS unsigned char* p) { return __builtin_bit_cast(s16x4, __builtin_amdgcn_ds_read_tr16_b64_v4i16((LAS v4i16_t*)p)); }

template <int NDT>
__device__ __forceinline__ void attn_tile(const LAS unsigned char* lds, int lane, const bf16x8 (&qf)[2], f32x4 (&o)[NDT], float& m_run, float& l_run,
                                          int qpos, int kbase, bool causal, const LAS float* bt) {
    constexpr int VSTR = NDT * 16 + 8;
    const int c = lane & 15, g = lane >> 4;
    f32x4 s[4];
#pragma unroll
    for (int kt = 0; kt < 4; ++kt) { s[kt] = (f32x4){0.f, 0.f, 0.f, 0.f};
#pragma unroll
        for (int ks = 0; ks < 2; ++ks) { const bf16x8 a = *(const LAS bf16x8*)(lds + AT_K + ((16 * kt + c) * 72 + 32 * ks + 8 * g) * 2);
            s[kt] = __builtin_amdgcn_mfma_f32_16x16x32_bf16(a, qf[ks], s[kt], 0, 0, 0); } }
    if (__any((qpos - (kbase + 63)) < 128)) {
#pragma unroll
        for (int kt = 0; kt < 4; ++kt)
#pragma unroll
            for (int i = 0; i < 4; ++i) { const int dist = qpos - (kbase + 16 * kt + 4 * g + i); const int di = dist < 0 ? 0 : (dist > 127 ? 127 : dist);
                const float bv = bt[di]; float v = s[kt][i];
                if (dist >= 0 && dist < 128) v += bv;
                if (causal && dist < 0) v = -INFINITY;
                s[kt][i] = v; }
    }
    float mx = fmaxf(fmaxf(s[0][0], s[0][1]), fmaxf(s[0][2], s[0][3]));
#pragma unroll
    for (int kt = 1; kt < 4; ++kt) mx = fmaxf(mx, fmaxf(fmaxf(s[kt][0], s[kt][1]), fmaxf(s[kt][2], s[kt][3])));
    mx = fmaxf(mx, __shfl_xor(mx, 16)); mx = fmaxf(mx, __shfl_xor(mx, 32));
    const float m_new = fmaxf(m_run, mx), alpha = __builtin_amdgcn_exp2f(m_run - m_new);
    float psum = 0.f;
#pragma unroll
    for (int kt = 0; kt < 4; ++kt)
#pragma unroll
        for (int i = 0; i < 4; ++i) { const float p = __builtin_amdgcn_exp2f(s[kt][i] - m_new); s[kt][i] = p; psum += p; }
    l_run = l_run * alpha + psum; m_run = m_new;
#pragma unroll
    for (int i = 0; i < 4; ++i) { const float ai = __shfl(alpha, 4 * g + i);
#pragma unroll
        for (int dt = 0; dt < NDT; ++dt) o[dt][i] *= ai; }
    bf16x8 pa[2];
#pragma unroll
    for (int kk = 0; kk < 2; ++kk) { u32x4 w; w.x = cvt_pk_bf16(s[2 * kk][0], s[2 * kk][1]); w.y = cvt_pk_bf16(s[2 * kk][2], s[2 * kk][3]);
        w.z = cvt_pk_bf16(s[2 * kk + 1][0], s[2 * kk + 1][1]); w.w = cvt_pk_bf16(s[2 * kk + 1][2], s[2 * kk + 1][3]); pa[kk] = __builtin_bit_cast(bf16x8, w); }
    const LAS unsigned char* vb = lds + AT_V + ((4 * g + (c >> 2)) * VSTR + 4 * (c & 3)) * 2;
#pragma unroll
    for (int dt = 0; dt < NDT; ++dt)
#pragma unroll
        for (int kk = 0; kk < 2; ++kk) { const s16x4 lo = tr16(vb + (32 * kk * VSTR + 16 * dt) * 2), hi = tr16(vb + ((32 * kk + 16) * VSTR + 16 * dt) * 2);
            const bf16x8 b = (bf16x8){lo[0], lo[1], lo[2], lo[3], hi[0], hi[1], hi[2], hi[3]};
            o[dt] = __builtin_amdgcn_mfma_f32_16x16x32_bf16(pa[kk], b, o[dt], 0, 0, 0); }
}

template <int NV> struct TileRegs { u32x4 k; u32x4 v[NV]; };
template <int NV> __device__ __forceinline__ void tile_fetch(TileRegs<NV>& r, const bf16_t* kg, const bf16_t* vg, int tid) {
    const int row = tid >> 3, ch = tid & 7;
    r.k = *(const u32x4*)(kg + (size_t)row * 1024 + ch * 8);
#pragma unroll
    for (int i = 0; i < NV; ++i) r.v[i] = *(const u32x4*)(vg + (size_t)row * 1024 + (ch + 8 * i) * 8);
}
template <int NV> __device__ __forceinline__ void tile_store(const TileRegs<NV>& r, LAS unsigned char* lds, int tid) {
    constexpr int VSTR = NV * 64 + 8;
    const int row = tid >> 3, ch = tid & 7;
    *(LAS u32x4*)(lds + AT_K + (row * 72 + ch * 8) * 2) = r.k;
#pragma unroll
    for (int i = 0; i < NV; ++i) *(LAS u32x4*)(lds + AT_V + (row * VSTR + (ch + 8 * i) * 8) * 2) = r.v[i];
}
#include <hip/hip_bf16.h>
#include <cmath>
namespace attn_body {
using bf16=__hip_bfloat16;
using bf16x8=__attribute__((ext_vector_type(8)))short;
using s16x4=__attribute__((ext_vector_type(4)))short;
using f32x16=__attribute__((ext_vector_type(16)))float;
using u32x4=__attribute__((ext_vector_type(4)))unsigned;
constexpr int BATCH=2,NHEAD=16,SEQ=8192,D=64,DM=NHEAD*D;
constexpr int NW=8,QBLK=32,QB=QBLK*NW,KVBLK=64,NQB=SEQ/QB;
constexpr int ATTN_PITCH=DM, ATTN_UNIT_ROWS=QB;
__device__ __forceinline__ int crow(int r,int hi){return (r&3)+8*(r>>2)+4*hi;}
#define SBAR() __builtin_amdgcn_sched_barrier(0)
typedef const __attribute__((address_space(3))) float* lds_cfptr;
__device__ __forceinline__ void cbias(f32x16&p0,f32x16&p1,int jb,int qrel,int hi,lds_cfptr bt){
  const float NEG=-INFINITY; const int kb=64*jb+4*hi;
  #pragma unroll
  for(int r=0;r<16;++r){const int d0=qrel-(kb+(r&3)+8*(r>>2)),d1=d0-32;
    const unsigned c0=(unsigned)d0<128u?(unsigned)d0:128u,c1=(unsigned)d1<128u?(unsigned)d1:128u;
    const float v0=p0[r]+bt[c0],v1=p1[r]+bt[c1];
    p0[r]=d0<0?NEG:v0; p1[r]=d1<0?NEG:v1;}
}
constexpr int NSLOT=3, SLOTB=8192;
constexpr int LDS_K=0, LDS_V=NSLOT*SLOTB, LDS_WS=2*NSLOT*SLOTB, LDS_OST=LDS_WS+NW*64*4, LDS_BYTES=LDS_OST+NW*4096;
constexpr float C2=0.125f*1.4426950408889634f;
__device__ __forceinline__ void glds16(const void*gsrc,unsigned lds_dst){unsigned keep;
  asm volatile("s_mov_b32 %0, m0\n\ts_mov_b32 m0, %2\n\ts_nop 0\n\tglobal_load_lds_dwordx4 %1, off\n\ts_mov_b32 m0, %0":"=&s"(keep):"v"(gsrc),"s"(lds_dst):"memory");}
__device__ __forceinline__ float max3f(float a,float b,float c){float r;asm("v_max3_f32 %0, %1, %2, %3":"=v"(r):"v"(a),"v"(b),"v"(c));return r;}
__device__ __forceinline__ float max2f(float a,float b){float r;asm("v_max_f32_e32 %0, %1, %2":"=v"(r):"v"(a),"v"(b));return r;}
__device__ __forceinline__ float fadd_s(float a,float b){float r;asm("v_add_f32_e32 %0, %1, %2":"=v"(r):"v"(a),"v"(b));return r;}
__device__ __forceinline__ float fsub_s(float a,float b){float r;asm("v_sub_f32_e32 %0, %1, %2":"=v"(r):"v"(a),"v"(b));return r;}
typedef float f32x2_t __attribute__((ext_vector_type(2))); typedef __bf16 bf16x2_t __attribute__((ext_vector_type(2)));
__device__ __forceinline__ unsigned cvtpk_s(float lo,float hi){f32x2_t v={lo,hi};bf16x2_t b=__builtin_convertvector(v,bf16x2_t);return __builtin_bit_cast(unsigned,b);}
#define WAIT_BAR(N) asm volatile("s_waitcnt vmcnt(" #N ") lgkmcnt(0)\n\ts_barrier":::"memory")

__device__ __forceinline__ void qkt(f32x16&p0,f32x16&p1,const char*Kslot,const bf16x8*qr,const f32x16&negm,int r32,int hi){
  const char*kb=Kslot+hi*1024+r32*16;
  #pragma unroll
  for(int d0=0;d0<4;++d0){
    const bf16x8 b0=*reinterpret_cast<const bf16x8*>(kb+d0*2048);
    const bf16x8 b1=*reinterpret_cast<const bf16x8*>(kb+d0*2048+512);
    if(d0==0){p0=__builtin_amdgcn_mfma_f32_32x32x16_bf16(b0,qr[0],negm,0,0,0);p1=__builtin_amdgcn_mfma_f32_32x32x16_bf16(b1,qr[0],negm,0,0,0);}
    else{p0=__builtin_amdgcn_mfma_f32_32x32x16_bf16(b0,qr[d0],p0,0,0,0);p1=__builtin_amdgcn_mfma_f32_32x32x16_bf16(b1,qr[d0],p1,0,0,0);}}
}
typedef __attribute__((address_space(3))) const char* lds_cptr;
typedef short v4i16_t __attribute__((ext_vector_type(4)));
__device__ __forceinline__ void kload8(bf16x8*kf,lds_cptr kp){
  kf[0]=*(const __attribute__((address_space(3))) bf16x8*)(kp);      kf[1]=*(const __attribute__((address_space(3))) bf16x8*)(kp+512);
  kf[2]=*(const __attribute__((address_space(3))) bf16x8*)(kp+2048); kf[3]=*(const __attribute__((address_space(3))) bf16x8*)(kp+2560);
  kf[4]=*(const __attribute__((address_space(3))) bf16x8*)(kp+4096); kf[5]=*(const __attribute__((address_space(3))) bf16x8*)(kp+4608);
  kf[6]=*(const __attribute__((address_space(3))) bf16x8*)(kp+6144); kf[7]=*(const __attribute__((address_space(3))) bf16x8*)(kp+6656);
}
__device__ __forceinline__ void kload2(bf16x8*kf,lds_cptr kp,int j){ kf[2*j]=*(const __attribute__((address_space(3))) bf16x8*)(kp+j*2048); kf[2*j+1]=*(const __attribute__((address_space(3))) bf16x8*)(kp+j*2048+512); }
__device__ __forceinline__ s16x4 vtr(lds_cptr p){ return __builtin_bit_cast(s16x4,__builtin_amdgcn_ds_read_tr16_b64_v4i16((__attribute__((address_space(3))) v4i16_t*)p)); }
__device__ __forceinline__ float rowmax(const f32x16&p0,const f32x16&p1){
  float a=max3f(p0[0],p0[1],p1[0]),b=max3f(p0[2],p0[3],p1[1]);a=max3f(a,p1[2],p1[3]);
  #pragma unroll
  for(int r=4;r<16;r+=4){a=max3f(a,p0[r],p0[r+1]);b=max3f(b,p0[r+2],p0[r+3]);a=max3f(a,p1[r],p1[r+1]);b=max3f(b,p1[r+2],p1[r+3]);}
  const float m=max2f(a,b);
  auto rr=__builtin_amdgcn_permlane32_swap(__float_as_uint(m),__float_as_uint(m),false,false);
  return max2f(__uint_as_float(rr[0]),__uint_as_float(rr[1]));
}
__device__ __forceinline__ void pv(f32x16*o,int vb,bf16x8 pa0,bf16x8 pa1,bf16x8 pa2,bf16x8 pa3){
  #pragma unroll
  for(int d0=0;d0<2;++d0){s16x4 lo[4],hi[4];
    #pragma unroll
    for(int ks=0;ks<4;++ks){
      asm volatile("ds_read_b64_tr_b16 %0,%1 offset:%c2":"=&v"(lo[ks]):"v"(vb),"i"(d0*4096+ks*1024):"memory");
      asm volatile("ds_read_b64_tr_b16 %0,%1 offset:%c2":"=&v"(hi[ks]):"v"(vb),"i"(d0*4096+ks*1024+512):"memory");}
    asm volatile("s_waitcnt lgkmcnt(0)":::"memory");SBAR();
    #define PK(k) (bf16x8){lo[k][0],lo[k][1],lo[k][2],lo[k][3],hi[k][0],hi[k][1],hi[k][2],hi[k][3]}
    o[d0]=__builtin_amdgcn_mfma_f32_32x32x16_bf16(pa0,PK(0),o[d0],0,0,0);
    o[d0]=__builtin_amdgcn_mfma_f32_32x32x16_bf16(pa1,PK(1),o[d0],0,0,0);
    o[d0]=__builtin_amdgcn_mfma_f32_32x32x16_bf16(pa2,PK(2),o[d0],0,0,0);
    o[d0]=__builtin_amdgcn_mfma_f32_32x32x16_bf16(pa3,PK(3),o[d0],0,0,0);
    #undef PK
  }
}

#ifndef ATTN_STORE16
#define ATTN_STORE16(p,v) (*(u32x4*)(p)=(v))
#endif
template<int THRL> __device__ __forceinline__ void attn_unit(int b,int qb,const bf16*Q,const bf16*__restrict__ K,const bf16*__restrict__ V,bf16*O,int qc,int kc,int vc,int oc,lds_cfptr bt,char*shm){
  int tid_=threadIdx.x; asm volatile("":"+v"(tid_)); const int tid=tid_,lane=tid&63,r32=lane&31,hi=lane>>5; const int wid=__builtin_amdgcn_readfirstlane(tid>>6);
  const long rowbase=(long)b*SEQ; const int q0=qb*QB;
  const bf16*Qw=Q+(rowbase+q0+wid*QBLK)*DM+qc;
  const bf16*Kh=K+rowbase*DM+kc,*Vh=V+rowbase*DM+vc;
  const unsigned lds0=(unsigned)(uintptr_t)shm;
  float*wsf=(float*)(shm+LDS_WS)+wid*64;
  const bf16*ksrc=Kh+(long)lane*DM+wid*8;
  const bf16*vsrc=Vh+(long)(16*(wid&3)+(lane>>2))*DM+(wid>>2)*32+(lane&3)*8;
  const unsigned kdst=lds0+LDS_K+wid*1024, vdst=lds0+LDS_V+wid*1024;
  #define DMA_K(t,slot) glds16(ksrc+(long)(t)*KVBLK*DM,(unsigned)__builtin_amdgcn_readfirstlane(kdst+(slot)))
  #define DMA_V(t,slot) glds16(vsrc+(long)(t)*KVBLK*DM,(unsigned)__builtin_amdgcn_readfirstlane(vdst+(slot)))
  const int vb0=(int)(lds0+LDS_V)+((lane>>4)&1)*32+(lane&3)*8+(4*hi+((lane&15)>>2))*64;
  const char*Kbase=shm+LDS_K; bf16x8 kf[8];
  const lds_cptr shm3=(lds_cptr)shm; const lds_cptr kp0=shm3+LDS_K+hi*1024+r32*16; const lds_cptr vp0=shm3+LDS_V+((lane>>4)&1)*32+(lane&3)*8+(4*hi+((lane&15)>>2))*64;
  const int NT=(q0+QB)/KVBLK;
  DMA_K(0,0);DMA_V(0,0);DMA_K(1,SLOTB);
  bf16x8 qr[4];
  #pragma unroll
  for(int d0=0;d0<4;++d0)qr[d0]=*reinterpret_cast<const bf16x8*>(&Qw[(long)r32*DM+d0*16+hi*8]);
  float mhat=0.f,l_reg=0.f;f32x16 o[2],negm; { float z_=0.f; asm volatile("":"+v"(z_));
    _Pragma("unroll") for(int r=0;r<16;++r){o[0][r]=z_;o[1][r]=z_;negm[r]=z_;} } asm volatile("":"+v"(negm));
  const int qrel=wid*QBLK+r32;
  #define CMASK(P0,P1,t) do{int jb_=(t)-(NT-4); if(jb_>=-2 && (wid*QBLK-(64*jb_+63))<128)cbias(P0,P1,jb_,qrel,hi,bt);}while(0)
  bool resc=false;
  #define START(P0,P1) do{ const float rm=rowmax(P0,P1); resc=false; \
    { const float dl=rm; mhat=fadd_s(mhat,dl); \
      _Pragma("unroll") for(int r=0;r<16;++r){P0[r]=fsub_s(P0[r],dl);P1[r]=fsub_s(P1[r],dl);} \
      _Pragma("unroll") for(int r=0;r<16;++r)negm[r]=-mhat; asm volatile("":"+v"(negm)); } \
    _Pragma("unroll") for(int r=0;r<16;++r)P0[r]=__builtin_amdgcn_exp2f(P0[r]); }while(0)
  #define RESC() do{ if(resc){ asm volatile("s_waitcnt lgkmcnt(0)":::"memory"); \
      _Pragma("unroll") for(int d_=0;d_<2;++d_) _Pragma("unroll") for(int r=0;r<16;++r)o[d_][r]*=wsf[crow(r,hi)]; } }while(0)
  f32x16 pA0,pA1,pB0,pB1;
  int sl_prev=0,sl_cur=0,sl_next=SLOTB;
  #define ROT() do{sl_prev=sl_cur;sl_cur=sl_next;sl_next=(sl_next==(NSLOT-1)*SLOTB)?0:sl_next+SLOTB;}while(0)
  DMA_K(2,2*SLOTB);
  WAIT_BAR(3);
  qkt(pA0,pA1,Kbase,qr,negm,r32,hi);asm volatile("s_nop 15\n\ts_nop 7":"+v"(pA0),"+v"(pA1));CMASK(pA0,pA1,0);
  START(pA0,pA1);
  _Pragma("unroll") for(int r=0;r<16;++r)pA1[r]=__builtin_amdgcn_exp2f(pA1[r]);
  WAIT_BAR(0);
  DMA_K(3,0);DMA_V(1,SLOTB);
  ROT();
  kload8(kf,kp0+sl_cur);
  WAIT_BAR(2);
  s16x4 vlo[8],vhi[8]; u32x4 pw0,pw1,pw2,pw3;
  #define PKW(P,B) cvtpk_s(P[B],P[B+1])
  #define PAF(k) __builtin_bit_cast(bf16x8,pw##k)
  #define VFR(i) (bf16x8){vlo[i][0],vlo[i][1],vlo[i][2],vlo[i][3],vhi[i][0],vhi[i][1],vhi[i][2],vhi[i][3]}
  #define PIN(x) asm volatile("":"+v"(x))
  #define MX3(a,b,c) __builtin_fmaxf(__builtin_fmaxf((a),(b)),(c))
  #define GAPA(MF,A0,A1,A2,A3,W0,W1,PW) do{ MF; sacc+=A0; sacc+=A1; sacc+=A2; sacc+=A3; PIN(sacc); W0; W1; PIN(PW); SBAR(); }while(0)
  #define EX(v) __builtin_amdgcn_exp2f(v)
  #define GAPB(MF,X,B) do{ MF; X[B]=EX(X[B]); X[B+1]=EX(X[B+1]); X[B+2]=EX(X[B+2]); X[B+3]=EX(X[B+3]); PIN(X); SBAR(); }while(0)
  #define VRD(i) do{ vlo[i]=vtr(vp_+(((i)>>2)*4096+((i)&3)*1024)); vhi[i]=vtr(vp_+(((i)>>2)*4096+((i)&3)*1024+512)); }while(0)
  #define KRD(G,j) do{ if(G){ kload2(kf,kp0+sl_next,j); SBAR(); } }while(0)
  #define STEP(C0,C1,P0,P1,t,GK,GV,GL) do{ SBAR(); \
    const lds_cptr vp_=vp0+sl_prev; \
    VRD(0); SBAR(); float sacc=(P0[0]+P0[1]); \
    GAPA(C0=__builtin_amdgcn_mfma_f32_32x32x16_bf16(kf[0],qr[0],negm,0,0,0), P0[2],P0[3],P0[4],P0[5],     pw0[0]=PKW(P0,0), pw0[1]=PKW(P0,2), pw0); \
    VRD(4); SBAR(); GAPA(C1=__builtin_amdgcn_mfma_f32_32x32x16_bf16(kf[1],qr[0],negm,0,0,0), P0[6],P0[7],P0[8],P0[9],     pw0[2]=PKW(P0,4), pw0[3]=PKW(P0,6), pw0); \
    VRD(1); SBAR(); GAPA(C0=__builtin_amdgcn_mfma_f32_32x32x16_bf16(kf[2],qr[1],C0,0,0,0),   P0[10],P0[11],P0[12],P0[13], pw1[0]=PKW(P0,8), pw1[1]=PKW(P0,10), pw1); \
    VRD(5); SBAR(); GAPA(C1=__builtin_amdgcn_mfma_f32_32x32x16_bf16(kf[3],qr[1],C1,0,0,0),   P0[14],P0[15],P1[0],P1[1],   pw1[2]=PKW(P0,12),pw1[3]=PKW(P0,14), pw1); \
    VRD(2); SBAR(); GAPA(C0=__builtin_amdgcn_mfma_f32_32x32x16_bf16(kf[4],qr[2],C0,0,0,0),   P1[2],P1[3],P1[4],P1[5],     pw2[0]=PKW(P1,0), pw2[1]=PKW(P1,2), pw2); \
    VRD(6); SBAR(); GAPA(C1=__builtin_amdgcn_mfma_f32_32x32x16_bf16(kf[5],qr[2],C1,0,0,0),   P1[6],P1[7],P1[8],P1[9],     pw2[2]=PKW(P1,4), pw2[3]=PKW(P1,6), pw2); \
    VRD(3); SBAR(); GAPA(C0=__builtin_amdgcn_mfma_f32_32x32x16_bf16(kf[6],qr[3],C0,0,0,0),   P1[10],P1[11],P1[12],P1[13], pw3[0]=PKW(P1,8), pw3[1]=PKW(P1,10), pw3); \
    VRD(7); SBAR(); GAPA(C1=__builtin_amdgcn_mfma_f32_32x32x16_bf16(kf[7],qr[3],C1,0,0,0),   P1[14],P1[15],0.f,0.f,       pw3[2]=PKW(P1,12),pw3[3]=PKW(P1,14), pw3); \
    l_reg+=sacc; \
    if(GK){DMA_K((t)+3,sl_cur);} if(GV){DMA_V((t)+1,sl_next);} \
    CMASK(C0,C1,t); \
    { float a=MX3(C0[0],C0[1],C1[0]),b=MX3(C0[2],C0[3],C1[1]); a=MX3(a,C1[2],C1[3]); \
      _Pragma("unroll") for(int r=4;r<16;r+=4){a=MX3(a,C0[r],C0[r+1]);b=MX3(b,C0[r+2],C0[r+3]);a=MX3(a,C1[r],C1[r+1]);b=MX3(b,C1[r+2],C1[r+3]);} \
      float rm=__builtin_fmaxf(a,b); { auto rr=__builtin_amdgcn_permlane32_swap(__float_as_uint(rm),__float_as_uint(rm),false,false); rm=__builtin_fmaxf(__uint_as_float(rr[0]),__uint_as_float(rr[1])); } \
      resc=false; \
      if(__builtin_expect(__any(rm>(float)THRL),0)){ const float dl=__builtin_fmaxf(rm,0.f); mhat+=dl; \
        _Pragma("unroll") for(int r=0;r<16;++r){C0[r]-=dl;C1[r]-=dl;} \
        _Pragma("unroll") for(int r=0;r<16;++r)negm[r]=-mhat; asm volatile("":"+v"(negm)); \
        const float f=__builtin_amdgcn_exp2f(-dl); l_reg*=f; if(hi==0)wsf[r32]=f; resc=true; } } \
    SBAR(); \
    GAPB(o[0]=__builtin_amdgcn_mfma_f32_32x32x16_bf16(PAF(0),VFR(0),o[0],0,0,0), C0,0); \
    GAPB(o[1]=__builtin_amdgcn_mfma_f32_32x32x16_bf16(PAF(0),VFR(4),o[1],0,0,0), C0,4); \
    KRD(GL,0); GAPB(o[0]=__builtin_amdgcn_mfma_f32_32x32x16_bf16(PAF(1),VFR(1),o[0],0,0,0), C0,8); \
    KRD(GL,1); GAPB(o[1]=__builtin_amdgcn_mfma_f32_32x32x16_bf16(PAF(1),VFR(5),o[1],0,0,0), C0,12); \
    KRD(GL,2); GAPB(o[0]=__builtin_amdgcn_mfma_f32_32x32x16_bf16(PAF(2),VFR(2),o[0],0,0,0), C1,0); \
    KRD(GL,3); GAPB(o[1]=__builtin_amdgcn_mfma_f32_32x32x16_bf16(PAF(2),VFR(6),o[1],0,0,0), C1,4); \
    GAPB(o[0]=__builtin_amdgcn_mfma_f32_32x32x16_bf16(PAF(3),VFR(3),o[0],0,0,0), C1,8); \
    GAPB(o[1]=__builtin_amdgcn_mfma_f32_32x32x16_bf16(PAF(3),VFR(7),o[1],0,0,0), C1,12); \
    }while(0)
  int t=1;
  #undef CMASK
  #define CMASK(P0,P1,t) do{}while(0)
  for(;t+7<NT;t+=2){
    STEP(pB0,pB1,pA0,pA1,t,true,true,true);     WAIT_BAR(2); RESC(); ROT();
    STEP(pA0,pA1,pB0,pB1,t+1,true,true,true);   WAIT_BAR(2); RESC(); ROT();
  }
  #undef CMASK
  #define CMASK(P0,P1,t) do{int jb_=(t)-(NT-4); if(jb_>=-2 && (wid*QBLK-(64*jb_+63))<128)cbias(P0,P1,jb_,qrel,hi,bt);}while(0)
  #define ENDW(tt) do{ if((tt)+3<NT){WAIT_BAR(2);} else if((tt)+2<NT){WAIT_BAR(1);} else {WAIT_BAR(0);} }while(0)
  for(;t+1<NT;t+=2){
    STEP(pB0,pB1,pA0,pA1,t,(t+3<NT),(t+1<NT),(t+1<NT));       ENDW(t);   RESC(); ROT();
    STEP(pA0,pA1,pB0,pB1,t+1,(t+4<NT),(t+2<NT),(t+2<NT));     ENDW(t+1); RESC(); ROT();
  }
  STEP(pB0,pB1,pA0,pA1,NT-1,false,false,false); RESC();
  { float sacc=pB0[0]+pB0[1]; _Pragma("unroll") for(int r=2;r<16;++r)sacc+=pB0[r]; _Pragma("unroll") for(int r=0;r<16;++r)sacc+=pB1[r]; l_reg+=sacc;
    pw0=(u32x4){PKW(pB0,0),PKW(pB0,2),PKW(pB0,4),PKW(pB0,6)};pw1=(u32x4){PKW(pB0,8),PKW(pB0,10),PKW(pB0,12),PKW(pB0,14)};pw2=(u32x4){PKW(pB1,0),PKW(pB1,2),PKW(pB1,4),PKW(pB1,6)};pw3=(u32x4){PKW(pB1,8),PKW(pB1,10),PKW(pB1,12),PKW(pB1,14)};
    SBAR(); pv(o,vb0+sl_cur,PAF(0),PAF(1),PAF(2),PAF(3)); }
  #undef PKW
  #undef PAF
  #undef VFR
  #undef PIN
  #undef MX3
  #undef GAPA
  #undef GAPB
  #undef EX
  #undef VRD
  #undef KRD
  #undef STEP
  #undef ENDW
  {auto rr=__builtin_amdgcn_permlane32_swap(__float_as_uint(l_reg),__float_as_uint(l_reg),false,false);l_reg=__uint_as_float(rr[0])+__uint_as_float(rr[1]);}
  if(hi==0)wsf[32+r32]=l_reg;asm volatile("s_waitcnt lgkmcnt(0)":::"memory");
  float rli[16];
  #pragma unroll
  for(int r=0;r<16;++r)rli[r]=__builtin_amdgcn_rcpf(wsf[32+crow(r,hi)]);
  bf16*Ow=O+(rowbase+q0+wid*QBLK)*DM+oc;
  { bf16*stg=(bf16*)(shm+LDS_OST)+wid*2048;
    #pragma unroll
    for(int r=0;r<16;++r){const int orow=crow(r,hi);
      #pragma unroll
      for(int d0=0;d0<2;++d0)stg[orow*64+d0*32+r32]=__float2bfloat16(o[d0][r]*rli[r]);}
    asm volatile("s_waitcnt lgkmcnt(0)":::"memory");
    #pragma unroll
    for(int i=0;i<4;++i){const int row=i*8+(lane>>3),ch=lane&7; const u32x4 v=*(const u32x4*)(stg+row*64+ch*8); ATTN_STORE16(Ow+(long)row*DM+ch*8,v);} }
  asm volatile("s_waitcnt lgkmcnt(0)\n\ts_barrier":::"memory");
  #undef DMA_K
  #undef DMA_V
  #undef CMASK
  #undef START
  #undef RESC
  #undef ROT
}
constexpr int ATTN_LDS_BYTES=LDS_BYTES;
#undef SBAR
#undef WAIT_BAR
}
#include <hip/hip_bf16.h>
#include <cmath>
#ifndef ATTN_QLDS
#define ATTN_QLDS 1
#endif
namespace attn_nat {
using bf16=__hip_bfloat16;
using bf16x8=__attribute__((ext_vector_type(8)))short;
using s16x4=__attribute__((ext_vector_type(4)))short;
using f32x16=__attribute__((ext_vector_type(16)))float;
using u32x4=__attribute__((ext_vector_type(4)))unsigned;
constexpr int BATCH=2,NHEAD=16,SEQ=8192,D=64,DM=NHEAD*D;
constexpr int NW=8,QBLK=32,QB=QBLK*NW,KVBLK=64,NQB=SEQ/QB;
constexpr int ATTN_PITCH=DM, ATTN_UNIT_ROWS=QB;
__device__ __forceinline__ int crow(int r,int hi){return (r&3)+8*(r>>2)+4*hi;}
#define SBAR() __builtin_amdgcn_sched_barrier(0)
typedef const __attribute__((address_space(3))) float* lds_cfptr;
__device__ __forceinline__ void cbias(f32x16&p0,f32x16&p1,int jb,int qrel,int hi,lds_cfptr bt){
  const float NEG=-INFINITY; const int kb=64*jb+4*hi;
  #pragma unroll
  for(int r=0;r<16;++r){const int d0=qrel-(kb+(r&3)+8*(r>>2)),d1=d0-32;
    const unsigned c0=(unsigned)d0<128u?(unsigned)d0:128u,c1=(unsigned)d1<128u?(unsigned)d1:128u;
    const float v0=p0[r]+bt[c0],v1=p1[r]+bt[c1];
    p0[r]=d0<0?NEG:v0; p1[r]=d1<0?NEG:v1;
    if((r&3)==3)__builtin_amdgcn_sched_barrier(0);}
}
constexpr int NSLOT=3, SLOTB=8192;
constexpr int LDS_K=0, LDS_V=NSLOT*SLOTB, LDS_WS=3*NSLOT*SLOTB, LDS_OST=LDS_WS+NW*64*4, LDS_BYTES=LDS_OST+NW*4096;
constexpr float C2=0.125f*1.4426950408889634f;
__device__ __forceinline__ void glds16(const void*sbase,unsigned voff,unsigned lds_dst){unsigned keep;
  asm volatile("s_mov_b32 %0, m0\n\ts_mov_b32 m0, %3\n\ts_nop 0\n\tglobal_load_lds_dwordx4 %1, %2\n\ts_mov_b32 m0, %0":"=&s"(keep):"v"(voff),"s"(sbase),"s"(lds_dst):"memory");}
__device__ __forceinline__ float max3f(float a,float b,float c){float r;asm("v_max3_f32 %0, %1, %2, %3":"=v"(r):"v"(a),"v"(b),"v"(c));return r;}
__device__ __forceinline__ float max2f(float a,float b){float r;asm("v_max_f32_e32 %0, %1, %2":"=v"(r):"v"(a),"v"(b));return r;}
__device__ __forceinline__ float fadd_s(float a,float b){float r;asm("v_add_f32_e32 %0, %1, %2":"=v"(r):"v"(a),"v"(b));return r;}
__device__ __forceinline__ float fsub_s(float a,float b){float r;asm("v_sub_f32_e32 %0, %1, %2":"=v"(r):"v"(a),"v"(b));return r;}
typedef float f32x2_t __attribute__((ext_vector_type(2))); typedef __bf16 bf16x2_t __attribute__((ext_vector_type(2)));
__device__ __forceinline__ unsigned cvtpk_s(float lo,float hi){f32x2_t v={lo,hi};bf16x2_t b=__builtin_convertvector(v,bf16x2_t);return __builtin_bit_cast(unsigned,b);}
#define WAIT_BAR(N) asm volatile("s_waitcnt vmcnt(" #N ") lgkmcnt(0)\n\ts_barrier":::"memory")

__device__ __forceinline__ void qkt(f32x16&p0,f32x16&p1,const char*Kslot,const bf16x8*qr,const f32x16&negm,int r32,int hi){
  const char*kb=Kslot+hi*1024+r32*16;
  #pragma unroll
  for(int d0=0;d0<4;++d0){
    const bf16x8 b0=*reinterpret_cast<const bf16x8*>(kb+d0*2048);
    const bf16x8 b1=*reinterpret_cast<const bf16x8*>(kb+d0*2048+512);
    if(d0==0){p0=__builtin_amdgcn_mfma_f32_32x32x16_bf16(b0,qr[0],negm,0,0,0);p1=__builtin_amdgcn_mfma_f32_32x32x16_bf16(b1,qr[0],negm,0,0,0);}
    else{p0=__builtin_amdgcn_mfma_f32_32x32x16_bf16(b0,qr[d0],p0,0,0,0);p1=__builtin_amdgcn_mfma_f32_32x32x16_bf16(b1,qr[d0],p1,0,0,0);}}
}
typedef __attribute__((address_space(3))) const char* lds_cptr;
typedef short v4i16_t __attribute__((ext_vector_type(4)));
__device__ __forceinline__ void kload8(bf16x8*kf,lds_cptr kp){
  kf[0]=*(const __attribute__((address_space(3))) bf16x8*)(kp);      kf[1]=*(const __attribute__((address_space(3))) bf16x8*)(kp+512);
  kf[2]=*(const __attribute__((address_space(3))) bf16x8*)(kp+2048); kf[3]=*(const __attribute__((address_space(3))) bf16x8*)(kp+2560);
  kf[4]=*(const __attribute__((address_space(3))) bf16x8*)(kp+4096); kf[5]=*(const __attribute__((address_space(3))) bf16x8*)(kp+4608);
  kf[6]=*(const __attribute__((address_space(3))) bf16x8*)(kp+6144); kf[7]=*(const __attribute__((address_space(3))) bf16x8*)(kp+6656);
}
__device__ __forceinline__ void kload2(bf16x8*kf,lds_cptr kp,int j){ kf[2*j]=*(const __attribute__((address_space(3))) bf16x8*)(kp+j*2048); kf[2*j+1]=*(const __attribute__((address_space(3))) bf16x8*)(kp+j*2048+512); }
__device__ __forceinline__ s16x4 vtr(lds_cptr p){ return __builtin_bit_cast(s16x4,__builtin_amdgcn_ds_read_tr16_b64_v4i16((__attribute__((address_space(3))) v4i16_t*)p)); }
__device__ __forceinline__ float rowmax(const f32x16&p0,const f32x16&p1){
  float a=max3f(p0[0],p0[1],p1[0]),b=max3f(p0[2],p0[3],p1[1]);a=max3f(a,p1[2],p1[3]);
  #pragma unroll
  for(int r=4;r<16;r+=4){a=max3f(a,p0[r],p0[r+1]);b=max3f(b,p0[r+2],p0[r+3]);a=max3f(a,p1[r],p1[r+1]);b=max3f(b,p1[r+2],p1[r+3]);}
  const float m=max2f(a,b);
  auto rr=__builtin_amdgcn_permlane32_swap(__float_as_uint(m),__float_as_uint(m),false,false);
  return max2f(__uint_as_float(rr[0]),__uint_as_float(rr[1]));
}
__device__ __forceinline__ void pv(f32x16*o,int vb,bf16x8 pa0,bf16x8 pa1,bf16x8 pa2,bf16x8 pa3){
  #pragma unroll
  for(int d0=0;d0<4;++d0){s16x4 lo[4],hi[4];
    #pragma unroll
    for(int ks=0;ks<4;++ks){
      asm volatile("ds_read_b64_tr_b16 %0,%1 offset:%c2":"=&v"(lo[ks]):"v"(vb),"i"(d0*4096+ks*1024):"memory");
      asm volatile("ds_read_b64_tr_b16 %0,%1 offset:%c2":"=&v"(hi[ks]):"v"(vb),"i"(d0*4096+ks*1024+512):"memory");}
    asm volatile("s_waitcnt lgkmcnt(0)":::"memory");SBAR();
    #define PK(k) (bf16x8){lo[k][0],lo[k][1],lo[k][2],lo[k][3],hi[k][0],hi[k][1],hi[k][2],hi[k][3]}
    o[d0]=__builtin_amdgcn_mfma_f32_32x32x16_bf16(pa0,PK(0),o[d0],0,0,0);
    o[d0]=__builtin_amdgcn_mfma_f32_32x32x16_bf16(pa1,PK(1),o[d0],0,0,0);
    o[d0]=__builtin_amdgcn_mfma_f32_32x32x16_bf16(pa2,PK(2),o[d0],0,0,0);
    o[d0]=__builtin_amdgcn_mfma_f32_32x32x16_bf16(pa3,PK(3),o[d0],0,0,0);
    #undef PK
  }
}

#ifndef ATTN_STORE16
#define ATTN_STORE16(p,v) (*(u32x4*)(p)=(v))
#endif
template<int THRL> __device__ __forceinline__ void attn_unit(int b,int qb,const bf16*Q,const bf16*__restrict__ K,const bf16*__restrict__ V,bf16*O,int qc,int kc,int vc,int oc,lds_cfptr bt,char*shm){
  int tid_=threadIdx.x; asm volatile("":"+v"(tid_)); const int tid=tid_,lane=tid&63,r32=lane&31,hi=lane>>5; const int wid=__builtin_amdgcn_readfirstlane(tid>>6);
  const long rowbase=(long)b*SEQ; const int q0=qb*QB;
  const bf16*Qw=Q+(rowbase+q0+wid*QBLK)*DM+qc;
  const bf16*Kh=K+rowbase*DM+kc,*Vh=V+rowbase*DM+vc;
  const unsigned lds0=(unsigned)(uintptr_t)shm;
  float*wsf=(float*)(shm+LDS_WS)+wid*64;
  const unsigned koff=(unsigned)((lane*DM+wid*8)*2);
  const unsigned voff=(unsigned)(((16*(wid&3)+(lane>>2))*DM+(wid>>2)*32+(lane&3)*8)*2);
  const unsigned kdst=lds0+LDS_K+wid*1024, vdst=lds0+LDS_V+wid*1024;
  #define DMA_K(t,slot) glds16(Kh+(long)(t)*KVBLK*DM,koff,(unsigned)__builtin_amdgcn_readfirstlane(kdst+(slot)))
  #define DMA_V(t,slot) do{ glds16(Vh+(long)(t)*KVBLK*DM,voff,(unsigned)__builtin_amdgcn_readfirstlane(vdst+2*(slot))); glds16(Vh+(long)(t)*KVBLK*DM+64,voff,(unsigned)__builtin_amdgcn_readfirstlane(vdst+2*(slot)+8192)); }while(0)
  const char*Kbase=shm+LDS_K; bf16x8 kf[8];
  const lds_cptr shm3=(lds_cptr)shm; const lds_cptr kp0=shm3+LDS_K+hi*1024+r32*16; const lds_cptr vp0=shm3+LDS_V+((lane>>4)&1)*32+(lane&3)*8+(4*hi+((lane&15)>>2))*64;
  const int NT=(q0+QB)/KVBLK;
  DMA_K(0,0);DMA_V(0,0);DMA_K(1,SLOTB);
  bf16x8 qr[4];
  #pragma unroll
  for(int d0=0;d0<4;++d0)qr[d0]=*reinterpret_cast<const bf16x8*>(&Qw[(long)r32*DM+d0*16+hi*8]);
#if ATTN_QLDS
  const lds_cptr qst=shm3+LDS_OST+wid*4096+r32*128;
  #pragma unroll
  for(int d0=0;d0<4;++d0)*(__attribute__((address_space(3))) bf16x8*)(shm3+LDS_OST+wid*4096+r32*128+(((2*d0+hi)^(r32&7))<<4))=qr[d0];
  #define QF(d) (*(const __attribute__((address_space(3))) bf16x8*)(qst+(((2*(d)+hi)^(r32&7))<<4)))
#else
  #define QF(d) qr[d]
#endif
  float mhat=0.f,l_reg=0.f;f32x16 o[4]; { float z_=0.f; asm volatile("":"+v"(z_));
    _Pragma("unroll") for(int r=0;r<16;++r){o[0][r]=z_;o[1][r]=z_;o[2][r]=z_;o[3][r]=z_;} }
  const int qrel=wid*QBLK+r32;
  #define CMASK(P0,P1,t) do{int jb_=(t)-(NT-4); if(jb_>=-2 && (wid*QBLK-(64*jb_+63))<128)cbias(P0,P1,jb_,qrel,hi,bt);}while(0)
  bool resc=false;
  #define START(P0,P1) do{ const float rm=rowmax(P0,P1); resc=false; \
    { const float dl=rm; mhat=fadd_s(mhat,dl); \
      _Pragma("unroll") for(int r=0;r<16;++r){P0[r]=fsub_s(P0[r],dl);P1[r]=fsub_s(P1[r],dl);} } \
    _Pragma("unroll") for(int r=0;r<16;++r)P0[r]=__builtin_amdgcn_exp2f(P0[r]); }while(0)
  #define RESC() do{ if(resc){ asm volatile("s_waitcnt lgkmcnt(0)":::"memory"); \
      _Pragma("unroll") for(int d_=0;d_<4;++d_) _Pragma("unroll") for(int r=0;r<16;++r)o[d_][r]*=wsf[crow(r,hi)]; } }while(0)
  f32x16 pA0,pA1,pB0,pB1;
  int sl_prev=0,sl_cur=0,sl_next=SLOTB;
  #define ROT() do{sl_prev=sl_cur;sl_cur=sl_next;sl_next=(sl_next==(NSLOT-1)*SLOTB)?0:sl_next+SLOTB;}while(0)
  DMA_K(2,2*SLOTB);
  WAIT_BAR(4);
  qkt(pA0,pA1,Kbase,qr,f32x16{},r32,hi);asm volatile("s_nop 15\n\ts_nop 7":"+v"(pA0),"+v"(pA1));CMASK(pA0,pA1,0);
  START(pA0,pA1);
  _Pragma("unroll") for(int r=0;r<16;++r)pA1[r]=__builtin_amdgcn_exp2f(pA1[r]);
  WAIT_BAR(0);
  DMA_K(3,0);DMA_V(1,SLOTB);
  ROT();
  kload8(kf,kp0+sl_cur);
  WAIT_BAR(3);
  s16x4 vlo[8],vhi[8]; u32x4 pw0,pw1,pw2,pw3;
  #define PKW(P,B) cvtpk_s(P[B],P[B+1])
  #define PAF(k) __builtin_bit_cast(bf16x8,pw##k)
  #define VFR(i) (bf16x8){vlo[i][0],vlo[i][1],vlo[i][2],vlo[i][3],vhi[i][0],vhi[i][1],vhi[i][2],vhi[i][3]}
  #define PIN(x) asm volatile("":"+v"(x))
  #define MX3(a,b,c) __builtin_fmaxf(__builtin_fmaxf((a),(b)),(c))
  #define GAPA(MF,A0,A1,A2,A3,W0,W1,PW) do{ MF; sacc+=A0; sacc+=A1; sacc+=A2; sacc+=A3; PIN(sacc); W0; W1; PIN(PW); SBAR(); }while(0)
  #define EX(v) __builtin_amdgcn_exp2f(v)
  #define GAPB(MF,X,B) do{ MF; X[B]=EX(X[B]); X[B+1]=EX(X[B+1]); X[B+2]=EX(X[B+2]); X[B+3]=EX(X[B+3]); PIN(X); SBAR(); }while(0)
  #define GAPB2(MF,X,B) do{ MF; X[B]=EX(X[B]); X[B+1]=EX(X[B+1]); PIN(X); SBAR(); }while(0)
  #define VRD2(i) do{ vlo[i]=vtr(vp_+((2+((i)>>2))*4096+((i)&3)*1024)); vhi[i]=vtr(vp_+((2+((i)>>2))*4096+((i)&3)*1024+512)); SBAR(); }while(0)
  #define VRD(i) do{ vlo[i]=vtr(vp_+(((i)>>2)*4096+((i)&3)*1024)); vhi[i]=vtr(vp_+(((i)>>2)*4096+((i)&3)*1024+512)); }while(0)
  #define KRD(G,j) do{ if(G){ kload2(kf,kp0+sl_next,j); SBAR(); } }while(0)
  #define STEP(C0,C1,P0,P1,t,GK,GV,GL) do{ SBAR(); \
    const lds_cptr vp_=vp0+2*sl_prev; \
    VRD(0); SBAR(); float sacc=(P0[0]+P0[1]); \
    GAPA(C0=__builtin_amdgcn_mfma_f32_32x32x16_bf16(kf[0],QF(0),f32x16{},0,0,0), P0[2],P0[3],P0[4],P0[5],     pw0[0]=PKW(P0,0), pw0[1]=PKW(P0,2), pw0); \
    VRD(4); SBAR(); GAPA(C1=__builtin_amdgcn_mfma_f32_32x32x16_bf16(kf[1],QF(0),f32x16{},0,0,0), P0[6],P0[7],P0[8],P0[9],     pw0[2]=PKW(P0,4), pw0[3]=PKW(P0,6), pw0); \
    VRD(1); SBAR(); GAPA(C0=__builtin_amdgcn_mfma_f32_32x32x16_bf16(kf[2],QF(1),C0,0,0,0),   P0[10],P0[11],P0[12],P0[13], pw1[0]=PKW(P0,8), pw1[1]=PKW(P0,10), pw1); \
    VRD(5); SBAR(); GAPA(C1=__builtin_amdgcn_mfma_f32_32x32x16_bf16(kf[3],QF(1),C1,0,0,0),   P0[14],P0[15],P1[0],P1[1],   pw1[2]=PKW(P0,12),pw1[3]=PKW(P0,14), pw1); \
    VRD(2); SBAR(); GAPA(C0=__builtin_amdgcn_mfma_f32_32x32x16_bf16(kf[4],QF(2),C0,0,0,0),   P1[2],P1[3],P1[4],P1[5],     pw2[0]=PKW(P1,0), pw2[1]=PKW(P1,2), pw2); \
    VRD(6); SBAR(); GAPA(C1=__builtin_amdgcn_mfma_f32_32x32x16_bf16(kf[5],QF(2),C1,0,0,0),   P1[6],P1[7],P1[8],P1[9],     pw2[2]=PKW(P1,4), pw2[3]=PKW(P1,6), pw2); \
    VRD(3); SBAR(); GAPA(C0=__builtin_amdgcn_mfma_f32_32x32x16_bf16(kf[6],QF(3),C0,0,0,0),   P1[10],P1[11],P1[12],P1[13], pw3[0]=PKW(P1,8), pw3[1]=PKW(P1,10), pw3); \
    VRD(7); SBAR(); GAPA(C1=__builtin_amdgcn_mfma_f32_32x32x16_bf16(kf[7],QF(3),C1,0,0,0),   P1[14],P1[15],0.f,0.f,       pw3[2]=PKW(P1,12),pw3[3]=PKW(P1,14), pw3); \
    l_reg+=sacc; \
    if(GK){DMA_K((t)+3,sl_cur);} if(GV){DMA_V((t)+1,sl_next);} \
    _Pragma("unroll") for(int r=0;r<16;++r){C0[r]-=mhat;C1[r]-=mhat;} \
    SBAR(); CMASK(C0,C1,t); SBAR(); \
    { float a=MX3(C0[0],C0[1],C1[0]),b=MX3(C0[2],C0[3],C1[1]); a=MX3(a,C1[2],C1[3]); \
      _Pragma("unroll") for(int r=4;r<16;r+=4){a=MX3(a,C0[r],C0[r+1]);b=MX3(b,C0[r+2],C0[r+3]);a=MX3(a,C1[r],C1[r+1]);b=MX3(b,C1[r+2],C1[r+3]);} \
      float rm=__builtin_fmaxf(a,b); { auto rr=__builtin_amdgcn_permlane32_swap(__float_as_uint(rm),__float_as_uint(rm),false,false); rm=__builtin_fmaxf(__uint_as_float(rr[0]),__uint_as_float(rr[1])); } \
      resc=false; \
      if(__builtin_expect(__any(rm>(float)THRL),0)){ const float dl=__builtin_fmaxf(rm,0.f); mhat+=dl; \
        _Pragma("unroll") for(int r=0;r<16;++r){C0[r]-=dl;C1[r]-=dl;} \
        const float f=__builtin_amdgcn_exp2f(-dl); l_reg*=f; if(hi==0)wsf[r32]=f; resc=true; } } \
    SBAR(); \
    GAPB2(o[0]=__builtin_amdgcn_mfma_f32_32x32x16_bf16(PAF(0),VFR(0),o[0],0,0,0), C0,0);  VRD2(0); \
    GAPB2(o[1]=__builtin_amdgcn_mfma_f32_32x32x16_bf16(PAF(0),VFR(4),o[1],0,0,0), C0,2);  VRD2(4); \
    GAPB2(o[0]=__builtin_amdgcn_mfma_f32_32x32x16_bf16(PAF(1),VFR(1),o[0],0,0,0), C0,4);  VRD2(1); \
    GAPB2(o[1]=__builtin_amdgcn_mfma_f32_32x32x16_bf16(PAF(1),VFR(5),o[1],0,0,0), C0,6);  VRD2(5); \
    GAPB2(o[0]=__builtin_amdgcn_mfma_f32_32x32x16_bf16(PAF(2),VFR(2),o[0],0,0,0), C0,8);  VRD2(2); \
    GAPB2(o[1]=__builtin_amdgcn_mfma_f32_32x32x16_bf16(PAF(2),VFR(6),o[1],0,0,0), C0,10); VRD2(6); \
    GAPB2(o[0]=__builtin_amdgcn_mfma_f32_32x32x16_bf16(PAF(3),VFR(3),o[0],0,0,0), C0,12); VRD2(3); \
    GAPB2(o[1]=__builtin_amdgcn_mfma_f32_32x32x16_bf16(PAF(3),VFR(7),o[1],0,0,0), C0,14); VRD2(7); \
    GAPB2(o[2]=__builtin_amdgcn_mfma_f32_32x32x16_bf16(PAF(0),VFR(0),o[2],0,0,0), C1,0); \
    GAPB2(o[3]=__builtin_amdgcn_mfma_f32_32x32x16_bf16(PAF(0),VFR(4),o[3],0,0,0), C1,2); \
    KRD(GL,0); GAPB2(o[2]=__builtin_amdgcn_mfma_f32_32x32x16_bf16(PAF(1),VFR(1),o[2],0,0,0), C1,4); \
    GAPB2(o[3]=__builtin_amdgcn_mfma_f32_32x32x16_bf16(PAF(1),VFR(5),o[3],0,0,0), C1,6); \
    KRD(GL,1); GAPB2(o[2]=__builtin_amdgcn_mfma_f32_32x32x16_bf16(PAF(2),VFR(2),o[2],0,0,0), C1,8); \
    GAPB2(o[3]=__builtin_amdgcn_mfma_f32_32x32x16_bf16(PAF(2),VFR(6),o[3],0,0,0), C1,10); \
    KRD(GL,2); GAPB2(o[2]=__builtin_amdgcn_mfma_f32_32x32x16_bf16(PAF(3),VFR(3),o[2],0,0,0), C1,12); \
    GAPB2(o[3]=__builtin_amdgcn_mfma_f32_32x32x16_bf16(PAF(3),VFR(7),o[3],0,0,0), C1,14); \
    KRD(GL,3); \
    }while(0)
  int t=1;
  #undef CMASK
  #define CMASK(P0,P1,t) do{}while(0)
  for(;t+7<NT;t+=2){
    STEP(pB0,pB1,pA0,pA1,t,true,true,true);     WAIT_BAR(3); RESC(); ROT();
    STEP(pA0,pA1,pB0,pB1,t+1,true,true,true);   WAIT_BAR(3); RESC(); ROT();
  }
  #undef CMASK
  int tb_=threadIdx.x; asm volatile("":"+v"(tb_)); const int qrel_b=(tb_>>6)*QBLK+(tb_&31),hi_b=(tb_&63)>>5;
  #define CMASK(P0,P1,t) do{int jb_=(t)-(NT-4); if(jb_>=-2 && (wid*QBLK-(64*jb_+63))<128)cbias(P0,P1,jb_,qrel_b,hi_b,bt);}while(0)
  #define ENDW(tt) do{ if((tt)+3<NT){WAIT_BAR(3);} else if((tt)+2<NT){WAIT_BAR(2);} else {WAIT_BAR(0);} }while(0)
  for(;t+1<NT;t+=2){
    STEP(pB0,pB1,pA0,pA1,t,(t+3<NT),(t+1<NT),(t+1<NT));       ENDW(t);   RESC(); ROT();
    STEP(pA0,pA1,pB0,pB1,t+1,(t+4<NT),(t+2<NT),(t+2<NT));     ENDW(t+1); RESC(); ROT();
  }
  STEP(pB0,pB1,pA0,pA1,NT-1,false,false,false); RESC();
  { float sacc=pB0[0]+pB0[1]; _Pragma("unroll") for(int r=2;r<16;++r)sacc+=pB0[r]; _Pragma("unroll") for(int r=0;r<16;++r)sacc+=pB1[r]; l_reg+=sacc;
    pw0=(u32x4){PKW(pB0,0),PKW(pB0,2),PKW(pB0,4),PKW(pB0,6)};pw1=(u32x4){PKW(pB0,8),PKW(pB0,10),PKW(pB0,12),PKW(pB0,14)};pw2=(u32x4){PKW(pB1,0),PKW(pB1,2),PKW(pB1,4),PKW(pB1,6)};pw3=(u32x4){PKW(pB1,8),PKW(pB1,10),PKW(pB1,12),PKW(pB1,14)};
    SBAR(); { int td_=threadIdx.x; asm volatile("":"+v"(td_)); const int ld_=td_&63; const int vb0=(int)((unsigned)(uintptr_t)shm+LDS_V)+((ld_>>4)&1)*32+(ld_&3)*8+(4*(ld_>>5)+((ld_&15)>>2))*64;
      pv(o,vb0+2*sl_cur,PAF(0),PAF(1),PAF(2),PAF(3)); } }
  #undef PKW
  #undef PAF
  #undef VFR
  #undef PIN
  #undef MX3
  #undef GAPA
  #undef GAPB
  #undef GAPB2
  #undef VRD2
  #undef EX
  #undef VRD
  #undef KRD
  #undef STEP
  #undef ENDW
  { int te_=threadIdx.x; asm volatile("":"+v"(te_)); const int lane_e=te_&63,r32e=lane_e&31,hie=lane_e>>5; const int wide=__builtin_amdgcn_readfirstlane(te_>>6);
  float*wsfe=(float*)(shm+LDS_WS)+wide*64;
  {auto rr=__builtin_amdgcn_permlane32_swap(__float_as_uint(l_reg),__float_as_uint(l_reg),false,false);l_reg=__uint_as_float(rr[0])+__uint_as_float(rr[1]);}
  if(hie==0)wsfe[32+r32e]=l_reg;asm volatile("s_waitcnt lgkmcnt(0)":::"memory");
  float rli[16];
  #pragma unroll
  for(int r=0;r<16;++r)rli[r]=__builtin_amdgcn_rcpf(wsfe[32+crow(r,hie)]);
  bf16*Ow=O+((long)b*SEQ+qb*QB+wide*QBLK)*DM+oc;
  { bf16*stg=(bf16*)(shm+LDS_OST)+wide*2048;
    #pragma unroll
    for(int hf=0;hf<2;++hf){
      #pragma unroll
      for(int r=0;r<16;++r){const int orow=crow(r,hie);
        #pragma unroll
        for(int d0=0;d0<2;++d0)stg[orow*64+d0*32+r32e]=__float2bfloat16(o[2*hf+d0][r]*rli[r]);}
      asm volatile("s_waitcnt lgkmcnt(0)":::"memory");
      #pragma unroll
      for(int i=0;i<4;++i){const int row=i*8+(lane_e>>3),ch=lane_e&7; const u32x4 v=*(const u32x4*)(stg+row*64+ch*8); ATTN_STORE16(Ow+(long)row*DM+hf*64+ch*8,v);}
      asm volatile("s_waitcnt lgkmcnt(0)":::"memory"); } } }
  asm volatile("s_waitcnt lgkmcnt(0)\n\ts_barrier":::"memory");
  #undef DMA_K
  #undef DMA_V
  #undef CMASK
  #undef START
  #undef RESC
  #undef ROT
  #undef QF
}
constexpr int ATTN_LDS_BYTES=LDS_BYTES;
#undef SBAR
#undef WAIT_BAR
}
#define XROW(m0) ((C.G == 256) ? (((gw >> 8) << 11) + (gw & 255) + (((m0) - gw) >> 11) * 256) : (m0))
struct Ctx {
    LAS unsigned char* lds; char* ldsg; int tid, lane, wave, G, vcu;
    const float* in[23]; float* out; unsigned char* ws;
};
#define WSP(T, off) ((T*)(C.ws + (off)))
#define PHASE_IDS() Ctx C = C0; { int t_ = threadIdx.x; asm volatile("" : "+v"(t_)); C.tid = t_; C.lane = t_ & 63; C.wave = __builtin_amdgcn_readfirstlane(t_ >> 6); }

struct ConvDesc { const float* src; bf16_t* dst; int N, K; };
__device__ __forceinline__ ConvDesc conv_desc(const Ctx& C, int it) {
    constexpr int I_IN = 16 * 160, I_BR = 8 * 32, I_GU1 = 16 * 64, I_GU = NE * I_GU1, I_D1 = 16 * 32, I_D = NE * I_D1;
    const float* W; bf16_t* WT; int K, N, kb, nb, orow; int r = it;
    if (r < I_GU) { const int e = r / I_GU1, q = r % I_GU1; kb = q / 64; nb = q % 64; const int n0 = 32 * nb, half = n0 >> 10, rem = n0 & 1023;
        W = C.in[18] + (size_t)e * 1024 * 2048; WT = WSP(bf16_t, WS_WGU) + (size_t)e * 2048 * 1024; K = 1024; N = 2048; orow = (rem >> 7) * 256 + half * 128 + (rem & 127); }
    else if ((r -= I_GU) < I_D) { const int e = r / I_D1, q = r % I_D1; kb = q / 32; nb = q % 32; W = C.in[20] + (size_t)e * 1024 * 1024; WT = WSP(bf16_t, WS_WD) + (size_t)e * 1024 * 1024; K = 1024; N = 1024; orow = 32 * nb; }
    else if ((r -= I_D) < I_IN) { kb = r / 160; nb = r % 160; W = C.in[6]; WT = WSP(bf16_t, WS_WIN); K = 1024; N = INW; orow = 32 * nb; }
    else if ((r -= I_IN) < I_BR) { kb = r / 32; nb = r % 32; W = C.in[12]; WT = WSP(bf16_t, WS_WBR); K = 1024; N = 1024; orow = 32 * nb; }
    else if ((r -= I_BR) < I_BR) { kb = r / 32; nb = r % 32; W = C.in[13]; WT = WSP(bf16_t, WS_WBR) + 512; K = 1024; N = 1024; orow = 32 * nb; }
    else { r -= I_BR; kb = r / 32; nb = r % 32; W = C.in[14]; WT = WSP(bf16_t, WS_WOUT); K = 1024; N = 1024; orow = 32 * nb; }
    ConvDesc d; d.src = W + (size_t)(64 * kb) * N + 32 * nb; d.dst = WT + (size_t)orow * K + 64 * kb; d.N = N; d.K = K; return d;
}
__device__ __forceinline__ void conv_load(const ConvDesc& d, f32x4 (&v)[8], int lane) {
    const int kr = lane >> 3, nc = lane & 7;
#pragma unroll
    for (int i = 0; i < 8; ++i) v[i] = *(const f32x4*)(d.src + (size_t)(8 * i + kr) * d.N + 4 * nc);
}
__device__ __forceinline__ void conv_finish(const ConvDesc& d, const f32x4 (&v)[8], LAS float* scr, int lane) {
    const int kr = lane >> 3, nc = lane & 7;
#pragma unroll
    for (int i = 0; i < 8; ++i) { LAS float* s = scr + (8 * i + kr) * 33 + 4 * nc; s[0] = v[i][0]; s[1] = v[i][1]; s[2] = v[i][2]; s[3] = v[i][3]; }
    LDS_WAIT(); asm volatile("" ::: "memory");
    const int c = lane & 7;
#pragma unroll
    for (int j = 0; j < 4; ++j) { const int n = (lane >> 3) + 8 * j; const LAS float* s = scr + (8 * c) * 33 + n;
        u32x4 o; o.x = cvt_pk_bf16(s[0 * 33], s[1 * 33]); o.y = cvt_pk_bf16(s[2 * 33], s[3 * 33]); o.z = cvt_pk_bf16(s[4 * 33], s[5 * 33]); o.w = cvt_pk_bf16(s[6 * 33], s[7 * 33]);
        *(u32x4*)(d.dst + (size_t)n * d.K + 8 * c) = o; }
    LDS_WAIT(); asm volatile("" ::: "memory");
}
__device__ __forceinline__ void conv_range(const Ctx& C, int lo, int hi, int wi, int nw, LAS float* scr) {
    const int first = lo + wi;
    if (first < hi) {
        ConvDesc d0 = conv_desc(C, first), d1 = d0; f32x4 v0[8], v1[8]; conv_load(d0, v0, C.lane);
        for (int it = first; it < hi; it += 2 * nw) {
            const int n1 = it + nw, n2 = it + 2 * nw;
            d1 = conv_desc(C, n1 < hi ? n1 : it); conv_load(d1, v1, C.lane);
            conv_finish(d0, v0, scr, C.lane);
            if (n1 >= hi) break;
            d0 = conv_desc(C, n2 < hi ? n2 : it); conv_load(d0, v0, C.lane);
            conv_finish(d1, v1, scr, C.lane);
        }
    }
}
template <int MODE> __device__ __noinline__ void conv_q_blocks(const float* Wgu, unsigned char* ws, LAS unsigned char* lds, int wave, int first, int stride) {
    int lane_ = (int)__builtin_amdgcn_mbcnt_hi(~0u, __builtin_amdgcn_mbcnt_lo(~0u, 0u)); asm volatile("" : "+v"(lane_));
    const int lane = lane_, tid = wave * 64 + lane, lr = tid >> 3, c4 = tid & 7, n = tid & 31, kg = tid >> 5;
    LAS float* blk = (LAS float*)lds;
    LAS float* wmx = (LAS float*)(lds + LDSCTL_OFF + 14336);
    f32x4 v[16];
    constexpr int NBLK = MODE == 0 ? NE * 64 : 128, LDW = MODE == 0 ? 2048 : INW;
#define QB_SRC(b_) (MODE == 0 ? Wgu + (size_t)((b_) >> 6) * 1024 * 2048 + 32 * ((b_) & 63) : Wgu + 32 * ((b_) < 48 ? (b_) : (b_) + 32))
    if (first < NBLK) { const float* W = QB_SRC(first) + 4 * c4 + (size_t)lr * LDW;
#pragma unroll
        for (int i = 0; i < 16; ++i) v[i] = *(const f32x4*)(W + (size_t)(64 * i) * LDW); }
    for (int bk = first; bk < NBLK; bk += stride) { const int e = MODE == 0 ? bk >> 6 : 0, n0 = MODE == 0 ? 32 * (bk & 63) : 32 * (bk < 48 ? bk : bk + 32), hgu = n0 >> 10, rem = n0 & 1023, orow = MODE == 0 ? (rem >> 7) * 256 + hgu * 128 + (rem & 127) : n0;
        f32x4 mx = (f32x4){0.f, 0.f, 0.f, 0.f};
#pragma unroll
        for (int i = 0; i < 16; ++i) { *(LAS f32x4*)(blk + (64 * i + lr) * 32 + 4 * c4) = v[i]; mx = __builtin_elementwise_max(mx, __builtin_elementwise_abs(v[i])); }
#pragma unroll
        for (int j = 0; j < 4; ++j) { float t = mx[j]; t = fmaxf(t, __shfl_xor(t, 8)); t = fmaxf(t, __shfl_xor(t, 16)); t = fmaxf(t, __shfl_xor(t, 32)); mx[j] = t; }
        if (lane < 8) *(LAS f32x4*)(wmx + wave * 32 + 4 * lane) = mx;
        { const int nk = bk + stride < NBLK ? bk + stride : bk;
          const float* W = QB_SRC(nk) + 4 * c4 + (size_t)lr * LDW;
#pragma unroll
          for (int i = 0; i < 16; ++i) v[i] = *(const f32x4*)(W + (size_t)(64 * i) * LDW); }
        LDS_WAIT(); __builtin_amdgcn_s_barrier(); asm volatile("" ::: "memory");
        float cm = wmx[n];
#pragma unroll
        for (int w = 1; w < 8; ++w) cm = fmaxf(cm, wmx[w * 32 + n]);
        const float inv = cm > 0.f ? 127.0f / cm : 0.f;
        if (kg == 0) ((float*)(ws + (MODE == 0 ? WS_SW : WS_SWIN)))[(size_t)e * 2048 + n0 + n] = cm > 0.f ? cm * (1.0f / 127.0f) : 1.0f;
        signed char* dst = (signed char*)(ws + (MODE == 0 ? WS_WGU : WS_WINQ)) + ((size_t)e * 2048 + orow + n) * 1024 + 64 * kg;
        const LAS float* src = blk + (64 * kg) * 32 + n;
#pragma unroll
        for (int s = 0; s < 4; ++s) { unsigned w4[4];
#pragma unroll
            for (int d = 0; d < 4; ++d) { int b[4];
#pragma unroll
                for (int k = 0; k < 4; ++k) b[k] = (int)fminf(fmaxf(__builtin_rintf(src[(16 * s + 4 * d + k) * 32] * inv), -127.0f), 127.0f);
                w4[d] = (unsigned)(b[0] & 255) | ((unsigned)(b[1] & 255) << 8) | ((unsigned)(b[2] & 255) << 16) | ((unsigned)b[3] << 24); }
            *(u32x4*)(dst + 16 * s) = (u32x4){w4[0], w4[1], w4[2], w4[3]}; }
        LDS_WAIT(); __builtin_amdgcn_s_barrier(); asm volatile("" ::: "memory");
    }
}
#undef QB_SRC
constexpr int CONV_MOE_ITEMS = NE * 16 * 64 + NE * 16 * 32;
constexpr int CONV_ALL_ITEMS = CONV_MOE_ITEMS + 16 * 160 + 2 * 8 * 32 + 16 * 32;
#ifndef NCONV_
#define NCONV_ 13
#endif
constexpr int NCONV = NCONV_;
__device__ __forceinline__ void p0_prologue(const Ctx& C0) {
    PHASE_IDS();
    LAS float* scr = (LAS float*)(C.lds + C.wave * 8448);
    const int gw = C.vcu * NWAVES + C.wave, NGW = C.G * NWAVES;
    conv_q_blocks<1>(C.in[6], C.ws, C.lds, C.wave, (int)blockIdx.x, C.G);
    __syncthreads();
    for (int it = gw; it < 16 * 32; it += NGW) { const int kb = it >> 5, nb = 48 + (it & 31);
        ConvDesc d; d.src = C.in[6] + (size_t)(64 * kb) * INW + 32 * nb; d.dst = WSP(bf16_t, WS_WIN) + (size_t)(32 * nb) * 1024 + 64 * kb; d.N = INW; d.K = 1024;
        f32x4 v[8]; conv_load(d, v, C.lane); conv_finish(d, v, scr, C.lane); }
    conv_range(C, CONV_MOE_ITEMS + 16 * 160, CONV_ALL_ITEMS, gw, NGW, scr);
    const float* cvec = C.in[1]; const float* wada = C.in[3]; float* adap = WSP(float, WS_ADAP);
    for (int it = gw; it < 96 * 16; it += NGW) { const int cc = it % 96, ks = it / 96; const int n = 64 * cc + C.lane; float a0 = 0.f, a1 = 0.f;
#pragma unroll 16
        for (int k = 0; k < 64; ++k) { const int kk = 64 * ks + k; const float w = wada[(size_t)kk * 6144 + n]; a0 += cvec[kk] * w; a1 += cvec[1024 + kk] * w; }
        adap[(ks * 2 + 0) * 6144 + n] = a0; adap[(ks * 2 + 1) * 6144 + n] = a1; }
}
__device__ __forceinline__ float ada_val(const Ctx& C, int b, int n) {
    const float* adap = WSP(const float, WS_ADAP); float s = C.in[4][n];
#pragma unroll
    for (int ks = 0; ks < 16; ++ks) s += adap[(ks * 2 + b) * 6144 + n];
    return s;
}
__device__ __forceinline__ void rms_mod_row(const float* xrow, bf16_t* orow, const LAS float* MA, const LAS float* MB, int lane, signed char* qrow, float* qscale) {
    const f32x4* xr = (const f32x4*)xrow + lane;
    f32x4 v[4]; float s = 0.f;
#pragma unroll
    for (int j = 0; j < 4; ++j) { v[j] = xr[64 * j]; s += (v[j][0] * v[j][0] + v[j][1] * v[j][1]) + (v[j][2] * v[j][2] + v[j][3] * v[j][3]); }
    const float rstd = 1.0f / sqrtf(wave_sum(s) * (1.0f / D) + RMS_EPS);
    u32x2* o8 = (u32x2*)orow + lane;
#pragma unroll
    for (int j = 0; j < 4; ++j) { const f32x4 a = *(const LAS f32x4*)(MA + 4 * lane + 256 * j), b = *(const LAS f32x4*)(MB + 4 * lane + 256 * j);
        const f32x4 h = v[j] * rstd * a + b; u32x2 w; w.x = pk2(h[0], h[1]); w.y = pk2(h[2], h[3]); o8[64 * j] = w; v[j] = h; }
    if (qrow) {
        float am = 0.f;
#pragma unroll
        for (int j = 0; j < 4; ++j)
#pragma unroll
            for (int k = 0; k < 4; ++k) am = fmaxf(am, fabsf(v[j][k]));
#pragma unroll
        for (int o = 1; o < 64; o <<= 1) am = fmaxf(am, __shfl_xor(am, o));
        const float inv = am > 0.f ? 127.0f / am : 0.f;
        if (lane == 0) *qscale = am > 0.f ? am * (1.0f / 127.0f) : 1.0f;
#pragma unroll
        for (int j = 0; j < 4; ++j) { int b4[4];
#pragma unroll
            for (int k = 0; k < 4; ++k) b4[k] = (int)fminf(fmaxf(__builtin_rintf(v[j][k] * inv), -127.0f), 127.0f);
            ((unsigned*)qrow)[lane + 64 * j] = (unsigned)(b4[0] & 255) | ((unsigned)(b4[1] & 255) << 8) | ((unsigned)(b4[2] & 255) << 16) | ((unsigned)b4[3] << 24); } }
}
__device__ __forceinline__ void rms_mod_row_bf16(const bf16_t* xrow, bf16_t* orow, const LAS float* MA, const LAS float* MB, int lane, signed char* qrow, float* qscale) {
    float v[16]; float s = 0.f;
#pragma unroll
    for (int j = 0; j < 2; ++j) { const u32x4 w = *(const u32x4*)(xrow + 512 * j + 8 * lane);
        v[8 * j + 0] = bf_lo(w.x); v[8 * j + 1] = bf_hi(w.x); v[8 * j + 2] = bf_lo(w.y); v[8 * j + 3] = bf_hi(w.y); v[8 * j + 4] = bf_lo(w.z); v[8 * j + 5] = bf_hi(w.z); v[8 * j + 6] = bf_lo(w.w); v[8 * j + 7] = bf_hi(w.w); }
#pragma unroll
    for (int k = 0; k < 16; ++k) s += v[k] * v[k];
    const float rstd = 1.0f / sqrtf(wave_sum(s) * (1.0f / D) + RMS_EPS);
#pragma unroll
    for (int j = 0; j < 2; ++j) { const LAS float* a = MA + 512 * j + 8 * lane; const LAS float* b = MB + 512 * j + 8 * lane;
        const f32x4 a0 = *(const LAS f32x4*)a, a1 = *(const LAS f32x4*)(a + 4), b0 = *(const LAS f32x4*)b, b1 = *(const LAS f32x4*)(b + 4);
        u32x4 w; w.x = pk2(v[8 * j + 0] * rstd * a0[0] + b0[0], v[8 * j + 1] * rstd * a0[1] + b0[1]); w.y = pk2(v[8 * j + 2] * rstd * a0[2] + b0[2], v[8 * j + 3] * rstd * a0[3] + b0[3]);
        w.z = pk2(v[8 * j + 4] * rstd * a1[0] + b1[0], v[8 * j + 5] * rstd * a1[1] + b1[1]); w.w = pk2(v[8 * j + 6] * rstd * a1[2] + b1[2], v[8 * j + 7] * rstd * a1[3] + b1[3]);
        *(u32x4*)(orow + 512 * j + 8 * lane) = w; }
    if (qrow) {
        float hq[16]; float am = 0.f;
#pragma unroll
        for (int j = 0; j < 2; ++j) { const LAS float* a = MA + 512 * j + 8 * lane; const LAS float* b = MB + 512 * j + 8 * lane;
#pragma unroll
            for (int k = 0; k < 8; ++k) { hq[8 * j + k] = v[8 * j + k] * rstd * a[k] + b[k]; am = fmaxf(am, fabsf(hq[8 * j + k])); } }
#pragma unroll
        for (int o = 1; o < 64; o <<= 1) am = fmaxf(am, __shfl_xor(am, o));
        const float inv = am > 0.f ? 127.0f / am : 0.f;
        if (lane == 0) *qscale = am > 0.f ? am * (1.0f / 127.0f) : 1.0f;
#pragma unroll
        for (int j = 0; j < 2; ++j) { unsigned w2[2];
#pragma unroll
            for (int d = 0; d < 2; ++d) { int b4[4];
#pragma unroll
                for (int k = 0; k < 4; ++k) b4[k] = (int)fminf(fmaxf(__builtin_rintf(hq[8 * j + 4 * d + k] * inv), -127.0f), 127.0f);
                w2[d] = (unsigned)(b4[0] & 255) | ((unsigned)(b4[1] & 255) << 8) | ((unsigned)(b4[2] & 255) << 16) | ((unsigned)b4[3] << 24); }
            *(u32x2*)(qrow + 512 * j + 8 * lane) = (u32x2){w2[0], w2[1]}; } }
}
__device__ __forceinline__ void p1_h1(const Ctx& C0) {
    PHASE_IDS();
    LAS float* MA = (LAS float*)C.lds;
    LAS float* MB = MA + 2048;
    for (int idx = C.tid; idx < 2048; idx += 512) { const int b = idx >> 10, col = idx & 1023;
        const float sh = ada_val(C, b, col), sc = ada_val(C, b, 1024 + col);
        MA[idx] = C.in[5][col] * (1.0f + sc); MB[idx] = sh; }
    if (blockIdx.x < NE) { const int e = blockIdx.x; bf16_t* wrt = WSP(bf16_t, WS_WRT) + (size_t)e * 1024;
        for (int k = C.tid; k < 1024; k += 512) wrt[k] = (bf16_t)f2bf(C.in[16][(size_t)k * 32 + e]); }
    {
        const int per = (2 * 6144 + C.G - 1) / C.G;
        for (int i = C.tid; i < per; i += 512) { const int idx = blockIdx.x * per + i; if (idx < 2 * 6144) WSP(float, WS_ADAF)[idx] = ada_val(C, idx / 6144, idx % 6144); }
    }
    __syncthreads();
    const int gw = C.vcu * NWAVES + C.wave, NGW = C.G * NWAVES;
    for (int m0 = gw; m0 < M; m0 += NGW) { const int m = XROW(m0); const int b = m >= SEQ; rms_mod_row(C.in[0] + (size_t)m * D, WSP(bf16_t, WS_H) + (size_t)m * D, MA + b * 1024, MB + b * 1024, C.lane, (signed char*)(C.ws + WS_H2Q) + (size_t)m * D, WSP(float, WS_SA) + m); }
    __syncthreads();
}
__device__ __forceinline__ void p3a_kmean(const Ctx& C0) {
    PHASE_IDS();
    LAS float* red = (LAS float*)C.lds;
    const bf16_t* kb = WSP(const bf16_t, WS_PROJ + 2 * PROJ_STRIDE);
    for (int it = blockIdx.x; it < 64; it += C.G) { const int b = it >> 5, n = it & 31;
        float a[8];
#pragma unroll
        for (int j = 0; j < 8; ++j) a[j] = 0.f;
        const bf16_t* src = kb + (size_t)(b * SEQ + 256 * n + 32 * C.wave) * 1024 + 8 * C.lane;
#pragma unroll 8
        for (int r = 0; r < 32; ++r) { const u32x4 v = *(const u32x4*)(src + (size_t)r * 1024);
            a[0] += bf_lo(v.x); a[1] += bf_hi(v.x); a[2] += bf_lo(v.y); a[3] += bf_hi(v.y); a[4] += bf_lo(v.z); a[5] += bf_hi(v.z); a[6] += bf_lo(v.w); a[7] += bf_hi(v.w); }
        __syncthreads();
#pragma unroll
        for (int j = 0; j < 8; ++j) red[C.wave * 512 + 8 * C.lane + j] = a[j];
        __syncthreads();
        { const int col = C.tid; float s = 0.f;
#pragma unroll
            for (int w = 0; w < 8; ++w) s += red[w * 512 + col];
            const int h = col >> 6, d = col & 63; WSP(float, WS_KMEAN)[((b * 8 + h) * 32 + n) * 64 + d] = s * (1.0f / 256.0f); }
    }
    __syncthreads();
}
__device__ __forceinline__ void p3b_gate(const Ctx& C0) {
    PHASE_IDS();
    LAS float* km = (LAS float*)C.lds;
    const bf16_t* qb = WSP(const bf16_t, WS_PROJ + 1 * PROJ_STRIDE) + 512;
    unsigned* cnt = WSP(unsigned, WS_CTL) + CW_MCNT; unsigned* list = WSP(unsigned, WS_LIST);
    for (int it = blockIdx.x; it < 256; it += C.G) { const int bh = it >> 4, qc = it & 15, b = bh >> 3, h = bh & 7;
        __syncthreads();
        for (int i = C.tid; i < 2048; i += 512) km[i] = WSP(const float, WS_KMEAN)[bh * 2048 + i];
        __syncthreads();
        const int q = 512 * qc + C.tid, own = q >> 8;
        u32x4 qv[8];
        { const u32x4* qp = (const u32x4*)(qb + (size_t)(b * SEQ + q) * 1024 + h * 64);
#pragma unroll
            for (int j = 0; j < 8; ++j) qv[j] = qp[j]; }
        float v0 = -INFINITY, v1 = -INFINITY, v2 = -INFINITY; int i0 = 0, i1 = 0, i2 = 0;
        const int nmax = ((512 * qc + 511) >> 8);
        for (int n = 0; n < nmax; ++n) { const LAS f32x4* kr = (const LAS f32x4*)(km + n * 64); float s = 0.f;
#pragma unroll
            for (int j = 0; j < 8; ++j) { const f32x4 ka = kr[2 * j], kb2 = kr[2 * j + 1];
                s += bf_lo(qv[j].x) * ka[0] + bf_hi(qv[j].x) * ka[1] + bf_lo(qv[j].y) * ka[2] + bf_hi(qv[j].y) * ka[3]
                   + bf_lo(qv[j].z) * kb2[0] + bf_hi(qv[j].z) * kb2[1] + bf_lo(qv[j].w) * kb2[2] + bf_hi(qv[j].w) * kb2[3]; }
            if (n < own) {
                if (s > v0) { v2 = v1; i2 = i1; v1 = v0; i1 = i0; v0 = s; i0 = n; }
                else if (s > v1) { v2 = v1; i2 = i1; v1 = s; i1 = n; }
                else if (s > v2) { v2 = s; i2 = n; }
            } }
        const int nsel = own < 3 ? own : 3;
        LAS unsigned* lc = (LAS unsigned*)(C.lds + 8192);
        if (C.tid < 128) lc[C.tid] = 0u;
        __syncthreads();
        const int l0 = 2 * i0 + (i0 == own - 1 ? 1 : 0), l1 = 2 * i1 + (i1 == own - 1 ? 1 : 0), l2 = 2 * i2 + (i2 == own - 1 ? 1 : 0);
        unsigned lp0 = 0u, lp1 = 0u, lp2 = 0u;
        if (nsel > 0) lp0 = atomicAdd((unsigned*)(lc + l0), 1u);
        if (nsel > 1) lp1 = atomicAdd((unsigned*)(lc + l1), 1u);
        if (nsel > 2) lp2 = atomicAdd((unsigned*)(lc + l2), 1u);
        __syncthreads();
        if (C.tid < 64) { const unsigned c = lc[C.tid]; lc[64 + C.tid] = c ? atomicAdd(cnt + bh * 64 + C.tid, c) : 0u; }
        __syncthreads();
#pragma unroll
        for (int j = 0; j < 3; ++j) if (j < nsel) { const int n = j == 0 ? i0 : (j == 1 ? i1 : i2); const int l = j == 0 ? l0 : (j == 1 ? l1 : l2); const unsigned pos = lc[64 + l] + (j == 0 ? lp0 : (j == 1 ? lp1 : lp2));
            list[(size_t)bh * LIST_PER_BH + 256 * (31 * n - (n * (n - 1)) / 2) + ((l & 1) ? 0 : 256) + pos] = (unsigned)q | ((unsigned)j << 13); }
    }
    __syncthreads();
}
__device__ __forceinline__ void build_bias_tables(const Ctx& C) {
    LAS float* bt = (LAS float*)(C.lds + AT_BT);
    for (int idx = C.tid; idx < 12 * BT_STR; idx += 512) { const int hd = idx / BT_STR, n = idx % BT_STR;
        if (n >= 128) { bt[idx] = 0.f; continue; }
        int bk;
        if (n < 16) bk = n; else { const float nf = (float)n; int lg = 16 + (int)(logf(nf / 16.0f) / logf(8.0f) * 16.0f); bk = lg < 31 ? lg : 31; }
        bt[idx] = (C.in[2][bk * 12 + hd] - C.in[2][31 * 12 + hd]) * LOG2E; }
}
#if SIMPLE_DIFF
__device__ __forceinline__ void diff_unit(const Ctx& C, int b, int h, int qblk, float lam) {
    const int lane = C.lane, c = lane & 15, g = lane >> 4, wid = C.wave;
    const bf16_t* qka = WSP(const bf16_t, WS_PROJ);
    const bf16_t* va = WSP(const bf16_t, WS_PROJ + PROJ_STRIDE);
    const int q0 = qblk * 128, q = q0 + wid * 16 + c, NT = 2 * qblk + 2;
    const LAS float* bt = (const LAS float*)(C.lds + AT_BT) + h * 128;
    f32x4 o0[8];
    for (int map = 0; map < 2; ++map) {
        bf16x8 qf[2];
#pragma unroll
        for (int ks = 0; ks < 2; ++ks) qf[ks] = *(const bf16x8*)(qka + (size_t)(b * SEQ + q) * 1024 + h * 128 + map * 64 + 32 * ks + 8 * g);
        const bf16_t* kg = qka + (size_t)(b * SEQ) * 1024 + 512 + h * 128 + map * 64;
        const bf16_t* vg = va + (size_t)(b * SEQ) * 1024 + h * 128;
        float m_run = -1e30f, l_run = 0.f; f32x4 o[8];
#pragma unroll
        for (int dt = 0; dt < 8; ++dt) o[dt] = (f32x4){0.f, 0.f, 0.f, 0.f};
        TileRegs<2> tr; tile_fetch<2>(tr, kg, vg, C.tid);
        for (int t = 0; t < NT; ++t) {
            __syncthreads();
            tile_store<2>(tr, C.lds, C.tid);
            __syncthreads();
            if (t + 1 < NT) tile_fetch<2>(tr, kg + (size_t)(t + 1) * 64 * 1024, vg + (size_t)(t + 1) * 64 * 1024, C.tid);
            attn_tile<8>(C.lds, lane, qf, o, m_run, l_run, q, 64 * t, true, bt);
        }
        float lt = l_run; lt += __shfl_xor(lt, 16); lt += __shfl_xor(lt, 32);
        const float rl = 1.0f / lt;
#pragma unroll
        for (int i = 0; i < 4; ++i) { const float ri = __shfl(rl, 4 * g + i);
#pragma unroll
            for (int dt = 0; dt < 8; ++dt) { if (map == 0) o0[dt][i] = o[dt][i] * ri; else o0[dt][i] = o0[dt][i] - lam * (o[dt][i] * ri); } }
    }
    bf16_t* y = WSP(bf16_t, WS_Y);
#pragma unroll
    for (int i = 0; i < 4; ++i) { float ss = 0.f;
#pragma unroll
        for (int dt = 0; dt < 8; ++dt) ss += o0[dt][i] * o0[dt][i];
        ss += __shfl_xor(ss, 1); ss += __shfl_xor(ss, 2); ss += __shfl_xor(ss, 4); ss += __shfl_xor(ss, 8);
        const float rstd = 1.0f / sqrtf(ss * (1.0f / 128.0f) + RMS_EPS);
        bf16_t* yr = y + (size_t)(b * SEQ + q0 + wid * 16 + 4 * g + i) * 1024 + h * 128 + c;
#pragma unroll
        for (int dt = 0; dt < 8; ++dt) yr[16 * dt] = (bf16_t)f2bf(o0[dt][i] * rstd * C.in[11][16 * dt + c] * 0.8f); }
}
#endif
#if 0
__device__ __forceinline__ void moba_item(const Ctx& C, int b, int h, int n, bool own, int half, const unsigned* lst, int lcnt, int chunk) {
    const int lane = C.lane, c = lane & 15, g = lane >> 4, wid = C.wave;
    const bf16_t* qb = WSP(const bf16_t, WS_PROJ + PROJ_STRIDE) + 512;
    const bf16_t* kv = WSP(const bf16_t, WS_PROJ + 2 * PROJ_STRIDE);
    int qtok, jslot; bool valid;
    if (own) { qtok = 256 * n + 128 * half + wid * 16 + c; jslot = 3; valid = true; }
    else { const int idx = chunk * 128 + wid * 16 + c; valid = idx < lcnt; const unsigned e = lst[valid ? idx : 0]; qtok = (int)(e & 8191u); jslot = (int)(e >> 13); }
    bf16x8 qf[2];
#pragma unroll
    for (int ks = 0; ks < 2; ++ks) qf[ks] = *(const bf16x8*)(qb + (size_t)(b * SEQ + qtok) * 1024 + h * 64 + 32 * ks + 8 * g);
    const bf16_t* kg = kv + (size_t)(b * SEQ + 256 * n) * 1024 + h * 64;
    const bf16_t* vg = kg + 512;
    const LAS float* bt = (const LAS float*)(C.lds + AT_BT) + (4 + h) * 128;
    const int NT = own ? 2 * (half + 1) : 4;
    float m_run = -1e30f, l_run = 0.f; f32x4 o[4];
#pragma unroll
    for (int dt = 0; dt < 4; ++dt) o[dt] = (f32x4){0.f, 0.f, 0.f, 0.f};
    TileRegs<1> tr; tile_fetch<1>(tr, kg, vg, C.tid);
    for (int t = 0; t < NT; ++t) {
        __syncthreads();
        tile_store<1>(tr, C.lds, C.tid);
        __syncthreads();
        if (t + 1 < NT) tile_fetch<1>(tr, kg + (size_t)(t + 1) * 64 * 1024, vg + (size_t)(t + 1) * 64 * 1024, C.tid);
        attn_tile<4>(C.lds, lane, qf, o, m_run, l_run, qtok, 256 * n + 64 * t, own, bt);
    }
    float lt = l_run; lt += __shfl_xor(lt, 16); lt += __shfl_xor(lt, 32);
    const int slot = ((b * SEQ + qtok) * 8 + h) * 4 + jslot;
    if (g == 0 && valid) { f32x2 ml; ml[0] = m_run; ml[1] = lt; *(f32x2*)(WSP(float, WS_PML) + (size_t)slot * 2) = ml; }
    bf16_t* po = WSP(bf16_t, WS_PO);
#pragma unroll
    for (int i = 0; i < 4; ++i) { const int sl = __shfl(slot, 4 * g + i); const int vl = __shfl((int)valid, 4 * g + i);
        if (vl) {
#pragma unroll
            for (int dt = 0; dt < 4; ++dt) po[(size_t)sl * 64 + 16 * dt + c] = (bf16_t)f2bf(o[dt][i]); } }
}
#endif
constexpr int MB_BUF = 65536, MB_OST = LDSCTL_OFF + 14336;
struct MItem { int valid, b, h, n, own, half, near, lcnt, chunk, lbase; };
__device__ __forceinline__ MItem moba_decode(int it, int nitems, const LAS int* pre, const unsigned* cnt) {
    MItem m; m.valid = it < nitems ? 1 : 0; if (!m.valid) it = 0;
    if (it < 1024) { const int bh = it >> 6, r = it & 63; m.b = bh >> 3; m.h = bh & 7; m.n = r >> 1; m.own = 1; m.half = (r ^ (bh >> 2)) & 1; m.near = 0;
        m.lcnt = 128; m.chunk = 0; m.lbase = 0; }
    else { const int gi = it - 1024; int lo = 0, hi = 1023;
        while (lo < hi) { const int mid = (lo + hi + 1) >> 1; if (pre[mid] <= gi) lo = mid; else hi = mid - 1; }
        const int L = lo, bh = L >> 6, n = (L >> 1) & 31, near = L & 1;
        m.b = bh >> 3; m.h = bh & 7; m.n = n; m.own = 0; m.half = 0; m.near = near; m.lcnt = (int)__hip_atomic_load(cnt + L, RLX_AGENT); m.chunk = gi - pre[L];
        m.lbase = bh * LIST_PER_BH + 256 * (31 * n - (n * (n - 1)) / 2) + (near ? 0 : 256); }
    return m;
}
__device__ __forceinline__ unsigned moba_entry(const Ctx& C, const MItem& m) {
    const int c = C.lane & 15;
    if (m.own) return (unsigned)(256 * m.n + 128 * m.half + C.wave * 16 + c) | (3u << 13) | (1u << 15);
    const int idx = m.chunk * 128 + C.wave * 16 + c; const bool v = idx < m.lcnt;
    const unsigned e = WSP(const unsigned, WS_LIST)[(size_t)m.lbase + (v ? idx : 0)];
    return (e & 0x7fffu) | (v ? (1u << 15) : 0u);
}
__device__ __forceinline__ void moba_qload(const Ctx& C, const MItem& m, unsigned ent, bf16x8 (&qf)[2]) {
    const bf16_t* qb = WSP(const bf16_t, WS_PROJ + PROJ_STRIDE) + 512; const int g = C.lane >> 4;
#pragma unroll
    for (int ks = 0; ks < 2; ++ks) qf[ks] = *(const bf16x8*)(qb + (size_t)(m.b * SEQ + (int)(ent & 8191u)) * 1024 + m.h * 64 + 32 * ks + 8 * g);
}
__device__ __forceinline__ void moba_dma(const Ctx& C, const MItem& m, int bo) {
    const bf16_t* kg = WSP(const bf16_t, WS_PROJ + 2 * PROJ_STRIDE) + (size_t)(m.b * SEQ + 256 * m.n) * 1024 + m.h * 64;
    const int r8 = C.lane >> 3, sch = (C.lane & 7) ^ r8;
#pragma unroll
    for (int j = 0; j < 4; ++j) { const int p = C.wave * 4 + j; const bf16_t* src = kg + (size_t)(8 * p + r8) * 1024 + sch * 8;
        __builtin_amdgcn_global_load_lds((const unsigned*)src, (LAS unsigned*)(C.lds + bo + p * 1024), 16, 0, 0);
        __builtin_amdgcn_global_load_lds((const unsigned*)(src + 512), (LAS unsigned*)(C.lds + bo + 32768 + p * 1024), 16, 0, 0); }
}
constexpr int MB_STG = 2304;
__device__ __forceinline__ void moba_flush(const Ctx& C) {
    const LAS unsigned char* stg = C.lds + MB_OST + C.wave * MB_STG; const int lane = C.lane;
    const LAS int* sslot = (const LAS int*)(stg + 2176);
    bf16_t* po = WSP(bf16_t, WS_PO);
#pragma unroll
    for (int r = 0; r < 2; ++r) { const int row = (lane >> 3) + 8 * r, ch = lane & 7; const u32x4 v = *(const LAS u32x4*)(stg + row * 128 + ch * 16); const int sl = sslot[row];
        if (sl >= 0) *(u32x4*)(po + (size_t)sl * 64 + ch * 8) = v; }
    if (lane < 16) { const int sl = sslot[lane]; const f32x2 ml = *(const LAS f32x2*)(stg + 2048 + lane * 8); if (sl >= 0) *(f32x2*)(WSP(float, WS_PML) + (size_t)sl * 2) = ml; }
}
__device__ __forceinline__ void moba_compute(const Ctx& C, const MItem& m, unsigned ent, const bf16x8 (&qf)[2], int bo, int mode) {
    if (!(mode & 2)) return;
    const int lane = C.lane, c = lane & 15, g = lane >> 4, cx = c & 7;
    const int qtok = (int)(ent & 8191u), jslot = (int)((ent >> 13) & 3u), valid = (int)((ent >> 15) & 1u);
    const int nkt = m.own ? 8 * (m.half + 1) : 16;
    const LAS float* bt = (const LAS float*)(C.lds + AT_BT) + (4 + m.h) * BT_STR;
    f32x4 s[16];
    const LAS unsigned char* kb = C.lds + bo + c * 128;
    const int kc0 = ((0 + g) ^ cx) << 4, kc1 = ((4 + g) ^ cx) << 4;
#define MB_BIAS(t4) do { if (m.own | m.near) { const int kbase_ = 256 * m.n + 64 * (t4); \
            _Pragma("unroll") for (int k4 = 0; k4 < 4; ++k4) _Pragma("unroll") for (int i = 0; i < 4; ++i) { const int kt_ = 4 * (t4) + k4; const int dist = qtok - (kbase_ + 16 * k4 + 4 * g + i); \
                const unsigned di = (unsigned)dist < 128u ? (unsigned)dist : 128u; const float v = s[kt_][i] + bt[di]; s[kt_][i] = (m.own && dist < 0) ? -INFINITY : v; } } } while (0)
#pragma unroll
    for (int kt = 0; kt < 4; ++kt) { const bf16x8 a0 = *(const LAS bf16x8*)(kb + kt * 2048 + kc0), a1 = *(const LAS bf16x8*)(kb + kt * 2048 + kc1);
        f32x4 z = (f32x4){0.f, 0.f, 0.f, 0.f}; z = __builtin_amdgcn_mfma_f32_16x16x32_bf16(a0, qf[0], z, 0, 0, 0); s[kt] = __builtin_amdgcn_mfma_f32_16x16x32_bf16(a1, qf[1], z, 0, 0, 0); }
    MB_BIAS(0);
    float mx = fmaxf(fmaxf(s[0][0], s[0][1]), fmaxf(s[0][2], s[0][3]));
#pragma unroll
    for (int kt = 1; kt < 4; ++kt) mx = fmaxf(mx, fmaxf(fmaxf(s[kt][0], s[kt][1]), fmaxf(s[kt][2], s[kt][3])));
    mx = fmaxf(mx, __shfl_xor(mx, 16)); mx = fmaxf(mx, __shfl_xor(mx, 32));
    const f32x4 negm = (f32x4){-mx, -mx, -mx, -mx};
#pragma unroll
    for (int kt = 0; kt < 4; ++kt) s[kt] += negm;
#pragma unroll
    for (int kt = 4; kt < 16; ++kt) {
        if (kt < nkt) { const bf16x8 a0 = *(const LAS bf16x8*)(kb + kt * 2048 + kc0), a1 = *(const LAS bf16x8*)(kb + kt * 2048 + kc1);
            f32x4 z = __builtin_amdgcn_mfma_f32_16x16x32_bf16(a0, qf[0], negm, 0, 0, 0); s[kt] = __builtin_amdgcn_mfma_f32_16x16x32_bf16(a1, qf[1], z, 0, 0, 0); }
        else s[kt] = (f32x4){-INFINITY, -INFINITY, -INFINITY, -INFINITY};
    }
    if (4 < nkt) MB_BIAS(1);
    if (8 < nkt) { MB_BIAS(2); MB_BIAS(3); }
#undef MB_BIAS
#pragma unroll
    for (int kt = 0; kt < 16; ++kt)
#pragma unroll
        for (int i = 0; i < 4; ++i) s[kt][i] = __builtin_amdgcn_exp2f(s[kt][i]);
    f32x4 o[4], osum = (f32x4){0.f, 0.f, 0.f, 0.f};
#pragma unroll
    for (int dt = 0; dt < 4; ++dt) o[dt] = (f32x4){0.f, 0.f, 0.f, 0.f};
    const short one = (c == 0) ? (short)0x3F80 : (short)0; const bf16x8 ones = (bf16x8){one, one, one, one, one, one, one, one};
    const int rv = 4 * g + (c >> 2), x7 = rv & 7, hb = (c & 3) >> 1;
    const LAS unsigned char* vb = C.lds + bo + 32768 + rv * 128 + 8 * (c & 1);
    int cv[4];
#pragma unroll
    for (int dt = 0; dt < 4; ++dt) cv[dt] = ((2 * dt + hb) ^ x7) << 4;
#pragma unroll
    for (int kk = 0; kk < 8; ++kk) {
        if (2 * kk < nkt) { u32x4 w; w.x = cvt_pk_bf16(s[2 * kk][0], s[2 * kk][1]); w.y = cvt_pk_bf16(s[2 * kk][2], s[2 * kk][3]);
            w.z = cvt_pk_bf16(s[2 * kk + 1][0], s[2 * kk + 1][1]); w.w = cvt_pk_bf16(s[2 * kk + 1][2], s[2 * kk + 1][3]); const bf16x8 pa = __builtin_bit_cast(bf16x8, w);
            osum = __builtin_amdgcn_mfma_f32_16x16x32_bf16(pa, ones, osum, 0, 0, 0);
#pragma unroll
            for (int dt = 0; dt < 4; ++dt) { const s16x4 lo = tr16(vb + (32 * kk) * 128 + cv[dt]), hi = tr16(vb + (32 * kk + 16) * 128 + cv[dt]);
                const bf16x8 bfr = (bf16x8){lo[0], lo[1], lo[2], lo[3], hi[0], hi[1], hi[2], hi[3]};
                o[dt] = __builtin_amdgcn_mfma_f32_16x16x32_bf16(pa, bfr, o[dt], 0, 0, 0); } }
    }
    if (!(mode & 1)) return;
    LAS unsigned char* stg = C.lds + MB_OST + C.wave * MB_STG;
    LAS bf16_t* so = (LAS bf16_t*)stg;
#pragma unroll
    for (int i = 0; i < 4; ++i)
#pragma unroll
        for (int dt = 0; dt < 4; ++dt) so[(4 * g + i) * 64 + 16 * dt + c] = (bf16_t)f2bf(o[dt][i]);
    const int slot = valid ? ((m.b * SEQ + qtok) * 8 + m.h) * 4 + jslot : -1;
    if (g == 0) { ((LAS int*)(stg + 2176))[c] = slot; ((LAS float*)(stg + 2048))[2 * c] = mx; }
    if (c == 0) {
#pragma unroll
        for (int i = 0; i < 4; ++i) ((LAS float*)(stg + 2048))[2 * (4 * g + i) + 1] = osum[i]; }
}
__device__ __forceinline__ MItem moba_item_at(const LAS int* tab, int j) {
    MItem m; const int w0 = __builtin_amdgcn_readfirstlane(tab[4 * j]), w1 = __builtin_amdgcn_readfirstlane(tab[4 * j + 1]), w2 = __builtin_amdgcn_readfirstlane(tab[4 * j + 2]), w3 = __builtin_amdgcn_readfirstlane(tab[4 * j + 3]);
    m.valid = (j < 32 && w1 >= 0) ? 1 : 0; const int bh = w0 & 255; m.b = bh >> 3; m.h = bh & 7; m.n = (w0 >> 8) & 255; m.own = (w0 >> 16) & 1; m.half = (w0 >> 17) & 1; m.near = (w0 >> 18) & 1; m.lcnt = w1; m.chunk = w2; m.lbase = w3; return m;
}
__device__ __forceinline__ void moba_phase(const Ctx& C, const LAS int* pre, const unsigned* cnt, int mode) {
    const int nitems = 1024 + pre[1024]; const int G = C.G;
    LAS int* tab = (LAS int*)(C.lds + LDSCTL_OFF + 7424);
    if (C.tid < 33) { MItem m = moba_decode(C.vcu + C.tid * G, nitems, pre, cnt); if (C.tid == 32) m.valid = 0;
        tab[4 * C.tid] = (m.b * 8 + m.h) | (m.n << 8) | (m.own << 16) | (m.half << 17) | (m.near << 18); tab[4 * C.tid + 1] = m.valid ? m.lcnt : -1; tab[4 * C.tid + 2] = m.chunk; tab[4 * C.tid + 3] = m.lbase; }
    __syncthreads();
    int j = 0;
    MItem m0 = moba_item_at(tab, 0), m1 = moba_item_at(tab, 1);
    unsigned e0 = 0u, e1 = 0u; bf16x8 qf0[2];
    qf0[0] = (bf16x8){0, 0, 0, 0, 0, 0, 0, 0}; qf0[1] = qf0[0];
    if (m0.valid) { e0 = moba_entry(C, m0); moba_qload(C, m0, e0, qf0); moba_dma(C, m0, 0); }
    if (m1.valid) e1 = moba_entry(C, m1);
    int bo = 0; bool pending = false;
    while (m0.valid) {
        VM_WAIT(); __syncthreads();
        if (pending) moba_flush(C);
        bf16x8 qf1[2]; qf1[0] = qf0[0]; qf1[1] = qf0[1];
        if (m1.valid) moba_qload(C, m1, e1, qf1);
        const MItem m2 = moba_item_at(tab, j + 2 < 32 ? j + 2 : 32);
        unsigned e2 = 0u; if (m2.valid) e2 = moba_entry(C, m2);
        if (m1.valid) moba_dma(C, m1, bo ^ MB_BUF);
        moba_compute(C, m0, e0, qf0, bo, mode); pending = (mode & 3) == 3;
        m0 = m1; m1 = m2; e0 = e1; e1 = e2; qf0[0] = qf1[0]; qf0[1] = qf1[1]; bo ^= MB_BUF; ++j;
    }
    if (pending) { LDS_WAIT(); moba_flush(C); }
    VM_WAIT(); __syncthreads();
}
#ifndef PROBE_SUB
#define PROBE_SUB 3
#endif
__device__ __forceinline__ void p4_attention(const Ctx& C0, int sub, bool gate) {
    if (gate) { p3b_gate(C0);
        asm volatile("s_waitcnt vmcnt(0)" ::: "memory"); __syncthreads();
        if (threadIdx.x == 0) { __builtin_amdgcn_fence(__ATOMIC_RELEASE, "agent"); asm volatile("s_waitcnt vmcnt(0)" ::: "memory"); xb_add((unsigned*)(C0.ws + WS_CTL) + CW_GDONE, 1u); } }
    PHASE_IDS();
    __syncthreads();
    build_bias_tables(C);
    float lam;
    { const float a = wave_sum(C.in[7][C.lane] * C.in[8][C.lane]), b2 = wave_sum(C.in[9][C.lane] * C.in[10][C.lane]); lam = expf(a) - expf(b2) + 0.2f; }
    __syncthreads();
#if SIMPLE_DIFF
    if (sub & 1) for (int p = blockIdx.x; p < 256; p += C.G) { const int bh = p >> 5, qa = p & 31;
        diff_unit(C, bh >> 2, bh & 3, qa, lam); diff_unit(C, bh >> 2, bh & 3, 63 - qa, lam); }
#else
#if NATIVE_DIFF
    {
        const int grp = blockIdx.x & 7, rank = blockIdx.x >> 3;
        if ((sub & 1) && rank < NCONV) { LAS float* scr = (LAS float*)(C.lds + C.wave * 8448);
            const int wi = (rank * 8 + grp) * NWAVES + C.wave, nw = NCONV * 8 * NWAVES;
            conv_q_blocks<0>(C.in[18], C.ws, C.lds, C.wave, rank * 8 + grp, NCONV * 8);
            conv_range(C, NE * 16 * 64, CONV_MOE_ITEMS, wi, nw, scr); }
        unsigned* qctr = WSP(unsigned, WS_CTL) + CW_AQ + 64 * grp;
        LAS int* qslot = (LAS int*)(C.lds + LDSCTL_OFF + 512);
        const attn_nat::bf16* qk = (const attn_nat::bf16*)WSP(const bf16_t, WS_PROJ); const attn_nat::bf16* vv = (const attn_nat::bf16*)WSP(const bf16_t, WS_PROJ + PROJ_STRIDE);
        attn_nat::bf16* oa = (attn_nat::bf16*)WSP(bf16_t, WS_OA);
        if (sub & 1) for (;;) {
            __syncthreads();
            if (C.tid == 0) *qslot = (int)atomicAdd(qctr, 1u);
            __syncthreads();
            const int j = __builtin_amdgcn_readfirstlane(*qslot);
            if (j >= 64) break;
            const int qb = 31 - (j >> 1), st = grp + 8 * (j & 1), b = st >> 3, h = (st >> 1) & 3, mp = st & 1;
            const LAS float* bth = (const LAS float*)(C.lds + AT_BT) + h * BT_STR;
            attn_nat::attn_unit<8>(b, qb, qk, qk, vv, oa, h * 128 + mp * 64, 512 + h * 128 + mp * 64, h * 128, mp * 512 + h * 128, bth, C.ldsg); }
    }
#else
    if (sub & 1) for (int v = C.vcu; v < 256; v += C.G) { const int bvh = v >> 3, s = v & 7, b = bvh >> 4, vh = bvh & 15, h = vh >> 2, mp = (vh >> 1) & 1, vhf = vh & 1;
        const attn_body::bf16* qk = (const attn_body::bf16*)WSP(const bf16_t, WS_PROJ); const attn_body::bf16* vv = (const attn_body::bf16*)WSP(const bf16_t, WS_PROJ + PROJ_STRIDE);
        attn_body::bf16* oa = (attn_body::bf16*)WSP(bf16_t, WS_OA);
        const LAS float* bth = (const LAS float*)(C.lds + AT_BT) + h * BT_STR;
#pragma unroll 1
        for (int i = 0; i < 4; ++i) { const int qb = (i == 0) ? s : (i == 1) ? 15 - s : (i == 2) ? 16 + s : 31 - s;
            attn_body::attn_unit<8>(b, qb, qk, qk, vv, oa, h * 128 + mp * 64, 512 + h * 128 + mp * 64, h * 128 + vhf * 64, mp * 512 + h * 128 + vhf * 64, bth, C.ldsg); } }
#endif
#endif
    LAS int* pre = (LAS int*)(C.lds + AT_MISC);
    LAS int* wtot = pre + 1032;
    const unsigned* cnt = WSP(const unsigned, WS_CTL) + CW_MCNT;
    if (gate && C.tid == 0) { unsigned* gd = WSP(unsigned, WS_CTL) + CW_GDONE; unsigned* tmo = WSP(unsigned, WS_CTL) + CW_TMO; unsigned sp = 0u;
        while (xb_ld(gd) < (unsigned)C.G) { __builtin_amdgcn_s_sleep(2); if ((++sp & 255u) == 0u) { if (xb_ld(tmo)) break; if (sp > XB_SPIN_CAP) { atomicAdd(tmo, 1u); break; } } }
        __builtin_amdgcn_fence(__ATOMIC_ACQUIRE, "agent"); asm volatile("s_waitcnt vmcnt(0)" ::: "memory"); }
    __syncthreads();
    { const int L = 2 * C.tid; const int n0_ = ((int)__hip_atomic_load(cnt + L, RLX_AGENT) + 127) >> 7, n1_ = ((int)__hip_atomic_load(cnt + L + 1, RLX_AGENT) + 127) >> 7; const int nch = n0_ + n1_;
        int inc = nch;
#pragma unroll
        for (int o = 1; o < 64; o <<= 1) { const int t = __shfl_up(inc, o); if (C.lane >= o) inc += t; }
        if (C.lane == 63) wtot[C.wave] = inc;
        __syncthreads();
        int base = 0;
        for (int w = 0; w < C.wave; ++w) base += wtot[w];
        pre[L] = base + inc - nch; pre[L + 1] = base + inc - nch + n0_;
        if (C.tid == 511) pre[1024] = base + inc;
    }
    __syncthreads();
    if (sub & 2) moba_phase(C, pre, cnt, sub >> 2);
    __syncthreads();
}
__device__ __forceinline__ void p5_ycombine(const Ctx& C0) {
    PHASE_IDS();
    const int gw = C.vcu * NWAVES + C.wave, NGW = C.G * NWAVES;
    const bf16_t* po = WSP(const bf16_t, WS_PO); const float* pml = WSP(const float, WS_PML); bf16_t* y = WSP(bf16_t, WS_Y);
#if !SIMPLE_DIFF
    {
        const float lam = expf(wave_sum(C.in[7][C.lane] * C.in[8][C.lane])) - expf(wave_sum(C.in[9][C.lane] * C.in[10][C.lane])) + 0.2f;
        const bf16_t* oa = WSP(const bf16_t, WS_OA);
        const f32x4 g0 = *(const f32x4*)(C.in[11] + 8 * (C.lane & 15)), g1 = *(const f32x4*)(C.in[11] + 8 * (C.lane & 15) + 4);
        for (int m0 = gw; m0 < M; m0 += NGW) { const int m = XROW(m0); const u32x4 a = *(const u32x4*)(oa + (size_t)m * 1024 + 8 * C.lane), b2 = *(const u32x4*)(oa + (size_t)m * 1024 + 512 + 8 * C.lane);
            float v[8];
            v[0] = bf_lo(a.x) - lam * bf_lo(b2.x); v[1] = bf_hi(a.x) - lam * bf_hi(b2.x); v[2] = bf_lo(a.y) - lam * bf_lo(b2.y); v[3] = bf_hi(a.y) - lam * bf_hi(b2.y);
            v[4] = bf_lo(a.z) - lam * bf_lo(b2.z); v[5] = bf_hi(a.z) - lam * bf_hi(b2.z); v[6] = bf_lo(a.w) - lam * bf_lo(b2.w); v[7] = bf_hi(a.w) - lam * bf_hi(b2.w);
            float ss = 0.f;
#pragma unroll
            for (int k = 0; k < 8; ++k) ss += v[k] * v[k];
            ss += __shfl_xor(ss, 1); ss += __shfl_xor(ss, 2); ss += __shfl_xor(ss, 4); ss += __shfl_xor(ss, 8);
            const float r = 0.8f / sqrtf(ss * (1.0f / 128.0f) + RMS_EPS);
            u32x4 w; w.x = pk2(v[0] * r * g0[0], v[1] * r * g0[1]); w.y = pk2(v[2] * r * g0[2], v[3] * r * g0[3]); w.z = pk2(v[4] * r * g1[0], v[5] * r * g1[1]); w.w = pk2(v[6] * r * g1[2], v[7] * r * g1[3]);
            *(u32x4*)(y + (size_t)m * 1024 + 8 * C.lane) = w; }
    }
#endif
    for (int m0 = gw; m0 < M; m0 += NGW) { const int m = XROW(m0); const int h = C.lane >> 3, dch = C.lane & 7; const int own = (m & (SEQ - 1)) >> 8, nsel = own < 3 ? own : 3;
        const size_t s0 = ((size_t)m * 8 + h) * 4;
        float mm[4], ll[4]; u32x4 ov[4];
#pragma unroll
        for (int j = 0; j < 4; ++j) { const bool use = (j == 3) || (j < nsel);
            if (use) { const f32x2 ml = *(const f32x2*)(pml + (s0 + j) * 2); mm[j] = ml[0]; ll[j] = ml[1]; ov[j] = *(const u32x4*)(po + (s0 + j) * 64 + 8 * dch); }
            else { mm[j] = -INFINITY; ll[j] = 0.f; ov[j] = (u32x4){0u, 0u, 0u, 0u}; } }
        const float mx = fmaxf(fmaxf(mm[0], mm[1]), fmaxf(mm[2], mm[3]));
        float den = 0.f; float acc[8];
#pragma unroll
        for (int k = 0; k < 8; ++k) acc[k] = 0.f;
#pragma unroll
        for (int j = 0; j < 4; ++j) { const float w = __builtin_amdgcn_exp2f(mm[j] - mx); den += w * ll[j];
            acc[0] += w * bf_lo(ov[j].x); acc[1] += w * bf_hi(ov[j].x); acc[2] += w * bf_lo(ov[j].y); acc[3] += w * bf_hi(ov[j].y);
            acc[4] += w * bf_lo(ov[j].z); acc[5] += w * bf_hi(ov[j].z); acc[6] += w * bf_lo(ov[j].w); acc[7] += w * bf_hi(ov[j].w); }
        const float r = 1.0f / den;
        u32x4 w; w.x = pk2(acc[0] * r, acc[1] * r); w.y = pk2(acc[2] * r, acc[3] * r); w.z = pk2(acc[4] * r, acc[5] * r); w.w = pk2(acc[6] * r, acc[7] * r);
        *(u32x4*)(y + (size_t)m * 1024 + 512 + h * 64 + 8 * dch) = w; }
}
__device__ __forceinline__ void p8_router(const Ctx& C0) {
    PHASE_IDS();
    LAS float* MA = (LAS float*)(C.lds + LDSCTL_OFF + 2048); LAS float* MB = MA + 2048;
    LAS int* hist = (LAS int*)(C.lds + LDSCTL_OFF + 2048 + 16384);
    LAS float* xch = (LAS float*)(C.lds + LDSCTL_OFF + 2048 + 16384 + 256);
    for (int idx = C.tid; idx < 2048; idx += 512) { const int b = idx >> 10, col = idx & 1023; const float* af = WSP(const float, WS_ADAF) + b * 6144;
        MA[idx] = C.in[15][col] * (1.0f + af[4096 + col]); MB[idx] = af[3072 + col]; }
    if (C.tid < 32) hist[C.tid] = 0;
    __syncthreads();
    for (int blk = (C.G == 256 ? C.vcu : (int)blockIdx.x); blk < M / 64; blk += C.G) {
        const int r0 = 64 * blk, b = r0 >= SEQ;
        {
            u32x4 xr[8][2];
#pragma unroll
            for (int r = 0; r < 8; ++r)
#pragma unroll
                for (int j = 0; j < 2; ++j) xr[r][j] = *(const u32x4*)(WSP(const bf16_t, WS_X1) + (size_t)(r0 + 8 * C.wave + r) * D + 512 * j + 8 * C.lane);
#pragma unroll
            for (int r = 0; r < 8; ++r) { const int lr = 8 * C.wave + r, m = r0 + lr; const LAS float* ma = MA + b * 1024; const LAS float* mb = MB + b * 1024;
                float v[16]; float s = 0.f;
#pragma unroll
                for (int j = 0; j < 2; ++j) { const u32x4 w = xr[r][j];
                    v[8 * j + 0] = bf_lo(w.x); v[8 * j + 1] = bf_hi(w.x); v[8 * j + 2] = bf_lo(w.y); v[8 * j + 3] = bf_hi(w.y); v[8 * j + 4] = bf_lo(w.z); v[8 * j + 5] = bf_hi(w.z); v[8 * j + 6] = bf_lo(w.w); v[8 * j + 7] = bf_hi(w.w); }
#pragma unroll
                for (int k = 0; k < 16; ++k) s += v[k] * v[k];
                const float rstd = 1.0f / sqrtf(wave_sum(s) * (1.0f / D) + RMS_EPS);
                float am = 0.f;
#pragma unroll
                for (int j = 0; j < 2; ++j) { const LAS float* a = ma + 512 * j + 8 * C.lane; const LAS float* bb = mb + 512 * j + 8 * C.lane;
                    const f32x4 a0 = *(const LAS f32x4*)a, a1 = *(const LAS f32x4*)(a + 4), b0 = *(const LAS f32x4*)bb, b1 = *(const LAS f32x4*)(bb + 4);
#pragma unroll
                    for (int k = 0; k < 4; ++k) { v[8 * j + k] = v[8 * j + k] * rstd * a0[k] + b0[k]; v[8 * j + 4 + k] = v[8 * j + 4 + k] * rstd * a1[k] + b1[k]; }
#pragma unroll
                    for (int k = 0; k < 8; ++k) am = fmaxf(am, fabsf(v[8 * j + k]));
                    u32x4 w; w.x = pk2(v[8 * j + 0], v[8 * j + 1]); w.y = pk2(v[8 * j + 2], v[8 * j + 3]); w.z = pk2(v[8 * j + 4], v[8 * j + 5]); w.w = pk2(v[8 * j + 6], v[8 * j + 7]);
                    *(LAS u32x4*)(C.lds + lr * 2048 + (((64 * j + C.lane) ^ (lr & 15)) << 4)) = w; }
#pragma unroll
                for (int o = 1; o < 64; o <<= 1) am = fmaxf(am, __shfl_xor(am, o));
                const float inv = am > 0.f ? 127.0f / am : 0.f;
                if (C.lane == 0) WSP(float, WS_SA)[m] = am > 0.f ? am * (1.0f / 127.0f) : 1.0f;
                signed char* qrow = (signed char*)(C.ws + WS_H2Q) + (size_t)m * D;
#pragma unroll
                for (int j = 0; j < 2; ++j) { unsigned w2[2];
#pragma unroll
                    for (int d = 0; d < 2; ++d) { int b4[4];
#pragma unroll
                        for (int k = 0; k < 4; ++k) b4[k] = (int)fminf(fmaxf(__builtin_rintf(v[8 * j + 4 * d + k] * inv), -127.0f), 127.0f);
                        w2[d] = (unsigned)(b4[0] & 255) | ((unsigned)(b4[1] & 255) << 8) | ((unsigned)(b4[2] & 255) << 16) | ((unsigned)b4[3] << 24); }
                    *(u32x2*)(qrow + 512 * j + 8 * C.lane) = (u32x2){w2[0], w2[1]}; } }
        }
        __syncthreads();
        const int lane = C.lane, c = lane & 15, g = lane >> 4, rq = C.wave & 3, kh = C.wave >> 2; const int rb = r0 + 16 * rq;
        f32x4 lg[2]; lg[0] = (f32x4){0.f, 0.f, 0.f, 0.f}; lg[1] = lg[0];
        { const bf16_t* wt = WSP(const bf16_t, WS_WRT) + (size_t)c * 1024 + 8 * g + 512 * kh; const LAS unsigned char* arow = C.lds + (16 * rq + c) * 2048;
#pragma unroll 8
            for (int ks = 0; ks < 16; ++ks) { const bf16x8 a = *(const LAS bf16x8*)(arow + ((((64 * kh + 4 * ks + g)) ^ c) << 4));
#pragma unroll
                for (int nt = 0; nt < 2; ++nt) { const bf16x8 w = *(const bf16x8*)(wt + (size_t)nt * 16 * 1024 + 32 * ks);
                    lg[nt] = __builtin_amdgcn_mfma_f32_16x16x32_bf16(a, w, lg[nt], 0, 0, 0); } } }
        if (kh == 1) { *(LAS f32x4*)(xch + (rq * 64 + lane) * 8) = lg[0]; *(LAS f32x4*)(xch + (rq * 64 + lane) * 8 + 4) = lg[1]; }
        __syncthreads();
        if (kh == 0) { lg[0] += *(const LAS f32x4*)(xch + (rq * 64 + lane) * 8); lg[1] += *(const LAS f32x4*)(xch + (rq * 64 + lane) * 8 + 4);
            const float br0 = C.in[17][c], br1 = C.in[17][16 + c];
#pragma unroll
            for (int i = 0; i < 4; ++i) { float a0 = lg[0][i] + br0, a1 = lg[1][i] + br1; float tv[4]; int ti[4];
#pragma unroll
                for (int k = 0; k < 4; ++k) { float bv; int bi; if (a1 > a0) { bv = a1; bi = 16 + c; } else { bv = a0; bi = c; }
#pragma unroll
                    for (int o = 1; o < 16; o <<= 1) { const float ov = __shfl_xor(bv, o); const int oi = __shfl_xor(bi, o); if (ov > bv || (ov == bv && oi < bi)) { bv = ov; bi = oi; } }
                    tv[k] = bv; ti[k] = bi; if (bi == c) a0 = -INFINITY; if (bi == 16 + c) a1 = -INFINITY; }
                if (c == 0) { const int row = rb + 4 * g + i; const float e1 = __expf(tv[1] - tv[0]), e2 = __expf(tv[2] - tv[0]), e3 = __expf(tv[3] - tv[0]); const float inv = 1.0f / (1.0f + e1 + e2 + e3);
                    *(int4*)(WSP(int, WS_TOPI) + (size_t)row * 4) = make_int4(ti[0], ti[1], ti[2], ti[3]);
                    *(f32x4*)(WSP(float, WS_TOPW) + (size_t)row * 4) = (f32x4){inv, e1 * inv, e2 * inv, e3 * inv};
                    atomicAdd((int*)(hist + ti[0]), 1); atomicAdd((int*)(hist + ti[1]), 1); atomicAdd((int*)(hist + ti[2]), 1); atomicAdd((int*)(hist + ti[3]), 1); } }
        }
        __syncthreads();
        if (C.tid < 32) { WSP(int, WS_HIST)[blk * 32 + C.tid] = hist[C.tid]; hist[C.tid] = 0; }
        __syncthreads();
    }
}
__device__ __forceinline__ void p9_slots(const Ctx& C0) {
    PHASE_IDS();
    LAS int* tot = (LAS int*)C.lds;
    LAS int* off = tot + 32;
    LAS int* cur = off + 40;
    const int* hist = WSP(const int, WS_HIST);
    for (int blk = blockIdx.x; blk < M / 64; blk += C.G) {
        __syncthreads();
        if (C.tid < 32) { int t = 0, p = 0; for (int w = 0; w < M / 64; ++w) { const int v = hist[w * 32 + C.tid]; t += v; p += (w < blk) ? v : 0; } tot[C.tid] = t; cur[C.tid] = p; }
        __syncthreads();
        if (C.tid == 0) { int o = 0; for (int e = 0; e < 32; ++e) { off[e] = o; o += (tot[e] + 255) & ~255; } off[32] = o; }
        __syncthreads();
        if (C.tid < 32) cur[C.tid] += off[C.tid];
        __syncthreads();
        if (C.tid < 256) { const int token = 64 * blk + (C.tid >> 2), k = C.tid & 3; const int e = WSP(const int, WS_TOPI)[token * 4 + k];
            const int slot = atomicAdd((int*)(cur + e), 1);
            WSP(int, WS_SLOTTOK)[slot] = token; WSP(float, WS_SLOTW)[slot] = WSP(const float, WS_TOPW)[token * 4 + k]; WSP(int, WS_TOKSLOT)[token * 4 + k] = slot; WSP(float, WS_SLOTSA)[slot] = WSP(const float, WS_SA)[token]; }
        if (blk < 32) { const int e = blk; for (int s = off[e] + tot[e] + C.tid; s < off[e + 1]; s += 512) { WSP(int, WS_SLOTTOK)[s] = 0; WSP(float, WS_SLOTW)[s] = 0.f; WSP(float, WS_SLOTSA)[s] = 0.f; } }
        if (blk == 0 && C.tid < 33) WSP(int, WS_EOFF)[C.tid] = off[C.tid];
    }
    __syncthreads();
}
__device__ __forceinline__ void p12_final(const Ctx& C0) {
    PHASE_IDS();
    const int gw = C.vcu * NWAVES + C.wave, NGW = C.G * NWAVES;
    const bf16_t* so = WSP(const bf16_t, WS_SOUT); const bf16_t* x1 = WSP(const bf16_t, WS_X1); const int* ts = WSP(const int, WS_TOKSLOT);
    for (int m = gw; m < M; m += NGW) { const float* gt = WSP(const float, WS_ADAF) + (m >= SEQ ? 6144 : 0) + 5120;
        const int4 sl = *(const int4*)(ts + (size_t)m * 4);
        f32x4 v[4]; float s = 0.f;
#pragma unroll
        for (int j = 0; j < 4; ++j) { const int col = 4 * C.lane + 256 * j; f32x4 a = (f32x4){0.f, 0.f, 0.f, 0.f};
            { const u32x2 w = *(const u32x2*)(so + (size_t)sl.x * 1024 + col); a[0] += bf_lo(w.x); a[1] += bf_hi(w.x); a[2] += bf_lo(w.y); a[3] += bf_hi(w.y); }
            { const u32x2 w = *(const u32x2*)(so + (size_t)sl.y * 1024 + col); a[0] += bf_lo(w.x); a[1] += bf_hi(w.x); a[2] += bf_lo(w.y); a[3] += bf_hi(w.y); }
            { const u32x2 w = *(const u32x2*)(so + (size_t)sl.z * 1024 + col); a[0] += bf_lo(w.x); a[1] += bf_hi(w.x); a[2] += bf_lo(w.y); a[3] += bf_hi(w.y); }
            { const u32x2 w = *(const u32x2*)(so + (size_t)sl.w * 1024 + col); a[0] += bf_lo(w.x); a[1] += bf_hi(w.x); a[2] += bf_lo(w.y); a[3] += bf_hi(w.y); }
            { const u32x2 xw = *(const u32x2*)(x1 + (size_t)m * D + col); const f32x4 xv = (f32x4){bf_lo(xw.x), bf_hi(xw.x), bf_lo(xw.y), bf_hi(xw.y)}; v[j] = xv + *(const f32x4*)(gt + col) * a; }
            s += (v[j][0] * v[j][0] + v[j][1] * v[j][1]) + (v[j][2] * v[j][2] + v[j][3] * v[j][3]); }
        const float rstd = 1.0f / sqrtf(wave_sum(s) * (1.0f / D) + RMS_EPS);
#pragma unroll
        for (int j = 0; j < 4; ++j) { const int col = 4 * C.lane + 256 * j; *(f32x4*)(C.out + (size_t)m * D + col) = v[j] * rstd * *(const f32x4*)(C.in[22] + col); } }
}

constexpr int CW_GRP = 118000;
__device__ __forceinline__ void grp_barrier(const XcdBarrier& b, unsigned* gwd, unsigned n, volatile LAS unsigned* mode) {
    asm volatile("s_waitcnt vmcnt(0)" ::: "memory");
    __syncthreads();
    if (threadIdx.x == 0) {
        __builtin_amdgcn_s_waitcnt(0);
        unsigned md = mode[0];
        if (md == 0u) { md = (xb_ld(gwd + 128) + xb_ld(gwd + 192) == 17u) ? 1u : 2u; mode[0] = md; }
        if (md != 1u) { __builtin_amdgcn_fence(__ATOMIC_RELEASE, "agent"); asm volatile("s_waitcnt vmcnt(0)" ::: "memory"); }
        const unsigned old = xb_add(gwd, 1u); const unsigned gen = old / n;
        if (old + 1u == (gen + 1u) * n) xb_add(gwd + 64, 1u);
        else XB_SPIN(xb_ld(gwd + 64) == gen, b.bar);
        __builtin_amdgcn_fence(__ATOMIC_ACQUIRE, "agent");
        asm volatile("s_waitcnt vmcnt(0)" ::: "memory");
    }
    __syncthreads();
}
struct Args { const float* in[23]; float* out; unsigned char* ws; int ph_lo, ph_hi, li, pad; };
constexpr int N_PHASES = 13;
#ifndef MK_N_LAUNCHES
#define MK_N_LAUNCHES 1
#endif

__global__ void __launch_bounds__(NWAVES * 64, 2) mega_fwd(Args args) {
    extern __shared__ __attribute__((aligned(16))) unsigned char lds_raw[];
    Ctx C;
    C.lds = (LAS unsigned char*)lds_raw; C.ldsg = (char*)lds_raw;
    C.tid = threadIdx.x; C.lane = C.tid & 63; C.wave = __builtin_amdgcn_readfirstlane(C.tid >> 6);
    C.G = gridDim.x; { const int bx = blockIdx.x; C.vcu = (C.G % 8 == 0) ? (bx % 8) * (C.G / 8) + bx / 8 : bx; }
#pragma unroll
    for (int i = 0; i < 23; ++i) C.in[i] = args.in[i];
    C.out = args.out; C.ws = args.ws;
    volatile LAS unsigned* MISC = (volatile LAS unsigned*)(C.lds + MISC_OFF);
    for (int u = C.tid; u < (LDS_BYTES - LDSCTL_OFF) / 4; u += NWAVES * 64) ((LAS unsigned*)(C.lds + LDSCTL_OFF))[u] = 0u;
    __syncthreads();
    unsigned* ctl = (unsigned*)(C.ws + WS_CTL);
    XcdBarrier bar = xcd_barrier_post(ctl + CW_BAR + args.li * XCD_BAR_WORDS, MISC + 8);
    unsigned* gwd = ctl + CW_GRP + 256 * ((int)blockIdx.x & 7);
    if (threadIdx.x == 0) { const unsigned xc = xb_xcc_id(); __hip_atomic_fetch_max(gwd + 128, xc + 1u, __ATOMIC_RELAXED, __HIP_MEMORY_SCOPE_AGENT); __hip_atomic_fetch_max(gwd + 192, 16u - xc, __ATOMIC_RELAXED, __HIP_MEMORY_SCOPE_AGENT); }
    const bool gloc = (C.G == 256) && (MK_N_LAUNCHES == 1);
    const int lo = args.ph_lo, hi = args.ph_hi;
#define IN(k) (lo <= (k) && (k) < hi)
#define SEAM(k) do { if (IN(k) && IN((k) + 1)) xcd_barrier(bar); } while (0)
#define SEAMG(k) do { if (gloc) grp_barrier(bar, gwd, 32u, MISC + 12); else xcd_barrier(bar); } while (0)
#ifndef PROBE_REP
#define PROBE_REP -1
#endif
#define REPS(k) (((k) == PROBE_REP) ? 2 : 1)
#define DUP(k, ...) do { __VA_ARGS__; if (REPS(k) == 2) { __VA_ARGS__; } } while (0)

    if (IN(0)) { DUP(0, p0_prologue(C)); } SEAM(0);
    if (IN(1)) { DUP(30, p1_h1(C)); } SEAMG(1);
    if (IN(2)) {
        { pg8::DenseSched S; S.init(M, 1024, C.G, (int)blockIdx.x, WSP(bf16_t, WS_WIN), 1024); S.pn_base = 6; pg8::EpiProj E{WSP(bf16_t, WS_PROJ), WSP(float, WS_KMEAN)};
          DUP(2, pg8::gemm_phase<pg8::EpiProj, pg8::DenseSched, true>(C.lds, WSP(bf16_t, WS_H), 1024, 1024, 1024, S, E)); }
        { pg8::DenseSched S; S.init(M, INW - 1024, C.G, (int)blockIdx.x, C.ws + WS_WINQ, 512); S.pn_skip_at = 6; S.pn_skip = 4; pg8::EpiProjQ E{WSP(bf16_t, WS_PROJ), WSP(const float, WS_SA), WSP(const float, WS_SWIN)};
          DUP(2, pg8::gemm_phase<pg8::EpiProjQ, pg8::DenseSched, true, true>(C.lds, C.ws + WS_H2Q, 512, 512, 512, S, E)); }
    } if (IN(2) && IN(5)) xcd_barrier(bar);
    if (IN(5)) { p4_attention(C, 3 | (3 << 2), true); if (REPS(5) == 2) p4_attention(C, PROBE_SUB, false); } SEAM(5);
    if (IN(6)) { DUP(30, p5_ycombine(C)); } SEAMG(6);
    if (IN(7)) { pg8::DenseSched S; S.init(M, D, C.G, (int)blockIdx.x, WSP(bf16_t, WS_WBR), 1024); pg8::EpiBr E{WSP(const bf16_t, WS_PROJ + 3 * PROJ_STRIDE), WSP(const bf16_t, WS_PROJ + 4 * PROJ_STRIDE), WSP(bf16_t, WS_MERGED)};
        DUP(31, pg8::gemm_phase<pg8::EpiBr, pg8::DenseSched, true>(C.lds, WSP(bf16_t, WS_Y), 1024, 1024, 1024, S, E)); } SEAMG(7);
    if (IN(9)) { pg8::DenseSched S; S.init(M, D, C.G, (int)blockIdx.x, WSP(bf16_t, WS_WOUT), 1024); pg8::EpiOut E{C.in[0], WSP(const float, WS_ADAF), WSP(bf16_t, WS_X1)};
        DUP(32, pg8::gemm_phase<pg8::EpiOut, pg8::DenseSched, true>(C.lds, WSP(bf16_t, WS_MERGED), 1024, 1024, 1024, S, E)); } SEAMG(9);
    if (IN(10)) { DUP(30, p8_router(C)); } SEAM(10);
    if (IN(11)) { DUP(33, p9_slots(C)); } SEAM(11);
    if (IN(12)) {
        LAS int* te = (LAS int*)(C.lds + RING_BYTES + 64);
        if (C.tid < 33) te[C.tid] = WSP(const int, WS_EOFF)[C.tid] >> 8;
        __syncthreads();
        unsigned* tdone = (unsigned*)(C.ws + WS_CTL) + CW_TDONE; unsigned* tmo = (unsigned*)(C.ws + WS_CTL) + CW_TMO;
        { pg8::MoeSched<true, false, false> S{te, 8, C.G, (int)blockIdx.x, WSP(const int, WS_SLOTTOK), (const char*)(C.ws + WS_WGU), (size_t)2048 * 1024, (size_t)256 * 1024, tdone, tmo};
          pg8::EpiGUQ E{C.in[19], WSP(const float, WS_SW), WSP(const float, WS_SLOTSA), WSP(bf16_t, WS_ACT)};
          DUP(20, pg8::gemm_phase<pg8::EpiGUQ, pg8::MoeSched<true, false, false>, true, true>(C.lds, C.ws + WS_H2Q, 512, 512, 512, S, E)); }
        SEAMG(12);
        { pg8::MoeSched<false, false, false, true> S{te, 4, C.G, (int)blockIdx.x, nullptr, (const char*)WSP(bf16_t, WS_WD), (size_t)1024 * 1024 * 2, (size_t)256 * 1024 * 2, tdone, tmo};
          pg8::EpiDown E{C.in[21], WSP(const float, WS_SLOTW), WSP(bf16_t, WS_SOUT)};
          DUP(21, pg8::gemm_phase<pg8::EpiDown, pg8::MoeSched<false, false, false, true>, true>(C.lds, WSP(bf16_t, WS_ACT), 1024, 1024, 1024, S, E)); }
        xcd_barrier(bar);
        DUP(30, p12_final(C));
    }
#undef IN
#undef SEAM
}

extern "C" void kernel_launch(void* const* d_in, const int* in_sizes, int n_in, void* d_out, int out_size, void* d_ws, size_t ws_size, hipStream_t stream) {
    static int grid = 0;
    if (grid == 0) {
        if (n_in != 23 || in_sizes[0] != M * D || out_size != M * D || ws_size < WS_END) { fprintf(stderr, "kernel_launch: unexpected shapes (n_in %d, in0 %d, out %d, ws %zu); nothing launched\n", n_in, n_in > 0 ? in_sizes[0] : -1, out_size, ws_size); grid = -1; return; }
        int dev = 0, cus = 0, per_cu = 0;
        if (hipGetDevice(&dev) != hipSuccess || hipDeviceGetAttribute(&cus, hipDeviceAttributeMultiprocessorCount, dev) != hipSuccess) { grid = -1; return; }
        if (hipFuncSetAttribute((const void*)mega_fwd, hipFuncAttributeMaxDynamicSharedMemorySize, LDS_BYTES) != hipSuccess) { fprintf(stderr, "kernel_launch: hipFuncSetAttribute failed\n"); grid = -1; return; }
        if (hipOccupancyMaxActiveBlocksPerMultiprocessor(&per_cu, (const void*)mega_fwd, NWAVES * 64, LDS_BYTES) != hipSuccess || per_cu < 1) { fprintf(stderr, "kernel_launch: occupancy query reports %d workgroups per CU\n", per_cu); }
        (void)hipGetLastError();
        grid = cus >= 8 ? cus - cus % 8 : cus;
    }
    if (grid < 0) return;
    if (hipMemsetAsync((char*)d_ws + WS_CTL, 0, CTL_ZERO_BYTES, stream) != hipSuccess) { fprintf(stderr, "kernel_launch: memset failed\n"); return; }
    Args a{};
    for (int i = 0; i < 23; ++i) a.in[i] = (const float*)d_in[i];
    a.out = (float*)d_out; a.ws = (unsigned char*)d_ws;
    constexpr int NL = MK_N_LAUNCHES;
    for (int li = 0; li < NL; ++li) {
        a.ph_lo = (NL == 1) ? 0 : li; a.ph_hi = (NL == 1) ? N_PHASES : li + 1; a.li = (NL == 1) ? 0 : li; a.pad = 0;
        hipLaunchKernelGGL(mega_fwd, dim3(grid), dim3(NWAVES * 64), LDS_BYTES, stream, a);
        const hipError_t le = hipPeekAtLastError();
        if (le != hipSuccess) { fprintf(stderr, "kernel_launch: launch %d failed: %s\n", li, hipGetErrorName(le)); break; }
    }
}
```

```cpp
#include <hip/hip_runtime.h>
#include <cstdio>
#include <cstdint>
#ifndef SIMPLE_DIFF
#define SIMPLE_DIFF 0
#endif
#ifndef NATIVE_DIFF
#define NATIVE_DIFF 1
#endif

#define GAS __attribute__((address_space(1)))
#define LAS __attribute__((address_space(3)))
typedef unsigned short bf16_t;
typedef short bf16x8 __attribute__((ext_vector_type(8)));
typedef short s16x4 __attribute__((ext_vector_type(4)));
typedef float f32x4 __attribute__((ext_vector_type(4)));
typedef float f32x2 __attribute__((ext_vector_type(2)));
typedef unsigned u32x4 __attribute__((ext_vector_type(4)));
typedef unsigned u32x2 __attribute__((ext_vector_type(2)));
typedef int i32x4 __attribute__((ext_vector_type(4)));
#define RLX_AGENT __ATOMIC_RELAXED, __HIP_MEMORY_SCOPE_AGENT
#define LDS_WAIT() asm volatile("s_waitcnt lgkmcnt(0)" ::: "memory")
#define VM_WAIT() asm volatile("s_waitcnt vmcnt(0)" ::: "memory")

constexpr int BATCH = 2, SEQ = 8192, M = BATCH * SEQ, D = 1024, INW = 5120;
constexpr int NE = 32, TOPK = 4;
constexpr int NWAVES = 8;
constexpr float RMS_EPS = 1e-5f;
constexpr float LOG2E = 1.4426950408889634f;
constexpr float C2 = 0.125f * LOG2E;
constexpr int SLOT_ROWS = M * TOPK + NE * 256;

constexpr size_t MiB = 1u << 20, KiB = 1u << 10;
constexpr size_t WS_CTL = 0, CTL_ZERO_BYTES = 1 * MiB;
constexpr size_t WS_ADAP = 1 * MiB;
constexpr size_t WS_ADAF = 1 * MiB + 896 * KiB;
constexpr size_t WS_KMEAN = 512 * KiB;
constexpr size_t WS_TOPI = 2 * MiB + 256 * KiB;
constexpr size_t WS_TOPW = 2 * MiB + 512 * KiB;
constexpr size_t WS_TOKSLOT = 2 * MiB + 768 * KiB;
constexpr size_t WS_SLOTTOK = 3 * MiB;
constexpr size_t WS_SLOTW = 3 * MiB + 512 * KiB;
constexpr size_t WS_HIST = 4 * MiB;
constexpr size_t WS_EOFF = 4 * MiB + 64 * KiB;
constexpr size_t WS_WRT = 4 * MiB + 128 * KiB;
constexpr size_t WS_SLOTSA = 4 * MiB + 256 * KiB;
constexpr size_t WS_SW = 5 * MiB;
constexpr size_t WS_SWIN = 5 * MiB + 640 * KiB;
constexpr size_t WS_SA = 5 * MiB + 512 * KiB;
constexpr size_t WS_LIST = 6 * MiB;
constexpr size_t WS_PML = 14 * MiB;
constexpr size_t WS_WIN = 18 * MiB, WS_WBR = 28 * MiB, WS_WOUT = 30 * MiB, WS_WGU = 32 * MiB, WS_WD = 160 * MiB;
constexpr size_t WS_H = 224 * MiB;
constexpr size_t WS_PROJ = 256 * MiB;
constexpr size_t PROJ_STRIDE = 32 * MiB;
constexpr size_t WS_Y = 416 * MiB;
constexpr size_t WS_PO = 448 * MiB;
constexpr size_t WS_H2Q = 512 * MiB;
constexpr size_t WS_MERGED = 576 * MiB;
constexpr size_t WS_X1 = 608 * MiB;
constexpr size_t WS_ACT = 672 * MiB;
constexpr size_t WS_SOUT = 816 * MiB;
constexpr size_t WS_OA = 960 * MiB;
constexpr size_t WS_WINQ = 992 * MiB;
constexpr size_t WS_END = 1000 * MiB;
constexpr int LIST_PER_BH = 126976;
constexpr int CW_TMO = 0, CW_CODE = 1, CW_BAR = 4096, CW_MCNT = 65536, CW_TDONE = 80000, CW_AQ = 110000, CW_GDONE = 121000;

constexpr int RING_BYTES = 131072, LDSCTL_OFF = RING_BYTES, MISC_OFF = LDSCTL_OFF + 320, LDS_BYTES = 163840;

__device__ __forceinline__ unsigned f2bf(float f) { unsigned u = __builtin_bit_cast(unsigned, f); return (u + 0x7fffu + ((u >> 16) & 1u)) >> 16; }
__device__ __forceinline__ unsigned pk2(float lo, float hi) { return f2bf(lo) | (f2bf(hi) << 16); }
__device__ __forceinline__ unsigned cvt_pk_bf16(float lo, float hi) { unsigned r; asm volatile("v_cvt_pk_bf16_f32 %0, %1, %2" : "=v"(r) : "v"(lo), "v"(hi)); return r; }
__device__ __forceinline__ float bf_lo(unsigned u) { return __builtin_bit_cast(float, u << 16); }
__device__ __forceinline__ float bf_hi(unsigned u) { return __builtin_bit_cast(float, u & 0xffff0000u); }
__device__ __forceinline__ float sigmoidf_fast(float v) { return __builtin_amdgcn_rcpf(1.0f + __builtin_amdgcn_exp2f(-v * LOG2E)); }
__device__ __forceinline__ float wave_sum(float v) {
#pragma unroll
    for (int o = 1; o < 64; o <<= 1) v += __shfl_xor(v, o);
    return v;
}

namespace pg8 {
constexpr int BM = 256, BK = 64, HALF = 128, HTB = HALF * BK * 2, STAGE_BYTES = 8 * HTB, NXCD = 8, WGM = 8;
__device__ __forceinline__ int lds_byte(int r, int c) { const int st = (r >> 4) * 2 + (c >> 5), rr = r & 15, cc = c & 31, ob = rr * 64 + cc * 2; return st * 1024 + (ob ^ (((ob >> 9) & 1) << 5)); }
__device__ __forceinline__ void stage_rc(int b, int& R, int& C) { const int st = b / 1024, sb = b % 1024, swz = sb ^ (((sb >> 9) & 1) << 5); R = (st >> 1) * 16 + swz / 64; C = (st & 1) * 32 + (swz % 64) / 2; }
__device__ __forceinline__ int perm32(int rho) { const int n = rho >> 4, i = rho & 15; return 8 * (i >> 2) + 4 * n + (i & 3); }

struct Unit { int row0; int pm, pn, e, half; const char* bptr; };

struct DenseSched {
    static constexpr bool HAS_READY = false, HAS_DONE = false;
    int nM, nN, nwg, G, c; const char* Bt; size_t btile;
    int pn_base = 0, pn_skip_at = 1 << 30, pn_skip = 0;
    __device__ __forceinline__ void init(int M_, int N_, int G_, int c_, const void* Bt_, int ldb) { nM = M_ / BM; nN = N_ / BM; nwg = nM * nN; G = G_; c = c_; Bt = (const char*)Bt_; btile = (size_t)BM * ldb * 2; }
    __device__ __forceinline__ bool next(int i, Unit& u) const {
        const long L = (long)i * G + c; if (L >= nwg) return false;
        int wgid = (int)L; { const int q = nwg / NXCD, r = nwg % NXCD, xcd = wgid % NXCD, off = wgid / NXCD; wgid = (xcd < r ? xcd * (q + 1) : r * (q + 1) + (xcd - r) * q) + off; }
        const int nig = WGM * nN, gid = wgid / nig, fm = gid * WGM, gsz = (nM - fm) < WGM ? (nM - fm) : WGM;
        u.pm = fm + ((wgid % nig) % gsz); { const int pl = (wgid % nig) / gsz; u.pn = pn_base + pl + (pl >= pn_skip_at ? pn_skip : 0); } u.row0 = u.pm * BM; u.e = 0; u.half = 0; u.bptr = Bt + (size_t)u.pn * btile; return true;
    }
    __device__ __forceinline__ int arow(const Unit& u, int r) const { return u.row0 + r; }
    __device__ __forceinline__ void a_ready(const Unit&) const {}
    __device__ __forceinline__ void done(int) const {}
};

template <bool I8> struct AccSel { typedef f32x4 T; };
template <> struct AccSel<true> { typedef i32x4 T; };
template <class Epi, class Sched, bool ALIGN_EPI, bool I8 = false>
__device__ __forceinline__ void gemm_phase(LAS unsigned char* lds, const void* Abase_, int lda, int ldb, int K, const Sched& S, const Epi& E) {
    int tid_ = threadIdx.x; asm volatile("" : "+v"(tid_));
    const int tid = tid_, wid = __builtin_amdgcn_readfirstlane(tid >> 6), lane = tid & 63, wr = wid >> 2, wc = wid & 3, fr = lane & 15, fq = lane >> 4;
    const int nt = K / BK;
    const char* Abase = (const char*)Abase_;
    int Rr[2], Cc[2]; unsigned voffB[2];
#pragma unroll
    for (int i = 0; i < 2; ++i) { stage_rc(tid * 16 + i * 8192, Rr[i], Cc[i]); const int Rb = Epi::PERM ? ((Rr[i] & ~31) + perm32(Rr[i] & 31)) : Rr[i]; voffB[i] = (unsigned)(Rb * ldb + Cc[i]) * 2u; }
    const size_t kstep = (size_t)(BK * 2);
    const size_t hstepB = (size_t)HALF * ldb * 2;
    const unsigned ldsw = (unsigned)wid * 1024u;
    const int aoff = lds_byte(wr * 64 + fr, fq * 8), boff = lds_byte(wc * 32 + fr, fq * 8);
#define PG8_SA(b, h) (((b) * 2 + (h)) * HTB)
#define PG8_SB(b, h) ((4 + (b) * 2 + (h)) * HTB)
#define PG8_STAGE(bufoff, gbase, voff) do { _Pragma("unroll") for (int _i = 0; _i < 2; ++_i) \
        __builtin_amdgcn_global_load_lds((const unsigned*)((const char*)(gbase) + (voff)[_i]), (LAS unsigned*)(lds + (bufoff) + ldsw + _i * 8192), 16, 0, 0); } while (0)
#define PG8_LDA(dst, b, h) do { _Pragma("unroll") for (int m = 0; m < 4; ++m) _Pragma("unroll") for (int k = 0; k < 2; ++k) dst[m][k] = *(const LAS bf16x8*)(lds + PG8_SA(b, h) + aoff + m * 2048 + k * 1024); } while (0)
#define PG8_LDB(dst, b, h) do { _Pragma("unroll") for (int n = 0; n < 2; ++n) _Pragma("unroll") for (int k = 0; k < 2; ++k) dst[n][k] = *(const LAS bf16x8*)(lds + PG8_SB(b, h) + boff + n * 2048 + k * 1024); } while (0)
#define PG8_MMA(ai, bj, At, Bt) do { __builtin_amdgcn_s_setprio(1); _Pragma("unroll") for (int m = 0; m < 4; ++m) _Pragma("unroll") for (int n = 0; n < 2; ++n) _Pragma("unroll") for (int k = 0; k < 2; ++k) { \
        if constexpr (I8) acc[ai][bj][m][n] = __builtin_amdgcn_mfma_i32_16x16x64_i8(__builtin_bit_cast(i32x4, Bt[n][k]), __builtin_bit_cast(i32x4, At[m][k]), acc[ai][bj][m][n], 0, 0, 0); \
        else acc[ai][bj][m][n] = __builtin_amdgcn_mfma_f32_16x16x32_bf16(Bt[n][k], At[m][k], acc[ai][bj][m][n], 0, 0, 0); } __builtin_amdgcn_s_setprio(0); } while (0)
#define PG8_WAIT_V(n) asm volatile("s_waitcnt vmcnt(" #n ")" ::: "memory")
#define PG8_WAIT_L(n) asm volatile("s_waitcnt lgkmcnt(" #n ")" ::: "memory")
#define PG8_BAR __builtin_amdgcn_s_barrier()
#define PG8_SCHED __builtin_amdgcn_sched_barrier(0)
#define PG8_ROWS(u, va) do { _Pragma("unroll") for (int _h = 0; _h < 2; ++_h) _Pragma("unroll") for (int _i = 0; _i < 2; ++_i) \
        va[_h][_i] = (unsigned)(S.arow(u, _h * HALF + Rr[_i]) * lda + Cc[_i]) * 2u; } while (0)
    Unit cur, nxt; int ui = 0; int prev_pm = -1;
    if (!S.next(0, cur)) return;
    unsigned vaC[2][2], vaN[2][2];
    PG8_ROWS(cur, vaC);
    typedef typename AccSel<I8>::T acc_t;
    acc_t acc[2][2][4][2];
#pragma unroll
    for (int a = 0; a < 2; ++a)
#pragma unroll
        for (int b = 0; b < 2; ++b)
#pragma unroll
            for (int m = 0; m < 4; ++m)
#pragma unroll
                for (int n = 0; n < 2; ++n) acc[a][b][m][n] = (acc_t){0, 0, 0, 0};
    bf16x8 At[4][2], B0[2][2], B1[2][2];
    const char* cB = cur.bptr;
    if constexpr (Sched::HAS_READY) S.a_ready(cur);
    PG8_STAGE(PG8_SB(0, 0), cB, voffB); PG8_STAGE(PG8_SB(0, 1), cB + hstepB, voffB); PG8_STAGE(PG8_SA(0, 0), Abase, vaC[0]); PG8_STAGE(PG8_SA(0, 1), Abase, vaC[1]);
    if (wr == 1) PG8_BAR;
    PG8_WAIT_V(2); PG8_BAR;
    PG8_STAGE(PG8_SB(1, 0), cB + kstep, voffB); PG8_STAGE(PG8_SA(1, 0), Abase + kstep, vaC[0]); PG8_STAGE(PG8_SB(1, 1), cB + hstepB + kstep, voffB);
    PG8_WAIT_V(6); PG8_BAR;
    for (;;) {
        const bool has_next = S.next(ui + 1, nxt);
        if (has_next) { PG8_ROWS(nxt, vaN); } else { nxt = cur;
#pragma unroll
            for (int h = 0; h < 2; ++h)
#pragma unroll
                for (int i = 0; i < 2; ++i) vaN[h][i] = vaC[h][i]; }
        const char* nB = nxt.bptr;
        for (int t = 0; t < nt; t += 2) {
            if constexpr (Epi::HAS_MID) { if (t == (nt >> 1)) E.mid(acc, cur, wr, wc, fr, fq); }
            const bool last = (t == nt - 2);
            if constexpr (Sched::HAS_DONE) { if (last && prev_pm >= 0) { S.done(prev_pm); prev_pm = -1; } }
            if constexpr (Sched::HAS_READY) { if (last && has_next) S.a_ready(nxt); }
            const char* a1 = Abase + (size_t)(t + 1) * kstep;
            const char* a2 = last ? Abase : Abase + (size_t)(t + 2) * kstep; const char* b2 = last ? nB : cB + (size_t)(t + 2) * kstep;
            const char* a3 = a2 + kstep; const char* b3 = b2 + kstep;
            unsigned v2[2][2];
#pragma unroll
            for (int h = 0; h < 2; ++h)
#pragma unroll
                for (int i = 0; i < 2; ++i) v2[h][i] = last ? vaN[h][i] : vaC[h][i];
            PG8_LDB(B0, 0, 0); PG8_LDB(B1, 0, 1); PG8_SCHED; PG8_LDA(At, 0, 0); PG8_STAGE(PG8_SA(1, 1), a1, vaC[1]);
            PG8_WAIT_V(8); PG8_WAIT_L(0); PG8_BAR; PG8_MMA(0, 0, At, B0); PG8_MMA(0, 1, At, B1); PG8_BAR; PG8_SCHED;
            PG8_LDA(At, 0, 1); PG8_STAGE(PG8_SB(0, 0), b2, voffB); PG8_STAGE(PG8_SB(0, 1), b2 + hstepB, voffB); PG8_STAGE(PG8_SA(0, 0), a2, v2[0]);
            PG8_WAIT_V(8); PG8_WAIT_L(0); PG8_BAR; if (!cur.half) { PG8_MMA(1, 0, At, B0); PG8_MMA(1, 1, At, B1); } PG8_BAR; PG8_SCHED;
            PG8_LDB(B0, 1, 0); PG8_LDB(B1, 1, 1); PG8_SCHED; PG8_LDA(At, 1, 0); PG8_STAGE(PG8_SA(0, 1), a2, v2[1]);
            PG8_WAIT_V(8); PG8_WAIT_L(0); PG8_BAR; PG8_MMA(0, 0, At, B0); PG8_MMA(0, 1, At, B1); PG8_BAR; PG8_SCHED;
            PG8_LDA(At, 1, 1); PG8_STAGE(PG8_SB(1, 0), b3, voffB); PG8_STAGE(PG8_SB(1, 1), b3 + hstepB, voffB); PG8_STAGE(PG8_SA(1, 0), a3, v2[0]);
            PG8_WAIT_V(8); PG8_WAIT_L(0); PG8_BAR; if (!cur.half) { PG8_MMA(1, 0, At, B0); PG8_MMA(1, 1, At, B1); } PG8_BAR; PG8_SCHED;
        }
        if constexpr (ALIGN_EPI) { if (wr == 0) PG8_BAR; }
        E(acc, cur, wr, wc, fr, fq); if constexpr (Sched::HAS_DONE) prev_pm = cur.pm;
        if (!has_next) break;
#pragma unroll
        for (int a = 0; a < 2; ++a)
#pragma unroll
            for (int b = 0; b < 2; ++b)
#pragma unroll
                for (int m = 0; m < 4; ++m)
#pragma unroll
                    for (int n = 0; n < 2; ++n) acc[a][b][m][n] = (acc_t){0, 0, 0, 0};
        cur = nxt; cB = nB; ++ui;
#pragma unroll
        for (int h = 0; h < 2; ++h)
#pragma unroll
            for (int i = 0; i < 2; ++i) vaC[h][i] = vaN[h][i];
        if constexpr (ALIGN_EPI) { if (wr == 1) PG8_BAR; }
    }
    PG8_WAIT_V(0);
    if constexpr (Sched::HAS_DONE) { if (prev_pm >= 0) S.done(prev_pm); }
    if constexpr (!ALIGN_EPI) { if (wr == 0) PG8_BAR; }
    PG8_BAR;
#undef PG8_SA
#undef PG8_SB
#undef PG8_STAGE
#undef PG8_LDA
#undef PG8_LDB
#undef PG8_MMA
#undef PG8_WAIT_V
#undef PG8_WAIT_L
#undef PG8_BAR
#undef PG8_SCHED
#undef PG8_ROWS
}
}
#define XB_TMO      128
#define XB_XCNT(j)  (256  + 64 * (j))
#define XB_XSUB(j)  (1280 + 64 * (j))
#define XB_XGEN(j)  (2304 + 64 * (j))
#define XB_TOP      3328
#define XB_TOPGEN   3392
#define XCD_BAR_WORDS 3456
#define XB_SPIN_CAP (1u << 18)

__device__ __forceinline__ unsigned xb_ld(unsigned* p)              { return __hip_atomic_load(p, __ATOMIC_RELAXED, __HIP_MEMORY_SCOPE_AGENT); }
__device__ __forceinline__ unsigned xb_add(unsigned* p, unsigned v) { return __hip_atomic_fetch_add(p, v, __ATOMIC_RELAXED, __HIP_MEMORY_SCOPE_AGENT); }
__device__ __forceinline__ unsigned xb_xcc_id() { return (unsigned)__builtin_amdgcn_s_getreg((3 << 11) | 20) & 0xFu; }
#define XB_SPIN(cond, bar) do { unsigned _sp = 0; while (cond) { __builtin_amdgcn_s_sleep(1); \
    if ((++_sp & 255u) == 0u) { if (xb_ld(&(bar)[XB_TMO])) break; if (_sp > XB_SPIN_CAP) { atomicAdd(&(bar)[XB_TMO], 1u); break; } } } } while (0)

struct XcdBarrier {
    unsigned* bar; unsigned x;
    volatile LAS unsigned* st;
};

__device__ __forceinline__ XcdBarrier xcd_barrier_post(unsigned* bar, volatile LAS unsigned* st) {
    XcdBarrier b; b.bar = bar; b.x = xb_xcc_id(); b.st = st;
    if (threadIdx.x == 0) (void)xb_add(&bar[XB_XCNT(b.x)], 1u);
    return b;
}
__device__ __forceinline__ void xcd_barrier_complete(unsigned* bar, unsigned x, unsigned& nloc, unsigned& nx) {
    const unsigned G = gridDim.x * gridDim.y * gridDim.z;
    unsigned sum, cnt, mine, sp = 0u;
    for (;;) {
        sum = 0u; cnt = 0u; mine = 0u;
#pragma unroll
        for (unsigned j = 0; j < 16; ++j) { const unsigned c = xb_ld(&bar[XB_XCNT(j)]); sum += c; cnt += (c > 0u) ? 1u : 0u; mine = (j == x) ? c : mine; }
        if (sum == G) break;
        __builtin_amdgcn_s_sleep(1);
        if ((++sp & 255u) == 0u) { if (xb_ld(&bar[XB_TMO])) break; if (sp > XB_SPIN_CAP) { atomicAdd(&bar[XB_TMO], 1u); break; } }
    }
    nloc = mine > 0u ? mine : 1u; nx = cnt > 0u ? cnt : 1u;
}

__device__ __forceinline__ void xcd_barrier(const XcdBarrier& b) {
    asm volatile("s_waitcnt vmcnt(0)" ::: "memory");
    __syncthreads();
    if (threadIdx.x == 0) {
        unsigned* bar = b.bar;
        __builtin_amdgcn_s_waitcnt(0);
        unsigned nloc = b.st[0], nx = b.st[1];
        if (nloc == 0u) { xcd_barrier_complete(bar, b.x, nloc, nx); b.st[0] = nloc; b.st[1] = nx; }
        const unsigned old = xb_add(&bar[XB_XSUB(b.x)], 1u);
        const unsigned gen = old / nloc;
        if (old + 1u == (gen + 1u) * nloc) {
            __builtin_amdgcn_fence(__ATOMIC_RELEASE, "agent");
            asm volatile("s_waitcnt vmcnt(0)" ::: "memory");
            const unsigned og = xb_add(&bar[XB_TOP], 1u);
            const unsigned tg = og / nx;
            if (og + 1u == (tg + 1u) * nx) xb_add(&bar[XB_TOPGEN], 1u);
            else XB_SPIN(xb_ld(&bar[XB_TOPGEN]) == tg, bar);
            __builtin_amdgcn_fence(__ATOMIC_ACQUIRE, "agent");
            xb_add(&bar[XB_XGEN(b.x)], 1u);
            asm volatile("s_waitcnt vmcnt(0)" ::: "memory");
        } else {
            XB_SPIN(xb_ld(&bar[XB_XGEN(b.x)]) == gen, bar);
            __builtin_amdgcn_fence(__ATOMIC_ACQUIRE, "agent");
            asm volatile("s_waitcnt vmcnt(0)" ::: "memory");
        }
    }
    __syncthreads();
}
namespace pg8 {
struct EpiProj {
    static constexpr bool PERM = true, HAS_MID = false;
    bf16_t* base; float* kmean;
    __device__ __forceinline__ void operator()(const f32x4 (&acc)[2][2][4][2], const Unit& u, int wr, int wc, int fr, int fq) const {
        if (u.pn == 8 || u.pn == 9) {
            const int b = u.pm >> 5, nblk = u.pm & 31;
#pragma unroll
            for (int bj = 0; bj < 2; ++bj)
#pragma unroll
                for (int n = 0; n < 2; ++n) { f32x4 s = (f32x4){0.f, 0.f, 0.f, 0.f};
#pragma unroll
                    for (int ai = 0; ai < 2; ++ai)
#pragma unroll
                        for (int m = 0; m < 4; ++m) s += acc[ai][bj][m][n];
#pragma unroll
                    for (int j = 0; j < 4; ++j) { float v = s[j]; v += __shfl_xor(v, 1); v += __shfl_xor(v, 2); v += __shfl_xor(v, 4); v += __shfl_xor(v, 8); s[j] = v; }
                    if (fr == 0) { const int col = (u.pn - 8) * 256 + bj * HALF + wc * 32 + 8 * fq + 4 * n; const int h = col >> 6, d = col & 63; float* kp = kmean + ((size_t)((b * 8 + h) * 32 + nblk)) * 64 + d;
#pragma unroll
                        for (int j = 0; j < 4; ++j) atomicAdd(kp + j, s[j] * (1.0f / 256.0f)); } }
        }
        const int buf = u.pn >> 2, colt = (u.pn & 3) * 256;
        const float sc = (u.pn < 2 || u.pn == 6 || u.pn == 7) ? C2 : 1.0f;
        bf16_t* dst = base + (size_t)buf * (PROJ_STRIDE / 2);
        const int row0 = u.row0 + wr * 64 + fr, col0 = colt + wc * 32 + 8 * fq;
#pragma unroll
        for (int ai = 0; ai < 2; ++ai)
#pragma unroll
            for (int m = 0; m < 4; ++m) { bf16_t* rowp = dst + (size_t)(row0 + ai * HALF + m * 16) * 1024 + col0;
#pragma unroll
                for (int bj = 0; bj < 2; ++bj) { const f32x4 v0 = acc[ai][bj][m][0] * sc, v1 = acc[ai][bj][m][1] * sc;
                    u32x4 w; w.x = cvt_pk_bf16(v0[0], v0[1]); w.y = cvt_pk_bf16(v0[2], v0[3]); w.z = cvt_pk_bf16(v1[0], v1[1]); w.w = cvt_pk_bf16(v1[2], v1[3]);
                    *(u32x4*)(rowp + bj * HALF) = w; } }
    }
};
struct EpiProjQ {
    static constexpr bool PERM = true, HAS_MID = false;
    bf16_t* base; const float* sa; const float* sw;
    __device__ __forceinline__ void operator()(const i32x4 (&acc)[2][2][4][2], const Unit& u, int wr, int wc, int fr, int fq) const {
        const int buf = u.pn >> 2, colt = (u.pn & 3) * 256;
        const float sc = (u.pn < 2) ? C2 : 1.0f;
        bf16_t* dst = base + (size_t)buf * (PROJ_STRIDE / 2);
        const int row0 = u.row0 + wr * 64 + fr, col0 = colt + wc * 32 + 8 * fq;
        const float* swp = sw + u.pn * 256 + wc * 32 + 8 * fq;
        f32x4 sv[2][2];
#pragma unroll
        for (int bj = 0; bj < 2; ++bj)
#pragma unroll
            for (int n = 0; n < 2; ++n) sv[bj][n] = *(const f32x4*)(swp + bj * HALF + 4 * n) * sc;
#pragma unroll
        for (int ai = 0; ai < 2; ++ai)
#pragma unroll
            for (int m = 0; m < 4; ++m) { const int row = row0 + ai * HALF + m * 16; const float ts = sa[row]; bf16_t* rowp = dst + (size_t)row * 1024 + col0;
#pragma unroll
                for (int bj = 0; bj < 2; ++bj) { const i32x4 a0 = acc[ai][bj][m][0], a1 = acc[ai][bj][m][1];
                    const f32x4 v0 = (f32x4){(float)a0[0], (float)a0[1], (float)a0[2], (float)a0[3]} * (sv[bj][0] * ts), v1 = (f32x4){(float)a1[0], (float)a1[1], (float)a1[2], (float)a1[3]} * (sv[bj][1] * ts);
                    u32x4 w; w.x = cvt_pk_bf16(v0[0], v0[1]); w.y = cvt_pk_bf16(v0[2], v0[3]); w.z = cvt_pk_bf16(v1[0], v1[1]); w.w = cvt_pk_bf16(v1[2], v1[3]);
                    *(u32x4*)(rowp + bj * HALF) = w; } }
    }
};
struct EpiBr {
    static constexpr bool PERM = true, HAS_MID = true;
    const bf16_t* gla; const bf16_t* glb; bf16_t* out;
    __device__ __forceinline__ void mid(f32x4 (&acc)[2][2][4][2], const Unit& u, int wr, int wc, int fr, int fq) const {
        int row0 = u.row0 + wr * 64 + fr, col0 = u.pn * 256 + wc * 32 + 8 * fq; asm volatile("" : "+v"(row0), "+v"(col0));
#pragma unroll
        for (int ai = 0; ai < 2; ++ai)
#pragma unroll
            for (int m = 0; m < 4; ++m) { const size_t ro = (size_t)(row0 + ai * HALF + m * 16) * 1024 + col0;
#pragma unroll
                for (int bj = 0; bj < 2; ++bj) { const u32x4 ga = *(const u32x4*)(gla + ro + bj * HALF), gb = *(const u32x4*)(glb + ro + bj * HALF);
                    f32x4 r0, r1;
#define RT2(R, I, GA, GB) do { f32x2 ea = (f32x2){bf_lo(GA), bf_hi(GA)} * (f32x2){-LOG2E, -LOG2E}, eb = (f32x2){bf_lo(GB), bf_hi(GB)} * (f32x2){-LOG2E, -LOG2E}; \
                        ea[0] = __builtin_amdgcn_exp2f(ea[0]); ea[1] = __builtin_amdgcn_exp2f(ea[1]); eb[0] = __builtin_amdgcn_exp2f(eb[0]); eb[1] = __builtin_amdgcn_exp2f(eb[1]); \
                        ea = ea + (f32x2){1.0f, 1.0f}; eb = eb + (f32x2){1.0f, 1.0f}; ea[0] = __builtin_amdgcn_rcpf(ea[0]); ea[1] = __builtin_amdgcn_rcpf(ea[1]); const f32x2 q_ = eb * ea; R[I] = q_[0]; R[I + 1] = q_[1]; } while (0)
                    RT2(r0, 0, ga.x, gb.x); RT2(r0, 2, ga.y, gb.y); RT2(r1, 0, ga.z, gb.z); RT2(r1, 2, ga.w, gb.w);
#undef RT2
                    acc[ai][bj][m][0] *= r0; acc[ai][bj][m][1] *= r1; } }
    }
    __device__ __forceinline__ void operator()(const f32x4 (&acc)[2][2][4][2], const Unit& u, int wr, int wc, int fr, int fq) const {
        int row0 = u.row0 + wr * 64 + fr, col0 = u.pn * 256 + wc * 32 + 8 * fq; asm volatile("" : "+v"(row0), "+v"(col0));
#pragma unroll
        for (int ai = 0; ai < 2; ++ai)
#pragma unroll
            for (int m = 0; m < 4; ++m) { const size_t ro = (size_t)(row0 + ai * HALF + m * 16) * 1024 + col0;
#pragma unroll
                for (int bj = 0; bj < 2; ++bj) { const u32x4 g = *(const u32x4*)(glb + ro + bj * HALF); const f32x4 v0 = acc[ai][bj][m][0], v1 = acc[ai][bj][m][1];
#define SG2(G, VA, VB) ({ f32x2 e_ = (f32x2){bf_lo(G), bf_hi(G)} * (f32x2){-LOG2E, -LOG2E}; e_[0] = __builtin_amdgcn_exp2f(e_[0]); e_[1] = __builtin_amdgcn_exp2f(e_[1]); e_ = e_ + (f32x2){1.0f, 1.0f}; \
                        e_[0] = __builtin_amdgcn_rcpf(e_[0]); e_[1] = __builtin_amdgcn_rcpf(e_[1]); e_ = e_ * (f32x2){VA, VB}; cvt_pk_bf16(e_[0], e_[1]); })
                    u32x4 w; w.x = SG2(g.x, v0[0], v0[1]); w.y = SG2(g.y, v0[2], v0[3]); w.z = SG2(g.z, v1[0], v1[1]); w.w = SG2(g.w, v1[2], v1[3]);
#undef SG2
                    *(u32x4*)(out + ro + bj * HALF) = w; } }
    }
};
struct EpiOut {
    static constexpr bool PERM = true, HAS_MID = false;
    const float* x; const float* adaf; bf16_t* x1;
    __device__ __forceinline__ void operator()(const f32x4 (&acc)[2][2][4][2], const Unit& u, int wr, int wc, int fr, int fq) const {
        const int row0 = u.row0 + wr * 64 + fr, col0 = u.pn * 256 + wc * 32 + 8 * fq;
        const float* gt = adaf + (u.row0 >= SEQ ? 6144 : 0) + 2048;
        f32x4 gv[2][2];
#pragma unroll
        for (int bj = 0; bj < 2; ++bj)
#pragma unroll
            for (int n = 0; n < 2; ++n) gv[bj][n] = *(const f32x4*)(gt + col0 + bj * HALF + 4 * n);
#pragma unroll
        for (int ai = 0; ai < 2; ++ai)
#pragma unroll
            for (int m = 0; m < 4; ++m) { const size_t ro = (size_t)(row0 + ai * HALF + m * 16) * 1024 + col0;
#pragma unroll
                for (int bj = 0; bj < 2; ++bj) { const f32x4 x0 = *(const f32x4*)(x + ro + bj * HALF), x4 = *(const f32x4*)(x + ro + bj * HALF + 4);
                    const f32x4 v0 = x0 + gv[bj][0] * acc[ai][bj][m][0], v1 = x4 + gv[bj][1] * acc[ai][bj][m][1];
                    u32x4 w; w.x = cvt_pk_bf16(v0[0], v0[1]); w.y = cvt_pk_bf16(v0[2], v0[3]); w.z = cvt_pk_bf16(v1[0], v1[1]); w.w = cvt_pk_bf16(v1[2], v1[3]);
                    *(u32x4*)(x1 + ro + bj * HALF) = w; } }
    }
};
struct EpiGU {
    static constexpr bool PERM = true, HAS_MID = false;
    const float* bgu; bf16_t* act;
    __device__ __forceinline__ void operator()(const f32x4 (&acc)[2][2][4][2], const Unit& u, int wr, int wc, int fr, int fq) const {
        const int row0 = u.row0 + wr * 64 + fr, col0 = u.pn * 128 + wc * 32 + 8 * fq;
        const float* bg = bgu + (size_t)u.e * 2048 + col0;
        f32x4 bgv[2], buv[2];
#pragma unroll
        for (int n = 0; n < 2; ++n) { bgv[n] = *(const f32x4*)(bg + 4 * n); buv[n] = *(const f32x4*)(bg + 1024 + 4 * n); }
#pragma unroll
        for (int ai = 0; ai < 2; ++ai)
#pragma unroll
            for (int m = 0; m < 4; ++m) { float r[8];
#pragma unroll
                for (int n = 0; n < 2; ++n)
#pragma unroll
                    for (int j = 0; j < 4; ++j) { const float gte = fminf(acc[ai][0][m][n][j] + bgv[n][j], 7.0f); const float up = fminf(fmaxf(acc[ai][1][m][n][j] + buv[n][j], -7.0f), 7.0f);
                        r[4 * n + j] = (up + 1.0f) * gte * sigmoidf_fast(1.702f * gte); }
                u32x4 w; w.x = cvt_pk_bf16(r[0], r[1]); w.y = cvt_pk_bf16(r[2], r[3]); w.z = cvt_pk_bf16(r[4], r[5]); w.w = cvt_pk_bf16(r[6], r[7]);
                *(u32x4*)(act + (size_t)(row0 + ai * HALF + m * 16) * 1024 + col0) = w; }
    }
};
struct EpiGUQ {
    static constexpr bool PERM = true, HAS_MID = false;
    const float* bgu; const float* sw; const float* slot_sa; bf16_t* act;
    __device__ __forceinline__ void operator()(const i32x4 (&acc)[2][2][4][2], const Unit& u, int wr, int wc, int fr, int fq) const {
        const int row0 = u.row0 + wr * 64 + fr, col0 = u.pn * 128 + wc * 32 + 8 * fq;
        const float* bg = bgu + (size_t)u.e * 2048 + col0; const float* sg = sw + (size_t)u.e * 2048 + col0;
        f32x4 bgv[2], buv[2], sgv[2], suv[2];
#pragma unroll
        for (int n = 0; n < 2; ++n) { bgv[n] = *(const f32x4*)(bg + 4 * n); buv[n] = *(const f32x4*)(bg + 1024 + 4 * n); sgv[n] = *(const f32x4*)(sg + 4 * n); suv[n] = *(const f32x4*)(sg + 1024 + 4 * n); }
#pragma unroll
        for (int ai = 0; ai < 2; ++ai)
#pragma unroll
            for (int m = 0; m < 4; ++m) { if (ai == 1 && u.half) continue; const int row = row0 + ai * HALF + m * 16; const float ts = slot_sa[row]; unsigned r[4];
#pragma unroll
                for (int n = 0; n < 2; ++n)
#pragma unroll
                    for (int h = 0; h < 2; ++h) { const int j = 2 * h;
                        const f32x2 ag = (f32x2){(float)acc[ai][0][m][n][j], (float)acc[ai][0][m][n][j + 1]}, au = (f32x2){(float)acc[ai][1][m][n][j], (float)acc[ai][1][m][n][j + 1]};
                        const f32x2 tsv = (f32x2){ts, ts};
                        f32x2 g = ag * ((f32x2){sgv[n][j], sgv[n][j + 1]} * tsv) + (f32x2){bgv[n][j], bgv[n][j + 1]};
                        f32x2 up = au * ((f32x2){suv[n][j], suv[n][j + 1]} * tsv) + (f32x2){buv[n][j], buv[n][j + 1]};
                        g[0] = fminf(g[0], 7.0f); g[1] = fminf(g[1], 7.0f); up[0] = fminf(fmaxf(up[0], -7.0f), 7.0f); up[1] = fminf(fmaxf(up[1], -7.0f), 7.0f);
                        f32x2 e = g * (f32x2){-1.702f * LOG2E, -1.702f * LOG2E};
                        e[0] = __builtin_amdgcn_exp2f(e[0]); e[1] = __builtin_amdgcn_exp2f(e[1]);
                        e = e + (f32x2){1.0f, 1.0f};
                        e[0] = __builtin_amdgcn_rcpf(e[0]); e[1] = __builtin_amdgcn_rcpf(e[1]);
                        const f32x2 o = (up + (f32x2){1.0f, 1.0f}) * (g * e);
                        r[2 * n + h] = cvt_pk_bf16(o[0], o[1]); }
                u32x4 w; w.x = r[0]; w.y = r[1]; w.z = r[2]; w.w = r[3];
                *(u32x4*)(act + (size_t)row * 1024 + col0) = w; }
    }
};
struct EpiDown {
    static constexpr bool PERM = true, HAS_MID = false;
    const float* bd; const float* slotw; bf16_t* out;
    __device__ __forceinline__ void operator()(const f32x4 (&acc)[2][2][4][2], const Unit& u, int wr, int wc, int fr, int fq) const {
        const int row0 = u.row0 + wr * 64 + fr, col0 = u.pn * 256 + wc * 32 + 8 * fq;
        const float* bp = bd + (size_t)u.e * 1024 + col0;
        f32x4 bv[2][2];
#pragma unroll
        for (int bj = 0; bj < 2; ++bj)
#pragma unroll
            for (int n = 0; n < 2; ++n) bv[bj][n] = *(const f32x4*)(bp + bj * HALF + 4 * n);
#pragma unroll
        for (int ai = 0; ai < 2; ++ai)
#pragma unroll
            for (int m = 0; m < 4; ++m) { if (ai == 1 && u.half) continue; const int row = row0 + ai * HALF + m * 16; const float w8 = slotw[row]; bf16_t* rowp = out + (size_t)row * 1024 + col0;
#pragma unroll
                for (int bj = 0; bj < 2; ++bj) { const f32x4 v0 = (acc[ai][bj][m][0] + bv[bj][0]) * w8, v1 = (acc[ai][bj][m][1] + bv[bj][1]) * w8;
                    u32x4 w; w.x = cvt_pk_bf16(v0[0], v0[1]); w.y = cvt_pk_bf16(v0[2], v0[3]); w.z = cvt_pk_bf16(v1[0], v1[1]); w.w = cvt_pk_bf16(v1[2], v1[3]);
                    *(u32x4*)(rowp + bj * HALF) = w; } }
    }
};
template <bool GATHER, bool WAIT, bool SIGNAL, bool SPLIT = false> struct MoeSched {
    static constexpr bool HAS_READY = WAIT, HAS_DONE = SIGNAL;
    const LAS int* te; int NP, G, c; const int* slot_tok; const char* W; size_t wstride, btile; unsigned* tdone; unsigned* tmo;
    __device__ __forceinline__ bool next(int i, Unit& u) const {
        const int ntl = te[32], nwg = ntl * NP;
        const int rounds = (nwg + G - 1) / G, rem = nwg - (rounds - 1) * G; const bool split = SPLIT && 2 * rem <= G;
        long L = (long)i * G + c; int half = 0, hsel = 0;
        if (split && i == rounds - 1) { if (c >= 2 * rem) return false; L = (long)i * G + (c >> 1); half = 1; hsel = c & 1; }
        if (L >= nwg) return false;
        int wgid = (int)L; { const int q = nwg / NXCD, r = nwg % NXCD, xcd = wgid % NXCD, off = wgid / NXCD; wgid = (xcd < r ? xcd * (q + 1) : r * (q + 1) + (xcd - r) * q) + off; }
        int e = 0;
        for (int k = 1; k < NE; ++k) e += (wgid >= te[k] * NP) ? 1 : 0;
        const int t0 = te[e], nte = te[e + 1] - t0, r_ = wgid - t0 * NP; const int pn = r_ / nte, t = t0 + r_ % nte;
        u.row0 = t * 256 + hsel * 128; u.pn = pn; u.pm = t; u.e = e; u.half = half; u.bptr = W + (size_t)e * wstride + (size_t)pn * btile; return true;
    }
    __device__ __forceinline__ int arow(const Unit& u, int r) const { if (u.half) r &= 127; if constexpr (GATHER) return slot_tok[u.row0 + r]; else return u.row0 + r; }
    __device__ __forceinline__ void a_ready(const Unit& u) const {
        if constexpr (WAIT) {
            if (threadIdx.x < 64) {
                const unsigned long long t0 = __builtin_amdgcn_s_memrealtime(); unsigned polls = 0;
                while ((unsigned)__builtin_amdgcn_readfirstlane(__hip_atomic_load(tdone + 64 * u.pm, __ATOMIC_RELAXED, __HIP_MEMORY_SCOPE_AGENT)) < 64u) {
                    if ((++polls & 255u) == 0u && __builtin_amdgcn_readfirstlane(__hip_atomic_load(tmo, __ATOMIC_RELAXED, __HIP_MEMORY_SCOPE_AGENT)) != 0u) break;
                    if (__builtin_amdgcn_s_memrealtime() - t0 > 2000000ull) { if (threadIdx.x == 0) __hip_atomic_store(tmo, 1u, __ATOMIC_RELAXED, __HIP_MEMORY_SCOPE_AGENT); break; }
                    __builtin_amdgcn_s_sleep(2); }
                __builtin_amdgcn_fence(__ATOMIC_ACQUIRE, "agent");
                asm volatile("s_waitcnt vmcnt(0)" ::: "memory");
            }
            asm volatile("" ::: "memory"); __builtin_amdgcn_s_barrier(); asm volatile("" ::: "memory");
        }
    }
    __device__ __forceinline__ void done(int pm) const {
        if constexpr (SIGNAL) {
            if ((threadIdx.x & 63) == 0) __hip_atomic_fetch_add(tdone + 64 * pm, 1u, __ATOMIC_RELAXED, __HIP_MEMORY_SCOPE_AGENT); }
    }
};
}

constexpr int BT_STR = 132;
constexpr int AT_BT = LDSCTL_OFF + 1024, AT_K = 0, AT_V = AT_K + 64 * 72 * 2, AT_MISC = LDSCTL_OFF + 8192;
typedef short v4i16_t __attribute__((ext_vector_type(4)));
__device__ __forceinline__ s16x4 tr16(const LAS unsigned char* p) { return __builtin_bit_cast(s16x4, __builtin_amdgcn_ds_read_tr16_b64_v4i16((LAS v4i16_t*)p)); }

template <int NDT>
__device__ __forceinline__ void attn_tile(const LAS unsigned char* lds, int lane, const bf16x8 (&qf)[2], f32x4 (&o)[NDT], float& m_run, float& l_run,
                                          int qpos, int kbase, bool causal, const LAS float* bt) {
    constexpr int VSTR = NDT * 16 + 8;
    const int c = lane & 15, g = lane >> 4;
    f32x4 s[4];
#pragma unroll
    for (int kt = 0; kt < 4; ++kt) { s[kt] = (f32x4){0.f, 0.f, 0.f, 0.f};
#pragma unroll
        for (int ks = 0; ks < 2; ++ks) { const bf16x8 a = *(const LAS bf16x8*)(lds + AT_K + ((16 * kt + c) * 72 + 32 * ks + 8 * g) * 2);
            s[kt] = __builtin_amdgcn_mfma_f32_16x16x32_bf16(a, qf[ks], s[kt], 0, 0, 0); } }
    if (__any((qpos - (kbase + 63)) < 128)) {
#pragma unroll
        for (int kt = 0; kt < 4; ++kt)
#pragma unroll
            for (int i = 0; i < 4; ++i) { const int dist = qpos - (kbase + 16 * kt + 4 * g + i); const int di = dist < 0 ? 0 : (dist > 127 ? 127 : dist);
                const float bv = bt[di]; float v = s[kt][i];
                if (dist >= 0 && dist < 128) v += bv;
                if (causal && dist < 0) v = -INFINITY;
                s[kt][i] = v; }
    }
    float mx = fmaxf(fmaxf(s[0][0], s[0][1]), fmaxf(s[0][2], s[0][3]));
#pragma unroll
    for (int kt = 1; kt < 4; ++kt) mx = fmaxf(mx, fmaxf(fmaxf(s[kt][0], s[kt][1]), fmaxf(s[kt][2], s[kt][3])));
    mx = fmaxf(mx, __shfl_xor(mx, 16)); mx = fmaxf(mx, __shfl_xor(mx, 32));
    const float m_new = fmaxf(m_run, mx), alpha = __builtin_amdgcn_exp2f(m_run - m_new);
    float psum = 0.f;
#pragma unroll
    for (int kt = 0; kt < 4; ++kt)
#pragma unroll
        for (int i = 0; i < 4; ++i) { const float p = __builtin_amdgcn_exp2f(s[kt][i] - m_new); s[kt][i] = p; psum += p; }
    l_run = l_run * alpha + psum; m_run = m_new;
#pragma unroll
    for (int i = 0; i < 4; ++i) { const float ai = __shfl(alpha, 4 * g + i);
#pragma unroll
        for (int dt = 0; dt < NDT; ++dt) o[dt][i] *= ai; }
    bf16x8 pa[2];
#pragma unroll
    for (int kk = 0; kk < 2; ++kk) { u32x4 w; w.x = cvt_pk_bf16(s[2 * kk][0], s[2 * kk][1]); w.y = cvt_pk_bf16(s[2 * kk][2], s[2 * kk][3]);
        w.z = cvt_pk_bf16(s[2 * kk + 1][0], s[2 * kk + 1][1]); w.w = cvt_pk_bf16(s[2 * kk + 1][2], s[2 * kk + 1][3]); pa[kk] = __builtin_bit_cast(bf16x8, w); }
    const LAS unsigned char* vb = lds + AT_V + ((4 * g + (c >> 2)) * VSTR + 4 * (c & 3)) * 2;
#pragma unroll
    for (int dt = 0; dt < NDT; ++dt)
#pragma unroll
        for (int kk = 0; kk < 2; ++kk) { const s16x4 lo = tr16(vb + (32 * kk * VSTR + 16 * dt) * 2), hi = tr16(vb + ((32 * kk + 16) * VSTR + 16 * dt) * 2);
            const bf16x8 b = (bf16x8){lo[0], lo[1], lo[2], lo[3], hi[0], hi[1], hi[2], hi[3]};
            o[dt] = __builtin_amdgcn_mfma_f32_16x16x32_bf16(pa[kk], b, o[dt], 0, 0, 0); }
}

template <int NV> struct TileRegs { u32x4 k; u32x4 v[NV]; };
template <int NV> __device__ __forceinline__ void tile_fetch(TileRegs<NV>& r, const bf16_t* kg, const bf16_t* vg, int tid) {
    const int row = tid >> 3, ch = tid & 7;
    r.k = *(const u32x4*)(kg + (size_t)row * 1024 + ch * 8);
#pragma unroll
    for (int i = 0; i < NV; ++i) r.v[i] = *(const u32x4*)(vg + (size_t)row * 1024 + (ch + 8 * i) * 8);
}
template <int NV> __device__ __forceinline__ void tile_store(const TileRegs<NV>& r, LAS unsigned char* lds, int tid) {
    constexpr int VSTR = NV * 64 + 8;
    const int row = tid >> 3, ch = tid & 7;
    *(LAS u32x4*)(lds + AT_K + (row * 72 + ch * 8) * 2) = r.k;
#pragma unroll
    for (int i = 0; i < NV; ++i) *(LAS u32x4*)(lds + AT_V + (row * VSTR + (ch + 8 * i) * 8) * 2) = r.v[i];
}
#include <hip/hip_bf16.h>
#include <cmath>
namespace attn_body {
using bf16=__hip_bfloat16;
using bf16x8=__attribute__((ext_vector_type(8)))short;
using s16x4=__attribute__((ext_vector_type(4)))short;
using f32x16=__attribute__((ext_vector_type(16)))float;
using u32x4=__attribute__((ext_vector_type(4)))unsigned;
constexpr int BATCH=2,NHEAD=16,SEQ=8192,D=64,DM=NHEAD*D;
constexpr int NW=8,QBLK=32,QB=QBLK*NW,KVBLK=64,NQB=SEQ/QB;
constexpr int ATTN_PITCH=DM, ATTN_UNIT_ROWS=QB;
__device__ __forceinline__ int crow(int r,int hi){return (r&3)+8*(r>>2)+4*hi;}
#define SBAR() __builtin_amdgcn_sched_barrier(0)
typedef const __attribute__((address_space(3))) float* lds_cfptr;
__device__ __forceinline__ void cbias(f32x16&p0,f32x16&p1,int jb,int qrel,int hi,lds_cfptr bt){
  const float NEG=-INFINITY; const int kb=64*jb+4*hi;
  #pragma unroll
  for(int r=0;r<16;++r){const int d0=qrel-(kb+(r&3)+8*(r>>2)),d1=d0-32;
    const unsigned c0=(unsigned)d0<128u?(unsigned)d0:128u,c1=(unsigned)d1<128u?(unsigned)d1:128u;
    const float v0=p0[r]+bt[c0],v1=p1[r]+bt[c1];
    p0[r]=d0<0?NEG:v0; p1[r]=d1<0?NEG:v1;}
}
constexpr int NSLOT=3, SLOTB=8192;
constexpr int LDS_K=0, LDS_V=NSLOT*SLOTB, LDS_WS=2*NSLOT*SLOTB, LDS_OST=LDS_WS+NW*64*4, LDS_BYTES=LDS_OST+NW*4096;
constexpr float C2=0.125f*1.4426950408889634f;
__device__ __forceinline__ void glds16(const void*gsrc,unsigned lds_dst){unsigned keep;
  asm volatile("s_mov_b32 %0, m0\n\ts_mov_b32 m0, %2\n\ts_nop 0\n\tglobal_load_lds_dwordx4 %1, off\n\ts_mov_b32 m0, %0":"=&s"(keep):"v"(gsrc),"s"(lds_dst):"memory");}
__device__ __forceinline__ float max3f(float a,float b,float c){float r;asm("v_max3_f32 %0, %1, %2, %3":"=v"(r):"v"(a),"v"(b),"v"(c));return r;}
__device__ __forceinline__ float max2f(float a,float b){float r;asm("v_max_f32_e32 %0, %1, %2":"=v"(r):"v"(a),"v"(b));return r;}
__device__ __forceinline__ float fadd_s(float a,float b){float r;asm("v_add_f32_e32 %0, %1, %2":"=v"(r):"v"(a),"v"(b));return r;}
__device__ __forceinline__ float fsub_s(float a,float b){float r;asm("v_sub_f32_e32 %0, %1, %2":"=v"(r):"v"(a),"v"(b));return r;}
typedef float f32x2_t __attribute__((ext_vector_type(2))); typedef __bf16 bf16x2_t __attribute__((ext_vector_type(2)));
__device__ __forceinline__ unsigned cvtpk_s(float lo,float hi){f32x2_t v={lo,hi};bf16x2_t b=__builtin_convertvector(v,bf16x2_t);return __builtin_bit_cast(unsigned,b);}
#define WAIT_BAR(N) asm volatile("s_waitcnt vmcnt(" #N ") lgkmcnt(0)\n\ts_barrier":::"memory")

__device__ __forceinline__ void qkt(f32x16&p0,f32x16&p1,const char*Kslot,const bf16x8*qr,const f32x16&negm,int r32,int hi){
  const char*kb=Kslot+hi*1024+r32*16;
  #pragma unroll
  for(int d0=0;d0<4;++d0){
    const bf16x8 b0=*reinterpret_cast<const bf16x8*>(kb+d0*2048);
    const bf16x8 b1=*reinterpret_cast<const bf16x8*>(kb+d0*2048+512);
    if(d0==0){p0=__builtin_amdgcn_mfma_f32_32x32x16_bf16(b0,qr[0],negm,0,0,0);p1=__builtin_amdgcn_mfma_f32_32x32x16_bf16(b1,qr[0],negm,0,0,0);}
    else{p0=__builtin_amdgcn_mfma_f32_32x32x16_bf16(b0,qr[d0],p0,0,0,0);p1=__builtin_amdgcn_mfma_f32_32x32x16_bf16(b1,qr[d0],p1,0,0,0);}}
}
typedef __attribute__((address_space(3))) const char* lds_cptr;
typedef short v4i16_t __attribute__((ext_vector_type(4)));
__device__ __forceinline__ void kload8(bf16x8*kf,lds_cptr kp){
  kf[0]=*(const __attribute__((address_space(3))) bf16x8*)(kp);      kf[1]=*(const __attribute__((address_space(3))) bf16x8*)(kp+512);
  kf[2]=*(const __attribute__((address_space(3))) bf16x8*)(kp+2048); kf[3]=*(const __attribute__((address_space(3))) bf16x8*)(kp+2560);
  kf[4]=*(const __attribute__((address_space(3))) bf16x8*)(kp+4096); kf[5]=*(const __attribute__((address_space(3))) bf16x8*)(kp+4608);
  kf[6]=*(const __attribute__((address_space(3))) bf16x8*)(kp+6144); kf[7]=*(const __attribute__((address_space(3))) bf16x8*)(kp+6656);
}
__device__ __forceinline__ void kload2(bf16x8*kf,lds_cptr kp,int j){ kf[2*j]=*(const __attribute__((address_space(3))) bf16x8*)(kp+j*2048); kf[2*j+1]=*(const __attribute__((address_space(3))) bf16x8*)(kp+j*2048+512); }
__device__ __forceinline__ s16x4 vtr(lds_cptr p){ return __builtin_bit_cast(s16x4,__builtin_amdgcn_ds_read_tr16_b64_v4i16((__attribute__((address_space(3))) v4i16_t*)p)); }
__device__ __forceinline__ float rowmax(const f32x16&p0,const f32x16&p1){
  float a=max3f(p0[0],p0[1],p1[0]),b=max3f(p0[2],p0[3],p1[1]);a=max3f(a,p1[2],p1[3]);
  #pragma unroll
  for(int r=4;r<16;r+=4){a=max3f(a,p0[r],p0[r+1]);b=max3f(b,p0[r+2],p0[r+3]);a=max3f(a,p1[r],p1[r+1]);b=max3f(b,p1[r+2],p1[r+3]);}
  const float m=max2f(a,b);
  auto rr=__builtin_amdgcn_permlane32_swap(__float_as_uint(m),__float_as_uint(m),false,false);
  return max2f(__uint_as_float(rr[0]),__uint_as_float(rr[1]));
}
__device__ __forceinline__ void pv(f32x16*o,int vb,bf16x8 pa0,bf16x8 pa1,bf16x8 pa2,bf16x8 pa3){
  #pragma unroll
  for(int d0=0;d0<2;++d0){s16x4 lo[4],hi[4];
    #pragma unroll
    for(int ks=0;ks<4;++ks){
      asm volatile("ds_read_b64_tr_b16 %0,%1 offset:%c2":"=&v"(lo[ks]):"v"(vb),"i"(d0*4096+ks*1024):"memory");
      asm volatile("ds_read_b64_tr_b16 %0,%1 offset:%c2":"=&v"(hi[ks]):"v"(vb),"i"(d0*4096+ks*1024+512):"memory");}
    asm volatile("s_waitcnt lgkmcnt(0)":::"memory");SBAR();
    #define PK(k) (bf16x8){lo[k][0],lo[k][1],lo[k][2],lo[k][3],hi[k][0],hi[k][1],hi[k][2],hi[k][3]}
    o[d0]=__builtin_amdgcn_mfma_f32_32x32x16_bf16(pa0,PK(0),o[d0],0,0,0);
    o[d0]=__builtin_amdgcn_mfma_f32_32x32x16_bf16(pa1,PK(1),o[d0],0,0,0);
    o[d0]=__builtin_amdgcn_mfma_f32_32x32x16_bf16(pa2,PK(2),o[d0],0,0,0);
    o[d0]=__builtin_amdgcn_mfma_f32_32x32x16_bf16(pa3,PK(3),o[d0],0,0,0);
    #undef PK
  }
}

#ifndef ATTN_STORE16
#define ATTN_STORE16(p,v) (*(u32x4*)(p)=(v))
#endif
template<int THRL> __device__ __forceinline__ void attn_unit(int b,int qb,const bf16*Q,const bf16*__restrict__ K,const bf16*__restrict__ V,bf16*O,int qc,int kc,int vc,int oc,lds_cfptr bt,char*shm){
  int tid_=threadIdx.x; asm volatile("":"+v"(tid_)); const int tid=tid_,lane=tid&63,r32=lane&31,hi=lane>>5; const int wid=__builtin_amdgcn_readfirstlane(tid>>6);
  const long rowbase=(long)b*SEQ; const int q0=qb*QB;
  const bf16*Qw=Q+(rowbase+q0+wid*QBLK)*DM+qc;
  const bf16*Kh=K+rowbase*DM+kc,*Vh=V+rowbase*DM+vc;
  const unsigned lds0=(unsigned)(uintptr_t)shm;
  float*wsf=(float*)(shm+LDS_WS)+wid*64;
  const bf16*ksrc=Kh+(long)lane*DM+wid*8;
  const bf16*vsrc=Vh+(long)(16*(wid&3)+(lane>>2))*DM+(wid>>2)*32+(lane&3)*8;
  const unsigned kdst=lds0+LDS_K+wid*1024, vdst=lds0+LDS_V+wid*1024;
  #define DMA_K(t,slot) glds16(ksrc+(long)(t)*KVBLK*DM,(unsigned)__builtin_amdgcn_readfirstlane(kdst+(slot)))
  #define DMA_V(t,slot) glds16(vsrc+(long)(t)*KVBLK*DM,(unsigned)__builtin_amdgcn_readfirstlane(vdst+(slot)))
  const int vb0=(int)(lds0+LDS_V)+((lane>>4)&1)*32+(lane&3)*8+(4*hi+((lane&15)>>2))*64;
  const char*Kbase=shm+LDS_K; bf16x8 kf[8];
  const lds_cptr shm3=(lds_cptr)shm; const lds_cptr kp0=shm3+LDS_K+hi*1024+r32*16; const lds_cptr vp0=shm3+LDS_V+((lane>>4)&1)*32+(lane&3)*8+(4*hi+((lane&15)>>2))*64;
  const int NT=(q0+QB)/KVBLK;
  DMA_K(0,0);DMA_V(0,0);DMA_K(1,SLOTB);
  bf16x8 qr[4];
  #pragma unroll
  for(int d0=0;d0<4;++d0)qr[d0]=*reinterpret_cast<const bf16x8*>(&Qw[(long)r32*DM+d0*16+hi*8]);
  float mhat=0.f,l_reg=0.f;f32x16 o[2],negm; { float z_=0.f; asm volatile("":"+v"(z_));
    _Pragma("unroll") for(int r=0;r<16;++r){o[0][r]=z_;o[1][r]=z_;negm[r]=z_;} } asm volatile("":"+v"(negm));
  const int qrel=wid*QBLK+r32;
  #define CMASK(P0,P1,t) do{int jb_=(t)-(NT-4); if(jb_>=-2 && (wid*QBLK-(64*jb_+63))<128)cbias(P0,P1,jb_,qrel,hi,bt);}while(0)
  bool resc=false;
  #define START(P0,P1) do{ const float rm=rowmax(P0,P1); resc=false; \
    { const float dl=rm; mhat=fadd_s(mhat,dl); \
      _Pragma("unroll") for(int r=0;r<16;++r){P0[r]=fsub_s(P0[r],dl);P1[r]=fsub_s(P1[r],dl);} \
      _Pragma("unroll") for(int r=0;r<16;++r)negm[r]=-mhat; asm volatile("":"+v"(negm)); } \
    _Pragma("unroll") for(int r=0;r<16;++r)P0[r]=__builtin_amdgcn_exp2f(P0[r]); }while(0)
  #define RESC() do{ if(resc){ asm volatile("s_waitcnt lgkmcnt(0)":::"memory"); \
      _Pragma("unroll") for(int d_=0;d_<2;++d_) _Pragma("unroll") for(int r=0;r<16;++r)o[d_][r]*=wsf[crow(r,hi)]; } }while(0)
  f32x16 pA0,pA1,pB0,pB1;
  int sl_prev=0,sl_cur=0,sl_next=SLOTB;
  #define ROT() do{sl_prev=sl_cur;sl_cur=sl_next;sl_next=(sl_next==(NSLOT-1)*SLOTB)?0:sl_next+SLOTB;}while(0)
  DMA_K(2,2*SLOTB);
  WAIT_BAR(3);
  qkt(pA0,pA1,Kbase,qr,negm,r32,hi);asm volatile("s_nop 15\n\ts_nop 7":"+v"(pA0),"+v"(pA1));CMASK(pA0,pA1,0);
  START(pA0,pA1);
  _Pragma("unroll") for(int r=0;r<16;++r)pA1[r]=__builtin_amdgcn_exp2f(pA1[r]);
  WAIT_BAR(0);
  DMA_K(3,0);DMA_V(1,SLOTB);
  ROT();
  kload8(kf,kp0+sl_cur);
  WAIT_BAR(2);
  s16x4 vlo[8],vhi[8]; u32x4 pw0,pw1,pw2,pw3;
  #define PKW(P,B) cvtpk_s(P[B],P[B+1])
  #define PAF(k) __builtin_bit_cast(bf16x8,pw##k)
  #define VFR(i) (bf16x8){vlo[i][0],vlo[i][1],vlo[i][2],vlo[i][3],vhi[i][0],vhi[i][1],vhi[i][2],vhi[i][3]}
  #define PIN(x) asm volatile("":"+v"(x))
  #define MX3(a,b,c) __builtin_fmaxf(__builtin_fmaxf((a),(b)),(c))
  #define GAPA(MF,A0,A1,A2,A3,W0,W1,PW) do{ MF; sacc+=A0; sacc+=A1; sacc+=A2; sacc+=A3; PIN(sacc); W0; W1; PIN(PW); SBAR(); }while(0)
  #define EX(v) __builtin_amdgcn_exp2f(v)
  #define GAPB(MF,X,B) do{ MF; X[B]=EX(X[B]); X[B+1]=EX(X[B+1]); X[B+2]=EX(X[B+2]); X[B+3]=EX(X[B+3]); PIN(X); SBAR(); }while(0)
  #define VRD(i) do{ vlo[i]=vtr(vp_+(((i)>>2)*4096+((i)&3)*1024)); vhi[i]=vtr(vp_+(((i)>>2)*4096+((i)&3)*1024+512)); }while(0)
  #define KRD(G,j) do{ if(G){ kload2(kf,kp0+sl_next,j); SBAR(); } }while(0)
  #define STEP(C0,C1,P0,P1,t,GK,GV,GL) do{ SBAR(); \
    const lds_cptr vp_=vp0+sl_prev; \
    VRD(0); SBAR(); float sacc=(P0[0]+P0[1]); \
    GAPA(C0=__builtin_amdgcn_mfma_f32_32x32x16_bf16(kf[0],qr[0],negm,0,0,0), P0[2],P0[3],P0[4],P0[5],     pw0[0]=PKW(P0,0), pw0[1]=PKW(P0,2), pw0); \
    VRD(4); SBAR(); GAPA(C1=__builtin_amdgcn_mfma_f32_32x32x16_bf16(kf[1],qr[0],negm,0,0,0), P0[6],P0[7],P0[8],P0[9],     pw0[2]=PKW(P0,4), pw0[3]=PKW(P0,6), pw0); \
    VRD(1); SBAR(); GAPA(C0=__builtin_amdgcn_mfma_f32_32x32x16_bf16(kf[2],qr[1],C0,0,0,0),   P0[10],P0[11],P0[12],P0[13], pw1[0]=PKW(P0,8), pw1[1]=PKW(P0,10), pw1); \
    VRD(5); SBAR(); GAPA(C1=__builtin_amdgcn_mfma_f32_32x32x16_bf16(kf[3],qr[1],C1,0,0,0),   P0[14],P0[15],P1[0],P1[1],   pw1[2]=PKW(P0,12),pw1[3]=PKW(P0,14), pw1); \
    VRD(2); SBAR(); GAPA(C0=__builtin_amdgcn_mfma_f32_32x32x16_bf16(kf[4],qr[2],C0,0,0,0),   P1[2],P1[3],P1[4],P1[5],     pw2[0]=PKW(P1,0), pw2[1]=PKW(P1,2), pw2); \
    VRD(6); SBAR(); GAPA(C1=__builtin_amdgcn_mfma_f32_32x32x16_bf16(kf[5],qr[2],C1,0,0,0),   P1[6],P1[7],P1[8],P1[9],     pw2[2]=PKW(P1,4), pw2[3]=PKW(P1,6), pw2); \
    VRD(3); SBAR(); GAPA(C0=__builtin_amdgcn_mfma_f32_32x32x16_bf16(kf[6],qr[3],C0,0,0,0),   P1[10],P1[11],P1[12],P1[13], pw3[0]=PKW(P1,8), pw3[1]=PKW(P1,10), pw3); \
    VRD(7); SBAR(); GAPA(C1=__builtin_amdgcn_mfma_f32_32x32x16_bf16(kf[7],qr[3],C1,0,0,0),   P1[14],P1[15],0.f,0.f,       pw3[2]=PKW(P1,12),pw3[3]=PKW(P1,14), pw3); \
    l_reg+=sacc; \
    if(GK){DMA_K((t)+3,sl_cur);} if(GV){DMA_V((t)+1,sl_next);} \
    CMASK(C0,C1,t); \
    { float a=MX3(C0[0],C0[1],C1[0]),b=MX3(C0[2],C0[3],C1[1]); a=MX3(a,C1[2],C1[3]); \
      _Pragma("unroll") for(int r=4;r<16;r+=4){a=MX3(a,C0[r],C0[r+1]);b=MX3(b,C0[r+2],C0[r+3]);a=MX3(a,C1[r],C1[r+1]);b=MX3(b,C1[r+2],C1[r+3]);} \
      float rm=__builtin_fmaxf(a,b); { auto rr=__builtin_amdgcn_permlane32_swap(__float_as_uint(rm),__float_as_uint(rm),false,false); rm=__builtin_fmaxf(__uint_as_float(rr[0]),__uint_as_float(rr[1])); } \
      resc=false; \
      if(__builtin_expect(__any(rm>(float)THRL),0)){ const float dl=__builtin_fmaxf(rm,0.f); mhat+=dl; \
        _Pragma("unroll") for(int r=0;r<16;++r){C0[r]-=dl;C1[r]-=dl;} \
        _Pragma("unroll") for(int r=0;r<16;++r)negm[r]=-mhat; asm volatile("":"+v"(negm)); \
        const float f=__builtin_amdgcn_exp2f(-dl); l_reg*=f; if(hi==0)wsf[r32]=f; resc=true; } } \
    SBAR(); \
    GAPB(o[0]=__builtin_amdgcn_mfma_f32_32x32x16_bf16(PAF(0),VFR(0),o[0],0,0,0), C0,0); \
    GAPB(o[1]=__builtin_amdgcn_mfma_f32_32x32x16_bf16(PAF(0),VFR(4),o[1],0,0,0), C0,4); \
    KRD(GL,0); GAPB(o[0]=__builtin_amdgcn_mfma_f32_32x32x16_bf16(PAF(1),VFR(1),o[0],0,0,0), C0,8); \
    KRD(GL,1); GAPB(o[1]=__builtin_amdgcn_mfma_f32_32x32x16_bf16(PAF(1),VFR(5),o[1],0,0,0), C0,12); \
    KRD(GL,2); GAPB(o[0]=__builtin_amdgcn_mfma_f32_32x32x16_bf16(PAF(2),VFR(2),o[0],0,0,0), C1,0); \
    KRD(GL,3); GAPB(o[1]=__builtin_amdgcn_mfma_f32_32x32x16_bf16(PAF(2),VFR(6),o[1],0,0,0), C1,4); \
    GAPB(o[0]=__builtin_amdgcn_mfma_f32_32x32x16_bf16(PAF(3),VFR(3),o[0],0,0,0), C1,8); \
    GAPB(o[1]=__builtin_amdgcn_mfma_f32_32x32x16_bf16(PAF(3),VFR(7),o[1],0,0,0), C1,12); \
    }while(0)
  int t=1;
  #undef CMASK
  #define CMASK(P0,P1,t) do{}while(0)
  for(;t+7<NT;t+=2){
    STEP(pB0,pB1,pA0,pA1,t,true,true,true);     WAIT_BAR(2); RESC(); ROT();
    STEP(pA0,pA1,pB0,pB1,t+1,true,true,true);   WAIT_BAR(2); RESC(); ROT();
  }
  #undef CMASK
  #define CMASK(P0,P1,t) do{int jb_=(t)-(NT-4); if(jb_>=-2 && (wid*QBLK-(64*jb_+63))<128)cbias(P0,P1,jb_,qrel,hi,bt);}while(0)
  #define ENDW(tt) do{ if((tt)+3<NT){WAIT_BAR(2);} else if((tt)+2<NT){WAIT_BAR(1);} else {WAIT_BAR(0);} }while(0)
  for(;t+1<NT;t+=2){
    STEP(pB0,pB1,pA0,pA1,t,(t+3<NT),(t+1<NT),(t+1<NT));       ENDW(t);   RESC(); ROT();
    STEP(pA0,pA1,pB0,pB1,t+1,(t+4<NT),(t+2<NT),(t+2<NT));     ENDW(t+1); RESC(); ROT();
  }
  STEP(pB0,pB1,pA0,pA1,NT-1,false,false,false); RESC();
  { float sacc=pB0[0]+pB0[1]; _Pragma("unroll") for(int r=2;r<16;++r)sacc+=pB0[r]; _Pragma("unroll") for(int r=0;r<16;++r)sacc+=pB1[r]; l_reg+=sacc;
    pw0=(u32x4){PKW(pB0,0),PKW(pB0,2),PKW(pB0,4),PKW(pB0,6)};pw1=(u32x4){PKW(pB0,8),PKW(pB0,10),PKW(pB0,12),PKW(pB0,14)};pw2=(u32x4){PKW(pB1,0),PKW(pB1,2),PKW(pB1,4),PKW(pB1,6)};pw3=(u32x4){PKW(pB1,8),PKW(pB1,10),PKW(pB1,12),PKW(pB1,14)};
    SBAR(); pv(o,vb0+sl_cur,PAF(0),PAF(1),PAF(2),PAF(3)); }
  #undef PKW
  #undef PAF
  #undef VFR
  #undef PIN
  #undef MX3
  #undef GAPA
  #undef GAPB
  #undef EX
  #undef VRD
  #undef KRD
  #undef STEP
  #undef ENDW
  {auto rr=__builtin_amdgcn_permlane32_swap(__float_as_uint(l_reg),__float_as_uint(l_reg),false,false);l_reg=__uint_as_float(rr[0])+__uint_as_float(rr[1]);}
  if(hi==0)wsf[32+r32]=l_reg;asm volatile("s_waitcnt lgkmcnt(0)":::"memory");
  float rli[16];
  #pragma unroll
  for(int r=0;r<16;++r)rli[r]=__builtin_amdgcn_rcpf(wsf[32+crow(r,hi)]);
  bf16*Ow=O+(rowbase+q0+wid*QBLK)*DM+oc;
  { bf16*stg=(bf16*)(shm+LDS_OST)+wid*2048;
    #pragma unroll
    for(int r=0;r<16;++r){const int orow=crow(r,hi);
      #pragma unroll
      for(int d0=0;d0<2;++d0)stg[orow*64+d0*32+r32]=__float2bfloat16(o[d0][r]*rli[r]);}
    asm volatile("s_waitcnt lgkmcnt(0)":::"memory");
    #pragma unroll
    for(int i=0;i<4;++i){const int row=i*8+(lane>>3),ch=lane&7; const u32x4 v=*(const u32x4*)(stg+row*64+ch*8); ATTN_STORE16(Ow+(long)row*DM+ch*8,v);} }
  asm volatile("s_waitcnt lgkmcnt(0)\n\ts_barrier":::"memory");
  #undef DMA_K
  #undef DMA_V
  #undef CMASK
  #undef START
  #undef RESC
  #undef ROT
}
constexpr int ATTN_LDS_BYTES=LDS_BYTES;
#undef SBAR
#undef WAIT_BAR
}
#include <hip/hip_bf16.h>
#include <cmath>
#ifndef ATTN_QLDS
#define ATTN_QLDS 1
#endif
namespace attn_nat {
using bf16=__hip_bfloat16;
using bf16x8=__attribute__((ext_vector_type(8)))short;
using s16x4=__attribute__((ext_vector_type(4)))short;
using f32x16=__attribute__((ext_vector_type(16)))float;
using u32x4=__attribute__((ext_vector_type(4)))unsigned;
constexpr int BATCH=2,NHEAD=16,SEQ=8192,D=64,DM=NHEAD*D;
constexpr int NW=8,QBLK=32,QB=QBLK*NW,KVBLK=64,NQB=SEQ/QB;
constexpr int ATTN_PITCH=DM, ATTN_UNIT_ROWS=QB;
__device__ __forceinline__ int crow(int r,int hi){return (r&3)+8*(r>>2)+4*hi;}
#define SBAR() __builtin_amdgcn_sched_barrier(0)
typedef const __attribute__((address_space(3))) float* lds_cfptr;
__device__ __forceinline__ void cbias(f32x16&p0,f32x16&p1,int jb,int qrel,int hi,lds_cfptr bt){
  const float NEG=-INFINITY; const int kb=64*jb+4*hi;
  #pragma unroll
  for(int r=0;r<16;++r){const int d0=qrel-(kb+(r&3)+8*(r>>2)),d1=d0-32;
    const unsigned c0=(unsigned)d0<128u?(unsigned)d0:128u,c1=(unsigned)d1<128u?(unsigned)d1:128u;
    const float v0=p0[r]+bt[c0],v1=p1[r]+bt[c1];
    p0[r]=d0<0?NEG:v0; p1[r]=d1<0?NEG:v1;
    if((r&3)==3)__builtin_amdgcn_sched_barrier(0);}
}
constexpr int NSLOT=3, SLOTB=8192;
constexpr int LDS_K=0, LDS_V=NSLOT*SLOTB, LDS_WS=3*NSLOT*SLOTB, LDS_OST=LDS_WS+NW*64*4, LDS_BYTES=LDS_OST+NW*4096;
constexpr float C2=0.125f*1.4426950408889634f;
__device__ __forceinline__ void glds16(const void*sbase,unsigned voff,unsigned lds_dst){unsigned keep;
  asm volatile("s_mov_b32 %0, m0\n\ts_mov_b32 m0, %3\n\ts_nop 0\n\tglobal_load_lds_dwordx4 %1, %2\n\ts_mov_b32 m0, %0":"=&s"(keep):"v"(voff),"s"(sbase),"s"(lds_dst):"memory");}
__device__ __forceinline__ float max3f(float a,float b,float c){float r;asm("v_max3_f32 %0, %1, %2, %3":"=v"(r):"v"(a),"v"(b),"v"(c));return r;}
__device__ __forceinline__ float max2f(float a,float b){float r;asm("v_max_f32_e32 %0, %1, %2":"=v"(r):"v"(a),"v"(b));return r;}
__device__ __forceinline__ float fadd_s(float a,float b){float r;asm("v_add_f32_e32 %0, %1, %2":"=v"(r):"v"(a),"v"(b));return r;}
__device__ __forceinline__ float fsub_s(float a,float b){float r;asm("v_sub_f32_e32 %0, %1, %2":"=v"(r):"v"(a),"v"(b));return r;}
typedef float f32x2_t __attribute__((ext_vector_type(2))); typedef __bf16 bf16x2_t __attribute__((ext_vector_type(2)));
__device__ __forceinline__ unsigned cvtpk_s(float lo,float hi){f32x2_t v={lo,hi};bf16x2_t b=__builtin_convertvector(v,bf16x2_t);return __builtin_bit_cast(unsigned,b);}
#define WAIT_BAR(N) asm volatile("s_waitcnt vmcnt(" #N ") lgkmcnt(0)\n\ts_barrier":::"memory")

__device__ __forceinline__ void qkt(f32x16&p0,f32x16&p1,const char*Kslot,const bf16x8*qr,const f32x16&negm,int r32,int hi){
  const char*kb=Kslot+hi*1024+r32*16;
  #pragma unroll
  for(int d0=0;d0<4;++d0){
    const bf16x8 b0=*reinterpret_cast<const bf16x8*>(kb+d0*2048);
    const bf16x8 b1=*reinterpret_cast<const bf16x8*>(kb+d0*2048+512);
    if(d0==0){p0=__builtin_amdgcn_mfma_f32_32x32x16_bf16(b0,qr[0],negm,0,0,0);p1=__builtin_amdgcn_mfma_f32_32x32x16_bf16(b1,qr[0],negm,0,0,0);}
    else{p0=__builtin_amdgcn_mfma_f32_32x32x16_bf16(b0,qr[d0],p0,0,0,0);p1=__builtin_amdgcn_mfma_f32_32x32x16_bf16(b1,qr[d0],p1,0,0,0);}}
}
typedef __attribute__((address_space(3))) const char* lds_cptr;
typedef short v4i16_t __attribute__((ext_vector_type(4)));
__device__ __forceinline__ void kload8(bf16x8*kf,lds_cptr kp){
  kf[0]=*(const __attribute__((address_space(3))) bf16x8*)(kp);      kf[1]=*(const __attribute__((address_space(3))) bf16x8*)(kp+512);
  kf[2]=*(const __attribute__((address_space(3))) bf16x8*)(kp+2048); kf[3]=*(const __attribute__((address_space(3))) bf16x8*)(kp+2560);
  kf[4]=*(const __attribute__((address_space(3))) bf16x8*)(kp+4096); kf[5]=*(const __attribute__((address_space(3))) bf16x8*)(kp+4608);
  kf[6]=*(const __attribute__((address_space(3))) bf16x8*)(kp+6144); kf[7]=*(const __attribute__((address_space(3))) bf16x8*)(kp+6656);
}
__device__ __forceinline__ void kload2(bf16x8*kf,lds_cptr kp,int j){ kf[2*j]=*(const __attribute__((address_space(3))) bf16x8*)(kp+j*2048); kf[2*j+1]=*(const __attribute__((address_space(3))) bf16x8*)(kp+j*2048+512); }
__device__ __forceinline__ s16x4 vtr(lds_cptr p){ return __builtin_bit_cast(s16x4,__builtin_amdgcn_ds_read_tr16_b64_v4i16((__attribute__((address_space(3))) v4i16_t*)p)); }
__device__ __forceinline__ float rowmax(const f32x16&p0,const f32x16&p1){
  float a=max3f(p0[0],p0[1],p1[0]),b=max3f(p0[2],p0[3],p1[1]);a=max3f(a,p1[2],p1[3]);
  #pragma unroll
  for(int r=4;r<16;r+=4){a=max3f(a,p0[r],p0[r+1]);b=max3f(b,p0[r+2],p0[r+3]);a=max3f(a,p1[r],p1[r+1]);b=max3f(b,p1[r+2],p1[r+3]);}
  const float m=max2f(a,b);
  auto rr=__builtin_amdgcn_permlane32_swap(__float_as_uint(m),__float_as_uint(m),false,false);
  return max2f(__uint_as_float(rr[0]),__uint_as_float(rr[1]));
}
__device__ __forceinline__ void pv(f32x16*o,int vb,bf16x8 pa0,bf16x8 pa1,bf16x8 pa2,bf16x8 pa3){
  #pragma unroll
  for(int d0=0;d0<4;++d0){s16x4 lo[4],hi[4];
    #pragma unroll
    for(int ks=0;ks<4;++ks){
      asm volatile("ds_read_b64_tr_b16 %0,%1 offset:%c2":"=&v"(lo[ks]):"v"(vb),"i"(d0*4096+ks*1024):"memory");
      asm volatile("ds_read_b64_tr_b16 %0,%1 offset:%c2":"=&v"(hi[ks]):"v"(vb),"i"(d0*4096+ks*1024+512):"memory");}
    asm volatile("s_waitcnt lgkmcnt(0)":::"memory");SBAR();
    #define PK(k) (bf16x8){lo[k][0],lo[k][1],lo[k][2],lo[k][3],hi[k][0],hi[k][1],hi[k][2],hi[k][3]}
    o[d0]=__builtin_amdgcn_mfma_f32_32x32x16_bf16(pa0,PK(0),o[d0],0,0,0);
    o[d0]=__builtin_amdgcn_mfma_f32_32x32x16_bf16(pa1,PK(1),o[d0],0,0,0);
    o[d0]=__builtin_amdgcn_mfma_f32_32x32x16_bf16(pa2,PK(2),o[d0],0,0,0);
    o[d0]=__builtin_amdgcn_mfma_f32_32x32x16_bf16(pa3,PK(3),o[d0],0,0,0);
    #undef PK
  }
}

#ifndef ATTN_STORE16
#define ATTN_STORE16(p,v) (*(u32x4*)(p)=(v))
#endif
template<int THRL> __device__ __forceinline__ void attn_unit(int b,int qb,const bf16*Q,const bf16*__restrict__ K,const bf16*__restrict__ V,bf16*O,int qc,int kc,int vc,int oc,lds_cfptr bt,char*shm){
  int tid_=threadIdx.x; asm volatile("":"+v"(tid_)); const int tid=tid_,lane=tid&63,r32=lane&31,hi=lane>>5; const int wid=__builtin_amdgcn_readfirstlane(tid>>6);
  const long rowbase=(long)b*SEQ; const int q0=qb*QB;
  const bf16*Qw=Q+(rowbase+q0+wid*QBLK)*DM+qc;
  const bf16*Kh=K+rowbase*DM+kc,*Vh=V+rowbase*DM+vc;
  const unsigned lds0=(unsigned)(uintptr_t)shm;
  float*wsf=(float*)(shm+LDS_WS)+wid*64;
  const unsigned koff=(unsigned)((lane*DM+wid*8)*2);
  const unsigned voff=(unsigned)(((16*(wid&3)+(lane>>2))*DM+(wid>>2)*32+(lane&3)*8)*2);
  const unsigned kdst=lds0+LDS_K+wid*1024, vdst=lds0+LDS_V+wid*1024;
  #define DMA_K(t,slot) glds16(Kh+(long)(t)*KVBLK*DM,koff,(unsigned)__builtin_amdgcn_readfirstlane(kdst+(slot)))
  #define DMA_V(t,slot) do{ glds16(Vh+(long)(t)*KVBLK*DM,voff,(unsigned)__builtin_amdgcn_readfirstlane(vdst+2*(slot))); glds16(Vh+(long)(t)*KVBLK*DM+64,voff,(unsigned)__builtin_amdgcn_readfirstlane(vdst+2*(slot)+8192)); }while(0)
  const char*Kbase=shm+LDS_K; bf16x8 kf[8];
  const lds_cptr shm3=(lds_cptr)shm; const lds_cptr kp0=shm3+LDS_K+hi*1024+r32*16; const lds_cptr vp0=shm3+LDS_V+((lane>>4)&1)*32+(lane&3)*8+(4*hi+((lane&15)>>2))*64;
  const int NT=(q0+QB)/KVBLK;
  DMA_K(0,0);DMA_V(0,0);DMA_K(1,SLOTB);
  bf16x8 qr[4];
  #pragma unroll
  for(int d0=0;d0<4;++d0)qr[d0]=*reinterpret_cast<const bf16x8*>(&Qw[(long)r32*DM+d0*16+hi*8]);
#if ATTN_QLDS
  const lds_cptr qst=shm3+LDS_OST+wid*4096+r32*128;
  #pragma unroll
  for(int d0=0;d0<4;++d0)*(__attribute__((address_space(3))) bf16x8*)(shm3+LDS_OST+wid*4096+r32*128+(((2*d0+hi)^(r32&7))<<4))=qr[d0];
  #define QF(d) (*(const __attribute__((address_space(3))) bf16x8*)(qst+(((2*(d)+hi)^(r32&7))<<4)))
#else
  #define QF(d) qr[d]
#endif
  float mhat=0.f,l_reg=0.f;f32x16 o[4]; { float z_=0.f; asm volatile("":"+v"(z_));
    _Pragma("unroll") for(int r=0;r<16;++r){o[0][r]=z_;o[1][r]=z_;o[2][r]=z_;o[3][r]=z_;} }
  const int qrel=wid*QBLK+r32;
  #define CMASK(P0,P1,t) do{int jb_=(t)-(NT-4); if(jb_>=-2 && (wid*QBLK-(64*jb_+63))<128)cbias(P0,P1,jb_,qrel,hi,bt);}while(0)
  bool resc=false;
  #define START(P0,P1) do{ const float rm=rowmax(P0,P1); resc=false; \
    { const float dl=rm; mhat=fadd_s(mhat,dl); \
      _Pragma("unroll") for(int r=0;r<16;++r){P0[r]=fsub_s(P0[r],dl);P1[r]=fsub_s(P1[r],dl);} } \
    _Pragma("unroll") for(int r=0;r<16;++r)P0[r]=__builtin_amdgcn_exp2f(P0[r]); }while(0)
  #define RESC() do{ if(resc){ asm volatile("s_waitcnt lgkmcnt(0)":::"memory"); \
      _Pragma("unroll") for(int d_=0;d_<4;++d_) _Pragma("unroll") for(int r=0;r<16;++r)o[d_][r]*=wsf[crow(r,hi)]; } }while(0)
  f32x16 pA0,pA1,pB0,pB1;
  int sl_prev=0,sl_cur=0,sl_next=SLOTB;
  #define ROT() do{sl_prev=sl_cur;sl_cur=sl_next;sl_next=(sl_next==(NSLOT-1)*SLOTB)?0:sl_next+SLOTB;}while(0)
  DMA_K(2,2*SLOTB);
  WAIT_BAR(4);
  qkt(pA0,pA1,Kbase,qr,f32x16{},r32,hi);asm volatile("s_nop 15\n\ts_nop 7":"+v"(pA0),"+v"(pA1));CMASK(pA0,pA1,0);
  START(pA0,pA1);
  _Pragma("unroll") for(int r=0;r<16;++r)pA1[r]=__builtin_amdgcn_exp2f(pA1[r]);
  WAIT_BAR(0);
  DMA_K(3,0);DMA_V(1,SLOTB);
  ROT();
  kload8(kf,kp0+sl_cur);
  WAIT_BAR(3);
  s16x4 vlo[8],vhi[8]; u32x4 pw0,pw1,pw2,pw3;
  #define PKW(P,B) cvtpk_s(P[B],P[B+1])
  #define PAF(k) __builtin_bit_cast(bf16x8,pw##k)
  #define VFR(i) (bf16x8){vlo[i][0],vlo[i][1],vlo[i][2],vlo[i][3],vhi[i][0],vhi[i][1],vhi[i][2],vhi[i][3]}
  #define PIN(x) asm volatile("":"+v"(x))
  #define MX3(a,b,c) __builtin_fmaxf(__builtin_fmaxf((a),(b)),(c))
  #define GAPA(MF,A0,A1,A2,A3,W0,W1,PW) do{ MF; sacc+=A0; sacc+=A1; sacc+=A2; sacc+=A3; PIN(sacc); W0; W1; PIN(PW); SBAR(); }while(0)
  #define EX(v) __builtin_amdgcn_exp2f(v)
  #define GAPB(MF,X,B) do{ MF; X[B]=EX(X[B]); X[B+1]=EX(X[B+1]); X[B+2]=EX(X[B+2]); X[B+3]=EX(X[B+3]); PIN(X); SBAR(); }while(0)
  #define GAPB2(MF,X,B) do{ MF; X[B]=EX(X[B]); X[B+1]=EX(X[B+1]); PIN(X); SBAR(); }while(0)
  #define VRD2(i) do{ vlo[i]=vtr(vp_+((2+((i)>>2))*4096+((i)&3)*1024)); vhi[i]=vtr(vp_+((2+((i)>>2))*4096+((i)&3)*1024+512)); SBAR(); }while(0)
  #define VRD(i) do{ vlo[i]=vtr(vp_+(((i)>>2)*4096+((i)&3)*1024)); vhi[i]=vtr(vp_+(((i)>>2)*4096+((i)&3)*1024+512)); }while(0)
  #define KRD(G,j) do{ if(G){ kload2(kf,kp0+sl_next,j); SBAR(); } }while(0)
  #define STEP(C0,C1,P0,P1,t,GK,GV,GL) do{ SBAR(); \
    const lds_cptr vp_=vp0+2*sl_prev; \
    VRD(0); SBAR(); float sacc=(P0[0]+P0[1]); \
    GAPA(C0=__builtin_amdgcn_mfma_f32_32x32x16_bf16(kf[0],QF(0),f32x16{},0,0,0), P0[2],P0[3],P0[4],P0[5],     pw0[0]=PKW(P0,0), pw0[1]=PKW(P0,2), pw0); \
    VRD(4); SBAR(); GAPA(C1=__builtin_amdgcn_mfma_f32_32x32x16_bf16(kf[1],QF(0),f32x16{},0,0,0), P0[6],P0[7],P0[8],P0[9],     pw0[2]=PKW(P0,4), pw0[3]=PKW(P0,6), pw0); \
    VRD(1); SBAR(); GAPA(C0=__builtin_amdgcn_mfma_f32_32x32x16_bf16(kf[2],QF(1),C0,0,0,0),   P0[10],P0[11],P0[12],P0[13], pw1[0]=PKW(P0,8), pw1[1]=PKW(P0,10), pw1); \
    VRD(5); SBAR(); GAPA(C1=__builtin_amdgcn_mfma_f32_32x32x16_bf16(kf[3],QF(1),C1,0,0,0),   P0[14],P0[15],P1[0],P1[1],   pw1[2]=PKW(P0,12),pw1[3]=PKW(P0,14), pw1); \
    VRD(2); SBAR(); GAPA(C0=__builtin_amdgcn_mfma_f32_32x32x16_bf16(kf[4],QF(2),C0,0,0,0),   P1[2],P1[3],P1[4],P1[5],     pw2[0]=PKW(P1,0), pw2[1]=PKW(P1,2), pw2); \
    VRD(6); SBAR(); GAPA(C1=__builtin_amdgcn_mfma_f32_32x32x16_bf16(kf[5],QF(2),C1,0,0,0),   P1[6],P1[7],P1[8],P1[9],     pw2[2]=PKW(P1,4), pw2[3]=PKW(P1,6), pw2); \
    VRD(3); SBAR(); GAPA(C0=__builtin_amdgcn_mfma_f32_32x32x16_bf16(kf[6],QF(3),C0,0,0,0),   P1[10],P1[11],P1[12],P1[13], pw3[0]=PKW(P1,8), pw3[1]=PKW(P1,10), pw3); \
    VRD(7); SBAR(); GAPA(C1=__builtin_amdgcn_mfma_f32_32x32x16_bf16(kf[7],QF(3),C1,0,0,0),   P1[14],P1[15],0.f,0.f,       pw3[2]=PKW(P1,12),pw3[3]=PKW(P1,14), pw3); \
    l_reg+=sacc; \
    if(GK){DMA_K((t)+3,sl_cur);} if(GV){DMA_V((t)+1,sl_next);} \
    _Pragma("unroll") for(int r=0;r<16;++r){C0[r]-=mhat;C1[r]-=mhat;} \
    SBAR(); CMASK(C0,C1,t); SBAR(); \
    { float a=MX3(C0[0],C0[1],C1[0]),b=MX3(C0[2],C0[3],C1[1]); a=MX3(a,C1[2],C1[3]); \
      _Pragma("unroll") for(int r=4;r<16;r+=4){a=MX3(a,C0[r],C0[r+1]);b=MX3(b,C0[r+2],C0[r+3]);a=MX3(a,C1[r],C1[r+1]);b=MX3(b,C1[r+2],C1[r+3]);} \
      float rm=__builtin_fmaxf(a,b); { auto rr=__builtin_amdgcn_permlane32_swap(__float_as_uint(rm),__float_as_uint(rm),false,false); rm=__builtin_fmaxf(__uint_as_float(rr[0]),__uint_as_float(rr[1])); } \
      resc=false; \
      if(__builtin_expect(__any(rm>(float)THRL),0)){ const float dl=__builtin_fmaxf(rm,0.f); mhat+=dl; \
        _Pragma("unroll") for(int r=0;r<16;++r){C0[r]-=dl;C1[r]-=dl;} \
        const float f=__builtin_amdgcn_exp2f(-dl); l_reg*=f; if(hi==0)wsf[r32]=f; resc=true; } } \
    SBAR(); \
    GAPB2(o[0]=__builtin_amdgcn_mfma_f32_32x32x16_bf16(PAF(0),VFR(0),o[0],0,0,0), C0,0);  VRD2(0); \
    GAPB2(o[1]=__builtin_amdgcn_mfma_f32_32x32x16_bf16(PAF(0),VFR(4),o[1],0,0,0), C0,2);  VRD2(4); \
    GAPB2(o[0]=__builtin_amdgcn_mfma_f32_32x32x16_bf16(PAF(1),VFR(1),o[0],0,0,0), C0,4);  VRD2(1); \
    GAPB2(o[1]=__builtin_amdgcn_mfma_f32_32x32x16_bf16(PAF(1),VFR(5),o[1],0,0,0), C0,6);  VRD2(5); \
    GAPB2(o[0]=__builtin_amdgcn_mfma_f32_32x32x16_bf16(PAF(2),VFR(2),o[0],0,0,0), C0,8);  VRD2(2); \
    GAPB2(o[1]=__builtin_amdgcn_mfma_f32_32x32x16_bf16(PAF(2),VFR(6),o[1],0,0,0), C0,10); VRD2(6); \
    GAPB2(o[0]=__builtin_amdgcn_mfma_f32_32x32x16_bf16(PAF(3),VFR(3),o[0],0,0,0), C0,12); VRD2(3); \
    GAPB2(o[1]=__builtin_amdgcn_mfma_f32_32x32x16_bf16(PAF(3),VFR(7),o[1],0,0,0), C0,14); VRD2(7); \
    GAPB2(o[2]=__builtin_amdgcn_mfma_f32_32x32x16_bf16(PAF(0),VFR(0),o[2],0,0,0), C1,0); \
    GAPB2(o[3]=__builtin_amdgcn_mfma_f32_32x32x16_bf16(PAF(0),VFR(4),o[3],0,0,0), C1,2); \
    KRD(GL,0); GAPB2(o[2]=__builtin_amdgcn_mfma_f32_32x32x16_bf16(PAF(1),VFR(1),o[2],0,0,0), C1,4); \
    GAPB2(o[3]=__builtin_amdgcn_mfma_f32_32x32x16_bf16(PAF(1),VFR(5),o[3],0,0,0), C1,6); \
    KRD(GL,1); GAPB2(o[2]=__builtin_amdgcn_mfma_f32_32x32x16_bf16(PAF(2),VFR(2),o[2],0,0,0), C1,8); \
    GAPB2(o[3]=__builtin_amdgcn_mfma_f32_32x32x16_bf16(PAF(2),VFR(6),o[3],0,0,0), C1,10); \
    KRD(GL,2); GAPB2(o[2]=__builtin_amdgcn_mfma_f32_32x32x16_bf16(PAF(3),VFR(3),o[2],0,0,0), C1,12); \
    GAPB2(o[3]=__builtin_amdgcn_mfma_f32_32x32x16_bf16(PAF(3),VFR(7),o[3],0,0,0), C1,14); \
    KRD(GL,3); \
    }while(0)
  int t=1;
  #undef CMASK
  #define CMASK(P0,P1,t) do{}while(0)
  for(;t+7<NT;t+=2){
    STEP(pB0,pB1,pA0,pA1,t,true,true,true);     WAIT_BAR(3); RESC(); ROT();
    STEP(pA0,pA1,pB0,pB1,t+1,true,true,true);   WAIT_BAR(3); RESC(); ROT();
  }
  #undef CMASK
  int tb_=threadIdx.x; asm volatile("":"+v"(tb_)); const int qrel_b=(tb_>>6)*QBLK+(tb_&31),hi_b=(tb_&63)>>5;
  #define CMASK(P0,P1,t) do{int jb_=(t)-(NT-4); if(jb_>=-2 && (wid*QBLK-(64*jb_+63))<128)cbias(P0,P1,jb_,qrel_b,hi_b,bt);}while(0)
  #define ENDW(tt) do{ if((tt)+3<NT){WAIT_BAR(3);} else if((tt)+2<NT){WAIT_BAR(2);} else {WAIT_BAR(0);} }while(0)
  for(;t+1<NT;t+=2){
    STEP(pB0,pB1,pA0,pA1,t,(t+3<NT),(t+1<NT),(t+1<NT));       ENDW(t);   RESC(); ROT();
    STEP(pA0,pA1,pB0,pB1,t+1,(t+4<NT),(t+2<NT),(t+2<NT));     ENDW(t+1); RESC(); ROT();
  }
  STEP(pB0,pB1,pA0,pA1,NT-1,false,false,false); RESC();
  { float sacc=pB0[0]+pB0[1]; _Pragma("unroll") for(int r=2;r<16;++r)sacc+=pB0[r]; _Pragma("unroll") for(int r=0;r<16;++r)sacc+=pB1[r]; l_reg+=sacc;
    pw0=(u32x4){PKW(pB0,0),PKW(pB0,2),PKW(pB0,4),PKW(pB0,6)};pw1=(u32x4){PKW(pB0,8),PKW(pB0,10),PKW(pB0,12),PKW(pB0,14)};pw2=(u32x4){PKW(pB1,0),PKW(pB1,2),PKW(pB1,4),PKW(pB1,6)};pw3=(u32x4){PKW(pB1,8),PKW(pB1,10),PKW(pB1,12),PKW(pB1,14)};
    SBAR(); { int td_=threadIdx.x; asm volatile("":"+v"(td_)); const int ld_=td_&63; const int vb0=(int)((unsigned)(uintptr_t)shm+LDS_V)+((ld_>>4)&1)*32+(ld_&3)*8+(4*(ld_>>5)+((ld_&15)>>2))*64;
      pv(o,vb0+2*sl_cur,PAF(0),PAF(1),PAF(2),PAF(3)); } }
  #undef PKW
  #undef PAF
  #undef VFR
  #undef PIN
  #undef MX3
  #undef GAPA
  #undef GAPB
  #undef GAPB2
  #undef VRD2
  #undef EX
  #undef VRD
  #undef KRD
  #undef STEP
  #undef ENDW
  { int te_=threadIdx.x; asm volatile("":"+v"(te_)); const int lane_e=te_&63,r32e=lane_e&31,hie=lane_e>>5; const int wide=__builtin_amdgcn_readfirstlane(te_>>6);
  float*wsfe=(float*)(shm+LDS_WS)+wide*64;
  {auto rr=__builtin_amdgcn_permlane32_swap(__float_as_uint(l_reg),__float_as_uint(l_reg),false,false);l_reg=__uint_as_float(rr[0])+__uint_as_float(rr[1]);}
  if(hie==0)wsfe[32+r32e]=l_reg;asm volatile("s_waitcnt lgkmcnt(0)":::"memory");
  float rli[16];
  #pragma unroll
  for(int r=0;r<16;++r)rli[r]=__builtin_amdgcn_rcpf(wsfe[32+crow(r,hie)]);
  bf16*Ow=O+((long)b*SEQ+qb*QB+wide*QBLK)*DM+oc;
  { bf16*stg=(bf16*)(shm+LDS_OST)+wide*2048;
    #pragma unroll
    for(int hf=0;hf<2;++hf){
      #pragma unroll
      for(int r=0;r<16;++r){const int orow=crow(r,hie);
        #pragma unroll
        for(int d0=0;d0<2;++d0)stg[orow*64+d0*32+r32e]=__float2bfloat16(o[2*hf+d0][r]*rli[r]);}
      asm volatile("s_waitcnt lgkmcnt(0)":::"memory");
      #pragma unroll
      for(int i=0;i<4;++i){const int row=i*8+(lane_e>>3),ch=lane_e&7; const u32x4 v=*(const u32x4*)(stg+row*64+ch*8); ATTN_STORE16(Ow+(long)row*DM+hf*64+ch*8,v);}
      asm volatile("s_waitcnt lgkmcnt(0)":::"memory"); } } }
  asm volatile("s_waitcnt lgkmcnt(0)\n\ts_barrier":::"memory");
  #undef DMA_K
  #undef DMA_V
  #undef CMASK
  #undef START
  #undef RESC
  #undef ROT
  #undef QF
}
constexpr int ATTN_LDS_BYTES=LDS_BYTES;
#undef SBAR
#undef WAIT_BAR
}
#define XROW(m0) ((C.G == 256) ? (((gw >> 8) << 11) + (gw & 255) + (((m0) - gw) >> 11) * 256) : (m0))
struct Ctx {
    LAS unsigned char* lds; char* ldsg; int tid, lane, wave, G, vcu;
    const float* in[23]; float* out; unsigned char* ws;
};
#define WSP(T, off) ((T*)(C.ws + (off)))
#define PHASE_IDS() Ctx C = C0; { int t_ = threadIdx.x; asm volatile("" : "+v"(t_)); C.tid = t_; C.lane = t_ & 63; C.wave = __builtin_amdgcn_readfirstlane(t_ >> 6); }

struct ConvDesc { const float* src; bf16_t* dst; int N, K; };
__device__ __forceinline__ ConvDesc conv_desc(const Ctx& C, int it) {
    constexpr int I_IN = 16 * 160, I_BR = 8 * 32, I_GU1 = 16 * 64, I_GU = NE * I_GU1, I_D1 = 16 * 32, I_D = NE * I_D1;
    const float* W; bf16_t* WT; int K, N, kb, nb, orow; int r = it;
    if (r < I_GU) { const int e = r / I_GU1, q = r % I_GU1; kb = q / 64; nb = q % 64; const int n0 = 32 * nb, half = n0 >> 10, rem = n0 & 1023;
        W = C.in[18] + (size_t)e * 1024 * 2048; WT = WSP(bf16_t, WS_WGU) + (size_t)e * 2048 * 1024; K = 1024; N = 2048; orow = (rem >> 7) * 256 + half * 128 + (rem & 127); }
    else if ((r -= I_GU) < I_D) { const int e = r / I_D1, q = r % I_D1; kb = q / 32; nb = q % 32; W = C.in[20] + (size_t)e * 1024 * 1024; WT = WSP(bf16_t, WS_WD) + (size_t)e * 1024 * 1024; K = 1024; N = 1024; orow = 32 * nb; }
    else if ((r -= I_D) < I_IN) { kb = r / 160; nb = r % 160; W = C.in[6]; WT = WSP(bf16_t, WS_WIN); K = 1024; N = INW; orow = 32 * nb; }
    else if ((r -= I_IN) < I_BR) { kb = r / 32; nb = r % 32; W = C.in[12]; WT = WSP(bf16_t, WS_WBR); K = 1024; N = 1024; orow = 32 * nb; }
    else if ((r -= I_BR) < I_BR) { kb = r / 32; nb = r % 32; W = C.in[13]; WT = WSP(bf16_t, WS_WBR) + 512; K = 1024; N = 1024; orow = 32 * nb; }
    else { r -= I_BR; kb = r / 32; nb = r % 32; W = C.in[14]; WT = WSP(bf16_t, WS_WOUT); K = 1024; N = 1024; orow = 32 * nb; }
    ConvDesc d; d.src = W + (size_t)(64 * kb) * N + 32 * nb; d.dst = WT + (size_t)orow * K + 64 * kb; d.N = N; d.K = K; return d;
}
__device__ __forceinline__ void conv_load(const ConvDesc& d, f32x4 (&v)[8], int lane) {
    const int kr = lane >> 3, nc = lane & 7;
#pragma unroll
    for (int i = 0; i < 8; ++i) v[i] = *(const f32x4*)(d.src + (size_t)(8 * i + kr) * d.N + 4 * nc);
}
__device__ __forceinline__ void conv_finish(const ConvDesc& d, const f32x4 (&v)[8], LAS float* scr, int lane) {
    const int kr = lane >> 3, nc = lane & 7;
#pragma unroll
    for (int i = 0; i < 8; ++i) { LAS float* s = scr + (8 * i + kr) * 33 + 4 * nc; s[0] = v[i][0]; s[1] = v[i][1]; s[2] = v[i][2]; s[3] = v[i][3]; }
    LDS_WAIT(); asm volatile("" ::: "memory");
    const int c = lane & 7;
#pragma unroll
    for (int j = 0; j < 4; ++j) { const int n = (lane >> 3) + 8 * j; const LAS float* s = scr + (8 * c) * 33 + n;
        u32x4 o; o.x = cvt_pk_bf16(s[0 * 33], s[1 * 33]); o.y = cvt_pk_bf16(s[2 * 33], s[3 * 33]); o.z = cvt_pk_bf16(s[4 * 33], s[5 * 33]); o.w = cvt_pk_bf16(s[6 * 33], s[7 * 33]);
        *(u32x4*)(d.dst + (size_t)n * d.K + 8 * c) = o; }
    LDS_WAIT(); asm volatile("" ::: "memory");
}
__device__ __forceinline__ void conv_range(const Ctx& C, int lo, int hi, int wi, int nw, LAS float* scr) {
    const int first = lo + wi;
    if (first < hi) {
        ConvDesc d0 = conv_desc(C, first), d1 = d0; f32x4 v0[8], v1[8]; conv_load(d0, v0, C.lane);
        for (int it = first; it < hi; it += 2 * nw) {
            const int n1 = it + nw, n2 = it + 2 * nw;
            d1 = conv_desc(C, n1 < hi ? n1 : it); conv_load(d1, v1, C.lane);
            conv_finish(d0, v0, scr, C.lane);
            if (n1 >= hi) break;
            d0 = conv_desc(C, n2 < hi ? n2 : it); conv_load(d0, v0, C.lane);
            conv_finish(d1, v1, scr, C.lane);
        }
    }
}
template <int MODE> __device__ __noinline__ void conv_q_blocks(const float* Wgu, unsigned char* ws, LAS unsigned char* lds, int wave, int first, int stride) {
    int lane_ = (int)__builtin_amdgcn_mbcnt_hi(~0u, __builtin_amdgcn_mbcnt_lo(~0u, 0u)); asm volatile("" : "+v"(lane_));
    const int lane = lane_, tid = wave * 64 + lane, lr = tid >> 3, c4 = tid & 7, n = tid & 31, kg = tid >> 5;
    LAS float* blk = (LAS float*)lds;
    LAS float* wmx = (LAS float*)(lds + LDSCTL_OFF + 14336);
    f32x4 v[16];
    constexpr int NBLK = MODE == 0 ? NE * 64 : 128, LDW = MODE == 0 ? 2048 : INW;
#define QB_SRC(b_) (MODE == 0 ? Wgu + (size_t)((b_) >> 6) * 1024 * 2048 + 32 * ((b_) & 63) : Wgu + 32 * ((b_) < 48 ? (b_) : (b_) + 32))
    if (first < NBLK) { const float* W = QB_SRC(first) + 4 * c4 + (size_t)lr * LDW;
#pragma unroll
        for (int i = 0; i < 16; ++i) v[i] = *(const f32x4*)(W + (size_t)(64 * i) * LDW); }
    for (int bk = first; bk < NBLK; bk += stride) { const int e = MODE == 0 ? bk >> 6 : 0, n0 = MODE == 0 ? 32 * (bk & 63) : 32 * (bk < 48 ? bk : bk + 32), hgu = n0 >> 10, rem = n0 & 1023, orow = MODE == 0 ? (rem >> 7) * 256 + hgu * 128 + (rem & 127) : n0;
        f32x4 mx = (f32x4){0.f, 0.f, 0.f, 0.f};
#pragma unroll
        for (int i = 0; i < 16; ++i) { *(LAS f32x4*)(blk + (64 * i + lr) * 32 + 4 * c4) = v[i]; mx = __builtin_elementwise_max(mx, __builtin_elementwise_abs(v[i])); }
#pragma unroll
        for (int j = 0; j < 4; ++j) { float t = mx[j]; t = fmaxf(t, __shfl_xor(t, 8)); t = fmaxf(t, __shfl_xor(t, 16)); t = fmaxf(t, __shfl_xor(t, 32)); mx[j] = t; }
        if (lane < 8) *(LAS f32x4*)(wmx + wave * 32 + 4 * lane) = mx;
        { const int nk = bk + stride < NBLK ? bk + stride : bk;
          const float* W = QB_SRC(nk) + 4 * c4 + (size_t)lr * LDW;
#pragma unroll
          for (int i = 0; i < 16; ++i) v[i] = *(const f32x4*)(W + (size_t)(64 * i) * LDW); }
        LDS_WAIT(); __builtin_amdgcn_s_barrier(); asm volatile("" ::: "memory");
        float cm = wmx[n];
#pragma unroll
        for (int w = 1; w < 8; ++w) cm = fmaxf(cm, wmx[w * 32 + n]);
        const float inv = cm > 0.f ? 127.0f / cm : 0.f;
        if (kg == 0) ((float*)(ws + (MODE == 0 ? WS_SW : WS_SWIN)))[(size_t)e * 2048 + n0 + n] = cm > 0.f ? cm * (1.0f / 127.0f) : 1.0f;
        signed char* dst = (signed char*)(ws + (MODE == 0 ? WS_WGU : WS_WINQ)) + ((size_t)e * 2048 + orow + n) * 1024 + 64 * kg;
        const LAS float* src = blk + (64 * kg) * 32 + n;
#pragma unroll
        for (int s = 0; s < 4; ++s) { unsigned w4[4];
#pragma unroll
            for (int d = 0; d < 4; ++d) { int b[4];
#pragma unroll
                for (int k = 0; k < 4; ++k) b[k] = (int)fminf(fmaxf(__builtin_rintf(src[(16 * s + 4 * d + k) * 32] * inv), -127.0f), 127.0f);
                w4[d] = (unsigned)(b[0] & 255) | ((unsigned)(b[1] & 255) << 8) | ((unsigned)(b[2] & 255) << 16) | ((unsigned)b[3] << 24); }
            *(u32x4*)(dst + 16 * s) = (u32x4){w4[0], w4[1], w4[2], w4[3]}; }
        LDS_WAIT(); __builtin_amdgcn_s_barrier(); asm volatile("" ::: "memory");
    }
}
#undef QB_SRC
constexpr int CONV_MOE_ITEMS = NE * 16 * 64 + NE * 16 * 32;
constexpr int CONV_ALL_ITEMS = CONV_MOE_ITEMS + 16 * 160 + 2 * 8 * 32 + 16 * 32;
#ifndef NCONV_
#define NCONV_ 13
#endif
constexpr int NCONV = NCONV_;
__device__ __forceinline__ void p0_prologue(const Ctx& C0) {
    PHASE_IDS();
    LAS float* scr = (LAS float*)(C.lds + C.wave * 8448);
    const int gw = C.vcu * NWAVES + C.wave, NGW = C.G * NWAVES;
    conv_q_blocks<1>(C.in[6], C.ws, C.lds, C.wave, (int)blockIdx.x, C.G);
    __syncthreads();
    for (int it = gw; it < 16 * 32; it += NGW) { const int kb = it >> 5, nb = 48 + (it & 31);
        ConvDesc d; d.src = C.in[6] + (size_t)(64 * kb) * INW + 32 * nb; d.dst = WSP(bf16_t, WS_WIN) + (size_t)(32 * nb) * 1024 + 64 * kb; d.N = INW; d.K = 1024;
        f32x4 v[8]; conv_load(d, v, C.lane); conv_finish(d, v, scr, C.lane); }
    conv_range(C, CONV_MOE_ITEMS + 16 * 160, CONV_ALL_ITEMS, gw, NGW, scr);
    const float* cvec = C.in[1]; const float* wada = C.in[3]; float* adap = WSP(float, WS_ADAP);
    for (int it = gw; it < 96 * 16; it += NGW) { const int cc = it % 96, ks = it / 96; const int n = 64 * cc + C.lane; float a0 = 0.f, a1 = 0.f;
#pragma unroll 16
        for (int k = 0; k < 64; ++k) { const int kk = 64 * ks + k; const float w = wada[(size_t)kk * 6144 + n]; a0 += cvec[kk] * w; a1 += cvec[1024 + kk] * w; }
        adap[(ks * 2 + 0) * 6144 + n] = a0; adap[(ks * 2 + 1) * 6144 + n] = a1; }
}
__device__ __forceinline__ float ada_val(const Ctx& C, int b, int n) {
    const float* adap = WSP(const float, WS_ADAP); float s = C.in[4][n];
#pragma unroll
    for (int ks = 0; ks < 16; ++ks) s += adap[(ks * 2 + b) * 6144 + n];
    return s;
}
__device__ __forceinline__ void rms_mod_row(const float* xrow, bf16_t* orow, const LAS float* MA, const LAS float* MB, int lane, signed char* qrow, float* qscale) {
    const f32x4* xr = (const f32x4*)xrow + lane;
    f32x4 v[4]; float s = 0.f;
#pragma unroll
    for (int j = 0; j < 4; ++j) { v[j] = xr[64 * j]; s += (v[j][0] * v[j][0] + v[j][1] * v[j][1]) + (v[j][2] * v[j][2] + v[j][3] * v[j][3]); }
    const float rstd = 1.0f / sqrtf(wave_sum(s) * (1.0f / D) + RMS_EPS);
    u32x2* o8 = (u32x2*)orow + lane;
#pragma unroll
    for (int j = 0; j < 4; ++j) { const f32x4 a = *(const LAS f32x4*)(MA + 4 * lane + 256 * j), b = *(const LAS f32x4*)(MB + 4 * lane + 256 * j);
        const f32x4 h = v[j] * rstd * a + b; u32x2 w; w.x = pk2(h[0], h[1]); w.y = pk2(h[2], h[3]); o8[64 * j] = w; v[j] = h; }
    if (qrow) {
        float am = 0.f;
#pragma unroll
        for (int j = 0; j < 4; ++j)
#pragma unroll
            for (int k = 0; k < 4; ++k) am = fmaxf(am, fabsf(v[j][k]));
#pragma unroll
        for (int o = 1; o < 64; o <<= 1) am = fmaxf(am, __shfl_xor(am, o));
        const float inv = am > 0.f ? 127.0f / am : 0.f;
        if (lane == 0) *qscale = am > 0.f ? am * (1.0f / 127.0f) : 1.0f;
#pragma unroll
        for (int j = 0; j < 4; ++j) { int b4[4];
#pragma unroll
            for (int k = 0; k < 4; ++k) b4[k] = (int)fminf(fmaxf(__builtin_rintf(v[j][k] * inv), -127.0f), 127.0f);
            ((unsigned*)qrow)[lane + 64 * j] = (unsigned)(b4[0] & 255) | ((unsigned)(b4[1] & 255) << 8) | ((unsigned)(b4[2] & 255) << 16) | ((unsigned)b4[3] << 24); } }
}
__device__ __forceinline__ void rms_mod_row_bf16(const bf16_t* xrow, bf16_t* orow, const LAS float* MA, const LAS float* MB, int lane, signed char* qrow, float* qscale) {
    float v[16]; float s = 0.f;
#pragma unroll
    for (int j = 0; j < 2; ++j) { const u32x4 w = *(const u32x4*)(xrow + 512 * j + 8 * lane);
        v[8 * j + 0] = bf_lo(w.x); v[8 * j + 1] = bf_hi(w.x); v[8 * j + 2] = bf_lo(w.y); v[8 * j + 3] = bf_hi(w.y); v[8 * j + 4] = bf_lo(w.z); v[8 * j + 5] = bf_hi(w.z); v[8 * j + 6] = bf_lo(w.w); v[8 * j + 7] = bf_hi(w.w); }
#pragma unroll
    for (int k = 0; k < 16; ++k) s += v[k] * v[k];
    const float rstd = 1.0f / sqrtf(wave_sum(s) * (1.0f / D) + RMS_EPS);
#pragma unroll
    for (int j = 0; j < 2; ++j) { const LAS float* a = MA + 512 * j + 8 * lane; const LAS float* b = MB + 512 * j + 8 * lane;
        const f32x4 a0 = *(const LAS f32x4*)a, a1 = *(const LAS f32x4*)(a + 4), b0 = *(const LAS f32x4*)b, b1 = *(const LAS f32x4*)(b + 4);
        u32x4 w; w.x = pk2(v[8 * j + 0] * rstd * a0[0] + b0[0], v[8 * j + 1] * rstd * a0[1] + b0[1]); w.y = pk2(v[8 * j + 2] * rstd * a0[2] + b0[2], v[8 * j + 3] * rstd * a0[3] + b0[3]);
        w.z = pk2(v[8 * j + 4] * rstd * a1[0] + b1[0], v[8 * j + 5] * rstd * a1[1] + b1[1]); w.w = pk2(v[8 * j + 6] * rstd * a1[2] + b1[2], v[8 * j + 7] * rstd * a1[3] + b1[3]);
        *(u32x4*)(orow + 512 * j + 8 * lane) = w; }
    if (qrow) {
        float hq[16]; float am = 0.f;
#pragma unroll
        for (int j = 0; j < 2; ++j) { const LAS float* a = MA + 512 * j + 8 * lane; const LAS float* b = MB + 512 * j + 8 * lane;
#pragma unroll
            for (int k = 0; k < 8; ++k) { hq[8 * j + k] = v[8 * j + k] * rstd * a[k] + b[k]; am = fmaxf(am, fabsf(hq[8 * j + k])); } }
#pragma unroll
        for (int o = 1; o < 64; o <<= 1) am = fmaxf(am, __shfl_xor(am, o));
        const float inv = am > 0.f ? 127.0f / am : 0.f;
        if (lane == 0) *qscale = am > 0.f ? am * (1.0f / 127.0f) : 1.0f;
#pragma unroll
        for (int j = 0; j < 2; ++j) { unsigned w2[2];
#pragma unroll
            for (int d = 0; d < 2; ++d) { int b4[4];
#pragma unroll
                for (int k = 0; k < 4; ++k) b4[k] = (int)fminf(fmaxf(__builtin_rintf(hq[8 * j + 4 * d + k] * inv), -127.0f), 127.0f);
                w2[d] = (unsigned)(b4[0] & 255) | ((unsigned)(b4[1] & 255) << 8) | ((unsigned)(b4[2] & 255) << 16) | ((unsigned)b4[3] << 24); }
            *(u32x2*)(qrow + 512 * j + 8 * lane) = (u32x2){w2[0], w2[1]}; } }
}
__device__ __forceinline__ void p1_h1(const Ctx& C0) {
    PHASE_IDS();
    LAS float* MA = (LAS float*)C.lds;
    LAS float* MB = MA + 2048;
    for (int idx = C.tid; idx < 2048; idx += 512) { const int b = idx >> 10, col = idx & 1023;
        const float sh = ada_val(C, b, col), sc = ada_val(C, b, 1024 + col);
        MA[idx] = C.in[5][col] * (1.0f + sc); MB[idx] = sh; }
    if (blockIdx.x < NE) { const int e = blockIdx.x; bf16_t* wrt = WSP(bf16_t, WS_WRT) + (size_t)e * 1024;
        for (int k = C.tid; k < 1024; k += 512) wrt[k] = (bf16_t)f2bf(C.in[16][(size_t)k * 32 + e]); }
    {
        const int per = (2 * 6144 + C.G - 1) / C.G;
        for (int i = C.tid; i < per; i += 512) { const int idx = blockIdx.x * per + i; if (idx < 2 * 6144) WSP(float, WS_ADAF)[idx] = ada_val(C, idx / 6144, idx % 6144); }
    }
    __syncthreads();
    const int gw = C.vcu * NWAVES + C.wave, NGW = C.G * NWAVES;
    for (int m0 = gw; m0 < M; m0 += NGW) { const int m = XROW(m0); const int b = m >= SEQ; rms_mod_row(C.in[0] + (size_t)m * D, WSP(bf16_t, WS_H) + (size_t)m * D, MA + b * 1024, MB + b * 1024, C.lane, (signed char*)(C.ws + WS_H2Q) + (size_t)m * D, WSP(float, WS_SA) + m); }
    __syncthreads();
}
__device__ __forceinline__ void p3a_kmean(const Ctx& C0) {
    PHASE_IDS();
    LAS float* red = (LAS float*)C.lds;
    const bf16_t* kb = WSP(const bf16_t, WS_PROJ + 2 * PROJ_STRIDE);
    for (int it = blockIdx.x; it < 64; it += C.G) { const int b = it >> 5, n = it & 31;
        float a[8];
#pragma unroll
        for (int j = 0; j < 8; ++j) a[j] = 0.f;
        const bf16_t* src = kb + (size_t)(b * SEQ + 256 * n + 32 * C.wave) * 1024 + 8 * C.lane;
#pragma unroll 8
        for (int r = 0; r < 32; ++r) { const u32x4 v = *(const u32x4*)(src + (size_t)r * 1024);
            a[0] += bf_lo(v.x); a[1] += bf_hi(v.x); a[2] += bf_lo(v.y); a[3] += bf_hi(v.y); a[4] += bf_lo(v.z); a[5] += bf_hi(v.z); a[6] += bf_lo(v.w); a[7] += bf_hi(v.w); }
        __syncthreads();
#pragma unroll
        for (int j = 0; j < 8; ++j) red[C.wave * 512 + 8 * C.lane + j] = a[j];
        __syncthreads();
        { const int col = C.tid; float s = 0.f;
#pragma unroll
            for (int w = 0; w < 8; ++w) s += red[w * 512 + col];
            const int h = col >> 6, d = col & 63; WSP(float, WS_KMEAN)[((b * 8 + h) * 32 + n) * 64 + d] = s * (1.0f / 256.0f); }
    }
    __syncthreads();
}
__device__ __forceinline__ void p3b_gate(const Ctx& C0) {
    PHASE_IDS();
    LAS float* km = (LAS float*)C.lds;
    const bf16_t* qb = WSP(const bf16_t, WS_PROJ + 1 * PROJ_STRIDE) + 512;
    unsigned* cnt = WSP(unsigned, WS_CTL) + CW_MCNT; unsigned* list = WSP(unsigned, WS_LIST);
    for (int it = blockIdx.x; it < 256; it += C.G) { const int bh = it >> 4, qc = it & 15, b = bh >> 3, h = bh & 7;
        __syncthreads();
        for (int i = C.tid; i < 2048; i += 512) km[i] = WSP(const float, WS_KMEAN)[bh * 2048 + i];
        __syncthreads();
        const int q = 512 * qc + C.tid, own = q >> 8;
        u32x4 qv[8];
        { const u32x4* qp = (const u32x4*)(qb + (size_t)(b * SEQ + q) * 1024 + h * 64);
#pragma unroll
            for (int j = 0; j < 8; ++j) qv[j] = qp[j]; }
        float v0 = -INFINITY, v1 = -INFINITY, v2 = -INFINITY; int i0 = 0, i1 = 0, i2 = 0;
        const int nmax = ((512 * qc + 511) >> 8);
        for (int n = 0; n < nmax; ++n) { const LAS f32x4* kr = (const LAS f32x4*)(km + n * 64); float s = 0.f;
#pragma unroll
            for (int j = 0; j < 8; ++j) { const f32x4 ka = kr[2 * j], kb2 = kr[2 * j + 1];
                s += bf_lo(qv[j].x) * ka[0] + bf_hi(qv[j].x) * ka[1] + bf_lo(qv[j].y) * ka[2] + bf_hi(qv[j].y) * ka[3]
                   + bf_lo(qv[j].z) * kb2[0] + bf_hi(qv[j].z) * kb2[1] + bf_lo(qv[j].w) * kb2[2] + bf_hi(qv[j].w) * kb2[3]; }
            if (n < own) {
                if (s > v0) { v2 = v1; i2 = i1; v1 = v0; i1 = i0; v0 = s; i0 = n; }
                else if (s > v1) { v2 = v1; i2 = i1; v1 = s; i1 = n; }
                else if (s > v2) { v2 = s; i2 = n; }
            } }
        const int nsel = own < 3 ? own : 3;
        LAS unsigned* lc = (LAS unsigned*)(C.lds + 8192);
        if (C.tid < 128) lc[C.tid] = 0u;
        __syncthreads();
        const int l0 = 2 * i0 + (i0 == own - 1 ? 1 : 0), l1 = 2 * i1 + (i1 == own - 1 ? 1 : 0), l2 = 2 * i2 + (i2 == own - 1 ? 1 : 0);
        unsigned lp0 = 0u, lp1 = 0u, lp2 = 0u;
        if (nsel > 0) lp0 = atomicAdd((unsigned*)(lc + l0), 1u);
        if (nsel > 1) lp1 = atomicAdd((unsigned*)(lc + l1), 1u);
        if (nsel > 2) lp2 = atomicAdd((unsigned*)(lc + l2), 1u);
        __syncthreads();
        if (C.tid < 64) { const unsigned c = lc[C.tid]; lc[64 + C.tid] = c ? atomicAdd(cnt + bh * 64 + C.tid, c) : 0u; }
        __syncthreads();
#pragma unroll
        for (int j = 0; j < 3; ++j) if (j < nsel) { const int n = j == 0 ? i0 : (j == 1 ? i1 : i2); const int l = j == 0 ? l0 : (j == 1 ? l1 : l2); const unsigned pos = lc[64 + l] + (j == 0 ? lp0 : (j == 1 ? lp1 : lp2));
            list[(size_t)bh * LIST_PER_BH + 256 * (31 * n - (n * (n - 1)) / 2) + ((l & 1) ? 0 : 256) + pos] = (unsigned)q | ((unsigned)j << 13); }
    }
    __syncthreads();
}
__device__ __forceinline__ void build_bias_tables(const Ctx& C) {
    LAS float* bt = (LAS float*)(C.lds + AT_BT);
    for (int idx = C.tid; idx < 12 * BT_STR; idx += 512) { const int hd = idx / BT_STR, n = idx % BT_STR;
        if (n >= 128) { bt[idx] = 0.f; continue; }
        int bk;
        if (n < 16) bk = n; else { const float nf = (float)n; int lg = 16 + (int)(logf(nf / 16.0f) / logf(8.0f) * 16.0f); bk = lg < 31 ? lg : 31; }
        bt[idx] = (C.in[2][bk * 12 + hd] - C.in[2][31 * 12 + hd]) * LOG2E; }
}
#if SIMPLE_DIFF
__device__ __forceinline__ void diff_unit(const Ctx& C, int b, int h, int qblk, float lam) {
    const int lane = C.lane, c = lane & 15, g = lane >> 4, wid = C.wave;
    const bf16_t* qka = WSP(const bf16_t, WS_PROJ);
    const bf16_t* va = WSP(const bf16_t, WS_PROJ + PROJ_STRIDE);
    const int q0 = qblk * 128, q = q0 + wid * 16 + c, NT = 2 * qblk + 2;
    const LAS float* bt = (const LAS float*)(C.lds + AT_BT) + h * 128;
    f32x4 o0[8];
    for (int map = 0; map < 2; ++map) {
        bf16x8 qf[2];
#pragma unroll
        for (int ks = 0; ks < 2; ++ks) qf[ks] = *(const bf16x8*)(qka + (size_t)(b * SEQ + q) * 1024 + h * 128 + map * 64 + 32 * ks + 8 * g);
        const bf16_t* kg = qka + (size_t)(b * SEQ) * 1024 + 512 + h * 128 + map * 64;
        const bf16_t* vg = va + (size_t)(b * SEQ) * 1024 + h * 128;
        float m_run = -1e30f, l_run = 0.f; f32x4 o[8];
#pragma unroll
        for (int dt = 0; dt < 8; ++dt) o[dt] = (f32x4){0.f, 0.f, 0.f, 0.f};
        TileRegs<2> tr; tile_fetch<2>(tr, kg, vg, C.tid);
        for (int t = 0; t < NT; ++t) {
            __syncthreads();
            tile_store<2>(tr, C.lds, C.tid);
            __syncthreads();
            if (t + 1 < NT) tile_fetch<2>(tr, kg + (size_t)(t + 1) * 64 * 1024, vg + (size_t)(t + 1) * 64 * 1024, C.tid);
            attn_tile<8>(C.lds, lane, qf, o, m_run, l_run, q, 64 * t, true, bt);
        }
        float lt = l_run; lt += __shfl_xor(lt, 16); lt += __shfl_xor(lt, 32);
        const float rl = 1.0f / lt;
#pragma unroll
        for (int i = 0; i < 4; ++i) { const float ri = __shfl(rl, 4 * g + i);
#pragma unroll
            for (int dt = 0; dt < 8; ++dt) { if (map == 0) o0[dt][i] = o[dt][i] * ri; else o0[dt][i] = o0[dt][i] - lam * (o[dt][i] * ri); } }
    }
    bf16_t* y = WSP(bf16_t, WS_Y);
#pragma unroll
    for (int i = 0; i < 4; ++i) { float ss = 0.f;
#pragma unroll
        for (int dt = 0; dt < 8; ++dt) ss += o0[dt][i] * o0[dt][i];
        ss += __shfl_xor(ss, 1); ss += __shfl_xor(ss, 2); ss += __shfl_xor(ss, 4); ss += __shfl_xor(ss, 8);
        const float rstd = 1.0f / sqrtf(ss * (1.0f / 128.0f) + RMS_EPS);
        bf16_t* yr = y + (size_t)(b * SEQ + q0 + wid * 16 + 4 * g + i) * 1024 + h * 128 + c;
#pragma unroll
        for (int dt = 0; dt < 8; ++dt) yr[16 * dt] = (bf16_t)f2bf(o0[dt][i] * rstd * C.in[11][16 * dt + c] * 0.8f); }
}
#endif
#if 0
__device__ __forceinline__ void moba_item(const Ctx& C, int b, int h, int n, bool own, int half, const unsigned* lst, int lcnt, int chunk) {
    const int lane = C.lane, c = lane & 15, g = lane >> 4, wid = C.wave;
    const bf16_t* qb = WSP(const bf16_t, WS_PROJ + PROJ_STRIDE) + 512;
    const bf16_t* kv = WSP(const bf16_t, WS_PROJ + 2 * PROJ_STRIDE);
    int qtok, jslot; bool valid;
    if (own) { qtok = 256 * n + 128 * half + wid * 16 + c; jslot = 3; valid = true; }
    else { const int idx = chunk * 128 + wid * 16 + c; valid = idx < lcnt; const unsigned e = lst[valid ? idx : 0]; qtok = (int)(e & 8191u); jslot = (int)(e >> 13); }
    bf16x8 qf[2];
#pragma unroll
    for (int ks = 0; ks < 2; ++ks) qf[ks] = *(const bf16x8*)(qb + (size_t)(b * SEQ + qtok) * 1024 + h * 64 + 32 * ks + 8 * g);
    const bf16_t* kg = kv + (size_t)(b * SEQ + 256 * n) * 1024 + h * 64;
    const bf16_t* vg = kg + 512;
    const LAS float* bt = (const LAS float*)(C.lds + AT_BT) + (4 + h) * 128;
    const int NT = own ? 2 * (half + 1) : 4;
    float m_run = -1e30f, l_run = 0.f; f32x4 o[4];
#pragma unroll
    for (int dt = 0; dt < 4; ++dt) o[dt] = (f32x4){0.f, 0.f, 0.f, 0.f};
    TileRegs<1> tr; tile_fetch<1>(tr, kg, vg, C.tid);
    for (int t = 0; t < NT; ++t) {
        __syncthreads();
        tile_store<1>(tr, C.lds, C.tid);
        __syncthreads();
        if (t + 1 < NT) tile_fetch<1>(tr, kg + (size_t)(t + 1) * 64 * 1024, vg + (size_t)(t + 1) * 64 * 1024, C.tid);
        attn_tile<4>(C.lds, lane, qf, o, m_run, l_run, qtok, 256 * n + 64 * t, own, bt);
    }
    float lt = l_run; lt += __shfl_xor(lt, 16); lt += __shfl_xor(lt, 32);
    const int slot = ((b * SEQ + qtok) * 8 + h) * 4 + jslot;
    if (g == 0 && valid) { f32x2 ml; ml[0] = m_run; ml[1] = lt; *(f32x2*)(WSP(float, WS_PML) + (size_t)slot * 2) = ml; }
    bf16_t* po = WSP(bf16_t, WS_PO);
#pragma unroll
    for (int i = 0; i < 4; ++i) { const int sl = __shfl(slot, 4 * g + i); const int vl = __shfl((int)valid, 4 * g + i);
        if (vl) {
#pragma unroll
            for (int dt = 0; dt < 4; ++dt) po[(size_t)sl * 64 + 16 * dt + c] = (bf16_t)f2bf(o[dt][i]); } }
}
#endif
constexpr int MB_BUF = 65536, MB_OST = LDSCTL_OFF + 14336;
struct MItem { int valid, b, h, n, own, half, near, lcnt, chunk, lbase; };
__device__ __forceinline__ MItem moba_decode(int it, int nitems, const LAS int* pre, const unsigned* cnt) {
    MItem m; m.valid = it < nitems ? 1 : 0; if (!m.valid) it = 0;
    if (it < 1024) { const int bh = it >> 6, r = it & 63; m.b = bh >> 3; m.h = bh & 7; m.n = r >> 1; m.own = 1; m.half = (r ^ (bh >> 2)) & 1; m.near = 0;
        m.lcnt = 128; m.chunk = 0; m.lbase = 0; }
    else { const int gi = it - 1024; int lo = 0, hi = 1023;
        while (lo < hi) { const int mid = (lo + hi + 1) >> 1; if (pre[mid] <= gi) lo = mid; else hi = mid - 1; }
        const int L = lo, bh = L >> 6, n = (L >> 1) & 31, near = L & 1;
        m.b = bh >> 3; m.h = bh & 7; m.n = n; m.own = 0; m.half = 0; m.near = near; m.lcnt = (int)__hip_atomic_load(cnt + L, RLX_AGENT); m.chunk = gi - pre[L];
        m.lbase = bh * LIST_PER_BH + 256 * (31 * n - (n * (n - 1)) / 2) + (near ? 0 : 256); }
    return m;
}
__device__ __forceinline__ unsigned moba_entry(const Ctx& C, const MItem& m) {
    const int c = C.lane & 15;
    if (m.own) return (unsigned)(256 * m.n + 128 * m.half + C.wave * 16 + c) | (3u << 13) | (1u << 15);
    const int idx = m.chunk * 128 + C.wave * 16 + c; const bool v = idx < m.lcnt;
    const unsigned e = WSP(const unsigned, WS_LIST)[(size_t)m.lbase + (v ? idx : 0)];
    return (e & 0x7fffu) | (v ? (1u << 15) : 0u);
}
__device__ __forceinline__ void moba_qload(const Ctx& C, const MItem& m, unsigned ent, bf16x8 (&qf)[2]) {
    const bf16_t* qb = WSP(const bf16_t, WS_PROJ + PROJ_STRIDE) + 512; const int g = C.lane >> 4;
#pragma unroll
    for (int ks = 0; ks < 2; ++ks) qf[ks] = *(const bf16x8*)(qb + (size_t)(m.b * SEQ + (int)(ent & 8191u)) * 1024 + m.h * 64 + 32 * ks + 8 * g);
}
__device__ __forceinline__ void moba_dma(const Ctx& C, const MItem& m, int bo) {
    const bf16_t* kg = WSP(const bf16_t, WS_PROJ + 2 * PROJ_STRIDE) + (size_t)(m.b * SEQ + 256 * m.n) * 1024 + m.h * 64;
    const int r8 = C.lane >> 3, sch = (C.lane & 7) ^ r8;
#pragma unroll
    for (int j = 0; j < 4; ++j) { const int p = C.wave * 4 + j; const bf16_t* src = kg + (size_t)(8 * p + r8) * 1024 + sch * 8;
        __builtin_amdgcn_global_load_lds((const unsigned*)src, (LAS unsigned*)(C.lds + bo + p * 1024), 16, 0, 0);
        __builtin_amdgcn_global_load_lds((const unsigned*)(src + 512), (LAS unsigned*)(C.lds + bo + 32768 + p * 1024), 16, 0, 0); }
}
constexpr int MB_STG = 2304;
__device__ __forceinline__ void moba_flush(const Ctx& C) {
    const LAS unsigned char* stg = C.lds + MB_OST + C.wave * MB_STG; const int lane = C.lane;
    const LAS int* sslot = (const LAS int*)(stg + 2176);
    bf16_t* po = WSP(bf16_t, WS_PO);
#pragma unroll
    for (int r = 0; r < 2; ++r) { const int row = (lane >> 3) + 8 * r, ch = lane & 7; const u32x4 v = *(const LAS u32x4*)(stg + row * 128 + ch * 16); const int sl = sslot[row];
        if (sl >= 0) *(u32x4*)(po + (size_t)sl * 64 + ch * 8) = v; }
    if (lane < 16) { const int sl = sslot[lane]; const f32x2 ml = *(const LAS f32x2*)(stg + 2048 + lane * 8); if (sl >= 0) *(f32x2*)(WSP(float, WS_PML) + (size_t)sl * 2) = ml; }
}
__device__ __forceinline__ void moba_compute(const Ctx& C, const MItem& m, unsigned ent, const bf16x8 (&qf)[2], int bo, int mode) {
    if (!(mode & 2)) return;
    const int lane = C.lane, c = lane & 15, g = lane >> 4, cx = c & 7;
    const int qtok = (int)(ent & 8191u), jslot = (int)((ent >> 13) & 3u), valid = (int)((ent >> 15) & 1u);
    const int nkt = m.own ? 8 * (m.half + 1) : 16;
    const LAS float* bt = (const LAS float*)(C.lds + AT_BT) + (4 + m.h) * BT_STR;
    f32x4 s[16];
    const LAS unsigned char* kb = C.lds + bo + c * 128;
    const int kc0 = ((0 + g) ^ cx) << 4, kc1 = ((4 + g) ^ cx) << 4;
#define MB_BIAS(t4) do { if (m.own | m.near) { const int kbase_ = 256 * m.n + 64 * (t4); \
            _Pragma("unroll") for (int k4 = 0; k4 < 4; ++k4) _Pragma("unroll") for (int i = 0; i < 4; ++i) { const int kt_ = 4 * (t4) + k4; const int dist = qtok - (kbase_ + 16 * k4 + 4 * g + i); \
                const unsigned di = (unsigned)dist < 128u ? (unsigned)dist : 128u; const float v = s[kt_][i] + bt[di]; s[kt_][i] = (m.own && dist < 0) ? -INFINITY : v; } } } while (0)
#pragma unroll
    for (int kt = 0; kt < 4; ++kt) { const bf16x8 a0 = *(const LAS bf16x8*)(kb + kt * 2048 + kc0), a1 = *(const LAS bf16x8*)(kb + kt * 2048 + kc1);
        f32x4 z = (f32x4){0.f, 0.f, 0.f, 0.f}; z = __builtin_amdgcn_mfma_f32_16x16x32_bf16(a0, qf[0], z, 0, 0, 0); s[kt] = __builtin_amdgcn_mfma_f32_16x16x32_bf16(a1, qf[1], z, 0, 0, 0); }
    MB_BIAS(0);
    float mx = fmaxf(fmaxf(s[0][0], s[0][1]), fmaxf(s[0][2], s[0][3]));
#pragma unroll
    for (int kt = 1; kt < 4; ++kt) mx = fmaxf(mx, fmaxf(fmaxf(s[kt][0], s[kt][1]), fmaxf(s[kt][2], s[kt][3])));
    mx = fmaxf(mx, __shfl_xor(mx, 16)); mx = fmaxf(mx, __shfl_xor(mx, 32));
    const f32x4 negm = (f32x4){-mx, -mx, -mx, -mx};
#pragma unroll
    for (int kt = 0; kt < 4; ++kt) s[kt] += negm;
#pragma unroll
    for (int kt = 4; kt < 16; ++kt) {
        if (kt < nkt) { const bf16x8 a0 = *(const LAS bf16x8*)(kb + kt * 2048 + kc0), a1 = *(const LAS bf16x8*)(kb + kt * 2048 + kc1);
            f32x4 z = __builtin_amdgcn_mfma_f32_16x16x32_bf16(a0, qf[0], negm, 0, 0, 0); s[kt] = __builtin_amdgcn_mfma_f32_16x16x32_bf16(a1, qf[1], z, 0, 0, 0); }
        else s[kt] = (f32x4){-INFINITY, -INFINITY, -INFINITY, -INFINITY};
    }
    if (4 < nkt) MB_BIAS(1);
    if (8 < nkt) { MB_BIAS(2); MB_BIAS(3); }
#undef MB_BIAS
#pragma unroll
    for (int kt = 0; kt < 16; ++kt)
#pragma unroll
        for (int i = 0; i < 4; ++i) s[kt][i] = __builtin_amdgcn_exp2f(s[kt][i]);
    f32x4 o[4], osum = (f32x4){0.f, 0.f, 0.f, 0.f};
#pragma unroll
    for (int dt = 0; dt < 4; ++dt) o[dt] = (f32x4){0.f, 0.f, 0.f, 0.f};
    const short one = (c == 0) ? (short)0x3F80 : (short)0; const bf16x8 ones = (bf16x8){one, one, one, one, one, one, one, one};
    const int rv = 4 * g + (c >> 2), x7 = rv & 7, hb = (c & 3) >> 1;
    const LAS unsigned char* vb = C.lds + bo + 32768 + rv * 128 + 8 * (c & 1);
    int cv[4];
#pragma unroll
    for (int dt = 0; dt < 4; ++dt) cv[dt] = ((2 * dt + hb) ^ x7) << 4;
#pragma unroll
    for (int kk = 0; kk < 8; ++kk) {
        if (2 * kk < nkt) { u32x4 w; w.x = cvt_pk_bf16(s[2 * kk][0], s[2 * kk][1]); w.y = cvt_pk_bf16(s[2 * kk][2], s[2 * kk][3]);
            w.z = cvt_pk_bf16(s[2 * kk + 1][0], s[2 * kk + 1][1]); w.w = cvt_pk_bf16(s[2 * kk + 1][2], s[2 * kk + 1][3]); const bf16x8 pa = __builtin_bit_cast(bf16x8, w);
            osum = __builtin_amdgcn_mfma_f32_16x16x32_bf16(pa, ones, osum, 0, 0, 0);
#pragma unroll
            for (int dt = 0; dt < 4; ++dt) { const s16x4 lo = tr16(vb + (32 * kk) * 128 + cv[dt]), hi = tr16(vb + (32 * kk + 16) * 128 + cv[dt]);
                const bf16x8 bfr = (bf16x8){lo[0], lo[1], lo[2], lo[3], hi[0], hi[1], hi[2], hi[3]};
                o[dt] = __builtin_amdgcn_mfma_f32_16x16x32_bf16(pa, bfr, o[dt], 0, 0, 0); } }
    }
    if (!(mode & 1)) return;
    LAS unsigned char* stg = C.lds + MB_OST + C.wave * MB_STG;
    LAS bf16_t* so = (LAS bf16_t*)stg;
#pragma unroll
    for (int i = 0; i < 4; ++i)
#pragma unroll
        for (int dt = 0; dt < 4; ++dt) so[(4 * g + i) * 64 + 16 * dt + c] = (bf16_t)f2bf(o[dt][i]);
    const int slot = valid ? ((m.b * SEQ + qtok) * 8 + m.h) * 4 + jslot : -1;
    if (g == 0) { ((LAS int*)(stg + 2176))[c] = slot; ((LAS float*)(stg + 2048))[2 * c] = mx; }
    if (c == 0) {
#pragma unroll
        for (int i = 0; i < 4; ++i) ((LAS float*)(stg + 2048))[2 * (4 * g + i) + 1] = osum[i]; }
}
__device__ __forceinline__ MItem moba_item_at(const LAS int* tab, int j) {
    MItem m; const int w0 = __builtin_amdgcn_readfirstlane(tab[4 * j]), w1 = __builtin_amdgcn_readfirstlane(tab[4 * j + 1]), w2 = __builtin_amdgcn_readfirstlane(tab[4 * j + 2]), w3 = __builtin_amdgcn_readfirstlane(tab[4 * j + 3]);
    m.valid = (j < 32 && w1 >= 0) ? 1 : 0; const int bh = w0 & 255; m.b = bh >> 3; m.h = bh & 7; m.n = (w0 >> 8) & 255; m.own = (w0 >> 16) & 1; m.half = (w0 >> 17) & 1; m.near = (w0 >> 18) & 1; m.lcnt = w1; m.chunk = w2; m.lbase = w3; return m;
}
__device__ __forceinline__ void moba_phase(const Ctx& C, const LAS int* pre, const unsigned* cnt, int mode) {
    const int nitems = 1024 + pre[1024]; const int G = C.G;
    LAS int* tab = (LAS int*)(C.lds + LDSCTL_OFF + 7424);
    if (C.tid < 33) { MItem m = moba_decode(C.vcu + C.tid * G, nitems, pre, cnt); if (C.tid == 32) m.valid = 0;
        tab[4 * C.tid] = (m.b * 8 + m.h) | (m.n << 8) | (m.own << 16) | (m.half << 17) | (m.near << 18); tab[4 * C.tid + 1] = m.valid ? m.lcnt : -1; tab[4 * C.tid + 2] = m.chunk; tab[4 * C.tid + 3] = m.lbase; }
    __syncthreads();
    int j = 0;
    MItem m0 = moba_item_at(tab, 0), m1 = moba_item_at(tab, 1);
    unsigned e0 = 0u, e1 = 0u; bf16x8 qf0[2];
    qf0[0] = (bf16x8){0, 0, 0, 0, 0, 0, 0, 0}; qf0[1] = qf0[0];
    if (m0.valid) { e0 = moba_entry(C, m0); moba_qload(C, m0, e0, qf0); moba_dma(C, m0, 0); }
    if (m1.valid) e1 = moba_entry(C, m1);
    int bo = 0; bool pending = false;
    while (m0.valid) {
        VM_WAIT(); __syncthreads();
        if (pending) moba_flush(C);
        bf16x8 qf1[2]; qf1[0] = qf0[0]; qf1[1] = qf0[1];
        if (m1.valid) moba_qload(C, m1, e1, qf1);
        const MItem m2 = moba_item_at(tab, j + 2 < 32 ? j + 2 : 32);
        unsigned e2 = 0u; if (m2.valid) e2 = moba_entry(C, m2);
        if (m1.valid) moba_dma(C, m1, bo ^ MB_BUF);
        moba_compute(C, m0, e0, qf0, bo, mode); pending = (mode & 3) == 3;
        m0 = m1; m1 = m2; e0 = e1; e1 = e2; qf0[0] = qf1[0]; qf0[1] = qf1[1]; bo ^= MB_BUF; ++j;
    }
    if (pending) { LDS_WAIT(); moba_flush(C); }
    VM_WAIT(); __syncthreads();
}
#ifndef PROBE_SUB
#define PROBE_SUB 3
#endif
__device__ __forceinline__ void p4_attention(const Ctx& C0, int sub, bool gate) {
    if (gate) { p3b_gate(C0);
        asm volatile("s_waitcnt vmcnt(0)" ::: "memory"); __syncthreads();
        if (threadIdx.x == 0) { __builtin_amdgcn_fence(__ATOMIC_RELEASE, "agent"); asm volatile("s_waitcnt vmcnt(0)" ::: "memory"); xb_add((unsigned*)(C0.ws + WS_CTL) + CW_GDONE, 1u); } }
    PHASE_IDS();
    __syncthreads();
    build_bias_tables(C);
    float lam;
    { const float a = wave_sum(C.in[7][C.lane] * C.in[8][C.lane]), b2 = wave_sum(C.in[9][C.lane] * C.in[10][C.lane]); lam = expf(a) - expf(b2) + 0.2f; }
    __syncthreads();
#if SIMPLE_DIFF
    if (sub & 1) for (int p = blockIdx.x; p < 256; p += C.G) { const int bh = p >> 5, qa = p & 31;
        diff_unit(C, bh >> 2, bh & 3, qa, lam); diff_unit(C, bh >> 2, bh & 3, 63 - qa, lam); }
#else
#if NATIVE_DIFF
    {
        const int grp = blockIdx.x & 7, rank = blockIdx.x >> 3;
        if ((sub & 1) && rank < NCONV) { LAS float* scr = (LAS float*)(C.lds + C.wave * 8448);
            const int wi = (rank * 8 + grp) * NWAVES + C.wave, nw = NCONV * 8 * NWAVES;
            conv_q_blocks<0>(C.in[18], C.ws, C.lds, C.wave, rank * 8 + grp, NCONV * 8);
            conv_range(C, NE * 16 * 64, CONV_MOE_ITEMS, wi, nw, scr); }
        unsigned* qctr = WSP(unsigned, WS_CTL) + CW_AQ + 64 * grp;
        LAS int* qslot = (LAS int*)(C.lds + LDSCTL_OFF + 512);
        const attn_nat::bf16* qk = (const attn_nat::bf16*)WSP(const bf16_t, WS_PROJ); const attn_nat::bf16* vv = (const attn_nat::bf16*)WSP(const bf16_t, WS_PROJ + PROJ_STRIDE);
        attn_nat::bf16* oa = (attn_nat::bf16*)WSP(bf16_t, WS_OA);
        if (sub & 1) for (;;) {
            __syncthreads();
            if (C.tid == 0) *qslot = (int)atomicAdd(qctr, 1u);
            __syncthreads();
            const int j = __builtin_amdgcn_readfirstlane(*qslot);
            if (j >= 64) break;
            const int qb = 31 - (j >> 1), st = grp + 8 * (j & 1), b = st >> 3, h = (st >> 1) & 3, mp = st & 1;
            const LAS float* bth = (const LAS float*)(C.lds + AT_BT) + h * BT_STR;
            attn_nat::attn_unit<8>(b, qb, qk, qk, vv, oa, h * 128 + mp * 64, 512 + h * 128 + mp * 64, h * 128, mp * 512 + h * 128, bth, C.ldsg); }
    }
#else
    if (sub & 1) for (int v = C.vcu; v < 256; v += C.G) { const int bvh = v >> 3, s = v & 7, b = bvh >> 4, vh = bvh & 15, h = vh >> 2, mp = (vh >> 1) & 1, vhf = vh & 1;
        const attn_body::bf16* qk = (const attn_body::bf16*)WSP(const bf16_t, WS_PROJ); const attn_body::bf16* vv = (const attn_body::bf16*)WSP(const bf16_t, WS_PROJ + PROJ_STRIDE);
        attn_body::bf16* oa = (attn_body::bf16*)WSP(bf16_t, WS_OA);
        const LAS float* bth = (const LAS float*)(C.lds + AT_BT) + h * BT_STR;
#pragma unroll 1
        for (int i = 0; i < 4; ++i) { const int qb = (i == 0) ? s : (i == 1) ? 15 - s : (i == 2) ? 16 + s : 31 - s;
            attn_body::attn_unit<8>(b, qb, qk, qk, vv, oa, h * 128 + mp * 64, 512 + h * 128 + mp * 64, h * 128 + vhf * 64, mp * 512 + h * 128 + vhf * 64, bth, C.ldsg); } }
#endif
#endif
    LAS int* pre = (LAS int*)(C.lds + AT_MISC);
    LAS int* wtot = pre + 1032;
    const unsigned* cnt = WSP(const unsigned, WS_CTL) + CW_MCNT;
    if (gate && C.tid == 0) { unsigned* gd = WSP(unsigned, WS_CTL) + CW_GDONE; unsigned* tmo = WSP(unsigned, WS_CTL) + CW_TMO; unsigned sp = 0u;
        while (xb_ld(gd) < (unsigned)C.G) { __builtin_amdgcn_s_sleep(2); if ((++sp & 255u) == 0u) { if (xb_ld(tmo)) break; if (sp > XB_SPIN_CAP) { atomicAdd(tmo, 1u); break; } } }
        __builtin_amdgcn_fence(__ATOMIC_ACQUIRE, "agent"); asm volatile("s_waitcnt vmcnt(0)" ::: "memory"); }
    __syncthreads();
    { const int L = 2 * C.tid; const int n0_ = ((int)__hip_atomic_load(cnt + L, RLX_AGENT) + 127) >> 7, n1_ = ((int)__hip_atomic_load(cnt + L + 1, RLX_AGENT) + 127) >> 7; const int nch = n0_ + n1_;
        int inc = nch;
#pragma unroll
        for (int o = 1; o < 64; o <<= 1) { const int t = __shfl_up(inc, o); if (C.lane >= o) inc += t; }
        if (C.lane == 63) wtot[C.wave] = inc;
        __syncthreads();
        int base = 0;
        for (int w = 0; w < C.wave; ++w) base += wtot[w];
        pre[L] = base + inc - nch; pre[L + 1] = base + inc - nch + n0_;
        if (C.tid == 511) pre[1024] = base + inc;
    }
    __syncthreads();
    if (sub & 2) moba_phase(C, pre, cnt, sub >> 2);
    __syncthreads();
}
__device__ __forceinline__ void p5_ycombine(const Ctx& C0) {
    PHASE_IDS();
    const int gw = C.vcu * NWAVES + C.wave, NGW = C.G * NWAVES;
    const bf16_t* po = WSP(const bf16_t, WS_PO); const float* pml = WSP(const float, WS_PML); bf16_t* y = WSP(bf16_t, WS_Y);
#if !SIMPLE_DIFF
    {
        const float lam = expf(wave_sum(C.in[7][C.lane] * C.in[8][C.lane])) - expf(wave_sum(C.in[9][C.lane] * C.in[10][C.lane])) + 0.2f;
        const bf16_t* oa = WSP(const bf16_t, WS_OA);
        const f32x4 g0 = *(const f32x4*)(C.in[11] + 8 * (C.lane & 15)), g1 = *(const f32x4*)(C.in[11] + 8 * (C.lane & 15) + 4);
        for (int m0 = gw; m0 < M; m0 += NGW) { const int m = XROW(m0); const u32x4 a = *(const u32x4*)(oa + (size_t)m * 1024 + 8 * C.lane), b2 = *(const u32x4*)(oa + (size_t)m * 1024 + 512 + 8 * C.lane);
            float v[8];
            v[0] = bf_lo(a.x) - lam * bf_lo(b2.x); v[1] = bf_hi(a.x) - lam * bf_hi(b2.x); v[2] = bf_lo(a.y) - lam * bf_lo(b2.y); v[3] = bf_hi(a.y) - lam * bf_hi(b2.y);
            v[4] = bf_lo(a.z) - lam * bf_lo(b2.z); v[5] = bf_hi(a.z) - lam * bf_hi(b2.z); v[6] = bf_lo(a.w) - lam * bf_lo(b2.w); v[7] = bf_hi(a.w) - lam * bf_hi(b2.w);
            float ss = 0.f;
#pragma unroll
            for (int k = 0; k < 8; ++k) ss += v[k] * v[k];
            ss += __shfl_xor(ss, 1); ss += __shfl_xor(ss, 2); ss += __shfl_xor(ss, 4); ss += __shfl_xor(ss, 8);
            const float r = 0.8f / sqrtf(ss * (1.0f / 128.0f) + RMS_EPS);
            u32x4 w; w.x = pk2(v[0] * r * g0[0], v[1] * r * g0[1]); w.y = pk2(v[2] * r * g0[2], v[3] * r * g0[3]); w.z = pk2(v[4] * r * g1[0], v[5] * r * g1[1]); w.w = pk2(v[6] * r * g1[2], v[7] * r * g1[3]);
            *(u32x4*)(y + (size_t)m * 1024 + 8 * C.lane) = w; }
    }
#endif
    for (int m0 = gw; m0 < M; m0 += NGW) { const int m = XROW(m0); const int h = C.lane >> 3, dch = C.lane & 7; const int own = (m & (SEQ - 1)) >> 8, nsel = own < 3 ? own : 3;
        const size_t s0 = ((size_t)m * 8 + h) * 4;
        float mm[4], ll[4]; u32x4 ov[4];
#pragma unroll
        for (int j = 0; j < 4; ++j) { const bool use = (j == 3) || (j < nsel);
            if (use) { const f32x2 ml = *(const f32x2*)(pml + (s0 + j) * 2); mm[j] = ml[0]; ll[j] = ml[1]; ov[j] = *(const u32x4*)(po + (s0 + j) * 64 + 8 * dch); }
            else { mm[j] = -INFINITY; ll[j] = 0.f; ov[j] = (u32x4){0u, 0u, 0u, 0u}; } }
        const float mx = fmaxf(fmaxf(mm[0], mm[1]), fmaxf(mm[2], mm[3]));
        float den = 0.f; float acc[8];
#pragma unroll
        for (int k = 0; k < 8; ++k) acc[k] = 0.f;
#pragma unroll
        for (int j = 0; j < 4; ++j) { const float w = __builtin_amdgcn_exp2f(mm[j] - mx); den += w * ll[j];
            acc[0] += w * bf_lo(ov[j].x); acc[1] += w * bf_hi(ov[j].x); acc[2] += w * bf_lo(ov[j].y); acc[3] += w * bf_hi(ov[j].y);
            acc[4] += w * bf_lo(ov[j].z); acc[5] += w * bf_hi(ov[j].z); acc[6] += w * bf_lo(ov[j].w); acc[7] += w * bf_hi(ov[j].w); }
        const float r = 1.0f / den;
        u32x4 w; w.x = pk2(acc[0] * r, acc[1] * r); w.y = pk2(acc[2] * r, acc[3] * r); w.z = pk2(acc[4] * r, acc[5] * r); w.w = pk2(acc[6] * r, acc[7] * r);
        *(u32x4*)(y + (size_t)m * 1024 + 512 + h * 64 + 8 * dch) = w; }
}
__device__ __forceinline__ void p8_router(const Ctx& C0) {
    PHASE_IDS();
    LAS float* MA = (LAS float*)(C.lds + LDSCTL_OFF + 2048); LAS float* MB = MA + 2048;
    LAS int* hist = (LAS int*)(C.lds + LDSCTL_OFF + 2048 + 16384);
    LAS float* xch = (LAS float*)(C.lds + LDSCTL_OFF + 2048 + 16384 + 256);
    for (int idx = C.tid; idx < 2048; idx += 512) { const int b = idx >> 10, col = idx & 1023; const float* af = WSP(const float, WS_ADAF) + b * 6144;
        MA[idx] = C.in[15][col] * (1.0f + af[4096 + col]); MB[idx] = af[3072 + col]; }
    if (C.tid < 32) hist[C.tid] = 0;
    __syncthreads();
    for (int blk = (C.G == 256 ? C.vcu : (int)blockIdx.x); blk < M / 64; blk += C.G) {
        const int r0 = 64 * blk, b = r0 >= SEQ;
        {
            u32x4 xr[8][2];
#pragma unroll
            for (int r = 0; r < 8; ++r)
#pragma unroll
                for (int j = 0; j < 2; ++j) xr[r][j] = *(const u32x4*)(WSP(const bf16_t, WS_X1) + (size_t)(r0 + 8 * C.wave + r) * D + 512 * j + 8 * C.lane);
#pragma unroll
            for (int r = 0; r < 8; ++r) { const int lr = 8 * C.wave + r, m = r0 + lr; const LAS float* ma = MA + b * 1024; const LAS float* mb = MB + b * 1024;
                float v[16]; float s = 0.f;
#pragma unroll
                for (int j = 0; j < 2; ++j) { const u32x4 w = xr[r][j];
                    v[8 * j + 0] = bf_lo(w.x); v[8 * j + 1] = bf_hi(w.x); v[8 * j + 2] = bf_lo(w.y); v[8 * j + 3] = bf_hi(w.y); v[8 * j + 4] = bf_lo(w.z); v[8 * j + 5] = bf_hi(w.z); v[8 * j + 6] = bf_lo(w.w); v[8 * j + 7] = bf_hi(w.w); }
#pragma unroll
                for (int k = 0; k < 16; ++k) s += v[k] * v[k];
                const float rstd = 1.0f / sqrtf(wave_sum(s) * (1.0f / D) + RMS_EPS);
                float am = 0.f;
#pragma unroll
                for (int j = 0; j < 2; ++j) { const LAS float* a = ma + 512 * j + 8 * C.lane; const LAS float* bb = mb + 512 * j + 8 * C.lane;
                    const f32x4 a0 = *(const LAS f32x4*)a, a1 = *(const LAS f32x4*)(a + 4), b0 = *(const LAS f32x4*)bb, b1 = *(const LAS f32x4*)(bb + 4);
#pragma unroll
                    for (int k = 0; k < 4; ++k) { v[8 * j + k] = v[8 * j + k] * rstd * a0[k] + b0[k]; v[8 * j + 4 + k] = v[8 * j + 4 + k] * rstd * a1[k] + b1[k]; }
#pragma unroll
                    for (int k = 0; k < 8; ++k) am = fmaxf(am, fabsf(v[8 * j + k]));
                    u32x4 w; w.x = pk2(v[8 * j + 0], v[8 * j + 1]); w.y = pk2(v[8 * j + 2], v[8 * j + 3]); w.z = pk2(v[8 * j + 4], v[8 * j + 5]); w.w = pk2(v[8 * j + 6], v[8 * j + 7]);
                    *(LAS u32x4*)(C.lds + lr * 2048 + (((64 * j + C.lane) ^ (lr & 15)) << 4)) = w; }
#pragma unroll
                for (int o = 1; o < 64; o <<= 1) am = fmaxf(am, __shfl_xor(am, o));
                const float inv = am > 0.f ? 127.0f / am : 0.f;
                if (C.lane == 0) WSP(float, WS_SA)[m] = am > 0.f ? am * (1.0f / 127.0f) : 1.0f;
                signed char* qrow = (signed char*)(C.ws + WS_H2Q) + (size_t)m * D;
#pragma unroll
                for (int j = 0; j < 2; ++j) { unsigned w2[2];
#pragma unroll
                    for (int d = 0; d < 2; ++d) { int b4[4];
#pragma unroll
                        for (int k = 0; k < 4; ++k) b4[k] = (int)fminf(fmaxf(__builtin_rintf(v[8 * j + 4 * d + k] * inv), -127.0f), 127.0f);
                        w2[d] = (unsigned)(b4[0] & 255) | ((unsigned)(b4[1] & 255) << 8) | ((unsigned)(b4[2] & 255) << 16) | ((unsigned)b4[3] << 24); }
                    *(u32x2*)(qrow + 512 * j + 8 * C.lane) = (u32x2){w2[0], w2[1]}; } }
        }
        __syncthreads();
        const int lane = C.lane, c = lane & 15, g = lane >> 4, rq = C.wave & 3, kh = C.wave >> 2; const int rb = r0 + 16 * rq;
        f32x4 lg[2]; lg[0] = (f32x4){0.f, 0.f, 0.f, 0.f}; lg[1] = lg[0];
        { const bf16_t* wt = WSP(const bf16_t, WS_WRT) + (size_t)c * 1024 + 8 * g + 512 * kh; const LAS unsigned char* arow = C.lds + (16 * rq + c) * 2048;
#pragma unroll 8
            for (int ks = 0; ks < 16; ++ks) { const bf16x8 a = *(const LAS bf16x8*)(arow + ((((64 * kh + 4 * ks + g)) ^ c) << 4));
#pragma unroll
                for (int nt = 0; nt < 2; ++nt) { const bf16x8 w = *(const bf16x8*)(wt + (size_t)nt * 16 * 1024 + 32 * ks);
                    lg[nt] = __builtin_amdgcn_mfma_f32_16x16x32_bf16(a, w, lg[nt], 0, 0, 0); } } }
        if (kh == 1) { *(LAS f32x4*)(xch + (rq * 64 + lane) * 8) = lg[0]; *(LAS f32x4*)(xch + (rq * 64 + lane) * 8 + 4) = lg[1]; }
        __syncthreads();
        if (kh == 0) { lg[0] += *(const LAS f32x4*)(xch + (rq * 64 + lane) * 8); lg[1] += *(const LAS f32x4*)(xch + (rq * 64 + lane) * 8 + 4);
            const float br0 = C.in[17][c], br1 = C.in[17][16 + c];
#pragma unroll
            for (int i = 0; i < 4; ++i) { float a0 = lg[0][i] + br0, a1 = lg[1][i] + br1; float tv[4]; int ti[4];
#pragma unroll
                for (int k = 0; k < 4; ++k) { float bv; int bi; if (a1 > a0) { bv = a1; bi = 16 + c; } else { bv = a0; bi = c; }
#pragma unroll
                    for (int o = 1; o < 16; o <<= 1) { const float ov = __shfl_xor(bv, o); const int oi = __shfl_xor(bi, o); if (ov > bv || (ov == bv && oi < bi)) { bv = ov; bi = oi; } }
                    tv[k] = bv; ti[k] = bi; if (bi == c) a0 = -INFINITY; if (bi == 16 + c) a1 = -INFINITY; }
                if (c == 0) { const int row = rb + 4 * g + i; const float e1 = __expf(tv[1] - tv[0]), e2 = __expf(tv[2] - tv[0]), e3 = __expf(tv[3] - tv[0]); const float inv = 1.0f / (1.0f + e1 + e2 + e3);
                    *(int4*)(WSP(int, WS_TOPI) + (size_t)row * 4) = make_int4(ti[0], ti[1], ti[2], ti[3]);
                    *(f32x4*)(WSP(float, WS_TOPW) + (size_t)row * 4) = (f32x4){inv, e1 * inv, e2 * inv, e3 * inv};
                    atomicAdd((int*)(hist + ti[0]), 1); atomicAdd((int*)(hist + ti[1]), 1); atomicAdd((int*)(hist + ti[2]), 1); atomicAdd((int*)(hist + ti[3]), 1); } }
        }
        __syncthreads();
        if (C.tid < 32) { WSP(int, WS_HIST)[blk * 32 + C.tid] = hist[C.tid]; hist[C.tid] = 0; }
        __syncthreads();
    }
}
__device__ __forceinline__ void p9_slots(const Ctx& C0) {
    PHASE_IDS();
    LAS int* tot = (LAS int*)C.lds;
    LAS int* off = tot + 32;
    LAS int* cur = off + 40;
    const int* hist = WSP(const int, WS_HIST);
    for (int blk = blockIdx.x; blk < M / 64; blk += C.G) {
        __syncthreads();
        if (C.tid < 32) { int t = 0, p = 0; for (int w = 0; w < M / 64; ++w) { const int v = hist[w * 32 + C.tid]; t += v; p += (w < blk) ? v : 0; } tot[C.tid] = t; cur[C.tid] = p; }
        __syncthreads();
        if (C.tid == 0) { int o = 0; for (int e = 0; e < 32; ++e) { off[e] = o; o += (tot[e] + 255) & ~255; } off[32] = o; }
        __syncthreads();
        if (C.tid < 32) cur[C.tid] += off[C.tid];
        __syncthreads();
        if (C.tid < 256) { const int token = 64 * blk + (C.tid >> 2), k = C.tid & 3; const int e = WSP(const int, WS_TOPI)[token * 4 + k];
            const int slot = atomicAdd((int*)(cur + e), 1);
            WSP(int, WS_SLOTTOK)[slot] = token; WSP(float, WS_SLOTW)[slot] = WSP(const float, WS_TOPW)[token * 4 + k]; WSP(int, WS_TOKSLOT)[token * 4 + k] = slot; WSP(float, WS_SLOTSA)[slot] = WSP(const float, WS_SA)[token]; }
        if (blk < 32) { const int e = blk; for (int s = off[e] + tot[e] + C.tid; s < off[e + 1]; s += 512) { WSP(int, WS_SLOTTOK)[s] = 0; WSP(float, WS_SLOTW)[s] = 0.f; WSP(float, WS_SLOTSA)[s] = 0.f; } }
        if (blk == 0 && C.tid < 33) WSP(int, WS_EOFF)[C.tid] = off[C.tid];
    }
    __syncthreads();
}
__device__ __forceinline__ void p12_final(const Ctx& C0) {
    PHASE_IDS();
    const int gw = C.vcu * NWAVES + C.wave, NGW = C.G * NWAVES;
    const bf16_t* so = WSP(const bf16_t, WS_SOUT); const bf16_t* x1 = WSP(const bf16_t, WS_X1); const int* ts = WSP(const int, WS_TOKSLOT);
    for (int m = gw; m < M; m += NGW) { const float* gt = WSP(const float, WS_ADAF) + (m >= SEQ ? 6144 : 0) + 5120;
        const int4 sl = *(const int4*)(ts + (size_t)m * 4);
        f32x4 v[4]; float s = 0.f;
#pragma unroll
        for (int j = 0; j < 4; ++j) { const int col = 4 * C.lane + 256 * j; f32x4 a = (f32x4){0.f, 0.f, 0.f, 0.f};
            { const u32x2 w = *(const u32x2*)(so + (size_t)sl.x * 1024 + col); a[0] += bf_lo(w.x); a[1] += bf_hi(w.x); a[2] += bf_lo(w.y); a[3] += bf_hi(w.y); }
            { const u32x2 w = *(const u32x2*)(so + (size_t)sl.y * 1024 + col); a[0] += bf_lo(w.x); a[1] += bf_hi(w.x); a[2] += bf_lo(w.y); a[3] += bf_hi(w.y); }
            { const u32x2 w = *(const u32x2*)(so + (size_t)sl.z * 1024 + col); a[0] += bf_lo(w.x); a[1] += bf_hi(w.x); a[2] += bf_lo(w.y); a[3] += bf_hi(w.y); }
            { const u32x2 w = *(const u32x2*)(so + (size_t)sl.w * 1024 + col); a[0] += bf_lo(w.x); a[1] += bf_hi(w.x); a[2] += bf_lo(w.y); a[3] += bf_hi(w.y); }
            { const u32x2 xw = *(const u32x2*)(x1 + (size_t)m * D + col); const f32x4 xv = (f32x4){bf_lo(xw.x), bf_hi(xw.x), bf_lo(xw.y), bf_hi(xw.y)}; v[j] = xv + *(const f32x4*)(gt + col) * a; }
            s += (v[j][0] * v[j][0] + v[j][1] * v[j][1]) + (v[j][2] * v[j][2] + v[j][3] * v[j][3]); }
        const float rstd = 1.0f / sqrtf(wave_sum(s) * (1.0f / D) + RMS_EPS);
#pragma unroll
        for (int j = 0; j < 4; ++j) { const int col = 4 * C.lane + 256 * j; *(f32x4*)(C.out + (size_t)m * D + col) = v[j] * rstd * *(const f32x4*)(C.in[22] + col); } }
}

constexpr int CW_GRP = 118000;
__device__ __forceinline__ void grp_barrier(const XcdBarrier& b, unsigned* gwd, unsigned n, volatile LAS unsigned* mode) {
    asm volatile("s_waitcnt vmcnt(0)" ::: "memory");
    __syncthreads();
    if (threadIdx.x == 0) {
        __builtin_amdgcn_s_waitcnt(0);
        unsigned md = mode[0];
        if (md == 0u) { md = (xb_ld(gwd + 128) + xb_ld(gwd + 192) == 17u) ? 1u : 2u; mode[0] = md; }
        if (md != 1u) { __builtin_amdgcn_fence(__ATOMIC_RELEASE, "agent"); asm volatile("s_waitcnt vmcnt(0)" ::: "memory"); }
        const unsigned old = xb_add(gwd, 1u); const unsigned gen = old / n;
        if (old + 1u == (gen + 1u) * n) xb_add(gwd + 64, 1u);
        else XB_SPIN(xb_ld(gwd + 64) == gen, b.bar);
        __builtin_amdgcn_fence(__ATOMIC_ACQUIRE, "agent");
        asm volatile("s_waitcnt vmcnt(0)" ::: "memory");
    }
    __syncthreads();
}
struct Args { const float* in[23]; float* out; unsigned char* ws; int ph_lo, ph_hi, li, pad; };
constexpr int N_PHASES = 13;
#ifndef MK_N_LAUNCHES
#define MK_N_LAUNCHES 1
#endif

__global__ void __launch_bounds__(NWAVES * 64, 2) mega_fwd(Args args) {
    extern __shared__ __attribute__((aligned(16))) unsigned char lds_raw[];
    Ctx C;
    C.lds = (LAS unsigned char*)lds_raw; C.ldsg = (char*)lds_raw;
    C.tid = threadIdx.x; C.lane = C.tid & 63; C.wave = __builtin_amdgcn_readfirstlane(C.tid >> 6);
    C.G = gridDim.x; { const int bx = blockIdx.x; C.vcu = (C.G % 8 == 0) ? (bx % 8) * (C.G / 8) + bx / 8 : bx; }
#pragma unroll
    for (int i = 0; i < 23; ++i) C.in[i] = args.in[i];
    C.out = args.out; C.ws = args.ws;
    volatile LAS unsigned* MISC = (volatile LAS unsigned*)(C.lds + MISC_OFF);
    for (int u = C.tid; u < (LDS_BYTES - LDSCTL_OFF) / 4; u += NWAVES * 64) ((LAS unsigned*)(C.lds + LDSCTL_OFF))[u] = 0u;
    __syncthreads();
    unsigned* ctl = (unsigned*)(C.ws + WS_CTL);
    XcdBarrier bar = xcd_barrier_post(ctl + CW_BAR + args.li * XCD_BAR_WORDS, MISC + 8);
    unsigned* gwd = ctl + CW_GRP + 256 * ((int)blockIdx.x & 7);
    if (threadIdx.x == 0) { const unsigned xc = xb_xcc_id(); __hip_atomic_fetch_max(gwd + 128, xc + 1u, __ATOMIC_RELAXED, __HIP_MEMORY_SCOPE_AGENT); __hip_atomic_fetch_max(gwd + 192, 16u - xc, __ATOMIC_RELAXED, __HIP_MEMORY_SCOPE_AGENT); }
    const bool gloc = (C.G == 256) && (MK_N_LAUNCHES == 1);
    const int lo = args.ph_lo, hi = args.ph_hi;
#define IN(k) (lo <= (k) && (k) < hi)
#define SEAM(k) do { if (IN(k) && IN((k) + 1)) xcd_barrier(bar); } while (0)
#define SEAMG(k) do { if (gloc) grp_barrier(bar, gwd, 32u, MISC + 12); else xcd_barrier(bar); } while (0)
#ifndef PROBE_REP
#define PROBE_REP -1
#endif
#define REPS(k) (((k) == PROBE_REP) ? 2 : 1)
#define DUP(k, ...) do { __VA_ARGS__; if (REPS(k) == 2) { __VA_ARGS__; } } while (0)

    if (IN(0)) { DUP(0, p0_prologue(C)); } SEAM(0);
    if (IN(1)) { DUP(30, p1_h1(C)); } SEAMG(1);
    if (IN(2)) {
        { pg8::DenseSched S; S.init(M, 1024, C.G, (int)blockIdx.x, WSP(bf16_t, WS_WIN), 1024); S.pn_base = 6; pg8::EpiProj E{WSP(bf16_t, WS_PROJ), WSP(float, WS_KMEAN)};
          DUP(2, pg8::gemm_phase<pg8::EpiProj, pg8::DenseSched, true>(C.lds, WSP(bf16_t, WS_H), 1024, 1024, 1024, S, E)); }
        { pg8::DenseSched S; S.init(M, INW - 1024, C.G, (int)blockIdx.x, C.ws + WS_WINQ, 512); S.pn_skip_at = 6; S.pn_skip = 4; pg8::EpiProjQ E{WSP(bf16_t, WS_PROJ), WSP(const float, WS_SA), WSP(const float, WS_SWIN)};
          DUP(2, pg8::gemm_phase<pg8::EpiProjQ, pg8::DenseSched, true, true>(C.lds, C.ws + WS_H2Q, 512, 512, 512, S, E)); }
    } if (IN(2) && IN(5)) xcd_barrier(bar);
    if (IN(5)) { p4_attention(C, 3 | (3 << 2), true); if (REPS(5) == 2) p4_attention(C, PROBE_SUB, false); } SEAM(5);
    if (IN(6)) { DUP(30, p5_ycombine(C)); } SEAMG(6);
    if (IN(7)) { pg8::DenseSched S; S.init(M, D, C.G, (int)blockIdx.x, WSP(bf16_t, WS_WBR), 1024); pg8::EpiBr E{WSP(const bf16_t, WS_PROJ + 3 * PROJ_STRIDE), WSP(const bf16_t, WS_PROJ + 4 * PROJ_STRIDE), WSP(bf16_t, WS_MERGED)};
        DUP(31, pg8::gemm_phase<pg8::EpiBr, pg8::DenseSched, true>(C.lds, WSP(bf16_t, WS_Y), 1024, 1024, 1024, S, E)); } SEAMG(7);
    if (IN(9)) { pg8::DenseSched S; S.init(M, D, C.G, (int)blockIdx.x, WSP(bf16_t, WS_WOUT), 1024); pg8::EpiOut E{C.in[0], WSP(const float, WS_ADAF), WSP(bf16_t, WS_X1)};
        DUP(32, pg8::gemm_phase<pg8::EpiOut, pg8::DenseSched, true>(C.lds, WSP(bf16_t, WS_MERGED), 1024, 1024, 1024, S, E)); } SEAMG(9);
    if (IN(10)) { DUP(30, p8_router(C)); } SEAM(10);
    if (IN(11)) { DUP(33, p9_slots(C)); } SEAM(11);
    if (IN(12)) {
        LAS int* te = (LAS int*)(C.lds + RING_BYTES + 64);
        if (C.tid < 33) te[C.tid] = WSP(const int, WS_EOFF)[C.tid] >> 8;
        __syncthreads();
        unsigned* tdone = (unsigned*)(C.ws + WS_CTL) + CW_TDONE; unsigned* tmo = (unsigned*)(C.ws + WS_CTL) + CW_TMO;
        { pg8::MoeSched<true, false, false> S{te, 8, C.G, (int)blockIdx.x, WSP(const int, WS_SLOTTOK), (const char*)(C.ws + WS_WGU), (size_t)2048 * 1024, (size_t)256 * 1024, tdone, tmo};
          pg8::EpiGUQ E{C.in[19], WSP(const float, WS_SW), WSP(const float, WS_SLOTSA), WSP(bf16_t, WS_ACT)};
          DUP(20, pg8::gemm_phase<pg8::EpiGUQ, pg8::MoeSched<true, false, false>, true, true>(C.lds, C.ws + WS_H2Q, 512, 512, 512, S, E)); }
        xcd_barrier(bar);
        { pg8::MoeSched<false, false, false, true> S{te, 4, C.G, (int)blockIdx.x, nullptr, (const char*)WSP(bf16_t, WS_WD), (size_t)1024 * 1024 * 2, (size_t)256 * 1024 * 2, tdone, tmo};
          pg8::EpiDown E{C.in[21], WSP(const float, WS_SLOTW), WSP(bf16_t, WS_SOUT)};
          DUP(21, pg8::gemm_phase<pg8::EpiDown, pg8::MoeSched<false, false, false, true>, true>(C.lds, WSP(bf16_t, WS_ACT), 1024, 1024, 1024, S, E)); }
        xcd_barrier(bar);
        DUP(30, p12_final(C));
    }
#undef IN
#undef SEAM
}

extern "C" void kernel_launch(void* const* d_in, const int* in_sizes, int n_in, void* d_out, int out_size, void* d_ws, size_t ws_size, hipStream_t stream) {
    static int grid = 0;
    if (grid == 0) {
        if (n_in != 23 || in_sizes[0] != M * D || out_size != M * D || ws_size < WS_END) { fprintf(stderr, "kernel_launch: unexpected shapes (n_in %d, in0 %d, out %d, ws %zu); nothing launched\n", n_in, n_in > 0 ? in_sizes[0] : -1, out_size, ws_size); grid = -1; return; }
        int dev = 0, cus = 0, per_cu = 0;
        if (hipGetDevice(&dev) != hipSuccess || hipDeviceGetAttribute(&cus, hipDeviceAttributeMultiprocessorCount, dev) != hipSuccess) { grid = -1; return; }
        if (hipFuncSetAttribute((const void*)mega_fwd, hipFuncAttributeMaxDynamicSharedMemorySize, LDS_BYTES) != hipSuccess) { fprintf(stderr, "kernel_launch: hipFuncSetAttribute failed\n"); grid = -1; return; }
        if (hipOccupancyMaxActiveBlocksPerMultiprocessor(&per_cu, (const void*)mega_fwd, NWAVES * 64, LDS_BYTES) != hipSuccess || per_cu < 1) { fprintf(stderr, "kernel_launch: occupancy query reports %d workgroups per CU\n", per_cu); }
        (void)hipGetLastError();
        grid = cus;
    }
    if (grid < 0) return;
    if (hipMemsetAsync((char*)d_ws + WS_CTL, 0, CTL_ZERO_BYTES, stream) != hipSuccess) { fprintf(stderr, "kernel_launch: memset failed\n"); return; }
    Args a{};
    for (int i = 0; i < 23; ++i) a.in[i] = (const float*)d_in[i];
    a.out = (float*)d_out; a.ws = (unsigned char*)d_ws;
    constexpr int NL = MK_N_LAUNCHES;
    for (int li = 0; li < NL; ++li) {
        a.ph_lo = (NL == 1) ? 0 : li; a.ph_hi = (NL == 1) ? N_PHASES : li + 1; a.li = (NL == 1) ? 0 : li; a.pad = 0;
        hipLaunchKernelGGL(mega_fwd, dim3(grid), dim3(NWAVES * 64), LDS_BYTES, stream, a);
        const hipError_t le = hipPeekAtLastError();
        if (le != hipSuccess) { fprintf(stderr, "kernel_launch: launch %d failed: %s\n", li, hipGetErrorName(le)); break; }
    }
}
```

```cpp
#include <hip/hip_runtime.h>
#include <cstdio>
#include <cstdint>
#ifndef SIMPLE_DIFF
#define SIMPLE_DIFF 0
#endif
#ifndef NATIVE_DIFF
#define NATIVE_DIFF 1
#endif

#define GAS __attribute__((address_space(1)))
#define LAS __attribute__((address_space(3)))
typedef unsigned short bf16_t;
typedef short bf16x8 __attribute__((ext_vector_type(8)));
typedef short s16x4 __attribute__((ext_vector_type(4)));
typedef float f32x4 __attribute__((ext_vector_type(4)));
typedef float f32x2 __attribute__((ext_vector_type(2)));
typedef unsigned u32x4 __attribute__((ext_vector_type(4)));
typedef unsigned u32x2 __attribute__((ext_vector_type(2)));
typedef int i32x4 __attribute__((ext_vector_type(4)));
#define RLX_AGENT __ATOMIC_RELAXED, __HIP_MEMORY_SCOPE_AGENT
#define LDS_WAIT() asm volatile("s_waitcnt lgkmcnt(0)" ::: "memory")
#define VM_WAIT() asm volatile("s_waitcnt vmcnt(0)" ::: "memory")

constexpr int BATCH = 2, SEQ = 8192, M = BATCH * SEQ, D = 1024, INW = 5120;
constexpr int NE = 32, TOPK = 4;
constexpr int NWAVES = 8;
constexpr float RMS_EPS = 1e-5f;
constexpr float LOG2E = 1.4426950408889634f;
constexpr float C2 = 0.125f * LOG2E;
constexpr int SLOT_ROWS = M * TOPK + NE * 256;

constexpr size_t MiB = 1u << 20, KiB = 1u << 10;
constexpr size_t WS_CTL = 0, CTL_ZERO_BYTES = 1 * MiB;
constexpr size_t WS_ADAP = 1 * MiB;
constexpr size_t WS_ADAF = 1 * MiB + 896 * KiB;
constexpr size_t WS_KMEAN = 512 * KiB;
constexpr size_t WS_TOPI = 2 * MiB + 256 * KiB;
constexpr size_t WS_TOPW = 2 * MiB + 512 * KiB;
constexpr size_t WS_TOKSLOT = 2 * MiB + 768 * KiB;
constexpr size_t WS_SLOTTOK = 3 * MiB;
constexpr size_t WS_SLOTW = 3 * MiB + 512 * KiB;
constexpr size_t WS_HIST = 4 * MiB;
constexpr size_t WS_EOFF = 4 * MiB + 64 * KiB;
constexpr size_t WS_WRT = 4 * MiB + 128 * KiB;
constexpr size_t WS_SLOTSA = 4 * MiB + 256 * KiB;
constexpr size_t WS_SW = 5 * MiB;
constexpr size_t WS_SWIN = 5 * MiB + 640 * KiB;
constexpr size_t WS_SA = 5 * MiB + 512 * KiB;
constexpr size_t WS_LIST = 6 * MiB;
constexpr size_t WS_PML = 14 * MiB;
constexpr size_t WS_WIN = 18 * MiB, WS_WBR = 28 * MiB, WS_WOUT = 30 * MiB, WS_WGU = 32 * MiB, WS_WD = 160 * MiB;
constexpr size_t WS_H = 224 * MiB;
constexpr size_t WS_PROJ = 256 * MiB;
constexpr size_t PROJ_STRIDE = 32 * MiB;
constexpr size_t WS_Y = 416 * MiB;
constexpr size_t WS_PO = 448 * MiB;
constexpr size_t WS_H2Q = 512 * MiB;
constexpr size_t WS_MERGED = 576 * MiB;
constexpr size_t WS_X1 = 608 * MiB;
constexpr size_t WS_ACT = 672 * MiB;
constexpr size_t WS_SOUT = 816 * MiB;
constexpr size_t WS_OA = 960 * MiB;
constexpr size_t WS_WINQ = 992 * MiB;
constexpr size_t WS_END = 1000 * MiB;
constexpr int LIST_PER_BH = 126976;
constexpr int CW_TMO = 0, CW_CODE = 1, CW_BAR = 4096, CW_MCNT = 65536, CW_TDONE = 80000, CW_AQ = 110000, CW_GDONE = 121000;

constexpr int RING_BYTES = 131072, LDSCTL_OFF = RING_BYTES, MISC_OFF = LDSCTL_OFF + 320, LDS_BYTES = 163840;

__device__ __forceinline__ unsigned f2bf(float f) { unsigned u = __builtin_bit_cast(unsigned, f); return (u + 0x7fffu + ((u >> 16) & 1u)) >> 16; }
__device__ __forceinline__ unsigned pk2(float lo, float hi) { return f2bf(lo) | (f2bf(hi) << 16); }
__device__ __forceinline__ unsigned cvt_pk_bf16(float lo, float hi) { unsigned r; asm volatile("v_cvt_pk_bf16_f32 %0, %1, %2" : "=v"(r) : "v"(lo), "v"(hi)); return r; }
__device__ __forceinline__ float bf_lo(unsigned u) { return __builtin_bit_cast(float, u << 16); }
__device__ __forceinline__ float bf_hi(unsigned u) { return __builtin_bit_cast(float, u & 0xffff0000u); }
__device__ __forceinline__ float sigmoidf_fast(float v) { return __builtin_amdgcn_rcpf(1.0f + __builtin_amdgcn_exp2f(-v * LOG2E)); }
__device__ __forceinline__ float wave_sum(float v) {
#pragma unroll
    for (int o = 1; o < 64; o <<= 1) v += __shfl_xor(v, o);
    return v;
}

namespace pg8 {
constexpr int BM = 256, BK = 64, HALF = 128, HTB = HALF * BK * 2, STAGE_BYTES = 8 * HTB, NXCD = 8, WGM = 8;
__device__ __forceinline__ int lds_byte(int r, int c) { const int st = (r >> 4) * 2 + (c >> 5), rr = r & 15, cc = c & 31, ob = rr * 64 + cc * 2; return st * 1024 + (ob ^ (((ob >> 9) & 1) << 5)); }
__device__ __forceinline__ void stage_rc(int b, int& R, int& C) { const int st = b / 1024, sb = b % 1024, swz = sb ^ (((sb >> 9) & 1) << 5); R = (st >> 1) * 16 + swz / 64; C = (st & 1) * 32 + (swz % 64) / 2; }
__device__ __forceinline__ int perm32(int rho) { const int n = rho >> 4, i = rho & 15; return 8 * (i >> 2) + 4 * n + (i & 3); }

struct Unit { int row0; int pm, pn, e, half; const char* bptr; };

struct DenseSched {
    static constexpr bool HAS_READY = false, HAS_DONE = false;
    int nM, nN, nwg, G, c; const char* Bt; size_t btile;
    int pn_base = 0, pn_skip_at = 1 << 30, pn_skip = 0;
    __device__ __forceinline__ void init(int M_, int N_, int G_, int c_, const void* Bt_, int ldb) { nM = M_ / BM; nN = N_ / BM; nwg = nM * nN; G = G_; c = c_; Bt = (const char*)Bt_; btile = (size_t)BM * ldb * 2; }
    __device__ __forceinline__ bool next(int i, Unit& u) const {
        const long L = (long)i * G + c; if (L >= nwg) return false;
        int wgid = (int)L; { const int q = nwg / NXCD, r = nwg % NXCD, xcd = wgid % NXCD, off = wgid / NXCD; wgid = (xcd < r ? xcd * (q + 1) : r * (q + 1) + (xcd - r) * q) + off; }
        const int nig = WGM * nN, gid = wgid / nig, fm = gid * WGM, gsz = (nM - fm) < WGM ? (nM - fm) : WGM;
        u.pm = fm + ((wgid % nig) % gsz); { const int pl = (wgid % nig) / gsz; u.pn = pn_base + pl + (pl >= pn_skip_at ? pn_skip : 0); } u.row0 = u.pm * BM; u.e = 0; u.half = 0; u.bptr = Bt + (size_t)u.pn * btile; return true;
    }
    __device__ __forceinline__ int arow(const Unit& u, int r) const { return u.row0 + r; }
    __device__ __forceinline__ void a_ready(const Unit&) const {}
    __device__ __forceinline__ void done(int) const {}
};

template <bool I8> struct AccSel { typedef f32x4 T; };
template <> struct AccSel<true> { typedef i32x4 T; };
template <class Epi, class Sched, bool ALIGN_EPI, bool I8 = false>
__device__ __forceinline__ void gemm_phase(LAS unsigned char* lds, const void* Abase_, int lda, int ldb, int K, const Sched& S, const Epi& E) {
    int tid_ = threadIdx.x; asm volatile("" : "+v"(tid_));
    const int tid = tid_, wid = __builtin_amdgcn_readfirstlane(tid >> 6), lane = tid & 63, wr = wid >> 2, wc = wid & 3, fr = lane & 15, fq = lane >> 4;
    const int nt = K / BK;
    const char* Abase = (const char*)Abase_;
    int Rr[2], Cc[2]; unsigned voffB[2];
#pragma unroll
    for (int i = 0; i < 2; ++i) { stage_rc(tid * 16 + i * 8192, Rr[i], Cc[i]); const int Rb = Epi::PERM ? ((Rr[i] & ~31) + perm32(Rr[i] & 31)) : Rr[i]; voffB[i] = (unsigned)(Rb * ldb + Cc[i]) * 2u; }
    const size_t kstep = (size_t)(BK * 2);
    const size_t hstepB = (size_t)HALF * ldb * 2;
    const unsigned ldsw = (unsigned)wid * 1024u;
    const int aoff = lds_byte(wr * 64 + fr, fq * 8), boff = lds_byte(wc * 32 + fr, fq * 8);
#define PG8_SA(b, h) (((b) * 2 + (h)) * HTB)
#define PG8_SB(b, h) ((4 + (b) * 2 + (h)) * HTB)
#define PG8_STAGE(bufoff, gbase, voff) do { _Pragma("unroll") for (int _i = 0; _i < 2; ++_i) \
        __builtin_amdgcn_global_load_lds((const unsigned*)((const char*)(gbase) + (voff)[_i]), (LAS unsigned*)(lds + (bufoff) + ldsw + _i * 8192), 16, 0, 0); } while (0)
#define PG8_LDA(dst, b, h) do { _Pragma("unroll") for (int m = 0; m < 4; ++m) _Pragma("unroll") for (int k = 0; k < 2; ++k) dst[m][k] = *(const LAS bf16x8*)(lds + PG8_SA(b, h) + aoff + m * 2048 + k * 1024); } while (0)
#define PG8_LDB(dst, b, h) do { _Pragma("unroll") for (int n = 0; n < 2; ++n) _Pragma("unroll") for (int k = 0; k < 2; ++k) dst[n][k] = *(const LAS bf16x8*)(lds + PG8_SB(b, h) + boff + n * 2048 + k * 1024); } while (0)
#define PG8_MMA(ai, bj, At, Bt) do { __builtin_amdgcn_s_setprio(1); _Pragma("unroll") for (int m = 0; m < 4; ++m) _Pragma("unroll") for (int n = 0; n < 2; ++n) _Pragma("unroll") for (int k = 0; k < 2; ++k) { \
        if constexpr (I8) acc[ai][bj][m][n] = __builtin_amdgcn_mfma_i32_16x16x64_i8(__builtin_bit_cast(i32x4, Bt[n][k]), __builtin_bit_cast(i32x4, At[m][k]), acc[ai][bj][m][n], 0, 0, 0); \
        else acc[ai][bj][m][n] = __builtin_amdgcn_mfma_f32_16x16x32_bf16(Bt[n][k], At[m][k], acc[ai][bj][m][n], 0, 0, 0); } __builtin_amdgcn_s_setprio(0); } while (0)
#define PG8_WAIT_V(n) asm volatile("s_waitcnt vmcnt(" #n ")" ::: "memory")
#define PG8_WAIT_L(n) asm volatile("s_waitcnt lgkmcnt(" #n ")" ::: "memory")
#define PG8_BAR __builtin_amdgcn_s_barrier()
#define PG8_SCHED __builtin_amdgcn_sched_barrier(0)
#define PG8_ROWS(u, va) do { _Pragma("unroll") for (int _h = 0; _h < 2; ++_h) _Pragma("unroll") for (int _i = 0; _i < 2; ++_i) \
        va[_h][_i] = (unsigned)(S.arow(u, _h * HALF + Rr[_i]) * lda + Cc[_i]) * 2u; } while (0)
    Unit cur, nxt; int ui = 0; int prev_pm = -1;
    if (!S.next(0, cur)) return;
    unsigned vaC[2][2], vaN[2][2];
    PG8_ROWS(cur, vaC);
    typedef typename AccSel<I8>::T acc_t;
    acc_t acc[2][2][4][2];
#pragma unroll
    for (int a = 0; a < 2; ++a)
#pragma unroll
        for (int b = 0; b < 2; ++b)
#pragma unroll
            for (int m = 0; m < 4; ++m)
#pragma unroll
                for (int n = 0; n < 2; ++n) acc[a][b][m][n] = (acc_t){0, 0, 0, 0};
    bf16x8 At[4][2], B0[2][2], B1[2][2];
    const char* cB = cur.bptr;
    if constexpr (Sched::HAS_READY) S.a_ready(cur);
    PG8_STAGE(PG8_SB(0, 0), cB, voffB); PG8_STAGE(PG8_SB(0, 1), cB + hstepB, voffB); PG8_STAGE(PG8_SA(0, 0), Abase, vaC[0]); PG8_STAGE(PG8_SA(0, 1), Abase, vaC[1]);
    if (wr == 1) PG8_BAR;
    PG8_WAIT_V(2); PG8_BAR;
    PG8_STAGE(PG8_SB(1, 0), cB + kstep, voffB); PG8_STAGE(PG8_SA(1, 0), Abase + kstep, vaC[0]); PG8_STAGE(PG8_SB(1, 1), cB + hstepB + kstep, voffB);
    PG8_WAIT_V(6); PG8_BAR;
    for (;;) {
        const bool has_next = S.next(ui + 1, nxt);
        if (has_next) { PG8_ROWS(nxt, vaN); } else { nxt = cur;
#pragma unroll
            for (int h = 0; h < 2; ++h)
#pragma unroll
                for (int i = 0; i < 2; ++i) vaN[h][i] = vaC[h][i]; }
        const char* nB = nxt.bptr;
        for (int t = 0; t < nt; t += 2) {
            if constexpr (Epi::HAS_MID) { if (t == (nt >> 1)) E.mid(acc, cur, wr, wc, fr, fq); }
            const bool last = (t == nt - 2);
            if constexpr (Sched::HAS_DONE) { if (last && prev_pm >= 0) { S.done(prev_pm); prev_pm = -1; } }
            if constexpr (Sched::HAS_READY) { if (last && has_next) S.a_ready(nxt); }
            const char* a1 = Abase + (size_t)(t + 1) * kstep;
            const char* a2 = last ? Abase : Abase + (size_t)(t + 2) * kstep; const char* b2 = last ? nB : cB + (size_t)(t + 2) * kstep;
            const char* a3 = a2 + kstep; const char* b3 = b2 + kstep;
            unsigned v2[2][2];
#pragma unroll
            for (int h = 0; h < 2; ++h)
#pragma unroll
                for (int i = 0; i < 2; ++i) v2[h][i] = last ? vaN[h][i] : vaC[h][i];
            PG8_LDB(B0, 0, 0); PG8_LDB(B1, 0, 1); PG8_SCHED; PG8_LDA(At, 0, 0); PG8_STAGE(PG8_SA(1, 1), a1, vaC[1]);
            PG8_WAIT_V(8); PG8_WAIT_L(0); PG8_BAR; PG8_MMA(0, 0, At, B0); PG8_MMA(0, 1, At, B1); PG8_BAR; PG8_SCHED;
            PG8_LDA(At, 0, 1); PG8_STAGE(PG8_SB(0, 0), b2, voffB); PG8_STAGE(PG8_SB(0, 1), b2 + hstepB, voffB); PG8_STAGE(PG8_SA(0, 0), a2, v2[0]);
            PG8_WAIT_V(8); PG8_WAIT_L(0); PG8_BAR; if (!cur.half) { PG8_MMA(1, 0, At, B0); PG8_MMA(1, 1, At, B1); } PG8_BAR; PG8_SCHED;
            PG8_LDB(B0, 1, 0); PG8_LDB(B1, 1, 1); PG8_SCHED; PG8_LDA(At, 1, 0); PG8_STAGE(PG8_SA(0, 1), a2, v2[1]);
            PG8_WAIT_V(8); PG8_WAIT_L(0); PG8_BAR; PG8_MMA(0, 0, At, B0); PG8_MMA(0, 1, At, B1); PG8_BAR; PG8_SCHED;
            PG8_LDA(At, 1, 1); PG8_STAGE(PG8_SB(1, 0), b3, voffB); PG8_STAGE(PG8_SB(1, 1), b3 + hstepB, voffB); PG8_STAGE(PG8_SA(1, 0), a3, v2[0]);
            PG8_WAIT_V(8); PG8_WAIT_L(0); PG8_BAR; if (!cur.half) { PG8_MMA(1, 0, At, B0); PG8_MMA(1, 1, At, B1); } PG8_BAR; PG8_SCHED;
        }
        if constexpr (ALIGN_EPI) { if (wr == 0) PG8_BAR; }
        E(acc, cur, wr, wc, fr, fq); if constexpr (Sched::HAS_DONE) prev_pm = cur.pm;
        if (!has_next) break;
#pragma unroll
        for (int a = 0; a < 2; ++a)
#pragma unroll
            for (int b = 0; b < 2; ++b)
#pragma unroll
                for (int m = 0; m < 4; ++m)
#pragma unroll
                    for (int n = 0; n < 2; ++n) acc[a][b][m][n] = (acc_t){0, 0, 0, 0};
        cur = nxt; cB = nB; ++ui;
#pragma unroll
        for (int h = 0; h < 2; ++h)
#pragma unroll
            for (int i = 0; i < 2; ++i) vaC[h][i] = vaN[h][i];
        if constexpr (ALIGN_EPI) { if (wr == 1) PG8_BAR; }
    }
    PG8_WAIT_V(0);
    if constexpr (Sched::HAS_DONE) { if (prev_pm >= 0) S.done(prev_pm); }
    if constexpr (!ALIGN_EPI) { if (wr == 0) PG8_BAR; }
    PG8_BAR;
#undef PG8_SA
#undef PG8_SB
#undef PG8_STAGE
#undef PG8_LDA
#undef PG8_LDB
#undef PG8_MMA
#undef PG8_WAIT_V
#undef PG8_WAIT_L
#undef PG8_BAR
#undef PG8_SCHED
#undef PG8_ROWS
}
}
#define XB_TMO      128
#define XB_XCNT(j)  (256  + 64 * (j))
#define XB_XSUB(j)  (1280 + 64 * (j))
#define XB_XGEN(j)  (2304 + 64 * (j))
#define XB_TOP      3328
#define XB_TOPGEN   3392
#define XCD_BAR_WORDS 3456
#define XB_SPIN_CAP (1u << 18)

__device__ __forceinline__ unsigned xb_ld(unsigned* p)              { return __hip_atomic_load(p, __ATOMIC_RELAXED, __HIP_MEMORY_SCOPE_AGENT); }
__device__ __forceinline__ unsigned xb_add(unsigned* p, unsigned v) { return __hip_atomic_fetch_add(p, v, __ATOMIC_RELAXED, __HIP_MEMORY_SCOPE_AGENT); }
__device__ __forceinline__ unsigned xb_xcc_id() { return (unsigned)__builtin_amdgcn_s_getreg((3 << 11) | 20) & 0xFu; }
#define XB_SPIN(cond, bar) do { unsigned _sp = 0; while (cond) { __builtin_amdgcn_s_sleep(1); \
    if ((++_sp & 255u) == 0u) { if (xb_ld(&(bar)[XB_TMO])) break; if (_sp > XB_SPIN_CAP) { atomicAdd(&(bar)[XB_TMO], 1u); break; } } } } while (0)

struct XcdBarrier {
    unsigned* bar; unsigned x;
    volatile LAS unsigned* st;
};

__device__ __forceinline__ XcdBarrier xcd_barrier_post(unsigned* bar, volatile LAS unsigned* st) {
    XcdBarrier b; b.bar = bar; b.x = xb_xcc_id(); b.st = st;
    if (threadIdx.x == 0) (void)xb_add(&bar[XB_XCNT(b.x)], 1u);
    return b;
}
__device__ __forceinline__ void xcd_barrier_complete(unsigned* bar, unsigned x, unsigned& nloc, unsigned& nx) {
    const unsigned G = gridDim.x * gridDim.y * gridDim.z;
    unsigned sum, cnt, mine, sp = 0u;
    for (;;) {
        sum = 0u; cnt = 0u; mine = 0u;
#pragma unroll
        for (unsigned j = 0; j < 16; ++j) { const unsigned c = xb_ld(&bar[XB_XCNT(j)]); sum += c; cnt += (c > 0u) ? 1u : 0u; mine = (j == x) ? c : mine; }
        if (sum == G) break;
        __builtin_amdgcn_s_sleep(1);
        if ((++sp & 255u) == 0u) { if (xb_ld(&bar[XB_TMO])) break; if (sp > XB_SPIN_CAP) { atomicAdd(&bar[XB_TMO], 1u); break; } }
    }
    nloc = mine > 0u ? mine : 1u; nx = cnt > 0u ? cnt : 1u;
}

__device__ __forceinline__ void xcd_barrier(const XcdBarrier& b) {
    asm volatile("s_waitcnt vmcnt(0)" ::: "memory");
    __syncthreads();
    if (threadIdx.x == 0) {
        unsigned* bar = b.bar;
        __builtin_amdgcn_s_waitcnt(0);
        unsigned nloc = b.st[0], nx = b.st[1];
        if (nloc == 0u) { xcd_barrier_complete(bar, b.x, nloc, nx); b.st[0] = nloc; b.st[1] = nx; }
        const unsigned old = xb_add(&bar[XB_XSUB(b.x)], 1u);
        const unsigned gen = old / nloc;
        if (old + 1u == (gen + 1u) * nloc) {
            __builtin_amdgcn_fence(__ATOMIC_RELEASE, "agent");
            asm volatile("s_waitcnt vmcnt(0)" ::: "memory");
            const unsigned og = xb_add(&bar[XB_TOP], 1u);
            const unsigned tg = og / nx;
            if (og + 1u == (tg + 1u) * nx) xb_add(&bar[XB_TOPGEN], 1u);
            else XB_SPIN(xb_ld(&bar[XB_TOPGEN]) == tg, bar);
            __builtin_amdgcn_fence(__ATOMIC_ACQUIRE, "agent");
            xb_add(&bar[XB_XGEN(b.x)], 1u);
            asm volatile("s_waitcnt vmcnt(0)" ::: "memory");
        } else {
            XB_SPIN(xb_ld(&bar[XB_XGEN(b.x)]) == gen, bar);
            __builtin_amdgcn_fence(__ATOMIC_ACQUIRE, "agent");
            asm volatile("s_waitcnt vmcnt(0)" ::: "memory");
        }
    }
    __syncthreads();
}
namespace pg8 {
struct EpiProj {
    static constexpr bool PERM = true, HAS_MID = false;
    bf16_t* base; float* kmean;
    __device__ __forceinline__ void operator()(const f32x4 (&acc)[2][2][4][2], const Unit& u, int wr, int wc, int fr, int fq) const {
        if (u.pn == 8 || u.pn == 9) {
            const int b = u.pm >> 5, nblk = u.pm & 31;
#pragma unroll
            for (int bj = 0; bj < 2; ++bj)
#pragma unroll
                for (int n = 0; n < 2; ++n) { f32x4 s = (f32x4){0.f, 0.f, 0.f, 0.f};
#pragma unroll
                    for (int ai = 0; ai < 2; ++ai)
#pragma unroll
                        for (int m = 0; m < 4; ++m) s += acc[ai][bj][m][n];
#pragma unroll
                    for (int j = 0; j < 4; ++j) { float v = s[j]; v += __shfl_xor(v, 1); v += __shfl_xor(v, 2); v += __shfl_xor(v, 4); v += __shfl_xor(v, 8); s[j] = v; }
                    if (fr == 0) { const int col = (u.pn - 8) * 256 + bj * HALF + wc * 32 + 8 * fq + 4 * n; const int h = col >> 6, d = col & 63; float* kp = kmean + ((size_t)((b * 8 + h) * 32 + nblk)) * 64 + d;
#pragma unroll
                        for (int j = 0; j < 4; ++j) atomicAdd(kp + j, s[j] * (1.0f / 256.0f)); } }
        }
        const int buf = u.pn >> 2, colt = (u.pn & 3) * 256;
        const float sc = (u.pn < 2 || u.pn == 6 || u.pn == 7) ? C2 : 1.0f;
        bf16_t* dst = base + (size_t)buf * (PROJ_STRIDE / 2);
        const int row0 = u.row0 + wr * 64 + fr, col0 = colt + wc * 32 + 8 * fq;
#pragma unroll
        for (int ai = 0; ai < 2; ++ai)
#pragma unroll
            for (int m = 0; m < 4; ++m) { bf16_t* rowp = dst + (size_t)(row0 + ai * HALF + m * 16) * 1024 + col0;
#pragma unroll
                for (int bj = 0; bj < 2; ++bj) { const f32x4 v0 = acc[ai][bj][m][0] * sc, v1 = acc[ai][bj][m][1] * sc;
                    u32x4 w; w.x = cvt_pk_bf16(v0[0], v0[1]); w.y = cvt_pk_bf16(v0[2], v0[3]); w.z = cvt_pk_bf16(v1[0], v1[1]); w.w = cvt_pk_bf16(v1[2], v1[3]);
                    *(u32x4*)(rowp + bj * HALF) = w; } }
    }
};
struct EpiProjQ {
    static constexpr bool PERM = true, HAS_MID = false;
    bf16_t* base; const float* sa; const float* sw;
    __device__ __forceinline__ void operator()(const i32x4 (&acc)[2][2][4][2], const Unit& u, int wr, int wc, int fr, int fq) const {
        const int buf = u.pn >> 2, colt = (u.pn & 3) * 256;
        const float sc = (u.pn < 2) ? C2 : 1.0f;
        bf16_t* dst = base + (size_t)buf * (PROJ_STRIDE / 2);
        const int row0 = u.row0 + wr * 64 + fr, col0 = colt + wc * 32 + 8 * fq;
        const float* swp = sw + u.pn * 256 + wc * 32 + 8 * fq;
        f32x4 sv[2][2];
#pragma unroll
        for (int bj = 0; bj < 2; ++bj)
#pragma unroll
            for (int n = 0; n < 2; ++n) sv[bj][n] = *(const f32x4*)(swp + bj * HALF + 4 * n) * sc;
#pragma unroll
        for (int ai = 0; ai < 2; ++ai)
#pragma unroll
            for (int m = 0; m < 4; ++m) { const int row = row0 + ai * HALF + m * 16; const float ts = sa[row]; bf16_t* rowp = dst + (size_t)row * 1024 + col0;
#pragma unroll
                for (int bj = 0; bj < 2; ++bj) { const i32x4 a0 = acc[ai][bj][m][0], a1 = acc[ai][bj][m][1];
                    const f32x4 v0 = (f32x4){(float)a0[0], (float)a0[1], (float)a0[2], (float)a0[3]} * (sv[bj][0] * ts), v1 = (f32x4){(float)a1[0], (float)a1[1], (float)a1[2], (float)a1[3]} * (sv[bj][1] * ts);
                    u32x4 w; w.x = cvt_pk_bf16(v0[0], v0[1]); w.y = cvt_pk_bf16(v0[2], v0[3]); w.z = cvt_pk_bf16(v1[0], v1[1]); w.w = cvt_pk_bf16(v1[2], v1[3]);
                    *(u32x4*)(rowp + bj * HALF) = w; } }
    }
};
struct EpiBr {
    static constexpr bool PERM = true, HAS_MID = true;
    const bf16_t* gla; const bf16_t* glb; bf16_t* out;
    __device__ __forceinline__ void mid(f32x4 (&acc)[2][2][4][2], const Unit& u, int wr, int wc, int fr, int fq) const {
        int row0 = u.row0 + wr * 64 + fr, col0 = u.pn * 256 + wc * 32 + 8 * fq; asm volatile("" : "+v"(row0), "+v"(col0));
#pragma unroll
        for (int ai = 0; ai < 2; ++ai)
#pragma unroll
            for (int m = 0; m < 4; ++m) { const size_t ro = (size_t)(row0 + ai * HALF + m * 16) * 1024 + col0;
#pragma unroll
                for (int bj = 0; bj < 2; ++bj) { const u32x4 ga = *(const u32x4*)(gla + ro + bj * HALF), gb = *(const u32x4*)(glb + ro + bj * HALF);
                    f32x4 r0, r1;
#define RT2(R, I, GA, GB) do { f32x2 ea = (f32x2){bf_lo(GA), bf_hi(GA)} * (f32x2){-LOG2E, -LOG2E}, eb = (f32x2){bf_lo(GB), bf_hi(GB)} * (f32x2){-LOG2E, -LOG2E}; \
                        ea[0] = __builtin_amdgcn_exp2f(ea[0]); ea[1] = __builtin_amdgcn_exp2f(ea[1]); eb[0] = __builtin_amdgcn_exp2f(eb[0]); eb[1] = __builtin_amdgcn_exp2f(eb[1]); \
                        ea = ea + (f32x2){1.0f, 1.0f}; eb = eb + (f32x2){1.0f, 1.0f}; ea[0] = __builtin_amdgcn_rcpf(ea[0]); ea[1] = __builtin_amdgcn_rcpf(ea[1]); const f32x2 q_ = eb * ea; R[I] = q_[0]; R[I + 1] = q_[1]; } while (0)
                    RT2(r0, 0, ga.x, gb.x); RT2(r0, 2, ga.y, gb.y); RT2(r1, 0, ga.z, gb.z); RT2(r1, 2, ga.w, gb.w);
#undef RT2
                    acc[ai][bj][m][0] *= r0; acc[ai][bj][m][1] *= r1; } }
    }
    __device__ __forceinline__ void operator()(const f32x4 (&acc)[2][2][4][2], const Unit& u, int wr, int wc, int fr, int fq) const {
        int row0 = u.row0 + wr * 64 + fr, col0 = u.pn * 256 + wc * 32 + 8 * fq; asm volatile("" : "+v"(row0), "+v"(col0));
#pragma unroll
        for (int ai = 0; ai < 2; ++ai)
#pragma unroll
            for (int m = 0; m < 4; ++m) { const size_t ro = (size_t)(row0 + ai * HALF + m * 16) * 1024 + col0;
#pragma unroll
                for (int bj = 0; bj < 2; ++bj) { const u32x4 g = *(const u32x4*)(glb + ro + bj * HALF); const f32x4 v0 = acc[ai][bj][m][0], v1 = acc[ai][bj][m][1];
#define SG2(G, VA, VB) ({ f32x2 e_ = (f32x2){bf_lo(G), bf_hi(G)} * (f32x2){-LOG2E, -LOG2E}; e_[0] = __builtin_amdgcn_exp2f(e_[0]); e_[1] = __builtin_amdgcn_exp2f(e_[1]); e_ = e_ + (f32x2){1.0f, 1.0f}; \
                        e_[0] = __builtin_amdgcn_rcpf(e_[0]); e_[1] = __builtin_amdgcn_rcpf(e_[1]); e_ = e_ * (f32x2){VA, VB}; cvt_pk_bf16(e_[0], e_[1]); })
                    u32x4 w; w.x = SG2(g.x, v0[0], v0[1]); w.y = SG2(g.y, v0[2], v0[3]); w.z = SG2(g.z, v1[0], v1[1]); w.w = SG2(g.w, v1[2], v1[3]);
#undef SG2
                    *(u32x4*)(out + ro + bj * HALF) = w; } }
    }
};
struct EpiOut {
    static constexpr bool PERM = true, HAS_MID = false;
    const float* x; const float* adaf; bf16_t* x1;
    __device__ __forceinline__ void operator()(const f32x4 (&acc)[2][2][4][2], const Unit& u, int wr, int wc, int fr, int fq) const {
        const int row0 = u.row0 + wr * 64 + fr, col0 = u.pn * 256 + wc * 32 + 8 * fq;
        const float* gt = adaf + (u.row0 >= SEQ ? 6144 : 0) + 2048;
        f32x4 gv[2][2];
#pragma unroll
        for (int bj = 0; bj < 2; ++bj)
#pragma unroll
            for (int n = 0; n < 2; ++n) gv[bj][n] = *(const f32x4*)(gt + col0 + bj * HALF + 4 * n);
#pragma unroll
        for (int ai = 0; ai < 2; ++ai)
#pragma unroll
            for (int m = 0; m < 4; ++m) { const size_t ro = (size_t)(row0 + ai * HALF + m * 16) * 1024 + col0;
#pragma unroll
                for (int bj = 0; bj < 2; ++bj) { const f32x4 x0 = *(const f32x4*)(x + ro + bj * HALF), x4 = *(const f32x4*)(x + ro + bj * HALF + 4);
                    const f32x4 v0 = x0 + gv[bj][0] * acc[ai][bj][m][0], v1 = x4 + gv[bj][1] * acc[ai][bj][m][1];
                    u32x4 w; w.x = cvt_pk_bf16(v0[0], v0[1]); w.y = cvt_pk_bf16(v0[2], v0[3]); w.z = cvt_pk_bf16(v1[0], v1[1]); w.w = cvt_pk_bf16(v1[2], v1[3]);
                    *(u32x4*)(x1 + ro + bj * HALF) = w; } }
    }
};
struct EpiGU {
    static constexpr bool PERM = true, HAS_MID = false;
    const float* bgu; bf16_t* act;
    __device__ __forceinline__ void operator()(const f32x4 (&acc)[2][2][4][2], const Unit& u, int wr, int wc, int fr, int fq) const {
        const int row0 = u.row0 + wr * 64 + fr, col0 = u.pn * 128 + wc * 32 + 8 * fq;
        const float* bg = bgu + (size_t)u.e * 2048 + col0;
        f32x4 bgv[2], buv[2];
#pragma unroll
        for (int n = 0; n < 2; ++n) { bgv[n] = *(const f32x4*)(bg + 4 * n); buv[n] = *(const f32x4*)(bg + 1024 + 4 * n); }
#pragma unroll
        for (int ai = 0; ai < 2; ++ai)
#pragma unroll
            for (int m = 0; m < 4; ++m) { float r[8];
#pragma unroll
                for (int n = 0; n < 2; ++n)
#pragma unroll
                    for (int j = 0; j < 4; ++j) { const float gte = fminf(acc[ai][0][m][n][j] + bgv[n][j], 7.0f); const float up = fminf(fmaxf(acc[ai][1][m][n][j] + buv[n][j], -7.0f), 7.0f);
                        r[4 * n + j] = (up + 1.0f) * gte * sigmoidf_fast(1.702f * gte); }
                u32x4 w; w.x = cvt_pk_bf16(r[0], r[1]); w.y = cvt_pk_bf16(r[2], r[3]); w.z = cvt_pk_bf16(r[4], r[5]); w.w = cvt_pk_bf16(r[6], r[7]);
                *(u32x4*)(act + (size_t)(row0 + ai * HALF + m * 16) * 1024 + col0) = w; }
    }
};
struct EpiGUQ {
    static constexpr bool PERM = true, HAS_MID = false;
    const float* bgu; const float* sw; const float* slot_sa; bf16_t* act;
    __device__ __forceinline__ void operator()(const i32x4 (&acc)[2][2][4][2], const Unit& u, int wr, int wc, int fr, int fq) const {
        const int row0 = u.row0 + wr * 64 + fr, col0 = u.pn * 128 + wc * 32 + 8 * fq;
        const float* bg = bgu + (size_t)u.e * 2048 + col0; const float* sg = sw + (size_t)u.e * 2048 + col0;
        f32x4 bgv[2], buv[2], sgv[2], suv[2];
#pragma unroll
        for (int n = 0; n < 2; ++n) { bgv[n] = *(const f32x4*)(bg + 4 * n); buv[n] = *(const f32x4*)(bg + 1024 + 4 * n); sgv[n] = *(const f32x4*)(sg + 4 * n); suv[n] = *(const f32x4*)(sg + 1024 + 4 * n); }
#pragma unroll
        for (int ai = 0; ai < 2; ++ai)
#pragma unroll
            for (int m = 0; m < 4; ++m) { if (ai == 1 && u.half) continue; const int row = row0 + ai * HALF + m * 16; const float ts = slot_sa[row]; unsigned r[4];
#pragma unroll
                for (int n = 0; n < 2; ++n)
#pragma unroll
                    for (int h = 0; h < 2; ++h) { const int j = 2 * h;
                        const f32x2 ag = (f32x2){(float)acc[ai][0][m][n][j], (float)acc[ai][0][m][n][j + 1]}, au = (f32x2){(float)acc[ai][1][m][n][j], (float)acc[ai][1][m][n][j + 1]};
                        const f32x2 tsv = (f32x2){ts, ts};
                        f32x2 g = ag * ((f32x2){sgv[n][j], sgv[n][j + 1]} * tsv) + (f32x2){bgv[n][j], bgv[n][j + 1]};
                        f32x2 up = au * ((f32x2){suv[n][j], suv[n][j + 1]} * tsv) + (f32x2){buv[n][j], buv[n][j + 1]};
                        g[0] = fminf(g[0], 7.0f); g[1] = fminf(g[1], 7.0f); up[0] = fminf(fmaxf(up[0], -7.0f), 7.0f); up[1] = fminf(fmaxf(up[1], -7.0f), 7.0f);
                        f32x2 e = g * (f32x2){-1.702f * LOG2E, -1.702f * LOG2E};
                        e[0] = __builtin_amdgcn_exp2f(e[0]); e[1] = __builtin_amdgcn_exp2f(e[1]);
                        e = e + (f32x2){1.0f, 1.0f};
                        e[0] = __builtin_amdgcn_rcpf(e[0]); e[1] = __builtin_amdgcn_rcpf(e[1]);
                        const f32x2 o = (up + (f32x2){1.0f, 1.0f}) * (g * e);
                        r[2 * n + h] = cvt_pk_bf16(o[0], o[1]); }
                u32x4 w; w.x = r[0]; w.y = r[1]; w.z = r[2]; w.w = r[3];
                *(u32x4*)(act + (size_t)row * 1024 + col0) = w; }
    }
};
struct EpiDown {
    static constexpr bool PERM = true, HAS_MID = false;
    const float* bd; const float* slotw; bf16_t* out;
    __device__ __forceinline__ void operator()(const f32x4 (&acc)[2][2][4][2], const Unit& u, int wr, int wc, int fr, int fq) const {
        const int row0 = u.row0 + wr * 64 + fr, col0 = u.pn * 256 + wc * 32 + 8 * fq;
        const float* bp = bd + (size_t)u.e * 1024 + col0;
        f32x4 bv[2][2];
#pragma unroll
        for (int bj = 0; bj < 2; ++bj)
#pragma unroll
            for (int n = 0; n < 2; ++n) bv[bj][n] = *(const f32x4*)(bp + bj * HALF + 4 * n);
#pragma unroll
        for (int ai = 0; ai < 2; ++ai)
#pragma unroll
            for (int m = 0; m < 4; ++m) { if (ai == 1 && u.half) continue; const int row = row0 + ai * HALF + m * 16; const float w8 = slotw[row]; bf16_t* rowp = out + (size_t)row * 1024 + col0;
#pragma unroll
                for (int bj = 0; bj < 2; ++bj) { const f32x4 v0 = (acc[ai][bj][m][0] + bv[bj][0]) * w8, v1 = (acc[ai][bj][m][1] + bv[bj][1]) * w8;
                    u32x4 w; w.x = cvt_pk_bf16(v0[0], v0[1]); w.y = cvt_pk_bf16(v0[2], v0[3]); w.z = cvt_pk_bf16(v1[0], v1[1]); w.w = cvt_pk_bf16(v1[2], v1[3]);
                    *(u32x4*)(rowp + bj * HALF) = w; } }
    }
};
template <bool GATHER, bool WAIT, bool SIGNAL, bool SPLIT = false> struct MoeSched {
    static constexpr bool HAS_READY = WAIT, HAS_DONE = SIGNAL;
    const LAS int* te; int NP, G, c; const int* slot_tok; const char* W; size_t wstride, btile; unsigned* tdone; unsigned* tmo;
    __device__ __forceinline__ bool next(int i, Unit& u) const {
        const int ntl = te[32], nwg = ntl * NP;
        const int rounds = (nwg + G - 1) / G, rem = nwg - (rounds - 1) * G; const bool split = SPLIT && 2 * rem <= G;
        long L = (long)i * G + c; int half = 0, hsel = 0;
        if (split && i == rounds - 1) { if (c >= 2 * rem) return false; L = (long)i * G + (c >> 1); half = 1; hsel = c & 1; }
        if (L >= nwg) return false;
        int wgid = (int)L; { const int q = nwg / NXCD, r = nwg % NXCD, xcd = wgid % NXCD, off = wgid / NXCD; wgid = (xcd < r ? xcd * (q + 1) : r * (q + 1) + (xcd - r) * q) + off; }
        int e = 0;
        for (int k = 1; k < NE; ++k) e += (wgid >= te[k] * NP) ? 1 : 0;
        const int t0 = te[e], nte = te[e + 1] - t0, r_ = wgid - t0 * NP; const int pn = r_ / nte, t = t0 + r_ % nte;
        u.row0 = t * 256 + hsel * 128; u.pn = pn; u.pm = t; u.e = e; u.half = half; u.bptr = W + (size_t)e * wstride + (size_t)pn * btile; return true;
    }
    __device__ __forceinline__ int arow(const Unit& u, int r) const { if (u.half) r &= 127; if constexpr (GATHER) return slot_tok[u.row0 + r]; else return u.row0 + r; }
    __device__ __forceinline__ void a_ready(const Unit& u) const {
        if constexpr (WAIT) {
            if (threadIdx.x < 64) {
                const unsigned long long t0 = __builtin_amdgcn_s_memrealtime(); unsigned polls = 0;
                while ((unsigned)__builtin_amdgcn_readfirstlane(__hip_atomic_load(tdone + 64 * u.pm, __ATOMIC_RELAXED, __HIP_MEMORY_SCOPE_AGENT)) < 64u) {
                    if ((++polls & 255u) == 0u && __builtin_amdgcn_readfirstlane(__hip_atomic_load(tmo, __ATOMIC_RELAXED, __HIP_MEMORY_SCOPE_AGENT)) != 0u) break;
                    if (__builtin_amdgcn_s_memrealtime() - t0 > 2000000ull) { if (threadIdx.x == 0) __hip_atomic_store(tmo, 1u, __ATOMIC_RELAXED, __HIP_MEMORY_SCOPE_AGENT); break; }
                    __builtin_amdgcn_s_sleep(2); }
                __builtin_amdgcn_fence(__ATOMIC_ACQUIRE, "agent");
                asm volatile("s_waitcnt vmcnt(0)" ::: "memory");
            }
            asm volatile("" ::: "memory"); __builtin_amdgcn_s_barrier(); asm volatile("" ::: "memory");
        }
    }
    __device__ __forceinline__ void done(int pm) const {
        if constexpr (SIGNAL) {
            if ((threadIdx.x & 63) == 0) __hip_atomic_fetch_add(tdone + 64 * pm, 1u, __ATOMIC_RELAXED, __HIP_MEMORY_SCOPE_AGENT); }
    }
};
}

constexpr int BT_STR = 132;
constexpr int AT_BT = LDSCTL_OFF + 1024, AT_K = 0, AT_V = AT_K + 64 * 72 * 2, AT_MISC = LDSCTL_OFF + 8192;
typedef short v4i16_t __attribute__((ext_vector_type(4)));
__device__ __forceinline__ s16x4 tr16(const LAS unsigned char* p) { return __builtin_bit_cast(s16x4, __builtin_amdgcn_ds_read_tr16_b64_v4i16((LAS v4i16_t*)p)); }

template <int NDT>
__device__ __forceinline__ void attn_tile(const LAS unsigned char* lds, int lane, const bf16x8 (&qf)[2], f32x4 (&o)[NDT], float& m_run, float& l_run,
                                          int qpos, int kbase, bool causal, const LAS float* bt) {
    constexpr int VSTR = NDT * 16 + 8;
    const int c = lane & 15, g = lane >> 4;
    f32x4 s[4];
#pragma unroll
    for (int kt = 0; kt < 4; ++kt) { s[kt] = (f32x4){0.f, 0.f, 0.f, 0.f};
#pragma unroll
        for (int ks = 0; ks < 2; ++ks) { const bf16x8 a = *(const LAS bf16x8*)(lds + AT_K + ((16 * kt + c) * 72 + 32 * ks + 8 * g) * 2);
            s[kt] = __builtin_amdgcn_mfma_f32_16x16x32_bf16(a, qf[ks], s[kt], 0, 0, 0); } }
    if (__any((qpos - (kbase + 63)) < 128)) {
#pragma unroll
        for (int kt = 0; kt < 4; ++kt)
#pragma unroll
            for (int i = 0; i < 4; ++i) { const int dist = qpos - (kbase + 16 * kt + 4 * g + i); const int di = dist < 0 ? 0 : (dist > 127 ? 127 : dist);
                const float bv = bt[di]; float v = s[kt][i];
                if (dist >= 0 && dist < 128) v += bv;
                if (causal && dist < 0) v = -INFINITY;
                s[kt][i] = v; }
    }
    float mx = fmaxf(fmaxf(s[0][0], s[0][1]), fmaxf(s[0][2], s[0][3]));
#pragma unroll
    for (int kt = 1; kt < 4; ++kt) mx = fmaxf(mx, fmaxf(fmaxf(s[kt][0], s[kt][1]), fmaxf(s[kt][2], s[kt][3])));
    mx = fmaxf(mx, __shfl_xor(mx, 16)); mx = fmaxf(mx, __shfl_xor(mx, 32));
    const float m_new = fmaxf(m_run, mx), alpha = __builtin_amdgcn_exp2f(m_run - m_new);
    float psum = 0.f;
#pragma unroll
    for (int kt = 0; kt < 4; ++kt)
#pragma unroll
        for (int i = 0; i < 4; ++i) { const float p = __builtin_amdgcn_exp2f(s[kt][i] - m_new); s[kt][i] = p; psum += p; }
    l_run = l_run * alpha + psum; m_run = m_new;
#pragma unroll
    for (int i = 0; i < 4; ++i) { const float ai = __shfl(alpha, 4 * g + i);
#pragma unroll
        for (int dt = 0; dt < NDT; ++dt) o[dt][i] *= ai; }
    bf16x8 pa[2];
#pragma unroll
    for (int kk = 0; kk < 2; ++kk) { u32x4 w; w.x = cvt_pk_bf16(s[2 * kk][0], s[2 * kk][1]); w.y = cvt_pk_bf16(s[2 * kk][2], s[2 * kk][3]);
        w.z = cvt_pk_bf16(s[2 * kk + 1][0], s[2 * kk + 1][1]); w.w = cvt_pk_bf16(s[2 * kk + 1][2], s[2 * kk + 1][3]); pa[kk] = __builtin_bit_cast(bf16x8, w); }
    const LAS unsigned char* vb = lds + AT_V + ((4 * g + (c >> 2)) * VSTR + 4 * (c & 3)) * 2;
#pragma unroll
    for (int dt = 0; dt < NDT; ++dt)
#pragma unroll
        for (int kk = 0; kk < 2; ++kk) { const s16x4 lo = tr16(vb + (32 * kk * VSTR + 16 * dt) * 2), hi = tr16(vb + ((32 * kk + 16) * VSTR + 16 * dt) * 2);
            const bf16x8 b = (bf16x8){lo[0], lo[1], lo[2], lo[3], hi[0], hi[1], hi[2], hi[3]};
            o[dt] = __builtin_amdgcn_mfma_f32_16x16x32_bf16(pa[kk], b, o[dt], 0, 0, 0); }
}

template <int NV> struct TileRegs { u32x4 k; u32x4 v[NV]; };
template <int NV> __device__ __forceinline__ void tile_fetch(TileRegs<NV>& r, const bf16_t* kg, const bf16_t* vg, int tid) {
    const int row = tid >> 3, ch = tid & 7;
    r.k = *(const u32x4*)(kg + (size_t)row * 1024 + ch * 8);
#pragma unroll
    for (int i = 0; i < NV; ++i) r.v[i] = *(const u32x4*)(vg + (size_t)row * 1024 + (ch + 8 * i) * 8);
}
template <int NV> __device__ __forceinline__ void tile_store(const TileRegs<NV>& r, LAS unsigned char* lds, int tid) {
    constexpr int VSTR = NV * 64 + 8;
    const int row = tid >> 3, ch = tid & 7;
    *(LAS u32x4*)(lds + AT_K + (row * 72 + ch * 8) * 2) = r.k;
#pragma unroll
    for (int i = 0; i < NV; ++i) *(LAS u32x4*)(lds + AT_V + (row * VSTR + (ch + 8 * i) * 8) * 2) = r.v[i];
}
#include <hip/hip_bf16.h>
#include <cmath>
namespace attn_body {
using bf16=__hip_bfloat16;
using bf16x8=__attribute__((ext_vector_type(8)))short;
using s16x4=__attribute__((ext_vector_type(4)))short;
using f32x16=__attribute__((ext_vector_type(16)))float;
using u32x4=__attribute__((ext_vector_type(4)))unsigned;
constexpr int BATCH=2,NHEAD=16,SEQ=8192,D=64,DM=NHEAD*D;
constexpr int NW=8,QBLK=32,QB=QBLK*NW,KVBLK=64,NQB=SEQ/QB;
constexpr int ATTN_PITCH=DM, ATTN_UNIT_ROWS=QB;
__device__ __forceinline__ int crow(int r,int hi){return (r&3)+8*(r>>2)+4*hi;}
#define SBAR() __builtin_amdgcn_sched_barrier(0)
typedef const __attribute__((address_space(3))) float* lds_cfptr;
__device__ __forceinline__ void cbias(f32x16&p0,f32x16&p1,int jb,int qrel,int hi,lds_cfptr bt){
  const float NEG=-INFINITY; const int kb=64*jb+4*hi;
  #pragma unroll
  for(int r=0;r<16;++r){const int d0=qrel-(kb+(r&3)+8*(r>>2)),d1=d0-32;
    const unsigned c0=(unsigned)d0<128u?(unsigned)d0:128u,c1=(unsigned)d1<128u?(unsigned)d1:128u;
    const float v0=p0[r]+bt[c0],v1=p1[r]+bt[c1];
    p0[r]=d0<0?NEG:v0; p1[r]=d1<0?NEG:v1;}
}
constexpr int NSLOT=3, SLOTB=8192;
constexpr int LDS_K=0, LDS_V=NSLOT*SLOTB, LDS_WS=2*NSLOT*SLOTB, LDS_OST=LDS_WS+NW*64*4, LDS_BYTES=LDS_OST+NW*4096;
constexpr float C2=0.125f*1.4426950408889634f;
__device__ __forceinline__ void glds16(const void*gsrc,unsigned lds_dst){unsigned keep;
  asm volatile("s_mov_b32 %0, m0\n\ts_mov_b32 m0, %2\n\ts_nop 0\n\tglobal_load_lds_dwordx4 %1, off\n\ts_mov_b32 m0, %0":"=&s"(keep):"v"(gsrc),"s"(lds_dst):"memory");}
__device__ __forceinline__ float max3f(float a,float b,float c){float r;asm("v_max3_f32 %0, %1, %2, %3":"=v"(r):"v"(a),"v"(b),"v"(c));return r;}
__device__ __forceinline__ float max2f(float a,float b){float r;asm("v_max_f32_e32 %0, %1, %2":"=v"(r):"v"(a),"v"(b));return r;}
__device__ __forceinline__ float fadd_s(float a,float b){float r;asm("v_add_f32_e32 %0, %1, %2":"=v"(r):"v"(a),"v"(b));return r;}
__device__ __forceinline__ float fsub_s(float a,float b){float r;asm("v_sub_f32_e32 %0, %1, %2":"=v"(r):"v"(a),"v"(b));return r;}
typedef float f32x2_t __attribute__((ext_vector_type(2))); typedef __bf16 bf16x2_t __attribute__((ext_vector_type(2)));
__device__ __forceinline__ unsigned cvtpk_s(float lo,float hi){f32x2_t v={lo,hi};bf16x2_t b=__builtin_convertvector(v,bf16x2_t);return __builtin_bit_cast(unsigned,b);}
#define WAIT_BAR(N) asm volatile("s_waitcnt vmcnt(" #N ") lgkmcnt(0)\n\ts_barrier":::"memory")

__device__ __forceinline__ void qkt(f32x16&p0,f32x16&p1,const char*Kslot,const bf16x8*qr,const f32x16&negm,int r32,int hi){
  const char*kb=Kslot+hi*1024+r32*16;
  #pragma unroll
  for(int d0=0;d0<4;++d0){
    const bf16x8 b0=*reinterpret_cast<const bf16x8*>(kb+d0*2048);
    const bf16x8 b1=*reinterpret_cast<const bf16x8*>(kb+d0*2048+512);
    if(d0==0){p0=__builtin_amdgcn_mfma_f32_32x32x16_bf16(b0,qr[0],negm,0,0,0);p1=__builtin_amdgcn_mfma_f32_32x32x16_bf16(b1,qr[0],negm,0,0,0);}
    else{p0=__builtin_amdgcn_mfma_f32_32x32x16_bf16(b0,qr[d0],p0,0,0,0);p1=__builtin_amdgcn_mfma_f32_32x32x16_bf16(b1,qr[d0],p1,0,0,0);}}
}
typedef __attribute__((address_space(3))) const char* lds_cptr;
typedef short v4i16_t __attribute__((ext_vector_type(4)));
__device__ __forceinline__ void kload8(bf16x8*kf,lds_cptr kp){
  kf[0]=*(const __attribute__((address_space(3))) bf16x8*)(kp);      kf[1]=*(const __attribute__((address_space(3))) bf16x8*)(kp+512);
  kf[2]=*(const __attribute__((address_space(3))) bf16x8*)(kp+2048); kf[3]=*(const __attribute__((address_space(3))) bf16x8*)(kp+2560);
  kf[4]=*(const __attribute__((address_space(3))) bf16x8*)(kp+4096); kf[5]=*(const __attribute__((address_space(3))) bf16x8*)(kp+4608);
  kf[6]=*(const __attribute__((address_space(3))) bf16x8*)(kp+6144); kf[7]=*(const __attribute__((address_space(3))) bf16x8*)(kp+6656);
}
__device__ __forceinline__ void kload2(bf16x8*kf,lds_cptr kp,int j){ kf[2*j]=*(const __attribute__((address_space(3))) bf16x8*)(kp+j*2048); kf[2*j+1]=*(const __attribute__((address_space(3))) bf16x8*)(kp+j*2048+512); }
__device__ __forceinline__ s16x4 vtr(lds_cptr p){ return __builtin_bit_cast(s16x4,__builtin_amdgcn_ds_read_tr16_b64_v4i16((__attribute__((address_space(3))) v4i16_t*)p)); }
__device__ __forceinline__ float rowmax(const f32x16&p0,const f32x16&p1){
  float a=max3f(p0[0],p0[1],p1[0]),b=max3f(p0[2],p0[3],p1[1]);a=max3f(a,p1[2],p1[3]);
  #pragma unroll
  for(int r=4;r<16;r+=4){a=max3f(a,p0[r],p0[r+1]);b=max3f(b,p0[r+2],p0[r+3]);a=max3f(a,p1[r],p1[r+1]);b=max3f(b,p1[r+2],p1[r+3]);}
  const float m=max2f(a,b);
  auto rr=__builtin_amdgcn_permlane32_swap(__float_as_uint(m),__float_as_uint(m),false,false);
  return max2f(__uint_as_float(rr[0]),__uint_as_float(rr[1]));
}
__device__ __forceinline__ void pv(f32x16*o,int vb,bf16x8 pa0,bf16x8 pa1,bf16x8 pa2,bf16x8 pa3){
  #pragma unroll
  for(int d0=0;d0<2;++d0){s16x4 lo[4],hi[4];
    #pragma unroll
    for(int ks=0;ks<4;++ks){
      asm volatile("ds_read_b64_tr_b16 %0,%1 offset:%c2":"=&v"(lo[ks]):"v"(vb),"i"(d0*4096+ks*1024):"memory");
      asm volatile("ds_read_b64_tr_b16 %0,%1 offset:%c2":"=&v"(hi[ks]):"v"(vb),"i"(d0*4096+ks*1024+512):"memory");}
    asm volatile("s_waitcnt lgkmcnt(0)":::"memory");SBAR();
    #define PK(k) (bf16x8){lo[k][0],lo[k][1],lo[k][2],lo[k][3],hi[k][0],hi[k][1],hi[k][2],hi[k][3]}
    o[d0]=__builtin_amdgcn_mfma_f32_32x32x16_bf16(pa0,PK(0),o[d0],0,0,0);
    o[d0]=__builtin_amdgcn_mfma_f32_32x32x16_bf16(pa1,PK(1),o[d0],0,0,0);
    o[d0]=__builtin_amdgcn_mfma_f32_32x32x16_bf16(pa2,PK(2),o[d0],0,0,0);
    o[d0]=__builtin_amdgcn_mfma_f32_32x32x16_bf16(pa3,PK(3),o[d0],0,0,0);
    #undef PK
  }
}

#ifndef ATTN_STORE16
#define ATTN_STORE16(p,v) (*(u32x4*)(p)=(v))
#endif
template<int THRL> __device__ __forceinline__ void attn_unit(int b,int qb,const bf16*Q,const bf16*__restrict__ K,const bf16*__restrict__ V,bf16*O,int qc,int kc,int vc,int oc,lds_cfptr bt,char*shm){
  int tid_=threadIdx.x; asm volatile("":"+v"(tid_)); const int tid=tid_,lane=tid&63,r32=lane&31,hi=lane>>5; const int wid=__builtin_amdgcn_readfirstlane(tid>>6);
  const long rowbase=(long)b*SEQ; const int q0=qb*QB;
  const bf16*Qw=Q+(rowbase+q0+wid*QBLK)*DM+qc;
  const bf16*Kh=K+rowbase*DM+kc,*Vh=V+rowbase*DM+vc;
  const unsigned lds0=(unsigned)(uintptr_t)shm;
  float*wsf=(float*)(shm+LDS_WS)+wid*64;
  const bf16*ksrc=Kh+(long)lane*DM+wid*8;
  const bf16*vsrc=Vh+(long)(16*(wid&3)+(lane>>2))*DM+(wid>>2)*32+(lane&3)*8;
  const unsigned kdst=lds0+LDS_K+wid*1024, vdst=lds0+LDS_V+wid*1024;
  #define DMA_K(t,slot) glds16(ksrc+(long)(t)*KVBLK*DM,(unsigned)__builtin_amdgcn_readfirstlane(kdst+(slot)))
  #define DMA_V(t,slot) glds16(vsrc+(long)(t)*KVBLK*DM,(unsigned)__builtin_amdgcn_readfirstlane(vdst+(slot)))
  const int vb0=(int)(lds0+LDS_V)+((lane>>4)&1)*32+(lane&3)*8+(4*hi+((lane&15)>>2))*64;
  const char*Kbase=shm+LDS_K; bf16x8 kf[8];
  const lds_cptr shm3=(lds_cptr)shm; const lds_cptr kp0=shm3+LDS_K+hi*1024+r32*16; const lds_cptr vp0=shm3+LDS_V+((lane>>4)&1)*32+(lane&3)*8+(4*hi+((lane&15)>>2))*64;
  const int NT=(q0+QB)/KVBLK;
  DMA_K(0,0);DMA_V(0,0);DMA_K(1,SLOTB);
  bf16x8 qr[4];
  #pragma unroll
  for(int d0=0;d0<4;++d0)qr[d0]=*reinterpret_cast<const bf16x8*>(&Qw[(long)r32*DM+d0*16+hi*8]);
  float mhat=0.f,l_reg=0.f;f32x16 o[2],negm; { float z_=0.f; asm volatile("":"+v"(z_));
    _Pragma("unroll") for(int r=0;r<16;++r){o[0][r]=z_;o[1][r]=z_;negm[r]=z_;} } asm volatile("":"+v"(negm));
  const int qrel=wid*QBLK+r32;
  #define CMASK(P0,P1,t) do{int jb_=(t)-(NT-4); if(jb_>=-2 && (wid*QBLK-(64*jb_+63))<128)cbias(P0,P1,jb_,qrel,hi,bt);}while(0)
  bool resc=false;
  #define START(P0,P1) do{ const float rm=rowmax(P0,P1); resc=false; \
    { const float dl=rm; mhat=fadd_s(mhat,dl); \
      _Pragma("unroll") for(int r=0;r<16;++r){P0[r]=fsub_s(P0[r],dl);P1[r]=fsub_s(P1[r],dl);} \
      _Pragma("unroll") for(int r=0;r<16;++r)negm[r]=-mhat; asm volatile("":"+v"(negm)); } \
    _Pragma("unroll") for(int r=0;r<16;++r)P0[r]=__builtin_amdgcn_exp2f(P0[r]); }while(0)
  #define RESC() do{ if(resc){ asm volatile("s_waitcnt lgkmcnt(0)":::"memory"); \
      _Pragma("unroll") for(int d_=0;d_<2;++d_) _Pragma("unroll") for(int r=0;r<16;++r)o[d_][r]*=wsf[crow(r,hi)]; } }while(0)
  f32x16 pA0,pA1,pB0,pB1;
  int sl_prev=0,sl_cur=0,sl_next=SLOTB;
  #define ROT() do{sl_prev=sl_cur;sl_cur=sl_next;sl_next=(sl_next==(NSLOT-1)*SLOTB)?0:sl_next+SLOTB;}while(0)
  DMA_K(2,2*SLOTB);
  WAIT_BAR(3);
  qkt(pA0,pA1,Kbase,qr,negm,r32,hi);asm volatile("s_nop 15\n\ts_nop 7":"+v"(pA0),"+v"(pA1));CMASK(pA0,pA1,0);
  START(pA0,pA1);
  _Pragma("unroll") for(int r=0;r<16;++r)pA1[r]=__builtin_amdgcn_exp2f(pA1[r]);
  WAIT_BAR(0);
  DMA_K(3,0);DMA_V(1,SLOTB);
  ROT();
  kload8(kf,kp0+sl_cur);
  WAIT_BAR(2);
  s16x4 vlo[8],vhi[8]; u32x4 pw0,pw1,pw2,pw3;
  #define PKW(P,B) cvtpk_s(P[B],P[B+1])
  #define PAF(k) __builtin_bit_cast(bf16x8,pw##k)
  #define VFR(i) (bf16x8){vlo[i][0],vlo[i][1],vlo[i][2],vlo[i][3],vhi[i][0],vhi[i][1],vhi[i][2],vhi[i][3]}
  #define PIN(x) asm volatile("":"+v"(x))
  #define MX3(a,b,c) __builtin_fmaxf(__builtin_fmaxf((a),(b)),(c))
  #define GAPA(MF,A0,A1,A2,A3,W0,W1,PW) do{ MF; sacc+=A0; sacc+=A1; sacc+=A2; sacc+=A3; PIN(sacc); W0; W1; PIN(PW); SBAR(); }while(0)
  #define EX(v) __builtin_amdgcn_exp2f(v)
  #define GAPB(MF,X,B) do{ MF; X[B]=EX(X[B]); X[B+1]=EX(X[B+1]); X[B+2]=EX(X[B+2]); X[B+3]=EX(X[B+3]); PIN(X); SBAR(); }while(0)
  #define VRD(i) do{ vlo[i]=vtr(vp_+(((i)>>2)*4096+((i)&3)*1024)); vhi[i]=vtr(vp_+(((i)>>2)*4096+((i)&3)*1024+512)); }while(0)
  #define KRD(G,j) do{ if(G){ kload2(kf,kp0+sl_next,j); SBAR(); } }while(0)
  #define STEP(C0,C1,P0,P1,t,GK,GV,GL) do{ SBAR(); \
    const lds_cptr vp_=vp0+sl_prev; \
    VRD(0); SBAR(); float sacc=(P0[0]+P0[1]); \
    GAPA(C0=__builtin_amdgcn_mfma_f32_32x32x16_bf16(kf[0],qr[0],negm,0,0,0), P0[2],P0[3],P0[4],P0[5],     pw0[0]=PKW(P0,0), pw0[1]=PKW(P0,2), pw0); \
    VRD(4); SBAR(); GAPA(C1=__builtin_amdgcn_mfma_f32_32x32x16_bf16(kf[1],qr[0],negm,0,0,0), P0[6],P0[7],P0[8],P0[9],     pw0[2]=PKW(P0,4), pw0[3]=PKW(P0,6), pw0); \
    VRD(1); SBAR(); GAPA(C0=__builtin_amdgcn_mfma_f32_32x32x16_bf16(kf[2],qr[1],C0,0,0,0),   P0[10],P0[11],P0[12],P0[13], pw1[0]=PKW(P0,8), pw1[1]=PKW(P0,10), pw1); \
    VRD(5); SBAR(); GAPA(C1=__builtin_amdgcn_mfma_f32_32x32x16_bf16(kf[3],qr[1],C1,0,0,0),   P0[14],P0[15],P1[0],P1[1],   pw1[2]=PKW(P0,12),pw1[3]=PKW(P0,14), pw1); \
    VRD(2); SBAR(); GAPA(C0=__builtin_amdgcn_mfma_f32_32x32x16_bf16(kf[4],qr[2],C0,0,0,0),   P1[2],P1[3],P1[4],P1[5],     pw2[0]=PKW(P1,0), pw2[1]=PKW(P1,2), pw2); \
    VRD(6); SBAR(); GAPA(C1=__builtin_amdgcn_mfma_f32_32x32x16_bf16(kf[5],qr[2],C1,0,0,0),   P1[6],P1[7],P1[8],P1[9],     pw2[2]=PKW(P1,4), pw2[3]=PKW(P1,6), pw2); \
    VRD(3); SBAR(); GAPA(C0=__builtin_amdgcn_mfma_f32_32x32x16_bf16(kf[6],qr[3],C0,0,0,0),   P1[10],P1[11],P1[12],P1[13], pw3[0]=PKW(P1,8), pw3[1]=PKW(P1,10), pw3); \
    VRD(7); SBAR(); GAPA(C1=__builtin_amdgcn_mfma_f32_32x32x16_bf16(kf[7],qr[3],C1,0,0,0),   P1[14],P1[15],0.f,0.f,       pw3[2]=PKW(P1,12),pw3[3]=PKW(P1,14), pw3); \
    l_reg+=sacc; \
    if(GK){DMA_K((t)+3,sl_cur);} if(GV){DMA_V((t)+1,sl_next);} \
    CMASK(C0,C1,t); \
    { float a=MX3(C0[0],C0[1],C1[0]),b=MX3(C0[2],C0[3],C1[1]); a=MX3(a,C1[2],C1[3]); \
      _Pragma("unroll") for(int r=4;r<16;r+=4){a=MX3(a,C0[r],C0[r+1]);b=MX3(b,C0[r+2],C0[r+3]);a=MX3(a,C1[r],C1[r+1]);b=MX3(b,C1[r+2],C1[r+3]);} \
      float rm=__builtin_fmaxf(a,b); { auto rr=__builtin_amdgcn_permlane32_swap(__float_as_uint(rm),__float_as_uint(rm),false,false); rm=__builtin_fmaxf(__uint_as_float(rr[0]),__uint_as_float(rr[1])); } \
      resc=false; \
      if(__builtin_expect(__any(rm>(float)THRL),0)){ const float dl=__builtin_fmaxf(rm,0.f); mhat+=dl; \
        _Pragma("unroll") for(int r=0;r<16;++r){C0[r]-=dl;C1[r]-=dl;} \
        _Pragma("unroll") for(int r=0;r<16;++r)negm[r]=-mhat; asm volatile("":"+v"(negm)); \
        const float f=__builtin_amdgcn_exp2f(-dl); l_reg*=f; if(hi==0)wsf[r32]=f; resc=true; } } \
    SBAR(); \
    GAPB(o[0]=__builtin_amdgcn_mfma_f32_32x32x16_bf16(PAF(0),VFR(0),o[0],0,0,0), C0,0); \
    GAPB(o[1]=__builtin_amdgcn_mfma_f32_32x32x16_bf16(PAF(0),VFR(4),o[1],0,0,0), C0,4); \
    KRD(GL,0); GAPB(o[0]=__builtin_amdgcn_mfma_f32_32x32x16_bf16(PAF(1),VFR(1),o[0],0,0,0), C0,8); \
    KRD(GL,1); GAPB(o[1]=__builtin_amdgcn_mfma_f32_32x32x16_bf16(PAF(1),VFR(5),o[1],0,0,0), C0,12); \
    KRD(GL,2); GAPB(o[0]=__builtin_amdgcn_mfma_f32_32x32x16_bf16(PAF(2),VFR(2),o[0],0,0,0), C1,0); \
    KRD(GL,3); GAPB(o[1]=__builtin_amdgcn_mfma_f32_32x32x16_bf16(PAF(2),VFR(6),o[1],0,0,0), C1,4); \
    GAPB(o[0]=__builtin_amdgcn_mfma_f32_32x32x16_bf16(PAF(3),VFR(3),o[0],0,0,0), C1,8); \
    GAPB(o[1]=__builtin_amdgcn_mfma_f32_32x32x16_bf16(PAF(3),VFR(7),o[1],0,0,0), C1,12); \
    }while(0)
  int t=1;
  #undef CMASK
  #define CMASK(P0,P1,t) do{}while(0)
  for(;t+7<NT;t+=2){
    STEP(pB0,pB1,pA0,pA1,t,true,true,true);     WAIT_BAR(2); RESC(); ROT();
    STEP(pA0,pA1,pB0,pB1,t+1,true,true,true);   WAIT_BAR(2); RESC(); ROT();
  }
  #undef CMASK
  #define CMASK(P0,P1,t) do{int jb_=(t)-(NT-4); if(jb_>=-2 && (wid*QBLK-(64*jb_+63))<128)cbias(P0,P1,jb_,qrel,hi,bt);}while(0)
  #define ENDW(tt) do{ if((tt)+3<NT){WAIT_BAR(2);} else if((tt)+2<NT){WAIT_BAR(1);} else {WAIT_BAR(0);} }while(0)
  for(;t+1<NT;t+=2){
    STEP(pB0,pB1,pA0,pA1,t,(t+3<NT),(t+1<NT),(t+1<NT));       ENDW(t);   RESC(); ROT();
    STEP(pA0,pA1,pB0,pB1,t+1,(t+4<NT),(t+2<NT),(t+2<NT));     ENDW(t+1); RESC(); ROT();
  }
  STEP(pB0,pB1,pA0,pA1,NT-1,false,false,false); RESC();
  { float sacc=pB0[0]+pB0[1]; _Pragma("unroll") for(int r=2;r<16;++r)sacc+=pB0[r]; _Pragma("unroll") for(int r=0;r<16;++r)sacc+=pB1[r]; l_reg+=sacc;
    pw0=(u32x4){PKW(pB0,0),PKW(pB0,2),PKW(pB0,4),PKW(pB0,6)};pw1=(u32x4){PKW(pB0,8),PKW(pB0,10),PKW(pB0,12),PKW(pB0,14)};pw2=(u32x4){PKW(pB1,0),PKW(pB1,2),PKW(pB1,4),PKW(pB1,6)};pw3=(u32x4){PKW(pB1,8),PKW(pB1,10),PKW(pB1,12),PKW(pB1,14)};
    SBAR(); pv(o,vb0+sl_cur,PAF(0),PAF(1),PAF(2),PAF(3)); }
  #undef PKW
  #undef PAF
  #undef VFR
  #undef PIN
  #undef MX3
  #undef GAPA
  #undef GAPB
  #undef EX
  #undef VRD
  #undef KRD
  #undef STEP
  #undef ENDW
  {auto rr=__builtin_amdgcn_permlane32_swap(__float_as_uint(l_reg),__float_as_uint(l_reg),false,false);l_reg=__uint_as_float(rr[0])+__uint_as_float(rr[1]);}
  if(hi==0)wsf[32+r32]=l_reg;asm volatile("s_waitcnt lgkmcnt(0)":::"memory");
  float rli[16];
  #pragma unroll
  for(int r=0;r<16;++r)rli[r]=__builtin_amdgcn_rcpf(wsf[32+crow(r,hi)]);
  bf16*Ow=O+(rowbase+q0+wid*QBLK)*DM+oc;
  { bf16*stg=(bf16*)(shm+LDS_OST)+wid*2048;
    #pragma unroll
    for(int r=0;r<16;++r){const int orow=crow(r,hi);
      #pragma unroll
      for(int d0=0;d0<2;++d0)stg[orow*64+d0*32+r32]=__float2bfloat16(o[d0][r]*rli[r]);}
    asm volatile("s_waitcnt lgkmcnt(0)":::"memory");
    #pragma unroll
    for(int i=0;i<4;++i){const int row=i*8+(lane>>3),ch=lane&7; const u32x4 v=*(const u32x4*)(stg+row*64+ch*8); ATTN_STORE16(Ow+(long)row*DM+ch*8,v);} }
  asm volatile("s_waitcnt lgkmcnt(0)\n\ts_barrier":::"memory");
  #undef DMA_K
  #undef DMA_V
  #undef CMASK
  #undef START
  #undef RESC
  #undef ROT
}
constexpr int ATTN_LDS_BYTES=LDS_BYTES;
#undef SBAR
#undef WAIT_BAR
}
#include <hip/hip_bf16.h>
#include <cmath>
#ifndef ATTN_QLDS
#define ATTN_QLDS 1
#endif
namespace attn_nat {
using bf16=__hip_bfloat16;
using bf16x8=__attribute__((ext_vector_type(8)))short;
using s16x4=__attribute__((ext_vector_type(4)))short;
using f32x16=__attribute__((ext_vector_type(16)))float;
using u32x4=__attribute__((ext_vector_type(4)))unsigned;
constexpr int BATCH=2,NHEAD=16,SEQ=8192,D=64,DM=NHEAD*D;
constexpr int NW=8,QBLK=32,QB=QBLK*NW,KVBLK=64,NQB=SEQ/QB;
constexpr int ATTN_PITCH=DM, ATTN_UNIT_ROWS=QB;
__device__ __forceinline__ int crow(int r,int hi){return (r&3)+8*(r>>2)+4*hi;}
#define SBAR() __builtin_amdgcn_sched_barrier(0)
typedef const __attribute__((address_space(3))) float* lds_cfptr;
__device__ __forceinline__ void cbias(f32x16&p0,f32x16&p1,int jb,int qrel,int hi,lds_cfptr bt){
  const float NEG=-INFINITY; const int kb=64*jb+4*hi;
  #pragma unroll
  for(int r=0;r<16;++r){const int d0=qrel-(kb+(r&3)+8*(r>>2)),d1=d0-32;
    const unsigned c0=(unsigned)d0<128u?(unsigned)d0:128u,c1=(unsigned)d1<128u?(unsigned)d1:128u;
    const float v0=p0[r]+bt[c0],v1=p1[r]+bt[c1];
    p0[r]=d0<0?NEG:v0; p1[r]=d1<0?NEG:v1;
    if((r&3)==3)__builtin_amdgcn_sched_barrier(0);}
}
constexpr int NSLOT=3, SLOTB=8192;
constexpr int LDS_K=0, LDS_V=NSLOT*SLOTB, LDS_WS=3*NSLOT*SLOTB, LDS_OST=LDS_WS+NW*64*4, LDS_BYTES=LDS_OST+NW*4096;
constexpr float C2=0.125f*1.4426950408889634f;
__device__ __forceinline__ void glds16(const void*sbase,unsigned voff,unsigned lds_dst){unsigned keep;
  asm volatile("s_mov_b32 %0, m0\n\ts_mov_b32 m0, %3\n\ts_nop 0\n\tglobal_load_lds_dwordx4 %1, %2\n\ts_mov_b32 m0, %0":"=&s"(keep):"v"(voff),"s"(sbase),"s"(lds_dst):"memory");}
__device__ __forceinline__ float max3f(float a,float b,float c){float r;asm("v_max3_f32 %0, %1, %2, %3":"=v"(r):"v"(a),"v"(b),"v"(c));return r;}
__device__ __forceinline__ float max2f(float a,float b){float r;asm("v_max_f32_e32 %0, %1, %2":"=v"(r):"v"(a),"v"(b));return r;}
__device__ __forceinline__ float fadd_s(float a,float b){float r;asm("v_add_f32_e32 %0, %1, %2":"=v"(r):"v"(a),"v"(b));return r;}
__device__ __forceinline__ float fsub_s(float a,float b){float r;asm("v_sub_f32_e32 %0, %1, %2":"=v"(r):"v"(a),"v"(b));return r;}
typedef float f32x2_t __attribute__((ext_vector_type(2))); typedef __bf16 bf16x2_t __attribute__((ext_vector_type(2)));
__device__ __forceinline__ unsigned cvtpk_s(float lo,float hi){f32x2_t v={lo,hi};bf16x2_t b=__builtin_convertvector(v,bf16x2_t);return __builtin_bit_cast(unsigned,b);}
#define WAIT_BAR(N) asm volatile("s_waitcnt vmcnt(" #N ") lgkmcnt(0)\n\ts_barrier":::"memory")

__device__ __forceinline__ void qkt(f32x16&p0,f32x16&p1,const char*Kslot,const bf16x8*qr,const f32x16&negm,int r32,int hi){
  const char*kb=Kslot+hi*1024+r32*16;
  #pragma unroll
  for(int d0=0;d0<4;++d0){
    const bf16x8 b0=*reinterpret_cast<const bf16x8*>(kb+d0*2048);
    const bf16x8 b1=*reinterpret_cast<const bf16x8*>(kb+d0*2048+512);
    if(d0==0){p0=__builtin_amdgcn_mfma_f32_32x32x16_bf16(b0,qr[0],negm,0,0,0);p1=__builtin_amdgcn_mfma_f32_32x32x16_bf16(b1,qr[0],negm,0,0,0);}
    else{p0=__builtin_amdgcn_mfma_f32_32x32x16_bf16(b0,qr[d0],p0,0,0,0);p1=__builtin_amdgcn_mfma_f32_32x32x16_bf16(b1,qr[d0],p1,0,0,0);}}
}
typedef __attribute__((address_space(3))) const char* lds_cptr;
typedef short v4i16_t __attribute__((ext_vector_type(4)));
__device__ __forceinline__ void kload8(bf16x8*kf,lds_cptr kp){
  kf[0]=*(const __attribute__((address_space(3))) bf16x8*)(kp);      kf[1]=*(const __attribute__((address_space(3))) bf16x8*)(kp+512);
  kf[2]=*(const __attribute__((address_space(3))) bf16x8*)(kp+2048); kf[3]=*(const __attribute__((address_space(3))) bf16x8*)(kp+2560);
  kf[4]=*(const __attribute__((address_space(3))) bf16x8*)(kp+4096); kf[5]=*(const __attribute__((address_space(3))) bf16x8*)(kp+4608);
  kf[6]=*(const __attribute__((address_space(3))) bf16x8*)(kp+6144); kf[7]=*(const __attribute__((address_space(3))) bf16x8*)(kp+6656);
}
__device__ __forceinline__ void kload2(bf16x8*kf,lds_cptr kp,int j){ kf[2*j]=*(const __attribute__((address_space(3))) bf16x8*)(kp+j*2048); kf[2*j+1]=*(const __attribute__((address_space(3))) bf16x8*)(kp+j*2048+512); }
__device__ __forceinline__ s16x4 vtr(lds_cptr p){ return __builtin_bit_cast(s16x4,__builtin_amdgcn_ds_read_tr16_b64_v4i16((__attribute__((address_space(3))) v4i16_t*)p)); }
__device__ __forceinline__ float rowmax(const f32x16&p0,const f32x16&p1){
  float a=max3f(p0[0],p0[1],p1[0]),b=max3f(p0[2],p0[3],p1[1]);a=max3f(a,p1[2],p1[3]);
  #pragma unroll
  for(int r=4;r<16;r+=4){a=max3f(a,p0[r],p0[r+1]);b=max3f(b,p0[r+2],p0[r+3]);a=max3f(a,p1[r],p1[r+1]);b=max3f(b,p1[r+2],p1[r+3]);}
  const float m=max2f(a,b);
  auto rr=__builtin_amdgcn_permlane32_swap(__float_as_uint(m),__float_as_uint(m),false,false);
  return max2f(__uint_as_float(rr[0]),__uint_as_float(rr[1]));
}
__device__ __forceinline__ void pv(f32x16*o,int vb,bf16x8 pa0,bf16x8 pa1,bf16x8 pa2,bf16x8 pa3){
  #pragma unroll
  for(int d0=0;d0<4;++d0){s16x4 lo[4],hi[4];
    #pragma unroll
    for(int ks=0;ks<4;++ks){
      asm volatile("ds_read_b64_tr_b16 %0,%1 offset:%c2":"=&v"(lo[ks]):"v"(vb),"i"(d0*4096+ks*1024):"memory");
      asm volatile("ds_read_b64_tr_b16 %0,%1 offset:%c2":"=&v"(hi[ks]):"v"(vb),"i"(d0*4096+ks*1024+512):"memory");}
    asm volatile("s_waitcnt lgkmcnt(0)":::"memory");SBAR();
    #define PK(k) (bf16x8){lo[k][0],lo[k][1],lo[k][2],lo[k][3],hi[k][0],hi[k][1],hi[k][2],hi[k][3]}
    o[d0]=__builtin_amdgcn_mfma_f32_32x32x16_bf16(pa0,PK(0),o[d0],0,0,0);
    o[d0]=__builtin_amdgcn_mfma_f32_32x32x16_bf16(pa1,PK(1),o[d0],0,0,0);
    o[d0]=__builtin_amdgcn_mfma_f32_32x32x16_bf16(pa2,PK(2),o[d0],0,0,0);
    o[d0]=__builtin_amdgcn_mfma_f32_32x32x16_bf16(pa3,PK(3),o[d0],0,0,0);
    #undef PK
  }
}

#ifndef ATTN_STORE16
#define ATTN_STORE16(p,v) (*(u32x4*)(p)=(v))
#endif
template<int THRL> __device__ __forceinline__ void attn_unit(int b,int qb,const bf16*Q,const bf16*__restrict__ K,const bf16*__restrict__ V,bf16*O,int qc,int kc,int vc,int oc,lds_cfptr bt,char*shm){
  int tid_=threadIdx.x; asm volatile("":"+v"(tid_)); const int tid=tid_,lane=tid&63,r32=lane&31,hi=lane>>5; const int wid=__builtin_amdgcn_readfirstlane(tid>>6);
  const long rowbase=(long)b*SEQ; const int q0=qb*QB;
  const bf16*Qw=Q+(rowbase+q0+wid*QBLK)*DM+qc;
  const bf16*Kh=K+rowbase*DM+kc,*Vh=V+rowbase*DM+vc;
  const unsigned lds0=(unsigned)(uintptr_t)shm;
  float*wsf=(float*)(shm+LDS_WS)+wid*64;
  const unsigned koff=(unsigned)((lane*DM+wid*8)*2);
  const unsigned voff=(unsigned)(((16*(wid&3)+(lane>>2))*DM+(wid>>2)*32+(lane&3)*8)*2);
  const unsigned kdst=lds0+LDS_K+wid*1024, vdst=lds0+LDS_V+wid*1024;
  #define DMA_K(t,slot) glds16(Kh+(long)(t)*KVBLK*DM,koff,(unsigned)__builtin_amdgcn_readfirstlane(kdst+(slot)))
  #define DMA_V(t,slot) do{ glds16(Vh+(long)(t)*KVBLK*DM,voff,(unsigned)__builtin_amdgcn_readfirstlane(vdst+2*(slot))); glds16(Vh+(long)(t)*KVBLK*DM+64,voff,(unsigned)__builtin_amdgcn_readfirstlane(vdst+2*(slot)+8192)); }while(0)
  const char*Kbase=shm+LDS_K; bf16x8 kf[8];
  const lds_cptr shm3=(lds_cptr)shm; const lds_cptr kp0=shm3+LDS_K+hi*1024+r32*16; const lds_cptr vp0=shm3+LDS_V+((lane>>4)&1)*32+(lane&3)*8+(4*hi+((lane&15)>>2))*64;
  const int NT=(q0+QB)/KVBLK;
  DMA_K(0,0);DMA_V(0,0);DMA_K(1,SLOTB);
  bf16x8 qr[4];
  #pragma unroll
  for(int d0=0;d0<4;++d0)qr[d0]=*reinterpret_cast<const bf16x8*>(&Qw[(long)r32*DM+d0*16+hi*8]);
#if ATTN_QLDS
  const lds_cptr qst=shm3+LDS_OST+wid*4096+r32*128;
  #pragma unroll
  for(int d0=0;d0<4;++d0)*(__attribute__((address_space(3))) bf16x8*)(shm3+LDS_OST+wid*4096+r32*128+(((2*d0+hi)^(r32&7))<<4))=qr[d0];
  #define QF(d) (*(const __attribute__((address_space(3))) bf16x8*)(qst+(((2*(d)+hi)^(r32&7))<<4)))
#else
  #define QF(d) qr[d]
#endif
  float mhat=0.f,l_reg=0.f;f32x16 o[4]; { float z_=0.f; asm volatile("":"+v"(z_));
    _Pragma("unroll") for(int r=0;r<16;++r){o[0][r]=z_;o[1][r]=z_;o[2][r]=z_;o[3][r]=z_;} }
  const int qrel=wid*QBLK+r32;
  #define CMASK(P0,P1,t) do{int jb_=(t)-(NT-4); if(jb_>=-2 && (wid*QBLK-(64*jb_+63))<128)cbias(P0,P1,jb_,qrel,hi,bt);}while(0)
  bool resc=false;
  #define START(P0,P1) do{ const float rm=rowmax(P0,P1); resc=false; \
    { const float dl=rm; mhat=fadd_s(mhat,dl); \
      _Pragma("unroll") for(int r=0;r<16;++r){P0[r]=fsub_s(P0[r],dl);P1[r]=fsub_s(P1[r],dl);} } \
    _Pragma("unroll") for(int r=0;r<16;++r)P0[r]=__builtin_amdgcn_exp2f(P0[r]); }while(0)
  #define RESC() do{ if(resc){ asm volatile("s_waitcnt lgkmcnt(0)":::"memory"); \
      _Pragma("unroll") for(int d_=0;d_<4;++d_) _Pragma("unroll") for(int r=0;r<16;++r)o[d_][r]*=wsf[crow(r,hi)]; } }while(0)
  f32x16 pA0,pA1,pB0,pB1;
  int sl_prev=0,sl_cur=0,sl_next=SLOTB;
  #define ROT() do{sl_prev=sl_cur;sl_cur=sl_next;sl_next=(sl_next==(NSLOT-1)*SLOTB)?0:sl_next+SLOTB;}while(0)
  DMA_K(2,2*SLOTB);
  WAIT_BAR(4);
  qkt(pA0,pA1,Kbase,qr,f32x16{},r32,hi);asm volatile("s_nop 15\n\ts_nop 7":"+v"(pA0),"+v"(pA1));CMASK(pA0,pA1,0);
  START(pA0,pA1);
  _Pragma("unroll") for(int r=0;r<16;++r)pA1[r]=__builtin_amdgcn_exp2f(pA1[r]);
  WAIT_BAR(0);
  DMA_K(3,0);DMA_V(1,SLOTB);
  ROT();
  kload8(kf,kp0+sl_cur);
  WAIT_BAR(3);
  s16x4 vlo[8],vhi[8]; u32x4 pw0,pw1,pw2,pw3;
  #define PKW(P,B) cvtpk_s(P[B],P[B+1])
  #define PAF(k) __builtin_bit_cast(bf16x8,pw##k)
  #define VFR(i) (bf16x8){vlo[i][0],vlo[i][1],vlo[i][2],vlo[i][3],vhi[i][0],vhi[i][1],vhi[i][2],vhi[i][3]}
  #define PIN(x) asm volatile("":"+v"(x))
  #define MX3(a,b,c) __builtin_fmaxf(__builtin_fmaxf((a),(b)),(c))
  #define GAPA(MF,A0,A1,A2,A3,W0,W1,PW) do{ MF; sacc+=A0; sacc+=A1; sacc+=A2; sacc+=A3; PIN(sacc); W0; W1; PIN(PW); SBAR(); }while(0)
  #define EX(v) __builtin_amdgcn_exp2f(v)
  #define GAPB(MF,X,B) do{ MF; X[B]=EX(X[B]); X[B+1]=EX(X[B+1]); X[B+2]=EX(X[B+2]); X[B+3]=EX(X[B+3]); PIN(X); SBAR(); }while(0)
  #define GAPB2(MF,X,B) do{ MF; X[B]=EX(X[B]); X[B+1]=EX(X[B+1]); PIN(X); SBAR(); }while(0)
  #define VRD2(i) do{ vlo[i]=vtr(vp_+((2+((i)>>2))*4096+((i)&3)*1024)); vhi[i]=vtr(vp_+((2+((i)>>2))*4096+((i)&3)*1024+512)); SBAR(); }while(0)
  #define VRD(i) do{ vlo[i]=vtr(vp_+(((i)>>2)*4096+((i)&3)*1024)); vhi[i]=vtr(vp_+(((i)>>2)*4096+((i)&3)*1024+512)); }while(0)
  #define KRD(G,j) do{ if(G){ kload2(kf,kp0+sl_next,j); SBAR(); } }while(0)
  #define STEP(C0,C1,P0,P1,t,GK,GV,GL) do{ SBAR(); \
    const lds_cptr vp_=vp0+2*sl_prev; \
    VRD(0); SBAR(); float sacc=(P0[0]+P0[1]); \
    GAPA(C0=__builtin_amdgcn_mfma_f32_32x32x16_bf16(kf[0],QF(0),f32x16{},0,0,0), P0[2],P0[3],P0[4],P0[5],     pw0[0]=PKW(P0,0), pw0[1]=PKW(P0,2), pw0); \
    VRD(4); SBAR(); GAPA(C1=__builtin_amdgcn_mfma_f32_32x32x16_bf16(kf[1],QF(0),f32x16{},0,0,0), P0[6],P0[7],P0[8],P0[9],     pw0[2]=PKW(P0,4), pw0[3]=PKW(P0,6), pw0); \
    VRD(1); SBAR(); GAPA(C0=__builtin_amdgcn_mfma_f32_32x32x16_bf16(kf[2],QF(1),C0,0,0,0),   P0[10],P0[11],P0[12],P0[13], pw1[0]=PKW(P0,8), pw1[1]=PKW(P0,10), pw1); \
    VRD(5); SBAR(); GAPA(C1=__builtin_amdgcn_mfma_f32_32x32x16_bf16(kf[3],QF(1),C1,0,0,0),   P0[14],P0[15],P1[0],P1[1],   pw1[2]=PKW(P0,12),pw1[3]=PKW(P0,14), pw1); \
    VRD(2); SBAR(); GAPA(C0=__builtin_amdgcn_mfma_f32_32x32x16_bf16(kf[4],QF(2),C0,0,0,0),   P1[2],P1[3],P1[4],P1[5],     pw2[0]=PKW(P1,0), pw2[1]=PKW(P1,2), pw2); \
    VRD(6); SBAR(); GAPA(C1=__builtin_amdgcn_mfma_f32_32x32x16_bf16(kf[5],QF(2),C1,0,0,0),   P1[6],P1[7],P1[8],P1[9],     pw2[2]=PKW(P1,4), pw2[3]=PKW(P1,6), pw2); \
    VRD(3); SBAR(); GAPA(C0=__builtin_amdgcn_mfma_f32_32x32x16_bf16(kf[6],QF(3),C0,0,0,0),   P1[10],P1[11],P1[12],P1[13], pw3[0]=PKW(P1,8), pw3[1]=PKW(P1,10), pw3); \
    VRD(7); SBAR(); GAPA(C1=__builtin_amdgcn_mfma_f32_32x32x16_bf16(kf[7],QF(3),C1,0,0,0),   P1[14],P1[15],0.f,0.f,       pw3[2]=PKW(P1,12),pw3[3]=PKW(P1,14), pw3); \
    l_reg+=sacc; \
    if(GK){DMA_K((t)+3,sl_cur);} if(GV){DMA_V((t)+1,sl_next);} \
    _Pragma("unroll") for(int r=0;r<16;++r){C0[r]-=mhat;C1[r]-=mhat;} \
    SBAR(); CMASK(C0,C1,t); SBAR(); \
    { float a=MX3(C0[0],C0[1],C1[0]),b=MX3(C0[2],C0[3],C1[1]); a=MX3(a,C1[2],C1[3]); \
      _Pragma("unroll") for(int r=4;r<16;r+=4){a=MX3(a,C0[r],C0[r+1]);b=MX3(b,C0[r+2],C0[r+3]);a=MX3(a,C1[r],C1[r+1]);b=MX3(b,C1[r+2],C1[r+3]);} \
      float rm=__builtin_fmaxf(a,b); { auto rr=__builtin_amdgcn_permlane32_swap(__float_as_uint(rm),__float_as_uint(rm),false,false); rm=__builtin_fmaxf(__uint_as_float(rr[0]),__uint_as_float(rr[1])); } \
      resc=false; \
      if(__builtin_expect(__any(rm>(float)THRL),0)){ const float dl=__builtin_fmaxf(rm,0.f); mhat+=dl; \
        _Pragma("unroll") for(int r=0;r<16;++r){C0[r]-=dl;C1[r]-=dl;} \
        const float f=__builtin_amdgcn_exp2f(-dl); l_reg*=f; if(hi==0)wsf[r32]=f; resc=true; } } \
    SBAR(); \
    GAPB2(o[0]=__builtin_amdgcn_mfma_f32_32x32x16_bf16(PAF(0),VFR(0),o[0],0,0,0), C0,0);  VRD2(0); \
    GAPB2(o[1]=__builtin_amdgcn_mfma_f32_32x32x16_bf16(PAF(0),VFR(4),o[1],0,0,0), C0,2);  VRD2(4); \
    GAPB2(o[0]=__builtin_amdgcn_mfma_f32_32x32x16_bf16(PAF(1),VFR(1),o[0],0,0,0), C0,4);  VRD2(1); \
    GAPB2(o[1]=__builtin_amdgcn_mfma_f32_32x32x16_bf16(PAF(1),VFR(5),o[1],0,0,0), C0,6);  VRD2(5); \
    GAPB2(o[0]=__builtin_amdgcn_mfma_f32_32x32x16_bf16(PAF(2),VFR(2),o[0],0,0,0), C0,8);  VRD2(2); \
    GAPB2(o[1]=__builtin_amdgcn_mfma_f32_32x32x16_bf16(PAF(2),VFR(6),o[1],0,0,0), C0,10); VRD2(6); \
    GAPB2(o[0]=__builtin_amdgcn_mfma_f32_32x32x16_bf16(PAF(3),VFR(3),o[0],0,0,0), C0,12); VRD2(3); \
    GAPB2(o[1]=__builtin_amdgcn_mfma_f32_32x32x16_bf16(PAF(3),VFR(7),o[1],0,0,0), C0,14); VRD2(7); \
    GAPB2(o[2]=__builtin_amdgcn_mfma_f32_32x32x16_bf16(PAF(0),VFR(0),o[2],0,0,0), C1,0); \
    GAPB2(o[3]=__builtin_amdgcn_mfma_f32_32x32x16_bf16(PAF(0),VFR(4),o[3],0,0,0), C1,2); \
    KRD(GL,0); GAPB2(o[2]=__builtin_amdgcn_mfma_f32_32x32x16_bf16(PAF(1),VFR(1),o[2],0,0,0), C1,4); \
    GAPB2(o[3]=__builtin_amdgcn_mfma_f32_32x32x16_bf16(PAF(1),VFR(5),o[3],0,0,0), C1,6); \
    KRD(GL,1); GAPB2(o[2]=__builtin_amdgcn_mfma_f32_32x32x16_bf16(PAF(2),VFR(2),o[2],0,0,0), C1,8); \
    GAPB2(o[3]=__builtin_amdgcn_mfma_f32_32x32x16_bf16(PAF(2),VFR(6),o[3],0,0,0), C1,10); \
    KRD(GL,2); GAPB2(o[2]=__builtin_amdgcn_mfma_f32_32x32x16_bf16(PAF(3),VFR(3),o[2],0,0,0), C1,12); \
    GAPB2(o[3]=__builtin_amdgcn_mfma_f32_32x32x16_bf16(PAF(3),VFR(7),o[3],0,0,0), C1,14); \
    KRD(GL,3); \
    }while(0)
  int t=1;
  #undef CMASK
  #define CMASK(P0,P1,t) do{}while(0)
  for(;t+7<NT;t+=2){
    STEP(pB0,pB1,pA0,pA1,t,true,true,true);     WAIT_BAR(3); RESC(); ROT();
    STEP(pA0,pA1,pB0,pB1,t+1,true,true,true);   WAIT_BAR(3); RESC(); ROT();
  }
  #undef CMASK
  int tb_=threadIdx.x; asm volatile("":"+v"(tb_)); const int qrel_b=(tb_>>6)*QBLK+(tb_&31),hi_b=(tb_&63)>>5;
  #define CMASK(P0,P1,t) do{int jb_=(t)-(NT-4); if(jb_>=-2 && (wid*QBLK-(64*jb_+63))<128)cbias(P0,P1,jb_,qrel_b,hi_b,bt);}while(0)
  #define ENDW(tt) do{ if((tt)+3<NT){WAIT_BAR(3);} else if((tt)+2<NT){WAIT_BAR(2);} else {WAIT_BAR(0);} }while(0)
  for(;t+1<NT;t+=2){
    STEP(pB0,pB1,pA0,pA1,t,(t+3<NT),(t+1<NT),(t+1<NT));       ENDW(t);   RESC(); ROT();
    STEP(pA0,pA1,pB0,pB1,t+1,(t+4<NT),(t+2<NT),(t+2<NT));     ENDW(t+1); RESC(); ROT();
  }
  STEP(pB0,pB1,pA0,pA1,NT-1,false,false,false); RESC();
  { float sacc=pB0[0]+pB0[1]; _Pragma("unroll") for(int r=2;r<16;++r)sacc+=pB0[r]; _Pragma("unroll") for(int r=0;r<16;++r)sacc+=pB1[r]; l_reg+=sacc;
    pw0=(u32x4){PKW(pB0,0),PKW(pB0,2),PKW(pB0,4),PKW(pB0,6)};pw1=(u32x4){PKW(pB0,8),PKW(pB0,10),PKW(pB0,12),PKW(pB0,14)};pw2=(u32x4){PKW(pB1,0),PKW(pB1,2),PKW(pB1,4),PKW(pB1,6)};pw3=(u32x4){PKW(pB1,8),PKW(pB1,10),PKW(pB1,12),PKW(pB1,14)};
    SBAR(); { int td_=threadIdx.x; asm volatile("":"+v"(td_)); const int ld_=td_&63; const int vb0=(int)((unsigned)(uintptr_t)shm+LDS_V)+((ld_>>4)&1)*32+(ld_&3)*8+(4*(ld_>>5)+((ld_&15)>>2))*64;
      pv(o,vb0+2*sl_cur,PAF(0),PAF(1),PAF(2),PAF(3)); } }
  #undef PKW
  #undef PAF
  #undef VFR
  #undef PIN
  #undef MX3
  #undef GAPA
  #undef GAPB
  #undef GAPB2
  #undef VRD2
  #undef EX
  #undef VRD
  #undef KRD
  #undef STEP
  #undef ENDW
  { int te_=threadIdx.x; asm volatile("":"+v"(te_)); const int lane_e=te_&63,r32e=lane_e&31,hie=lane_e>>5; const int wide=__builtin_amdgcn_readfirstlane(te_>>6);
  float*wsfe=(float*)(shm+LDS_WS)+wide*64;
  {auto rr=__builtin_amdgcn_permlane32_swap(__float_as_uint(l_reg),__float_as_uint(l_reg),false,false);l_reg=__uint_as_float(rr[0])+__uint_as_float(rr[1]);}
  if(hie==0)wsfe[32+r32e]=l_reg;asm volatile("s_waitcnt lgkmcnt(0)":::"memory");
  float rli[16];
  #pragma unroll
  for(int r=0;r<16;++r)rli[r]=__builtin_amdgcn_rcpf(wsfe[32+crow(r,hie)]);
  bf16*Ow=O+((long)b*SEQ+qb*QB+wide*QBLK)*DM+oc;
  { bf16*stg=(bf16*)(shm+LDS_OST)+wide*2048;
    #pragma unroll
    for(int hf=0;hf<2;++hf){
      #pragma unroll
      for(int r=0;r<16;++r){const int orow=crow(r,hie);
        #pragma unroll
        for(int d0=0;d0<2;++d0)stg[orow*64+d0*32+r32e]=__float2bfloat16(o[2*hf+d0][r]*rli[r]);}
      asm volatile("s_waitcnt lgkmcnt(0)":::"memory");
      #pragma unroll
      for(int i=0;i<4;++i){const int row=i*8+(lane_e>>3),ch=lane_e&7; const u32x4 v=*(const u32x4*)(stg+row*64+ch*8); ATTN_STORE16(Ow+(long)row*DM+hf*64+ch*8,v);}
      asm volatile("s_waitcnt lgkmcnt(0)":::"memory"); } } }
  asm volatile("s_waitcnt lgkmcnt(0)\n\ts_barrier":::"memory");
  #undef DMA_K
  #undef DMA_V
  #undef CMASK
  #undef START
  #undef RESC
  #undef ROT
  #undef QF
}
constexpr int ATTN_LDS_BYTES=LDS_BYTES;
#undef SBAR
#undef WAIT_BAR
}
#define XROW(m0) ((C.G == 256) ? (((gw >> 8) << 11) + (gw & 255) + (((m0) - gw) >> 11) * 256) : (m0))
struct Ctx {
    LAS unsigned char* lds; char* ldsg; int tid, lane, wave, G, vcu;
    const float* in[23]; float* out; unsigned char* ws;
};
#define WSP(T, off) ((T*)(C.ws + (off)))
#define PHASE_IDS() Ctx C = C0; { int t_ = threadIdx.x; asm volatile("" : "+v"(t_)); C.tid = t_; C.lane = t_ & 63; C.wave = __builtin_amdgcn_readfirstlane(t_ >> 6); }

struct ConvDesc { const float* src; bf16_t* dst; int N, K; };
__device__ __forceinline__ ConvDesc conv_desc(const Ctx& C, int it) {
    constexpr int I_IN = 16 * 160, I_BR = 8 * 32, I_GU1 = 16 * 64, I_GU = NE * I_GU1, I_D1 = 16 * 32, I_D = NE * I_D1;
    const float* W; bf16_t* WT; int K, N, kb, nb, orow; int r = it;
    if (r < I_GU) { const int e = r / I_GU1, q = r % I_GU1; kb = q / 64; nb = q % 64; const int n0 = 32 * nb, half = n0 >> 10, rem = n0 & 1023;
        W = C.in[18] + (size_t)e * 1024 * 2048; WT = WSP(bf16_t, WS_WGU) + (size_t)e * 2048 * 1024; K = 1024; N = 2048; orow = (rem >> 7) * 256 + half * 128 + (rem & 127); }
    else if ((r -= I_GU) < I_D) { const int e = r / I_D1, q = r % I_D1; kb = q / 32; nb = q % 32; W = C.in[20] + (size_t)e * 1024 * 1024; WT = WSP(bf16_t, WS_WD) + (size_t)e * 1024 * 1024; K = 1024; N = 1024; orow = 32 * nb; }
    else if ((r -= I_D) < I_IN) { kb = r / 160; nb = r % 160; W = C.in[6]; WT = WSP(bf16_t, WS_WIN); K = 1024; N = INW; orow = 32 * nb; }
    else if ((r -= I_IN) < I_BR) { kb = r / 32; nb = r % 32; W = C.in[12]; WT = WSP(bf16_t, WS_WBR); K = 1024; N = 1024; orow = 32 * nb; }
    else if ((r -= I_BR) < I_BR) { kb = r / 32; nb = r % 32; W = C.in[13]; WT = WSP(bf16_t, WS_WBR) + 512; K = 1024; N = 1024; orow = 32 * nb; }
    else { r -= I_BR; kb = r / 32; nb = r % 32; W = C.in[14]; WT = WSP(bf16_t, WS_WOUT); K = 1024; N = 1024; orow = 32 * nb; }
    ConvDesc d; d.src = W + (size_t)(64 * kb) * N + 32 * nb; d.dst = WT + (size_t)orow * K + 64 * kb; d.N = N; d.K = K; return d;
}
__device__ __forceinline__ void conv_load(const ConvDesc& d, f32x4 (&v)[8], int lane) {
    const int kr = lane >> 3, nc = lane & 7;
#pragma unroll
    for (int i = 0; i < 8; ++i) v[i] = *(const f32x4*)(d.src + (size_t)(8 * i + kr) * d.N + 4 * nc);
}
__device__ __forceinline__ void conv_finish(const ConvDesc& d, const f32x4 (&v)[8], LAS float* scr, int lane) {
    const int kr = lane >> 3, nc = lane & 7;
#pragma unroll
    for (int i = 0; i < 8; ++i) { LAS float* s = scr + (8 * i + kr) * 33 + 4 * nc; s[0] = v[i][0]; s[1] = v[i][1]; s[2] = v[i][2]; s[3] = v[i][3]; }
    LDS_WAIT(); asm volatile("" ::: "memory");
    const int c = lane & 7;
#pragma unroll
    for (int j = 0; j < 4; ++j) { const int n = (lane >> 3) + 8 * j; const LAS float* s = scr + (8 * c) * 33 + n;
        u32x4 o; o.x = cvt_pk_bf16(s[0 * 33], s[1 * 33]); o.y = cvt_pk_bf16(s[2 * 33], s[3 * 33]); o.z = cvt_pk_bf16(s[4 * 33], s[5 * 33]); o.w = cvt_pk_bf16(s[6 * 33], s[7 * 33]);
        *(u32x4*)(d.dst + (size_t)n * d.K + 8 * c) = o; }
    LDS_WAIT(); asm volatile("" ::: "memory");
}
__device__ __forceinline__ void conv_range(const Ctx& C, int lo, int hi, int wi, int nw, LAS float* scr) {
    const int first = lo + wi;
    if (first < hi) {
        ConvDesc d0 = conv_desc(C, first), d1 = d0; f32x4 v0[8], v1[8]; conv_load(d0, v0, C.lane);
        for (int it = first; it < hi; it += 2 * nw) {
            const int n1 = it + nw, n2 = it + 2 * nw;
            d1 = conv_desc(C, n1 < hi ? n1 : it); conv_load(d1, v1, C.lane);
            conv_finish(d0, v0, scr, C.lane);
            if (n1 >= hi) break;
            d0 = conv_desc(C, n2 < hi ? n2 : it); conv_load(d0, v0, C.lane);
            conv_finish(d1, v1, scr, C.lane);
        }
    }
}
template <int MODE> __device__ __noinline__ void conv_q_blocks(const float* Wgu, unsigned char* ws, LAS unsigned char* lds, int wave, int first, int stride) {
    int lane_ = (int)__builtin_amdgcn_mbcnt_hi(~0u, __builtin_amdgcn_mbcnt_lo(~0u, 0u)); asm volatile("" : "+v"(lane_));
    const int lane = lane_, tid = wave * 64 + lane, lr = tid >> 3, c4 = tid & 7, n = tid & 31, kg = tid >> 5;
    LAS float* blk = (LAS float*)lds;
    LAS float* wmx = (LAS float*)(lds + LDSCTL_OFF + 14336);
    f32x4 v[16];
    constexpr int NBLK = MODE == 0 ? NE * 64 : 128, LDW = MODE == 0 ? 2048 : INW;
#define QB_SRC(b_) (MODE == 0 ? Wgu + (size_t)((b_) >> 6) * 1024 * 2048 + 32 * ((b_) & 63) : Wgu + 32 * ((b_) < 48 ? (b_) : (b_) + 32))
    if (first < NBLK) { const float* W = QB_SRC(first) + 4 * c4 + (size_t)lr * LDW;
#pragma unroll
        for (int i = 0; i < 16; ++i) v[i] = *(const f32x4*)(W + (size_t)(64 * i) * LDW); }
    for (int bk = first; bk < NBLK; bk += stride) { const int e = MODE == 0 ? bk >> 6 : 0, n0 = MODE == 0 ? 32 * (bk & 63) : 32 * (bk < 48 ? bk : bk + 32), hgu = n0 >> 10, rem = n0 & 1023, orow = MODE == 0 ? (rem >> 7) * 256 + hgu * 128 + (rem & 127) : n0;
        f32x4 mx = (f32x4){0.f, 0.f, 0.f, 0.f};
#pragma unroll
        for (int i = 0; i < 16; ++i) { *(LAS f32x4*)(blk + (64 * i + lr) * 32 + 4 * c4) = v[i]; mx = __builtin_elementwise_max(mx, __builtin_elementwise_abs(v[i])); }
#pragma unroll
        for (int j = 0; j < 4; ++j) { float t = mx[j]; t = fmaxf(t, __shfl_xor(t, 8)); t = fmaxf(t, __shfl_xor(t, 16)); t = fmaxf(t, __shfl_xor(t, 32)); mx[j] = t; }
        if (lane < 8) *(LAS f32x4*)(wmx + wave * 32 + 4 * lane) = mx;
        { const int nk = bk + stride < NBLK ? bk + stride : bk;
          const float* W = QB_SRC(nk) + 4 * c4 + (size_t)lr * LDW;
#pragma unroll
          for (int i = 0; i < 16; ++i) v[i] = *(const f32x4*)(W + (size_t)(64 * i) * LDW); }
        LDS_WAIT(); __builtin_amdgcn_s_barrier(); asm volatile("" ::: "memory");
        float cm = wmx[n];
#pragma unroll
        for (int w = 1; w < 8; ++w) cm = fmaxf(cm, wmx[w * 32 + n]);
        const float inv = cm > 0.f ? 127.0f / cm : 0.f;
        if (kg == 0) ((float*)(ws + (MODE == 0 ? WS_SW : WS_SWIN)))[(size_t)e * 2048 + n0 + n] = cm > 0.f ? cm * (1.0f / 127.0f) : 1.0f;
        signed char* dst = (signed char*)(ws + (MODE == 0 ? WS_WGU : WS_WINQ)) + ((size_t)e * 2048 + orow + n) * 1024 + 64 * kg;
        const LAS float* src = blk + (64 * kg) * 32 + n;
#pragma unroll
        for (int s = 0; s < 4; ++s) { unsigned w4[4];
#pragma unroll
            for (int d = 0; d < 4; ++d) { int b[4];
#pragma unroll
                for (int k = 0; k < 4; ++k) b[k] = (int)fminf(fmaxf(__builtin_rintf(src[(16 * s + 4 * d + k) * 32] * inv), -127.0f), 127.0f);
                w4[d] = (unsigned)(b[0] & 255) | ((unsigned)(b[1] & 255) << 8) | ((unsigned)(b[2] & 255) << 16) | ((unsigned)b[3] << 24); }
            *(u32x4*)(dst + 16 * s) = (u32x4){w4[0], w4[1], w4[2], w4[3]}; }
        LDS_WAIT(); __builtin_amdgcn_s_barrier(); asm volatile("" ::: "memory");
    }
}
#undef QB_SRC
constexpr int CONV_MOE_ITEMS = NE * 16 * 64 + NE * 16 * 32;
constexpr int CONV_ALL_ITEMS = CONV_MOE_ITEMS + 16 * 160 + 2 * 8 * 32 + 16 * 32;
#ifndef NCONV_
#define NCONV_ 13
#endif
constexpr int NCONV = NCONV_;
__device__ __forceinline__ void p0_prologue(const Ctx& C0) {
    PHASE_IDS();
    LAS float* scr = (LAS float*)(C.lds + C.wave * 8448);
    const int gw = C.vcu * NWAVES + C.wave, NGW = C.G * NWAVES;
    conv_q_blocks<1>(C.in[6], C.ws, C.lds, C.wave, (int)blockIdx.x, C.G);
    __syncthreads();
    for (int it = gw; it < 16 * 32; it += NGW) { const int kb = it >> 5, nb = 48 + (it & 31);
        ConvDesc d; d.src = C.in[6] + (size_t)(64 * kb) * INW + 32 * nb; d.dst = WSP(bf16_t, WS_WIN) + (size_t)(32 * nb) * 1024 + 64 * kb; d.N = INW; d.K = 1024;
        f32x4 v[8]; conv_load(d, v, C.lane); conv_finish(d, v, scr, C.lane); }
    conv_range(C, CONV_MOE_ITEMS + 16 * 160, CONV_ALL_ITEMS, gw, NGW, scr);
    const float* cvec = C.in[1]; const float* wada = C.in[3]; float* adap = WSP(float, WS_ADAP);
    for (int it = gw; it < 96 * 16; it += NGW) { const int cc = it % 96, ks = it / 96; const int n = 64 * cc + C.lane; float a0 = 0.f, a1 = 0.f;
#pragma unroll 16
        for (int k = 0; k < 64; ++k) { const int kk = 64 * ks + k; const float w = wada[(size_t)kk * 6144 + n]; a0 += cvec[kk] * w; a1 += cvec[1024 + kk] * w; }
        adap[(ks * 2 + 0) * 6144 + n] = a0; adap[(ks * 2 + 1) * 6144 + n] = a1; }
}
__device__ __forceinline__ float ada_val(const Ctx& C, int b, int n) {
    const float* adap = WSP(const float, WS_ADAP); float s = C.in[4][n];
#pragma unroll
    for (int ks = 0; ks < 16; ++ks) s += adap[(ks * 2 + b) * 6144 + n];
    return s;
}
__device__ __forceinline__ void rms_mod_row(const float* xrow, bf16_t* orow, const LAS float* MA, const LAS float* MB, int lane, signed char* qrow, float* qscale) {
    const f32x4* xr = (const f32x4*)xrow + lane;
    f32x4 v[4]; float s = 0.f;
#pragma unroll
    for (int j = 0; j < 4; ++j) { v[j] = xr[64 * j]; s += (v[j][0] * v[j][0] + v[j][1] * v[j][1]) + (v[j][2] * v[j][2] + v[j][3] * v[j][3]); }
    const float rstd = 1.0f / sqrtf(wave_sum(s) * (1.0f / D) + RMS_EPS);
    u32x2* o8 = (u32x2*)orow + lane;
#pragma unroll
    for (int j = 0; j < 4; ++j) { const f32x4 a = *(const LAS f32x4*)(MA + 4 * lane + 256 * j), b = *(const LAS f32x4*)(MB + 4 * lane + 256 * j);
        const f32x4 h = v[j] * rstd * a + b; u32x2 w; w.x = pk2(h[0], h[1]); w.y = pk2(h[2], h[3]); o8[64 * j] = w; v[j] = h; }
    if (qrow) {
        float am = 0.f;
#pragma unroll
        for (int j = 0; j < 4; ++j)
#pragma unroll
            for (int k = 0; k < 4; ++k) am = fmaxf(am, fabsf(v[j][k]));
#pragma unroll
        for (int o = 1; o < 64; o <<= 1) am = fmaxf(am, __shfl_xor(am, o));
        const float inv = am > 0.f ? 127.0f / am : 0.f;
        if (lane == 0) *qscale = am > 0.f ? am * (1.0f / 127.0f) : 1.0f;
#pragma unroll
        for (int j = 0; j < 4; ++j) { int b4[4];
#pragma unroll
            for (int k = 0; k < 4; ++k) b4[k] = (int)fminf(fmaxf(__builtin_rintf(v[j][k] * inv), -127.0f), 127.0f);
            ((unsigned*)qrow)[lane + 64 * j] = (unsigned)(b4[0] & 255) | ((unsigned)(b4[1] & 255) << 8) | ((unsigned)(b4[2] & 255) << 16) | ((unsigned)b4[3] << 24); } }
}
__device__ __forceinline__ void rms_mod_row_bf16(const bf16_t* xrow, bf16_t* orow, const LAS float* MA, const LAS float* MB, int lane, signed char* qrow, float* qscale) {
    float v[16]; float s = 0.f;
#pragma unroll
    for (int j = 0; j < 2; ++j) { const u32x4 w = *(const u32x4*)(xrow + 512 * j + 8 * lane);
        v[8 * j + 0] = bf_lo(w.x); v[8 * j + 1] = bf_hi(w.x); v[8 * j + 2] = bf_lo(w.y); v[8 * j + 3] = bf_hi(w.y); v[8 * j + 4] = bf_lo(w.z); v[8 * j + 5] = bf_hi(w.z); v[8 * j + 6] = bf_lo(w.w); v[8 * j + 7] = bf_hi(w.w); }
#pragma unroll
    for (int k = 0; k < 16; ++k) s += v[k] * v[k];
    const float rstd = 1.0f / sqrtf(wave_sum(s) * (1.0f / D) + RMS_EPS);
#pragma unroll
    for (int j = 0; j < 2; ++j) { const LAS float* a = MA + 512 * j + 8 * lane; const LAS float* b = MB + 512 * j + 8 * lane;
        const f32x4 a0 = *(const LAS f32x4*)a, a1 = *(const LAS f32x4*)(a + 4), b0 = *(const LAS f32x4*)b, b1 = *(const LAS f32x4*)(b + 4);
        u32x4 w; w.x = pk2(v[8 * j + 0] * rstd * a0[0] + b0[0], v[8 * j + 1] * rstd * a0[1] + b0[1]); w.y = pk2(v[8 * j + 2] * rstd * a0[2] + b0[2], v[8 * j + 3] * rstd * a0[3] + b0[3]);
        w.z = pk2(v[8 * j + 4] * rstd * a1[0] + b1[0], v[8 * j + 5] * rstd * a1[1] + b1[1]); w.w = pk2(v[8 * j + 6] * rstd * a1[2] + b1[2], v[8 * j + 7] * rstd * a1[3] + b1[3]);
        *(u32x4*)(orow + 512 * j + 8 * lane) = w; }
    if (qrow) {
        float hq[16]; float am = 0.f;
#pragma unroll
        for (int j = 0; j < 2; ++j) { const LAS float* a = MA + 512 * j + 8 * lane; const LAS float* b = MB + 512 * j + 8 * lane;
#pragma unroll
            for (int k = 0; k < 8; ++k) { hq[8 * j + k] = v[8 * j + k] * rstd * a[k] + b[k]; am = fmaxf(am, fabsf(hq[8 * j + k])); } }
#pragma unroll
        for (int o = 1; o < 64; o <<= 1) am = fmaxf(am, __shfl_xor(am, o));
        const float inv = am > 0.f ? 127.0f / am : 0.f;
        if (lane == 0) *qscale = am > 0.f ? am * (1.0f / 127.0f) : 1.0f;
#pragma unroll
        for (int j = 0; j < 2; ++j) { unsigned w2[2];
#pragma unroll
            for (int d = 0; d < 2; ++d) { int b4[4];
#pragma unroll
                for (int k = 0; k < 4; ++k) b4[k] = (int)fminf(fmaxf(__builtin_rintf(hq[8 * j + 4 * d + k] * inv), -127.0f), 127.0f);
                w2[d] = (unsigned)(b4[0] & 255) | ((unsigned)(b4[1] & 255) << 8) | ((unsigned)(b4[2] & 255) << 16) | ((unsigned)b4[3] << 24); }
            *(u32x2*)(qrow + 512 * j + 8 * lane) = (u32x2){w2[0], w2[1]}; } }
}
__device__ __forceinline__ void p1_h1(const Ctx& C0) {
    PHASE_IDS();
    LAS float* MA = (LAS float*)C.lds;
    LAS float* MB = MA + 2048;
    for (int idx = C.tid; idx < 2048; idx += 512) { const int b = idx >> 10, col = idx & 1023;
        const float sh = ada_val(C, b, col), sc = ada_val(C, b, 1024 + col);
        MA[idx] = C.in[5][col] * (1.0f + sc); MB[idx] = sh; }
    if (blockIdx.x < NE) { const int e = blockIdx.x; bf16_t* wrt = WSP(bf16_t, WS_WRT) + (size_t)e * 1024;
        for (int k = C.tid; k < 1024; k += 512) wrt[k] = (bf16_t)f2bf(C.in[16][(size_t)k * 32 + e]); }
    {
        const int per = (2 * 6144 + C.G - 1) / C.G;
        for (int i = C.tid; i < per; i += 512) { const int idx = blockIdx.x * per + i; if (idx < 2 * 6144) WSP(float, WS_ADAF)[idx] = ada_val(C, idx / 6144, idx % 6144); }
    }
    __syncthreads();
    const int gw = C.vcu * NWAVES + C.wave, NGW = C.G * NWAVES;
    for (int m0 = gw; m0 < M; m0 += NGW) { const int m = XROW(m0); const int b = m >= SEQ; rms_mod_row(C.in[0] + (size_t)m * D, WSP(bf16_t, WS_H) + (size_t)m * D, MA + b * 1024, MB + b * 1024, C.lane, (signed char*)(C.ws + WS_H2Q) + (size_t)m * D, WSP(float, WS_SA) + m); }
    __syncthreads();
}
__device__ __forceinline__ void p3a_kmean(const Ctx& C0) {
    PHASE_IDS();
    LAS float* red = (LAS float*)C.lds;
    const bf16_t* kb = WSP(const bf16_t, WS_PROJ + 2 * PROJ_STRIDE);
    for (int it = blockIdx.x; it < 64; it += C.G) { const int b = it >> 5, n = it & 31;
        float a[8];
#pragma unroll
        for (int j = 0; j < 8; ++j) a[j] = 0.f;
        const bf16_t* src = kb + (size_t)(b * SEQ + 256 * n + 32 * C.wave) * 1024 + 8 * C.lane;
#pragma unroll 8
        for (int r = 0; r < 32; ++r) { const u32x4 v = *(const u32x4*)(src + (size_t)r * 1024);
            a[0] += bf_lo(v.x); a[1] += bf_hi(v.x); a[2] += bf_lo(v.y); a[3] += bf_hi(v.y); a[4] += bf_lo(v.z); a[5] += bf_hi(v.z); a[6] += bf_lo(v.w); a[7] += bf_hi(v.w); }
        __syncthreads();
#pragma unroll
        for (int j = 0; j < 8; ++j) red[C.wave * 512 + 8 * C.lane + j] = a[j];
        __syncthreads();
        { const int col = C.tid; float s = 0.f;
#pragma unroll
            for (int w = 0; w < 8; ++w) s += red[w * 512 + col];
            const int h = col >> 6, d = col & 63; WSP(float, WS_KMEAN)[((b * 8 + h) * 32 + n) * 64 + d] = s * (1.0f / 256.0f); }
    }
    __syncthreads();
}
__device__ __forceinline__ void p3b_gate(const Ctx& C0) {
    PHASE_IDS();
    LAS float* km = (LAS float*)C.lds;
    const bf16_t* qb = WSP(const bf16_t, WS_PROJ + 1 * PROJ_STRIDE) + 512;
    unsigned* cnt = WSP(unsigned, WS_CTL) + CW_MCNT; unsigned* list = WSP(unsigned, WS_LIST);
    for (int it = blockIdx.x; it < 256; it += C.G) { const int bh = it >> 4, qc = it & 15, b = bh >> 3, h = bh & 7;
        __syncthreads();
        for (int i = C.tid; i < 2048; i += 512) km[i] = WSP(const float, WS_KMEAN)[bh * 2048 + i];
        __syncthreads();
        const int q = 512 * qc + C.tid, own = q >> 8;
        u32x4 qv[8];
        { const u32x4* qp = (const u32x4*)(qb + (size_t)(b * SEQ + q) * 1024 + h * 64);
#pragma unroll
            for (int j = 0; j < 8; ++j) qv[j] = qp[j]; }
        float v0 = -INFINITY, v1 = -INFINITY, v2 = -INFINITY; int i0 = 0, i1 = 0, i2 = 0;
        const int nmax = ((512 * qc + 511) >> 8);
        for (int n = 0; n < nmax; ++n) { const LAS f32x4* kr = (const LAS f32x4*)(km + n * 64); float s = 0.f;
#pragma unroll
            for (int j = 0; j < 8; ++j) { const f32x4 ka = kr[2 * j], kb2 = kr[2 * j + 1];
                s += bf_lo(qv[j].x) * ka[0] + bf_hi(qv[j].x) * ka[1] + bf_lo(qv[j].y) * ka[2] + bf_hi(qv[j].y) * ka[3]
                   + bf_lo(qv[j].z) * kb2[0] + bf_hi(qv[j].z) * kb2[1] + bf_lo(qv[j].w) * kb2[2] + bf_hi(qv[j].w) * kb2[3]; }
            if (n < own) {
                if (s > v0) { v2 = v1; i2 = i1; v1 = v0; i1 = i0; v0 = s; i0 = n; }
                else if (s > v1) { v2 = v1; i2 = i1; v1 = s; i1 = n; }
                else if (s > v2) { v2 = s; i2 = n; }
            } }
        const int nsel = own < 3 ? own : 3;
        LAS unsigned* lc = (LAS unsigned*)(C.lds + 8192);
        if (C.tid < 128) lc[C.tid] = 0u;
        __syncthreads();
        const int l0 = 2 * i0 + (i0 == own - 1 ? 1 : 0), l1 = 2 * i1 + (i1 == own - 1 ? 1 : 0), l2 = 2 * i2 + (i2 == own - 1 ? 1 : 0);
        unsigned lp0 = 0u, lp1 = 0u, lp2 = 0u;
        if (nsel > 0) lp0 = atomicAdd((unsigned*)(lc + l0), 1u);
        if (nsel > 1) lp1 = atomicAdd((unsigned*)(lc + l1), 1u);
        if (nsel > 2) lp2 = atomicAdd((unsigned*)(lc + l2), 1u);
        __syncthreads();
        if (C.tid < 64) { const unsigned c = lc[C.tid]; lc[64 + C.tid] = c ? atomicAdd(cnt + bh * 64 + C.tid, c) : 0u; }
        __syncthreads();
#pragma unroll
        for (int j = 0; j < 3; ++j) if (j < nsel) { const int n = j == 0 ? i0 : (j == 1 ? i1 : i2); const int l = j == 0 ? l0 : (j == 1 ? l1 : l2); const unsigned pos = lc[64 + l] + (j == 0 ? lp0 : (j == 1 ? lp1 : lp2));
            list[(size_t)bh * LIST_PER_BH + 256 * (31 * n - (n * (n - 1)) / 2) + ((l & 1) ? 0 : 256) + pos] = (unsigned)q | ((unsigned)j << 13); }
    }
    __syncthreads();
}
__device__ __forceinline__ void build_bias_tables(const Ctx& C) {
    LAS float* bt = (LAS float*)(C.lds + AT_BT);
    for (int idx = C.tid; idx < 12 * BT_STR; idx += 512) { const int hd = idx / BT_STR, n = idx % BT_STR;
        if (n >= 128) { bt[idx] = 0.f; continue; }
        int bk;
        if (n < 16) bk = n; else { const float nf = (float)n; int lg = 16 + (int)(logf(nf / 16.0f) / logf(8.0f) * 16.0f); bk = lg < 31 ? lg : 31; }
        bt[idx] = (C.in[2][bk * 12 + hd] - C.in[2][31 * 12 + hd]) * LOG2E; }
}
#if SIMPLE_DIFF
__device__ __forceinline__ void diff_unit(const Ctx& C, int b, int h, int qblk, float lam) {
    const int lane = C.lane, c = lane & 15, g = lane >> 4, wid = C.wave;
    const bf16_t* qka = WSP(const bf16_t, WS_PROJ);
    const bf16_t* va = WSP(const bf16_t, WS_PROJ + PROJ_STRIDE);
    const int q0 = qblk * 128, q = q0 + wid * 16 + c, NT = 2 * qblk + 2;
    const LAS float* bt = (const LAS float*)(C.lds + AT_BT) + h * 128;
    f32x4 o0[8];
    for (int map = 0; map < 2; ++map) {
        bf16x8 qf[2];
#pragma unroll
        for (int ks = 0; ks < 2; ++ks) qf[ks] = *(const bf16x8*)(qka + (size_t)(b * SEQ + q) * 1024 + h * 128 + map * 64 + 32 * ks + 8 * g);
        const bf16_t* kg = qka + (size_t)(b * SEQ) * 1024 + 512 + h * 128 + map * 64;
        const bf16_t* vg = va + (size_t)(b * SEQ) * 1024 + h * 128;
        float m_run = -1e30f, l_run = 0.f; f32x4 o[8];
#pragma unroll
        for (int dt = 0; dt < 8; ++dt) o[dt] = (f32x4){0.f, 0.f, 0.f, 0.f};
        TileRegs<2> tr; tile_fetch<2>(tr, kg, vg, C.tid);
        for (int t = 0; t < NT; ++t) {
            __syncthreads();
            tile_store<2>(tr, C.lds, C.tid);
            __syncthreads();
            if (t + 1 < NT) tile_fetch<2>(tr, kg + (size_t)(t + 1) * 64 * 1024, vg + (size_t)(t + 1) * 64 * 1024, C.tid);
            attn_tile<8>(C.lds, lane, qf, o, m_run, l_run, q, 64 * t, true, bt);
        }
        float lt = l_run; lt += __shfl_xor(lt, 16); lt += __shfl_xor(lt, 32);
        const float rl = 1.0f / lt;
#pragma unroll
        for (int i = 0; i < 4; ++i) { const float ri = __shfl(rl, 4 * g + i);
#pragma unroll
            for (int dt = 0; dt < 8; ++dt) { if (map == 0) o0[dt][i] = o[dt][i] * ri; else o0[dt][i] = o0[dt][i] - lam * (o[dt][i] * ri); } }
    }
    bf16_t* y = WSP(bf16_t, WS_Y);
#pragma unroll
    for (int i = 0; i < 4; ++i) { float ss = 0.f;
#pragma unroll
        for (int dt = 0; dt < 8; ++dt) ss += o0[dt][i] * o0[dt][i];
        ss += __shfl_xor(ss, 1); ss += __shfl_xor(ss, 2); ss += __shfl_xor(ss, 4); ss += __shfl_xor(ss, 8);
        const float rstd = 1.0f / sqrtf(ss * (1.0f / 128.0f) + RMS_EPS);
        bf16_t* yr = y + (size_t)(b * SEQ + q0 + wid * 16 + 4 * g + i) * 1024 + h * 128 + c;
#pragma unroll
        for (int dt = 0; dt < 8; ++dt) yr[16 * dt] = (bf16_t)f2bf(o0[dt][i] * rstd * C.in[11][16 * dt + c] * 0.8f); }
}
#endif
#if 0
__device__ __forceinline__ void moba_item(const Ctx& C, int b, int h, int n, bool own, int half, const unsigned* lst, int lcnt, int chunk) {
    const int lane = C.lane, c = lane & 15, g = lane >> 4, wid = C.wave;
    const bf16_t* qb = WSP(const bf16_t, WS_PROJ + PROJ_STRIDE) + 512;
    const bf16_t* kv = WSP(const bf16_t, WS_PROJ + 2 * PROJ_STRIDE);
    int qtok, jslot; bool valid;
    if (own) { qtok = 256 * n + 128 * half + wid * 16 + c; jslot = 3; valid = true; }
    else { const int idx = chunk * 128 + wid * 16 + c; valid = idx < lcnt; const unsigned e = lst[valid ? idx : 0]; qtok = (int)(e & 8191u); jslot = (int)(e >> 13); }
    bf16x8 qf[2];
#pragma unroll
    for (int ks = 0; ks < 2; ++ks) qf[ks] = *(const bf16x8*)(qb + (size_t)(b * SEQ + qtok) * 1024 + h * 64 + 32 * ks + 8 * g);
    const bf16_t* kg = kv + (size_t)(b * SEQ + 256 * n) * 1024 + h * 64;
    const bf16_t* vg = kg + 512;
    const LAS float* bt = (const LAS float*)(C.lds + AT_BT) + (4 + h) * 128;
    const int NT = own ? 2 * (half + 1) : 4;
    float m_run = -1e30f, l_run = 0.f; f32x4 o[4];
#pragma unroll
    for (int dt = 0; dt < 4; ++dt) o[dt] = (f32x4){0.f, 0.f, 0.f, 0.f};
    TileRegs<1> tr; tile_fetch<1>(tr, kg, vg, C.tid);
    for (int t = 0; t < NT; ++t) {
        __syncthreads();
        tile_store<1>(tr, C.lds, C.tid);
        __syncthreads();
        if (t + 1 < NT) tile_fetch<1>(tr, kg + (size_t)(t + 1) * 64 * 1024, vg + (size_t)(t + 1) * 64 * 1024, C.tid);
        attn_tile<4>(C.lds, lane, qf, o, m_run, l_run, qtok, 256 * n + 64 * t, own, bt);
    }
    float lt = l_run; lt += __shfl_xor(lt, 16); lt += __shfl_xor(lt, 32);
    const int slot = ((b * SEQ + qtok) * 8 + h) * 4 + jslot;
    if (g == 0 && valid) { f32x2 ml; ml[0] = m_run; ml[1] = lt; *(f32x2*)(WSP(float, WS_PML) + (size_t)slot * 2) = ml; }
    bf16_t* po = WSP(bf16_t, WS_PO);
#pragma unroll
    for (int i = 0; i < 4; ++i) { const int sl = __shfl(slot, 4 * g + i); const int vl = __shfl((int)valid, 4 * g + i);
        if (vl) {
#pragma unroll
            for (int dt = 0; dt < 4; ++dt) po[(size_t)sl * 64 + 16 * dt + c] = (bf16_t)f2bf(o[dt][i]); } }
}
#endif
constexpr int MB_BUF = 65536, MB_OST = LDSCTL_OFF + 14336;
struct MItem { int valid, b, h, n, own, half, near, lcnt, chunk, lbase; };
__device__ __forceinline__ MItem moba_decode(int it, int nitems, const LAS int* pre, const unsigned* cnt) {
    MItem m; m.valid = it < nitems ? 1 : 0; if (!m.valid) it = 0;
    if (it < 1024) { const int bh = it >> 6, r = it & 63; m.b = bh >> 3; m.h = bh & 7; m.n = r >> 1; m.own = 1; m.half = (r ^ (bh >> 2)) & 1; m.near = 0;
        m.lcnt = 128; m.chunk = 0; m.lbase = 0; }
    else { const int gi = it - 1024; int lo = 0, hi = 1023;
        while (lo < hi) { const int mid = (lo + hi + 1) >> 1; if (pre[mid] <= gi) lo = mid; else hi = mid - 1; }
        const int L = lo, bh = L >> 6, n = (L >> 1) & 31, near = L & 1;
        m.b = bh >> 3; m.h = bh & 7; m.n = n; m.own = 0; m.half = 0; m.near = near; m.lcnt = (int)__hip_atomic_load(cnt + L, RLX_AGENT); m.chunk = gi - pre[L];
        m.lbase = bh * LIST_PER_BH + 256 * (31 * n - (n * (n - 1)) / 2) + (near ? 0 : 256); }
    return m;
}
__device__ __forceinline__ unsigned moba_entry(const Ctx& C, const MItem& m) {
    const int c = C.lane & 15;
    if (m.own) return (unsigned)(256 * m.n + 128 * m.half + C.wave * 16 + c) | (3u << 13) | (1u << 15);
    const int idx = m.chunk * 128 + C.wave * 16 + c; const bool v = idx < m.lcnt;
    const unsigned e = WSP(const unsigned, WS_LIST)[(size_t)m.lbase + (v ? idx : 0)];
    return (e & 0x7fffu) | (v ? (1u << 15) : 0u);
}
__device__ __forceinline__ void moba_qload(const Ctx& C, const MItem& m, unsigned ent, bf16x8 (&qf)[2]) {
    const bf16_t* qb = WSP(const bf16_t, WS_PROJ + PROJ_STRIDE) + 512; const int g = C.lane >> 4;
#pragma unroll
    for (int ks = 0; ks < 2; ++ks) qf[ks] = *(const bf16x8*)(qb + (size_t)(m.b * SEQ + (int)(ent & 8191u)) * 1024 + m.h * 64 + 32 * ks + 8 * g);
}
__device__ __forceinline__ void moba_dma(const Ctx& C, const MItem& m, int bo) {
    const bf16_t* kg = WSP(const bf16_t, WS_PROJ + 2 * PROJ_STRIDE) + (size_t)(m.b * SEQ + 256 * m.n) * 1024 + m.h * 64;
    const int r8 = C.lane >> 3, sch = (C.lane & 7) ^ r8;
#pragma unroll
    for (int j = 0; j < 4; ++j) { const int p = C.wave * 4 + j; const bf16_t* src = kg + (size_t)(8 * p + r8) * 1024 + sch * 8;
        __builtin_amdgcn_global_load_lds((const unsigned*)src, (LAS unsigned*)(C.lds + bo + p * 1024), 16, 0, 0);
        __builtin_amdgcn_global_load_lds((const unsigned*)(src + 512), (LAS unsigned*)(C.lds + bo + 32768 + p * 1024), 16, 0, 0); }
}
constexpr int MB_STG = 2304;
__device__ __forceinline__ void moba_flush(const Ctx& C) {
    const LAS unsigned char* stg = C.lds + MB_OST + C.wave * MB_STG; const int lane = C.lane;
    const LAS int* sslot = (const LAS int*)(stg + 2176);
    bf16_t* po = WSP(bf16_t, WS_PO);
#pragma unroll
    for (int r = 0; r < 2; ++r) { const int row = (lane >> 3) + 8 * r, ch = lane & 7; const u32x4 v = *(const LAS u32x4*)(stg + row * 128 + ch * 16); const int sl = sslot[row];
        if (sl >= 0) *(u32x4*)(po + (size_t)sl * 64 + ch * 8) = v; }
    if (lane < 16) { const int sl = sslot[lane]; const f32x2 ml = *(const LAS f32x2*)(stg + 2048 + lane * 8); if (sl >= 0) *(f32x2*)(WSP(float, WS_PML) + (size_t)sl * 2) = ml; }
}
__device__ __forceinline__ void moba_compute(const Ctx& C, const MItem& m, unsigned ent, const bf16x8 (&qf)[2], int bo, int mode) {
    if (!(mode & 2)) return;
    const int lane = C.lane, c = lane & 15, g = lane >> 4, cx = c & 7;
    const int qtok = (int)(ent & 8191u), jslot = (int)((ent >> 13) & 3u), valid = (int)((ent >> 15) & 1u);
    const int nkt = m.own ? 8 * (m.half + 1) : 16;
    const LAS float* bt = (const LAS float*)(C.lds + AT_BT) + (4 + m.h) * BT_STR;
    f32x4 s[16];
    const LAS unsigned char* kb = C.lds + bo + c * 128;
    const int kc0 = ((0 + g) ^ cx) << 4, kc1 = ((4 + g) ^ cx) << 4;
#define MB_BIAS(t4) do { if (m.own | m.near) { const int kbase_ = 256 * m.n + 64 * (t4); \
            _Pragma("unroll") for (int k4 = 0; k4 < 4; ++k4) _Pragma("unroll") for (int i = 0; i < 4; ++i) { const int kt_ = 4 * (t4) + k4; const int dist = qtok - (kbase_ + 16 * k4 + 4 * g + i); \
                const unsigned di = (unsigned)dist < 128u ? (unsigned)dist : 128u; const float v = s[kt_][i] + bt[di]; s[kt_][i] = (m.own && dist < 0) ? -INFINITY : v; } } } while (0)
#pragma unroll
    for (int kt = 0; kt < 4; ++kt) { const bf16x8 a0 = *(const LAS bf16x8*)(kb + kt * 2048 + kc0), a1 = *(const LAS bf16x8*)(kb + kt * 2048 + kc1);
        f32x4 z = (f32x4){0.f, 0.f, 0.f, 0.f}; z = __builtin_amdgcn_mfma_f32_16x16x32_bf16(a0, qf[0], z, 0, 0, 0); s[kt] = __builtin_amdgcn_mfma_f32_16x16x32_bf16(a1, qf[1], z, 0, 0, 0); }
    MB_BIAS(0);
    float mx = fmaxf(fmaxf(s[0][0], s[0][1]), fmaxf(s[0][2], s[0][3]));
#pragma unroll
    for (int kt = 1; kt < 4; ++kt) mx = fmaxf(mx, fmaxf(fmaxf(s[kt][0], s[kt][1]), fmaxf(s[kt][2], s[kt][3])));
    mx = fmaxf(mx, __shfl_xor(mx, 16)); mx = fmaxf(mx, __shfl_xor(mx, 32));
    const f32x4 negm = (f32x4){-mx, -mx, -mx, -mx};
#pragma unroll
    for (int kt = 0; kt < 4; ++kt) s[kt] += negm;
#define MB_EXP4(t) do { s[t][0] = __builtin_amdgcn_exp2f(s[t][0]); s[t][1] = __builtin_amdgcn_exp2f(s[t][1]); s[t][2] = __builtin_amdgcn_exp2f(s[t][2]); s[t][3] = __builtin_amdgcn_exp2f(s[t][3]); } while (0)
#pragma unroll
    for (int kt = 4; kt < 16; ++kt) {
        if (kt < nkt) { const bf16x8 a0 = *(const LAS bf16x8*)(kb + kt * 2048 + kc0), a1 = *(const LAS bf16x8*)(kb + kt * 2048 + kc1);
            f32x4 z = __builtin_amdgcn_mfma_f32_16x16x32_bf16(a0, qf[0], negm, 0, 0, 0); s[kt] = __builtin_amdgcn_mfma_f32_16x16x32_bf16(a1, qf[1], z, 0, 0, 0); }
        else s[kt] = (f32x4){-INFINITY, -INFINITY, -INFINITY, -INFINITY};
        if (kt < 8) { MB_EXP4(kt - 4); asm volatile("" : "+v"(s[kt - 4])); }
        __builtin_amdgcn_sched_barrier(0);
    }
    if (4 < nkt) MB_BIAS(1);
    if (8 < nkt) { MB_BIAS(2); MB_BIAS(3); }
#undef MB_BIAS
    f32x4 o[4], osum = (f32x4){0.f, 0.f, 0.f, 0.f};
#pragma unroll
    for (int dt = 0; dt < 4; ++dt) o[dt] = (f32x4){0.f, 0.f, 0.f, 0.f};
    const short one = (c == 0) ? (short)0x3F80 : (short)0; const bf16x8 ones = (bf16x8){one, one, one, one, one, one, one, one};
    const int rv = 4 * g + (c >> 2), x7 = rv & 7, hb = (c & 3) >> 1;
    const LAS unsigned char* vb = C.lds + bo + 32768 + rv * 128 + 8 * (c & 1);
    int cv[4];
#pragma unroll
    for (int dt = 0; dt < 4; ++dt) cv[dt] = ((2 * dt + hb) ^ x7) << 4;
#pragma unroll
    for (int kk = 0; kk < 8; ++kk) {
        if (2 * kk < nkt) { u32x4 w; w.x = cvt_pk_bf16(s[2 * kk][0], s[2 * kk][1]); w.y = cvt_pk_bf16(s[2 * kk][2], s[2 * kk][3]);
            w.z = cvt_pk_bf16(s[2 * kk + 1][0], s[2 * kk + 1][1]); w.w = cvt_pk_bf16(s[2 * kk + 1][2], s[2 * kk + 1][3]); const bf16x8 pa = __builtin_bit_cast(bf16x8, w);
            osum = __builtin_amdgcn_mfma_f32_16x16x32_bf16(pa, ones, osum, 0, 0, 0);
#pragma unroll
            for (int dt = 0; dt < 4; ++dt) { const s16x4 lo = tr16(vb + (32 * kk) * 128 + cv[dt]), hi = tr16(vb + (32 * kk + 16) * 128 + cv[dt]);
                const bf16x8 bfr = (bf16x8){lo[0], lo[1], lo[2], lo[3], hi[0], hi[1], hi[2], hi[3]};
                o[dt] = __builtin_amdgcn_mfma_f32_16x16x32_bf16(pa, bfr, o[dt], 0, 0, 0); } }
        if (kk < 6 && 2 * kk + 4 < nkt) { MB_EXP4(2 * kk + 4); MB_EXP4(2 * kk + 5); asm volatile("" : "+v"(s[2 * kk + 4]), "+v"(s[2 * kk + 5])); }
        __builtin_amdgcn_sched_barrier(0);
    }
#undef MB_EXP4
    if (!(mode & 1)) return;
    LAS unsigned char* stg = C.lds + MB_OST + C.wave * MB_STG;
    LAS bf16_t* so = (LAS bf16_t*)stg;
#pragma unroll
    for (int i = 0; i < 4; ++i)
#pragma unroll
        for (int dt = 0; dt < 4; ++dt) so[(4 * g + i) * 64 + 16 * dt + c] = (bf16_t)f2bf(o[dt][i]);
    const int slot = valid ? ((m.b * SEQ + qtok) * 8 + m.h) * 4 + jslot : -1;
    if (g == 0) { ((LAS int*)(stg + 2176))[c] = slot; ((LAS float*)(stg + 2048))[2 * c] = mx; }
    if (c == 0) {
#pragma unroll
        for (int i = 0; i < 4; ++i) ((LAS float*)(stg + 2048))[2 * (4 * g + i) + 1] = osum[i]; }
}
__device__ __forceinline__ MItem moba_item_at(const LAS int* tab, int j) {
    MItem m; const int w0 = __builtin_amdgcn_readfirstlane(tab[4 * j]), w1 = __builtin_amdgcn_readfirstlane(tab[4 * j + 1]), w2 = __builtin_amdgcn_readfirstlane(tab[4 * j + 2]), w3 = __builtin_amdgcn_readfirstlane(tab[4 * j + 3]);
    m.valid = (j < 32 && w1 >= 0) ? 1 : 0; const int bh = w0 & 255; m.b = bh >> 3; m.h = bh & 7; m.n = (w0 >> 8) & 255; m.own = (w0 >> 16) & 1; m.half = (w0 >> 17) & 1; m.near = (w0 >> 18) & 1; m.lcnt = w1; m.chunk = w2; m.lbase = w3; return m;
}
__device__ __forceinline__ void moba_phase(const Ctx& C, const LAS int* pre, const unsigned* cnt, int mode) {
    const int nitems = 1024 + pre[1024]; const int G = C.G;
    LAS int* tab = (LAS int*)(C.lds + LDSCTL_OFF + 7424);
    if (C.tid < 33) { MItem m = moba_decode(C.vcu + C.tid * G, nitems, pre, cnt); if (C.tid == 32) m.valid = 0;
        tab[4 * C.tid] = (m.b * 8 + m.h) | (m.n << 8) | (m.own << 16) | (m.half << 17) | (m.near << 18); tab[4 * C.tid + 1] = m.valid ? m.lcnt : -1; tab[4 * C.tid + 2] = m.chunk; tab[4 * C.tid + 3] = m.lbase; }
    __syncthreads();
    int j = 0;
    MItem m0 = moba_item_at(tab, 0), m1 = moba_item_at(tab, 1);
    unsigned e0 = 0u, e1 = 0u; bf16x8 qf0[2];
    qf0[0] = (bf16x8){0, 0, 0, 0, 0, 0, 0, 0}; qf0[1] = qf0[0];
    if (m0.valid) { e0 = moba_entry(C, m0); moba_qload(C, m0, e0, qf0); moba_dma(C, m0, 0); }
    if (m1.valid) e1 = moba_entry(C, m1);
    int bo = 0; bool pending = false;
    while (m0.valid) {
        VM_WAIT(); __syncthreads();
        if (pending) moba_flush(C);
        bf16x8 qf1[2]; qf1[0] = qf0[0]; qf1[1] = qf0[1];
        if (m1.valid) moba_qload(C, m1, e1, qf1);
        const MItem m2 = moba_item_at(tab, j + 2 < 32 ? j + 2 : 32);
        unsigned e2 = 0u; if (m2.valid) e2 = moba_entry(C, m2);
        if (m1.valid) moba_dma(C, m1, bo ^ MB_BUF);
        moba_compute(C, m0, e0, qf0, bo, mode); pending = (mode & 3) == 3;
        m0 = m1; m1 = m2; e0 = e1; e1 = e2; qf0[0] = qf1[0]; qf0[1] = qf1[1]; bo ^= MB_BUF; ++j;
    }
    if (pending) { LDS_WAIT(); moba_flush(C); }
    VM_WAIT(); __syncthreads();
}
#ifndef PROBE_SUB
#define PROBE_SUB 3
#endif
__device__ __forceinline__ void p4_attention(const Ctx& C0, int sub, bool gate) {
    if (gate) { p3b_gate(C0);
        asm volatile("s_waitcnt vmcnt(0)" ::: "memory"); __syncthreads();
        if (threadIdx.x == 0) { __builtin_amdgcn_fence(__ATOMIC_RELEASE, "agent"); asm volatile("s_waitcnt vmcnt(0)" ::: "memory"); xb_add((unsigned*)(C0.ws + WS_CTL) + CW_GDONE, 1u); } }
    PHASE_IDS();
    __syncthreads();
    build_bias_tables(C);
    float lam;
    { const float a = wave_sum(C.in[7][C.lane] * C.in[8][C.lane]), b2 = wave_sum(C.in[9][C.lane] * C.in[10][C.lane]); lam = expf(a) - expf(b2) + 0.2f; }
    __syncthreads();
#if SIMPLE_DIFF
    if (sub & 1) for (int p = blockIdx.x; p < 256; p += C.G) { const int bh = p >> 5, qa = p & 31;
        diff_unit(C, bh >> 2, bh & 3, qa, lam); diff_unit(C, bh >> 2, bh & 3, 63 - qa, lam); }
#else
#if NATIVE_DIFF
    {
        const int grp = blockIdx.x & 7, rank = blockIdx.x >> 3;
        if ((sub & 1) && rank < NCONV) { LAS float* scr = (LAS float*)(C.lds + C.wave * 8448);
            const int wi = (rank * 8 + grp) * NWAVES + C.wave, nw = NCONV * 8 * NWAVES;
            conv_q_blocks<0>(C.in[18], C.ws, C.lds, C.wave, rank * 8 + grp, NCONV * 8);
            conv_range(C, NE * 16 * 64, CONV_MOE_ITEMS, wi, nw, scr); }
        unsigned* qctr = WSP(unsigned, WS_CTL) + CW_AQ + 64 * grp;
        LAS int* qslot = (LAS int*)(C.lds + LDSCTL_OFF + 512);
        const attn_nat::bf16* qk = (const attn_nat::bf16*)WSP(const bf16_t, WS_PROJ); const attn_nat::bf16* vv = (const attn_nat::bf16*)WSP(const bf16_t, WS_PROJ + PROJ_STRIDE);
        attn_nat::bf16* oa = (attn_nat::bf16*)WSP(bf16_t, WS_OA);
        if (sub & 1) for (;;) {
            __syncthreads();
            if (C.tid == 0) *qslot = (int)atomicAdd(qctr, 1u);
            __syncthreads();
            const int j = __builtin_amdgcn_readfirstlane(*qslot);
            if (j >= 64) break;
            const int qb = 31 - (j >> 1), st = grp + 8 * (j & 1), b = st >> 3, h = (st >> 1) & 3, mp = st & 1;
            const LAS float* bth = (const LAS float*)(C.lds + AT_BT) + h * BT_STR;
            attn_nat::attn_unit<8>(b, qb, qk, qk, vv, oa, h * 128 + mp * 64, 512 + h * 128 + mp * 64, h * 128, mp * 512 + h * 128, bth, C.ldsg); }
    }
#else
    if (sub & 1) for (int v = C.vcu; v < 256; v += C.G) { const int bvh = v >> 3, s = v & 7, b = bvh >> 4, vh = bvh & 15, h = vh >> 2, mp = (vh >> 1) & 1, vhf = vh & 1;
        const attn_body::bf16* qk = (const attn_body::bf16*)WSP(const bf16_t, WS_PROJ); const attn_body::bf16* vv = (const attn_body::bf16*)WSP(const bf16_t, WS_PROJ + PROJ_STRIDE);
        attn_body::bf16* oa = (attn_body::bf16*)WSP(bf16_t, WS_OA);
        const LAS float* bth = (const LAS float*)(C.lds + AT_BT) + h * BT_STR;
#pragma unroll 1
        for (int i = 0; i < 4; ++i) { const int qb = (i == 0) ? s : (i == 1) ? 15 - s : (i == 2) ? 16 + s : 31 - s;
            attn_body::attn_unit<8>(b, qb, qk, qk, vv, oa, h * 128 + mp * 64, 512 + h * 128 + mp * 64, h * 128 + vhf * 64, mp * 512 + h * 128 + vhf * 64, bth, C.ldsg); } }
#endif
#endif
    LAS int* pre = (LAS int*)(C.lds + AT_MISC);
    LAS int* wtot = pre + 1032;
    const unsigned* cnt = WSP(const unsigned, WS_CTL) + CW_MCNT;
    if (gate && C.tid == 0) { unsigned* gd = WSP(unsigned, WS_CTL) + CW_GDONE; unsigned* tmo = WSP(unsigned, WS_CTL) + CW_TMO; unsigned sp = 0u;
        while (xb_ld(gd) < (unsigned)C.G) { __builtin_amdgcn_s_sleep(2); if ((++sp & 255u) == 0u) { if (xb_ld(tmo)) break; if (sp > XB_SPIN_CAP) { atomicAdd(tmo, 1u); break; } } }
        __builtin_amdgcn_fence(__ATOMIC_ACQUIRE, "agent"); asm volatile("s_waitcnt vmcnt(0)" ::: "memory"); }
    __syncthreads();
    { const int L = 2 * C.tid; const int n0_ = ((int)__hip_atomic_load(cnt + L, RLX_AGENT) + 127) >> 7, n1_ = ((int)__hip_atomic_load(cnt + L + 1, RLX_AGENT) + 127) >> 7; const int nch = n0_ + n1_;
        int inc = nch;
#pragma unroll
        for (int o = 1; o < 64; o <<= 1) { const int t = __shfl_up(inc, o); if (C.lane >= o) inc += t; }
        if (C.lane == 63) wtot[C.wave] = inc;
        __syncthreads();
        int base = 0;
        for (int w = 0; w < C.wave; ++w) base += wtot[w];
        pre[L] = base + inc - nch; pre[L + 1] = base + inc - nch + n0_;
        if (C.tid == 511) pre[1024] = base + inc;
    }
    __syncthreads();
    if (sub & 2) moba_phase(C, pre, cnt, sub >> 2);
    __syncthreads();
}
__device__ __forceinline__ void p5_ycombine(const Ctx& C0) {
    PHASE_IDS();
    const int gw = C.vcu * NWAVES + C.wave, NGW = C.G * NWAVES;
    const bf16_t* po = WSP(const bf16_t, WS_PO); const float* pml = WSP(const float, WS_PML); bf16_t* y = WSP(bf16_t, WS_Y);
#if !SIMPLE_DIFF
    {
        const float lam = expf(wave_sum(C.in[7][C.lane] * C.in[8][C.lane])) - expf(wave_sum(C.in[9][C.lane] * C.in[10][C.lane])) + 0.2f;
        const bf16_t* oa = WSP(const bf16_t, WS_OA);
        const f32x4 g0 = *(const f32x4*)(C.in[11] + 8 * (C.lane & 15)), g1 = *(const f32x4*)(C.in[11] + 8 * (C.lane & 15) + 4);
        for (int m0 = gw; m0 < M; m0 += NGW) { const int m = XROW(m0); const u32x4 a = *(const u32x4*)(oa + (size_t)m * 1024 + 8 * C.lane), b2 = *(const u32x4*)(oa + (size_t)m * 1024 + 512 + 8 * C.lane);
            float v[8];
            v[0] = bf_lo(a.x) - lam * bf_lo(b2.x); v[1] = bf_hi(a.x) - lam * bf_hi(b2.x); v[2] = bf_lo(a.y) - lam * bf_lo(b2.y); v[3] = bf_hi(a.y) - lam * bf_hi(b2.y);
            v[4] = bf_lo(a.z) - lam * bf_lo(b2.z); v[5] = bf_hi(a.z) - lam * bf_hi(b2.z); v[6] = bf_lo(a.w) - lam * bf_lo(b2.w); v[7] = bf_hi(a.w) - lam * bf_hi(b2.w);
            float ss = 0.f;
#pragma unroll
            for (int k = 0; k < 8; ++k) ss += v[k] * v[k];
            ss += __shfl_xor(ss, 1); ss += __shfl_xor(ss, 2); ss += __shfl_xor(ss, 4); ss += __shfl_xor(ss, 8);
            const float r = 0.8f / sqrtf(ss * (1.0f / 128.0f) + RMS_EPS);
            u32x4 w; w.x = pk2(v[0] * r * g0[0], v[1] * r * g0[1]); w.y = pk2(v[2] * r * g0[2], v[3] * r * g0[3]); w.z = pk2(v[4] * r * g1[0], v[5] * r * g1[1]); w.w = pk2(v[6] * r * g1[2], v[7] * r * g1[3]);
            *(u32x4*)(y + (size_t)m * 1024 + 8 * C.lane) = w; }
    }
#endif
    for (int m0 = gw; m0 < M; m0 += NGW) { const int m = XROW(m0); const int h = C.lane >> 3, dch = C.lane & 7; const int own = (m & (SEQ - 1)) >> 8, nsel = own < 3 ? own : 3;
        const size_t s0 = ((size_t)m * 8 + h) * 4;
        float mm[4], ll[4]; u32x4 ov[4];
#pragma unroll
        for (int j = 0; j < 4; ++j) { const bool use = (j == 3) || (j < nsel);
            if (use) { const f32x2 ml = *(const f32x2*)(pml + (s0 + j) * 2); mm[j] = ml[0]; ll[j] = ml[1]; ov[j] = *(const u32x4*)(po + (s0 + j) * 64 + 8 * dch); }
            else { mm[j] = -INFINITY; ll[j] = 0.f; ov[j] = (u32x4){0u, 0u, 0u, 0u}; } }
        const float mx = fmaxf(fmaxf(mm[0], mm[1]), fmaxf(mm[2], mm[3]));
        float den = 0.f; float acc[8];
#pragma unroll
        for (int k = 0; k < 8; ++k) acc[k] = 0.f;
#pragma unroll
        for (int j = 0; j < 4; ++j) { const float w = __builtin_amdgcn_exp2f(mm[j] - mx); den += w * ll[j];
            acc[0] += w * bf_lo(ov[j].x); acc[1] += w * bf_hi(ov[j].x); acc[2] += w * bf_lo(ov[j].y); acc[3] += w * bf_hi(ov[j].y);
            acc[4] += w * bf_lo(ov[j].z); acc[5] += w * bf_hi(ov[j].z); acc[6] += w * bf_lo(ov[j].w); acc[7] += w * bf_hi(ov[j].w); }
        const float r = 1.0f / den;
        u32x4 w; w.x = pk2(acc[0] * r, acc[1] * r); w.y = pk2(acc[2] * r, acc[3] * r); w.z = pk2(acc[4] * r, acc[5] * r); w.w = pk2(acc[6] * r, acc[7] * r);
        *(u32x4*)(y + (size_t)m * 1024 + 512 + h * 64 + 8 * dch) = w; }
}
__device__ __forceinline__ void p8_router(const Ctx& C0) {
    PHASE_IDS();
    LAS float* MA = (LAS float*)(C.lds + LDSCTL_OFF + 2048); LAS float* MB = MA + 2048;
    LAS int* hist = (LAS int*)(C.lds + LDSCTL_OFF + 2048 + 16384);
    LAS float* xch = (LAS float*)(C.lds + LDSCTL_OFF + 2048 + 16384 + 256);
    for (int idx = C.tid; idx < 2048; idx += 512) { const int b = idx >> 10, col = idx & 1023; const float* af = WSP(const float, WS_ADAF) + b * 6144;
        MA[idx] = C.in[15][col] * (1.0f + af[4096 + col]); MB[idx] = af[3072 + col]; }
    if (C.tid < 32) hist[C.tid] = 0;
    __syncthreads();
    for (int blk = (C.G == 256 ? C.vcu : (int)blockIdx.x); blk < M / 64; blk += C.G) {
        const int r0 = 64 * blk, b = r0 >= SEQ;
        {
            u32x4 xr[8][2];
#pragma unroll
            for (int r = 0; r < 8; ++r)
#pragma unroll
                for (int j = 0; j < 2; ++j) xr[r][j] = *(const u32x4*)(WSP(const bf16_t, WS_X1) + (size_t)(r0 + 8 * C.wave + r) * D + 512 * j + 8 * C.lane);
#pragma unroll
            for (int r = 0; r < 8; ++r) { const int lr = 8 * C.wave + r, m = r0 + lr; const LAS float* ma = MA + b * 1024; const LAS float* mb = MB + b * 1024;
                float v[16]; float s = 0.f;
#pragma unroll
                for (int j = 0; j < 2; ++j) { const u32x4 w = xr[r][j];
                    v[8 * j + 0] = bf_lo(w.x); v[8 * j + 1] = bf_hi(w.x); v[8 * j + 2] = bf_lo(w.y); v[8 * j + 3] = bf_hi(w.y); v[8 * j + 4] = bf_lo(w.z); v[8 * j + 5] = bf_hi(w.z); v[8 * j + 6] = bf_lo(w.w); v[8 * j + 7] = bf_hi(w.w); }
#pragma unroll
                for (int k = 0; k < 16; ++k) s += v[k] * v[k];
                const float rstd = 1.0f / sqrtf(wave_sum(s) * (1.0f / D) + RMS_EPS);
                float am = 0.f;
#pragma unroll
                for (int j = 0; j < 2; ++j) { const LAS float* a = ma + 512 * j + 8 * C.lane; const LAS float* bb = mb + 512 * j + 8 * C.lane;
                    const f32x4 a0 = *(const LAS f32x4*)a, a1 = *(const LAS f32x4*)(a + 4), b0 = *(const LAS f32x4*)bb, b1 = *(const LAS f32x4*)(bb + 4);
#pragma unroll
                    for (int k = 0; k < 4; ++k) { v[8 * j + k] = v[8 * j + k] * rstd * a0[k] + b0[k]; v[8 * j + 4 + k] = v[8 * j + 4 + k] * rstd * a1[k] + b1[k]; }
#pragma unroll
                    for (int k = 0; k < 8; ++k) am = fmaxf(am, fabsf(v[8 * j + k]));
                    u32x4 w; w.x = pk2(v[8 * j + 0], v[8 * j + 1]); w.y = pk2(v[8 * j + 2], v[8 * j + 3]); w.z = pk2(v[8 * j + 4], v[8 * j + 5]); w.w = pk2(v[8 * j + 6], v[8 * j + 7]);
                    *(LAS u32x4*)(C.lds + lr * 2048 + (((64 * j + C.lane) ^ (lr & 15)) << 4)) = w; }
#pragma unroll
                for (int o = 1; o < 64; o <<= 1) am = fmaxf(am, __shfl_xor(am, o));
                const float inv = am > 0.f ? 127.0f / am : 0.f;
                if (C.lane == 0) WSP(float, WS_SA)[m] = am > 0.f ? am * (1.0f / 127.0f) : 1.0f;
                signed char* qrow = (signed char*)(C.ws + WS_H2Q) + (size_t)m * D;
#pragma unroll
                for (int j = 0; j < 2; ++j) { unsigned w2[2];
#pragma unroll
                    for (int d = 0; d < 2; ++d) { int b4[4];
#pragma unroll
                        for (int k = 0; k < 4; ++k) b4[k] = (int)fminf(fmaxf(__builtin_rintf(v[8 * j + 4 * d + k] * inv), -127.0f), 127.0f);
                        w2[d] = (unsigned)(b4[0] & 255) | ((unsigned)(b4[1] & 255) << 8) | ((unsigned)(b4[2] & 255) << 16) | ((unsigned)b4[3] << 24); }
                    *(u32x2*)(qrow + 512 * j + 8 * C.lane) = (u32x2){w2[0], w2[1]}; } }
        }
        __syncthreads();
        const int lane = C.lane, c = lane & 15, g = lane >> 4, rq = C.wave & 3, kh = C.wave >> 2; const int rb = r0 + 16 * rq;
        f32x4 lg[2]; lg[0] = (f32x4){0.f, 0.f, 0.f, 0.f}; lg[1] = lg[0];
        { const bf16_t* wt = WSP(const bf16_t, WS_WRT) + (size_t)c * 1024 + 8 * g + 512 * kh; const LAS unsigned char* arow = C.lds + (16 * rq + c) * 2048;
#pragma unroll 8
            for (int ks = 0; ks < 16; ++ks) { const bf16x8 a = *(const LAS bf16x8*)(arow + ((((64 * kh + 4 * ks + g)) ^ c) << 4));
#pragma unroll
                for (int nt = 0; nt < 2; ++nt) { const bf16x8 w = *(const bf16x8*)(wt + (size_t)nt * 16 * 1024 + 32 * ks);
                    lg[nt] = __builtin_amdgcn_mfma_f32_16x16x32_bf16(a, w, lg[nt], 0, 0, 0); } } }
        if (kh == 1) { *(LAS f32x4*)(xch + (rq * 64 + lane) * 8) = lg[0]; *(LAS f32x4*)(xch + (rq * 64 + lane) * 8 + 4) = lg[1]; }
        __syncthreads();
        if (kh == 0) { lg[0] += *(const LAS f32x4*)(xch + (rq * 64 + lane) * 8); lg[1] += *(const LAS f32x4*)(xch + (rq * 64 + lane) * 8 + 4);
            const float br0 = C.in[17][c], br1 = C.in[17][16 + c];
#pragma unroll
            for (int i = 0; i < 4; ++i) { float a0 = lg[0][i] + br0, a1 = lg[1][i] + br1; float tv[4]; int ti[4];
#pragma unroll
                for (int k = 0; k < 4; ++k) { float bv; int bi; if (a1 > a0) { bv = a1; bi = 16 + c; } else { bv = a0; bi = c; }
#pragma unroll
                    for (int o = 1; o < 16; o <<= 1) { const float ov = __shfl_xor(bv, o); const int oi = __shfl_xor(bi, o); if (ov > bv || (ov == bv && oi < bi)) { bv = ov; bi = oi; } }
                    tv[k] = bv; ti[k] = bi; if (bi == c) a0 = -INFINITY; if (bi == 16 + c) a1 = -INFINITY; }
                if (c == 0) { const int row = rb + 4 * g + i; const float e1 = __expf(tv[1] - tv[0]), e2 = __expf(tv[2] - tv[0]), e3 = __expf(tv[3] - tv[0]); const float inv = 1.0f / (1.0f + e1 + e2 + e3);
                    *(int4*)(WSP(int, WS_TOPI) + (size_t)row * 4) = make_int4(ti[0], ti[1], ti[2], ti[3]);
                    *(f32x4*)(WSP(float, WS_TOPW) + (size_t)row * 4) = (f32x4){inv, e1 * inv, e2 * inv, e3 * inv};
                    atomicAdd((int*)(hist + ti[0]), 1); atomicAdd((int*)(hist + ti[1]), 1); atomicAdd((int*)(hist + ti[2]), 1); atomicAdd((int*)(hist + ti[3]), 1); } }
        }
        __syncthreads();
        if (C.tid < 32) { WSP(int, WS_HIST)[blk * 32 + C.tid] = hist[C.tid]; hist[C.tid] = 0; }
        __syncthreads();
    }
}
__device__ __forceinline__ void p9_slots(const Ctx& C0) {
    PHASE_IDS();
    LAS int* tot = (LAS int*)C.lds;
    LAS int* off = tot + 32;
    LAS int* cur = off + 40;
    const int* hist = WSP(const int, WS_HIST);
    for (int blk = blockIdx.x; blk < M / 64; blk += C.G) {
        __syncthreads();
        if (C.tid < 32) { int t = 0, p = 0; for (int w = 0; w < M / 64; ++w) { const int v = hist[w * 32 + C.tid]; t += v; p += (w < blk) ? v : 0; } tot[C.tid] = t; cur[C.tid] = p; }
        __syncthreads();
        if (C.tid == 0) { int o = 0; for (int e = 0; e < 32; ++e) { off[e] = o; o += (tot[e] + 255) & ~255; } off[32] = o; }
        __syncthreads();
        if (C.tid < 32) cur[C.tid] += off[C.tid];
        __syncthreads();
        if (C.tid < 256) { const int token = 64 * blk + (C.tid >> 2), k = C.tid & 3; const int e = WSP(const int, WS_TOPI)[token * 4 + k];
            const int slot = atomicAdd((int*)(cur + e), 1);
            WSP(int, WS_SLOTTOK)[slot] = token; WSP(float, WS_SLOTW)[slot] = WSP(const float, WS_TOPW)[token * 4 + k]; WSP(int, WS_TOKSLOT)[token * 4 + k] = slot; WSP(float, WS_SLOTSA)[slot] = WSP(const float, WS_SA)[token]; }
        if (blk < 32) { const int e = blk; for (int s = off[e] + tot[e] + C.tid; s < off[e + 1]; s += 512) { WSP(int, WS_SLOTTOK)[s] = 0; WSP(float, WS_SLOTW)[s] = 0.f; WSP(float, WS_SLOTSA)[s] = 0.f; } }
        if (blk == 0 && C.tid < 33) WSP(int, WS_EOFF)[C.tid] = off[C.tid];
    }
    __syncthreads();
}
__device__ __forceinline__ void p12_final(const Ctx& C0) {
    PHASE_IDS();
    const int gw = C.vcu * NWAVES + C.wave, NGW = C.G * NWAVES;
    const bf16_t* so = WSP(const bf16_t, WS_SOUT); const bf16_t* x1 = WSP(const bf16_t, WS_X1); const int* ts = WSP(const int, WS_TOKSLOT);
    for (int m = gw; m < M; m += NGW) { const float* gt = WSP(const float, WS_ADAF) + (m >= SEQ ? 6144 : 0) + 5120;
        const int4 sl = *(const int4*)(ts + (size_t)m * 4);
        f32x4 v[4]; float s = 0.f;
#pragma unroll
        for (int j = 0; j < 4; ++j) { const int col = 4 * C.lane + 256 * j; f32x4 a = (f32x4){0.f, 0.f, 0.f, 0.f};
            { const u32x2 w = *(const u32x2*)(so + (size_t)sl.x * 1024 + col); a[0] += bf_lo(w.x); a[1] += bf_hi(w.x); a[2] += bf_lo(w.y); a[3] += bf_hi(w.y); }
            { const u32x2 w = *(const u32x2*)(so + (size_t)sl.y * 1024 + col); a[0] += bf_lo(w.x); a[1] += bf_hi(w.x); a[2] += bf_lo(w.y); a[3] += bf_hi(w.y); }
            { const u32x2 w = *(const u32x2*)(so + (size_t)sl.z * 1024 + col); a[0] += bf_lo(w.x); a[1] += bf_hi(w.x); a[2] += bf_lo(w.y); a[3] += bf_hi(w.y); }
            { const u32x2 w = *(const u32x2*)(so + (size_t)sl.w * 1024 + col); a[0] += bf_lo(w.x); a[1] += bf_hi(w.x); a[2] += bf_lo(w.y); a[3] += bf_hi(w.y); }
            { const u32x2 xw = *(const u32x2*)(x1 + (size_t)m * D + col); const f32x4 xv = (f32x4){bf_lo(xw.x), bf_hi(xw.x), bf_lo(xw.y), bf_hi(xw.y)}; v[j] = xv + *(const f32x4*)(gt + col) * a; }
            s += (v[j][0] * v[j][0] + v[j][1] * v[j][1]) + (v[j][2] * v[j][2] + v[j][3] * v[j][3]); }
        const float rstd = 1.0f / sqrtf(wave_sum(s) * (1.0f / D) + RMS_EPS);
#pragma unroll
        for (int j = 0; j < 4; ++j) { const int col = 4 * C.lane + 256 * j; *(f32x4*)(C.out + (size_t)m * D + col) = v[j] * rstd * *(const f32x4*)(C.in[22] + col); } }
}

constexpr int CW_GRP = 118000;
__device__ __forceinline__ void grp_barrier(const XcdBarrier& b, unsigned* gwd, unsigned n, volatile LAS unsigned* mode) {
    asm volatile("s_waitcnt vmcnt(0)" ::: "memory");
    __syncthreads();
    if (threadIdx.x == 0) {
        __builtin_amdgcn_s_waitcnt(0);
        unsigned md = mode[0];
        if (md == 0u) { md = (xb_ld(gwd + 128) + xb_ld(gwd + 192) == 17u) ? 1u : 2u; mode[0] = md; }
        if (md != 1u) { __builtin_amdgcn_fence(__ATOMIC_RELEASE, "agent"); asm volatile("s_waitcnt vmcnt(0)" ::: "memory"); }
        const unsigned old = xb_add(gwd, 1u); const unsigned gen = old / n;
        if (old + 1u == (gen + 1u) * n) xb_add(gwd + 64, 1u);
        else XB_SPIN(xb_ld(gwd + 64) == gen, b.bar);
        __builtin_amdgcn_fence(__ATOMIC_ACQUIRE, "agent");
        asm volatile("s_waitcnt vmcnt(0)" ::: "memory");
    }
    __syncthreads();
}
struct Args { const float* in[23]; float* out; unsigned char* ws; int ph_lo, ph_hi, li, pad; };
constexpr int N_PHASES = 13;
#ifndef MK_N_LAUNCHES
#define MK_N_LAUNCHES 1
#endif

__global__ void __launch_bounds__(NWAVES * 64, 2) mega_fwd(Args args) {
    extern __shared__ __attribute__((aligned(16))) unsigned char lds_raw[];
    Ctx C;
    C.lds = (LAS unsigned char*)lds_raw; C.ldsg = (char*)lds_raw;
    C.tid = threadIdx.x; C.lane = C.tid & 63; C.wave = __builtin_amdgcn_readfirstlane(C.tid >> 6);
    C.G = gridDim.x; { const int bx = blockIdx.x; C.vcu = (C.G % 8 == 0) ? (bx % 8) * (C.G / 8) + bx / 8 : bx; }
#pragma unroll
    for (int i = 0; i < 23; ++i) C.in[i] = args.in[i];
    C.out = args.out; C.ws = args.ws;
    volatile LAS unsigned* MISC = (volatile LAS unsigned*)(C.lds + MISC_OFF);
    for (int u = C.tid; u < (LDS_BYTES - LDSCTL_OFF) / 4; u += NWAVES * 64) ((LAS unsigned*)(C.lds + LDSCTL_OFF))[u] = 0u;
    __syncthreads();
    unsigned* ctl = (unsigned*)(C.ws + WS_CTL);
    XcdBarrier bar = xcd_barrier_post(ctl + CW_BAR + args.li * XCD_BAR_WORDS, MISC + 8);
    unsigned* gwd = ctl + CW_GRP + 256 * ((int)blockIdx.x & 7);
    if (threadIdx.x == 0) { const unsigned xc = xb_xcc_id(); __hip_atomic_fetch_max(gwd + 128, xc + 1u, __ATOMIC_RELAXED, __HIP_MEMORY_SCOPE_AGENT); __hip_atomic_fetch_max(gwd + 192, 16u - xc, __ATOMIC_RELAXED, __HIP_MEMORY_SCOPE_AGENT); }
    const bool gloc = (C.G == 256) && (MK_N_LAUNCHES == 1);
    const int lo = args.ph_lo, hi = args.ph_hi;
#define IN(k) (lo <= (k) && (k) < hi)
#define SEAM(k) do { if (IN(k) && IN((k) + 1)) xcd_barrier(bar); } while (0)
#define SEAMG(k) do { if (gloc) grp_barrier(bar, gwd, 32u, MISC + 12); else xcd_barrier(bar); } while (0)
#ifndef PROBE_REP
#define PROBE_REP -1
#endif
#define REPS(k) (((k) == PROBE_REP) ? 2 : 1)
#define DUP(k, ...) do { __VA_ARGS__; if (REPS(k) == 2) { __VA_ARGS__; } } while (0)

    if (IN(0)) { DUP(0, p0_prologue(C)); } SEAM(0);
    if (IN(1)) { DUP(30, p1_h1(C)); } SEAMG(1);
    if (IN(2)) {
        { pg8::DenseSched S; S.init(M, 1024, C.G, (int)blockIdx.x, WSP(bf16_t, WS_WIN), 1024); S.pn_base = 6; pg8::EpiProj E{WSP(bf16_t, WS_PROJ), WSP(float, WS_KMEAN)};
          DUP(2, pg8::gemm_phase<pg8::EpiProj, pg8::DenseSched, true>(C.lds, WSP(bf16_t, WS_H), 1024, 1024, 1024, S, E)); }
        { pg8::DenseSched S; S.init(M, INW - 1024, C.G, (int)blockIdx.x, C.ws + WS_WINQ, 512); S.pn_skip_at = 6; S.pn_skip = 4; pg8::EpiProjQ E{WSP(bf16_t, WS_PROJ), WSP(const float, WS_SA), WSP(const float, WS_SWIN)};
          DUP(2, pg8::gemm_phase<pg8::EpiProjQ, pg8::DenseSched, true, true>(C.lds, C.ws + WS_H2Q, 512, 512, 512, S, E)); }
    } if (IN(2) && IN(5)) xcd_barrier(bar);
    if (IN(5)) { p4_attention(C, 3 | (3 << 2), true); if (REPS(5) == 2) p4_attention(C, PROBE_SUB, false); } SEAM(5);
    if (IN(6)) { DUP(30, p5_ycombine(C)); } SEAMG(6);
    if (IN(7)) { pg8::DenseSched S; S.init(M, D, C.G, (int)blockIdx.x, WSP(bf16_t, WS_WBR), 1024); pg8::EpiBr E{WSP(const bf16_t, WS_PROJ + 3 * PROJ_STRIDE), WSP(const bf16_t, WS_PROJ + 4 * PROJ_STRIDE), WSP(bf16_t, WS_MERGED)};
        DUP(31, pg8::gemm_phase<pg8::EpiBr, pg8::DenseSched, true>(C.lds, WSP(bf16_t, WS_Y), 1024, 1024, 1024, S, E)); } SEAMG(7);
    if (IN(9)) { pg8::DenseSched S; S.init(M, D, C.G, (int)blockIdx.x, WSP(bf16_t, WS_WOUT), 1024); pg8::EpiOut E{C.in[0], WSP(const float, WS_ADAF), WSP(bf16_t, WS_X1)};
        DUP(32, pg8::gemm_phase<pg8::EpiOut, pg8::DenseSched, true>(C.lds, WSP(bf16_t, WS_MERGED), 1024, 1024, 1024, S, E)); } SEAMG(9);
    if (IN(10)) { DUP(30, p8_router(C)); } SEAM(10);
    if (IN(11)) { DUP(33, p9_slots(C)); } SEAM(11);
    if (IN(12)) {
        LAS int* te = (LAS int*)(C.lds + RING_BYTES + 64);
        if (C.tid < 33) te[C.tid] = WSP(const int, WS_EOFF)[C.tid] >> 8;
        __syncthreads();
        unsigned* tdone = (unsigned*)(C.ws + WS_CTL) + CW_TDONE; unsigned* tmo = (unsigned*)(C.ws + WS_CTL) + CW_TMO;
        { pg8::MoeSched<true, false, false> S{te, 8, C.G, (int)blockIdx.x, WSP(const int, WS_SLOTTOK), (const char*)(C.ws + WS_WGU), (size_t)2048 * 1024, (size_t)256 * 1024, tdone, tmo};
          pg8::EpiGUQ E{C.in[19], WSP(const float, WS_SW), WSP(const float, WS_SLOTSA), WSP(bf16_t, WS_ACT)};
          DUP(20, pg8::gemm_phase<pg8::EpiGUQ, pg8::MoeSched<true, false, false>, true, true>(C.lds, C.ws + WS_H2Q, 512, 512, 512, S, E)); }
        xcd_barrier(bar);
        { pg8::MoeSched<false, false, false, true> S{te, 4, C.G, (int)blockIdx.x, nullptr, (const char*)WSP(bf16_t, WS_WD), (size_t)1024 * 1024 * 2, (size_t)256 * 1024 * 2, tdone, tmo};
          pg8::EpiDown E{C.in[21], WSP(const float, WS_SLOTW), WSP(bf16_t, WS_SOUT)};
          DUP(21, pg8::gemm_phase<pg8::EpiDown, pg8::MoeSched<false, false, false, true>, true>(C.lds, WSP(bf16_t, WS_ACT), 1024, 1024, 1024, S, E)); }
        xcd_barrier(bar);
        DUP(30, p12_final(C));
    }
#undef IN
#undef SEAM
}

extern "C" void kernel_launch(void* const* d_in, const int* in_sizes, int n_in, void* d_out, int out_size, void* d_ws, size_t ws_size, hipStream_t stream) {
    static int grid = 0;
    if (grid == 0) {
        if (n_in != 23 || in_sizes[0] != M * D || out_size != M * D || ws_size < WS_END) { fprintf(stderr, "kernel_launch: unexpected shapes (n_in %d, in0 %d, out %d, ws %zu); nothing launched\n", n_in, n_in > 0 ? in_sizes[0] : -1, out_size, ws_size); grid = -1; return; }
        int dev = 0, cus = 0, per_cu = 0;
        if (hipGetDevice(&dev) != hipSuccess || hipDeviceGetAttribute(&cus, hipDeviceAttributeMultiprocessorCount, dev) != hipSuccess) { grid = -1; return; }
        if (hipFuncSetAttribute((const void*)mega_fwd, hipFuncAttributeMaxDynamicSharedMemorySize, LDS_BYTES) != hipSuccess) { fprintf(stderr, "kernel_launch: hipFuncSetAttribute failed\n"); grid = -1; return; }
        if (hipOccupancyMaxActiveBlocksPerMultiprocessor(&per_cu, (const void*)mega_fwd, NWAVES * 64, LDS_BYTES) != hipSuccess || per_cu < 1) { fprintf(stderr, "kernel_launch: occupancy query reports %d workgroups per CU\n", per_cu); }
        (void)hipGetLastError();
        grid = cus;
    }
    if (grid < 0) return;
    if (hipMemsetAsync((char*)d_ws + WS_CTL, 0, CTL_ZERO_BYTES, stream) != hipSuccess) { fprintf(stderr, "kernel_launch: memset failed\n"); return; }
    Args a{};
    for (int i = 0; i < 23; ++i) a.in[i] = (const float*)d_in[i];
    a.out = (float*)d_out; a.ws = (unsigned char*)d_ws;
    constexpr int NL = MK_N_LAUNCHES;
    for (int li = 0; li < NL; ++li) {
        a.ph_lo = (NL == 1) ? 0 : li; a.ph_hi = (NL == 1) ? N_PHASES : li + 1; a.li = (NL == 1) ? 0 : li; a.pad = 0;
        hipLaunchKernelGGL(mega_fwd, dim3(grid), dim3(NWAVES * 64), LDS_BYTES, stream, a);
        const hipError_t le = hipPeekAtLastError();
        if (le != hipSuccess) { fprintf(stderr, "kernel_launch: launch %d failed: %s\n", li, hipGetErrorName(le)); break; }
    }
}
```

```cpp
#include <hip/hip_runtime.h>
#include <cstdio>
#include <cstdint>
#ifndef SIMPLE_DIFF
#define SIMPLE_DIFF 0
#endif
#ifndef NATIVE_DIFF
#define NATIVE_DIFF 1
#endif

#define GAS __attribute__((address_space(1)))
#define LAS __attribute__((address_space(3)))
typedef unsigned short bf16_t;
typedef short bf16x8 __attribute__((ext_vector_type(8)));
typedef short s16x4 __attribute__((ext_vector_type(4)));
typedef float f32x4 __attribute__((ext_vector_type(4)));
typedef float f32x2 __attribute__((ext_vector_type(2)));
typedef unsigned u32x4 __attribute__((ext_vector_type(4)));
typedef unsigned u32x2 __attribute__((ext_vector_type(2)));
typedef int i32x4 __attribute__((ext_vector_type(4)));
#define RLX_AGENT __ATOMIC_RELAXED, __HIP_MEMORY_SCOPE_AGENT
#define LDS_WAIT() asm volatile("s_waitcnt lgkmcnt(0)" ::: "memory")
#define VM_WAIT() asm volatile("s_waitcnt vmcnt(0)" ::: "memory")

constexpr int BATCH = 2, SEQ = 8192, M = BATCH * SEQ, D = 1024, INW = 5120;
constexpr int NE = 32, TOPK = 4;
constexpr int NWAVES = 8;
constexpr float RMS_EPS = 1e-5f;
constexpr float LOG2E = 1.4426950408889634f;
constexpr float C2 = 0.125f * LOG2E;
constexpr int SLOT_ROWS = M * TOPK + NE * 256;

constexpr size_t MiB = 1u << 20, KiB = 1u << 10;
constexpr size_t WS_CTL = 0, CTL_ZERO_BYTES = 1 * MiB;
constexpr size_t WS_ADAP = 1 * MiB;
constexpr size_t WS_ADAF = 1 * MiB + 896 * KiB;
constexpr size_t WS_KMEAN = 512 * KiB;
constexpr size_t WS_TOPI = 2 * MiB + 256 * KiB;
constexpr size_t WS_TOPW = 2 * MiB + 512 * KiB;
constexpr size_t WS_TOKSLOT = 2 * MiB + 768 * KiB;
constexpr size_t WS_SLOTTOK = 3 * MiB;
constexpr size_t WS_SLOTW = 3 * MiB + 512 * KiB;
constexpr size_t WS_HIST = 4 * MiB;
constexpr size_t WS_EOFF = 4 * MiB + 64 * KiB;
constexpr size_t WS_WRT = 4 * MiB + 128 * KiB;
constexpr size_t WS_SLOTSA = 4 * MiB + 256 * KiB;
constexpr size_t WS_SW = 5 * MiB;
constexpr size_t WS_SWIN = 5 * MiB + 640 * KiB;
constexpr size_t WS_SA = 5 * MiB + 512 * KiB;
constexpr size_t WS_LIST = 6 * MiB;
constexpr size_t WS_PML = 14 * MiB;
constexpr size_t WS_WIN = 18 * MiB, WS_WBR = 28 * MiB, WS_WOUT = 30 * MiB, WS_WGU = 32 * MiB, WS_WD = 160 * MiB;
constexpr size_t WS_H = 224 * MiB;
constexpr size_t WS_PROJ = 256 * MiB;
constexpr size_t PROJ_STRIDE = 32 * MiB;
constexpr size_t WS_Y = 416 * MiB;
constexpr size_t WS_PO = 448 * MiB;
constexpr size_t WS_H2Q = 512 * MiB;
constexpr size_t WS_MERGED = 576 * MiB;
constexpr size_t WS_X1 = 608 * MiB;
constexpr size_t WS_ACT = 672 * MiB;
constexpr size_t WS_SOUT = 816 * MiB;
constexpr size_t WS_OA = 960 * MiB;
constexpr size_t WS_WINQ = 992 * MiB;
constexpr size_t WS_END = 1000 * MiB;
constexpr int LIST_PER_BH = 126976;
constexpr int CW_TMO = 0, CW_CODE = 1, CW_BAR = 4096, CW_MCNT = 65536, CW_TDONE = 80000, CW_AQ = 110000, CW_GDONE = 121000;

constexpr int RING_BYTES = 131072, LDSCTL_OFF = RING_BYTES, MISC_OFF = LDSCTL_OFF + 320, LDS_BYTES = 163840;

__device__ __forceinline__ unsigned f2bf(float f) { unsigned u = __builtin_bit_cast(unsigned, f); return (u + 0x7fffu + ((u >> 16) & 1u)) >> 16; }
__device__ __forceinline__ unsigned pk2(float lo, float hi) { return f2bf(lo) | (f2bf(hi) << 16); }
__device__ __forceinline__ unsigned cvt_pk_bf16(float lo, float hi) { unsigned r; asm volatile("v_cvt_pk_bf16_f32 %0, %1, %2" : "=v"(r) : "v"(lo), "v"(hi)); return r; }
__device__ __forceinline__ float bf_lo(unsigned u) { return __builtin_bit_cast(float, u << 16); }
__device__ __forceinline__ float bf_hi(unsigned u) { return __builtin_bit_cast(float, u & 0xffff0000u); }
__device__ __forceinline__ float sigmoidf_fast(float v) { return __builtin_amdgcn_rcpf(1.0f + __builtin_amdgcn_exp2f(-v * LOG2E)); }
__device__ __forceinline__ float wave_sum(float v) {
#pragma unroll
    for (int o = 1; o < 64; o <<= 1) v += __shfl_xor(v, o);
    return v;
}

namespace pg8 {
constexpr int BM = 256, BK = 64, HALF = 128, HTB = HALF * BK * 2, STAGE_BYTES = 8 * HTB, NXCD = 8, WGM = 8;
__device__ __forceinline__ int lds_byte(int r, int c) { const int st = (r >> 4) * 2 + (c >> 5), rr = r & 15, cc = c & 31, ob = rr * 64 + cc * 2; return st * 1024 + (ob ^ (((ob >> 9) & 1) << 5)); }
__device__ __forceinline__ void stage_rc(int b, int& R, int& C) { const int st = b / 1024, sb = b % 1024, swz = sb ^ (((sb >> 9) & 1) << 5); R = (st >> 1) * 16 + swz / 64; C = (st & 1) * 32 + (swz % 64) / 2; }
__device__ __forceinline__ int perm32(int rho) { const int n = rho >> 4, i = rho & 15; return 8 * (i >> 2) + 4 * n + (i & 3); }

struct Unit { int row0; int pm, pn, e, half; const char* bptr; };

struct DenseSched {
    static constexpr bool HAS_READY = false, HAS_DONE = false;
    int nM, nN, nwg, G, c; const char* Bt; size_t btile;
    int pn_base = 0, pn_skip_at = 1 << 30, pn_skip = 0;
    __device__ __forceinline__ void init(int M_, int N_, int G_, int c_, const void* Bt_, int ldb) { nM = M_ / BM; nN = N_ / BM; nwg = nM * nN; G = G_; c = c_; Bt = (const char*)Bt_; btile = (size_t)BM * ldb * 2; }
    __device__ __forceinline__ bool next(int i, Unit& u) const {
        const long L = (long)i * G + c; if (L >= nwg) return false;
        int wgid = (int)L; { const int q = nwg / NXCD, r = nwg % NXCD, xcd = wgid % NXCD, off = wgid / NXCD; wgid = (xcd < r ? xcd * (q + 1) : r * (q + 1) + (xcd - r) * q) + off; }
        const int nig = WGM * nN, gid = wgid / nig, fm = gid * WGM, gsz = (nM - fm) < WGM ? (nM - fm) : WGM;
        u.pm = fm + ((wgid % nig) % gsz); { const int pl = (wgid % nig) / gsz; u.pn = pn_base + pl + (pl >= pn_skip_at ? pn_skip : 0); } u.row0 = u.pm * BM; u.e = 0; u.half = 0; u.bptr = Bt + (size_t)u.pn * btile; return true;
    }
    __device__ __forceinline__ int arow(const Unit& u, int r) const { return u.row0 + r; }
    __device__ __forceinline__ void a_ready(const Unit&) const {}
    __device__ __forceinline__ void done(int) const {}
};

template <bool I8> struct AccSel { typedef f32x4 T; };
template <> struct AccSel<true> { typedef i32x4 T; };
template <class Epi, class Sched, bool ALIGN_EPI, bool I8 = false>
__device__ __forceinline__ void gemm_phase(LAS unsigned char* lds, const void* Abase_, int lda, int ldb, int K, const Sched& S, const Epi& E) {
    int tid_ = threadIdx.x; asm volatile("" : "+v"(tid_));
    const int tid = tid_, wid = __builtin_amdgcn_readfirstlane(tid >> 6), lane = tid & 63, wr = wid >> 2, wc = wid & 3, fr = lane & 15, fq = lane >> 4;
    const int nt = K / BK;
    const char* Abase = (const char*)Abase_;
    int Rr[2], Cc[2]; unsigned voffB[2];
#pragma unroll
    for (int i = 0; i < 2; ++i) { stage_rc(tid * 16 + i * 8192, Rr[i], Cc[i]); const int Rb = Epi::PERM ? ((Rr[i] & ~31) + perm32(Rr[i] & 31)) : Rr[i]; voffB[i] = (unsigned)(Rb * ldb + Cc[i]) * 2u; }
    const size_t kstep = (size_t)(BK * 2);
    const size_t hstepB = (size_t)HALF * ldb * 2;
    const unsigned ldsw = (unsigned)wid * 1024u;
    const int aoff = lds_byte(wr * 64 + fr, fq * 8), boff = lds_byte(wc * 32 + fr, fq * 8);
#define PG8_SA(b, h) (((b) * 2 + (h)) * HTB)
#define PG8_SB(b, h) ((4 + (b) * 2 + (h)) * HTB)
#define PG8_STAGE(bufoff, gbase, voff) do { _Pragma("unroll") for (int _i = 0; _i < 2; ++_i) \
        __builtin_amdgcn_global_load_lds((const unsigned*)((const char*)(gbase) + (voff)[_i]), (LAS unsigned*)(lds + (bufoff) + ldsw + _i * 8192), 16, 0, 0); } while (0)
#define PG8_LDA(dst, b, h) do { _Pragma("unroll") for (int m = 0; m < 4; ++m) _Pragma("unroll") for (int k = 0; k < 2; ++k) dst[m][k] = *(const LAS bf16x8*)(lds + PG8_SA(b, h) + aoff + m * 2048 + k * 1024); } while (0)
#define PG8_LDB(dst, b, h) do { _Pragma("unroll") for (int n = 0; n < 2; ++n) _Pragma("unroll") for (int k = 0; k < 2; ++k) dst[n][k] = *(const LAS bf16x8*)(lds + PG8_SB(b, h) + boff + n * 2048 + k * 1024); } while (0)
#define PG8_MMA(ai, bj, At, Bt) do { __builtin_amdgcn_s_setprio(1); _Pragma("unroll") for (int m = 0; m < 4; ++m) _Pragma("unroll") for (int n = 0; n < 2; ++n) _Pragma("unroll") for (int k = 0; k < 2; ++k) { \
        if constexpr (I8) acc[ai][bj][m][n] = __builtin_amdgcn_mfma_i32_16x16x64_i8(__builtin_bit_cast(i32x4, Bt[n][k]), __builtin_bit_cast(i32x4, At[m][k]), acc[ai][bj][m][n], 0, 0, 0); \
        else acc[ai][bj][m][n] = __builtin_amdgcn_mfma_f32_16x16x32_bf16(Bt[n][k], At[m][k], acc[ai][bj][m][n], 0, 0, 0); } __builtin_amdgcn_s_setprio(0); } while (0)
#define PG8_WAIT_V(n) asm volatile("s_waitcnt vmcnt(" #n ")" ::: "memory")
#define PG8_WAIT_L(n) asm volatile("s_waitcnt lgkmcnt(" #n ")" ::: "memory")
#define PG8_BAR __builtin_amdgcn_s_barrier()
#define PG8_SCHED __builtin_amdgcn_sched_barrier(0)
#define PG8_ROWS(u, va) do { _Pragma("unroll") for (int _h = 0; _h < 2; ++_h) _Pragma("unroll") for (int _i = 0; _i < 2; ++_i) \
        va[_h][_i] = (unsigned)(S.arow(u, _h * HALF + Rr[_i]) * lda + Cc[_i]) * 2u; } while (0)
    Unit cur, nxt; int ui = 0; int prev_pm = -1;
    if (!S.next(0, cur)) return;
    unsigned vaC[2][2], vaN[2][2];
    PG8_ROWS(cur, vaC);
    typedef typename AccSel<I8>::T acc_t;
    acc_t acc[2][2][4][2];
#pragma unroll
    for (int a = 0; a < 2; ++a)
#pragma unroll
        for (int b = 0; b < 2; ++b)
#pragma unroll
            for (int m = 0; m < 4; ++m)
#pragma unroll
                for (int n = 0; n < 2; ++n) acc[a][b][m][n] = (acc_t){0, 0, 0, 0};
    bf16x8 At[4][2], B0[2][2], B1[2][2];
    const char* cB = cur.bptr;
    if constexpr (Sched::HAS_READY) S.a_ready(cur);
    PG8_STAGE(PG8_SB(0, 0), cB, voffB); PG8_STAGE(PG8_SB(0, 1), cB + hstepB, voffB); PG8_STAGE(PG8_SA(0, 0), Abase, vaC[0]); PG8_STAGE(PG8_SA(0, 1), Abase, vaC[1]);
    if (wr == 1) PG8_BAR;
    PG8_WAIT_V(2); PG8_BAR;
    PG8_STAGE(PG8_SB(1, 0), cB + kstep, voffB); PG8_STAGE(PG8_SA(1, 0), Abase + kstep, vaC[0]); PG8_STAGE(PG8_SB(1, 1), cB + hstepB + kstep, voffB);
    PG8_WAIT_V(6); PG8_BAR;
    for (;;) {
        const bool has_next = S.next(ui + 1, nxt);
        if (has_next) { PG8_ROWS(nxt, vaN); } else { nxt = cur;
#pragma unroll
            for (int h = 0; h < 2; ++h)
#pragma unroll
                for (int i = 0; i < 2; ++i) vaN[h][i] = vaC[h][i]; }
        const char* nB = nxt.bptr;
        for (int t = 0; t < nt; t += 2) {
            if constexpr (Epi::HAS_MID) { if (t == (nt >> 1)) E.mid(acc, cur, wr, wc, fr, fq); }
            const bool last = (t == nt - 2);
            if constexpr (Sched::HAS_DONE) { if (last && prev_pm >= 0) { S.done(prev_pm); prev_pm = -1; } }
            if constexpr (Sched::HAS_READY) { if (last && has_next) S.a_ready(nxt); }
            const char* a1 = Abase + (size_t)(t + 1) * kstep;
            const char* a2 = last ? Abase : Abase + (size_t)(t + 2) * kstep; const char* b2 = last ? nB : cB + (size_t)(t + 2) * kstep;
            const char* a3 = a2 + kstep; const char* b3 = b2 + kstep;
            unsigned v2[2][2];
#pragma unroll
            for (int h = 0; h < 2; ++h)
#pragma unroll
                for (int i = 0; i < 2; ++i) v2[h][i] = last ? vaN[h][i] : vaC[h][i];
            PG8_LDB(B0, 0, 0); PG8_LDB(B1, 0, 1); PG8_SCHED; PG8_LDA(At, 0, 0); PG8_STAGE(PG8_SA(1, 1), a1, vaC[1]);
            PG8_WAIT_V(8); PG8_WAIT_L(0); PG8_BAR; PG8_MMA(0, 0, At, B0); PG8_MMA(0, 1, At, B1); PG8_BAR; PG8_SCHED;
            PG8_LDA(At, 0, 1); PG8_STAGE(PG8_SB(0, 0), b2, voffB); PG8_STAGE(PG8_SB(0, 1), b2 + hstepB, voffB); PG8_STAGE(PG8_SA(0, 0), a2, v2[0]);
            PG8_WAIT_V(8); PG8_WAIT_L(0); PG8_BAR; if (!cur.half) { PG8_MMA(1, 0, At, B0); PG8_MMA(1, 1, At, B1); } PG8_BAR; PG8_SCHED;
            PG8_LDB(B0, 1, 0); PG8_LDB(B1, 1, 1); PG8_SCHED; PG8_LDA(At, 1, 0); PG8_STAGE(PG8_SA(0, 1), a2, v2[1]);
            PG8_WAIT_V(8); PG8_WAIT_L(0); PG8_BAR; PG8_MMA(0, 0, At, B0); PG8_MMA(0, 1, At, B1); PG8_BAR; PG8_SCHED;
            PG8_LDA(At, 1, 1); PG8_STAGE(PG8_SB(1, 0), b3, voffB); PG8_STAGE(PG8_SB(1, 1), b3 + hstepB, voffB); PG8_STAGE(PG8_SA(1, 0), a3, v2[0]);
            PG8_WAIT_V(8); PG8_WAIT_L(0); PG8_BAR; if (!cur.half) { PG8_MMA(1, 0, At, B0); PG8_MMA(1, 1, At, B1); } PG8_BAR; PG8_SCHED;
        }
        if constexpr (ALIGN_EPI) { if (wr == 0) PG8_BAR; }
        E(acc, cur, wr, wc, fr, fq); if constexpr (Sched::HAS_DONE) prev_pm = cur.pm;
        if (!has_next) break;
#pragma unroll
        for (int a = 0; a < 2; ++a)
#pragma unroll
            for (int b = 0; b < 2; ++b)
#pragma unroll
                for (int m = 0; m < 4; ++m)
#pragma unroll
                    for (int n = 0; n < 2; ++n) acc[a][b][m][n] = (acc_t){0, 0, 0, 0};
        cur = nxt; cB = nB; ++ui;
#pragma unroll
        for (int h = 0; h < 2; ++h)
#pragma unroll
            for (int i = 0; i < 2; ++i) vaC[h][i] = vaN[h][i];
        if constexpr (ALIGN_EPI) { if (wr == 1) PG8_BAR; }
    }
    PG8_WAIT_V(0);
    if constexpr (Sched::HAS_DONE) { if (prev_pm >= 0) S.done(prev_pm); }
    if constexpr (!ALIGN_EPI) { if (wr == 0) PG8_BAR; }
    PG8_BAR;
#undef PG8_SA
#undef PG8_SB
#undef PG8_STAGE
#undef PG8_LDA
#undef PG8_LDB
#undef PG8_MMA
#undef PG8_WAIT_V
#undef PG8_WAIT_L
#undef PG8_BAR
#undef PG8_SCHED
#undef PG8_ROWS
}
}
#define XB_TMO      128
#define XB_XCNT(j)  (256  + 64 * (j))
#define XB_XSUB(j)  (1280 + 64 * (j))
#define XB_XGEN(j)  (2304 + 64 * (j))
#define XB_TOP      3328
#define XB_TOPGEN   3392
#define XCD_BAR_WORDS 3456
#define XB_SPIN_CAP (1u << 18)

__device__ __forceinline__ unsigned xb_ld(unsigned* p)              { return __hip_atomic_load(p, __ATOMIC_RELAXED, __HIP_MEMORY_SCOPE_AGENT); }
__device__ __forceinline__ unsigned xb_add(unsigned* p, unsigned v) { return __hip_atomic_fetch_add(p, v, __ATOMIC_RELAXED, __HIP_MEMORY_SCOPE_AGENT); }
__device__ __forceinline__ unsigned xb_xcc_id() { return (unsigned)__builtin_amdgcn_s_getreg((3 << 11) | 20) & 0xFu; }
#define XB_SPIN(cond, bar) do { unsigned _sp = 0; while (cond) { __builtin_amdgcn_s_sleep(1); \
    if ((++_sp & 255u) == 0u) { if (xb_ld(&(bar)[XB_TMO])) break; if (_sp > XB_SPIN_CAP) { atomicAdd(&(bar)[XB_TMO], 1u); break; } } } } while (0)

struct XcdBarrier {
    unsigned* bar; unsigned x;
    volatile LAS unsigned* st;
};

__device__ __forceinline__ XcdBarrier xcd_barrier_post(unsigned* bar, volatile LAS unsigned* st) {
    XcdBarrier b; b.bar = bar; b.x = xb_xcc_id(); b.st = st;
    if (threadIdx.x == 0) (void)xb_add(&bar[XB_XCNT(b.x)], 1u);
    return b;
}
__device__ __forceinline__ void xcd_barrier_complete(unsigned* bar, unsigned x, unsigned& nloc, unsigned& nx) {
    const unsigned G = gridDim.x * gridDim.y * gridDim.z;
    unsigned sum, cnt, mine, sp = 0u;
    for (;;) {
        sum = 0u; cnt = 0u; mine = 0u;
#pragma unroll
        for (unsigned j = 0; j < 16; ++j) { const unsigned c = xb_ld(&bar[XB_XCNT(j)]); sum += c; cnt += (c > 0u) ? 1u : 0u; mine = (j == x) ? c : mine; }
        if (sum == G) break;
        __builtin_amdgcn_s_sleep(1);
        if ((++sp & 255u) == 0u) { if (xb_ld(&bar[XB_TMO])) break; if (sp > XB_SPIN_CAP) { atomicAdd(&bar[XB_TMO], 1u); break; } }
    }
    nloc = mine > 0u ? mine : 1u; nx = cnt > 0u ? cnt : 1u;
}

__device__ __forceinline__ void xcd_barrier(const XcdBarrier& b) {
    asm volatile("s_waitcnt vmcnt(0)" ::: "memory");
    __syncthreads();
    if (threadIdx.x == 0) {
        unsigned* bar = b.bar;
        __builtin_amdgcn_s_waitcnt(0);
        unsigned nloc = b.st[0], nx = b.st[1];
        if (nloc == 0u) { xcd_barrier_complete(bar, b.x, nloc, nx); b.st[0] = nloc; b.st[1] = nx; }
        const unsigned old = xb_add(&bar[XB_XSUB(b.x)], 1u);
        const unsigned gen = old / nloc;
        if (old + 1u == (gen + 1u) * nloc) {
            __builtin_amdgcn_fence(__ATOMIC_RELEASE, "agent");
            asm volatile("s_waitcnt vmcnt(0)" ::: "memory");
            const unsigned og = xb_add(&bar[XB_TOP], 1u);
            const unsigned tg = og / nx;
            if (og + 1u == (tg + 1u) * nx) xb_add(&bar[XB_TOPGEN], 1u);
            else XB_SPIN(xb_ld(&bar[XB_TOPGEN]) == tg, bar);
            __builtin_amdgcn_fence(__ATOMIC_ACQUIRE, "agent");
            xb_add(&bar[XB_XGEN(b.x)], 1u);
            asm volatile("s_waitcnt vmcnt(0)" ::: "memory");
        } else {
            XB_SPIN(xb_ld(&bar[XB_XGEN(b.x)]) == gen, bar);
            __builtin_amdgcn_fence(__ATOMIC_ACQUIRE, "agent");
            asm volatile("s_waitcnt vmcnt(0)" ::: "memory");
        }
    }
    __syncthreads();
}
namespace pg8 {
struct EpiProj {
    static constexpr bool PERM = true, HAS_MID = false;
    bf16_t* base; float* kmean;
    __device__ __forceinline__ void operator()(const f32x4 (&acc)[2][2][4][2], const Unit& u, int wr, int wc, int fr, int fq) const {
        if (u.pn == 8 || u.pn == 9) {
            const int b = u.pm >> 5, nblk = u.pm & 31;
#pragma unroll
            for (int bj = 0; bj < 2; ++bj)
#pragma unroll
                for (int n = 0; n < 2; ++n) { f32x4 s = (f32x4){0.f, 0.f, 0.f, 0.f};
#pragma unroll
                    for (int ai = 0; ai < 2; ++ai)
#pragma unroll
                        for (int m = 0; m < 4; ++m) s += acc[ai][bj][m][n];
#pragma unroll
                    for (int j = 0; j < 4; ++j) { float v = s[j]; v += __shfl_xor(v, 1); v += __shfl_xor(v, 2); v += __shfl_xor(v, 4); v += __shfl_xor(v, 8); s[j] = v; }
                    if (fr == 0) { const int col = (u.pn - 8) * 256 + bj * HALF + wc * 32 + 8 * fq + 4 * n; const int h = col >> 6, d = col & 63; float* kp = kmean + ((size_t)((b * 8 + h) * 32 + nblk)) * 64 + d;
#pragma unroll
                        for (int j = 0; j < 4; ++j) atomicAdd(kp + j, s[j] * (1.0f / 256.0f)); } }
        }
        const int buf = u.pn >> 2, colt = (u.pn & 3) * 256;
        const float sc = (u.pn < 2 || u.pn == 6 || u.pn == 7) ? C2 : 1.0f;
        bf16_t* dst = base + (size_t)buf * (PROJ_STRIDE / 2);
        const int row0 = u.row0 + wr * 64 + fr, col0 = colt + wc * 32 + 8 * fq;
#pragma unroll
        for (int ai = 0; ai < 2; ++ai)
#pragma unroll
            for (int m = 0; m < 4; ++m) { bf16_t* rowp = dst + (size_t)(row0 + ai * HALF + m * 16) * 1024 + col0;
#pragma unroll
                for (int bj = 0; bj < 2; ++bj) { const f32x4 v0 = acc[ai][bj][m][0] * sc, v1 = acc[ai][bj][m][1] * sc;
                    u32x4 w; w.x = cvt_pk_bf16(v0[0], v0[1]); w.y = cvt_pk_bf16(v0[2], v0[3]); w.z = cvt_pk_bf16(v1[0], v1[1]); w.w = cvt_pk_bf16(v1[2], v1[3]);
                    *(u32x4*)(rowp + bj * HALF) = w; } }
    }
};
struct EpiProjQ {
    static constexpr bool PERM = true, HAS_MID = false;
    bf16_t* base; const float* sa; const float* sw;
    __device__ __forceinline__ void operator()(const i32x4 (&acc)[2][2][4][2], const Unit& u, int wr, int wc, int fr, int fq) const {
        const int buf = u.pn >> 2, colt = (u.pn & 3) * 256;
        const float sc = (u.pn < 2) ? C2 : 1.0f;
        bf16_t* dst = base + (size_t)buf * (PROJ_STRIDE / 2);
        const int row0 = u.row0 + wr * 64 + fr, col0 = colt + wc * 32 + 8 * fq;
        const float* swp = sw + u.pn * 256 + wc * 32 + 8 * fq;
        f32x4 sv[2][2];
#pragma unroll
        for (int bj = 0; bj < 2; ++bj)
#pragma unroll
            for (int n = 0; n < 2; ++n) sv[bj][n] = *(const f32x4*)(swp + bj * HALF + 4 * n) * sc;
#pragma unroll
        for (int ai = 0; ai < 2; ++ai)
#pragma unroll
            for (int m = 0; m < 4; ++m) { const int row = row0 + ai * HALF + m * 16; const float ts = sa[row]; bf16_t* rowp = dst + (size_t)row * 1024 + col0;
#pragma unroll
                for (int bj = 0; bj < 2; ++bj) { const i32x4 a0 = acc[ai][bj][m][0], a1 = acc[ai][bj][m][1];
                    const f32x4 v0 = (f32x4){(float)a0[0], (float)a0[1], (float)a0[2], (float)a0[3]} * (sv[bj][0] * ts), v1 = (f32x4){(float)a1[0], (float)a1[1], (float)a1[2], (float)a1[3]} * (sv[bj][1] * ts);
                    u32x4 w; w.x = cvt_pk_bf16(v0[0], v0[1]); w.y = cvt_pk_bf16(v0[2], v0[3]); w.z = cvt_pk_bf16(v1[0], v1[1]); w.w = cvt_pk_bf16(v1[2], v1[3]);
                    *(u32x4*)(rowp + bj * HALF) = w; } }
    }
};
struct EpiBr {
    static constexpr bool PERM = true, HAS_MID = true;
    const bf16_t* gla; const bf16_t* glb; bf16_t* out;
    __device__ __forceinline__ void mid(f32x4 (&acc)[2][2][4][2], const Unit& u, int wr, int wc, int fr, int fq) const {
        int row0 = u.row0 + wr * 64 + fr, col0 = u.pn * 256 + wc * 32 + 8 * fq; asm volatile("" : "+v"(row0), "+v"(col0));
#pragma unroll
        for (int ai = 0; ai < 2; ++ai)
#pragma unroll
            for (int m = 0; m < 4; ++m) { const size_t ro = (size_t)(row0 + ai * HALF + m * 16) * 1024 + col0;
#pragma unroll
                for (int bj = 0; bj < 2; ++bj) { const u32x4 ga = *(const u32x4*)(gla + ro + bj * HALF), gb = *(const u32x4*)(glb + ro + bj * HALF);
                    f32x4 r0, r1;
#define RT2(R, I, GA, GB) do { f32x2 ea = (f32x2){bf_lo(GA), bf_hi(GA)} * (f32x2){-LOG2E, -LOG2E}, eb = (f32x2){bf_lo(GB), bf_hi(GB)} * (f32x2){-LOG2E, -LOG2E}; \
                        ea[0] = __builtin_amdgcn_exp2f(ea[0]); ea[1] = __builtin_amdgcn_exp2f(ea[1]); eb[0] = __builtin_amdgcn_exp2f(eb[0]); eb[1] = __builtin_amdgcn_exp2f(eb[1]); \
                        ea = ea + (f32x2){1.0f, 1.0f}; eb = eb + (f32x2){1.0f, 1.0f}; ea[0] = __builtin_amdgcn_rcpf(ea[0]); ea[1] = __builtin_amdgcn_rcpf(ea[1]); const f32x2 q_ = eb * ea; R[I] = q_[0]; R[I + 1] = q_[1]; } while (0)
                    RT2(r0, 0, ga.x, gb.x); RT2(r0, 2, ga.y, gb.y); RT2(r1, 0, ga.z, gb.z); RT2(r1, 2, ga.w, gb.w);
#undef RT2
                    acc[ai][bj][m][0] *= r0; acc[ai][bj][m][1] *= r1; } }
    }
    __device__ __forceinline__ void operator()(const f32x4 (&acc)[2][2][4][2], const Unit& u, int wr, int wc, int fr, int fq) const {
        int row0 = u.row0 + wr * 64 + fr, col0 = u.pn * 256 + wc * 32 + 8 * fq; asm volatile("" : "+v"(row0), "+v"(col0));
#pragma unroll
        for (int ai = 0; ai < 2; ++ai)
#pragma unroll
            for (int m = 0; m < 4; ++m) { const size_t ro = (size_t)(row0 + ai * HALF + m * 16) * 1024 + col0;
#pragma unroll
                for (int bj = 0; bj < 2; ++bj) { const u32x4 g = *(const u32x4*)(glb + ro + bj * HALF); const f32x4 v0 = acc[ai][bj][m][0], v1 = acc[ai][bj][m][1];
#define SG2(G, VA, VB) ({ f32x2 e_ = (f32x2){bf_lo(G), bf_hi(G)} * (f32x2){-LOG2E, -LOG2E}; e_[0] = __builtin_amdgcn_exp2f(e_[0]); e_[1] = __builtin_amdgcn_exp2f(e_[1]); e_ = e_ + (f32x2){1.0f, 1.0f}; \
                        e_[0] = __builtin_amdgcn_rcpf(e_[0]); e_[1] = __builtin_amdgcn_rcpf(e_[1]); e_ = e_ * (f32x2){VA, VB}; cvt_pk_bf16(e_[0], e_[1]); })
                    u32x4 w; w.x = SG2(g.x, v0[0], v0[1]); w.y = SG2(g.y, v0[2], v0[3]); w.z = SG2(g.z, v1[0], v1[1]); w.w = SG2(g.w, v1[2], v1[3]);
#undef SG2
                    *(u32x4*)(out + ro + bj * HALF) = w; } }
    }
};
struct EpiOut {
    static constexpr bool PERM = true, HAS_MID = false;
    const float* x; const float* adaf; bf16_t* x1;
    __device__ __forceinline__ void operator()(const f32x4 (&acc)[2][2][4][2], const Unit& u, int wr, int wc, int fr, int fq) const {
        const int row0 = u.row0 + wr * 64 + fr, col0 = u.pn * 256 + wc * 32 + 8 * fq;
        const float* gt = adaf + (u.row0 >= SEQ ? 6144 : 0) + 2048;
        f32x4 gv[2][2];
#pragma unroll
        for (int bj = 0; bj < 2; ++bj)
#pragma unroll
            for (int n = 0; n < 2; ++n) gv[bj][n] = *(const f32x4*)(gt + col0 + bj * HALF + 4 * n);
#pragma unroll
        for (int ai = 0; ai < 2; ++ai)
#pragma unroll
            for (int m = 0; m < 4; ++m) { const size_t ro = (size_t)(row0 + ai * HALF + m * 16) * 1024 + col0;
#pragma unroll
                for (int bj = 0; bj < 2; ++bj) { const f32x4 x0 = *(const f32x4*)(x + ro + bj * HALF), x4 = *(const f32x4*)(x + ro + bj * HALF + 4);
                    const f32x4 v0 = x0 + gv[bj][0] * acc[ai][bj][m][0], v1 = x4 + gv[bj][1] * acc[ai][bj][m][1];
                    u32x4 w; w.x = cvt_pk_bf16(v0[0], v0[1]); w.y = cvt_pk_bf16(v0[2], v0[3]); w.z = cvt_pk_bf16(v1[0], v1[1]); w.w = cvt_pk_bf16(v1[2], v1[3]);
                    *(u32x4*)(x1 + ro + bj * HALF) = w; } }
    }
};
struct EpiGU {
    static constexpr bool PERM = true, HAS_MID = false;
    const float* bgu; bf16_t* act;
    __device__ __forceinline__ void operator()(const f32x4 (&acc)[2][2][4][2], const Unit& u, int wr, int wc, int fr, int fq) const {
        const int row0 = u.row0 + wr * 64 + fr, col0 = u.pn * 128 + wc * 32 + 8 * fq;
        const float* bg = bgu + (size_t)u.e * 2048 + col0;
        f32x4 bgv[2], buv[2];
#pragma unroll
        for (int n = 0; n < 2; ++n) { bgv[n] = *(const f32x4*)(bg + 4 * n); buv[n] = *(const f32x4*)(bg + 1024 + 4 * n); }
#pragma unroll
        for (int ai = 0; ai < 2; ++ai)
#pragma unroll
            for (int m = 0; m < 4; ++m) { float r[8];
#pragma unroll
                for (int n = 0; n < 2; ++n)
#pragma unroll
                    for (int j = 0; j < 4; ++j) { const float gte = fminf(acc[ai][0][m][n][j] + bgv[n][j], 7.0f); const float up = fminf(fmaxf(acc[ai][1][m][n][j] + buv[n][j], -7.0f), 7.0f);
                        r[4 * n + j] = (up + 1.0f) * gte * sigmoidf_fast(1.702f * gte); }
                u32x4 w; w.x = cvt_pk_bf16(r[0], r[1]); w.y = cvt_pk_bf16(r[2], r[3]); w.z = cvt_pk_bf16(r[4], r[5]); w.w = cvt_pk_bf16(r[6], r[7]);
                *(u32x4*)(act + (size_t)(row0 + ai * HALF + m * 16) * 1024 + col0) = w; }
    }
};
struct EpiGUQ {
    static constexpr bool PERM = true, HAS_MID = false;
    const float* bgu; const float* sw; const float* slot_sa; bf16_t* act;
    __device__ __forceinline__ void operator()(const i32x4 (&acc)[2][2][4][2], const Unit& u, int wr, int wc, int fr, int fq) const {
        const int row0 = u.row0 + wr * 64 + fr, col0 = u.pn * 128 + wc * 32 + 8 * fq;
        const float* bg = bgu + (size_t)u.e * 2048 + col0; const float* sg = sw + (size_t)u.e * 2048 + col0;
        f32x4 bgv[2], buv[2], sgv[2], suv[2];
#pragma unroll
        for (int n = 0; n < 2; ++n) { bgv[n] = *(const f32x4*)(bg + 4 * n); buv[n] = *(const f32x4*)(bg + 1024 + 4 * n); sgv[n] = *(const f32x4*)(sg + 4 * n); suv[n] = *(const f32x4*)(sg + 1024 + 4 * n); }
#pragma unroll
        for (int ai = 0; ai < 2; ++ai)
#pragma unroll
            for (int m = 0; m < 4; ++m) { if (ai == 1 && u.half) continue; const int row = row0 + ai * HALF + m * 16; const float ts = slot_sa[row]; unsigned r[4];
#pragma unroll
                for (int n = 0; n < 2; ++n)
#pragma unroll
                    for (int h = 0; h < 2; ++h) { const int j = 2 * h;
                        const f32x2 ag = (f32x2){(float)acc[ai][0][m][n][j], (float)acc[ai][0][m][n][j + 1]}, au = (f32x2){(float)acc[ai][1][m][n][j], (float)acc[ai][1][m][n][j + 1]};
                        const f32x2 tsv = (f32x2){ts, ts};
                        f32x2 g = ag * ((f32x2){sgv[n][j], sgv[n][j + 1]} * tsv) + (f32x2){bgv[n][j], bgv[n][j + 1]};
                        f32x2 up = au * ((f32x2){suv[n][j], suv[n][j + 1]} * tsv) + (f32x2){buv[n][j], buv[n][j + 1]};
                        g[0] = fminf(g[0], 7.0f); g[1] = fminf(g[1], 7.0f); up[0] = fminf(fmaxf(up[0], -7.0f), 7.0f); up[1] = fminf(fmaxf(up[1], -7.0f), 7.0f);
                        f32x2 e = g * (f32x2){-1.702f * LOG2E, -1.702f * LOG2E};
                        e[0] = __builtin_amdgcn_exp2f(e[0]); e[1] = __builtin_amdgcn_exp2f(e[1]);
                        e = e + (f32x2){1.0f, 1.0f};
                        e[0] = __builtin_amdgcn_rcpf(e[0]); e[1] = __builtin_amdgcn_rcpf(e[1]);
                        const f32x2 o = (up + (f32x2){1.0f, 1.0f}) * (g * e);
                        r[2 * n + h] = cvt_pk_bf16(o[0], o[1]); }
                u32x4 w; w.x = r[0]; w.y = r[1]; w.z = r[2]; w.w = r[3];
                *(u32x4*)(act + (size_t)row * 1024 + col0) = w; }
    }
};
struct EpiDown {
    static constexpr bool PERM = true, HAS_MID = false;
    const float* bd; const float* slotw; bf16_t* out;
    __device__ __forceinline__ void operator()(const f32x4 (&acc)[2][2][4][2], const Unit& u, int wr, int wc, int fr, int fq) const {
        const int row0 = u.row0 + wr * 64 + fr, col0 = u.pn * 256 + wc * 32 + 8 * fq;
        const float* bp = bd + (size_t)u.e * 1024 + col0;
        f32x4 bv[2][2];
#pragma unroll
        for (int bj = 0; bj < 2; ++bj)
#pragma unroll
            for (int n = 0; n < 2; ++n) bv[bj][n] = *(const f32x4*)(bp + bj * HALF + 4 * n);
#pragma unroll
        for (int ai = 0; ai < 2; ++ai)
#pragma unroll
            for (int m = 0; m < 4; ++m) { if (ai == 1 && u.half) continue; const int row = row0 + ai * HALF + m * 16; const float w8 = slotw[row]; bf16_t* rowp = out + (size_t)row * 1024 + col0;
#pragma unroll
                for (int bj = 0; bj < 2; ++bj) { const f32x4 v0 = (acc[ai][bj][m][0] + bv[bj][0]) * w8, v1 = (acc[ai][bj][m][1] + bv[bj][1]) * w8;
                    u32x4 w; w.x = cvt_pk_bf16(v0[0], v0[1]); w.y = cvt_pk_bf16(v0[2], v0[3]); w.z = cvt_pk_bf16(v1[0], v1[1]); w.w = cvt_pk_bf16(v1[2], v1[3]);
                    *(u32x4*)(rowp + bj * HALF) = w; } }
    }
};
template <bool GATHER, bool WAIT, bool SIGNAL, bool SPLIT = false> struct MoeSched {
    static constexpr bool HAS_READY = WAIT, HAS_DONE = SIGNAL;
    const LAS int* te; int NP, G, c; const int* slot_tok; const char* W; size_t wstride, btile; unsigned* tdone; unsigned* tmo;
    __device__ __forceinline__ bool next(int i, Unit& u) const {
        const int ntl = te[32], nwg = ntl * NP;
        const int rounds = (nwg + G - 1) / G, rem = nwg - (rounds - 1) * G; const bool split = SPLIT && 2 * rem <= G;
        long L = (long)i * G + c; int half = 0, hsel = 0;
        if (split && i == rounds - 1) { if (c >= 2 * rem) return false; L = (long)i * G + (c >> 1); half = 1; hsel = c & 1; }
        if (L >= nwg) return false;
        int wgid = (int)L; { const int q = nwg / NXCD, r = nwg % NXCD, xcd = wgid % NXCD, off = wgid / NXCD; wgid = (xcd < r ? xcd * (q + 1) : r * (q + 1) + (xcd - r) * q) + off; }
        int e = 0;
        for (int k = 1; k < NE; ++k) e += (wgid >= te[k] * NP) ? 1 : 0;
        const int t0 = te[e], nte = te[e + 1] - t0, r_ = wgid - t0 * NP; const int pn = r_ / nte, t = t0 + r_ % nte;
        u.row0 = t * 256 + hsel * 128; u.pn = pn; u.pm = t; u.e = e; u.half = half; u.bptr = W + (size_t)e * wstride + (size_t)pn * btile; return true;
    }
    __device__ __forceinline__ int arow(const Unit& u, int r) const { if (u.half) r &= 127; if constexpr (GATHER) return slot_tok[u.row0 + r]; else return u.row0 + r; }
    __device__ __forceinline__ void a_ready(const Unit& u) const {
        if constexpr (WAIT) {
            if (threadIdx.x < 64) {
                const unsigned long long t0 = __builtin_amdgcn_s_memrealtime(); unsigned polls = 0;
                while ((unsigned)__builtin_amdgcn_readfirstlane(__hip_atomic_load(tdone + 64 * u.pm, __ATOMIC_RELAXED, __HIP_MEMORY_SCOPE_AGENT)) < 64u) {
                    if ((++polls & 255u) == 0u && __builtin_amdgcn_readfirstlane(__hip_atomic_load(tmo, __ATOMIC_RELAXED, __HIP_MEMORY_SCOPE_AGENT)) != 0u) break;
                    if (__builtin_amdgcn_s_memrealtime() - t0 > 2000000ull) { if (threadIdx.x == 0) __hip_atomic_store(tmo, 1u, __ATOMIC_RELAXED, __HIP_MEMORY_SCOPE_AGENT); break; }
                    __builtin_amdgcn_s_sleep(2); }
                __builtin_amdgcn_fence(__ATOMIC_ACQUIRE, "agent");
                asm volatile("s_waitcnt vmcnt(0)" ::: "memory");
            }
            asm volatile("" ::: "memory"); __builtin_amdgcn_s_barrier(); asm volatile("" ::: "memory");
        }
    }
    __device__ __forceinline__ void done(int pm) const {
        if constexpr (SIGNAL) {
            if ((threadIdx.x & 63) == 0) __hip_atomic_fetch_add(tdone + 64 * pm, 1u, __ATOMIC_RELAXED, __HIP_MEMORY_SCOPE_AGENT); }
    }
};
}

constexpr int BT_STR = 132;
constexpr int AT_BT = LDSCTL_OFF + 1024, AT_K = 0, AT_V = AT_K + 64 * 72 * 2, AT_MISC = LDSCTL_OFF + 8192;
typedef short v4i16_t __attribute__((ext_vector_type(4)));
__device__ __forceinline__ s16x4 tr16(const LAS unsigned char* p) { return __builtin_bit_cast(s16x4, __builtin_amdgcn_ds_read_tr16_b64_v4i16((LAS v4i16_t*)p)); }

template <int NDT>
__device__ __forceinline__ void attn_tile(const LAS unsigned char* lds, int lane, const bf16x8 (&qf)[2], f32x4 (&o)[NDT], float& m_run, float& l_run,
                                          int qpos, int kbase, bool causal, const LAS float* bt) {
    constexpr int VSTR = NDT * 16 + 8;
    const int c = lane & 15, g = lane >> 4;
    f32x4 s[4];
#pragma unroll
    for (int kt = 0; kt < 4; ++kt) { s[kt] = (f32x4){0.f, 0.f, 0.f, 0.f};
#pragma unroll
        for (int ks = 0; ks < 2; ++ks) { const bf16x8 a = *(const LAS bf16x8*)(lds + AT_K + ((16 * kt + c) * 72 + 32 * ks + 8 * g) * 2);
            s[kt] = __builtin_amdgcn_mfma_f32_16x16x32_bf16(a, qf[ks], s[kt], 0, 0, 0); } }
    if (__any((qpos - (kbase + 63)) < 128)) {
#pragma unroll
        for (int kt = 0; kt < 4; ++kt)
#pragma unroll
            for (int i = 0; i < 4; ++i) { const int dist = qpos - (kbase + 16 * kt + 4 * g + i); const int di = dist < 0 ? 0 : (dist > 127 ? 127 : dist);
                const float bv = bt[di]; float v = s[kt][i];
                if (dist >= 0 && dist < 128) v += bv;
                if (causal && dist < 0) v = -INFINITY;
                s[kt][i] = v; }
    }
    float mx = fmaxf(fmaxf(s[0][0], s[0][1]), fmaxf(s[0][2], s[0][3]));
#pragma unroll
    for (int kt = 1; kt < 4; ++kt) mx = fmaxf(mx, fmaxf(fmaxf(s[kt][0], s[kt][1]), fmaxf(s[kt][2], s[kt][3])));
    mx = fmaxf(mx, __shfl_xor(mx, 16)); mx = fmaxf(mx, __shfl_xor(mx, 32));
    const float m_new = fmaxf(m_run, mx), alpha = __builtin_amdgcn_exp2f(m_run - m_new);
    float psum = 0.f;
#pragma unroll
    for (int kt = 0; kt < 4; ++kt)
#pragma unroll
        for (int i = 0; i < 4; ++i) { const float p = __builtin_amdgcn_exp2f(s[kt][i] - m_new); s[kt][i] = p; psum += p; }
    l_run = l_run * alpha + psum; m_run = m_new;
#pragma unroll
    for (int i = 0; i < 4; ++i) { const float ai = __shfl(alpha, 4 * g + i);
#pragma unroll
        for (int dt = 0; dt < NDT; ++dt) o[dt][i] *= ai; }
    bf16x8 pa[2];
#pragma unroll
    for (int kk = 0; kk < 2; ++kk) { u32x4 w; w.x = cvt_pk_bf16(s[2 * kk][0], s[2 * kk][1]); w.y = cvt_pk_bf16(s[2 * kk][2], s[2 * kk][3]);
        w.z = cvt_pk_bf16(s[2 * kk + 1][0], s[2 * kk + 1][1]); w.w = cvt_pk_bf16(s[2 * kk + 1][2], s[2 * kk + 1][3]); pa[kk] = __builtin_bit_cast(bf16x8, w); }
    const LAS unsigned char* vb = lds + AT_V + ((4 * g + (c >> 2)) * VSTR + 4 * (c & 3)) * 2;
#pragma unroll
    for (int dt = 0; dt < NDT; ++dt)
#pragma unroll
        for (int kk = 0; kk < 2; ++kk) { const s16x4 lo = tr16(vb + (32 * kk * VSTR + 16 * dt) * 2), hi = tr16(vb + ((32 * kk + 16) * VSTR + 16 * dt) * 2);
            const bf16x8 b = (bf16x8){lo[0], lo[1], lo[2], lo[3], hi[0], hi[1], hi[2], hi[3]};
            o[dt] = __builtin_amdgcn_mfma_f32_16x16x32_bf16(pa[kk], b, o[dt], 0, 0, 0); }
}

template <int NV> struct TileRegs { u32x4 k; u32x4 v[NV]; };
template <int NV> __device__ __forceinline__ void tile_fetch(TileRegs<NV>& r, const bf16_t* kg, const bf16_t* vg, int tid) {
    const int row = tid >> 3, ch = tid & 7;
    r.k = *(const u32x4*)(kg + (size_t)row * 1024 + ch * 8);
#pragma unroll
    for (int i = 0; i < NV; ++i) r.v[i] = *(const u32x4*)(vg + (size_t)row * 1024 + (ch + 8 * i) * 8);
}
template <int NV> __device__ __forceinline__ void tile_store(const TileRegs<NV>& r, LAS unsigned char* lds, int tid) {
    constexpr int VSTR = NV * 64 + 8;
    const int row = tid >> 3, ch = tid & 7;
    *(LAS u32x4*)(lds + AT_K + (row * 72 + ch * 8) * 2) = r.k;
#pragma unroll
    for (int i = 0; i < NV; ++i) *(LAS u32x4*)(lds + AT_V + (row * VSTR + (ch + 8 * i) * 8) * 2) = r.v[i];
}
#include <hip/hip_bf16.h>
#include <cmath>
namespace attn_body {
using bf16=__hip_bfloat16;
using bf16x8=__attribute__((ext_vector_type(8)))short;
using s16x4=__attribute__((ext_vector_type(4)))short;
using f32x16=__attribute__((ext_vector_type(16)))float;
using u32x4=__attribute__((ext_vector_type(4)))unsigned;
constexpr int BATCH=2,NHEAD=16,SEQ=8192,D=64,DM=NHEAD*D;
constexpr int NW=8,QBLK=32,QB=QBLK*NW,KVBLK=64,NQB=SEQ/QB;
constexpr int ATTN_PITCH=DM, ATTN_UNIT_ROWS=QB;
__device__ __forceinline__ int crow(int r,int hi){return (r&3)+8*(r>>2)+4*hi;}
#define SBAR() __builtin_amdgcn_sched_barrier(0)
typedef const __attribute__((address_space(3))) float* lds_cfptr;
__device__ __forceinline__ void cbias(f32x16&p0,f32x16&p1,int jb,int qrel,int hi,lds_cfptr bt){
  const float NEG=-INFINITY; const int kb=64*jb+4*hi;
  #pragma unroll
  for(int r=0;r<16;++r){const int d0=qrel-(kb+(r&3)+8*(r>>2)),d1=d0-32;
    const unsigned c0=(unsigned)d0<128u?(unsigned)d0:128u,c1=(unsigned)d1<128u?(unsigned)d1:128u;
    const float v0=p0[r]+bt[c0],v1=p1[r]+bt[c1];
    p0[r]=d0<0?NEG:v0; p1[r]=d1<0?NEG:v1;}
}
constexpr int NSLOT=3, SLOTB=8192;
constexpr int LDS_K=0, LDS_V=NSLOT*SLOTB, LDS_WS=2*NSLOT*SLOTB, LDS_OST=LDS_WS+NW*64*4, LDS_BYTES=LDS_OST+NW*4096;
constexpr float C2=0.125f*1.4426950408889634f;
__device__ __forceinline__ void glds16(const void*gsrc,unsigned lds_dst){unsigned keep;
  asm volatile("s_mov_b32 %0, m0\n\ts_mov_b32 m0, %2\n\ts_nop 0\n\tglobal_load_lds_dwordx4 %1, off\n\ts_mov_b32 m0, %0":"=&s"(keep):"v"(gsrc),"s"(lds_dst):"memory");}
__device__ __forceinline__ float max3f(float a,float b,float c){float r;asm("v_max3_f32 %0, %1, %2, %3":"=v"(r):"v"(a),"v"(b),"v"(c));return r;}
__device__ __forceinline__ float max2f(float a,float b){float r;asm("v_max_f32_e32 %0, %1, %2":"=v"(r):"v"(a),"v"(b));return r;}
__device__ __forceinline__ float fadd_s(float a,float b){float r;asm("v_add_f32_e32 %0, %1, %2":"=v"(r):"v"(a),"v"(b));return r;}
__device__ __forceinline__ float fsub_s(float a,float b){float r;asm("v_sub_f32_e32 %0, %1, %2":"=v"(r):"v"(a),"v"(b));return r;}
typedef float f32x2_t __attribute__((ext_vector_type(2))); typedef __bf16 bf16x2_t __attribute__((ext_vector_type(2)));
__device__ __forceinline__ unsigned cvtpk_s(float lo,float hi){f32x2_t v={lo,hi};bf16x2_t b=__builtin_convertvector(v,bf16x2_t);return __builtin_bit_cast(unsigned,b);}
#define WAIT_BAR(N) asm volatile("s_waitcnt vmcnt(" #N ") lgkmcnt(0)\n\ts_barrier":::"memory")

__device__ __forceinline__ void qkt(f32x16&p0,f32x16&p1,const char*Kslot,const bf16x8*qr,const f32x16&negm,int r32,int hi){
  const char*kb=Kslot+hi*1024+r32*16;
  #pragma unroll
  for(int d0=0;d0<4;++d0){
    const bf16x8 b0=*reinterpret_cast<const bf16x8*>(kb+d0*2048);
    const bf16x8 b1=*reinterpret_cast<const bf16x8*>(kb+d0*2048+512);
    if(d0==0){p0=__builtin_amdgcn_mfma_f32_32x32x16_bf16(b0,qr[0],negm,0,0,0);p1=__builtin_amdgcn_mfma_f32_32x32x16_bf16(b1,qr[0],negm,0,0,0);}
    else{p0=__builtin_amdgcn_mfma_f32_32x32x16_bf16(b0,qr[d0],p0,0,0,0);p1=__builtin_amdgcn_mfma_f32_32x32x16_bf16(b1,qr[d0],p1,0,0,0);}}
}
typedef __attribute__((address_space(3))) const char* lds_cptr;
typedef short v4i16_t __attribute__((ext_vector_type(4)));
__device__ __forceinline__ void kload8(bf16x8*kf,lds_cptr kp){
  kf[0]=*(const __attribute__((address_space(3))) bf16x8*)(kp);      kf[1]=*(const __attribute__((address_space(3))) bf16x8*)(kp+512);
  kf[2]=*(const __attribute__((address_space(3))) bf16x8*)(kp+2048); kf[3]=*(const __attribute__((address_space(3))) bf16x8*)(kp+2560);
  kf[4]=*(const __attribute__((address_space(3))) bf16x8*)(kp+4096); kf[5]=*(const __attribute__((address_space(3))) bf16x8*)(kp+4608);
  kf[6]=*(const __attribute__((address_space(3))) bf16x8*)(kp+6144); kf[7]=*(const __attribute__((address_space(3))) bf16x8*)(kp+6656);
}
__device__ __forceinline__ void kload2(bf16x8*kf,lds_cptr kp,int j){ kf[2*j]=*(const __attribute__((address_space(3))) bf16x8*)(kp+j*2048); kf[2*j+1]=*(const __attribute__((address_space(3))) bf16x8*)(kp+j*2048+512); }
__device__ __forceinline__ s16x4 vtr(lds_cptr p){ return __builtin_bit_cast(s16x4,__builtin_amdgcn_ds_read_tr16_b64_v4i16((__attribute__((address_space(3))) v4i16_t*)p)); }
__device__ __forceinline__ float rowmax(const f32x16&p0,const f32x16&p1){
  float a=max3f(p0[0],p0[1],p1[0]),b=max3f(p0[2],p0[3],p1[1]);a=max3f(a,p1[2],p1[3]);
  #pragma unroll
  for(int r=4;r<16;r+=4){a=max3f(a,p0[r],p0[r+1]);b=max3f(b,p0[r+2],p0[r+3]);a=max3f(a,p1[r],p1[r+1]);b=max3f(b,p1[r+2],p1[r+3]);}
  const float m=max2f(a,b);
  auto rr=__builtin_amdgcn_permlane32_swap(__float_as_uint(m),__float_as_uint(m),false,false);
  return max2f(__uint_as_float(rr[0]),__uint_as_float(rr[1]));
}
__device__ __forceinline__ void pv(f32x16*o,int vb,bf16x8 pa0,bf16x8 pa1,bf16x8 pa2,bf16x8 pa3){
  #pragma unroll
  for(int d0=0;d0<2;++d0){s16x4 lo[4],hi[4];
    #pragma unroll
    for(int ks=0;ks<4;++ks){
      asm volatile("ds_read_b64_tr_b16 %0,%1 offset:%c2":"=&v"(lo[ks]):"v"(vb),"i"(d0*4096+ks*1024):"memory");
      asm volatile("ds_read_b64_tr_b16 %0,%1 offset:%c2":"=&v"(hi[ks]):"v"(vb),"i"(d0*4096+ks*1024+512):"memory");}
    asm volatile("s_waitcnt lgkmcnt(0)":::"memory");SBAR();
    #define PK(k) (bf16x8){lo[k][0],lo[k][1],lo[k][2],lo[k][3],hi[k][0],hi[k][1],hi[k][2],hi[k][3]}
    o[d0]=__builtin_amdgcn_mfma_f32_32x32x16_bf16(pa0,PK(0),o[d0],0,0,0);
    o[d0]=__builtin_amdgcn_mfma_f32_32x32x16_bf16(pa1,PK(1),o[d0],0,0,0);
    o[d0]=__builtin_amdgcn_mfma_f32_32x32x16_bf16(pa2,PK(2),o[d0],0,0,0);
    o[d0]=__builtin_amdgcn_mfma_f32_32x32x16_bf16(pa3,PK(3),o[d0],0,0,0);
    #undef PK
  }
}

#ifndef ATTN_STORE16
#define ATTN_STORE16(p,v) (*(u32x4*)(p)=(v))
#endif
template<int THRL> __device__ __forceinline__ void attn_unit(int b,int qb,const bf16*Q,const bf16*__restrict__ K,const bf16*__restrict__ V,bf16*O,int qc,int kc,int vc,int oc,lds_cfptr bt,char*shm){
  int tid_=threadIdx.x; asm volatile("":"+v"(tid_)); const int tid=tid_,lane=tid&63,r32=lane&31,hi=lane>>5; const int wid=__builtin_amdgcn_readfirstlane(tid>>6);
  const long rowbase=(long)b*SEQ; const int q0=qb*QB;
  const bf16*Qw=Q+(rowbase+q0+wid*QBLK)*DM+qc;
  const bf16*Kh=K+rowbase*DM+kc,*Vh=V+rowbase*DM+vc;
  const unsigned lds0=(unsigned)(uintptr_t)shm;
  float*wsf=(float*)(shm+LDS_WS)+wid*64;
  const bf16*ksrc=Kh+(long)lane*DM+wid*8;
  const bf16*vsrc=Vh+(long)(16*(wid&3)+(lane>>2))*DM+(wid>>2)*32+(lane&3)*8;
  const unsigned kdst=lds0+LDS_K+wid*1024, vdst=lds0+LDS_V+wid*1024;
  #define DMA_K(t,slot) glds16(ksrc+(long)(t)*KVBLK*DM,(unsigned)__builtin_amdgcn_readfirstlane(kdst+(slot)))
  #define DMA_V(t,slot) glds16(vsrc+(long)(t)*KVBLK*DM,(unsigned)__builtin_amdgcn_readfirstlane(vdst+(slot)))
  const int vb0=(int)(lds0+LDS_V)+((lane>>4)&1)*32+(lane&3)*8+(4*hi+((lane&15)>>2))*64;
  const char*Kbase=shm+LDS_K; bf16x8 kf[8];
  const lds_cptr shm3=(lds_cptr)shm; const lds_cptr kp0=shm3+LDS_K+hi*1024+r32*16; const lds_cptr vp0=shm3+LDS_V+((lane>>4)&1)*32+(lane&3)*8+(4*hi+((lane&15)>>2))*64;
  const int NT=(q0+QB)/KVBLK;
  DMA_K(0,0);DMA_V(0,0);DMA_K(1,SLOTB);
  bf16x8 qr[4];
  #pragma unroll
  for(int d0=0;d0<4;++d0)qr[d0]=*reinterpret_cast<const bf16x8*>(&Qw[(long)r32*DM+d0*16+hi*8]);
  float mhat=0.f,l_reg=0.f;f32x16 o[2],negm; { float z_=0.f; asm volatile("":"+v"(z_));
    _Pragma("unroll") for(int r=0;r<16;++r){o[0][r]=z_;o[1][r]=z_;negm[r]=z_;} } asm volatile("":"+v"(negm));
  const int qrel=wid*QBLK+r32;
  #define CMASK(P0,P1,t) do{int jb_=(t)-(NT-4); if(jb_>=-2 && (wid*QBLK-(64*jb_+63))<128)cbias(P0,P1,jb_,qrel,hi,bt);}while(0)
  bool resc=false;
  #define START(P0,P1) do{ const float rm=rowmax(P0,P1); resc=false; \
    { const float dl=rm; mhat=fadd_s(mhat,dl); \
      _Pragma("unroll") for(int r=0;r<16;++r){P0[r]=fsub_s(P0[r],dl);P1[r]=fsub_s(P1[r],dl);} \
      _Pragma("unroll") for(int r=0;r<16;++r)negm[r]=-mhat; asm volatile("":"+v"(negm)); } \
    _Pragma("unroll") for(int r=0;r<16;++r)P0[r]=__builtin_amdgcn_exp2f(P0[r]); }while(0)
  #define RESC() do{ if(resc){ asm volatile("s_waitcnt lgkmcnt(0)":::"memory"); \
      _Pragma("unroll") for(int d_=0;d_<2;++d_) _Pragma("unroll") for(int r=0;r<16;++r)o[d_][r]*=wsf[crow(r,hi)]; } }while(0)
  f32x16 pA0,pA1,pB0,pB1;
  int sl_prev=0,sl_cur=0,sl_next=SLOTB;
  #define ROT() do{sl_prev=sl_cur;sl_cur=sl_next;sl_next=(sl_next==(NSLOT-1)*SLOTB)?0:sl_next+SLOTB;}while(0)
  DMA_K(2,2*SLOTB);
  WAIT_BAR(3);
  qkt(pA0,pA1,Kbase,qr,negm,r32,hi);asm volatile("s_nop 15\n\ts_nop 7":"+v"(pA0),"+v"(pA1));CMASK(pA0,pA1,0);
  START(pA0,pA1);
  _Pragma("unroll") for(int r=0;r<16;++r)pA1[r]=__builtin_amdgcn_exp2f(pA1[r]);
  WAIT_BAR(0);
  DMA_K(3,0);DMA_V(1,SLOTB);
  ROT();
  kload8(kf,kp0+sl_cur);
  WAIT_BAR(2);
  s16x4 vlo[8],vhi[8]; u32x4 pw0,pw1,pw2,pw3;
  #define PKW(P,B) cvtpk_s(P[B],P[B+1])
  #define PAF(k) __builtin_bit_cast(bf16x8,pw##k)
  #define VFR(i) (bf16x8){vlo[i][0],vlo[i][1],vlo[i][2],vlo[i][3],vhi[i][0],vhi[i][1],vhi[i][2],vhi[i][3]}
  #define PIN(x) asm volatile("":"+v"(x))
  #define MX3(a,b,c) __builtin_fmaxf(__builtin_fmaxf((a),(b)),(c))
  #define GAPA(MF,A0,A1,A2,A3,W0,W1,PW) do{ MF; sacc+=A0; sacc+=A1; sacc+=A2; sacc+=A3; PIN(sacc); W0; W1; PIN(PW); SBAR(); }while(0)
  #define EX(v) __builtin_amdgcn_exp2f(v)
  #define GAPB(MF,X,B) do{ MF; X[B]=EX(X[B]); X[B+1]=EX(X[B+1]); X[B+2]=EX(X[B+2]); X[B+3]=EX(X[B+3]); PIN(X); SBAR(); }while(0)
  #define VRD(i) do{ vlo[i]=vtr(vp_+(((i)>>2)*4096+((i)&3)*1024)); vhi[i]=vtr(vp_+(((i)>>2)*4096+((i)&3)*1024+512)); }while(0)
  #define KRD(G,j) do{ if(G){ kload2(kf,kp0+sl_next,j); SBAR(); } }while(0)
  #define STEP(C0,C1,P0,P1,t,GK,GV,GL) do{ SBAR(); \
    const lds_cptr vp_=vp0+sl_prev; \
    VRD(0); SBAR(); float sacc=(P0[0]+P0[1]); \
    GAPA(C0=__builtin_amdgcn_mfma_f32_32x32x16_bf16(kf[0],qr[0],negm,0,0,0), P0[2],P0[3],P0[4],P0[5],     pw0[0]=PKW(P0,0), pw0[1]=PKW(P0,2), pw0); \
    VRD(4); SBAR(); GAPA(C1=__builtin_amdgcn_mfma_f32_32x32x16_bf16(kf[1],qr[0],negm,0,0,0), P0[6],P0[7],P0[8],P0[9],     pw0[2]=PKW(P0,4), pw0[3]=PKW(P0,6), pw0); \
    VRD(1); SBAR(); GAPA(C0=__builtin_amdgcn_mfma_f32_32x32x16_bf16(kf[2],qr[1],C0,0,0,0),   P0[10],P0[11],P0[12],P0[13], pw1[0]=PKW(P0,8), pw1[1]=PKW(P0,10), pw1); \
    VRD(5); SBAR(); GAPA(C1=__builtin_amdgcn_mfma_f32_32x32x16_bf16(kf[3],qr[1],C1,0,0,0),   P0[14],P0[15],P1[0],P1[1],   pw1[2]=PKW(P0,12),pw1[3]=PKW(P0,14), pw1); \
    VRD(2); SBAR(); GAPA(C0=__builtin_amdgcn_mfma_f32_32x32x16_bf16(kf[4],qr[2],C0,0,0,0),   P1[2],P1[3],P1[4],P1[5],     pw2[0]=PKW(P1,0), pw2[1]=PKW(P1,2), pw2); \
    VRD(6); SBAR(); GAPA(C1=__builtin_amdgcn_mfma_f32_32x32x16_bf16(kf[5],qr[2],C1,0,0,0),   P1[6],P1[7],P1[8],P1[9],     pw2[2]=PKW(P1,4), pw2[3]=PKW(P1,6), pw2); \
    VRD(3); SBAR(); GAPA(C0=__builtin_amdgcn_mfma_f32_32x32x16_bf16(kf[6],qr[3],C0,0,0,0),   P1[10],P1[11],P1[12],P1[13], pw3[0]=PKW(P1,8), pw3[1]=PKW(P1,10), pw3); \
    VRD(7); SBAR(); GAPA(C1=__builtin_amdgcn_mfma_f32_32x32x16_bf16(kf[7],qr[3],C1,0,0,0),   P1[14],P1[15],0.f,0.f,       pw3[2]=PKW(P1,12),pw3[3]=PKW(P1,14), pw3); \
    l_reg+=sacc; \
    if(GK){DMA_K((t)+3,sl_cur);} if(GV){DMA_V((t)+1,sl_next);} \
    CMASK(C0,C1,t); \
    { float a=MX3(C0[0],C0[1],C1[0]),b=MX3(C0[2],C0[3],C1[1]); a=MX3(a,C1[2],C1[3]); \
      _Pragma("unroll") for(int r=4;r<16;r+=4){a=MX3(a,C0[r],C0[r+1]);b=MX3(b,C0[r+2],C0[r+3]);a=MX3(a,C1[r],C1[r+1]);b=MX3(b,C1[r+2],C1[r+3]);} \
      float rm=__builtin_fmaxf(a,b); { auto rr=__builtin_amdgcn_permlane32_swap(__float_as_uint(rm),__float_as_uint(rm),false,false); rm=__builtin_fmaxf(__uint_as_float(rr[0]),__uint_as_float(rr[1])); } \
      resc=false; \
      if(__builtin_expect(__any(rm>(float)THRL),0)){ const float dl=__builtin_fmaxf(rm,0.f); mhat+=dl; \
        _Pragma("unroll") for(int r=0;r<16;++r){C0[r]-=dl;C1[r]-=dl;} \
        _Pragma("unroll") for(int r=0;r<16;++r)negm[r]=-mhat; asm volatile("":"+v"(negm)); \
        const float f=__builtin_amdgcn_exp2f(-dl); l_reg*=f; if(hi==0)wsf[r32]=f; resc=true; } } \
    SBAR(); \
    GAPB(o[0]=__builtin_amdgcn_mfma_f32_32x32x16_bf16(PAF(0),VFR(0),o[0],0,0,0), C0,0); \
    GAPB(o[1]=__builtin_amdgcn_mfma_f32_32x32x16_bf16(PAF(0),VFR(4),o[1],0,0,0), C0,4); \
    KRD(GL,0); GAPB(o[0]=__builtin_amdgcn_mfma_f32_32x32x16_bf16(PAF(1),VFR(1),o[0],0,0,0), C0,8); \
    KRD(GL,1); GAPB(o[1]=__builtin_amdgcn_mfma_f32_32x32x16_bf16(PAF(1),VFR(5),o[1],0,0,0), C0,12); \
    KRD(GL,2); GAPB(o[0]=__builtin_amdgcn_mfma_f32_32x32x16_bf16(PAF(2),VFR(2),o[0],0,0,0), C1,0); \
    KRD(GL,3); GAPB(o[1]=__builtin_amdgcn_mfma_f32_32x32x16_bf16(PAF(2),VFR(6),o[1],0,0,0), C1,4); \
    GAPB(o[0]=__builtin_amdgcn_mfma_f32_32x32x16_bf16(PAF(3),VFR(3),o[0],0,0,0), C1,8); \
    GAPB(o[1]=__builtin_amdgcn_mfma_f32_32x32x16_bf16(PAF(3),VFR(7),o[1],0,0,0), C1,12); \
    }while(0)
  int t=1;
  #undef CMASK
  #define CMASK(P0,P1,t) do{}while(0)
  for(;t+7<NT;t+=2){
    STEP(pB0,pB1,pA0,pA1,t,true,true,true);     WAIT_BAR(2); RESC(); ROT();
    STEP(pA0,pA1,pB0,pB1,t+1,true,true,true);   WAIT_BAR(2); RESC(); ROT();
  }
  #undef CMASK
  #define CMASK(P0,P1,t) do{int jb_=(t)-(NT-4); if(jb_>=-2 && (wid*QBLK-(64*jb_+63))<128)cbias(P0,P1,jb_,qrel,hi,bt);}while(0)
  #define ENDW(tt) do{ if((tt)+3<NT){WAIT_BAR(2);} else if((tt)+2<NT){WAIT_BAR(1);} else {WAIT_BAR(0);} }while(0)
  for(;t+1<NT;t+=2){
    STEP(pB0,pB1,pA0,pA1,t,(t+3<NT),(t+1<NT),(t+1<NT));       ENDW(t);   RESC(); ROT();
    STEP(pA0,pA1,pB0,pB1,t+1,(t+4<NT),(t+2<NT),(t+2<NT));     ENDW(t+1); RESC(); ROT();
  }
  STEP(pB0,pB1,pA0,pA1,NT-1,false,false,false); RESC();
  { float sacc=pB0[0]+pB0[1]; _Pragma("unroll") for(int r=2;r<16;++r)sacc+=pB0[r]; _Pragma("unroll") for(int r=0;r<16;++r)sacc+=pB1[r]; l_reg+=sacc;
    pw0=(u32x4){PKW(pB0,0),PKW(pB0,2),PKW(pB0,4),PKW(pB0,6)};pw1=(u32x4){PKW(pB0,8),PKW(pB0,10),PKW(pB0,12),PKW(pB0,14)};pw2=(u32x4){PKW(pB1,0),PKW(pB1,2),PKW(pB1,4),PKW(pB1,6)};pw3=(u32x4){PKW(pB1,8),PKW(pB1,10),PKW(pB1,12),PKW(pB1,14)};
    SBAR(); pv(o,vb0+sl_cur,PAF(0),PAF(1),PAF(2),PAF(3)); }
  #undef PKW
  #undef PAF
  #undef VFR
  #undef PIN
  #undef MX3
  #undef GAPA
  #undef GAPB
  #undef EX
  #undef VRD
  #undef KRD
  #undef STEP
  #undef ENDW
  {auto rr=__builtin_amdgcn_permlane32_swap(__float_as_uint(l_reg),__float_as_uint(l_reg),false,false);l_reg=__uint_as_float(rr[0])+__uint_as_float(rr[1]);}
  if(hi==0)wsf[32+r32]=l_reg;asm volatile("s_waitcnt lgkmcnt(0)":::"memory");
  float rli[16];
  #pragma unroll
  for(int r=0;r<16;++r)rli[r]=__builtin_amdgcn_rcpf(wsf[32+crow(r,hi)]);
  bf16*Ow=O+(rowbase+q0+wid*QBLK)*DM+oc;
  { bf16*stg=(bf16*)(shm+LDS_OST)+wid*2048;
    #pragma unroll
    for(int r=0;r<16;++r){const int orow=crow(r,hi);
      #pragma unroll
      for(int d0=0;d0<2;++d0)stg[orow*64+d0*32+r32]=__float2bfloat16(o[d0][r]*rli[r]);}
    asm volatile("s_waitcnt lgkmcnt(0)":::"memory");
    #pragma unroll
    for(int i=0;i<4;++i){const int row=i*8+(lane>>3),ch=lane&7; const u32x4 v=*(const u32x4*)(stg+row*64+ch*8); ATTN_STORE16(Ow+(long)row*DM+ch*8,v);} }
  asm volatile("s_waitcnt lgkmcnt(0)\n\ts_barrier":::"memory");
  #undef DMA_K
  #undef DMA_V
  #undef CMASK
  #undef START
  #undef RESC
  #undef ROT
}
constexpr int ATTN_LDS_BYTES=LDS_BYTES;
#undef SBAR
#undef WAIT_BAR
}
#include <hip/hip_bf16.h>
#include <cmath>
#ifndef ATTN_QLDS
#define ATTN_QLDS 1
#endif
namespace attn_nat {
using bf16=__hip_bfloat16;
using bf16x8=__attribute__((ext_vector_type(8)))short;
using s16x4=__attribute__((ext_vector_type(4)))short;
using f32x16=__attribute__((ext_vector_type(16)))float;
using u32x4=__attribute__((ext_vector_type(4)))unsigned;
constexpr int BATCH=2,NHEAD=16,SEQ=8192,D=64,DM=NHEAD*D;
constexpr int NW=8,QBLK=32,QB=QBLK*NW,KVBLK=64,NQB=SEQ/QB;
constexpr int ATTN_PITCH=DM, ATTN_UNIT_ROWS=QB;
__device__ __forceinline__ int crow(int r,int hi){return (r&3)+8*(r>>2)+4*hi;}
#define SBAR() __builtin_amdgcn_sched_barrier(0)
typedef const __attribute__((address_space(3))) float* lds_cfptr;
__device__ __forceinline__ void cbias(f32x16&p0,f32x16&p1,int jb,int qrel,int hi,lds_cfptr bt){
  const float NEG=-INFINITY; const int kb=64*jb+4*hi;
  #pragma unroll
  for(int r=0;r<16;++r){const int d0=qrel-(kb+(r&3)+8*(r>>2)),d1=d0-32;
    const unsigned c0=(unsigned)d0<128u?(unsigned)d0:128u,c1=(unsigned)d1<128u?(unsigned)d1:128u;
    const float v0=p0[r]+bt[c0],v1=p1[r]+bt[c1];
    p0[r]=d0<0?NEG:v0; p1[r]=d1<0?NEG:v1;
    if((r&3)==3)__builtin_amdgcn_sched_barrier(0);}
}
constexpr int NSLOT=3, SLOTB=8192;
constexpr int LDS_K=0, LDS_V=NSLOT*SLOTB, LDS_WS=3*NSLOT*SLOTB, LDS_OST=LDS_WS+NW*64*4, LDS_BYTES=LDS_OST+NW*4096;
constexpr float C2=0.125f*1.4426950408889634f;
__device__ __forceinline__ void glds16(const void*sbase,unsigned voff,unsigned lds_dst){unsigned keep;
  asm volatile("s_mov_b32 %0, m0\n\ts_mov_b32 m0, %3\n\ts_nop 0\n\tglobal_load_lds_dwordx4 %1, %2\n\ts_mov_b32 m0, %0":"=&s"(keep):"v"(voff),"s"(sbase),"s"(lds_dst):"memory");}
__device__ __forceinline__ float max3f(float a,float b,float c){float r;asm("v_max3_f32 %0, %1, %2, %3":"=v"(r):"v"(a),"v"(b),"v"(c));return r;}
__device__ __forceinline__ float max2f(float a,float b){float r;asm("v_max_f32_e32 %0, %1, %2":"=v"(r):"v"(a),"v"(b));return r;}
__device__ __forceinline__ float fadd_s(float a,float b){float r;asm("v_add_f32_e32 %0, %1, %2":"=v"(r):"v"(a),"v"(b));return r;}
__device__ __forceinline__ float fsub_s(float a,float b){float r;asm("v_sub_f32_e32 %0, %1, %2":"=v"(r):"v"(a),"v"(b));return r;}
typedef float f32x2_t __attribute__((ext_vector_type(2))); typedef __bf16 bf16x2_t __attribute__((ext_vector_type(2)));
__device__ __forceinline__ unsigned cvtpk_s(float lo,float hi){f32x2_t v={lo,hi};bf16x2_t b=__builtin_convertvector(v,bf16x2_t);return __builtin_bit_cast(unsigned,b);}
#define WAIT_BAR(N) asm volatile("s_waitcnt vmcnt(" #N ") lgkmcnt(0)\n\ts_barrier":::"memory")

__device__ __forceinline__ void qkt(f32x16&p0,f32x16&p1,const char*Kslot,const bf16x8*qr,const f32x16&negm,int r32,int hi){
  const char*kb=Kslot+hi*1024+r32*16;
  #pragma unroll
  for(int d0=0;d0<4;++d0){
    const bf16x8 b0=*reinterpret_cast<const bf16x8*>(kb+d0*2048);
    const bf16x8 b1=*reinterpret_cast<const bf16x8*>(kb+d0*2048+512);
    if(d0==0){p0=__builtin_amdgcn_mfma_f32_32x32x16_bf16(b0,qr[0],negm,0,0,0);p1=__builtin_amdgcn_mfma_f32_32x32x16_bf16(b1,qr[0],negm,0,0,0);}
    else{p0=__builtin_amdgcn_mfma_f32_32x32x16_bf16(b0,qr[d0],p0,0,0,0);p1=__builtin_amdgcn_mfma_f32_32x32x16_bf16(b1,qr[d0],p1,0,0,0);}}
}
typedef __attribute__((address_space(3))) const char* lds_cptr;
typedef short v4i16_t __attribute__((ext_vector_type(4)));
__device__ __forceinline__ void kload8(bf16x8*kf,lds_cptr kp){
  kf[0]=*(const __attribute__((address_space(3))) bf16x8*)(kp);      kf[1]=*(const __attribute__((address_space(3))) bf16x8*)(kp+512);
  kf[2]=*(const __attribute__((address_space(3))) bf16x8*)(kp+2048); kf[3]=*(const __attribute__((address_space(3))) bf16x8*)(kp+2560);
  kf[4]=*(const __attribute__((address_space(3))) bf16x8*)(kp+4096); kf[5]=*(const __attribute__((address_space(3))) bf16x8*)(kp+4608);
  kf[6]=*(const __attribute__((address_space(3))) bf16x8*)(kp+6144); kf[7]=*(const __attribute__((address_space(3))) bf16x8*)(kp+6656);
}
__device__ __forceinline__ void kload2(bf16x8*kf,lds_cptr kp,int j){ kf[2*j]=*(const __attribute__((address_space(3))) bf16x8*)(kp+j*2048); kf[2*j+1]=*(const __attribute__((address_space(3))) bf16x8*)(kp+j*2048+512); }
__device__ __forceinline__ s16x4 vtr(lds_cptr p){ return __builtin_bit_cast(s16x4,__builtin_amdgcn_ds_read_tr16_b64_v4i16((__attribute__((address_space(3))) v4i16_t*)p)); }
__device__ __forceinline__ float rowmax(const f32x16&p0,const f32x16&p1){
  float a=max3f(p0[0],p0[1],p1[0]),b=max3f(p0[2],p0[3],p1[1]);a=max3f(a,p1[2],p1[3]);
  #pragma unroll
  for(int r=4;r<16;r+=4){a=max3f(a,p0[r],p0[r+1]);b=max3f(b,p0[r+2],p0[r+3]);a=max3f(a,p1[r],p1[r+1]);b=max3f(b,p1[r+2],p1[r+3]);}
  const float m=max2f(a,b);
  auto rr=__builtin_amdgcn_permlane32_swap(__float_as_uint(m),__float_as_uint(m),false,false);
  return max2f(__uint_as_float(rr[0]),__uint_as_float(rr[1]));
}
__device__ __forceinline__ void pv(f32x16*o,int vb,bf16x8 pa0,bf16x8 pa1,bf16x8 pa2,bf16x8 pa3){
  #pragma unroll
  for(int d0=0;d0<4;++d0){s16x4 lo[4],hi[4];
    #pragma unroll
    for(int ks=0;ks<4;++ks){
      asm volatile("ds_read_b64_tr_b16 %0,%1 offset:%c2":"=&v"(lo[ks]):"v"(vb),"i"(d0*4096+ks*1024):"memory");
      asm volatile("ds_read_b64_tr_b16 %0,%1 offset:%c2":"=&v"(hi[ks]):"v"(vb),"i"(d0*4096+ks*1024+512):"memory");}
    asm volatile("s_waitcnt lgkmcnt(0)":::"memory");SBAR();
    #define PK(k) (bf16x8){lo[k][0],lo[k][1],lo[k][2],lo[k][3],hi[k][0],hi[k][1],hi[k][2],hi[k][3]}
    o[d0]=__builtin_amdgcn_mfma_f32_32x32x16_bf16(pa0,PK(0),o[d0],0,0,0);
    o[d0]=__builtin_amdgcn_mfma_f32_32x32x16_bf16(pa1,PK(1),o[d0],0,0,0);
    o[d0]=__builtin_amdgcn_mfma_f32_32x32x16_bf16(pa2,PK(2),o[d0],0,0,0);
    o[d0]=__builtin_amdgcn_mfma_f32_32x32x16_bf16(pa3,PK(3),o[d0],0,0,0);
    #undef PK
  }
}

#ifndef ATTN_STORE16
#define ATTN_STORE16(p,v) (*(u32x4*)(p)=(v))
#endif
template<int THRL> __device__ __forceinline__ void attn_unit(int b,int qb,const bf16*Q,const bf16*__restrict__ K,const bf16*__restrict__ V,bf16*O,int qc,int kc,int vc,int oc,lds_cfptr bt,char*shm){
  int tid_=threadIdx.x; asm volatile("":"+v"(tid_)); const int tid=tid_,lane=tid&63,r32=lane&31,hi=lane>>5; const int wid=__builtin_amdgcn_readfirstlane(tid>>6);
  const long rowbase=(long)b*SEQ; const int q0=qb*QB;
  const bf16*Qw=Q+(rowbase+q0+wid*QBLK)*DM+qc;
  const bf16*Kh=K+rowbase*DM+kc,*Vh=V+rowbase*DM+vc;
  const unsigned lds0=(unsigned)(uintptr_t)shm;
  float*wsf=(float*)(shm+LDS_WS)+wid*64;
  const unsigned koff=(unsigned)((lane*DM+wid*8)*2);
  const unsigned voff=(unsigned)(((16*(wid&3)+(lane>>2))*DM+(wid>>2)*32+(lane&3)*8)*2);
  const unsigned kdst=lds0+LDS_K+wid*1024, vdst=lds0+LDS_V+wid*1024;
  #define DMA_K(t,slot) glds16(Kh+(long)(t)*KVBLK*DM,koff,(unsigned)__builtin_amdgcn_readfirstlane(kdst+(slot)))
  #define DMA_V(t,slot) do{ glds16(Vh+(long)(t)*KVBLK*DM,voff,(unsigned)__builtin_amdgcn_readfirstlane(vdst+2*(slot))); glds16(Vh+(long)(t)*KVBLK*DM+64,voff,(unsigned)__builtin_amdgcn_readfirstlane(vdst+2*(slot)+8192)); }while(0)
  const char*Kbase=shm+LDS_K; bf16x8 kf[8];
  const lds_cptr shm3=(lds_cptr)shm; const lds_cptr kp0=shm3+LDS_K+hi*1024+r32*16; const lds_cptr vp0=shm3+LDS_V+((lane>>4)&1)*32+(lane&3)*8+(4*hi+((lane&15)>>2))*64;
  const int NT=(q0+QB)/KVBLK;
  DMA_K(0,0);DMA_V(0,0);DMA_K(1,SLOTB);
  bf16x8 qr[4];
  #pragma unroll
  for(int d0=0;d0<4;++d0)qr[d0]=*reinterpret_cast<const bf16x8*>(&Qw[(long)r32*DM+d0*16+hi*8]);
#if ATTN_QLDS
  const lds_cptr qst=shm3+LDS_OST+wid*4096+r32*128;
  #pragma unroll
  for(int d0=0;d0<4;++d0)*(__attribute__((address_space(3))) bf16x8*)(shm3+LDS_OST+wid*4096+r32*128+(((2*d0+hi)^(r32&7))<<4))=qr[d0];
  #define QF(d) (*(const __attribute__((address_space(3))) bf16x8*)(qst+(((2*(d)+hi)^(r32&7))<<4)))
#else
  #define QF(d) qr[d]
#endif
  float mhat=0.f,l_reg=0.f;f32x16 o[4]; { float z_=0.f; asm volatile("":"+v"(z_));
    _Pragma("unroll") for(int r=0;r<16;++r){o[0][r]=z_;o[1][r]=z_;o[2][r]=z_;o[3][r]=z_;} }
  const int qrel=wid*QBLK+r32;
  #define CMASK(P0,P1,t) do{int jb_=(t)-(NT-4); if(jb_>=-2 && (wid*QBLK-(64*jb_+63))<128)cbias(P0,P1,jb_,qrel,hi,bt);}while(0)
  bool resc=false;
  #define START(P0,P1) do{ const float rm=rowmax(P0,P1); resc=false; \
    { const float dl=rm; mhat=fadd_s(mhat,dl); \
      _Pragma("unroll") for(int r=0;r<16;++r){P0[r]=fsub_s(P0[r],dl);P1[r]=fsub_s(P1[r],dl);} } \
    _Pragma("unroll") for(int r=0;r<16;++r)P0[r]=__builtin_amdgcn_exp2f(P0[r]); }while(0)
  #define RESC() do{ if(resc){ asm volatile("s_waitcnt lgkmcnt(0)":::"memory"); \
      _Pragma("unroll") for(int d_=0;d_<4;++d_) _Pragma("unroll") for(int r=0;r<16;++r)o[d_][r]*=wsf[crow(r,hi)]; } }while(0)
  f32x16 pA0,pA1,pB0,pB1;
  int sl_prev=0,sl_cur=0,sl_next=SLOTB;
  #define ROT() do{sl_prev=sl_cur;sl_cur=sl_next;sl_next=(sl_next==(NSLOT-1)*SLOTB)?0:sl_next+SLOTB;}while(0)
  DMA_K(2,2*SLOTB);
  WAIT_BAR(4);
  qkt(pA0,pA1,Kbase,qr,f32x16{},r32,hi);asm volatile("s_nop 15\n\ts_nop 7":"+v"(pA0),"+v"(pA1));CMASK(pA0,pA1,0);
  START(pA0,pA1);
  _Pragma("unroll") for(int r=0;r<16;++r)pA1[r]=__builtin_amdgcn_exp2f(pA1[r]);
  WAIT_BAR(0);
  DMA_K(3,0);DMA_V(1,SLOTB);
  ROT();
  kload8(kf,kp0+sl_cur);
  WAIT_BAR(3);
  s16x4 vlo[8],vhi[8]; u32x4 pw0,pw1,pw2,pw3;
  #define PKW(P,B) cvtpk_s(P[B],P[B+1])
  #define PAF(k) __builtin_bit_cast(bf16x8,pw##k)
  #define VFR(i) (bf16x8){vlo[i][0],vlo[i][1],vlo[i][2],vlo[i][3],vhi[i][0],vhi[i][1],vhi[i][2],vhi[i][3]}
  #define PIN(x) asm volatile("":"+v"(x))
  #define MX3(a,b,c) __builtin_fmaxf(__builtin_fmaxf((a),(b)),(c))
  #define GAPA(MF,A0,A1,A2,A3,W0,W1,PW) do{ MF; sacc+=A0; sacc+=A1; sacc+=A2; sacc+=A3; PIN(sacc); W0; W1; PIN(PW); SBAR(); }while(0)
  #define EX(v) __builtin_amdgcn_exp2f(v)
  #define GAPB(MF,X,B) do{ MF; X[B]=EX(X[B]); X[B+1]=EX(X[B+1]); X[B+2]=EX(X[B+2]); X[B+3]=EX(X[B+3]); PIN(X); SBAR(); }while(0)
  #define GAPB2(MF,X,B) do{ MF; X[B]=EX(X[B]); X[B+1]=EX(X[B+1]); PIN(X); SBAR(); }while(0)
  #define VRD2(i) do{ vlo[i]=vtr(vp_+((2+((i)>>2))*4096+((i)&3)*1024)); vhi[i]=vtr(vp_+((2+((i)>>2))*4096+((i)&3)*1024+512)); SBAR(); }while(0)
  #define VRD(i) do{ vlo[i]=vtr(vp_+(((i)>>2)*4096+((i)&3)*1024)); vhi[i]=vtr(vp_+(((i)>>2)*4096+((i)&3)*1024+512)); }while(0)
  #define KRD(G,j) do{ if(G){ kload2(kf,kp0+sl_next,j); SBAR(); } }while(0)
  #define STEP(C0,C1,P0,P1,t,GK,GV,GL) do{ SBAR(); \
    const lds_cptr vp_=vp0+2*sl_prev; \
    VRD(0); SBAR(); float sacc=(P0[0]+P0[1]); \
    GAPA(C0=__builtin_amdgcn_mfma_f32_32x32x16_bf16(kf[0],QF(0),f32x16{},0,0,0), P0[2],P0[3],P0[4],P0[5],     pw0[0]=PKW(P0,0), pw0[1]=PKW(P0,2), pw0); \
    VRD(4); SBAR(); GAPA(C1=__builtin_amdgcn_mfma_f32_32x32x16_bf16(kf[1],QF(0),f32x16{},0,0,0), P0[6],P0[7],P0[8],P0[9],     pw0[2]=PKW(P0,4), pw0[3]=PKW(P0,6), pw0); \
    VRD(1); SBAR(); GAPA(C0=__builtin_amdgcn_mfma_f32_32x32x16_bf16(kf[2],QF(1),C0,0,0,0),   P0[10],P0[11],P0[12],P0[13], pw1[0]=PKW(P0,8), pw1[1]=PKW(P0,10), pw1); \
    VRD(5); SBAR(); GAPA(C1=__builtin_amdgcn_mfma_f32_32x32x16_bf16(kf[3],QF(1),C1,0,0,0),   P0[14],P0[15],P1[0],P1[1],   pw1[2]=PKW(P0,12),pw1[3]=PKW(P0,14), pw1); \
    VRD(2); SBAR(); GAPA(C0=__builtin_amdgcn_mfma_f32_32x32x16_bf16(kf[4],QF(2),C0,0,0,0),   P1[2],P1[3],P1[4],P1[5],     pw2[0]=PKW(P1,0), pw2[1]=PKW(P1,2), pw2); \
    VRD(6); SBAR(); GAPA(C1=__builtin_amdgcn_mfma_f32_32x32x16_bf16(kf[5],QF(2),C1,0,0,0),   P1[6],P1[7],P1[8],P1[9],     pw2[2]=PKW(P1,4), pw2[3]=PKW(P1,6), pw2); \
    VRD(3); SBAR(); GAPA(C0=__builtin_amdgcn_mfma_f32_32x32x16_bf16(kf[6],QF(3),C0,0,0,0),   P1[10],P1[11],P1[12],P1[13], pw3[0]=PKW(P1,8), pw3[1]=PKW(P1,10), pw3); \
    VRD(7); SBAR(); GAPA(C1=__builtin_amdgcn_mfma_f32_32x32x16_bf16(kf[7],QF(3),C1,0,0,0),   P1[14],P1[15],0.f,0.f,       pw3[2]=PKW(P1,12),pw3[3]=PKW(P1,14), pw3); \
    l_reg+=sacc; \
    if(GK){DMA_K((t)+3,sl_cur);} if(GV){DMA_V((t)+1,sl_next);} \
    _Pragma("unroll") for(int r=0;r<16;++r){C0[r]-=mhat;C1[r]-=mhat;} \
    SBAR(); CMASK(C0,C1,t); SBAR(); \
    { float a=MX3(C0[0],C0[1],C1[0]),b=MX3(C0[2],C0[3],C1[1]); a=MX3(a,C1[2],C1[3]); \
      _Pragma("unroll") for(int r=4;r<16;r+=4){a=MX3(a,C0[r],C0[r+1]);b=MX3(b,C0[r+2],C0[r+3]);a=MX3(a,C1[r],C1[r+1]);b=MX3(b,C1[r+2],C1[r+3]);} \
      float rm=__builtin_fmaxf(a,b); { auto rr=__builtin_amdgcn_permlane32_swap(__float_as_uint(rm),__float_as_uint(rm),false,false); rm=__builtin_fmaxf(__uint_as_float(rr[0]),__uint_as_float(rr[1])); } \
      resc=false; \
      if(__builtin_expect(__any(rm>(float)THRL),0)){ const float dl=__builtin_fmaxf(rm,0.f); mhat+=dl; \
        _Pragma("unroll") for(int r=0;r<16;++r){C0[r]-=dl;C1[r]-=dl;} \
        const float f=__builtin_amdgcn_exp2f(-dl); l_reg*=f; if(hi==0)wsf[r32]=f; resc=true; } } \
    SBAR(); \
    GAPB2(o[0]=__builtin_amdgcn_mfma_f32_32x32x16_bf16(PAF(0),VFR(0),o[0],0,0,0), C0,0);  VRD2(0); \
    GAPB2(o[1]=__builtin_amdgcn_mfma_f32_32x32x16_bf16(PAF(0),VFR(4),o[1],0,0,0), C0,2);  VRD2(4); \
    GAPB2(o[0]=__builtin_amdgcn_mfma_f32_32x32x16_bf16(PAF(1),VFR(1),o[0],0,0,0), C0,4);  VRD2(1); \
    GAPB2(o[1]=__builtin_amdgcn_mfma_f32_32x32x16_bf16(PAF(1),VFR(5),o[1],0,0,0), C0,6);  VRD2(5); \
    GAPB2(o[0]=__builtin_amdgcn_mfma_f32_32x32x16_bf16(PAF(2),VFR(2),o[0],0,0,0), C0,8);  VRD2(2); \
    GAPB2(o[1]=__builtin_amdgcn_mfma_f32_32x32x16_bf16(PAF(2),VFR(6),o[1],0,0,0), C0,10); VRD2(6); \
    GAPB2(o[0]=__builtin_amdgcn_mfma_f32_32x32x16_bf16(PAF(3),VFR(3),o[0],0,0,0), C0,12); VRD2(3); \
    GAPB2(o[1]=__builtin_amdgcn_mfma_f32_32x32x16_bf16(PAF(3),VFR(7),o[1],0,0,0), C0,14); VRD2(7); \
    GAPB2(o[2]=__builtin_amdgcn_mfma_f32_32x32x16_bf16(PAF(0),VFR(0),o[2],0,0,0), C1,0); \
    GAPB2(o[3]=__builtin_amdgcn_mfma_f32_32x32x16_bf16(PAF(0),VFR(4),o[3],0,0,0), C1,2); \
    KRD(GL,0); GAPB2(o[2]=__builtin_amdgcn_mfma_f32_32x32x16_bf16(PAF(1),VFR(1),o[2],0,0,0), C1,4); \
    GAPB2(o[3]=__builtin_amdgcn_mfma_f32_32x32x16_bf16(PAF(1),VFR(5),o[3],0,0,0), C1,6); \
    KRD(GL,1); GAPB2(o[2]=__builtin_amdgcn_mfma_f32_32x32x16_bf16(PAF(2),VFR(2),o[2],0,0,0), C1,8); \
    GAPB2(o[3]=__builtin_amdgcn_mfma_f32_32x32x16_bf16(PAF(2),VFR(6),o[3],0,0,0), C1,10); \
    KRD(GL,2); GAPB2(o[2]=__builtin_amdgcn_mfma_f32_32x32x16_bf16(PAF(3),VFR(3),o[2],0,0,0), C1,12); \
    GAPB2(o[3]=__builtin_amdgcn_mfma_f32_32x32x16_bf16(PAF(3),VFR(7),o[3],0,0,0), C1,14); \
    KRD(GL,3); \
    }while(0)
  int t=1;
  #undef CMASK
  #define CMASK(P0,P1,t) do{}while(0)
  for(;t+7<NT;t+=2){
    STEP(pB0,pB1,pA0,pA1,t,true,true,true);     WAIT_BAR(3); RESC(); ROT();
    STEP(pA0,pA1,pB0,pB1,t+1,true,true,true);   WAIT_BAR(3); RESC(); ROT();
  }
  #undef CMASK
  int tb_=threadIdx.x; asm volatile("":"+v"(tb_)); const int qrel_b=(tb_>>6)*QBLK+(tb_&31),hi_b=(tb_&63)>>5;
  #define CMASK(P0,P1,t) do{int jb_=(t)-(NT-4); if(jb_>=-2 && (wid*QBLK-(64*jb_+63))<128)cbias(P0,P1,jb_,qrel_b,hi_b,bt);}while(0)
  #define ENDW(tt) do{ if((tt)+3<NT){WAIT_BAR(3);} else if((tt)+2<NT){WAIT_BAR(2);} else {WAIT_BAR(0);} }while(0)
  for(;t+1<NT;t+=2){
    STEP(pB0,pB1,pA0,pA1,t,(t+3<NT),(t+1<NT),(t+1<NT));       ENDW(t);   RESC(); ROT();
    STEP(pA0,pA1,pB0,pB1,t+1,(t+4<NT),(t+2<NT),(t+2<NT));     ENDW(t+1); RESC(); ROT();
  }
  STEP(pB0,pB1,pA0,pA1,NT-1,false,false,false); RESC();
  { float sacc=pB0[0]+pB0[1]; _Pragma("unroll") for(int r=2;r<16;++r)sacc+=pB0[r]; _Pragma("unroll") for(int r=0;r<16;++r)sacc+=pB1[r]; l_reg+=sacc;
    pw0=(u32x4){PKW(pB0,0),PKW(pB0,2),PKW(pB0,4),PKW(pB0,6)};pw1=(u32x4){PKW(pB0,8),PKW(pB0,10),PKW(pB0,12),PKW(pB0,14)};pw2=(u32x4){PKW(pB1,0),PKW(pB1,2),PKW(pB1,4),PKW(pB1,6)};pw3=(u32x4){PKW(pB1,8),PKW(pB1,10),PKW(pB1,12),PKW(pB1,14)};
    SBAR(); { int td_=threadIdx.x; asm volatile("":"+v"(td_)); const int ld_=td_&63; const int vb0=(int)((unsigned)(uintptr_t)shm+LDS_V)+((ld_>>4)&1)*32+(ld_&3)*8+(4*(ld_>>5)+((ld_&15)>>2))*64;
      pv(o,vb0+2*sl_cur,PAF(0),PAF(1),PAF(2),PAF(3)); } }
  #undef PKW
  #undef PAF
  #undef VFR
  #undef PIN
  #undef MX3
  #undef GAPA
  #undef GAPB
  #undef GAPB2
  #undef VRD2
  #undef EX
  #undef VRD
  #undef KRD
  #undef STEP
  #undef ENDW
  { int te_=threadIdx.x; asm volatile("":"+v"(te_)); const int lane_e=te_&63,r32e=lane_e&31,hie=lane_e>>5; const int wide=__builtin_amdgcn_readfirstlane(te_>>6);
  float*wsfe=(float*)(shm+LDS_WS)+wide*64;
  {auto rr=__builtin_amdgcn_permlane32_swap(__float_as_uint(l_reg),__float_as_uint(l_reg),false,false);l_reg=__uint_as_float(rr[0])+__uint_as_float(rr[1]);}
  if(hie==0)wsfe[32+r32e]=l_reg;asm volatile("s_waitcnt lgkmcnt(0)":::"memory");
  float rli[16];
  #pragma unroll
  for(int r=0;r<16;++r)rli[r]=__builtin_amdgcn_rcpf(wsfe[32+crow(r,hie)]);
  bf16*Ow=O+((long)b*SEQ+qb*QB+wide*QBLK)*DM+oc;
  { bf16*stg=(bf16*)(shm+LDS_OST)+wide*2048;
    #pragma unroll
    for(int hf=0;hf<2;++hf){
      #pragma unroll
      for(int r=0;r<16;++r){const int orow=crow(r,hie);
        #pragma unroll
        for(int d0=0;d0<2;++d0)stg[orow*64+d0*32+r32e]=__float2bfloat16(o[2*hf+d0][r]*rli[r]);}
      asm volatile("s_waitcnt lgkmcnt(0)":::"memory");
      #pragma unroll
      for(int i=0;i<4;++i){const int row=i*8+(lane_e>>3),ch=lane_e&7; const u32x4 v=*(const u32x4*)(stg+row*64+ch*8); ATTN_STORE16(Ow+(long)row*DM+hf*64+ch*8,v);}
      asm volatile("s_waitcnt lgkmcnt(0)":::"memory"); } } }
  asm volatile("s_waitcnt lgkmcnt(0)\n\ts_barrier":::"memory");
  #undef DMA_K
  #undef DMA_V
  #undef CMASK
  #undef START
  #undef RESC
  #undef ROT
  #undef QF
}
constexpr int ATTN_LDS_BYTES=LDS_BYTES;
#undef SBAR
#undef WAIT_BAR
}
#define XROW(m0) ((C.G == 256) ? (((gw >> 8) << 11) + (gw & 255) + (((m0) - gw) >> 11) * 256) : (m0))
struct Ctx {
    LAS unsigned char* lds; char* ldsg; int tid, lane, wave, G, vcu;
    const float* in[23]; float* out; unsigned char* ws;
};
#define WSP(T, off) ((T*)(C.ws + (off)))
#define PHASE_IDS() Ctx C = C0; { int t_ = threadIdx.x; asm volatile("" : "+v"(t_)); C.tid = t_; C.lane = t_ & 63; C.wave = __builtin_amdgcn_readfirstlane(t_ >> 6); }

struct ConvDesc { const float* src; bf16_t* dst; int N, K; };
__device__ __forceinline__ ConvDesc conv_desc(const Ctx& C, int it) {
    constexpr int I_IN = 16 * 160, I_BR = 8 * 32, I_GU1 = 16 * 64, I_GU = NE * I_GU1, I_D1 = 16 * 32, I_D = NE * I_D1;
    const float* W; bf16_t* WT; int K, N, kb, nb, orow; int r = it;
    if (r < I_GU) { const int e = r / I_GU1, q = r % I_GU1; kb = q / 64; nb = q % 64; const int n0 = 32 * nb, half = n0 >> 10, rem = n0 & 1023;
        W = C.in[18] + (size_t)e * 1024 * 2048; WT = WSP(bf16_t, WS_WGU) + (size_t)e * 2048 * 1024; K = 1024; N = 2048; orow = (rem >> 7) * 256 + half * 128 + (rem & 127); }
    else if ((r -= I_GU) < I_D) { const int e = r / I_D1, q = r % I_D1; kb = q / 32; nb = q % 32; W = C.in[20] + (size_t)e * 1024 * 1024; WT = WSP(bf16_t, WS_WD) + (size_t)e * 1024 * 1024; K = 1024; N = 1024; orow = 32 * nb; }
    else if ((r -= I_D) < I_IN) { kb = r / 160; nb = r % 160; W = C.in[6]; WT = WSP(bf16_t, WS_WIN); K = 1024; N = INW; orow = 32 * nb; }
    else if ((r -= I_IN) < I_BR) { kb = r / 32; nb = r % 32; W = C.in[12]; WT = WSP(bf16_t, WS_WBR); K = 1024; N = 1024; orow = 32 * nb; }
    else if ((r -= I_BR) < I_BR) { kb = r / 32; nb = r % 32; W = C.in[13]; WT = WSP(bf16_t, WS_WBR) + 512; K = 1024; N = 1024; orow = 32 * nb; }
    else { r -= I_BR; kb = r / 32; nb = r % 32; W = C.in[14]; WT = WSP(bf16_t, WS_WOUT); K = 1024; N = 1024; orow = 32 * nb; }
    ConvDesc d; d.src = W + (size_t)(64 * kb) * N + 32 * nb; d.dst = WT + (size_t)orow * K + 64 * kb; d.N = N; d.K = K; return d;
}
__device__ __forceinline__ void conv_load(const ConvDesc& d, f32x4 (&v)[8], int lane) {
    const int kr = lane >> 3, nc = lane & 7;
#pragma unroll
    for (int i = 0; i < 8; ++i) v[i] = *(const f32x4*)(d.src + (size_t)(8 * i + kr) * d.N + 4 * nc);
}
__device__ __forceinline__ void conv_finish(const ConvDesc& d, const f32x4 (&v)[8], LAS float* scr, int lane) {
    const int kr = lane >> 3, nc = lane & 7;
#pragma unroll
    for (int i = 0; i < 8; ++i) { LAS float* s = scr + (8 * i + kr) * 33 + 4 * nc; s[0] = v[i][0]; s[1] = v[i][1]; s[2] = v[i][2]; s[3] = v[i][3]; }
    LDS_WAIT(); asm volatile("" ::: "memory");
    const int c = lane & 7;
#pragma unroll
    for (int j = 0; j < 4; ++j) { const int n = (lane >> 3) + 8 * j; const LAS float* s = scr + (8 * c) * 33 + n;
        u32x4 o; o.x = cvt_pk_bf16(s[0 * 33], s[1 * 33]); o.y = cvt_pk_bf16(s[2 * 33], s[3 * 33]); o.z = cvt_pk_bf16(s[4 * 33], s[5 * 33]); o.w = cvt_pk_bf16(s[6 * 33], s[7 * 33]);
        *(u32x4*)(d.dst + (size_t)n * d.K + 8 * c) = o; }
    LDS_WAIT(); asm volatile("" ::: "memory");
}
__device__ __forceinline__ void conv_range(const Ctx& C, int lo, int hi, int wi, int nw, LAS float* scr) {
    const int first = lo + wi;
    if (first < hi) {
        ConvDesc d0 = conv_desc(C, first), d1 = d0; f32x4 v0[8], v1[8]; conv_load(d0, v0, C.lane);
        for (int it = first; it < hi; it += 2 * nw) {
            const int n1 = it + nw, n2 = it + 2 * nw;
            d1 = conv_desc(C, n1 < hi ? n1 : it); conv_load(d1, v1, C.lane);
            conv_finish(d0, v0, scr, C.lane);
            if (n1 >= hi) break;
            d0 = conv_desc(C, n2 < hi ? n2 : it); conv_load(d0, v0, C.lane);
            conv_finish(d1, v1, scr, C.lane);
        }
    }
}
template <int MODE> __device__ __noinline__ void conv_q_blocks(const float* Wgu, unsigned char* ws, LAS unsigned char* lds, int wave, int first, int stride) {
    int lane_ = (int)__builtin_amdgcn_mbcnt_hi(~0u, __builtin_amdgcn_mbcnt_lo(~0u, 0u)); asm volatile("" : "+v"(lane_));
    const int lane = lane_, tid = wave * 64 + lane, lr = tid >> 3, c4 = tid & 7, n = tid & 31, kg = tid >> 5;
    LAS float* blk = (LAS float*)lds;
    LAS float* wmx = (LAS float*)(lds + LDSCTL_OFF + 14336);
    f32x4 v[16];
    constexpr int NBLK = MODE == 0 ? NE * 64 : 128, LDW = MODE == 0 ? 2048 : INW;
#define QB_SRC(b_) (MODE == 0 ? Wgu + (size_t)((b_) >> 6) * 1024 * 2048 + 32 * ((b_) & 63) : Wgu + 32 * ((b_) < 48 ? (b_) : (b_) + 32))
    if (first < NBLK) { const float* W = QB_SRC(first) + 4 * c4 + (size_t)lr * LDW;
#pragma unroll
        for (int i = 0; i < 16; ++i) v[i] = *(const f32x4*)(W + (size_t)(64 * i) * LDW); }
    for (int bk = first; bk < NBLK; bk += stride) { const int e = MODE == 0 ? bk >> 6 : 0, n0 = MODE == 0 ? 32 * (bk & 63) : 32 * (bk < 48 ? bk : bk + 32), hgu = n0 >> 10, rem = n0 & 1023, orow = MODE == 0 ? (rem >> 7) * 256 + hgu * 128 + (rem & 127) : n0;
        f32x4 mx = (f32x4){0.f, 0.f, 0.f, 0.f};
#pragma unroll
        for (int i = 0; i < 16; ++i) { *(LAS f32x4*)(blk + (64 * i + lr) * 32 + 4 * c4) = v[i]; mx = __builtin_elementwise_max(mx, __builtin_elementwise_abs(v[i])); }
#pragma unroll
        for (int j = 0; j < 4; ++j) { float t = mx[j]; t = fmaxf(t, __shfl_xor(t, 8)); t = fmaxf(t, __shfl_xor(t, 16)); t = fmaxf(t, __shfl_xor(t, 32)); mx[j] = t; }
        if (lane < 8) *(LAS f32x4*)(wmx + wave * 32 + 4 * lane) = mx;
        { const int nk = bk + stride < NBLK ? bk + stride : bk;
          const float* W = QB_SRC(nk) + 4 * c4 + (size_t)lr * LDW;
#pragma unroll
          for (int i = 0; i < 16; ++i) v[i] = *(const f32x4*)(W + (size_t)(64 * i) * LDW); }
        LDS_WAIT(); __builtin_amdgcn_s_barrier(); asm volatile("" ::: "memory");
        float cm = wmx[n];
#pragma unroll
        for (int w = 1; w < 8; ++w) cm = fmaxf(cm, wmx[w * 32 + n]);
        const float inv = cm > 0.f ? 127.0f / cm : 0.f;
        if (kg == 0) ((float*)(ws + (MODE == 0 ? WS_SW : WS_SWIN)))[(size_t)e * 2048 + n0 + n] = cm > 0.f ? cm * (1.0f / 127.0f) : 1.0f;
        signed char* dst = (signed char*)(ws + (MODE == 0 ? WS_WGU : WS_WINQ)) + ((size_t)e * 2048 + orow + n) * 1024 + 64 * kg;
        const LAS float* src = blk + (64 * kg) * 32 + n;
#pragma unroll
        for (int s = 0; s < 4; ++s) { unsigned w4[4];
#pragma unroll
            for (int d = 0; d < 4; ++d) { int b[4];
#pragma unroll
                for (int k = 0; k < 4; ++k) b[k] = (int)fminf(fmaxf(__builtin_rintf(src[(16 * s + 4 * d + k) * 32] * inv), -127.0f), 127.0f);
                w4[d] = (unsigned)(b[0] & 255) | ((unsigned)(b[1] & 255) << 8) | ((unsigned)(b[2] & 255) << 16) | ((unsigned)b[3] << 24); }
            *(u32x4*)(dst + 16 * s) = (u32x4){w4[0], w4[1], w4[2], w4[3]}; }
        LDS_WAIT(); __builtin_amdgcn_s_barrier(); asm volatile("" ::: "memory");
    }
}
#undef QB_SRC
constexpr int CONV_MOE_ITEMS = NE * 16 * 64 + NE * 16 * 32;
constexpr int CONV_ALL_ITEMS = CONV_MOE_ITEMS + 16 * 160 + 2 * 8 * 32 + 16 * 32;
#ifndef NCONV_
#define NCONV_ 13
#endif
constexpr int NCONV = NCONV_;
__device__ __forceinline__ void p0_prologue(const Ctx& C0) {
    PHASE_IDS();
    LAS float* scr = (LAS float*)(C.lds + C.wave * 8448);
    const int gw = C.vcu * NWAVES + C.wave, NGW = C.G * NWAVES;
    conv_q_blocks<1>(C.in[6], C.ws, C.lds, C.wave, (int)blockIdx.x, C.G);
    __syncthreads();
    for (int it = gw; it < 16 * 32; it += NGW) { const int kb = it >> 5, nb = 48 + (it & 31);
        ConvDesc d; d.src = C.in[6] + (size_t)(64 * kb) * INW + 32 * nb; d.dst = WSP(bf16_t, WS_WIN) + (size_t)(32 * nb) * 1024 + 64 * kb; d.N = INW; d.K = 1024;
        f32x4 v[8]; conv_load(d, v, C.lane); conv_finish(d, v, scr, C.lane); }
    conv_range(C, CONV_MOE_ITEMS + 16 * 160, CONV_ALL_ITEMS, gw, NGW, scr);
    const float* cvec = C.in[1]; const float* wada = C.in[3]; float* adap = WSP(float, WS_ADAP);
    for (int it = gw; it < 96 * 16; it += NGW) { const int cc = it % 96, ks = it / 96; const int n = 64 * cc + C.lane; float a0 = 0.f, a1 = 0.f;
#pragma unroll 16
        for (int k = 0; k < 64; ++k) { const int kk = 64 * ks + k; const float w = wada[(size_t)kk * 6144 + n]; a0 += cvec[kk] * w; a1 += cvec[1024 + kk] * w; }
        adap[(ks * 2 + 0) * 6144 + n] = a0; adap[(ks * 2 + 1) * 6144 + n] = a1; }
}
__device__ __forceinline__ float ada_val(const Ctx& C, int b, int n) {
    const float* adap = WSP(const float, WS_ADAP); float s = C.in[4][n];
#pragma unroll
    for (int ks = 0; ks < 16; ++ks) s += adap[(ks * 2 + b) * 6144 + n];
    return s;
}
__device__ __forceinline__ void rms_mod_row(const float* xrow, bf16_t* orow, const LAS float* MA, const LAS float* MB, int lane, signed char* qrow, float* qscale) {
    const f32x4* xr = (const f32x4*)xrow + lane;
    f32x4 v[4]; float s = 0.f;
#pragma unroll
    for (int j = 0; j < 4; ++j) { v[j] = xr[64 * j]; s += (v[j][0] * v[j][0] + v[j][1] * v[j][1]) + (v[j][2] * v[j][2] + v[j][3] * v[j][3]); }
    const float rstd = 1.0f / sqrtf(wave_sum(s) * (1.0f / D) + RMS_EPS);
    u32x2* o8 = (u32x2*)orow + lane;
#pragma unroll
    for (int j = 0; j < 4; ++j) { const f32x4 a = *(const LAS f32x4*)(MA + 4 * lane + 256 * j), b = *(const LAS f32x4*)(MB + 4 * lane + 256 * j);
        const f32x4 h = v[j] * rstd * a + b; u32x2 w; w.x = pk2(h[0], h[1]); w.y = pk2(h[2], h[3]); o8[64 * j] = w; v[j] = h; }
    if (qrow) {
        float am = 0.f;
#pragma unroll
        for (int j = 0; j < 4; ++j)
#pragma unroll
            for (int k = 0; k < 4; ++k) am = fmaxf(am, fabsf(v[j][k]));
#pragma unroll
        for (int o = 1; o < 64; o <<= 1) am = fmaxf(am, __shfl_xor(am, o));
        const float inv = am > 0.f ? 127.0f / am : 0.f;
        if (lane == 0) *qscale = am > 0.f ? am * (1.0f / 127.0f) : 1.0f;
#pragma unroll
        for (int j = 0; j < 4; ++j) { int b4[4];
#pragma unroll
            for (int k = 0; k < 4; ++k) b4[k] = (int)fminf(fmaxf(__builtin_rintf(v[j][k] * inv), -127.0f), 127.0f);
            ((unsigned*)qrow)[lane + 64 * j] = (unsigned)(b4[0] & 255) | ((unsigned)(b4[1] & 255) << 8) | ((unsigned)(b4[2] & 255) << 16) | ((unsigned)b4[3] << 24); } }
}
__device__ __forceinline__ void rms_mod_row_bf16(const bf16_t* xrow, bf16_t* orow, const LAS float* MA, const LAS float* MB, int lane, signed char* qrow, float* qscale) {
    float v[16]; float s = 0.f;
#pragma unroll
    for (int j = 0; j < 2; ++j) { const u32x4 w = *(const u32x4*)(xrow + 512 * j + 8 * lane);
        v[8 * j + 0] = bf_lo(w.x); v[8 * j + 1] = bf_hi(w.x); v[8 * j + 2] = bf_lo(w.y); v[8 * j + 3] = bf_hi(w.y); v[8 * j + 4] = bf_lo(w.z); v[8 * j + 5] = bf_hi(w.z); v[8 * j + 6] = bf_lo(w.w); v[8 * j + 7] = bf_hi(w.w); }
#pragma unroll
    for (int k = 0; k < 16; ++k) s += v[k] * v[k];
    const float rstd = 1.0f / sqrtf(wave_sum(s) * (1.0f / D) + RMS_EPS);
#pragma unroll
    for (int j = 0; j < 2; ++j) { const LAS float* a = MA + 512 * j + 8 * lane; const LAS float* b = MB + 512 * j + 8 * lane;
        const f32x4 a0 = *(const LAS f32x4*)a, a1 = *(const LAS f32x4*)(a + 4), b0 = *(const LAS f32x4*)b, b1 = *(const LAS f32x4*)(b + 4);
        u32x4 w; w.x = pk2(v[8 * j + 0] * rstd * a0[0] + b0[0], v[8 * j + 1] * rstd * a0[1] + b0[1]); w.y = pk2(v[8 * j + 2] * rstd * a0[2] + b0[2], v[8 * j + 3] * rstd * a0[3] + b0[3]);
        w.z = pk2(v[8 * j + 4] * rstd * a1[0] + b1[0], v[8 * j + 5] * rstd * a1[1] + b1[1]); w.w = pk2(v[8 * j + 6] * rstd * a1[2] + b1[2], v[8 * j + 7] * rstd * a1[3] + b1[3]);
        *(u32x4*)(orow + 512 * j + 8 * lane) = w; }
    if (qrow) {
        float hq[16]; float am = 0.f;
#pragma unroll
        for (int j = 0; j < 2; ++j) { const LAS float* a = MA + 512 * j + 8 * lane; const LAS float* b = MB + 512 * j + 8 * lane;
#pragma unroll
            for (int k = 0; k < 8; ++k) { hq[8 * j + k] = v[8 * j + k] * rstd * a[k] + b[k]; am = fmaxf(am, fabsf(hq[8 * j + k])); } }
#pragma unroll
        for (int o = 1; o < 64; o <<= 1) am = fmaxf(am, __shfl_xor(am, o));
        const float inv = am > 0.f ? 127.0f / am : 0.f;
        if (lane == 0) *qscale = am > 0.f ? am * (1.0f / 127.0f) : 1.0f;
#pragma unroll
        for (int j = 0; j < 2; ++j) { unsigned w2[2];
#pragma unroll
            for (int d = 0; d < 2; ++d) { int b4[4];
#pragma unroll
                for (int k = 0; k < 4; ++k) b4[k] = (int)fminf(fmaxf(__builtin_rintf(hq[8 * j + 4 * d + k] * inv), -127.0f), 127.0f);
                w2[d] = (unsigned)(b4[0] & 255) | ((unsigned)(b4[1] & 255) << 8) | ((unsigned)(b4[2] & 255) << 16) | ((unsigned)b4[3] << 24); }
            *(u32x2*)(qrow + 512 * j + 8 * lane) = (u32x2){w2[0], w2[1]}; } }
}
__device__ __forceinline__ void p1_h1(const Ctx& C0) {
    PHASE_IDS();
    LAS float* MA = (LAS float*)C.lds;
    LAS float* MB = MA + 2048;
    for (int idx = C.tid; idx < 2048; idx += 512) { const int b = idx >> 10, col = idx & 1023;
        const float sh = ada_val(C, b, col), sc = ada_val(C, b, 1024 + col);
        MA[idx] = C.in[5][col] * (1.0f + sc); MB[idx] = sh; }
    if (blockIdx.x < NE) { const int e = blockIdx.x; bf16_t* wrt = WSP(bf16_t, WS_WRT) + (size_t)e * 1024;
        for (int k = C.tid; k < 1024; k += 512) wrt[k] = (bf16_t)f2bf(C.in[16][(size_t)k * 32 + e]); }
    {
        const int per = (2 * 6144 + C.G - 1) / C.G;
        for (int i = C.tid; i < per; i += 512) { const int idx = blockIdx.x * per + i; if (idx < 2 * 6144) WSP(float, WS_ADAF)[idx] = ada_val(C, idx / 6144, idx % 6144); }
    }
    __syncthreads();
    const int gw = C.vcu * NWAVES + C.wave, NGW = C.G * NWAVES;
    for (int m0 = gw; m0 < M; m0 += NGW) { const int m = XROW(m0); const int b = m >= SEQ; rms_mod_row(C.in[0] + (size_t)m * D, WSP(bf16_t, WS_H) + (size_t)m * D, MA + b * 1024, MB + b * 1024, C.lane, (signed char*)(C.ws + WS_H2Q) + (size_t)m * D, WSP(float, WS_SA) + m); }
    __syncthreads();
}
__device__ __forceinline__ void p3a_kmean(const Ctx& C0) {
    PHASE_IDS();
    LAS float* red = (LAS float*)C.lds;
    const bf16_t* kb = WSP(const bf16_t, WS_PROJ + 2 * PROJ_STRIDE);
    for (int it = blockIdx.x; it < 64; it += C.G) { const int b = it >> 5, n = it & 31;
        float a[8];
#pragma unroll
        for (int j = 0; j < 8; ++j) a[j] = 0.f;
        const bf16_t* src = kb + (size_t)(b * SEQ + 256 * n + 32 * C.wave) * 1024 + 8 * C.lane;
#pragma unroll 8
        for (int r = 0; r < 32; ++r) { const u32x4 v = *(const u32x4*)(src + (size_t)r * 1024);
            a[0] += bf_lo(v.x); a[1] += bf_hi(v.x); a[2] += bf_lo(v.y); a[3] += bf_hi(v.y); a[4] += bf_lo(v.z); a[5] += bf_hi(v.z); a[6] += bf_lo(v.w); a[7] += bf_hi(v.w); }
        __syncthreads();
#pragma unroll
        for (int j = 0; j < 8; ++j) red[C.wave * 512 + 8 * C.lane + j] = a[j];
        __syncthreads();
        { const int col = C.tid; float s = 0.f;
#pragma unroll
            for (int w = 0; w < 8; ++w) s += red[w * 512 + col];
            const int h = col >> 6, d = col & 63; WSP(float, WS_KMEAN)[((b * 8 + h) * 32 + n) * 64 + d] = s * (1.0f / 256.0f); }
    }
    __syncthreads();
}
__device__ __forceinline__ void p3b_gate(const Ctx& C0) {
    PHASE_IDS();
    LAS float* km = (LAS float*)C.lds;
    const bf16_t* qb = WSP(const bf16_t, WS_PROJ + 1 * PROJ_STRIDE) + 512;
    unsigned* cnt = WSP(unsigned, WS_CTL) + CW_MCNT; unsigned* list = WSP(unsigned, WS_LIST);
    for (int it = blockIdx.x; it < 256; it += C.G) { const int bh = it >> 4, qc = it & 15, b = bh >> 3, h = bh & 7;
        __syncthreads();
        for (int i = C.tid; i < 2048; i += 512) km[i] = WSP(const float, WS_KMEAN)[bh * 2048 + i];
        __syncthreads();
        const int q = 512 * qc + C.tid, own = q >> 8;
        u32x4 qv[8];
        { const u32x4* qp = (const u32x4*)(qb + (size_t)(b * SEQ + q) * 1024 + h * 64);
#pragma unroll
            for (int j = 0; j < 8; ++j) qv[j] = qp[j]; }
        float v0 = -INFINITY, v1 = -INFINITY, v2 = -INFINITY; int i0 = 0, i1 = 0, i2 = 0;
        const int nmax = ((512 * qc + 511) >> 8);
        for (int n = 0; n < nmax; ++n) { const LAS f32x4* kr = (const LAS f32x4*)(km + n * 64); float s = 0.f;
#pragma unroll
            for (int j = 0; j < 8; ++j) { const f32x4 ka = kr[2 * j], kb2 = kr[2 * j + 1];
                s += bf_lo(qv[j].x) * ka[0] + bf_hi(qv[j].x) * ka[1] + bf_lo(qv[j].y) * ka[2] + bf_hi(qv[j].y) * ka[3]
                   + bf_lo(qv[j].z) * kb2[0] + bf_hi(qv[j].z) * kb2[1] + bf_lo(qv[j].w) * kb2[2] + bf_hi(qv[j].w) * kb2[3]; }
            if (n < own) {
                if (s > v0) { v2 = v1; i2 = i1; v1 = v0; i1 = i0; v0 = s; i0 = n; }
                else if (s > v1) { v2 = v1; i2 = i1; v1 = s; i1 = n; }
                else if (s > v2) { v2 = s; i2 = n; }
            } }
        const int nsel = own < 3 ? own : 3;
        LAS unsigned* lc = (LAS unsigned*)(C.lds + 8192);
        if (C.tid < 128) lc[C.tid] = 0u;
        __syncthreads();
        const int l0 = 2 * i0 + (i0 == own - 1 ? 1 : 0), l1 = 2 * i1 + (i1 == own - 1 ? 1 : 0), l2 = 2 * i2 + (i2 == own - 1 ? 1 : 0);
        unsigned lp0 = 0u, lp1 = 0u, lp2 = 0u;
        if (nsel > 0) lp0 = atomicAdd((unsigned*)(lc + l0), 1u);
        if (nsel > 1) lp1 = atomicAdd((unsigned*)(lc + l1), 1u);
        if (nsel > 2) lp2 = atomicAdd((unsigned*)(lc + l2), 1u);
        __syncthreads();
        if (C.tid < 64) { const unsigned c = lc[C.tid]; lc[64 + C.tid] = c ? atomicAdd(cnt + bh * 64 + C.tid, c) : 0u; }
        __syncthreads();
#pragma unroll
        for (int j = 0; j < 3; ++j) if (j < nsel) { const int n = j == 0 ? i0 : (j == 1 ? i1 : i2); const int l = j == 0 ? l0 : (j == 1 ? l1 : l2); const unsigned pos = lc[64 + l] + (j == 0 ? lp0 : (j == 1 ? lp1 : lp2));
            list[(size_t)bh * LIST_PER_BH + 256 * (31 * n - (n * (n - 1)) / 2) + ((l & 1) ? 0 : 256) + pos] = (unsigned)q | ((unsigned)j << 13); }
    }
    __syncthreads();
}
__device__ __forceinline__ void build_bias_tables(const Ctx& C) {
    LAS float* bt = (LAS float*)(C.lds + AT_BT);
    for (int idx = C.tid; idx < 12 * BT_STR; idx += 512) { const int hd = idx / BT_STR, n = idx % BT_STR;
        if (n >= 128) { bt[idx] = 0.f; continue; }
        int bk;
        if (n < 16) bk = n; else { const float nf = (float)n; int lg = 16 + (int)(logf(nf / 16.0f) / logf(8.0f) * 16.0f); bk = lg < 31 ? lg : 31; }
        bt[idx] = (C.in[2][bk * 12 + hd] - C.in[2][31 * 12 + hd]) * LOG2E; }
}
#if SIMPLE_DIFF
__device__ __forceinline__ void diff_unit(const Ctx& C, int b, int h, int qblk, float lam) {
    const int lane = C.lane, c = lane & 15, g = lane >> 4, wid = C.wave;
    const bf16_t* qka = WSP(const bf16_t, WS_PROJ);
    const bf16_t* va = WSP(const bf16_t, WS_PROJ + PROJ_STRIDE);
    const int q0 = qblk * 128, q = q0 + wid * 16 + c, NT = 2 * qblk + 2;
    const LAS float* bt = (const LAS float*)(C.lds + AT_BT) + h * 128;
    f32x4 o0[8];
    for (int map = 0; map < 2; ++map) {
        bf16x8 qf[2];
#pragma unroll
        for (int ks = 0; ks < 2; ++ks) qf[ks] = *(const bf16x8*)(qka + (size_t)(b * SEQ + q) * 1024 + h * 128 + map * 64 + 32 * ks + 8 * g);
        const bf16_t* kg = qka + (size_t)(b * SEQ) * 1024 + 512 + h * 128 + map * 64;
        const bf16_t* vg = va + (size_t)(b * SEQ) * 1024 + h * 128;
        float m_run = -1e30f, l_run = 0.f; f32x4 o[8];
#pragma unroll
        for (int dt = 0; dt < 8; ++dt) o[dt] = (f32x4){0.f, 0.f, 0.f, 0.f};
        TileRegs<2> tr; tile_fetch<2>(tr, kg, vg, C.tid);
        for (int t = 0; t < NT; ++t) {
            __syncthreads();
            tile_store<2>(tr, C.lds, C.tid);
            __syncthreads();
            if (t + 1 < NT) tile_fetch<2>(tr, kg + (size_t)(t + 1) * 64 * 1024, vg + (size_t)(t + 1) * 64 * 1024, C.tid);
            attn_tile<8>(C.lds, lane, qf, o, m_run, l_run, q, 64 * t, true, bt);
        }
        float lt = l_run; lt += __shfl_xor(lt, 16); lt += __shfl_xor(lt, 32);
        const float rl = 1.0f / lt;
#pragma unroll
        for (int i = 0; i < 4; ++i) { const float ri = __shfl(rl, 4 * g + i);
#pragma unroll
            for (int dt = 0; dt < 8; ++dt) { if (map == 0) o0[dt][i] = o[dt][i] * ri; else o0[dt][i] = o0[dt][i] - lam * (o[dt][i] * ri); } }
    }
    bf16_t* y = WSP(bf16_t, WS_Y);
#pragma unroll
    for (int i = 0; i < 4; ++i) { float ss = 0.f;
#pragma unroll
        for (int dt = 0; dt < 8; ++dt) ss += o0[dt][i] * o0[dt][i];
        ss += __shfl_xor(ss, 1); ss += __shfl_xor(ss, 2); ss += __shfl_xor(ss, 4); ss += __shfl_xor(ss, 8);
        const float rstd = 1.0f / sqrtf(ss * (1.0f / 128.0f) + RMS_EPS);
        bf16_t* yr = y + (size_t)(b * SEQ + q0 + wid * 16 + 4 * g + i) * 1024 + h * 128 + c;
#pragma unroll
        for (int dt = 0; dt < 8; ++dt) yr[16 * dt] = (bf16_t)f2bf(o0[dt][i] * rstd * C.in[11][16 * dt + c] * 0.8f); }
}
#endif
#if 0
__device__ __forceinline__ void moba_item(const Ctx& C, int b, int h, int n, bool own, int half, const unsigned* lst, int lcnt, int chunk) {
    const int lane = C.lane, c = lane & 15, g = lane >> 4, wid = C.wave;
    const bf16_t* qb = WSP(const bf16_t, WS_PROJ + PROJ_STRIDE) + 512;
    const bf16_t* kv = WSP(const bf16_t, WS_PROJ + 2 * PROJ_STRIDE);
    int qtok, jslot; bool valid;
    if (own) { qtok = 256 * n + 128 * half + wid * 16 + c; jslot = 3; valid = true; }
    else { const int idx = chunk * 128 + wid * 16 + c; valid = idx < lcnt; const unsigned e = lst[valid ? idx : 0]; qtok = (int)(e & 8191u); jslot = (int)(e >> 13); }
    bf16x8 qf[2];
#pragma unroll
    for (int ks = 0; ks < 2; ++ks) qf[ks] = *(const bf16x8*)(qb + (size_t)(b * SEQ + qtok) * 1024 + h * 64 + 32 * ks + 8 * g);
    const bf16_t* kg = kv + (size_t)(b * SEQ + 256 * n) * 1024 + h * 64;
    const bf16_t* vg = kg + 512;
    const LAS float* bt = (const LAS float*)(C.lds + AT_BT) + (4 + h) * 128;
    const int NT = own ? 2 * (half + 1) : 4;
    float m_run = -1e30f, l_run = 0.f; f32x4 o[4];
#pragma unroll
    for (int dt = 0; dt < 4; ++dt) o[dt] = (f32x4){0.f, 0.f, 0.f, 0.f};
    TileRegs<1> tr; tile_fetch<1>(tr, kg, vg, C.tid);
    for (int t = 0; t < NT; ++t) {
        __syncthreads();
        tile_store<1>(tr, C.lds, C.tid);
        __syncthreads();
        if (t + 1 < NT) tile_fetch<1>(tr, kg + (size_t)(t + 1) * 64 * 1024, vg + (size_t)(t + 1) * 64 * 1024, C.tid);
        attn_tile<4>(C.lds, lane, qf, o, m_run, l_run, qtok, 256 * n + 64 * t, own, bt);
    }
    float lt = l_run; lt += __shfl_xor(lt, 16); lt += __shfl_xor(lt, 32);
    const int slot = ((b * SEQ + qtok) * 8 + h) * 4 + jslot;
    if (g == 0 && valid) { f32x2 ml; ml[0] = m_run; ml[1] = lt; *(f32x2*)(WSP(float, WS_PML) + (size_t)slot * 2) = ml; }
    bf16_t* po = WSP(bf16_t, WS_PO);
#pragma unroll
    for (int i = 0; i < 4; ++i) { const int sl = __shfl(slot, 4 * g + i); const int vl = __shfl((int)valid, 4 * g + i);
        if (vl) {
#pragma unroll
            for (int dt = 0; dt < 4; ++dt) po[(size_t)sl * 64 + 16 * dt + c] = (bf16_t)f2bf(o[dt][i]); } }
}
#endif
constexpr int MB_BUF = 65536, MB_OST = LDSCTL_OFF + 14336;
struct MItem { int valid, b, h, n, own, half, near, lcnt, chunk, lbase; };
__device__ __forceinline__ MItem moba_decode(int it, int nitems, const LAS int* pre, const unsigned* cnt) {
    MItem m; m.valid = it < nitems ? 1 : 0; if (!m.valid) it = 0;
    if (it < 1024) { const int bh = it >> 6, r = it & 63; m.b = bh >> 3; m.h = bh & 7; m.n = r >> 1; m.own = 1; m.half = (r ^ (bh >> 2)) & 1; m.near = 0;
        m.lcnt = 128; m.chunk = 0; m.lbase = 0; }
    else { const int gi = it - 1024; int lo = 0, hi = 1023;
        while (lo < hi) { const int mid = (lo + hi + 1) >> 1; if (pre[mid] <= gi) lo = mid; else hi = mid - 1; }
        const int L = lo, bh = L >> 6, n = (L >> 1) & 31, near = L & 1;
        m.b = bh >> 3; m.h = bh & 7; m.n = n; m.own = 0; m.half = 0; m.near = near; m.lcnt = (int)__hip_atomic_load(cnt + L, RLX_AGENT); m.chunk = gi - pre[L];
        m.lbase = bh * LIST_PER_BH + 256 * (31 * n - (n * (n - 1)) / 2) + (near ? 0 : 256); }
    return m;
}
__device__ __forceinline__ unsigned moba_entry(const Ctx& C, const MItem& m) {
    const int c = C.lane & 15;
    if (m.own) return (unsigned)(256 * m.n + 128 * m.half + C.wave * 16 + c) | (3u << 13) | (1u << 15);
    const int idx = m.chunk * 128 + C.wave * 16 + c; const bool v = idx < m.lcnt;
    const unsigned e = WSP(const unsigned, WS_LIST)[(size_t)m.lbase + (v ? idx : 0)];
    return (e & 0x7fffu) | (v ? (1u << 15) : 0u);
}
__device__ __forceinline__ void moba_qload(const Ctx& C, const MItem& m, unsigned ent, bf16x8 (&qf)[2]) {
    const bf16_t* qb = WSP(const bf16_t, WS_PROJ + PROJ_STRIDE) + 512; const int g = C.lane >> 4;
#pragma unroll
    for (int ks = 0; ks < 2; ++ks) qf[ks] = *(const bf16x8*)(qb + (size_t)(m.b * SEQ + (int)(ent & 8191u)) * 1024 + m.h * 64 + 32 * ks + 8 * g);
}
__device__ __forceinline__ void moba_dma(const Ctx& C, const MItem& m, int bo) {
    const bf16_t* kg = WSP(const bf16_t, WS_PROJ + 2 * PROJ_STRIDE) + (size_t)(m.b * SEQ + 256 * m.n) * 1024 + m.h * 64;
    const int r8 = C.lane >> 3, sch = (C.lane & 7) ^ r8;
#pragma unroll
    for (int j = 0; j < 4; ++j) { const int p = C.wave * 4 + j; const bf16_t* src = kg + (size_t)(8 * p + r8) * 1024 + sch * 8;
        __builtin_amdgcn_global_load_lds((const unsigned*)src, (LAS unsigned*)(C.lds + bo + p * 1024), 16, 0, 0);
        __builtin_amdgcn_global_load_lds((const unsigned*)(src + 512), (LAS unsigned*)(C.lds + bo + 32768 + p * 1024), 16, 0, 0); }
}
constexpr int MB_STG = 2304;
__device__ __forceinline__ void moba_flush(const Ctx& C) {
    const LAS unsigned char* stg = C.lds + MB_OST + C.wave * MB_STG; const int lane = C.lane;
    const LAS int* sslot = (const LAS int*)(stg + 2176);
    bf16_t* po = WSP(bf16_t, WS_PO);
#pragma unroll
    for (int r = 0; r < 2; ++r) { const int row = (lane >> 3) + 8 * r, ch = lane & 7; const u32x4 v = *(const LAS u32x4*)(stg + row * 128 + ch * 16); const int sl = sslot[row];
        if (sl >= 0) *(u32x4*)(po + (size_t)sl * 64 + ch * 8) = v; }
    if (lane < 16) { const int sl = sslot[lane]; const f32x2 ml = *(const LAS f32x2*)(stg + 2048 + lane * 8); if (sl >= 0) *(f32x2*)(WSP(float, WS_PML) + (size_t)sl * 2) = ml; }
}
__device__ __forceinline__ void moba_compute(const Ctx& C, const MItem& m, unsigned ent, const bf16x8 (&qf)[2], int bo, int mode) {
    if (!(mode & 2)) return;
    const int lane = C.lane, c = lane & 15, g = lane >> 4, cx = c & 7;
    const int qtok = (int)(ent & 8191u), jslot = (int)((ent >> 13) & 3u), valid = (int)((ent >> 15) & 1u);
    const int nkt = m.own ? 8 * (m.half + 1) : 16;
    const LAS float* bt = (const LAS float*)(C.lds + AT_BT) + (4 + m.h) * BT_STR;
    const bool nearb = m.near && __any((qtok & 255) < 127);
    f32x4 s[16];
    const LAS unsigned char* kb = C.lds + bo + c * 128;
    const int kc0 = ((0 + g) ^ cx) << 4, kc1 = ((4 + g) ^ cx) << 4;
#define MB_BIAS(t4) do { if (m.own || (nearb && (t4) >= 2)) { const int kbase_ = 256 * m.n + 64 * (t4); \
            _Pragma("unroll") for (int k4 = 0; k4 < 4; ++k4) _Pragma("unroll") for (int i = 0; i < 4; ++i) { const int kt_ = 4 * (t4) + k4; const int dist = qtok - (kbase_ + 16 * k4 + 4 * g + i); \
                const unsigned di = (unsigned)dist < 128u ? (unsigned)dist : 128u; const float v = s[kt_][i] + bt[di]; s[kt_][i] = (m.own && dist < 0) ? -INFINITY : v; } } } while (0)
#pragma unroll
    for (int kt = 0; kt < 4; ++kt) { const bf16x8 a0 = *(const LAS bf16x8*)(kb + kt * 2048 + kc0), a1 = *(const LAS bf16x8*)(kb + kt * 2048 + kc1);
        f32x4 z = (f32x4){0.f, 0.f, 0.f, 0.f}; z = __builtin_amdgcn_mfma_f32_16x16x32_bf16(a0, qf[0], z, 0, 0, 0); s[kt] = __builtin_amdgcn_mfma_f32_16x16x32_bf16(a1, qf[1], z, 0, 0, 0); }
    MB_BIAS(0);
    float mx = fmaxf(fmaxf(s[0][0], s[0][1]), fmaxf(s[0][2], s[0][3]));
#pragma unroll
    for (int kt = 1; kt < 4; ++kt) mx = fmaxf(mx, fmaxf(fmaxf(s[kt][0], s[kt][1]), fmaxf(s[kt][2], s[kt][3])));
    mx = fmaxf(mx, __shfl_xor(mx, 16)); mx = fmaxf(mx, __shfl_xor(mx, 32));
    const f32x4 negm = (f32x4){-mx, -mx, -mx, -mx};
#pragma unroll
    for (int kt = 0; kt < 4; ++kt) s[kt] += negm;
#define MB_EXP4(t) do { s[t][0] = __builtin_amdgcn_exp2f(s[t][0]); s[t][1] = __builtin_amdgcn_exp2f(s[t][1]); s[t][2] = __builtin_amdgcn_exp2f(s[t][2]); s[t][3] = __builtin_amdgcn_exp2f(s[t][3]); } while (0)
#pragma unroll
    for (int kt = 4; kt < 16; ++kt) {
        if (kt < nkt) { const bf16x8 a0 = *(const LAS bf16x8*)(kb + kt * 2048 + kc0), a1 = *(const LAS bf16x8*)(kb + kt * 2048 + kc1);
            f32x4 z = __builtin_amdgcn_mfma_f32_16x16x32_bf16(a0, qf[0], negm, 0, 0, 0); s[kt] = __builtin_amdgcn_mfma_f32_16x16x32_bf16(a1, qf[1], z, 0, 0, 0); }
        else s[kt] = (f32x4){-INFINITY, -INFINITY, -INFINITY, -INFINITY};
        if (kt < 8) { MB_EXP4(kt - 4); asm volatile("" : "+v"(s[kt - 4])); }
        __builtin_amdgcn_sched_barrier(0);
    }
    if (4 < nkt) MB_BIAS(1);
    if (8 < nkt) { MB_BIAS(2); MB_BIAS(3); }
#undef MB_BIAS
    f32x4 o[4], osum = (f32x4){0.f, 0.f, 0.f, 0.f};
#pragma unroll
    for (int dt = 0; dt < 4; ++dt) o[dt] = (f32x4){0.f, 0.f, 0.f, 0.f};
    const short one = (c == 0) ? (short)0x3F80 : (short)0; const bf16x8 ones = (bf16x8){one, one, one, one, one, one, one, one};
    const int rv = 4 * g + (c >> 2), x7 = rv & 7, hb = (c & 3) >> 1;
    const LAS unsigned char* vb = C.lds + bo + 32768 + rv * 128 + 8 * (c & 1);
    int cv[4];
#pragma unroll
    for (int dt = 0; dt < 4; ++dt) cv[dt] = ((2 * dt + hb) ^ x7) << 4;
#pragma unroll
    for (int kk = 0; kk < 8; ++kk) {
        if (2 * kk < nkt) { u32x4 w; w.x = cvt_pk_bf16(s[2 * kk][0], s[2 * kk][1]); w.y = cvt_pk_bf16(s[2 * kk][2], s[2 * kk][3]);
            w.z = cvt_pk_bf16(s[2 * kk + 1][0], s[2 * kk + 1][1]); w.w = cvt_pk_bf16(s[2 * kk + 1][2], s[2 * kk + 1][3]); const bf16x8 pa = __builtin_bit_cast(bf16x8, w);
            osum = __builtin_amdgcn_mfma_f32_16x16x32_bf16(pa, ones, osum, 0, 0, 0);
#pragma unroll
            for (int dt = 0; dt < 4; ++dt) { const s16x4 lo = tr16(vb + (32 * kk) * 128 + cv[dt]), hi = tr16(vb + (32 * kk + 16) * 128 + cv[dt]);
                const bf16x8 bfr = (bf16x8){lo[0], lo[1], lo[2], lo[3], hi[0], hi[1], hi[2], hi[3]};
                o[dt] = __builtin_amdgcn_mfma_f32_16x16x32_bf16(pa, bfr, o[dt], 0, 0, 0); } }
        if (kk < 6 && 2 * kk + 4 < nkt) { MB_EXP4(2 * kk + 4); MB_EXP4(2 * kk + 5); asm volatile("" : "+v"(s[2 * kk + 4]), "+v"(s[2 * kk + 5])); }
        __builtin_amdgcn_sched_barrier(0);
    }
#undef MB_EXP4
    if (!(mode & 1)) return;
    LAS unsigned char* stg = C.lds + MB_OST + C.wave * MB_STG;
    LAS bf16_t* so = (LAS bf16_t*)stg;
#pragma unroll
    for (int i = 0; i < 4; ++i)
#pragma unroll
        for (int dt = 0; dt < 4; ++dt) so[(4 * g + i) * 64 + 16 * dt + c] = (bf16_t)f2bf(o[dt][i]);
    const int slot = valid ? ((m.b * SEQ + qtok) * 8 + m.h) * 4 + jslot : -1;
    if (g == 0) { ((LAS int*)(stg + 2176))[c] = slot; ((LAS float*)(stg + 2048))[2 * c] = mx; }
    if (c == 0) {
#pragma unroll
        for (int i = 0; i < 4; ++i) ((LAS float*)(stg + 2048))[2 * (4 * g + i) + 1] = osum[i]; }
}
__device__ __forceinline__ MItem moba_item_at(const LAS int* tab, int j) {
    MItem m; const int w0 = __builtin_amdgcn_readfirstlane(tab[4 * j]), w1 = __builtin_amdgcn_readfirstlane(tab[4 * j + 1]), w2 = __builtin_amdgcn_readfirstlane(tab[4 * j + 2]), w3 = __builtin_amdgcn_readfirstlane(tab[4 * j + 3]);
    m.valid = (j < 32 && w1 >= 0) ? 1 : 0; const int bh = w0 & 255; m.b = bh >> 3; m.h = bh & 7; m.n = (w0 >> 8) & 255; m.own = (w0 >> 16) & 1; m.half = (w0 >> 17) & 1; m.near = (w0 >> 18) & 1; m.lcnt = w1; m.chunk = w2; m.lbase = w3; return m;
}
__device__ __forceinline__ void moba_phase(const Ctx& C, const LAS int* pre, const unsigned* cnt, int mode) {
    const int nitems = 1024 + pre[1024]; const int G = C.G;
    LAS int* tab = (LAS int*)(C.lds + LDSCTL_OFF + 7424);
    if (C.tid < 33) { MItem m = moba_decode(C.vcu + C.tid * G, nitems, pre, cnt); if (C.tid == 32) m.valid = 0;
        tab[4 * C.tid] = (m.b * 8 + m.h) | (m.n << 8) | (m.own << 16) | (m.half << 17) | (m.near << 18); tab[4 * C.tid + 1] = m.valid ? m.lcnt : -1; tab[4 * C.tid + 2] = m.chunk; tab[4 * C.tid + 3] = m.lbase; }
    __syncthreads();
    int j = 0;
    MItem m0 = moba_item_at(tab, 0), m1 = moba_item_at(tab, 1);
    unsigned e0 = 0u, e1 = 0u; bf16x8 qf0[2];
    qf0[0] = (bf16x8){0, 0, 0, 0, 0, 0, 0, 0}; qf0[1] = qf0[0];
    if (m0.valid) { e0 = moba_entry(C, m0); moba_qload(C, m0, e0, qf0); moba_dma(C, m0, 0); }
    if (m1.valid) e1 = moba_entry(C, m1);
    int bo = 0; bool pending = false;
    while (m0.valid) {
        VM_WAIT(); __syncthreads();
        if (pending) moba_flush(C);
        bf16x8 qf1[2]; qf1[0] = qf0[0]; qf1[1] = qf0[1];
        if (m1.valid) moba_qload(C, m1, e1, qf1);
        const MItem m2 = moba_item_at(tab, j + 2 < 32 ? j + 2 : 32);
        unsigned e2 = 0u; if (m2.valid) e2 = moba_entry(C, m2);
        if (m1.valid) moba_dma(C, m1, bo ^ MB_BUF);
        moba_compute(C, m0, e0, qf0, bo, mode); pending = (mode & 3) == 3;
        m0 = m1; m1 = m2; e0 = e1; e1 = e2; qf0[0] = qf1[0]; qf0[1] = qf1[1]; bo ^= MB_BUF; ++j;
    }
    if (pending) { LDS_WAIT(); moba_flush(C); }
    VM_WAIT(); __syncthreads();
}
#ifndef PROBE_SUB
#define PROBE_SUB 3
#endif
__device__ __forceinline__ void p4_attention(const Ctx& C0, int sub, bool gate) {
    if (gate) { p3b_gate(C0);
        asm volatile("s_waitcnt vmcnt(0)" ::: "memory"); __syncthreads();
        if (threadIdx.x == 0) { __builtin_amdgcn_fence(__ATOMIC_RELEASE, "agent"); asm volatile("s_waitcnt vmcnt(0)" ::: "memory"); xb_add((unsigned*)(C0.ws + WS_CTL) + CW_GDONE, 1u); } }
    PHASE_IDS();
    __syncthreads();
    build_bias_tables(C);
    float lam;
    { const float a = wave_sum(C.in[7][C.lane] * C.in[8][C.lane]), b2 = wave_sum(C.in[9][C.lane] * C.in[10][C.lane]); lam = expf(a) - expf(b2) + 0.2f; }
    __syncthreads();
#if SIMPLE_DIFF
    if (sub & 1) for (int p = blockIdx.x; p < 256; p += C.G) { const int bh = p >> 5, qa = p & 31;
        diff_unit(C, bh >> 2, bh & 3, qa, lam); diff_unit(C, bh >> 2, bh & 3, 63 - qa, lam); }
#else
#if NATIVE_DIFF
    {
        const int grp = blockIdx.x & 7, rank = blockIdx.x >> 3;
        if ((sub & 1) && rank < NCONV) { LAS float* scr = (LAS float*)(C.lds + C.wave * 8448);
            const int wi = (rank * 8 + grp) * NWAVES + C.wave, nw = NCONV * 8 * NWAVES;
            conv_q_blocks<0>(C.in[18], C.ws, C.lds, C.wave, rank * 8 + grp, NCONV * 8);
            conv_range(C, NE * 16 * 64, CONV_MOE_ITEMS, wi, nw, scr); }
        unsigned* qctr = WSP(unsigned, WS_CTL) + CW_AQ + 64 * grp;
        LAS int* qslot = (LAS int*)(C.lds + LDSCTL_OFF + 512);
        const attn_nat::bf16* qk = (const attn_nat::bf16*)WSP(const bf16_t, WS_PROJ); const attn_nat::bf16* vv = (const attn_nat::bf16*)WSP(const bf16_t, WS_PROJ + PROJ_STRIDE);
        attn_nat::bf16* oa = (attn_nat::bf16*)WSP(bf16_t, WS_OA);
        if (sub & 1) for (;;) {
            __syncthreads();
            if (C.tid == 0) *qslot = (int)atomicAdd(qctr, 1u);
            __syncthreads();
            const int j = __builtin_amdgcn_readfirstlane(*qslot);
            if (j >= 64) break;
            const int qb = 31 - (j >> 1), st = grp + 8 * (j & 1), b = st >> 3, h = (st >> 1) & 3, mp = st & 1;
            const LAS float* bth = (const LAS float*)(C.lds + AT_BT) + h * BT_STR;
            attn_nat::attn_unit<8>(b, qb, qk, qk, vv, oa, h * 128 + mp * 64, 512 + h * 128 + mp * 64, h * 128, mp * 512 + h * 128, bth, C.ldsg); }
    }
#else
    if (sub & 1) for (int v = C.vcu; v < 256; v += C.G) { const int bvh = v >> 3, s = v & 7, b = bvh >> 4, vh = bvh & 15, h = vh >> 2, mp = (vh >> 1) & 1, vhf = vh & 1;
        const attn_body::bf16* qk = (const attn_body::bf16*)WSP(const bf16_t, WS_PROJ); const attn_body::bf16* vv = (const attn_body::bf16*)WSP(const bf16_t, WS_PROJ + PROJ_STRIDE);
        attn_body::bf16* oa = (attn_body::bf16*)WSP(bf16_t, WS_OA);
        const LAS float* bth = (const LAS float*)(C.lds + AT_BT) + h * BT_STR;
#pragma unroll 1
        for (int i = 0; i < 4; ++i) { const int qb = (i == 0) ? s : (i == 1) ? 15 - s : (i == 2) ? 16 + s : 31 - s;
            attn_body::attn_unit<8>(b, qb, qk, qk, vv, oa, h * 128 + mp * 64, 512 + h * 128 + mp * 64, h * 128 + vhf * 64, mp * 512 + h * 128 + vhf * 64, bth, C.ldsg); } }
#endif
#endif
    LAS int* pre = (LAS int*)(C.lds + AT_MISC);
    LAS int* wtot = pre + 1032;
    const unsigned* cnt = WSP(const unsigned, WS_CTL) + CW_MCNT;
    if (gate && C.tid == 0) { unsigned* gd = WSP(unsigned, WS_CTL) + CW_GDONE; unsigned* tmo = WSP(unsigned, WS_CTL) + CW_TMO; unsigned sp = 0u;
        while (xb_ld(gd) < (unsigned)C.G) { __builtin_amdgcn_s_sleep(2); if ((++sp & 255u) == 0u) { if (xb_ld(tmo)) break; if (sp > XB_SPIN_CAP) { atomicAdd(tmo, 1u); break; } } }
        __builtin_amdgcn_fence(__ATOMIC_ACQUIRE, "agent"); asm volatile("s_waitcnt vmcnt(0)" ::: "memory"); }
    __syncthreads();
    { const int L = 2 * C.tid; const int n0_ = ((int)__hip_atomic_load(cnt + L, RLX_AGENT) + 127) >> 7, n1_ = ((int)__hip_atomic_load(cnt + L + 1, RLX_AGENT) + 127) >> 7; const int nch = n0_ + n1_;
        int inc = nch;
#pragma unroll
        for (int o = 1; o < 64; o <<= 1) { const int t = __shfl_up(inc, o); if (C.lane >= o) inc += t; }
        if (C.lane == 63) wtot[C.wave] = inc;
        __syncthreads();
        int base = 0;
        for (int w = 0; w < C.wave; ++w) base += wtot[w];
        pre[L] = base + inc - nch; pre[L + 1] = base + inc - nch + n0_;
        if (C.tid == 511) pre[1024] = base + inc;
    }
    __syncthreads();
    if (sub & 2) moba_phase(C, pre, cnt, sub >> 2);
    __syncthreads();
}
__device__ __forceinline__ void p5_ycombine(const Ctx& C0) {
    PHASE_IDS();
    const int gw = C.vcu * NWAVES + C.wave, NGW = C.G * NWAVES;
    const bf16_t* po = WSP(const bf16_t, WS_PO); const float* pml = WSP(const float, WS_PML); bf16_t* y = WSP(bf16_t, WS_Y);
#if !SIMPLE_DIFF
    {
        const float lam = expf(wave_sum(C.in[7][C.lane] * C.in[8][C.lane])) - expf(wave_sum(C.in[9][C.lane] * C.in[10][C.lane])) + 0.2f;
        const bf16_t* oa = WSP(const bf16_t, WS_OA);
        const f32x4 g0 = *(const f32x4*)(C.in[11] + 8 * (C.lane & 15)), g1 = *(const f32x4*)(C.in[11] + 8 * (C.lane & 15) + 4);
        for (int m0 = gw; m0 < M; m0 += NGW) { const int m = XROW(m0); const u32x4 a = *(const u32x4*)(oa + (size_t)m * 1024 + 8 * C.lane), b2 = *(const u32x4*)(oa + (size_t)m * 1024 + 512 + 8 * C.lane);
            float v[8];
            v[0] = bf_lo(a.x) - lam * bf_lo(b2.x); v[1] = bf_hi(a.x) - lam * bf_hi(b2.x); v[2] = bf_lo(a.y) - lam * bf_lo(b2.y); v[3] = bf_hi(a.y) - lam * bf_hi(b2.y);
            v[4] = bf_lo(a.z) - lam * bf_lo(b2.z); v[5] = bf_hi(a.z) - lam * bf_hi(b2.z); v[6] = bf_lo(a.w) - lam * bf_lo(b2.w); v[7] = bf_hi(a.w) - lam * bf_hi(b2.w);
            float ss = 0.f;
#pragma unroll
            for (int k = 0; k < 8; ++k) ss += v[k] * v[k];
            ss += __shfl_xor(ss, 1); ss += __shfl_xor(ss, 2); ss += __shfl_xor(ss, 4); ss += __shfl_xor(ss, 8);
            const float r = 0.8f / sqrtf(ss * (1.0f / 128.0f) + RMS_EPS);
            u32x4 w; w.x = pk2(v[0] * r * g0[0], v[1] * r * g0[1]); w.y = pk2(v[2] * r * g0[2], v[3] * r * g0[3]); w.z = pk2(v[4] * r * g1[0], v[5] * r * g1[1]); w.w = pk2(v[6] * r * g1[2], v[7] * r * g1[3]);
            *(u32x4*)(y + (size_t)m * 1024 + 8 * C.lane) = w; }
    }
#endif
    for (int m0 = gw; m0 < M; m0 += NGW) { const int m = XROW(m0); const int h = C.lane >> 3, dch = C.lane & 7; const int own = (m & (SEQ - 1)) >> 8, nsel = own < 3 ? own : 3;
        const size_t s0 = ((size_t)m * 8 + h) * 4;
        float mm[4], ll[4]; u32x4 ov[4];
#pragma unroll
        for (int j = 0; j < 4; ++j) { const bool use = (j == 3) || (j < nsel);
            if (use) { const f32x2 ml = *(const f32x2*)(pml + (s0 + j) * 2); mm[j] = ml[0]; ll[j] = ml[1]; ov[j] = *(const u32x4*)(po + (s0 + j) * 64 + 8 * dch); }
            else { mm[j] = -INFINITY; ll[j] = 0.f; ov[j] = (u32x4){0u, 0u, 0u, 0u}; } }
        const float mx = fmaxf(fmaxf(mm[0], mm[1]), fmaxf(mm[2], mm[3]));
        float den = 0.f; float acc[8];
#pragma unroll
        for (int k = 0; k < 8; ++k) acc[k] = 0.f;
#pragma unroll
        for (int j = 0; j < 4; ++j) { const float w = __builtin_amdgcn_exp2f(mm[j] - mx); den += w * ll[j];
            acc[0] += w * bf_lo(ov[j].x); acc[1] += w * bf_hi(ov[j].x); acc[2] += w * bf_lo(ov[j].y); acc[3] += w * bf_hi(ov[j].y);
            acc[4] += w * bf_lo(ov[j].z); acc[5] += w * bf_hi(ov[j].z); acc[6] += w * bf_lo(ov[j].w); acc[7] += w * bf_hi(ov[j].w); }
        const float r = 1.0f / den;
        u32x4 w; w.x = pk2(acc[0] * r, acc[1] * r); w.y = pk2(acc[2] * r, acc[3] * r); w.z = pk2(acc[4] * r, acc[5] * r); w.w = pk2(acc[6] * r, acc[7] * r);
        *(u32x4*)(y + (size_t)m * 1024 + 512 + h * 64 + 8 * dch) = w; }
}
__device__ __forceinline__ void p8_router(const Ctx& C0) {
    PHASE_IDS();
    LAS float* MA = (LAS float*)(C.lds + LDSCTL_OFF + 2048); LAS float* MB = MA + 2048;
    LAS int* hist = (LAS int*)(C.lds + LDSCTL_OFF + 2048 + 16384);
    LAS float* xch = (LAS float*)(C.lds + LDSCTL_OFF + 2048 + 16384 + 256);
    for (int idx = C.tid; idx < 2048; idx += 512) { const int b = idx >> 10, col = idx & 1023; const float* af = WSP(const float, WS_ADAF) + b * 6144;
        MA[idx] = C.in[15][col] * (1.0f + af[4096 + col]); MB[idx] = af[3072 + col]; }
    if (C.tid < 32) hist[C.tid] = 0;
    __syncthreads();
    for (int blk = (C.G == 256 ? C.vcu : (int)blockIdx.x); blk < M / 64; blk += C.G) {
        const int r0 = 64 * blk, b = r0 >= SEQ;
        {
            u32x4 xr[8][2];
#pragma unroll
            for (int r = 0; r < 8; ++r)
#pragma unroll
                for (int j = 0; j < 2; ++j) xr[r][j] = *(const u32x4*)(WSP(const bf16_t, WS_X1) + (size_t)(r0 + 8 * C.wave + r) * D + 512 * j + 8 * C.lane);
#pragma unroll
            for (int r = 0; r < 8; ++r) { const int lr = 8 * C.wave + r, m = r0 + lr; const LAS float* ma = MA + b * 1024; const LAS float* mb = MB + b * 1024;
                float v[16]; float s = 0.f;
#pragma unroll
                for (int j = 0; j < 2; ++j) { const u32x4 w = xr[r][j];
                    v[8 * j + 0] = bf_lo(w.x); v[8 * j + 1] = bf_hi(w.x); v[8 * j + 2] = bf_lo(w.y); v[8 * j + 3] = bf_hi(w.y); v[8 * j + 4] = bf_lo(w.z); v[8 * j + 5] = bf_hi(w.z); v[8 * j + 6] = bf_lo(w.w); v[8 * j + 7] = bf_hi(w.w); }
#pragma unroll
                for (int k = 0; k < 16; ++k) s += v[k] * v[k];
                const float rstd = 1.0f / sqrtf(wave_sum(s) * (1.0f / D) + RMS_EPS);
                float am = 0.f;
#pragma unroll
                for (int j = 0; j < 2; ++j) { const LAS float* a = ma + 512 * j + 8 * C.lane; const LAS float* bb = mb + 512 * j + 8 * C.lane;
                    const f32x4 a0 = *(const LAS f32x4*)a, a1 = *(const LAS f32x4*)(a + 4), b0 = *(const LAS f32x4*)bb, b1 = *(const LAS f32x4*)(bb + 4);
#pragma unroll
                    for (int k = 0; k < 4; ++k) { v[8 * j + k] = v[8 * j + k] * rstd * a0[k] + b0[k]; v[8 * j + 4 + k] = v[8 * j + 4 + k] * rstd * a1[k] + b1[k]; }
#pragma unroll
                    for (int k = 0; k < 8; ++k) am = fmaxf(am, fabsf(v[8 * j + k]));
                    u32x4 w; w.x = pk2(v[8 * j + 0], v[8 * j + 1]); w.y = pk2(v[8 * j + 2], v[8 * j + 3]); w.z = pk2(v[8 * j + 4], v[8 * j + 5]); w.w = pk2(v[8 * j + 6], v[8 * j + 7]);
                    *(LAS u32x4*)(C.lds + lr * 2048 + (((64 * j + C.lane) ^ (lr & 15)) << 4)) = w; }
#pragma unroll
                for (int o = 1; o < 64; o <<= 1) am = fmaxf(am, __shfl_xor(am, o));
                const float inv = am > 0.f ? 127.0f / am : 0.f;
                if (C.lane == 0) WSP(float, WS_SA)[m] = am > 0.f ? am * (1.0f / 127.0f) : 1.0f;
                signed char* qrow = (signed char*)(C.ws + WS_H2Q) + (size_t)m * D;
#pragma unroll
                for (int j = 0; j < 2; ++j) { unsigned w2[2];
#pragma unroll
                    for (int d = 0; d < 2; ++d) { int b4[4];
#pragma unroll
                        for (int k = 0; k < 4; ++k) b4[k] = (int)fminf(fmaxf(__builtin_rintf(v[8 * j + 4 * d + k] * inv), -127.0f), 127.0f);
                        w2[d] = (unsigned)(b4[0] & 255) | ((unsigned)(b4[1] & 255) << 8) | ((unsigned)(b4[2] & 255) << 16) | ((unsigned)b4[3] << 24); }
                    *(u32x2*)(qrow + 512 * j + 8 * C.lane) = (u32x2){w2[0], w2[1]}; } }
        }
        __syncthreads();
        const int lane = C.lane, c = lane & 15, g = lane >> 4, rq = C.wave & 3, kh = C.wave >> 2; const int rb = r0 + 16 * rq;
        f32x4 lg[2]; lg[0] = (f32x4){0.f, 0.f, 0.f, 0.f}; lg[1] = lg[0];
        { const bf16_t* wt = WSP(const bf16_t, WS_WRT) + (size_t)c * 1024 + 8 * g + 512 * kh; const LAS unsigned char* arow = C.lds + (16 * rq + c) * 2048;
#pragma unroll 8
            for (int ks = 0; ks < 16; ++ks) { const bf16x8 a = *(const LAS bf16x8*)(arow + ((((64 * kh + 4 * ks + g)) ^ c) << 4));
#pragma unroll
                for (int nt = 0; nt < 2; ++nt) { const bf16x8 w = *(const bf16x8*)(wt + (size_t)nt * 16 * 1024 + 32 * ks);
                    lg[nt] = __builtin_amdgcn_mfma_f32_16x16x32_bf16(a, w, lg[nt], 0, 0, 0); } } }
        if (kh == 1) { *(LAS f32x4*)(xch + (rq * 64 + lane) * 8) = lg[0]; *(LAS f32x4*)(xch + (rq * 64 + lane) * 8 + 4) = lg[1]; }
        __syncthreads();
        if (kh == 0) { lg[0] += *(const LAS f32x4*)(xch + (rq * 64 + lane) * 8); lg[1] += *(const LAS f32x4*)(xch + (rq * 64 + lane) * 8 + 4);
            const float br0 = C.in[17][c], br1 = C.in[17][16 + c];
#pragma unroll
            for (int i = 0; i < 4; ++i) { float a0 = lg[0][i] + br0, a1 = lg[1][i] + br1; float tv[4]; int ti[4];
#pragma unroll
                for (int k = 0; k < 4; ++k) { float bv; int bi; if (a1 > a0) { bv = a1; bi = 16 + c; } else { bv = a0; bi = c; }
#pragma unroll
                    for (int o = 1; o < 16; o <<= 1) { const float ov = __shfl_xor(bv, o); const int oi = __shfl_xor(bi, o); if (ov > bv || (ov == bv && oi < bi)) { bv = ov; bi = oi; } }
                    tv[k] = bv; ti[k] = bi; if (bi == c) a0 = -INFINITY; if (bi == 16 + c) a1 = -INFINITY; }
                if (c == 0) { const int row = rb + 4 * g + i; const float e1 = __expf(tv[1] - tv[0]), e2 = __expf(tv[2] - tv[0]), e3 = __expf(tv[3] - tv[0]); const float inv = 1.0f / (1.0f + e1 + e2 + e3);
                    *(int4*)(WSP(int, WS_TOPI) + (size_t)row * 4) = make_int4(ti[0], ti[1], ti[2], ti[3]);
                    *(f32x4*)(WSP(float, WS_TOPW) + (size_t)row * 4) = (f32x4){inv, e1 * inv, e2 * inv, e3 * inv};
                    atomicAdd((int*)(hist + ti[0]), 1); atomicAdd((int*)(hist + ti[1]), 1); atomicAdd((int*)(hist + ti[2]), 1); atomicAdd((int*)(hist + ti[3]), 1); } }
        }
        __syncthreads();
        if (C.tid < 32) { WSP(int, WS_HIST)[blk * 32 + C.tid] = hist[C.tid]; hist[C.tid] = 0; }
        __syncthreads();
    }
}
__device__ __forceinline__ void p9_slots(const Ctx& C0) {
    PHASE_IDS();
    LAS int* tot = (LAS int*)C.lds;
    LAS int* off = tot + 32;
    LAS int* cur = off + 40;
    const int* hist = WSP(const int, WS_HIST);
    for (int blk = blockIdx.x; blk < M / 64; blk += C.G) {
        __syncthreads();
        if (C.tid < 32) { int t = 0, p = 0; for (int w = 0; w < M / 64; ++w) { const int v = hist[w * 32 + C.tid]; t += v; p += (w < blk) ? v : 0; } tot[C.tid] = t; cur[C.tid] = p; }
        __syncthreads();
        if (C.tid == 0) { int o = 0; for (int e = 0; e < 32; ++e) { off[e] = o; o += (tot[e] + 255) & ~255; } off[32] = o; }
        __syncthreads();
        if (C.tid < 32) cur[C.tid] += off[C.tid];
        __syncthreads();
        if (C.tid < 256) { const int token = 64 * blk + (C.tid >> 2), k = C.tid & 3; const int e = WSP(const int, WS_TOPI)[token * 4 + k];
            const int slot = atomicAdd((int*)(cur + e), 1);
            WSP(int, WS_SLOTTOK)[slot] = token; WSP(float, WS_SLOTW)[slot] = WSP(const float, WS_TOPW)[token * 4 + k]; WSP(int, WS_TOKSLOT)[token * 4 + k] = slot; WSP(float, WS_SLOTSA)[slot] = WSP(const float, WS_SA)[token]; }
        if (blk < 32) { const int e = blk; for (int s = off[e] + tot[e] + C.tid; s < off[e + 1]; s += 512) { WSP(int, WS_SLOTTOK)[s] = 0; WSP(float, WS_SLOTW)[s] = 0.f; WSP(float, WS_SLOTSA)[s] = 0.f; } }
        if (blk == 0 && C.tid < 33) WSP(int, WS_EOFF)[C.tid] = off[C.tid];
    }
    __syncthreads();
}
__device__ __forceinline__ void p12_final(const Ctx& C0) {
    PHASE_IDS();
    const int gw = C.vcu * NWAVES + C.wave, NGW = C.G * NWAVES;
    const bf16_t* so = WSP(const bf16_t, WS_SOUT); const bf16_t* x1 = WSP(const bf16_t, WS_X1); const int* ts = WSP(const int, WS_TOKSLOT);
    for (int m = gw; m < M; m += NGW) { const float* gt = WSP(const float, WS_ADAF) + (m >= SEQ ? 6144 : 0) + 5120;
        const int4 sl = *(const int4*)(ts + (size_t)m * 4);
        f32x4 v[4]; float s = 0.f;
#pragma unroll
        for (int j = 0; j < 4; ++j) { const int col = 4 * C.lane + 256 * j; f32x4 a = (f32x4){0.f, 0.f, 0.f, 0.f};
            { const u32x2 w = *(const u32x2*)(so + (size_t)sl.x * 1024 + col); a[0] += bf_lo(w.x); a[1] += bf_hi(w.x); a[2] += bf_lo(w.y); a[3] += bf_hi(w.y); }
            { const u32x2 w = *(const u32x2*)(so + (size_t)sl.y * 1024 + col); a[0] += bf_lo(w.x); a[1] += bf_hi(w.x); a[2] += bf_lo(w.y); a[3] += bf_hi(w.y); }
            { const u32x2 w = *(const u32x2*)(so + (size_t)sl.z * 1024 + col); a[0] += bf_lo(w.x); a[1] += bf_hi(w.x); a[2] += bf_lo(w.y); a[3] += bf_hi(w.y); }
            { const u32x2 w = *(const u32x2*)(so + (size_t)sl.w * 1024 + col); a[0] += bf_lo(w.x); a[1] += bf_hi(w.x); a[2] += bf_lo(w.y); a[3] += bf_hi(w.y); }
            { const u32x2 xw = *(const u32x2*)(x1 + (size_t)m * D + col); const f32x4 xv = (f32x4){bf_lo(xw.x), bf_hi(xw.x), bf_lo(xw.y), bf_hi(xw.y)}; v[j] = xv + *(const f32x4*)(gt + col) * a; }
            s += (v[j][0] * v[j][0] + v[j][1] * v[j][1]) + (v[j][2] * v[j][2] + v[j][3] * v[j][3]); }
        const float rstd = 1.0f / sqrtf(wave_sum(s) * (1.0f / D) + RMS_EPS);
#pragma unroll
        for (int j = 0; j < 4; ++j) { const int col = 4 * C.lane + 256 * j; *(f32x4*)(C.out + (size_t)m * D + col) = v[j] * rstd * *(const f32x4*)(C.in[22] + col); } }
}

constexpr int CW_GRP = 118000;
__device__ __forceinline__ void grp_barrier(const XcdBarrier& b, unsigned* gwd, unsigned n, volatile LAS unsigned* mode) {
    asm volatile("s_waitcnt vmcnt(0)" ::: "memory");
    __syncthreads();
    if (threadIdx.x == 0) {
        __builtin_amdgcn_s_waitcnt(0);
        unsigned md = mode[0];
        if (md == 0u) { md = (xb_ld(gwd + 128) + xb_ld(gwd + 192) == 17u) ? 1u : 2u; mode[0] = md; }
        if (md != 1u) { __builtin_amdgcn_fence(__ATOMIC_RELEASE, "agent"); asm volatile("s_waitcnt vmcnt(0)" ::: "memory"); }
        const unsigned old = xb_add(gwd, 1u); const unsigned gen = old / n;
        if (old + 1u == (gen + 1u) * n) xb_add(gwd + 64, 1u);
        else XB_SPIN(xb_ld(gwd + 64) == gen, b.bar);
        __builtin_amdgcn_fence(__ATOMIC_ACQUIRE, "agent");
        asm volatile("s_waitcnt vmcnt(0)" ::: "memory");
    }
    __syncthreads();
}
struct Args { const float* in[23]; float* out; unsigned char* ws; int ph_lo, ph_hi, li, pad; };
constexpr int N_PHASES = 13;
#ifndef MK_N_LAUNCHES
#define MK_N_LAUNCHES 1
#endif

__global__ void __launch_bounds__(NWAVES * 64, 2) mega_fwd(Args args) {
    extern __shared__ __attribute__((aligned(16))) unsigned char lds_raw[];
    Ctx C;
    C.lds = (LAS unsigned char*)lds_raw; C.ldsg = (char*)lds_raw;
    C.tid = threadIdx.x; C.lane = C.tid & 63; C.wave = __builtin_amdgcn_readfirstlane(C.tid >> 6);
    C.G = gridDim.x; { const int bx = blockIdx.x; C.vcu = (C.G % 8 == 0) ? (bx % 8) * (C.G / 8) + bx / 8 : bx; }
#pragma unroll
    for (int i = 0; i < 23; ++i) C.in[i] = args.in[i];
    C.out = args.out; C.ws = args.ws;
    volatile LAS unsigned* MISC = (volatile LAS unsigned*)(C.lds + MISC_OFF);
    for (int u = C.tid; u < (LDS_BYTES - LDSCTL_OFF) / 4; u += NWAVES * 64) ((LAS unsigned*)(C.lds + LDSCTL_OFF))[u] = 0u;
    __syncthreads();
    unsigned* ctl = (unsigned*)(C.ws + WS_CTL);
    XcdBarrier bar = xcd_barrier_post(ctl + CW_BAR + args.li * XCD_BAR_WORDS, MISC + 8);
    unsigned* gwd = ctl + CW_GRP + 256 * ((int)blockIdx.x & 7);
    if (threadIdx.x == 0) { const unsigned xc = xb_xcc_id(); __hip_atomic_fetch_max(gwd + 128, xc + 1u, __ATOMIC_RELAXED, __HIP_MEMORY_SCOPE_AGENT); __hip_atomic_fetch_max(gwd + 192, 16u - xc, __ATOMIC_RELAXED, __HIP_MEMORY_SCOPE_AGENT); }
    const bool gloc = (C.G == 256) && (MK_N_LAUNCHES == 1);
    const int lo = args.ph_lo, hi = args.ph_hi;
#define IN(k) (lo <= (k) && (k) < hi)
#define SEAM(k) do { if (IN(k) && IN((k) + 1)) xcd_barrier(bar); } while (0)
#define SEAMG(k) do { if (gloc) grp_barrier(bar, gwd, 32u, MISC + 12); else xcd_barrier(bar); } while (0)
#ifndef PROBE_REP
#define PROBE_REP -1
#endif
#define REPS(k) (((k) == PROBE_REP) ? 2 : 1)
#define DUP(k, ...) do { __VA_ARGS__; if (REPS(k) == 2) { __VA_ARGS__; } } while (0)

    if (IN(0)) { DUP(0, p0_prologue(C)); } SEAM(0);
    if (IN(1)) { DUP(30, p1_h1(C)); } SEAMG(1);
    if (IN(2)) {
        { pg8::DenseSched S; S.init(M, 1024, C.G, (int)blockIdx.x, WSP(bf16_t, WS_WIN), 1024); S.pn_base = 6; pg8::EpiProj E{WSP(bf16_t, WS_PROJ), WSP(float, WS_KMEAN)};
          DUP(2, pg8::gemm_phase<pg8::EpiProj, pg8::DenseSched, true>(C.lds, WSP(bf16_t, WS_H), 1024, 1024, 1024, S, E)); }
        { pg8::DenseSched S; S.init(M, INW - 1024, C.G, (int)blockIdx.x, C.ws + WS_WINQ, 512); S.pn_skip_at = 6; S.pn_skip = 4; pg8::EpiProjQ E{WSP(bf16_t, WS_PROJ), WSP(const float, WS_SA), WSP(const float, WS_SWIN)};
          DUP(2, pg8::gemm_phase<pg8::EpiProjQ, pg8::DenseSched, true, true>(C.lds, C.ws + WS_H2Q, 512, 512, 512, S, E)); }
    } if (IN(2) && IN(5)) xcd_barrier(bar);
    if (IN(5)) { p4_attention(C, 3 | (3 << 2), true); if (REPS(5) == 2) p4_attention(C, PROBE_SUB, false); } SEAM(5);
    if (IN(6)) { DUP(30, p5_ycombine(C)); } SEAMG(6);
    if (IN(7)) { pg8::DenseSched S; S.init(M, D, C.G, (int)blockIdx.x, WSP(bf16_t, WS_WBR), 1024); pg8::EpiBr E{WSP(const bf16_t, WS_PROJ + 3 * PROJ_STRIDE), WSP(const bf16_t, WS_PROJ + 4 * PROJ_STRIDE), WSP(bf16_t, WS_MERGED)};
        DUP(31, pg8::gemm_phase<pg8::EpiBr, pg8::DenseSched, true>(C.lds, WSP(bf16_t, WS_Y), 1024, 1024, 1024, S, E)); } SEAMG(7);
    if (IN(9)) { pg8::DenseSched S; S.init(M, D, C.G, (int)blockIdx.x, WSP(bf16_t, WS_WOUT), 1024); pg8::EpiOut E{C.in[0], WSP(const float, WS_ADAF), WSP(bf16_t, WS_X1)};
        DUP(32, pg8::gemm_phase<pg8::EpiOut, pg8::DenseSched, true>(C.lds, WSP(bf16_t, WS_MERGED), 1024, 1024, 1024, S, E)); } SEAMG(9);
    if (IN(10)) { DUP(30, p8_router(C)); } SEAM(10);
    if (IN(11)) { DUP(33, p9_slots(C)); } SEAM(11);
    if (IN(12)) {
        LAS int* te = (LAS int*)(C.lds + RING_BYTES + 64);
        if (C.tid < 33) te[C.tid] = WSP(const int, WS_EOFF)[C.tid] >> 8;
        __syncthreads();
        unsigned* tdone = (unsigned*)(C.ws + WS_CTL) + CW_TDONE; unsigned* tmo = (unsigned*)(C.ws + WS_CTL) + CW_TMO;
        { pg8::MoeSched<true, false, false> S{te, 8, C.G, (int)blockIdx.x, WSP(const int, WS_SLOTTOK), (const char*)(C.ws + WS_WGU), (size_t)2048 * 1024, (size_t)256 * 1024, tdone, tmo};
          pg8::EpiGUQ E{C.in[19], WSP(const float, WS_SW), WSP(const float, WS_SLOTSA), WSP(bf16_t, WS_ACT)};
          DUP(20, pg8::gemm_phase<pg8::EpiGUQ, pg8::MoeSched<true, false, false>, true, true>(C.lds, C.ws + WS_H2Q, 512, 512, 512, S, E)); }
        xcd_barrier(bar);
        { pg8::MoeSched<false, false, false, true> S{te, 4, C.G, (int)blockIdx.x, nullptr, (const char*)WSP(bf16_t, WS_WD), (size_t)1024 * 1024 * 2, (size_t)256 * 1024 * 2, tdone, tmo};
          pg8::EpiDown E{C.in[21], WSP(const float, WS_SLOTW), WSP(bf16_t, WS_SOUT)};
          DUP(21, pg8::gemm_phase<pg8::EpiDown, pg8::MoeSched<false, false, false, true>, true>(C.lds, WSP(bf16_t, WS_ACT), 1024, 1024, 1024, S, E)); }
        xcd_barrier(bar);
        DUP(30, p12_final(C));
    }
#undef IN
#undef SEAM
}

extern "C" void kernel_launch(void* const* d_in, const int* in_sizes, int n_in, void* d_out, int out_size, void* d_ws, size_t ws_size, hipStream_t stream) {
    static int grid = 0;
    if (grid == 0) {
        if (n_in != 23 || in_sizes[0] != M * D || out_size != M * D || ws_size < WS_END) { fprintf(stderr, "kernel_launch: unexpected shapes (n_in %d, in0 %d, out %d, ws %zu); nothing launched\n", n_in, n_in > 0 ? in_sizes[0] : -1, out_size, ws_size); grid = -1; return; }
        int dev = 0, cus = 0, per_cu = 0;
        if (hipGetDevice(&dev) != hipSuccess || hipDeviceGetAttribute(&cus, hipDeviceAttributeMultiprocessorCount, dev) != hipSuccess) { grid = -1; return; }
        if (hipFuncSetAttribute((const void*)mega_fwd, hipFuncAttributeMaxDynamicSharedMemorySize, LDS_BYTES) != hipSuccess) { fprintf(stderr, "kernel_launch: hipFuncSetAttribute failed\n"); grid = -1; return; }
        if (hipOccupancyMaxActiveBlocksPerMultiprocessor(&per_cu, (const void*)mega_fwd, NWAVES * 64, LDS_BYTES) != hipSuccess || per_cu < 1) { fprintf(stderr, "kernel_launch: occupancy query reports %d workgroups per CU\n", per_cu); }
        (void)hipGetLastError();
        grid = cus;
    }
    if (grid < 0) return;
    if (hipMemsetAsync((char*)d_ws + WS_CTL, 0, CTL_ZERO_BYTES, stream) != hipSuccess) { fprintf(stderr, "kernel_launch: memset failed\n"); return; }
    Args a{};
    for (int i = 0; i < 23; ++i) a.in[i] = (const float*)d_in[i];
    a.out = (float*)d_out; a.ws = (unsigned char*)d_ws;
    constexpr int NL = MK_N_LAUNCHES;
    for (int li = 0; li < NL; ++li) {
        a.ph_lo = (NL == 1) ? 0 : li; a.ph_hi = (NL == 1) ? N_PHASES : li + 1; a.li = (NL == 1) ? 0 : li; a.pad = 0;
        hipLaunchKernelGGL(mega_fwd, dim3(grid), dim3(NWAVES * 64), LDS_BYTES, stream, a);
        const hipError_t le = hipPeekAtLastError();
        if (le != hipSuccess) { fprintf(stderr, "kernel_launch: launch %d failed: %s\n", li, hipGetErrorName(le)); break; }
    }
}
```

```cpp
#include <hip/hip_runtime.h>
#include <cstdio>
#include <cstdint>
#ifndef SIMPLE_DIFF
#define SIMPLE_DIFF 0
#endif
#ifndef NATIVE_DIFF
#define NATIVE_DIFF 1
#endif

#define GAS __attribute__((address_space(1)))
#define LAS __attribute__((address_space(3)))
typedef unsigned short bf16_t;
typedef short bf16x8 __attribute__((ext_vector_type(8)));
typedef short s16x4 __attribute__((ext_vector_type(4)));
typedef float f32x4 __attribute__((ext_vector_type(4)));
typedef float f32x2 __attribute__((ext_vector_type(2)));
typedef unsigned u32x4 __attribute__((ext_vector_type(4)));
typedef unsigned u32x2 __attribute__((ext_vector_type(2)));
typedef int i32x4 __attribute__((ext_vector_type(4)));
#define RLX_AGENT __ATOMIC_RELAXED, __HIP_MEMORY_SCOPE_AGENT
#define LDS_WAIT() asm volatile("s_waitcnt lgkmcnt(0)" ::: "memory")
#define VM_WAIT() asm volatile("s_waitcnt vmcnt(0)" ::: "memory")

constexpr int BATCH = 2, SEQ = 8192, M = BATCH * SEQ, D = 1024, INW = 5120;
constexpr int NE = 32, TOPK = 4;
constexpr int NWAVES = 8;
constexpr float RMS_EPS = 1e-5f;
constexpr float LOG2E = 1.4426950408889634f;
constexpr float C2 = 0.125f * LOG2E;
constexpr int SLOT_ROWS = M * TOPK + NE * 256;

constexpr size_t MiB = 1u << 20, KiB = 1u << 10;
constexpr size_t WS_CTL = 0, CTL_ZERO_BYTES = 1 * MiB;
constexpr size_t WS_ADAP = 1 * MiB;
constexpr size_t WS_ADAF = 1 * MiB + 896 * KiB;
constexpr size_t WS_KMEAN = 512 * KiB;
constexpr size_t WS_TOPI = 2 * MiB + 256 * KiB;
constexpr size_t WS_TOPW = 2 * MiB + 512 * KiB;
constexpr size_t WS_TOKSLOT = 2 * MiB + 768 * KiB;
constexpr size_t WS_SLOTTOK = 3 * MiB;
constexpr size_t WS_SLOTW = 3 * MiB + 512 * KiB;
constexpr size_t WS_HIST = 4 * MiB;
constexpr size_t WS_EOFF = 4 * MiB + 64 * KiB;
constexpr size_t WS_WRT = 4 * MiB + 128 * KiB;
constexpr size_t WS_SLOTSA = 4 * MiB + 256 * KiB;
constexpr size_t WS_SW = 5 * MiB;
constexpr size_t WS_SWIN = 5 * MiB + 640 * KiB;
constexpr size_t WS_SA = 5 * MiB + 512 * KiB;
constexpr size_t WS_LIST = 6 * MiB;
constexpr size_t WS_PML = 14 * MiB;
constexpr size_t WS_WIN = 18 * MiB, WS_WBR = 28 * MiB, WS_WOUT = 30 * MiB, WS_WGU = 32 * MiB, WS_WD = 160 * MiB;
constexpr size_t WS_H = 224 * MiB;
constexpr size_t WS_PROJ = 256 * MiB;
constexpr size_t PROJ_STRIDE = 32 * MiB;
constexpr size_t WS_Y = 416 * MiB;
constexpr size_t WS_PO = 448 * MiB;
constexpr size_t WS_H2Q = 512 * MiB;
constexpr size_t WS_MERGED = 576 * MiB;
constexpr size_t WS_X1 = 608 * MiB;
constexpr size_t WS_ACT = 672 * MiB;
constexpr size_t WS_SOUT = 816 * MiB;
constexpr size_t WS_OA = 960 * MiB;
constexpr size_t WS_WINQ = 992 * MiB;
constexpr size_t WS_END = 1000 * MiB;
constexpr int LIST_PER_BH = 126976;
constexpr int CW_TMO = 0, CW_CODE = 1, CW_BAR = 4096, CW_MCNT = 65536, CW_TDONE = 80000, CW_AQ = 110000, CW_GDONE = 121000;

constexpr int RING_BYTES = 131072, LDSCTL_OFF = RING_BYTES, MISC_OFF = LDSCTL_OFF + 320, LDS_BYTES = 163840;

__device__ __forceinline__ unsigned f2bf(float f) { unsigned u = __builtin_bit_cast(unsigned, f); return (u + 0x7fffu + ((u >> 16) & 1u)) >> 16; }
__device__ __forceinline__ unsigned pk2(float lo, float hi) { return f2bf(lo) | (f2bf(hi) << 16); }
__device__ __forceinline__ unsigned cvt_pk_bf16(float lo, float hi) { unsigned r; asm volatile("v_cvt_pk_bf16_f32 %0, %1, %2" : "=v"(r) : "v"(lo), "v"(hi)); return r; }
__device__ __forceinline__ float bf_lo(unsigned u) { return __builtin_bit_cast(float, u << 16); }
__device__ __forceinline__ float bf_hi(unsigned u) { return __builtin_bit_cast(float, u & 0xffff0000u); }
__device__ __forceinline__ float sigmoidf_fast(float v) { return __builtin_amdgcn_rcpf(1.0f + __builtin_amdgcn_exp2f(-v * LOG2E)); }
__device__ __forceinline__ float wave_sum(float v) {
#pragma unroll
    for (int o = 1; o < 64; o <<= 1) v += __shfl_xor(v, o);
    return v;
}

namespace pg8 {
constexpr int BM = 256, BK = 64, HALF = 128, HTB = HALF * BK * 2, STAGE_BYTES = 8 * HTB, NXCD = 8, WGM = 8;
__device__ __forceinline__ int lds_byte(int r, int c) { const int st = (r >> 4) * 2 + (c >> 5), rr = r & 15, cc = c & 31, ob = rr * 64 + cc * 2; return st * 1024 + (ob ^ (((ob >> 9) & 1) << 5)); }
__device__ __forceinline__ void stage_rc(int b, int& R, int& C) { const int st = b / 1024, sb = b % 1024, swz = sb ^ (((sb >> 9) & 1) << 5); R = (st >> 1) * 16 + swz / 64; C = (st & 1) * 32 + (swz % 64) / 2; }
__device__ __forceinline__ int perm32(int rho) { const int n = rho >> 4, i = rho & 15; return 8 * (i >> 2) + 4 * n + (i & 3); }

struct Unit { int row0; int pm, pn, e, half; const char* bptr; };

struct DenseSched {
    static constexpr bool HAS_READY = false, HAS_DONE = false;
    int nM, nN, nwg, G, c; const char* Bt; size_t btile;
    int pn_base = 0, pn_skip_at = 1 << 30, pn_skip = 0;
    __device__ __forceinline__ void init(int M_, int N_, int G_, int c_, const void* Bt_, int ldb) { nM = M_ / BM; nN = N_ / BM; nwg = nM * nN; G = G_; c = c_; Bt = (const char*)Bt_; btile = (size_t)BM * ldb * 2; }
    __device__ __forceinline__ bool next(int i, Unit& u) const {
        const long L = (long)i * G + c; if (L >= nwg) return false;
        int wgid = (int)L; { const int q = nwg / NXCD, r = nwg % NXCD, xcd = wgid % NXCD, off = wgid / NXCD; wgid = (xcd < r ? xcd * (q + 1) : r * (q + 1) + (xcd - r) * q) + off; }
        const int nig = WGM * nN, gid = wgid / nig, fm = gid * WGM, gsz = (nM - fm) < WGM ? (nM - fm) : WGM;
        u.pm = fm + ((wgid % nig) % gsz); { const int pl = (wgid % nig) / gsz; u.pn = pn_base + pl + (pl >= pn_skip_at ? pn_skip : 0); } u.row0 = u.pm * BM; u.e = 0; u.half = 0; u.bptr = Bt + (size_t)u.pn * btile; return true;
    }
    __device__ __forceinline__ int arow(const Unit& u, int r) const { return u.row0 + r; }
    __device__ __forceinline__ void a_ready(const Unit&) const {}
    __device__ __forceinline__ void done(int) const {}
};

template <bool I8> struct AccSel { typedef f32x4 T; };
template <> struct AccSel<true> { typedef i32x4 T; };
template <class Epi, class Sched, bool ALIGN_EPI, bool I8 = false>
__device__ __forceinline__ void gemm_phase(LAS unsigned char* lds, const void* Abase_, int lda, int ldb, int K, const Sched& S, const Epi& E) {
    int tid_ = threadIdx.x; asm volatile("" : "+v"(tid_));
    const int tid = tid_, wid = __builtin_amdgcn_readfirstlane(tid >> 6), lane = tid & 63, wr = wid >> 2, wc = wid & 3, fr = lane & 15, fq = lane >> 4;
    const int nt = K / BK;
    const char* Abase = (const char*)Abase_;
    int Rr[2], Cc[2]; unsigned voffB[2];
#pragma unroll
    for (int i = 0; i < 2; ++i) { stage_rc(tid * 16 + i * 8192, Rr[i], Cc[i]); const int Rb = Epi::PERM ? ((Rr[i] & ~31) + perm32(Rr[i] & 31)) : Rr[i]; voffB[i] = (unsigned)(Rb * ldb + Cc[i]) * 2u; }
    const size_t kstep = (size_t)(BK * 2);
    const size_t hstepB = (size_t)HALF * ldb * 2;
    const unsigned ldsw = (unsigned)wid * 1024u;
    const int aoff = lds_byte(wr * 64 + fr, fq * 8), boff = lds_byte(wc * 32 + fr, fq * 8);
#define PG8_SA(b, h) (((b) * 2 + (h)) * HTB)
#define PG8_SB(b, h) ((4 + (b) * 2 + (h)) * HTB)
#define PG8_STAGE(bufoff, gbase, voff) do { _Pragma("unroll") for (int _i = 0; _i < 2; ++_i) \
        __builtin_amdgcn_global_load_lds((const unsigned*)((const char*)(gbase) + (voff)[_i]), (LAS unsigned*)(lds + (bufoff) + ldsw + _i * 8192), 16, 0, 0); } while (0)
#define PG8_LDA(dst, b, h) do { _Pragma("unroll") for (int m = 0; m < 4; ++m) _Pragma("unroll") for (int k = 0; k < 2; ++k) dst[m][k] = *(const LAS bf16x8*)(lds + PG8_SA(b, h) + aoff + m * 2048 + k * 1024); } while (0)
#define PG8_LDB(dst, b, h) do { _Pragma("unroll") for (int n = 0; n < 2; ++n) _Pragma("unroll") for (int k = 0; k < 2; ++k) dst[n][k] = *(const LAS bf16x8*)(lds + PG8_SB(b, h) + boff + n * 2048 + k * 1024); } while (0)
#define PG8_MMA(ai, bj, At, Bt) do { __builtin_amdgcn_s_setprio(1); _Pragma("unroll") for (int m = 0; m < 4; ++m) _Pragma("unroll") for (int n = 0; n < 2; ++n) _Pragma("unroll") for (int k = 0; k < 2; ++k) { \
        if constexpr (I8) acc[ai][bj][m][n] = __builtin_amdgcn_mfma_i32_16x16x64_i8(__builtin_bit_cast(i32x4, Bt[n][k]), __builtin_bit_cast(i32x4, At[m][k]), acc[ai][bj][m][n], 0, 0, 0); \
        else acc[ai][bj][m][n] = __builtin_amdgcn_mfma_f32_16x16x32_bf16(Bt[n][k], At[m][k], acc[ai][bj][m][n], 0, 0, 0); } __builtin_amdgcn_s_setprio(0); } while (0)
#define PG8_WAIT_V(n) asm volatile("s_waitcnt vmcnt(" #n ")" ::: "memory")
#define PG8_WAIT_L(n) asm volatile("s_waitcnt lgkmcnt(" #n ")" ::: "memory")
#define PG8_BAR __builtin_amdgcn_s_barrier()
#define PG8_SCHED __builtin_amdgcn_sched_barrier(0)
#define PG8_ROWS(u, va) do { _Pragma("unroll") for (int _h = 0; _h < 2; ++_h) _Pragma("unroll") for (int _i = 0; _i < 2; ++_i) \
        va[_h][_i] = (unsigned)(S.arow(u, _h * HALF + Rr[_i]) * lda + Cc[_i]) * 2u; } while (0)
    Unit cur, nxt; int ui = 0; int prev_pm = -1;
    if (!S.next(0, cur)) return;
    unsigned vaC[2][2], vaN[2][2];
    PG8_ROWS(cur, vaC);
    typedef typename AccSel<I8>::T acc_t;
    acc_t acc[2][2][4][2];
#pragma unroll
    for (int a = 0; a < 2; ++a)
#pragma unroll
        for (int b = 0; b < 2; ++b)
#pragma unroll
            for (int m = 0; m < 4; ++m)
#pragma unroll
                for (int n = 0; n < 2; ++n) acc[a][b][m][n] = (acc_t){0, 0, 0, 0};
    bf16x8 At[4][2], B0[2][2], B1[2][2];
    const char* cB = cur.bptr;
    if constexpr (Sched::HAS_READY) S.a_ready(cur);
    PG8_STAGE(PG8_SB(0, 0), cB, voffB); PG8_STAGE(PG8_SB(0, 1), cB + hstepB, voffB); PG8_STAGE(PG8_SA(0, 0), Abase, vaC[0]); PG8_STAGE(PG8_SA(0, 1), Abase, vaC[1]);
    if (wr == 1) PG8_BAR;
    PG8_WAIT_V(2); PG8_BAR;
    PG8_STAGE(PG8_SB(1, 0), cB + kstep, voffB); PG8_STAGE(PG8_SA(1, 0), Abase + kstep, vaC[0]); PG8_STAGE(PG8_SB(1, 1), cB + hstepB + kstep, voffB);
    PG8_WAIT_V(6); PG8_BAR;
    for (;;) {
        const bool has_next = S.next(ui + 1, nxt);
        if (has_next) { PG8_ROWS(nxt, vaN); } else { nxt = cur;
#pragma unroll
            for (int h = 0; h < 2; ++h)
#pragma unroll
                for (int i = 0; i < 2; ++i) vaN[h][i] = vaC[h][i]; }
        const char* nB = nxt.bptr;
        for (int t = 0; t < nt; t += 2) {
            if constexpr (Epi::HAS_MID) { if (t == (nt >> 1)) E.mid(acc, cur, wr, wc, fr, fq); }
            const bool last = (t == nt - 2);
            if constexpr (Sched::HAS_DONE) { if (last && prev_pm >= 0) { S.done(prev_pm); prev_pm = -1; } }
            if constexpr (Sched::HAS_READY) { if (last && has_next) S.a_ready(nxt); }
            const char* a1 = Abase + (size_t)(t + 1) * kstep;
            const char* a2 = last ? Abase : Abase + (size_t)(t + 2) * kstep; const char* b2 = last ? nB : cB + (size_t)(t + 2) * kstep;
            const char* a3 = a2 + kstep; const char* b3 = b2 + kstep;
            unsigned v2[2][2];
#pragma unroll
            for (int h = 0; h < 2; ++h)
#pragma unroll
                for (int i = 0; i < 2; ++i) v2[h][i] = last ? vaN[h][i] : vaC[h][i];
            PG8_LDB(B0, 0, 0); PG8_LDB(B1, 0, 1); PG8_SCHED; PG8_LDA(At, 0, 0); PG8_STAGE(PG8_SA(1, 1), a1, vaC[1]);
            PG8_WAIT_V(8); PG8_WAIT_L(0); PG8_BAR; PG8_MMA(0, 0, At, B0); PG8_MMA(0, 1, At, B1); PG8_BAR; PG8_SCHED;
            PG8_LDA(At, 0, 1); PG8_STAGE(PG8_SB(0, 0), b2, voffB); PG8_STAGE(PG8_SB(0, 1), b2 + hstepB, voffB); PG8_STAGE(PG8_SA(0, 0), a2, v2[0]);
            PG8_WAIT_V(8); PG8_WAIT_L(0); PG8_BAR; if (!cur.half) { PG8_MMA(1, 0, At, B0); PG8_MMA(1, 1, At, B1); } PG8_BAR; PG8_SCHED;
            PG8_LDB(B0, 1, 0); PG8_LDB(B1, 1, 1); PG8_SCHED; PG8_LDA(At, 1, 0); PG8_STAGE(PG8_SA(0, 1), a2, v2[1]);
            PG8_WAIT_V(8); PG8_WAIT_L(0); PG8_BAR; PG8_MMA(0, 0, At, B0); PG8_MMA(0, 1, At, B1); PG8_BAR; PG8_SCHED;
            PG8_LDA(At, 1, 1); PG8_STAGE(PG8_SB(1, 0), b3, voffB); PG8_STAGE(PG8_SB(1, 1), b3 + hstepB, voffB); PG8_STAGE(PG8_SA(1, 0), a3, v2[0]);
            PG8_WAIT_V(8); PG8_WAIT_L(0); PG8_BAR; if (!cur.half) { PG8_MMA(1, 0, At, B0); PG8_MMA(1, 1, At, B1); } PG8_BAR; PG8_SCHED;
        }
        if constexpr (ALIGN_EPI) { if (wr == 0) PG8_BAR; }
        E(acc, cur, wr, wc, fr, fq); if constexpr (Sched::HAS_DONE) prev_pm = cur.pm;
        if (!has_next) break;
#pragma unroll
        for (int a = 0; a < 2; ++a)
#pragma unroll
            for (int b = 0; b < 2; ++b)
#pragma unroll
                for (int m = 0; m < 4; ++m)
#pragma unroll
                    for (int n = 0; n < 2; ++n) acc[a][b][m][n] = (acc_t){0, 0, 0, 0};
        cur = nxt; cB = nB; ++ui;
#pragma unroll
        for (int h = 0; h < 2; ++h)
#pragma unroll
            for (int i = 0; i < 2; ++i) vaC[h][i] = vaN[h][i];
        if constexpr (ALIGN_EPI) { if (wr == 1) PG8_BAR; }
    }
    PG8_WAIT_V(0);
    if constexpr (Sched::HAS_DONE) { if (prev_pm >= 0) S.done(prev_pm); }
    if constexpr (!ALIGN_EPI) { if (wr == 0) PG8_BAR; }
    PG8_BAR;
#undef PG8_SA
#undef PG8_SB
#undef PG8_STAGE
#undef PG8_LDA
#undef PG8_LDB
#undef PG8_MMA
#undef PG8_WAIT_V
#undef PG8_WAIT_L
#undef PG8_BAR
#undef PG8_SCHED
#undef PG8_ROWS
}
}
#define XB_TMO      128
#define XB_XCNT(j)  (256  + 64 * (j))
#define XB_XSUB(j)  (1280 + 64 * (j))
#define XB_XGEN(j)  (2304 + 64 * (j))
#define XB_TOP      3328
#define XB_TOPGEN   3392
#define XCD_BAR_WORDS 3456
#define XB_SPIN_CAP (1u << 18)

__device__ __forceinline__ unsigned xb_ld(unsigned* p)              { return __hip_atomic_load(p, __ATOMIC_RELAXED, __HIP_MEMORY_SCOPE_AGENT); }
__device__ __forceinline__ unsigned xb_add(unsigned* p, unsigned v) { return __hip_atomic_fetch_add(p, v, __ATOMIC_RELAXED, __HIP_MEMORY_SCOPE_AGENT); }
__device__ __forceinline__ unsigned xb_xcc_id() { return (unsigned)__builtin_amdgcn_s_getreg((3 << 11) | 20) & 0xFu; }
#define XB_SPIN(cond, bar) do { unsigned _sp = 0; while (cond) { __builtin_amdgcn_s_sleep(1); \
    if ((++_sp & 255u) == 0u) { if (xb_ld(&(bar)[XB_TMO])) break; if (_sp > XB_SPIN_CAP) { atomicAdd(&(bar)[XB_TMO], 1u); break; } } } } while (0)

struct XcdBarrier {
    unsigned* bar; unsigned x;
    volatile LAS unsigned* st;
};

__device__ __forceinline__ XcdBarrier xcd_barrier_post(unsigned* bar, volatile LAS unsigned* st) {
    XcdBarrier b; b.bar = bar; b.x = xb_xcc_id(); b.st = st;
    if (threadIdx.x == 0) (void)xb_add(&bar[XB_XCNT(b.x)], 1u);
    return b;
}
__device__ __forceinline__ void xcd_barrier_complete(unsigned* bar, unsigned x, unsigned& nloc, unsigned& nx) {
    const unsigned G = gridDim.x * gridDim.y * gridDim.z;
    unsigned sum, cnt, mine, sp = 0u;
    for (;;) {
        sum = 0u; cnt = 0u; mine = 0u;
#pragma unroll
        for (unsigned j = 0; j < 16; ++j) { const unsigned c = xb_ld(&bar[XB_XCNT(j)]); sum += c; cnt += (c > 0u) ? 1u : 0u; mine = (j == x) ? c : mine; }
        if (sum == G) break;
        __builtin_amdgcn_s_sleep(1);
        if ((++sp & 255u) == 0u) { if (xb_ld(&bar[XB_TMO])) break; if (sp > XB_SPIN_CAP) { atomicAdd(&bar[XB_TMO], 1u); break; } }
    }
    nloc = mine > 0u ? mine : 1u; nx = cnt > 0u ? cnt : 1u;
}

__device__ __forceinline__ void xcd_barrier(const XcdBarrier& b) {
    asm volatile("s_waitcnt vmcnt(0)" ::: "memory");
    __syncthreads();
    if (threadIdx.x == 0) {
        unsigned* bar = b.bar;
        __builtin_amdgcn_s_waitcnt(0);
        unsigned nloc = b.st[0], nx = b.st[1];
        if (nloc == 0u) { xcd_barrier_complete(bar, b.x, nloc, nx); b.st[0] = nloc; b.st[1] = nx; }
        const unsigned old = xb_add(&bar[XB_XSUB(b.x)], 1u);
        const unsigned gen = old / nloc;
        if (old + 1u == (gen + 1u) * nloc) {
            __builtin_amdgcn_fence(__ATOMIC_RELEASE, "agent");
            asm volatile("s_waitcnt vmcnt(0)" ::: "memory");
            const unsigned og = xb_add(&bar[XB_TOP], 1u);
            const unsigned tg = og / nx;
            if (og + 1u == (tg + 1u) * nx) xb_add(&bar[XB_TOPGEN], 1u);
            else XB_SPIN(xb_ld(&bar[XB_TOPGEN]) == tg, bar);
            __builtin_amdgcn_fence(__ATOMIC_ACQUIRE, "agent");
            xb_add(&bar[XB_XGEN(b.x)], 1u);
            asm volatile("s_waitcnt vmcnt(0)" ::: "memory");
        } else {
            XB_SPIN(xb_ld(&bar[XB_XGEN(b.x)]) == gen, bar);
            __builtin_amdgcn_fence(__ATOMIC_ACQUIRE, "agent");
            asm volatile("s_waitcnt vmcnt(0)" ::: "memory");
        }
    }
    __syncthreads();
}
namespace pg8 {
struct EpiProj {
    static constexpr bool PERM = true, HAS_MID = false;
    bf16_t* base; float* kmean;
    __device__ __forceinline__ void operator()(const f32x4 (&acc)[2][2][4][2], const Unit& u, int wr, int wc, int fr, int fq) const {
        if (u.pn == 8 || u.pn == 9) {
            const int b = u.pm >> 5, nblk = u.pm & 31;
#pragma unroll
            for (int bj = 0; bj < 2; ++bj)
#pragma unroll
                for (int n = 0; n < 2; ++n) { f32x4 s = (f32x4){0.f, 0.f, 0.f, 0.f};
#pragma unroll
                    for (int ai = 0; ai < 2; ++ai)
#pragma unroll
                        for (int m = 0; m < 4; ++m) s += acc[ai][bj][m][n];
#pragma unroll
                    for (int j = 0; j < 4; ++j) { float v = s[j]; v += __shfl_xor(v, 1); v += __shfl_xor(v, 2); v += __shfl_xor(v, 4); v += __shfl_xor(v, 8); s[j] = v; }
                    if (fr == 0) { const int col = (u.pn - 8) * 256 + bj * HALF + wc * 32 + 8 * fq + 4 * n; const int h = col >> 6, d = col & 63; float* kp = kmean + ((size_t)((b * 8 + h) * 32 + nblk)) * 64 + d;
#pragma unroll
                        for (int j = 0; j < 4; ++j) atomicAdd(kp + j, s[j] * (1.0f / 256.0f)); } }
        }
        const int buf = u.pn >> 2, colt = (u.pn & 3) * 256;
        const float sc = (u.pn < 2 || u.pn == 6 || u.pn == 7) ? C2 : 1.0f;
        bf16_t* dst = base + (size_t)buf * (PROJ_STRIDE / 2);
        const int row0 = u.row0 + wr * 64 + fr, col0 = colt + wc * 32 + 8 * fq;
#pragma unroll
        for (int ai = 0; ai < 2; ++ai)
#pragma unroll
            for (int m = 0; m < 4; ++m) { bf16_t* rowp = dst + (size_t)(row0 + ai * HALF + m * 16) * 1024 + col0;
#pragma unroll
                for (int bj = 0; bj < 2; ++bj) { const f32x4 v0 = acc[ai][bj][m][0] * sc, v1 = acc[ai][bj][m][1] * sc;
                    u32x4 w; w.x = cvt_pk_bf16(v0[0], v0[1]); w.y = cvt_pk_bf16(v0[2], v0[3]); w.z = cvt_pk_bf16(v1[0], v1[1]); w.w = cvt_pk_bf16(v1[2], v1[3]);
                    *(u32x4*)(rowp + bj * HALF) = w; } }
    }
};
struct EpiProjQ {
    static constexpr bool PERM = true, HAS_MID = false;
    bf16_t* base; const float* sa; const float* sw;
    __device__ __forceinline__ void operator()(const i32x4 (&acc)[2][2][4][2], const Unit& u, int wr, int wc, int fr, int fq) const {
        const int buf = u.pn >> 2, colt = (u.pn & 3) * 256;
        const float sc = (u.pn < 2) ? C2 : 1.0f;
        bf16_t* dst = base + (size_t)buf * (PROJ_STRIDE / 2);
        const int row0 = u.row0 + wr * 64 + fr, col0 = colt + wc * 32 + 8 * fq;
        const float* swp = sw + u.pn * 256 + wc * 32 + 8 * fq;
        f32x4 sv[2][2];
#pragma unroll
        for (int bj = 0; bj < 2; ++bj)
#pragma unroll
            for (int n = 0; n < 2; ++n) sv[bj][n] = *(const f32x4*)(swp + bj * HALF + 4 * n) * sc;
#pragma unroll
        for (int ai = 0; ai < 2; ++ai)
#pragma unroll
            for (int m = 0; m < 4; ++m) { const int row = row0 + ai * HALF + m * 16; const float ts = sa[row]; bf16_t* rowp = dst + (size_t)row * 1024 + col0;
#pragma unroll
                for (int bj = 0; bj < 2; ++bj) { const i32x4 a0 = acc[ai][bj][m][0], a1 = acc[ai][bj][m][1];
                    const f32x4 v0 = (f32x4){(float)a0[0], (float)a0[1], (float)a0[2], (float)a0[3]} * (sv[bj][0] * ts), v1 = (f32x4){(float)a1[0], (float)a1[1], (float)a1[2], (float)a1[3]} * (sv[bj][1] * ts);
                    u32x4 w; w.x = cvt_pk_bf16(v0[0], v0[1]); w.y = cvt_pk_bf16(v0[2], v0[3]); w.z = cvt_pk_bf16(v1[0], v1[1]); w.w = cvt_pk_bf16(v1[2], v1[3]);
                    *(u32x4*)(rowp + bj * HALF) = w; } }
    }
};
struct EpiBr {
    static constexpr bool PERM = true, HAS_MID = true;
    const bf16_t* gla; const bf16_t* glb; bf16_t* out;
    __device__ __forceinline__ void mid(f32x4 (&acc)[2][2][4][2], const Unit& u, int wr, int wc, int fr, int fq) const {
        int row0 = u.row0 + wr * 64 + fr, col0 = u.pn * 256 + wc * 32 + 8 * fq; asm volatile("" : "+v"(row0), "+v"(col0));
#pragma unroll
        for (int ai = 0; ai < 2; ++ai)
#pragma unroll
            for (int m = 0; m < 4; ++m) { const size_t ro = (size_t)(row0 + ai * HALF + m * 16) * 1024 + col0;
#pragma unroll
                for (int bj = 0; bj < 2; ++bj) { const u32x4 ga = *(const u32x4*)(gla + ro + bj * HALF), gb = *(const u32x4*)(glb + ro + bj * HALF);
                    f32x4 r0, r1;
#define RT2(R, I, GA, GB) do { f32x2 ea = (f32x2){bf_lo(GA), bf_hi(GA)} * (f32x2){-LOG2E, -LOG2E}, eb = (f32x2){bf_lo(GB), bf_hi(GB)} * (f32x2){-LOG2E, -LOG2E}; \
                        ea[0] = __builtin_amdgcn_exp2f(ea[0]); ea[1] = __builtin_amdgcn_exp2f(ea[1]); eb[0] = __builtin_amdgcn_exp2f(eb[0]); eb[1] = __builtin_amdgcn_exp2f(eb[1]); \
                        ea = ea + (f32x2){1.0f, 1.0f}; eb = eb + (f32x2){1.0f, 1.0f}; ea[0] = __builtin_amdgcn_rcpf(ea[0]); ea[1] = __builtin_amdgcn_rcpf(ea[1]); const f32x2 q_ = eb * ea; R[I] = q_[0]; R[I + 1] = q_[1]; } while (0)
                    RT2(r0, 0, ga.x, gb.x); RT2(r0, 2, ga.y, gb.y); RT2(r1, 0, ga.z, gb.z); RT2(r1, 2, ga.w, gb.w);
#undef RT2
                    acc[ai][bj][m][0] *= r0; acc[ai][bj][m][1] *= r1; } }
    }
    __device__ __forceinline__ void operator()(const f32x4 (&acc)[2][2][4][2], const Unit& u, int wr, int wc, int fr, int fq) const {
        int row0 = u.row0 + wr * 64 + fr, col0 = u.pn * 256 + wc * 32 + 8 * fq; asm volatile("" : "+v"(row0), "+v"(col0));
#pragma unroll
        for (int ai = 0; ai < 2; ++ai)
#pragma unroll
            for (int m = 0; m < 4; ++m) { const size_t ro = (size_t)(row0 + ai * HALF + m * 16) * 1024 + col0;
#pragma unroll
                for (int bj = 0; bj < 2; ++bj) { const u32x4 g = *(const u32x4*)(glb + ro + bj * HALF); const f32x4 v0 = acc[ai][bj][m][0], v1 = acc[ai][bj][m][1];
#define SG2(G, VA, VB) ({ f32x2 e_ = (f32x2){bf_lo(G), bf_hi(G)} * (f32x2){-LOG2E, -LOG2E}; e_[0] = __builtin_amdgcn_exp2f(e_[0]); e_[1] = __builtin_amdgcn_exp2f(e_[1]); e_ = e_ + (f32x2){1.0f, 1.0f}; \
                        e_[0] = __builtin_amdgcn_rcpf(e_[0]); e_[1] = __builtin_amdgcn_rcpf(e_[1]); e_ = e_ * (f32x2){VA, VB}; cvt_pk_bf16(e_[0], e_[1]); })
                    u32x4 w; w.x = SG2(g.x, v0[0], v0[1]); w.y = SG2(g.y, v0[2], v0[3]); w.z = SG2(g.z, v1[0], v1[1]); w.w = SG2(g.w, v1[2], v1[3]);
#undef SG2
                    *(u32x4*)(out + ro + bj * HALF) = w; } }
    }
};
struct EpiOut {
    static constexpr bool PERM = true, HAS_MID = false;
    const float* x; const float* adaf; bf16_t* x1;
    __device__ __forceinline__ void operator()(const f32x4 (&acc)[2][2][4][2], const Unit& u, int wr, int wc, int fr, int fq) const {
        const int row0 = u.row0 + wr * 64 + fr, col0 = u.pn * 256 + wc * 32 + 8 * fq;
        const float* gt = adaf + (u.row0 >= SEQ ? 6144 : 0) + 2048;
        f32x4 gv[2][2];
#pragma unroll
        for (int bj = 0; bj < 2; ++bj)
#pragma unroll
            for (int n = 0; n < 2; ++n) gv[bj][n] = *(const f32x4*)(gt + col0 + bj * HALF + 4 * n);
#pragma unroll
        for (int ai = 0; ai < 2; ++ai)
#pragma unroll
            for (int m = 0; m < 4; ++m) { const size_t ro = (size_t)(row0 + ai * HALF + m * 16) * 1024 + col0;
#pragma unroll
                for (int bj = 0; bj < 2; ++bj) { const f32x4 x0 = *(const f32x4*)(x + ro + bj * HALF), x4 = *(const f32x4*)(x + ro + bj * HALF + 4);
                    const f32x4 v0 = x0 + gv[bj][0] * acc[ai][bj][m][0], v1 = x4 + gv[bj][1] * acc[ai][bj][m][1];
                    u32x4 w; w.x = cvt_pk_bf16(v0[0], v0[1]); w.y = cvt_pk_bf16(v0[2], v0[3]); w.z = cvt_pk_bf16(v1[0], v1[1]); w.w = cvt_pk_bf16(v1[2], v1[3]);
                    *(u32x4*)(x1 + ro + bj * HALF) = w; } }
    }
};
struct EpiGU {
    static constexpr bool PERM = true, HAS_MID = false;
    const float* bgu; bf16_t* act;
    __device__ __forceinline__ void operator()(const f32x4 (&acc)[2][2][4][2], const Unit& u, int wr, int wc, int fr, int fq) const {
        const int row0 = u.row0 + wr * 64 + fr, col0 = u.pn * 128 + wc * 32 + 8 * fq;
        const float* bg = bgu + (size_t)u.e * 2048 + col0;
        f32x4 bgv[2], buv[2];
#pragma unroll
        for (int n = 0; n < 2; ++n) { bgv[n] = *(const f32x4*)(bg + 4 * n); buv[n] = *(const f32x4*)(bg + 1024 + 4 * n); }
#pragma unroll
        for (int ai = 0; ai < 2; ++ai)
#pragma unroll
            for (int m = 0; m < 4; ++m) { float r[8];
#pragma unroll
                for (int n = 0; n < 2; ++n)
#pragma unroll
                    for (int j = 0; j < 4; ++j) { const float gte = fminf(acc[ai][0][m][n][j] + bgv[n][j], 7.0f); const float up = fminf(fmaxf(acc[ai][1][m][n][j] + buv[n][j], -7.0f), 7.0f);
                        r[4 * n + j] = (up + 1.0f) * gte * sigmoidf_fast(1.702f * gte); }
                u32x4 w; w.x = cvt_pk_bf16(r[0], r[1]); w.y = cvt_pk_bf16(r[2], r[3]); w.z = cvt_pk_bf16(r[4], r[5]); w.w = cvt_pk_bf16(r[6], r[7]);
                *(u32x4*)(act + (size_t)(row0 + ai * HALF + m * 16) * 1024 + col0) = w; }
    }
};
struct EpiGUQ {
    static constexpr bool PERM = true, HAS_MID = false;
    const float* bgu; const float* sw; const float* slot_sa; bf16_t* act;
    __device__ __forceinline__ void operator()(const i32x4 (&acc)[2][2][4][2], const Unit& u, int wr, int wc, int fr, int fq) const {
        const int row0 = u.row0 + wr * 64 + fr, col0 = u.pn * 128 + wc * 32 + 8 * fq;
        const float* bg = bgu + (size_t)u.e * 2048 + col0; const float* sg = sw + (size_t)u.e * 2048 + col0;
        f32x4 bgv[2], buv[2], sgv[2], suv[2];
#pragma unroll
        for (int n = 0; n < 2; ++n) { bgv[n] = *(const f32x4*)(bg + 4 * n); buv[n] = *(const f32x4*)(bg + 1024 + 4 * n); sgv[n] = *(const f32x4*)(sg + 4 * n); suv[n] = *(const f32x4*)(sg + 1024 + 4 * n); }
#pragma unroll
        for (int ai = 0; ai < 2; ++ai)
#pragma unroll
            for (int m = 0; m < 4; ++m) { if (ai == 1 && u.half) continue; const int row = row0 + ai * HALF + m * 16; const float ts = slot_sa[row]; unsigned r[4];
#pragma unroll
                for (int n = 0; n < 2; ++n)
#pragma unroll
                    for (int h = 0; h < 2; ++h) { const int j = 2 * h;
                        const f32x2 ag = (f32x2){(float)acc[ai][0][m][n][j], (float)acc[ai][0][m][n][j + 1]}, au = (f32x2){(float)acc[ai][1][m][n][j], (float)acc[ai][1][m][n][j + 1]};
                        const f32x2 tsv = (f32x2){ts, ts};
                        f32x2 g = ag * ((f32x2){sgv[n][j], sgv[n][j + 1]} * tsv) + (f32x2){bgv[n][j], bgv[n][j + 1]};
                        f32x2 up = au * ((f32x2){suv[n][j], suv[n][j + 1]} * tsv) + (f32x2){buv[n][j], buv[n][j + 1]};
                        g[0] = fminf(g[0], 7.0f); g[1] = fminf(g[1], 7.0f); up[0] = fminf(fmaxf(up[0], -7.0f), 7.0f); up[1] = fminf(fmaxf(up[1], -7.0f), 7.0f);
                        f32x2 e = g * (f32x2){-1.702f * LOG2E, -1.702f * LOG2E};
                        e[0] = __builtin_amdgcn_exp2f(e[0]); e[1] = __builtin_amdgcn_exp2f(e[1]);
                        e = e + (f32x2){1.0f, 1.0f};
                        e[0] = __builtin_amdgcn_rcpf(e[0]); e[1] = __builtin_amdgcn_rcpf(e[1]);
                        const f32x2 o = (up + (f32x2){1.0f, 1.0f}) * (g * e);
                        r[2 * n + h] = cvt_pk_bf16(o[0], o[1]); }
                u32x4 w; w.x = r[0]; w.y = r[1]; w.z = r[2]; w.w = r[3];
                *(u32x4*)(act + (size_t)row * 1024 + col0) = w; }
    }
};
struct EpiDown {
    static constexpr bool PERM = true, HAS_MID = false;
    const float* bd; const float* slotw; bf16_t* out;
    __device__ __forceinline__ void operator()(const f32x4 (&acc)[2][2][4][2], const Unit& u, int wr, int wc, int fr, int fq) const {
        const int row0 = u.row0 + wr * 64 + fr, col0 = u.pn * 256 + wc * 32 + 8 * fq;
        const float* bp = bd + (size_t)u.e * 1024 + col0;
        f32x4 bv[2][2];
#pragma unroll
        for (int bj = 0; bj < 2; ++bj)
#pragma unroll
            for (int n = 0; n < 2; ++n) bv[bj][n] = *(const f32x4*)(bp + bj * HALF + 4 * n);
#pragma unroll
        for (int ai = 0; ai < 2; ++ai)
#pragma unroll
            for (int m = 0; m < 4; ++m) { if (ai == 1 && u.half) continue; const int row = row0 + ai * HALF + m * 16; const float w8 = slotw[row]; bf16_t* rowp = out + (size_t)row * 1024 + col0;
#pragma unroll
                for (int bj = 0; bj < 2; ++bj) { const f32x4 v0 = (acc[ai][bj][m][0] + bv[bj][0]) * w8, v1 = (acc[ai][bj][m][1] + bv[bj][1]) * w8;
                    u32x4 w; w.x = cvt_pk_bf16(v0[0], v0[1]); w.y = cvt_pk_bf16(v0[2], v0[3]); w.z = cvt_pk_bf16(v1[0], v1[1]); w.w = cvt_pk_bf16(v1[2], v1[3]);
                    *(u32x4*)(rowp + bj * HALF) = w; } }
    }
};
template <bool GATHER, bool WAIT, bool SIGNAL, bool SPLIT = false> struct MoeSched {
    static constexpr bool HAS_READY = WAIT, HAS_DONE = SIGNAL;
    const LAS int* te; int NP, G, c; const int* slot_tok; const char* W; size_t wstride, btile; unsigned* tdone; unsigned* tmo;
    __device__ __forceinline__ bool next(int i, Unit& u) const {
        const int ntl = te[32], nwg = ntl * NP;
        const int rounds = (nwg + G - 1) / G, rem = nwg - (rounds - 1) * G; const bool split = SPLIT && 2 * rem <= G;
        long L = (long)i * G + c; int half = 0, hsel = 0;
        if (split && i == rounds - 1) { if (c >= 2 * rem) return false; L = (long)i * G + (c >> 1); half = 1; hsel = c & 1; }
        if (L >= nwg) return false;
        int wgid = (int)L; { const int q = nwg / NXCD, r = nwg % NXCD, xcd = wgid % NXCD, off = wgid / NXCD; wgid = (xcd < r ? xcd * (q + 1) : r * (q + 1) + (xcd - r) * q) + off; }
        int e = 0;
        for (int k = 1; k < NE; ++k) e += (wgid >= te[k] * NP) ? 1 : 0;
        const int t0 = te[e], nte = te[e + 1] - t0, r_ = wgid - t0 * NP; const int pn = r_ / nte, t = t0 + r_ % nte;
        u.row0 = t * 256 + hsel * 128; u.pn = pn; u.pm = t; u.e = e; u.half = half; u.bptr = W + (size_t)e * wstride + (size_t)pn * btile; return true;
    }
    __device__ __forceinline__ int arow(const Unit& u, int r) const { if (u.half) r &= 127; if constexpr (GATHER) return slot_tok[u.row0 + r]; else return u.row0 + r; }
    __device__ __forceinline__ void a_ready(const Unit& u) const {
        if constexpr (WAIT) {
            if (threadIdx.x < 64) {
                const unsigned long long t0 = __builtin_amdgcn_s_memrealtime(); unsigned polls = 0;
                while ((unsigned)__builtin_amdgcn_readfirstlane(__hip_atomic_load(tdone + 64 * u.pm, __ATOMIC_RELAXED, __HIP_MEMORY_SCOPE_AGENT)) < 64u) {
                    if ((++polls & 255u) == 0u && __builtin_amdgcn_readfirstlane(__hip_atomic_load(tmo, __ATOMIC_RELAXED, __HIP_MEMORY_SCOPE_AGENT)) != 0u) break;
                    if (__builtin_amdgcn_s_memrealtime() - t0 > 2000000ull) { if (threadIdx.x == 0) __hip_atomic_store(tmo, 1u, __ATOMIC_RELAXED, __HIP_MEMORY_SCOPE_AGENT); break; }
                    __builtin_amdgcn_s_sleep(2); }
                __builtin_amdgcn_fence(__ATOMIC_ACQUIRE, "agent");
                asm volatile("s_waitcnt vmcnt(0)" ::: "memory");
            }
            asm volatile("" ::: "memory"); __builtin_amdgcn_s_barrier(); asm volatile("" ::: "memory");
        }
    }
    __device__ __forceinline__ void done(int pm) const {
        if constexpr (SIGNAL) {
            if ((threadIdx.x & 63) == 0) __hip_atomic_fetch_add(tdone + 64 * pm, 1u, __ATOMIC_RELAXED, __HIP_MEMORY_SCOPE_AGENT); }
    }
};
}

constexpr int BT_STR = 132;
constexpr int AT_BT = LDSCTL_OFF + 1024, AT_K = 0, AT_V = AT_K + 64 * 72 * 2, AT_MISC = LDSCTL_OFF + 8192;
typedef short v4i16_t __attribute__((ext_vector_type(4)));
__device__ __forceinline__ s16x4 tr16(const LAS unsigned char* p) { return __builtin_bit_cast(s16x4, __builtin_amdgcn_ds_read_tr16_b64_v4i16((LAS v4i16_t*)p)); }

template <int NDT>
__device__ __forceinline__ void attn_tile(const LAS unsigned char* lds, int lane, const bf16x8 (&qf)[2], f32x4 (&o)[NDT], float& m_run, float& l_run,
                                          int qpos, int kbase, bool causal, const LAS float* bt) {
    constexpr int VSTR = NDT * 16 + 8;
    const int c = lane & 15, g = lane >> 4;
    f32x4 s[4];
#pragma unroll
    for (int kt = 0; kt < 4; ++kt) { s[kt] = (f32x4){0.f, 0.f, 0.f, 0.f};
#pragma unroll
        for (int ks = 0; ks < 2; ++ks) { const bf16x8 a = *(const LAS bf16x8*)(lds + AT_K + ((16 * kt + c) * 72 + 32 * ks + 8 * g) * 2);
            s[kt] = __builtin_amdgcn_mfma_f32_16x16x32_bf16(a, qf[ks], s[kt], 0, 0, 0); } }
    if (__any((qpos - (kbase + 63)) < 128)) {
#pragma unroll
        for (int kt = 0; kt < 4; ++kt)
#pragma unroll
            for (int i = 0; i < 4; ++i) { const int dist = qpos - (kbase + 16 * kt + 4 * g + i); const int di = dist < 0 ? 0 : (dist > 127 ? 127 : dist);
                const float bv = bt[di]; float v = s[kt][i];
                if (dist >= 0 && dist < 128) v += bv;
                if (causal && dist < 0) v = -INFINITY;
                s[kt][i] = v; }
    }
    float mx = fmaxf(fmaxf(s[0][0], s[0][1]), fmaxf(s[0][2], s[0][3]));
#pragma unroll
    for (int kt = 1; kt < 4; ++kt) mx = fmaxf(mx, fmaxf(fmaxf(s[kt][0], s[kt][1]), fmaxf(s[kt][2], s[kt][3])));
    mx = fmaxf(mx, __shfl_xor(mx, 16)); mx = fmaxf(mx, __shfl_xor(mx, 32));
    const float m_new = fmaxf(m_run, mx), alpha = __builtin_amdgcn_exp2f(m_run - m_new);
    float psum = 0.f;
#pragma unroll
    for (int kt = 0; kt < 4; ++kt)
#pragma unroll
        for (int i = 0; i < 4; ++i) { const float p = __builtin_amdgcn_exp2f(s[kt][i] - m_new); s[kt][i] = p; psum += p; }
    l_run = l_run * alpha + psum; m_run = m_new;
#pragma unroll
    for (int i = 0; i < 4; ++i) { const float ai = __shfl(alpha, 4 * g + i);
#pragma unroll
        for (int dt = 0; dt < NDT; ++dt) o[dt][i] *= ai; }
    bf16x8 pa[2];
#pragma unroll
    for (int kk = 0; kk < 2; ++kk) { u32x4 w; w.x = cvt_pk_bf16(s[2 * kk][0], s[2 * kk][1]); w.y = cvt_pk_bf16(s[2 * kk][2], s[2 * kk][3]);
        w.z = cvt_pk_bf16(s[2 * kk + 1][0], s[2 * kk + 1][1]); w.w = cvt_pk_bf16(s[2 * kk + 1][2], s[2 * kk + 1][3]); pa[kk] = __builtin_bit_cast(bf16x8, w); }
    const LAS unsigned char* vb = lds + AT_V + ((4 * g + (c >> 2)) * VSTR + 4 * (c & 3)) * 2;
#pragma unroll
    for (int dt = 0; dt < NDT; ++dt)
#pragma unroll
        for (int kk = 0; kk < 2; ++kk) { const s16x4 lo = tr16(vb + (32 * kk * VSTR + 16 * dt) * 2), hi = tr16(vb + ((32 * kk + 16) * VSTR + 16 * dt) * 2);
            const bf16x8 b = (bf16x8){lo[0], lo[1], lo[2], lo[3], hi[0], hi[1], hi[2], hi[3]};
            o[dt] = __builtin_amdgcn_mfma_f32_16x16x32_bf16(pa[kk], b, o[dt], 0, 0, 0); }
}

template <int NV> struct TileRegs { u32x4 k; u32x4 v[NV]; };
template <int NV> __device__ __forceinline__ void tile_fetch(TileRegs<NV>& r, const bf16_t* kg, const bf16_t* vg, int tid) {
    const int row = tid >> 3, ch = tid & 7;
    r.k = *(const u32x4*)(kg + (size_t)row * 1024 + ch * 8);
#pragma unroll
    for (int i = 0; i < NV; ++i) r.v[i] = *(const u32x4*)(vg + (size_t)row * 1024 + (ch + 8 * i) * 8);
}
template <int NV> __device__ __forceinline__ void tile_store(const TileRegs<NV>& r, LAS unsigned char* lds, int tid) {
    constexpr int VSTR = NV * 64 + 8;
    const int row = tid >> 3, ch = tid & 7;
    *(LAS u32x4*)(lds + AT_K + (row * 72 + ch * 8) * 2) = r.k;
#pragma unroll
    for (int i = 0; i < NV; ++i) *(LAS u32x4*)(lds + AT_V + (row * VSTR + (ch + 8 * i) * 8) * 2) = r.v[i];
}
#include <hip/hip_bf16.h>
#include <cmath>
namespace attn_body {
using bf16=__hip_bfloat16;
using bf16x8=__attribute__((ext_vector_type(8)))short;
using s16x4=__attribute__((ext_vector_type(4)))short;
using f32x16=__attribute__((ext_vector_type(16)))float;
using u32x4=__attribute__((ext_vector_type(4)))unsigned;
constexpr int BATCH=2,NHEAD=16,SEQ=8192,D=64,DM=NHEAD*D;
constexpr int NW=8,QBLK=32,QB=QBLK*NW,KVBLK=64,NQB=SEQ/QB;
constexpr int ATTN_PITCH=DM, ATTN_UNIT_ROWS=QB;
__device__ __forceinline__ int crow(int r,int hi){return (r&3)+8*(r>>2)+4*hi;}
#define SBAR() __builtin_amdgcn_sched_barrier(0)
typedef const __attribute__((address_space(3))) float* lds_cfptr;
__device__ __forceinline__ void cbias(f32x16&p0,f32x16&p1,int jb,int qrel,int hi,lds_cfptr bt){
  const float NEG=-INFINITY; const int kb=64*jb+4*hi;
  #pragma unroll
  for(int r=0;r<16;++r){const int d0=qrel-(kb+(r&3)+8*(r>>2)),d1=d0-32;
    const unsigned c0=(unsigned)d0<128u?(unsigned)d0:128u,c1=(unsigned)d1<128u?(unsigned)d1:128u;
    const float v0=p0[r]+bt[c0],v1=p1[r]+bt[c1];
    p0[r]=d0<0?NEG:v0; p1[r]=d1<0?NEG:v1;}
}
constexpr int NSLOT=3, SLOTB=8192;
constexpr int LDS_K=0, LDS_V=NSLOT*SLOTB, LDS_WS=2*NSLOT*SLOTB, LDS_OST=LDS_WS+NW*64*4, LDS_BYTES=LDS_OST+NW*4096;
constexpr float C2=0.125f*1.4426950408889634f;
__device__ __forceinline__ void glds16(const void*gsrc,unsigned lds_dst){unsigned keep;
  asm volatile("s_mov_b32 %0, m0\n\ts_mov_b32 m0, %2\n\ts_nop 0\n\tglobal_load_lds_dwordx4 %1, off\n\ts_mov_b32 m0, %0":"=&s"(keep):"v"(gsrc),"s"(lds_dst):"memory");}
__device__ __forceinline__ float max3f(float a,float b,float c){float r;asm("v_max3_f32 %0, %1, %2, %3":"=v"(r):"v"(a),"v"(b),"v"(c));return r;}
__device__ __forceinline__ float max2f(float a,float b){float r;asm("v_max_f32_e32 %0, %1, %2":"=v"(r):"v"(a),"v"(b));return r;}
__device__ __forceinline__ float fadd_s(float a,float b){float r;asm("v_add_f32_e32 %0, %1, %2":"=v"(r):"v"(a),"v"(b));return r;}
__device__ __forceinline__ float fsub_s(float a,float b){float r;asm("v_sub_f32_e32 %0, %1, %2":"=v"(r):"v"(a),"v"(b));return r;}
typedef float f32x2_t __attribute__((ext_vector_type(2))); typedef __bf16 bf16x2_t __attribute__((ext_vector_type(2)));
__device__ __forceinline__ unsigned cvtpk_s(float lo,float hi){f32x2_t v={lo,hi};bf16x2_t b=__builtin_convertvector(v,bf16x2_t);return __builtin_bit_cast(unsigned,b);}
#define WAIT_BAR(N) asm volatile("s_waitcnt vmcnt(" #N ") lgkmcnt(0)\n\ts_barrier":::"memory")

__device__ __forceinline__ void qkt(f32x16&p0,f32x16&p1,const char*Kslot,const bf16x8*qr,const f32x16&negm,int r32,int hi){
  const char*kb=Kslot+hi*1024+r32*16;
  #pragma unroll
  for(int d0=0;d0<4;++d0){
    const bf16x8 b0=*reinterpret_cast<const bf16x8*>(kb+d0*2048);
    const bf16x8 b1=*reinterpret_cast<const bf16x8*>(kb+d0*2048+512);
    if(d0==0){p0=__builtin_amdgcn_mfma_f32_32x32x16_bf16(b0,qr[0],negm,0,0,0);p1=__builtin_amdgcn_mfma_f32_32x32x16_bf16(b1,qr[0],negm,0,0,0);}
    else{p0=__builtin_amdgcn_mfma_f32_32x32x16_bf16(b0,qr[d0],p0,0,0,0);p1=__builtin_amdgcn_mfma_f32_32x32x16_bf16(b1,qr[d0],p1,0,0,0);}}
}
typedef __attribute__((address_space(3))) const char* lds_cptr;
typedef short v4i16_t __attribute__((ext_vector_type(4)));
__device__ __forceinline__ void kload8(bf16x8*kf,lds_cptr kp){
  kf[0]=*(const __attribute__((address_space(3))) bf16x8*)(kp);      kf[1]=*(const __attribute__((address_space(3))) bf16x8*)(kp+512);
  kf[2]=*(const __attribute__((address_space(3))) bf16x8*)(kp+2048); kf[3]=*(const __attribute__((address_space(3))) bf16x8*)(kp+2560);
  kf[4]=*(const __attribute__((address_space(3))) bf16x8*)(kp+4096); kf[5]=*(const __attribute__((address_space(3))) bf16x8*)(kp+4608);
  kf[6]=*(const __attribute__((address_space(3))) bf16x8*)(kp+6144); kf[7]=*(const __attribute__((address_space(3))) bf16x8*)(kp+6656);
}
__device__ __forceinline__ void kload2(bf16x8*kf,lds_cptr kp,int j){ kf[2*j]=*(const __attribute__((address_space(3))) bf16x8*)(kp+j*2048); kf[2*j+1]=*(const __attribute__((address_space(3))) bf16x8*)(kp+j*2048+512); }
__device__ __forceinline__ s16x4 vtr(lds_cptr p){ return __builtin_bit_cast(s16x4,__builtin_amdgcn_ds_read_tr16_b64_v4i16((__attribute__((address_space(3))) v4i16_t*)p)); }
__device__ __forceinline__ float rowmax(const f32x16&p0,const f32x16&p1){
  float a=max3f(p0[0],p0[1],p1[0]),b=max3f(p0[2],p0[3],p1[1]);a=max3f(a,p1[2],p1[3]);
  #pragma unroll
  for(int r=4;r<16;r+=4){a=max3f(a,p0[r],p0[r+1]);b=max3f(b,p0[r+2],p0[r+3]);a=max3f(a,p1[r],p1[r+1]);b=max3f(b,p1[r+2],p1[r+3]);}
  const float m=max2f(a,b);
  auto rr=__builtin_amdgcn_permlane32_swap(__float_as_uint(m),__float_as_uint(m),false,false);
  return max2f(__uint_as_float(rr[0]),__uint_as_float(rr[1]));
}
__device__ __forceinline__ void pv(f32x16*o,int vb,bf16x8 pa0,bf16x8 pa1,bf16x8 pa2,bf16x8 pa3){
  #pragma unroll
  for(int d0=0;d0<2;++d0){s16x4 lo[4],hi[4];
    #pragma unroll
    for(int ks=0;ks<4;++ks){
      asm volatile("ds_read_b64_tr_b16 %0,%1 offset:%c2":"=&v"(lo[ks]):"v"(vb),"i"(d0*4096+ks*1024):"memory");
      asm volatile("ds_read_b64_tr_b16 %0,%1 offset:%c2":"=&v"(hi[ks]):"v"(vb),"i"(d0*4096+ks*1024+512):"memory");}
    asm volatile("s_waitcnt lgkmcnt(0)":::"memory");SBAR();
    #define PK(k) (bf16x8){lo[k][0],lo[k][1],lo[k][2],lo[k][3],hi[k][0],hi[k][1],hi[k][2],hi[k][3]}
    o[d0]=__builtin_amdgcn_mfma_f32_32x32x16_bf16(pa0,PK(0),o[d0],0,0,0);
    o[d0]=__builtin_amdgcn_mfma_f32_32x32x16_bf16(pa1,PK(1),o[d0],0,0,0);
    o[d0]=__builtin_amdgcn_mfma_f32_32x32x16_bf16(pa2,PK(2),o[d0],0,0,0);
    o[d0]=__builtin_amdgcn_mfma_f32_32x32x16_bf16(pa3,PK(3),o[d0],0,0,0);
    #undef PK
  }
}

#ifndef ATTN_STORE16
#define ATTN_STORE16(p,v) (*(u32x4*)(p)=(v))
#endif
template<int THRL> __device__ __forceinline__ void attn_unit(int b,int qb,const bf16*Q,const bf16*__restrict__ K,const bf16*__restrict__ V,bf16*O,int qc,int kc,int vc,int oc,lds_cfptr bt,char*shm){
  int tid_=threadIdx.x; asm volatile("":"+v"(tid_)); const int tid=tid_,lane=tid&63,r32=lane&31,hi=lane>>5; const int wid=__builtin_amdgcn_readfirstlane(tid>>6);
  const long rowbase=(long)b*SEQ; const int q0=qb*QB;
  const bf16*Qw=Q+(rowbase+q0+wid*QBLK)*DM+qc;
  const bf16*Kh=K+rowbase*DM+kc,*Vh=V+rowbase*DM+vc;
  const unsigned lds0=(unsigned)(uintptr_t)shm;
  float*wsf=(float*)(shm+LDS_WS)+wid*64;
  const bf16*ksrc=Kh+(long)lane*DM+wid*8;
  const bf16*vsrc=Vh+(long)(16*(wid&3)+(lane>>2))*DM+(wid>>2)*32+(lane&3)*8;
  const unsigned kdst=lds0+LDS_K+wid*1024, vdst=lds0+LDS_V+wid*1024;
  #define DMA_K(t,slot) glds16(ksrc+(long)(t)*KVBLK*DM,(unsigned)__builtin_amdgcn_readfirstlane(kdst+(slot)))
  #define DMA_V(t,slot) glds16(vsrc+(long)(t)*KVBLK*DM,(unsigned)__builtin_amdgcn_readfirstlane(vdst+(slot)))
  const int vb0=(int)(lds0+LDS_V)+((lane>>4)&1)*32+(lane&3)*8+(4*hi+((lane&15)>>2))*64;
  const char*Kbase=shm+LDS_K; bf16x8 kf[8];
  const lds_cptr shm3=(lds_cptr)shm; const lds_cptr kp0=shm3+LDS_K+hi*1024+r32*16; const lds_cptr vp0=shm3+LDS_V+((lane>>4)&1)*32+(lane&3)*8+(4*hi+((lane&15)>>2))*64;
  const int NT=(q0+QB)/KVBLK;
  DMA_K(0,0);DMA_V(0,0);DMA_K(1,SLOTB);
  bf16x8 qr[4];
  #pragma unroll
  for(int d0=0;d0<4;++d0)qr[d0]=*reinterpret_cast<const bf16x8*>(&Qw[(long)r32*DM+d0*16+hi*8]);
  float mhat=0.f,l_reg=0.f;f32x16 o[2],negm; { float z_=0.f; asm volatile("":"+v"(z_));
    _Pragma("unroll") for(int r=0;r<16;++r){o[0][r]=z_;o[1][r]=z_;negm[r]=z_;} } asm volatile("":"+v"(negm));
  const int qrel=wid*QBLK+r32;
  #define CMASK(P0,P1,t) do{int jb_=(t)-(NT-4); if(jb_>=-2 && (wid*QBLK-(64*jb_+63))<128)cbias(P0,P1,jb_,qrel,hi,bt);}while(0)
  bool resc=false;
  #define START(P0,P1) do{ const float rm=rowmax(P0,P1); resc=false; \
    { const float dl=rm; mhat=fadd_s(mhat,dl); \
      _Pragma("unroll") for(int r=0;r<16;++r){P0[r]=fsub_s(P0[r],dl);P1[r]=fsub_s(P1[r],dl);} \
      _Pragma("unroll") for(int r=0;r<16;++r)negm[r]=-mhat; asm volatile("":"+v"(negm)); } \
    _Pragma("unroll") for(int r=0;r<16;++r)P0[r]=__builtin_amdgcn_exp2f(P0[r]); }while(0)
  #define RESC() do{ if(resc){ asm volatile("s_waitcnt lgkmcnt(0)":::"memory"); \
      _Pragma("unroll") for(int d_=0;d_<2;++d_) _Pragma("unroll") for(int r=0;r<16;++r)o[d_][r]*=wsf[crow(r,hi)]; } }while(0)
  f32x16 pA0,pA1,pB0,pB1;
  int sl_prev=0,sl_cur=0,sl_next=SLOTB;
  #define ROT() do{sl_prev=sl_cur;sl_cur=sl_next;sl_next=(sl_next==(NSLOT-1)*SLOTB)?0:sl_next+SLOTB;}while(0)
  DMA_K(2,2*SLOTB);
  WAIT_BAR(3);
  qkt(pA0,pA1,Kbase,qr,negm,r32,hi);asm volatile("s_nop 15\n\ts_nop 7":"+v"(pA0),"+v"(pA1));CMASK(pA0,pA1,0);
  START(pA0,pA1);
  _Pragma("unroll") for(int r=0;r<16;++r)pA1[r]=__builtin_amdgcn_exp2f(pA1[r]);
  WAIT_BAR(0);
  DMA_K(3,0);DMA_V(1,SLOTB);
  ROT();
  kload8(kf,kp0+sl_cur);
  WAIT_BAR(2);
  s16x4 vlo[8],vhi[8]; u32x4 pw0,pw1,pw2,pw3;
  #define PKW(P,B) cvtpk_s(P[B],P[B+1])
  #define PAF(k) __builtin_bit_cast(bf16x8,pw##k)
  #define VFR(i) (bf16x8){vlo[i][0],vlo[i][1],vlo[i][2],vlo[i][3],vhi[i][0],vhi[i][1],vhi[i][2],vhi[i][3]}
  #define PIN(x) asm volatile("":"+v"(x))
  #define MX3(a,b,c) __builtin_fmaxf(__builtin_fmaxf((a),(b)),(c))
  #define GAPA(MF,A0,A1,A2,A3,W0,W1,PW) do{ MF; sacc+=A0; sacc+=A1; sacc+=A2; sacc+=A3; PIN(sacc); W0; W1; PIN(PW); SBAR(); }while(0)
  #define EX(v) __builtin_amdgcn_exp2f(v)
  #define GAPB(MF,X,B) do{ MF; X[B]=EX(X[B]); X[B+1]=EX(X[B+1]); X[B+2]=EX(X[B+2]); X[B+3]=EX(X[B+3]); PIN(X); SBAR(); }while(0)
  #define VRD(i) do{ vlo[i]=vtr(vp_+(((i)>>2)*4096+((i)&3)*1024)); vhi[i]=vtr(vp_+(((i)>>2)*4096+((i)&3)*1024+512)); }while(0)
  #define KRD(G,j) do{ if(G){ kload2(kf,kp0+sl_next,j); SBAR(); } }while(0)
  #define STEP(C0,C1,P0,P1,t,GK,GV,GL) do{ SBAR(); \
    const lds_cptr vp_=vp0+sl_prev; \
    VRD(0); SBAR(); float sacc=(P0[0]+P0[1]); \
    GAPA(C0=__builtin_amdgcn_mfma_f32_32x32x16_bf16(kf[0],qr[0],negm,0,0,0), P0[2],P0[3],P0[4],P0[5],     pw0[0]=PKW(P0,0), pw0[1]=PKW(P0,2), pw0); \
    VRD(4); SBAR(); GAPA(C1=__builtin_amdgcn_mfma_f32_32x32x16_bf16(kf[1],qr[0],negm,0,0,0), P0[6],P0[7],P0[8],P0[9],     pw0[2]=PKW(P0,4), pw0[3]=PKW(P0,6), pw0); \
    VRD(1); SBAR(); GAPA(C0=__builtin_amdgcn_mfma_f32_32x32x16_bf16(kf[2],qr[1],C0,0,0,0),   P0[10],P0[11],P0[12],P0[13], pw1[0]=PKW(P0,8), pw1[1]=PKW(P0,10), pw1); \
    VRD(5); SBAR(); GAPA(C1=__builtin_amdgcn_mfma_f32_32x32x16_bf16(kf[3],qr[1],C1,0,0,0),   P0[14],P0[15],P1[0],P1[1],   pw1[2]=PKW(P0,12),pw1[3]=PKW(P0,14), pw1); \
    VRD(2); SBAR(); GAPA(C0=__builtin_amdgcn_mfma_f32_32x32x16_bf16(kf[4],qr[2],C0,0,0,0),   P1[2],P1[3],P1[4],P1[5],     pw2[0]=PKW(P1,0), pw2[1]=PKW(P1,2), pw2); \
    VRD(6); SBAR(); GAPA(C1=__builtin_amdgcn_mfma_f32_32x32x16_bf16(kf[5],qr[2],C1,0,0,0),   P1[6],P1[7],P1[8],P1[9],     pw2[2]=PKW(P1,4), pw2[3]=PKW(P1,6), pw2); \
    VRD(3); SBAR(); GAPA(C0=__builtin_amdgcn_mfma_f32_32x32x16_bf16(kf[6],qr[3],C0,0,0,0),   P1[10],P1[11],P1[12],P1[13], pw3[0]=PKW(P1,8), pw3[1]=PKW(P1,10), pw3); \
    VRD(7); SBAR(); GAPA(C1=__builtin_amdgcn_mfma_f32_32x32x16_bf16(kf[7],qr[3],C1,0,0,0),   P1[14],P1[15],0.f,0.f,       pw3[2]=PKW(P1,12),pw3[3]=PKW(P1,14), pw3); \
    l_reg+=sacc; \
    if(GK){DMA_K((t)+3,sl_cur);} if(GV){DMA_V((t)+1,sl_next);} \
    CMASK(C0,C1,t); \
    { float a=MX3(C0[0],C0[1],C1[0]),b=MX3(C0[2],C0[3],C1[1]); a=MX3(a,C1[2],C1[3]); \
      _Pragma("unroll") for(int r=4;r<16;r+=4){a=MX3(a,C0[r],C0[r+1]);b=MX3(b,C0[r+2],C0[r+3]);a=MX3(a,C1[r],C1[r+1]);b=MX3(b,C1[r+2],C1[r+3]);} \
      float rm=__builtin_fmaxf(a,b); { auto rr=__builtin_amdgcn_permlane32_swap(__float_as_uint(rm),__float_as_uint(rm),false,false); rm=__builtin_fmaxf(__uint_as_float(rr[0]),__uint_as_float(rr[1])); } \
      resc=false; \
      if(__builtin_expect(__any(rm>(float)THRL),0)){ const float dl=__builtin_fmaxf(rm,0.f); mhat+=dl; \
        _Pragma("unroll") for(int r=0;r<16;++r){C0[r]-=dl;C1[r]-=dl;} \
        _Pragma("unroll") for(int r=0;r<16;++r)negm[r]=-mhat; asm volatile("":"+v"(negm)); \
        const float f=__builtin_amdgcn_exp2f(-dl); l_reg*=f; if(hi==0)wsf[r32]=f; resc=true; } } \
    SBAR(); \
    GAPB(o[0]=__builtin_amdgcn_mfma_f32_32x32x16_bf16(PAF(0),VFR(0),o[0],0,0,0), C0,0); \
    GAPB(o[1]=__builtin_amdgcn_mfma_f32_32x32x16_bf16(PAF(0),VFR(4),o[1],0,0,0), C0,4); \
    KRD(GL,0); GAPB(o[0]=__builtin_amdgcn_mfma_f32_32x32x16_bf16(PAF(1),VFR(1),o[0],0,0,0), C0,8); \
    KRD(GL,1); GAPB(o[1]=__builtin_amdgcn_mfma_f32_32x32x16_bf16(PAF(1),VFR(5),o[1],0,0,0), C0,12); \
    KRD(GL,2); GAPB(o[0]=__builtin_amdgcn_mfma_f32_32x32x16_bf16(PAF(2),VFR(2),o[0],0,0,0), C1,0); \
    KRD(GL,3); GAPB(o[1]=__builtin_amdgcn_mfma_f32_32x32x16_bf16(PAF(2),VFR(6),o[1],0,0,0), C1,4); \
    GAPB(o[0]=__builtin_amdgcn_mfma_f32_32x32x16_bf16(PAF(3),VFR(3),o[0],0,0,0), C1,8); \
    GAPB(o[1]=__builtin_amdgcn_mfma_f32_32x32x16_bf16(PAF(3),VFR(7),o[1],0,0,0), C1,12); \
    }while(0)
  int t=1;
  #undef CMASK
  #define CMASK(P0,P1,t) do{}while(0)
  for(;t+7<NT;t+=2){
    STEP(pB0,pB1,pA0,pA1,t,true,true,true);     WAIT_BAR(2); RESC(); ROT();
    STEP(pA0,pA1,pB0,pB1,t+1,true,true,true);   WAIT_BAR(2); RESC(); ROT();
  }
  #undef CMASK
  #define CMASK(P0,P1,t) do{int jb_=(t)-(NT-4); if(jb_>=-2 && (wid*QBLK-(64*jb_+63))<128)cbias(P0,P1,jb_,qrel,hi,bt);}while(0)
  #define ENDW(tt) do{ if((tt)+3<NT){WAIT_BAR(2);} else if((tt)+2<NT){WAIT_BAR(1);} else {WAIT_BAR(0);} }while(0)
  for(;t+1<NT;t+=2){
    STEP(pB0,pB1,pA0,pA1,t,(t+3<NT),(t+1<NT),(t+1<NT));       ENDW(t);   RESC(); ROT();
    STEP(pA0,pA1,pB0,pB1,t+1,(t+4<NT),(t+2<NT),(t+2<NT));     ENDW(t+1); RESC(); ROT();
  }
  STEP(pB0,pB1,pA0,pA1,NT-1,false,false,false); RESC();
  { float sacc=pB0[0]+pB0[1]; _Pragma("unroll") for(int r=2;r<16;++r)sacc+=pB0[r]; _Pragma("unroll") for(int r=0;r<16;++r)sacc+=pB1[r]; l_reg+=sacc;
    pw0=(u32x4){PKW(pB0,0),PKW(pB0,2),PKW(pB0,4),PKW(pB0,6)};pw1=(u32x4){PKW(pB0,8),PKW(pB0,10),PKW(pB0,12),PKW(pB0,14)};pw2=(u32x4){PKW(pB1,0),PKW(pB1,2),PKW(pB1,4),PKW(pB1,6)};pw3=(u32x4){PKW(pB1,8),PKW(pB1,10),PKW(pB1,12),PKW(pB1,14)};
    SBAR(); pv(o,vb0+sl_cur,PAF(0),PAF(1),PAF(2),PAF(3)); }
  #undef PKW
  #undef PAF
  #undef VFR
  #undef PIN
  #undef MX3
  #undef GAPA
  #undef GAPB
  #undef EX
  #undef VRD
  #undef KRD
  #undef STEP
  #undef ENDW
  {auto rr=__builtin_amdgcn_permlane32_swap(__float_as_uint(l_reg),__float_as_uint(l_reg),false,false);l_reg=__uint_as_float(rr[0])+__uint_as_float(rr[1]);}
  if(hi==0)wsf[32+r32]=l_reg;asm volatile("s_waitcnt lgkmcnt(0)":::"memory");
  float rli[16];
  #pragma unroll
  for(int r=0;r<16;++r)rli[r]=__builtin_amdgcn_rcpf(wsf[32+crow(r,hi)]);
  bf16*Ow=O+(rowbase+q0+wid*QBLK)*DM+oc;
  { bf16*stg=(bf16*)(shm+LDS_OST)+wid*2048;
    #pragma unroll
    for(int r=0;r<16;++r){const int orow=crow(r,hi);
      #pragma unroll
      for(int d0=0;d0<2;++d0)stg[orow*64+d0*32+r32]=__float2bfloat16(o[d0][r]*rli[r]);}
    asm volatile("s_waitcnt lgkmcnt(0)":::"memory");
    #pragma unroll
    for(int i=0;i<4;++i){const int row=i*8+(lane>>3),ch=lane&7; const u32x4 v=*(const u32x4*)(stg+row*64+ch*8); ATTN_STORE16(Ow+(long)row*DM+ch*8,v);} }
  asm volatile("s_waitcnt lgkmcnt(0)\n\ts_barrier":::"memory");
  #undef DMA_K
  #undef DMA_V
  #undef CMASK
  #undef START
  #undef RESC
  #undef ROT
}
constexpr int ATTN_LDS_BYTES=LDS_BYTES;
#undef SBAR
#undef WAIT_BAR
}
#include <hip/hip_bf16.h>
#include <cmath>
#ifndef ATTN_QLDS
#define ATTN_QLDS 1
#endif
namespace attn_nat {
using bf16=__hip_bfloat16;
using bf16x8=__attribute__((ext_vector_type(8)))short;
using s16x4=__attribute__((ext_vector_type(4)))short;
using f32x16=__attribute__((ext_vector_type(16)))float;
using u32x4=__attribute__((ext_vector_type(4)))unsigned;
constexpr int BATCH=2,NHEAD=16,SEQ=8192,D=64,DM=NHEAD*D;
constexpr int NW=8,QBLK=32,QB=QBLK*NW,KVBLK=64,NQB=SEQ/QB;
constexpr int ATTN_PITCH=DM, ATTN_UNIT_ROWS=QB;
__device__ __forceinline__ int crow(int r,int hi){return (r&3)+8*(r>>2)+4*hi;}
#define SBAR() __builtin_amdgcn_sched_barrier(0)
typedef const __attribute__((address_space(3))) float* lds_cfptr;
__device__ __forceinline__ void cbias(f32x16&p0,f32x16&p1,int jb,int qrel,int hi,lds_cfptr bt){
  const float NEG=-INFINITY; const int kb=64*jb+4*hi;
  #pragma unroll
  for(int r=0;r<16;++r){const int d0=qrel-(kb+(r&3)+8*(r>>2)),d1=d0-32;
    const unsigned c0=(unsigned)d0<128u?(unsigned)d0:128u,c1=(unsigned)d1<128u?(unsigned)d1:128u;
    const float v0=p0[r]+bt[c0],v1=p1[r]+bt[c1];
    p0[r]=d0<0?NEG:v0; p1[r]=d1<0?NEG:v1;
    if((r&3)==3)__builtin_amdgcn_sched_barrier(0);}
}
constexpr int NSLOT=3, SLOTB=8192;
constexpr int LDS_K=0, LDS_V=NSLOT*SLOTB, LDS_WS=3*NSLOT*SLOTB, LDS_OST=LDS_WS+NW*64*4, LDS_BYTES=LDS_OST+NW*4096;
constexpr float C2=0.125f*1.4426950408889634f;
__device__ __forceinline__ void glds16(const void*sbase,unsigned voff,unsigned lds_dst){unsigned keep;
  asm volatile("s_mov_b32 %0, m0\n\ts_mov_b32 m0, %3\n\ts_nop 0\n\tglobal_load_lds_dwordx4 %1, %2\n\ts_mov_b32 m0, %0":"=&s"(keep):"v"(voff),"s"(sbase),"s"(lds_dst):"memory");}
__device__ __forceinline__ float max3f(float a,float b,float c){float r;asm("v_max3_f32 %0, %1, %2, %3":"=v"(r):"v"(a),"v"(b),"v"(c));return r;}
__device__ __forceinline__ float max2f(float a,float b){float r;asm("v_max_f32_e32 %0, %1, %2":"=v"(r):"v"(a),"v"(b));return r;}
__device__ __forceinline__ float fadd_s(float a,float b){float r;asm("v_add_f32_e32 %0, %1, %2":"=v"(r):"v"(a),"v"(b));return r;}
__device__ __forceinline__ float fsub_s(float a,float b){float r;asm("v_sub_f32_e32 %0, %1, %2":"=v"(r):"v"(a),"v"(b));return r;}
typedef float f32x2_t __attribute__((ext_vector_type(2))); typedef __bf16 bf16x2_t __attribute__((ext_vector_type(2)));
__device__ __forceinline__ unsigned cvtpk_s(float lo,float hi){f32x2_t v={lo,hi};bf16x2_t b=__builtin_convertvector(v,bf16x2_t);return __builtin_bit_cast(unsigned,b);}
#define WAIT_BAR(N) asm volatile("s_waitcnt vmcnt(" #N ") lgkmcnt(0)\n\ts_barrier":::"memory")

__device__ __forceinline__ void qkt(f32x16&p0,f32x16&p1,const char*Kslot,const bf16x8*qr,const f32x16&negm,int r32,int hi){
  const char*kb=Kslot+hi*1024+r32*16;
  #pragma unroll
  for(int d0=0;d0<4;++d0){
    const bf16x8 b0=*reinterpret_cast<const bf16x8*>(kb+d0*2048);
    const bf16x8 b1=*reinterpret_cast<const bf16x8*>(kb+d0*2048+512);
    if(d0==0){p0=__builtin_amdgcn_mfma_f32_32x32x16_bf16(b0,qr[0],negm,0,0,0);p1=__builtin_amdgcn_mfma_f32_32x32x16_bf16(b1,qr[0],negm,0,0,0);}
    else{p0=__builtin_amdgcn_mfma_f32_32x32x16_bf16(b0,qr[d0],p0,0,0,0);p1=__builtin_amdgcn_mfma_f32_32x32x16_bf16(b1,qr[d0],p1,0,0,0);}}
}
typedef __attribute__((address_space(3))) const char* lds_cptr;
typedef short v4i16_t __attribute__((ext_vector_type(4)));
__device__ __forceinline__ void kload8(bf16x8*kf,lds_cptr kp){
  kf[0]=*(const __attribute__((address_space(3))) bf16x8*)(kp);      kf[1]=*(const __attribute__((address_space(3))) bf16x8*)(kp+512);
  kf[2]=*(const __attribute__((address_space(3))) bf16x8*)(kp+2048); kf[3]=*(const __attribute__((address_space(3))) bf16x8*)(kp+2560);
  kf[4]=*(const __attribute__((address_space(3))) bf16x8*)(kp+4096); kf[5]=*(const __attribute__((address_space(3))) bf16x8*)(kp+4608);
  kf[6]=*(const __attribute__((address_space(3))) bf16x8*)(kp+6144); kf[7]=*(const __attribute__((address_space(3))) bf16x8*)(kp+6656);
}
__device__ __forceinline__ void kload2(bf16x8*kf,lds_cptr kp,int j){ kf[2*j]=*(const __attribute__((address_space(3))) bf16x8*)(kp+j*2048); kf[2*j+1]=*(const __attribute__((address_space(3))) bf16x8*)(kp+j*2048+512); }
__device__ __forceinline__ s16x4 vtr(lds_cptr p){ return __builtin_bit_cast(s16x4,__builtin_amdgcn_ds_read_tr16_b64_v4i16((__attribute__((address_space(3))) v4i16_t*)p)); }
__device__ __forceinline__ float rowmax(const f32x16&p0,const f32x16&p1){
  float a=max3f(p0[0],p0[1],p1[0]),b=max3f(p0[2],p0[3],p1[1]);a=max3f(a,p1[2],p1[3]);
  #pragma unroll
  for(int r=4;r<16;r+=4){a=max3f(a,p0[r],p0[r+1]);b=max3f(b,p0[r+2],p0[r+3]);a=max3f(a,p1[r],p1[r+1]);b=max3f(b,p1[r+2],p1[r+3]);}
  const float m=max2f(a,b);
  auto rr=__builtin_amdgcn_permlane32_swap(__float_as_uint(m),__float_as_uint(m),false,false);
  return max2f(__uint_as_float(rr[0]),__uint_as_float(rr[1]));
}
__device__ __forceinline__ void pv(f32x16*o,int vb,bf16x8 pa0,bf16x8 pa1,bf16x8 pa2,bf16x8 pa3){
  #pragma unroll
  for(int d0=0;d0<4;++d0){s16x4 lo[4],hi[4];
    #pragma unroll
    for(int ks=0;ks<4;++ks){
      asm volatile("ds_read_b64_tr_b16 %0,%1 offset:%c2":"=&v"(lo[ks]):"v"(vb),"i"(d0*4096+ks*1024):"memory");
      asm volatile("ds_read_b64_tr_b16 %0,%1 offset:%c2":"=&v"(hi[ks]):"v"(vb),"i"(d0*4096+ks*1024+512):"memory");}
    asm volatile("s_waitcnt lgkmcnt(0)":::"memory");SBAR();
    #define PK(k) (bf16x8){lo[k][0],lo[k][1],lo[k][2],lo[k][3],hi[k][0],hi[k][1],hi[k][2],hi[k][3]}
    o[d0]=__builtin_amdgcn_mfma_f32_32x32x16_bf16(pa0,PK(0),o[d0],0,0,0);
    o[d0]=__builtin_amdgcn_mfma_f32_32x32x16_bf16(pa1,PK(1),o[d0],0,0,0);
    o[d0]=__builtin_amdgcn_mfma_f32_32x32x16_bf16(pa2,PK(2),o[d0],0,0,0);
    o[d0]=__builtin_amdgcn_mfma_f32_32x32x16_bf16(pa3,PK(3),o[d0],0,0,0);
    #undef PK
  }
}

#ifndef ATTN_STORE16
#define ATTN_STORE16(p,v) (*(u32x4*)(p)=(v))
#endif
template<int THRL> __device__ __forceinline__ void attn_unit(int b,int qb,const bf16*Q,const bf16*__restrict__ K,const bf16*__restrict__ V,bf16*O,int qc,int kc,int vc,int oc,lds_cfptr bt,char*shm){
  int tid_=threadIdx.x; asm volatile("":"+v"(tid_)); const int tid=tid_,lane=tid&63,r32=lane&31,hi=lane>>5; const int wid=__builtin_amdgcn_readfirstlane(tid>>6);
  const long rowbase=(long)b*SEQ; const int q0=qb*QB;
  const bf16*Qw=Q+(rowbase+q0+wid*QBLK)*DM+qc;
  const bf16*Kh=K+rowbase*DM+kc,*Vh=V+rowbase*DM+vc;
  const unsigned lds0=(unsigned)(uintptr_t)shm;
  float*wsf=(float*)(shm+LDS_WS)+wid*64;
  const unsigned koff=(unsigned)((lane*DM+wid*8)*2);
  const unsigned voff=(unsigned)(((16*(wid&3)+(lane>>2))*DM+(wid>>2)*32+(lane&3)*8)*2);
  const unsigned kdst=lds0+LDS_K+wid*1024, vdst=lds0+LDS_V+wid*1024;
  #define DMA_K(t,slot) glds16(Kh+(long)(t)*KVBLK*DM,koff,(unsigned)__builtin_amdgcn_readfirstlane(kdst+(slot)))
  #define DMA_V(t,slot) do{ glds16(Vh+(long)(t)*KVBLK*DM,voff,(unsigned)__builtin_amdgcn_readfirstlane(vdst+2*(slot))); glds16(Vh+(long)(t)*KVBLK*DM+64,voff,(unsigned)__builtin_amdgcn_readfirstlane(vdst+2*(slot)+8192)); }while(0)
  const char*Kbase=shm+LDS_K; bf16x8 kf[8];
  const lds_cptr shm3=(lds_cptr)shm; const lds_cptr kp0=shm3+LDS_K+hi*1024+r32*16; const lds_cptr vp0=shm3+LDS_V+((lane>>4)&1)*32+(lane&3)*8+(4*hi+((lane&15)>>2))*64;
  const int NT=(q0+QB)/KVBLK;
  DMA_K(0,0);DMA_V(0,0);DMA_K(1,SLOTB);
  bf16x8 qr[4];
  #pragma unroll
  for(int d0=0;d0<4;++d0)qr[d0]=*reinterpret_cast<const bf16x8*>(&Qw[(long)r32*DM+d0*16+hi*8]);
#if ATTN_QLDS
  const lds_cptr qst=shm3+LDS_OST+wid*4096+r32*128;
  #pragma unroll
  for(int d0=0;d0<4;++d0)*(__attribute__((address_space(3))) bf16x8*)(shm3+LDS_OST+wid*4096+r32*128+(((2*d0+hi)^(r32&7))<<4))=qr[d0];
  #define QF(d) (*(const __attribute__((address_space(3))) bf16x8*)(qst+(((2*(d)+hi)^(r32&7))<<4)))
#else
  #define QF(d) qr[d]
#endif
  float mhat=0.f,l_reg=0.f;f32x16 o[4]; { float z_=0.f; asm volatile("":"+v"(z_));
    _Pragma("unroll") for(int r=0;r<16;++r){o[0][r]=z_;o[1][r]=z_;o[2][r]=z_;o[3][r]=z_;} }
  const int qrel=wid*QBLK+r32;
  #define CMASK(P0,P1,t) do{int jb_=(t)-(NT-4); if(jb_>=-2 && (wid*QBLK-(64*jb_+63))<128)cbias(P0,P1,jb_,qrel,hi,bt);}while(0)
  bool resc=false;
  #define START(P0,P1) do{ const float rm=rowmax(P0,P1); resc=false; \
    { const float dl=rm; mhat=fadd_s(mhat,dl); \
      _Pragma("unroll") for(int r=0;r<16;++r){P0[r]=fsub_s(P0[r],dl);P1[r]=fsub_s(P1[r],dl);} } \
    _Pragma("unroll") for(int r=0;r<16;++r)P0[r]=__builtin_amdgcn_exp2f(P0[r]); }while(0)
  #define RESC() do{ if(resc){ asm volatile("s_waitcnt lgkmcnt(0)":::"memory"); \
      _Pragma("unroll") for(int d_=0;d_<4;++d_) _Pragma("unroll") for(int r=0;r<16;++r)o[d_][r]*=wsf[crow(r,hi)]; } }while(0)
  f32x16 pA0,pA1,pB0,pB1;
  int sl_prev=0,sl_cur=0,sl_next=SLOTB;
  #define ROT() do{sl_prev=sl_cur;sl_cur=sl_next;sl_next=(sl_next==(NSLOT-1)*SLOTB)?0:sl_next+SLOTB;}while(0)
  DMA_K(2,2*SLOTB);
  WAIT_BAR(4);
  qkt(pA0,pA1,Kbase,qr,f32x16{},r32,hi);asm volatile("s_nop 15\n\ts_nop 7":"+v"(pA0),"+v"(pA1));CMASK(pA0,pA1,0);
  START(pA0,pA1);
  _Pragma("unroll") for(int r=0;r<16;++r)pA1[r]=__builtin_amdgcn_exp2f(pA1[r]);
  WAIT_BAR(0);
  DMA_K(3,0);DMA_V(1,SLOTB);
  ROT();
  kload8(kf,kp0+sl_cur);
  WAIT_BAR(3);
  s16x4 vlo[8],vhi[8]; u32x4 pw0,pw1,pw2,pw3;
  #define PKW(P,B) cvtpk_s(P[B],P[B+1])
  #define PAF(k) __builtin_bit_cast(bf16x8,pw##k)
  #define VFR(i) (bf16x8){vlo[i][0],vlo[i][1],vlo[i][2],vlo[i][3],vhi[i][0],vhi[i][1],vhi[i][2],vhi[i][3]}
  #define PIN(x) asm volatile("":"+v"(x))
  #define MX3(a,b,c) __builtin_fmaxf(__builtin_fmaxf((a),(b)),(c))
  #define GAPA(MF,A0,A1,A2,A3,W0,W1,PW) do{ MF; sacc+=A0; sacc+=A1; sacc+=A2; sacc+=A3; PIN(sacc); W0; W1; PIN(PW); SBAR(); }while(0)
  #define EX(v) __builtin_amdgcn_exp2f(v)
  #define GAPB(MF,X,B) do{ MF; X[B]=EX(X[B]); X[B+1]=EX(X[B+1]); X[B+2]=EX(X[B+2]); X[B+3]=EX(X[B+3]); PIN(X); SBAR(); }while(0)
  #define GAPB2(MF,X,B) do{ MF; X[B]=EX(X[B]); X[B+1]=EX(X[B+1]); PIN(X); SBAR(); }while(0)
  #define VRD2(i) do{ vlo[i]=vtr(vp_+((2+((i)>>2))*4096+((i)&3)*1024)); vhi[i]=vtr(vp_+((2+((i)>>2))*4096+((i)&3)*1024+512)); SBAR(); }while(0)
  #define VRD(i) do{ vlo[i]=vtr(vp_+(((i)>>2)*4096+((i)&3)*1024)); vhi[i]=vtr(vp_+(((i)>>2)*4096+((i)&3)*1024+512)); }while(0)
  #define KRD(G,j) do{ if(G){ kload2(kf,kp0+sl_next,j); SBAR(); } }while(0)
  #define STEP(C0,C1,P0,P1,t,GK,GV,GL) do{ SBAR(); \
    const lds_cptr vp_=vp0+2*sl_prev; \
    VRD(0); SBAR(); float sacc=(P0[0]+P0[1]); \
    GAPA(C0=__builtin_amdgcn_mfma_f32_32x32x16_bf16(kf[0],QF(0),f32x16{},0,0,0), P0[2],P0[3],P0[4],P0[5],     pw0[0]=PKW(P0,0), pw0[1]=PKW(P0,2), pw0); \
    VRD(4); SBAR(); GAPA(C1=__builtin_amdgcn_mfma_f32_32x32x16_bf16(kf[1],QF(0),f32x16{},0,0,0), P0[6],P0[7],P0[8],P0[9],     pw0[2]=PKW(P0,4), pw0[3]=PKW(P0,6), pw0); \
    VRD(1); SBAR(); GAPA(C0=__builtin_amdgcn_mfma_f32_32x32x16_bf16(kf[2],QF(1),C0,0,0,0),   P0[10],P0[11],P0[12],P0[13], pw1[0]=PKW(P0,8), pw1[1]=PKW(P0,10), pw1); \
    VRD(5); SBAR(); GAPA(C1=__builtin_amdgcn_mfma_f32_32x32x16_bf16(kf[3],QF(1),C1,0,0,0),   P0[14],P0[15],P1[0],P1[1],   pw1[2]=PKW(P0,12),pw1[3]=PKW(P0,14), pw1); \
    VRD(2); SBAR(); GAPA(C0=__builtin_amdgcn_mfma_f32_32x32x16_bf16(kf[4],QF(2),C0,0,0,0),   P1[2],P1[3],P1[4],P1[5],     pw2[0]=PKW(P1,0), pw2[1]=PKW(P1,2), pw2); \
    VRD(6); SBAR(); GAPA(C1=__builtin_amdgcn_mfma_f32_32x32x16_bf16(kf[5],QF(2),C1,0,0,0),   P1[6],P1[7],P1[8],P1[9],     pw2[2]=PKW(P1,4), pw2[3]=PKW(P1,6), pw2); \
    VRD(3); SBAR(); GAPA(C0=__builtin_amdgcn_mfma_f32_32x32x16_bf16(kf[6],QF(3),C0,0,0,0),   P1[10],P1[11],P1[12],P1[13], pw3[0]=PKW(P1,8), pw3[1]=PKW(P1,10), pw3); \
    VRD(7); SBAR(); GAPA(C1=__builtin_amdgcn_mfma_f32_32x32x16_bf16(kf[7],QF(3),C1,0,0,0),   P1[14],P1[15],0.f,0.f,       pw3[2]=PKW(P1,12),pw3[3]=PKW(P1,14), pw3); \
    l_reg+=sacc; \
    if(GK){DMA_K((t)+3,sl_cur);} if(GV){DMA_V((t)+1,sl_next);} \
    _Pragma("unroll") for(int r=0;r<16;++r){C0[r]-=mhat;C1[r]-=mhat;} \
    SBAR(); CMASK(C0,C1,t); SBAR(); \
    { float a=MX3(C0[0],C0[1],C1[0]),b=MX3(C0[2],C0[3],C1[1]); a=MX3(a,C1[2],C1[3]); \
      _Pragma("unroll") for(int r=4;r<16;r+=4){a=MX3(a,C0[r],C0[r+1]);b=MX3(b,C0[r+2],C0[r+3]);a=MX3(a,C1[r],C1[r+1]);b=MX3(b,C1[r+2],C1[r+3]);} \
      float rm=__builtin_fmaxf(a,b); { auto rr=__builtin_amdgcn_permlane32_swap(__float_as_uint(rm),__float_as_uint(rm),false,false); rm=__builtin_fmaxf(__uint_as_float(rr[0]),__uint_as_float(rr[1])); } \
      resc=false; \
      if(__builtin_expect(__any(rm>(float)THRL),0)){ const float dl=__builtin_fmaxf(rm,0.f); mhat+=dl; \
        _Pragma("unroll") for(int r=0;r<16;++r){C0[r]-=dl;C1[r]-=dl;} \
        const float f=__builtin_amdgcn_exp2f(-dl); l_reg*=f; if(hi==0)wsf[r32]=f; resc=true; } } \
    SBAR(); \
    GAPB2(o[0]=__builtin_amdgcn_mfma_f32_32x32x16_bf16(PAF(0),VFR(0),o[0],0,0,0), C0,0);  VRD2(0); \
    GAPB2(o[1]=__builtin_amdgcn_mfma_f32_32x32x16_bf16(PAF(0),VFR(4),o[1],0,0,0), C0,2);  VRD2(4); \
    GAPB2(o[0]=__builtin_amdgcn_mfma_f32_32x32x16_bf16(PAF(1),VFR(1),o[0],0,0,0), C0,4);  VRD2(1); \
    GAPB2(o[1]=__builtin_amdgcn_mfma_f32_32x32x16_bf16(PAF(1),VFR(5),o[1],0,0,0), C0,6);  VRD2(5); \
    GAPB2(o[0]=__builtin_amdgcn_mfma_f32_32x32x16_bf16(PAF(2),VFR(2),o[0],0,0,0), C0,8);  VRD2(2); \
    GAPB2(o[1]=__builtin_amdgcn_mfma_f32_32x32x16_bf16(PAF(2),VFR(6),o[1],0,0,0), C0,10); VRD2(6); \
    GAPB2(o[0]=__builtin_amdgcn_mfma_f32_32x32x16_bf16(PAF(3),VFR(3),o[0],0,0,0), C0,12); VRD2(3); \
    GAPB2(o[1]=__builtin_amdgcn_mfma_f32_32x32x16_bf16(PAF(3),VFR(7),o[1],0,0,0), C0,14); VRD2(7); \
    GAPB2(o[2]=__builtin_amdgcn_mfma_f32_32x32x16_bf16(PAF(0),VFR(0),o[2],0,0,0), C1,0); \
    GAPB2(o[3]=__builtin_amdgcn_mfma_f32_32x32x16_bf16(PAF(0),VFR(4),o[3],0,0,0), C1,2); \
    KRD(GL,0); GAPB2(o[2]=__builtin_amdgcn_mfma_f32_32x32x16_bf16(PAF(1),VFR(1),o[2],0,0,0), C1,4); \
    GAPB2(o[3]=__builtin_amdgcn_mfma_f32_32x32x16_bf16(PAF(1),VFR(5),o[3],0,0,0), C1,6); \
    KRD(GL,1); GAPB2(o[2]=__builtin_amdgcn_mfma_f32_32x32x16_bf16(PAF(2),VFR(2),o[2],0,0,0), C1,8); \
    GAPB2(o[3]=__builtin_amdgcn_mfma_f32_32x32x16_bf16(PAF(2),VFR(6),o[3],0,0,0), C1,10); \
    KRD(GL,2); GAPB2(o[2]=__builtin_amdgcn_mfma_f32_32x32x16_bf16(PAF(3),VFR(3),o[2],0,0,0), C1,12); \
    GAPB2(o[3]=__builtin_amdgcn_mfma_f32_32x32x16_bf16(PAF(3),VFR(7),o[3],0,0,0), C1,14); \
    KRD(GL,3); \
    }while(0)
  int t=1;
  #undef CMASK
  #define CMASK(P0,P1,t) do{}while(0)
  for(;t+7<NT;t+=2){
    STEP(pB0,pB1,pA0,pA1,t,true,true,true);     WAIT_BAR(3); RESC(); ROT();
    STEP(pA0,pA1,pB0,pB1,t+1,true,true,true);   WAIT_BAR(3); RESC(); ROT();
  }
  #undef CMASK
  int tb_=threadIdx.x; asm volatile("":"+v"(tb_)); const int qrel_b=(tb_>>6)*QBLK+(tb_&31),hi_b=(tb_&63)>>5;
  #define CMASK(P0,P1,t) do{int jb_=(t)-(NT-4); if(jb_>=-2 && (wid*QBLK-(64*jb_+63))<128)cbias(P0,P1,jb_,qrel_b,hi_b,bt);}while(0)
  #define ENDW(tt) do{ if((tt)+3<NT){WAIT_BAR(3);} else if((tt)+2<NT){WAIT_BAR(2);} else {WAIT_BAR(0);} }while(0)
  for(;t+1<NT;t+=2){
    STEP(pB0,pB1,pA0,pA1,t,(t+3<NT),(t+1<NT),(t+1<NT));       ENDW(t);   RESC(); ROT();
    STEP(pA0,pA1,pB0,pB1,t+1,(t+4<NT),(t+2<NT),(t+2<NT));     ENDW(t+1); RESC(); ROT();
  }
  STEP(pB0,pB1,pA0,pA1,NT-1,false,false,false); RESC();
  { float sacc=pB0[0]+pB0[1]; _Pragma("unroll") for(int r=2;r<16;++r)sacc+=pB0[r]; _Pragma("unroll") for(int r=0;r<16;++r)sacc+=pB1[r]; l_reg+=sacc;
    pw0=(u32x4){PKW(pB0,0),PKW(pB0,2),PKW(pB0,4),PKW(pB0,6)};pw1=(u32x4){PKW(pB0,8),PKW(pB0,10),PKW(pB0,12),PKW(pB0,14)};pw2=(u32x4){PKW(pB1,0),PKW(pB1,2),PKW(pB1,4),PKW(pB1,6)};pw3=(u32x4){PKW(pB1,8),PKW(pB1,10),PKW(pB1,12),PKW(pB1,14)};
    SBAR(); { int td_=threadIdx.x; asm volatile("":"+v"(td_)); const int ld_=td_&63; const int vb0=(int)((unsigned)(uintptr_t)shm+LDS_V)+((ld_>>4)&1)*32+(ld_&3)*8+(4*(ld_>>5)+((ld_&15)>>2))*64;
      pv(o,vb0+2*sl_cur,PAF(0),PAF(1),PAF(2),PAF(3)); } }
  #undef PKW
  #undef PAF
  #undef VFR
  #undef PIN
  #undef MX3
  #undef GAPA
  #undef GAPB
  #undef GAPB2
  #undef VRD2
  #undef EX
  #undef VRD
  #undef KRD
  #undef STEP
  #undef ENDW
  { int te_=threadIdx.x; asm volatile("":"+v"(te_)); const int lane_e=te_&63,r32e=lane_e&31,hie=lane_e>>5; const int wide=__builtin_amdgcn_readfirstlane(te_>>6);
  float*wsfe=(float*)(shm+LDS_WS)+wide*64;
  {auto rr=__builtin_amdgcn_permlane32_swap(__float_as_uint(l_reg),__float_as_uint(l_reg),false,false);l_reg=__uint_as_float(rr[0])+__uint_as_float(rr[1]);}
  if(hie==0)wsfe[32+r32e]=l_reg;asm volatile("s_waitcnt lgkmcnt(0)":::"memory");
  float rli[16];
  #pragma unroll
  for(int r=0;r<16;++r)rli[r]=__builtin_amdgcn_rcpf(wsfe[32+crow(r,hie)]);
  bf16*Ow=O+((long)b*SEQ+qb*QB+wide*QBLK)*DM+oc;
  { bf16*stg=(bf16*)(shm+LDS_OST)+wide*2048;
    #pragma unroll
    for(int hf=0;hf<2;++hf){
      #pragma unroll
      for(int r=0;r<16;++r){const int orow=crow(r,hie);
        #pragma unroll
        for(int d0=0;d0<2;++d0)stg[orow*64+d0*32+r32e]=__float2bfloat16(o[2*hf+d0][r]*rli[r]);}
      asm volatile("s_waitcnt lgkmcnt(0)":::"memory");
      #pragma unroll
      for(int i=0;i<4;++i){const int row=i*8+(lane_e>>3),ch=lane_e&7; const u32x4 v=*(const u32x4*)(stg+row*64+ch*8); ATTN_STORE16(Ow+(long)row*DM+hf*64+ch*8,v);}
      asm volatile("s_waitcnt lgkmcnt(0)":::"memory"); } } }
  asm volatile("s_waitcnt lgkmcnt(0)\n\ts_barrier":::"memory");
  #undef DMA_K
  #undef DMA_V
  #undef CMASK
  #undef START
  #undef RESC
  #undef ROT
  #undef QF
}
constexpr int ATTN_LDS_BYTES=LDS_BYTES;
#undef SBAR
#undef WAIT_BAR
}
#define XROW(m0) ((C.G == 256) ? (((gw >> 8) << 11) + (gw & 255) + (((m0) - gw) >> 11) * 256) : (m0))
struct Ctx {
    LAS unsigned char* lds; char* ldsg; int tid, lane, wave, G, vcu;
    const float* in[23]; float* out; unsigned char* ws;
};
#define WSP(T, off) ((T*)(C.ws + (off)))
#define PHASE_IDS() Ctx C = C0; { int t_ = threadIdx.x; asm volatile("" : "+v"(t_)); C.tid = t_; C.lane = t_ & 63; C.wave = __builtin_amdgcn_readfirstlane(t_ >> 6); }

struct ConvDesc { const float* src; bf16_t* dst; int N, K; };
__device__ __forceinline__ ConvDesc conv_desc(const Ctx& C, int it) {
    constexpr int I_IN = 16 * 160, I_BR = 8 * 32, I_GU1 = 16 * 64, I_GU = NE * I_GU1, I_D1 = 16 * 32, I_D = NE * I_D1;
    const float* W; bf16_t* WT; int K, N, kb, nb, orow; int r = it;
    if (r < I_GU) { const int e = r / I_GU1, q = r % I_GU1; kb = q / 64; nb = q % 64; const int n0 = 32 * nb, half = n0 >> 10, rem = n0 & 1023;
        W = C.in[18] + (size_t)e * 1024 * 2048; WT = WSP(bf16_t, WS_WGU) + (size_t)e * 2048 * 1024; K = 1024; N = 2048; orow = (rem >> 7) * 256 + half * 128 + (rem & 127); }
    else if ((r -= I_GU) < I_D) { const int e = r / I_D1, q = r % I_D1; kb = q / 32; nb = q % 32; W = C.in[20] + (size_t)e * 1024 * 1024; WT = WSP(bf16_t, WS_WD) + (size_t)e * 1024 * 1024; K = 1024; N = 1024; orow = 32 * nb; }
    else if ((r -= I_D) < I_IN) { kb = r / 160; nb = r % 160; W = C.in[6]; WT = WSP(bf16_t, WS_WIN); K = 1024; N = INW; orow = 32 * nb; }
    else if ((r -= I_IN) < I_BR) { kb = r / 32; nb = r % 32; W = C.in[12]; WT = WSP(bf16_t, WS_WBR); K = 1024; N = 1024; orow = 32 * nb; }
    else if ((r -= I_BR) < I_BR) { kb = r / 32; nb = r % 32; W = C.in[13]; WT = WSP(bf16_t, WS_WBR) + 512; K = 1024; N = 1024; orow = 32 * nb; }
    else { r -= I_BR; kb = r / 32; nb = r % 32; W = C.in[14]; WT = WSP(bf16_t, WS_WOUT); K = 1024; N = 1024; orow = 32 * nb; }
    ConvDesc d; d.src = W + (size_t)(64 * kb) * N + 32 * nb; d.dst = WT + (size_t)orow * K + 64 * kb; d.N = N; d.K = K; return d;
}
__device__ __forceinline__ void conv_load(const ConvDesc& d, f32x4 (&v)[8], int lane) {
    const int kr = lane >> 3, nc = lane & 7;
#pragma unroll
    for (int i = 0; i < 8; ++i) v[i] = *(const f32x4*)(d.src + (size_t)(8 * i + kr) * d.N + 4 * nc);
}
__device__ __forceinline__ void conv_finish(const ConvDesc& d, const f32x4 (&v)[8], LAS float* scr, int lane) {
    const int kr = lane >> 3, nc = lane & 7;
#pragma unroll
    for (int i = 0; i < 8; ++i) { LAS float* s = scr + (8 * i + kr) * 33 + 4 * nc; s[0] = v[i][0]; s[1] = v[i][1]; s[2] = v[i][2]; s[3] = v[i][3]; }
    LDS_WAIT(); asm volatile("" ::: "memory");
    const int c = lane & 7;
#pragma unroll
    for (int j = 0; j < 4; ++j) { const int n = (lane >> 3) + 8 * j; const LAS float* s = scr + (8 * c) * 33 + n;
        u32x4 o; o.x = cvt_pk_bf16(s[0 * 33], s[1 * 33]); o.y = cvt_pk_bf16(s[2 * 33], s[3 * 33]); o.z = cvt_pk_bf16(s[4 * 33], s[5 * 33]); o.w = cvt_pk_bf16(s[6 * 33], s[7 * 33]);
        *(u32x4*)(d.dst + (size_t)n * d.K + 8 * c) = o; }
    LDS_WAIT(); asm volatile("" ::: "memory");
}
__device__ __forceinline__ void conv_range(const Ctx& C, int lo, int hi, int wi, int nw, LAS float* scr) {
    const int first = lo + wi;
    if (first < hi) {
        ConvDesc d0 = conv_desc(C, first), d1 = d0; f32x4 v0[8], v1[8]; conv_load(d0, v0, C.lane);
        for (int it = first; it < hi; it += 2 * nw) {
            const int n1 = it + nw, n2 = it + 2 * nw;
            d1 = conv_desc(C, n1 < hi ? n1 : it); conv_load(d1, v1, C.lane);
            conv_finish(d0, v0, scr, C.lane);
            if (n1 >= hi) break;
            d0 = conv_desc(C, n2 < hi ? n2 : it); conv_load(d0, v0, C.lane);
            conv_finish(d1, v1, scr, C.lane);
        }
    }
}
template <int MODE> __device__ __noinline__ void conv_q_blocks(const float* Wgu, unsigned char* ws, LAS unsigned char* lds, int wave, int first, int stride) {
    int lane_ = (int)__builtin_amdgcn_mbcnt_hi(~0u, __builtin_amdgcn_mbcnt_lo(~0u, 0u)); asm volatile("" : "+v"(lane_));
    const int lane = lane_, tid = wave * 64 + lane, lr = tid >> 3, c4 = tid & 7, n = tid & 31, kg = tid >> 5;
    LAS float* blk = (LAS float*)lds;
    LAS float* wmx = (LAS float*)(lds + LDSCTL_OFF + 14336);
    f32x4 v[16];
    constexpr int NBLK = MODE == 0 ? NE * 64 : 128, LDW = MODE == 0 ? 2048 : INW;
#define QB_SRC(b_) (MODE == 0 ? Wgu + (size_t)((b_) >> 6) * 1024 * 2048 + 32 * ((b_) & 63) : Wgu + 32 * ((b_) < 48 ? (b_) : (b_) + 32))
    if (first < NBLK) { const float* W = QB_SRC(first) + 4 * c4 + (size_t)lr * LDW;
#pragma unroll
        for (int i = 0; i < 16; ++i) v[i] = *(const f32x4*)(W + (size_t)(64 * i) * LDW); }
    for (int bk = first; bk < NBLK; bk += stride) { const int e = MODE == 0 ? bk >> 6 : 0, n0 = MODE == 0 ? 32 * (bk & 63) : 32 * (bk < 48 ? bk : bk + 32), hgu = n0 >> 10, rem = n0 & 1023, orow = MODE == 0 ? (rem >> 7) * 256 + hgu * 128 + (rem & 127) : n0;
        f32x4 mx = (f32x4){0.f, 0.f, 0.f, 0.f};
#pragma unroll
        for (int i = 0; i < 16; ++i) { *(LAS f32x4*)(blk + (64 * i + lr) * 32 + 4 * c4) = v[i]; mx = __builtin_elementwise_max(mx, __builtin_elementwise_abs(v[i])); }
#pragma unroll
        for (int j = 0; j < 4; ++j) { float t = mx[j]; t = fmaxf(t, __shfl_xor(t, 8)); t = fmaxf(t, __shfl_xor(t, 16)); t = fmaxf(t, __shfl_xor(t, 32)); mx[j] = t; }
        if (lane < 8) *(LAS f32x4*)(wmx + wave * 32 + 4 * lane) = mx;
        { const int nk = bk + stride < NBLK ? bk + stride : bk;
          const float* W = QB_SRC(nk) + 4 * c4 + (size_t)lr * LDW;
#pragma unroll
          for (int i = 0; i < 16; ++i) v[i] = *(const f32x4*)(W + (size_t)(64 * i) * LDW); }
        LDS_WAIT(); __builtin_amdgcn_s_barrier(); asm volatile("" ::: "memory");
        float cm = wmx[n];
#pragma unroll
        for (int w = 1; w < 8; ++w) cm = fmaxf(cm, wmx[w * 32 + n]);
        const float inv = cm > 0.f ? 127.0f / cm : 0.f;
        if (kg == 0) ((float*)(ws + (MODE == 0 ? WS_SW : WS_SWIN)))[(size_t)e * 2048 + n0 + n] = cm > 0.f ? cm * (1.0f / 127.0f) : 1.0f;
        signed char* dst = (signed char*)(ws + (MODE == 0 ? WS_WGU : WS_WINQ)) + ((size_t)e * 2048 + orow + n) * 1024 + 64 * kg;
        const LAS float* src = blk + (64 * kg) * 32 + n;
#pragma unroll
        for (int s = 0; s < 4; ++s) { unsigned w4[4];
#pragma unroll
            for (int d = 0; d < 4; ++d) { int b[4];
#pragma unroll
                for (int k = 0; k < 4; ++k) b[k] = (int)fminf(fmaxf(__builtin_rintf(src[(16 * s + 4 * d + k) * 32] * inv), -127.0f), 127.0f);
                w4[d] = (unsigned)(b[0] & 255) | ((unsigned)(b[1] & 255) << 8) | ((unsigned)(b[2] & 255) << 16) | ((unsigned)b[3] << 24); }
            *(u32x4*)(dst + 16 * s) = (u32x4){w4[0], w4[1], w4[2], w4[3]}; }
        LDS_WAIT(); __builtin_amdgcn_s_barrier(); asm volatile("" ::: "memory");
    }
}
#undef QB_SRC
constexpr int CONV_MOE_ITEMS = NE * 16 * 64 + NE * 16 * 32;
constexpr int CONV_ALL_ITEMS = CONV_MOE_ITEMS + 16 * 160 + 2 * 8 * 32 + 16 * 32;
#ifndef NCONV_
#define NCONV_ 13
#endif
constexpr int NCONV = NCONV_;
__device__ __forceinline__ void p0_prologue(const Ctx& C0) {
    PHASE_IDS();
    LAS float* scr = (LAS float*)(C.lds + C.wave * 8448);
    const int gw = C.vcu * NWAVES + C.wave, NGW = C.G * NWAVES;
    conv_q_blocks<1>(C.in[6], C.ws, C.lds, C.wave, (int)blockIdx.x, C.G);
    __syncthreads();
    for (int it = gw; it < 16 * 32; it += NGW) { const int kb = it >> 5, nb = 48 + (it & 31);
        ConvDesc d; d.src = C.in[6] + (size_t)(64 * kb) * INW + 32 * nb; d.dst = WSP(bf16_t, WS_WIN) + (size_t)(32 * nb) * 1024 + 64 * kb; d.N = INW; d.K = 1024;
        f32x4 v[8]; conv_load(d, v, C.lane); conv_finish(d, v, scr, C.lane); }
    conv_range(C, CONV_MOE_ITEMS + 16 * 160, CONV_ALL_ITEMS, gw, NGW, scr);
    const float* cvec = C.in[1]; const float* wada = C.in[3]; float* adap = WSP(float, WS_ADAP);
    for (int it = gw; it < 96 * 16; it += NGW) { const int cc = it % 96, ks = it / 96; const int n = 64 * cc + C.lane; float a0 = 0.f, a1 = 0.f;
#pragma unroll 16
        for (int k = 0; k < 64; ++k) { const int kk = 64 * ks + k; const float w = wada[(size_t)kk * 6144 + n]; a0 += cvec[kk] * w; a1 += cvec[1024 + kk] * w; }
        adap[(ks * 2 + 0) * 6144 + n] = a0; adap[(ks * 2 + 1) * 6144 + n] = a1; }
}
__device__ __forceinline__ float ada_val(const Ctx& C, int b, int n) {
    const float* adap = WSP(const float, WS_ADAP); float s = C.in[4][n];
#pragma unroll
    for (int ks = 0; ks < 16; ++ks) s += adap[(ks * 2 + b) * 6144 + n];
    return s;
}
__device__ __forceinline__ void rms_mod_row(const float* xrow, bf16_t* orow, const LAS float* MA, const LAS float* MB, int lane, signed char* qrow, float* qscale) {
    const f32x4* xr = (const f32x4*)xrow + lane;
    f32x4 v[4]; float s = 0.f;
#pragma unroll
    for (int j = 0; j < 4; ++j) { v[j] = xr[64 * j]; s += (v[j][0] * v[j][0] + v[j][1] * v[j][1]) + (v[j][2] * v[j][2] + v[j][3] * v[j][3]); }
    const float rstd = 1.0f / sqrtf(wave_sum(s) * (1.0f / D) + RMS_EPS);
    u32x2* o8 = (u32x2*)orow + lane;
#pragma unroll
    for (int j = 0; j < 4; ++j) { const f32x4 a = *(const LAS f32x4*)(MA + 4 * lane + 256 * j), b = *(const LAS f32x4*)(MB + 4 * lane + 256 * j);
        const f32x4 h = v[j] * rstd * a + b; u32x2 w; w.x = pk2(h[0], h[1]); w.y = pk2(h[2], h[3]); o8[64 * j] = w; v[j] = h; }
    if (qrow) {
        float am = 0.f;
#pragma unroll
        for (int j = 0; j < 4; ++j)
#pragma unroll
            for (int k = 0; k < 4; ++k) am = fmaxf(am, fabsf(v[j][k]));
#pragma unroll
        for (int o = 1; o < 64; o <<= 1) am = fmaxf(am, __shfl_xor(am, o));
        const float inv = am > 0.f ? 127.0f / am : 0.f;
        if (lane == 0) *qscale = am > 0.f ? am * (1.0f / 127.0f) : 1.0f;
#pragma unroll
        for (int j = 0; j < 4; ++j) { int b4[4];
#pragma unroll
            for (int k = 0; k < 4; ++k) b4[k] = (int)fminf(fmaxf(__builtin_rintf(v[j][k] * inv), -127.0f), 127.0f);
            ((unsigned*)qrow)[lane + 64 * j] = (unsigned)(b4[0] & 255) | ((unsigned)(b4[1] & 255) << 8) | ((unsigned)(b4[2] & 255) << 16) | ((unsigned)b4[3] << 24); } }
}
__device__ __forceinline__ void rms_mod_row_bf16(const bf16_t* xrow, bf16_t* orow, const LAS float* MA, const LAS float* MB, int lane, signed char* qrow, float* qscale) {
    float v[16]; float s = 0.f;
#pragma unroll
    for (int j = 0; j < 2; ++j) { const u32x4 w = *(const u32x4*)(xrow + 512 * j + 8 * lane);
        v[8 * j + 0] = bf_lo(w.x); v[8 * j + 1] = bf_hi(w.x); v[8 * j + 2] = bf_lo(w.y); v[8 * j + 3] = bf_hi(w.y); v[8 * j + 4] = bf_lo(w.z); v[8 * j + 5] = bf_hi(w.z); v[8 * j + 6] = bf_lo(w.w); v[8 * j + 7] = bf_hi(w.w); }
#pragma unroll
    for (int k = 0; k < 16; ++k) s += v[k] * v[k];
    const float rstd = 1.0f / sqrtf(wave_sum(s) * (1.0f / D) + RMS_EPS);
#pragma unroll
    for (int j = 0; j < 2; ++j) { const LAS float* a = MA + 512 * j + 8 * lane; const LAS float* b = MB + 512 * j + 8 * lane;
        const f32x4 a0 = *(const LAS f32x4*)a, a1 = *(const LAS f32x4*)(a + 4), b0 = *(const LAS f32x4*)b, b1 = *(const LAS f32x4*)(b + 4);
        u32x4 w; w.x = pk2(v[8 * j + 0] * rstd * a0[0] + b0[0], v[8 * j + 1] * rstd * a0[1] + b0[1]); w.y = pk2(v[8 * j + 2] * rstd * a0[2] + b0[2], v[8 * j + 3] * rstd * a0[3] + b0[3]);
        w.z = pk2(v[8 * j + 4] * rstd * a1[0] + b1[0], v[8 * j + 5] * rstd * a1[1] + b1[1]); w.w = pk2(v[8 * j + 6] * rstd * a1[2] + b1[2], v[8 * j + 7] * rstd * a1[3] + b1[3]);
        *(u32x4*)(orow + 512 * j + 8 * lane) = w; }
    if (qrow) {
        float hq[16]; float am = 0.f;
#pragma unroll
        for (int j = 0; j < 2; ++j) { const LAS float* a = MA + 512 * j + 8 * lane; const LAS float* b = MB + 512 * j + 8 * lane;
#pragma unroll
            for (int k = 0; k < 8; ++k) { hq[8 * j + k] = v[8 * j + k] * rstd * a[k] + b[k]; am = fmaxf(am, fabsf(hq[8 * j + k])); } }
#pragma unroll
        for (int o = 1; o < 64; o <<= 1) am = fmaxf(am, __shfl_xor(am, o));
        const float inv = am > 0.f ? 127.0f / am : 0.f;
        if (lane == 0) *qscale = am > 0.f ? am * (1.0f / 127.0f) : 1.0f;
#pragma unroll
        for (int j = 0; j < 2; ++j) { unsigned w2[2];
#pragma unroll
            for (int d = 0; d < 2; ++d) { int b4[4];
#pragma unroll
                for (int k = 0; k < 4; ++k) b4[k] = (int)fminf(fmaxf(__builtin_rintf(hq[8 * j + 4 * d + k] * inv), -127.0f), 127.0f);
                w2[d] = (unsigned)(b4[0] & 255) | ((unsigned)(b4[1] & 255) << 8) | ((unsigned)(b4[2] & 255) << 16) | ((unsigned)b4[3] << 24); }
            *(u32x2*)(qrow + 512 * j + 8 * lane) = (u32x2){w2[0], w2[1]}; } }
}
__device__ __forceinline__ void p1_h1(const Ctx& C0) {
    PHASE_IDS();
    LAS float* MA = (LAS float*)C.lds;
    LAS float* MB = MA + 2048;
    for (int idx = C.tid; idx < 2048; idx += 512) { const int b = idx >> 10, col = idx & 1023;
        const float sh = ada_val(C, b, col), sc = ada_val(C, b, 1024 + col);
        MA[idx] = C.in[5][col] * (1.0f + sc); MB[idx] = sh; }
    if (blockIdx.x < NE) { const int e = blockIdx.x; bf16_t* wrt = WSP(bf16_t, WS_WRT) + (size_t)e * 1024;
        for (int k = C.tid; k < 1024; k += 512) wrt[k] = (bf16_t)f2bf(C.in[16][(size_t)k * 32 + e]); }
    {
        const int per = (2 * 6144 + C.G - 1) / C.G;
        for (int i = C.tid; i < per; i += 512) { const int idx = blockIdx.x * per + i; if (idx < 2 * 6144) WSP(float, WS_ADAF)[idx] = ada_val(C, idx / 6144, idx % 6144); }
    }
    __syncthreads();
    const int gw = C.vcu * NWAVES + C.wave, NGW = C.G * NWAVES;
    for (int m0 = gw; m0 < M; m0 += NGW) { const int m = XROW(m0); const int b = m >= SEQ; rms_mod_row(C.in[0] + (size_t)m * D, WSP(bf16_t, WS_H) + (size_t)m * D, MA + b * 1024, MB + b * 1024, C.lane, (signed char*)(C.ws + WS_H2Q) + (size_t)m * D, WSP(float, WS_SA) + m); }
    __syncthreads();
}
__device__ __forceinline__ void p3a_kmean(const Ctx& C0) {
    PHASE_IDS();
    LAS float* red = (LAS float*)C.lds;
    const bf16_t* kb = WSP(const bf16_t, WS_PROJ + 2 * PROJ_STRIDE);
    for (int it = blockIdx.x; it < 64; it += C.G) { const int b = it >> 5, n = it & 31;
        float a[8];
#pragma unroll
        for (int j = 0; j < 8; ++j) a[j] = 0.f;
        const bf16_t* src = kb + (size_t)(b * SEQ + 256 * n + 32 * C.wave) * 1024 + 8 * C.lane;
#pragma unroll 8
        for (int r = 0; r < 32; ++r) { const u32x4 v = *(const u32x4*)(src + (size_t)r * 1024);
            a[0] += bf_lo(v.x); a[1] += bf_hi(v.x); a[2] += bf_lo(v.y); a[3] += bf_hi(v.y); a[4] += bf_lo(v.z); a[5] += bf_hi(v.z); a[6] += bf_lo(v.w); a[7] += bf_hi(v.w); }
        __syncthreads();
#pragma unroll
        for (int j = 0; j < 8; ++j) red[C.wave * 512 + 8 * C.lane + j] = a[j];
        __syncthreads();
        { const int col = C.tid; float s = 0.f;
#pragma unroll
            for (int w = 0; w < 8; ++w) s += red[w * 512 + col];
            const int h = col >> 6, d = col & 63; WSP(float, WS_KMEAN)[((b * 8 + h) * 32 + n) * 64 + d] = s * (1.0f / 256.0f); }
    }
    __syncthreads();
}
__device__ __forceinline__ void p3b_gate(const Ctx& C0) {
    PHASE_IDS();
    LAS float* km = (LAS float*)C.lds;
    const bf16_t* qb = WSP(const bf16_t, WS_PROJ + 1 * PROJ_STRIDE) + 512;
    unsigned* cnt = WSP(unsigned, WS_CTL) + CW_MCNT; unsigned* list = WSP(unsigned, WS_LIST);
    for (int it = blockIdx.x; it < 256; it += C.G) { const int bh = it >> 4, qc = it & 15, b = bh >> 3, h = bh & 7;
        __syncthreads();
        for (int i = C.tid; i < 2048; i += 512) km[i] = WSP(const float, WS_KMEAN)[bh * 2048 + i];
        __syncthreads();
        const int q = 512 * qc + C.tid, own = q >> 8;
        u32x4 qv[8];
        { const u32x4* qp = (const u32x4*)(qb + (size_t)(b * SEQ + q) * 1024 + h * 64);
#pragma unroll
            for (int j = 0; j < 8; ++j) qv[j] = qp[j]; }
        float v0 = -INFINITY, v1 = -INFINITY, v2 = -INFINITY; int i0 = 0, i1 = 0, i2 = 0;
        const int nmax = ((512 * qc + 511) >> 8);
        for (int n = 0; n < nmax; ++n) { const LAS f32x4* kr = (const LAS f32x4*)(km + n * 64); float s = 0.f;
#pragma unroll
            for (int j = 0; j < 8; ++j) { const f32x4 ka = kr[2 * j], kb2 = kr[2 * j + 1];
                s += bf_lo(qv[j].x) * ka[0] + bf_hi(qv[j].x) * ka[1] + bf_lo(qv[j].y) * ka[2] + bf_hi(qv[j].y) * ka[3]
                   + bf_lo(qv[j].z) * kb2[0] + bf_hi(qv[j].z) * kb2[1] + bf_lo(qv[j].w) * kb2[2] + bf_hi(qv[j].w) * kb2[3]; }
            if (n < own) {
                if (s > v0) { v2 = v1; i2 = i1; v1 = v0; i1 = i0; v0 = s; i0 = n; }
                else if (s > v1) { v2 = v1; i2 = i1; v1 = s; i1 = n; }
                else if (s > v2) { v2 = s; i2 = n; }
            } }
        const int nsel = own < 3 ? own : 3;
        LAS unsigned* lc = (LAS unsigned*)(C.lds + 8192);
        if (C.tid < 128) lc[C.tid] = 0u;
        __syncthreads();
        const int l0 = 2 * i0 + (i0 == own - 1 ? 1 : 0), l1 = 2 * i1 + (i1 == own - 1 ? 1 : 0), l2 = 2 * i2 + (i2 == own - 1 ? 1 : 0);
        unsigned lp0 = 0u, lp1 = 0u, lp2 = 0u;
        if (nsel > 0) lp0 = atomicAdd((unsigned*)(lc + l0), 1u);
        if (nsel > 1) lp1 = atomicAdd((unsigned*)(lc + l1), 1u);
        if (nsel > 2) lp2 = atomicAdd((unsigned*)(lc + l2), 1u);
        __syncthreads();
        if (C.tid < 64) { const unsigned c = lc[C.tid]; lc[64 + C.tid] = c ? atomicAdd(cnt + bh * 64 + C.tid, c) : 0u; }
        __syncthreads();
#pragma unroll
        for (int j = 0; j < 3; ++j) if (j < nsel) { const int n = j == 0 ? i0 : (j == 1 ? i1 : i2); const int l = j == 0 ? l0 : (j == 1 ? l1 : l2); const unsigned pos = lc[64 + l] + (j == 0 ? lp0 : (j == 1 ? lp1 : lp2));
            list[(size_t)bh * LIST_PER_BH + 256 * (31 * n - (n * (n - 1)) / 2) + ((l & 1) ? 0 : 256) + pos] = (unsigned)q | ((unsigned)j << 13); }
    }
    __syncthreads();
}
__device__ __forceinline__ void build_bias_tables(const Ctx& C) {
    LAS float* bt = (LAS float*)(C.lds + AT_BT);
    for (int idx = C.tid; idx < 12 * BT_STR; idx += 512) { const int hd = idx / BT_STR, n = idx % BT_STR;
        if (n >= 128) { bt[idx] = 0.f; continue; }
        int bk;
        if (n < 16) bk = n; else { const float nf = (float)n; int lg = 16 + (int)(logf(nf / 16.0f) / logf(8.0f) * 16.0f); bk = lg < 31 ? lg : 31; }
        bt[idx] = (C.in[2][bk * 12 + hd] - C.in[2][31 * 12 + hd]) * LOG2E; }
}
#if SIMPLE_DIFF
__device__ __forceinline__ void diff_unit(const Ctx& C, int b, int h, int qblk, float lam) {
    const int lane = C.lane, c = lane & 15, g = lane >> 4, wid = C.wave;
    const bf16_t* qka = WSP(const bf16_t, WS_PROJ);
    const bf16_t* va = WSP(const bf16_t, WS_PROJ + PROJ_STRIDE);
    const int q0 = qblk * 128, q = q0 + wid * 16 + c, NT = 2 * qblk + 2;
    const LAS float* bt = (const LAS float*)(C.lds + AT_BT) + h * 128;
    f32x4 o0[8];
    for (int map = 0; map < 2; ++map) {
        bf16x8 qf[2];
#pragma unroll
        for (int ks = 0; ks < 2; ++ks) qf[ks] = *(const bf16x8*)(qka + (size_t)(b * SEQ + q) * 1024 + h * 128 + map * 64 + 32 * ks + 8 * g);
        const bf16_t* kg = qka + (size_t)(b * SEQ) * 1024 + 512 + h * 128 + map * 64;
        const bf16_t* vg = va + (size_t)(b * SEQ) * 1024 + h * 128;
        float m_run = -1e30f, l_run = 0.f; f32x4 o[8];
#pragma unroll
        for (int dt = 0; dt < 8; ++dt) o[dt] = (f32x4){0.f, 0.f, 0.f, 0.f};
        TileRegs<2> tr; tile_fetch<2>(tr, kg, vg, C.tid);
        for (int t = 0; t < NT; ++t) {
            __syncthreads();
            tile_store<2>(tr, C.lds, C.tid);
            __syncthreads();
            if (t + 1 < NT) tile_fetch<2>(tr, kg + (size_t)(t + 1) * 64 * 1024, vg + (size_t)(t + 1) * 64 * 1024, C.tid);
            attn_tile<8>(C.lds, lane, qf, o, m_run, l_run, q, 64 * t, true, bt);
        }
        float lt = l_run; lt += __shfl_xor(lt, 16); lt += __shfl_xor(lt, 32);
        const float rl = 1.0f / lt;
#pragma unroll
        for (int i = 0; i < 4; ++i) { const float ri = __shfl(rl, 4 * g + i);
#pragma unroll
            for (int dt = 0; dt < 8; ++dt) { if (map == 0) o0[dt][i] = o[dt][i] * ri; else o0[dt][i] = o0[dt][i] - lam * (o[dt][i] * ri); } }
    }
    bf16_t* y = WSP(bf16_t, WS_Y);
#pragma unroll
    for (int i = 0; i < 4; ++i) { float ss = 0.f;
#pragma unroll
        for (int dt = 0; dt < 8; ++dt) ss += o0[dt][i] * o0[dt][i];
        ss += __shfl_xor(ss, 1); ss += __shfl_xor(ss, 2); ss += __shfl_xor(ss, 4); ss += __shfl_xor(ss, 8);
        const float rstd = 1.0f / sqrtf(ss * (1.0f / 128.0f) + RMS_EPS);
        bf16_t* yr = y + (size_t)(b * SEQ + q0 + wid * 16 + 4 * g + i) * 1024 + h * 128 + c;
#pragma unroll
        for (int dt = 0; dt < 8; ++dt) yr[16 * dt] = (bf16_t)f2bf(o0[dt][i] * rstd * C.in[11][16 * dt + c] * 0.8f); }
}
#endif
#if 0
__device__ __forceinline__ void moba_item(const Ctx& C, int b, int h, int n, bool own, int half, const unsigned* lst, int lcnt, int chunk) {
    const int lane = C.lane, c = lane & 15, g = lane >> 4, wid = C.wave;
    const bf16_t* qb = WSP(const bf16_t, WS_PROJ + PROJ_STRIDE) + 512;
    const bf16_t* kv = WSP(const bf16_t, WS_PROJ + 2 * PROJ_STRIDE);
    int qtok, jslot; bool valid;
    if (own) { qtok = 256 * n + 128 * half + wid * 16 + c; jslot = 3; valid = true; }
    else { const int idx = chunk * 128 + wid * 16 + c; valid = idx < lcnt; const unsigned e = lst[valid ? idx : 0]; qtok = (int)(e & 8191u); jslot = (int)(e >> 13); }
    bf16x8 qf[2];
#pragma unroll
    for (int ks = 0; ks < 2; ++ks) qf[ks] = *(const bf16x8*)(qb + (size_t)(b * SEQ + qtok) * 1024 + h * 64 + 32 * ks + 8 * g);
    const bf16_t* kg = kv + (size_t)(b * SEQ + 256 * n) * 1024 + h * 64;
    const bf16_t* vg = kg + 512;
    const LAS float* bt = (const LAS float*)(C.lds + AT_BT) + (4 + h) * 128;
    const int NT = own ? 2 * (half + 1) : 4;
    float m_run = -1e30f, l_run = 0.f; f32x4 o[4];
#pragma unroll
    for (int dt = 0; dt < 4; ++dt) o[dt] = (f32x4){0.f, 0.f, 0.f, 0.f};
    TileRegs<1> tr; tile_fetch<1>(tr, kg, vg, C.tid);
    for (int t = 0; t < NT; ++t) {
        __syncthreads();
        tile_store<1>(tr, C.lds, C.tid);
        __syncthreads();
        if (t + 1 < NT) tile_fetch<1>(tr, kg + (size_t)(t + 1) * 64 * 1024, vg + (size_t)(t + 1) * 64 * 1024, C.tid);
        attn_tile<4>(C.lds, lane, qf, o, m_run, l_run, qtok, 256 * n + 64 * t, own, bt);
    }
    float lt = l_run; lt += __shfl_xor(lt, 16); lt += __shfl_xor(lt, 32);
    const int slot = ((b * SEQ + qtok) * 8 + h) * 4 + jslot;
    if (g == 0 && valid) { f32x2 ml; ml[0] = m_run; ml[1] = lt; *(f32x2*)(WSP(float, WS_PML) + (size_t)slot * 2) = ml; }
    bf16_t* po = WSP(bf16_t, WS_PO);
#pragma unroll
    for (int i = 0; i < 4; ++i) { const int sl = __shfl(slot, 4 * g + i); const int vl = __shfl((int)valid, 4 * g + i);
        if (vl) {
#pragma unroll
            for (int dt = 0; dt < 4; ++dt) po[(size_t)sl * 64 + 16 * dt + c] = (bf16_t)f2bf(o[dt][i]); } }
}
#endif
constexpr int MB_BUF = 65536, MB_OST = LDSCTL_OFF + 14336;
struct MItem { int valid, b, h, n, own, half, near, lcnt, chunk, lbase; };
__device__ __forceinline__ MItem moba_decode(int it, int nitems, const LAS int* pre, const unsigned* cnt) {
    MItem m; m.valid = it < nitems ? 1 : 0; if (!m.valid) it = 0;
    if (it < 1024) { const int bh = it >> 6, r = it & 63; m.b = bh >> 3; m.h = bh & 7; m.n = r >> 1; m.own = 1; m.half = (r ^ (bh >> 2)) & 1; m.near = 0;
        m.lcnt = 128; m.chunk = 0; m.lbase = 0; }
    else { const int gi = it - 1024; int lo = 0, hi = 1023;
        while (lo < hi) { const int mid = (lo + hi + 1) >> 1; if (pre[mid] <= gi) lo = mid; else hi = mid - 1; }
        const int L = lo, bh = L >> 6, n = (L >> 1) & 31, near = L & 1;
        m.b = bh >> 3; m.h = bh & 7; m.n = n; m.own = 0; m.half = 0; m.near = near; m.lcnt = (int)__hip_atomic_load(cnt + L, RLX_AGENT); m.chunk = gi - pre[L];
        m.lbase = bh * LIST_PER_BH + 256 * (31 * n - (n * (n - 1)) / 2) + (near ? 0 : 256); }
    return m;
}
__device__ __forceinline__ unsigned moba_entry(const Ctx& C, const MItem& m) {
    const int c = C.lane & 15;
    if (m.own) return (unsigned)(256 * m.n + 128 * m.half + C.wave * 16 + c) | (3u << 13) | (1u << 15);
    const int idx = m.chunk * 128 + C.wave * 16 + c; const bool v = idx < m.lcnt;
    const unsigned e = WSP(const unsigned, WS_LIST)[(size_t)m.lbase + (v ? idx : 0)];
    return (e & 0x7fffu) | (v ? (1u << 15) : 0u);
}
__device__ __forceinline__ void moba_qload(const Ctx& C, const MItem& m, unsigned ent, bf16x8 (&qf)[2]) {
    const bf16_t* qb = WSP(const bf16_t, WS_PROJ + PROJ_STRIDE) + 512; const int g = C.lane >> 4;
#pragma unroll
    for (int ks = 0; ks < 2; ++ks) qf[ks] = *(const bf16x8*)(qb + (size_t)(m.b * SEQ + (int)(ent & 8191u)) * 1024 + m.h * 64 + 32 * ks + 8 * g);
}
__device__ __forceinline__ void moba_dma(const Ctx& C, const MItem& m, int bo) {
    const bf16_t* kg = WSP(const bf16_t, WS_PROJ + 2 * PROJ_STRIDE) + (size_t)(m.b * SEQ + 256 * m.n) * 1024 + m.h * 64;
    const int r8 = C.lane >> 3, sch = (C.lane & 7) ^ r8;
#pragma unroll
    for (int j = 0; j < 4; ++j) { const int p = C.wave * 4 + j; const bf16_t* src = kg + (size_t)(8 * p + r8) * 1024 + sch * 8;
        __builtin_amdgcn_global_load_lds((const unsigned*)src, (LAS unsigned*)(C.lds + bo + p * 1024), 16, 0, 0);
        __builtin_amdgcn_global_load_lds((const unsigned*)(src + 512), (LAS unsigned*)(C.lds + bo + 32768 + p * 1024), 16, 0, 0); }
}
constexpr int MB_STG = 2304;
__device__ __forceinline__ void moba_flush(const Ctx& C) {
    const LAS unsigned char* stg = C.lds + MB_OST + C.wave * MB_STG; const int lane = C.lane;
    const LAS int* sslot = (const LAS int*)(stg + 2176);
    bf16_t* po = WSP(bf16_t, WS_PO);
#pragma unroll
    for (int r = 0; r < 2; ++r) { const int row = (lane >> 3) + 8 * r, ch = lane & 7; const u32x4 v = *(const LAS u32x4*)(stg + row * 128 + ch * 16); const int sl = sslot[row];
        if (sl >= 0) *(u32x4*)(po + (size_t)sl * 64 + ch * 8) = v; }
    if (lane < 16) { const int sl = sslot[lane]; const f32x2 ml = *(const LAS f32x2*)(stg + 2048 + lane * 8); if (sl >= 0) *(f32x2*)(WSP(float, WS_PML) + (size_t)sl * 2) = ml; }
}
__device__ __forceinline__ void moba_compute(const Ctx& C, const MItem& m, unsigned ent, const bf16x8 (&qf)[2], int bo, int mode) {
    if (!(mode & 2)) return;
    const int lane = C.lane, c = lane & 15, g = lane >> 4, cx = c & 7;
    const int qtok = (int)(ent & 8191u), jslot = (int)((ent >> 13) & 3u), valid = (int)((ent >> 15) & 1u);
    const int nkt = m.own ? 8 * (m.half + 1) : 16;
    const LAS float* bt = (const LAS float*)(C.lds + AT_BT) + (4 + m.h) * BT_STR;
    const bool nearb = m.near && __any((qtok & 255) < 127);
    f32x4 s[16];
    const LAS unsigned char* kb = C.lds + bo + c * 128;
    const int kc0 = ((0 + g) ^ cx) << 4, kc1 = ((4 + g) ^ cx) << 4;
#define MB_BIAS(t4) do { if (m.own || (nearb && (t4) >= 2)) { const int kbase_ = 256 * m.n + 64 * (t4); \
            _Pragma("unroll") for (int k4 = 0; k4 < 4; ++k4) _Pragma("unroll") for (int i = 0; i < 4; ++i) { const int kt_ = 4 * (t4) + k4; const int dist = qtok - (kbase_ + 16 * k4 + 4 * g + i); \
                const unsigned di = (unsigned)dist < 128u ? (unsigned)dist : 128u; const float v = s[kt_][i] + bt[di]; s[kt_][i] = (m.own && dist < 0) ? -INFINITY : v; } } } while (0)
#pragma unroll
    for (int kt = 0; kt < 4; ++kt) { const bf16x8 a0 = *(const LAS bf16x8*)(kb + kt * 2048 + kc0), a1 = *(const LAS bf16x8*)(kb + kt * 2048 + kc1);
        f32x4 z = (f32x4){0.f, 0.f, 0.f, 0.f}; z = __builtin_amdgcn_mfma_f32_16x16x32_bf16(a0, qf[0], z, 0, 0, 0); s[kt] = __builtin_amdgcn_mfma_f32_16x16x32_bf16(a1, qf[1], z, 0, 0, 0); }
    MB_BIAS(0);
    float mx = fmaxf(fmaxf(s[0][0], s[0][1]), fmaxf(s[0][2], s[0][3]));
#pragma unroll
    for (int kt = 1; kt < 4; ++kt) mx = fmaxf(mx, fmaxf(fmaxf(s[kt][0], s[kt][1]), fmaxf(s[kt][2], s[kt][3])));
    mx = fmaxf(mx, __shfl_xor(mx, 16)); mx = fmaxf(mx, __shfl_xor(mx, 32));
    const f32x4 negm = (f32x4){-mx, -mx, -mx, -mx};
#pragma unroll
    for (int kt = 0; kt < 4; ++kt) s[kt] += negm;
#define MB_EXP4(t) do { s[t][0] = __builtin_amdgcn_exp2f(s[t][0]); s[t][1] = __builtin_amdgcn_exp2f(s[t][1]); s[t][2] = __builtin_amdgcn_exp2f(s[t][2]); s[t][3] = __builtin_amdgcn_exp2f(s[t][3]); } while (0)
#pragma unroll
    for (int kt = 4; kt < 16; ++kt) {
        if (kt < nkt) { const bf16x8 a0 = *(const LAS bf16x8*)(kb + kt * 2048 + kc0), a1 = *(const LAS bf16x8*)(kb + kt * 2048 + kc1);
            f32x4 z = __builtin_amdgcn_mfma_f32_16x16x32_bf16(a0, qf[0], negm, 0, 0, 0); s[kt] = __builtin_amdgcn_mfma_f32_16x16x32_bf16(a1, qf[1], z, 0, 0, 0); }
        else s[kt] = (f32x4){-INFINITY, -INFINITY, -INFINITY, -INFINITY};
        if (kt < 8) { MB_EXP4(kt - 4); asm volatile("" : "+v"(s[kt - 4])); }
        __builtin_amdgcn_sched_barrier(0);
    }
    if (4 < nkt) MB_BIAS(1);
    if (8 < nkt) { MB_BIAS(2); MB_BIAS(3); }
#undef MB_BIAS
    f32x4 o[4], osum = (f32x4){0.f, 0.f, 0.f, 0.f};
#pragma unroll
    for (int dt = 0; dt < 4; ++dt) o[dt] = (f32x4){0.f, 0.f, 0.f, 0.f};
    const short one = (c == 0) ? (short)0x3F80 : (short)0; const bf16x8 ones = (bf16x8){one, one, one, one, one, one, one, one};
    const int rv = 4 * g + (c >> 2), x7 = rv & 7, hb = (c & 3) >> 1;
    const LAS unsigned char* vb = C.lds + bo + 32768 + rv * 128 + 8 * (c & 1);
    int cv[4];
#pragma unroll
    for (int dt = 0; dt < 4; ++dt) cv[dt] = ((2 * dt + hb) ^ x7) << 4;
#pragma unroll
    for (int kk = 0; kk < 8; ++kk) {
        if (2 * kk < nkt) { u32x4 w; w.x = cvt_pk_bf16(s[2 * kk][0], s[2 * kk][1]); w.y = cvt_pk_bf16(s[2 * kk][2], s[2 * kk][3]);
            w.z = cvt_pk_bf16(s[2 * kk + 1][0], s[2 * kk + 1][1]); w.w = cvt_pk_bf16(s[2 * kk + 1][2], s[2 * kk + 1][3]); const bf16x8 pa = __builtin_bit_cast(bf16x8, w);
            osum = __builtin_amdgcn_mfma_f32_16x16x32_bf16(pa, ones, osum, 0, 0, 0);
#pragma unroll
            for (int dt = 0; dt < 4; ++dt) { const s16x4 lo = tr16(vb + (32 * kk) * 128 + cv[dt]), hi = tr16(vb + (32 * kk + 16) * 128 + cv[dt]);
                const bf16x8 bfr = (bf16x8){lo[0], lo[1], lo[2], lo[3], hi[0], hi[1], hi[2], hi[3]};
                o[dt] = __builtin_amdgcn_mfma_f32_16x16x32_bf16(pa, bfr, o[dt], 0, 0, 0); } }
        if (kk < 6 && 2 * kk + 4 < nkt) { MB_EXP4(2 * kk + 4); MB_EXP4(2 * kk + 5); asm volatile("" : "+v"(s[2 * kk + 4]), "+v"(s[2 * kk + 5])); }
        __builtin_amdgcn_sched_barrier(0);
    }
#undef MB_EXP4
    if (!(mode & 1)) return;
    LAS unsigned char* stg = C.lds + MB_OST + C.wave * MB_STG;
    LAS bf16_t* so = (LAS bf16_t*)stg;
#pragma unroll
    for (int i = 0; i < 4; ++i)
#pragma unroll
        for (int dt = 0; dt < 4; ++dt) so[(4 * g + i) * 64 + 16 * dt + c] = (bf16_t)f2bf(o[dt][i]);
    const int slot = valid ? ((m.b * SEQ + qtok) * 8 + m.h) * 4 + jslot : -1;
    if (g == 0) { ((LAS int*)(stg + 2176))[c] = slot; ((LAS float*)(stg + 2048))[2 * c] = mx; }
    if (c == 0) {
#pragma unroll
        for (int i = 0; i < 4; ++i) ((LAS float*)(stg + 2048))[2 * (4 * g + i) + 1] = osum[i]; }
}
__device__ __forceinline__ MItem moba_item_at(const LAS int* tab, int j) {
    MItem m; const int w0 = __builtin_amdgcn_readfirstlane(tab[4 * j]), w1 = __builtin_amdgcn_readfirstlane(tab[4 * j + 1]), w2 = __builtin_amdgcn_readfirstlane(tab[4 * j + 2]), w3 = __builtin_amdgcn_readfirstlane(tab[4 * j + 3]);
    m.valid = (j < 32 && w1 >= 0) ? 1 : 0; const int bh = w0 & 255; m.b = bh >> 3; m.h = bh & 7; m.n = (w0 >> 8) & 255; m.own = (w0 >> 16) & 1; m.half = (w0 >> 17) & 1; m.near = (w0 >> 18) & 1; m.lcnt = w1; m.chunk = w2; m.lbase = w3; return m;
}
__device__ __forceinline__ void moba_phase(const Ctx& C, const LAS int* pre, const unsigned* cnt, int mode) {
    const int nitems = 1024 + pre[1024]; const int G = C.G;
    LAS int* tab = (LAS int*)(C.lds + LDSCTL_OFF + 7424);
    if (C.tid < 33) { MItem m = moba_decode(C.vcu + C.tid * G, nitems, pre, cnt); if (C.tid == 32) m.valid = 0;
        tab[4 * C.tid] = (m.b * 8 + m.h) | (m.n << 8) | (m.own << 16) | (m.half << 17) | (m.near << 18); tab[4 * C.tid + 1] = m.valid ? m.lcnt : -1; tab[4 * C.tid + 2] = m.chunk; tab[4 * C.tid + 3] = m.lbase; }
    __syncthreads();
    int j = 0;
    MItem m0 = moba_item_at(tab, 0), m1 = moba_item_at(tab, 1);
    unsigned e0 = 0u, e1 = 0u; bf16x8 qf0[2];
    qf0[0] = (bf16x8){0, 0, 0, 0, 0, 0, 0, 0}; qf0[1] = qf0[0];
    if (m0.valid) { e0 = moba_entry(C, m0); moba_qload(C, m0, e0, qf0); moba_dma(C, m0, 0); }
    if (m1.valid) e1 = moba_entry(C, m1);
    int bo = 0; bool pending = false;
    while (m0.valid) {
        VM_WAIT(); __syncthreads();
        if (pending) moba_flush(C);
        bf16x8 qf1[2]; qf1[0] = qf0[0]; qf1[1] = qf0[1];
        if (m1.valid) moba_qload(C, m1, e1, qf1);
        const MItem m2 = moba_item_at(tab, j + 2 < 32 ? j + 2 : 32);
        unsigned e2 = 0u; if (m2.valid) e2 = moba_entry(C, m2);
        if (m1.valid) moba_dma(C, m1, bo ^ MB_BUF);
        moba_compute(C, m0, e0, qf0, bo, mode); pending = (mode & 3) == 3;
        m0 = m1; m1 = m2; e0 = e1; e1 = e2; qf0[0] = qf1[0]; qf0[1] = qf1[1]; bo ^= MB_BUF; ++j;
    }
    if (pending) { LDS_WAIT(); moba_flush(C); }
    VM_WAIT(); __syncthreads();
}
#ifndef PROBE_SUB
#define PROBE_SUB 3
#endif
__device__ __forceinline__ void p4_attention(const Ctx& C0, int sub, bool gate) {
    if (gate) { p3b_gate(C0);
        asm volatile("s_waitcnt vmcnt(0)" ::: "memory"); __syncthreads();
        if (threadIdx.x == 0) { __builtin_amdgcn_fence(__ATOMIC_RELEASE, "agent"); asm volatile("s_waitcnt vmcnt(0)" ::: "memory"); xb_add((unsigned*)(C0.ws + WS_CTL) + CW_GDONE, 1u); } }
    PHASE_IDS();
    __syncthreads();
    build_bias_tables(C);
    float lam;
    { const float a = wave_sum(C.in[7][C.lane] * C.in[8][C.lane]), b2 = wave_sum(C.in[9][C.lane] * C.in[10][C.lane]); lam = expf(a) - expf(b2) + 0.2f; }
    __syncthreads();
#if SIMPLE_DIFF
    if (sub & 1) for (int p = blockIdx.x; p < 256; p += C.G) { const int bh = p >> 5, qa = p & 31;
        diff_unit(C, bh >> 2, bh & 3, qa, lam); diff_unit(C, bh >> 2, bh & 3, 63 - qa, lam); }
#else
#if NATIVE_DIFF
    {
        const int grp = blockIdx.x & 7, rank = blockIdx.x >> 3;
        if ((sub & 1) && rank < NCONV) { LAS float* scr = (LAS float*)(C.lds + C.wave * 8448);
            const int wi = (rank * 8 + grp) * NWAVES + C.wave, nw = NCONV * 8 * NWAVES;
            conv_q_blocks<0>(C.in[18], C.ws, C.lds, C.wave, rank * 8 + grp, NCONV * 8);
            conv_range(C, NE * 16 * 64, CONV_MOE_ITEMS, wi, nw, scr); }
        unsigned* qctr = WSP(unsigned, WS_CTL) + CW_AQ + 64 * grp;
        LAS int* qslot = (LAS int*)(C.lds + LDSCTL_OFF + 512);
        const attn_nat::bf16* qk = (const attn_nat::bf16*)WSP(const bf16_t, WS_PROJ); const attn_nat::bf16* vv = (const attn_nat::bf16*)WSP(const bf16_t, WS_PROJ + PROJ_STRIDE);
        attn_nat::bf16* oa = (attn_nat::bf16*)WSP(bf16_t, WS_OA);
        if (sub & 1) for (;;) {
            __syncthreads();
            if (C.tid == 0) *qslot = (int)atomicAdd(qctr, 1u);
            __syncthreads();
            const int j = __builtin_amdgcn_readfirstlane(*qslot);
            if (j >= 64) break;
            const int qb = 31 - (j >> 1), st = grp + 8 * (j & 1), b = st >> 3, h = (st >> 1) & 3, mp = st & 1;
            const LAS float* bth = (const LAS float*)(C.lds + AT_BT) + h * BT_STR;
            attn_nat::attn_unit<8>(b, qb, qk, qk, vv, oa, h * 128 + mp * 64, 512 + h * 128 + mp * 64, h * 128, mp * 512 + h * 128, bth, C.ldsg); }
    }
#else
    if (sub & 1) for (int v = C.vcu; v < 256; v += C.G) { const int bvh = v >> 3, s = v & 7, b = bvh >> 4, vh = bvh & 15, h = vh >> 2, mp = (vh >> 1) & 1, vhf = vh & 1;
        const attn_body::bf16* qk = (const attn_body::bf16*)WSP(const bf16_t, WS_PROJ); const attn_body::bf16* vv = (const attn_body::bf16*)WSP(const bf16_t, WS_PROJ + PROJ_STRIDE);
        attn_body::bf16* oa = (attn_body::bf16*)WSP(bf16_t, WS_OA);
        const LAS float* bth = (const LAS float*)(C.lds + AT_BT) + h * BT_STR;
#pragma unroll 1
        for (int i = 0; i < 4; ++i) { const int qb = (i == 0) ? s : (i == 1) ? 15 - s : (i == 2) ? 16 + s : 31 - s;
            attn_body::attn_unit<8>(b, qb, qk, qk, vv, oa, h * 128 + mp * 64, 512 + h * 128 + mp * 64, h * 128 + vhf * 64, mp * 512 + h * 128 + vhf * 64, bth, C.ldsg); } }
#endif
#endif
    LAS int* pre = (LAS int*)(C.lds + AT_MISC);
    LAS int* wtot = pre + 1032;
    const unsigned* cnt = WSP(const unsigned, WS_CTL) + CW_MCNT;
    if (gate && C.tid == 0) { unsigned* gd = WSP(unsigned, WS_CTL) + CW_GDONE; unsigned* tmo = WSP(unsigned, WS_CTL) + CW_TMO; unsigned sp = 0u;
        while (xb_ld(gd) < (unsigned)C.G) { __builtin_amdgcn_s_sleep(2); if ((++sp & 255u) == 0u) { if (xb_ld(tmo)) break; if (sp > XB_SPIN_CAP) { atomicAdd(tmo, 1u); break; } } }
        __builtin_amdgcn_fence(__ATOMIC_ACQUIRE, "agent"); asm volatile("s_waitcnt vmcnt(0)" ::: "memory"); }
    __syncthreads();
    { const int L = 2 * C.tid; const int n0_ = ((int)__hip_atomic_load(cnt + L, RLX_AGENT) + 127) >> 7, n1_ = ((int)__hip_atomic_load(cnt + L + 1, RLX_AGENT) + 127) >> 7; const int nch = n0_ + n1_;
        int inc = nch;
#pragma unroll
        for (int o = 1; o < 64; o <<= 1) { const int t = __shfl_up(inc, o); if (C.lane >= o) inc += t; }
        if (C.lane == 63) wtot[C.wave] = inc;
        __syncthreads();
        int base = 0;
        for (int w = 0; w < C.wave; ++w) base += wtot[w];
        pre[L] = base + inc - nch; pre[L + 1] = base + inc - nch + n0_;
        if (C.tid == 511) pre[1024] = base + inc;
    }
    __syncthreads();
    if (sub & 2) moba_phase(C, pre, cnt, sub >> 2);
    __syncthreads();
}
__device__ __forceinline__ void p5_ycombine(const Ctx& C0) {
    PHASE_IDS();
    const int gw = C.vcu * NWAVES + C.wave, NGW = C.G * NWAVES;
    const bf16_t* po = WSP(const bf16_t, WS_PO); const float* pml = WSP(const float, WS_PML); bf16_t* y = WSP(bf16_t, WS_Y);
#if !SIMPLE_DIFF
    {
        const float lam = expf(wave_sum(C.in[7][C.lane] * C.in[8][C.lane])) - expf(wave_sum(C.in[9][C.lane] * C.in[10][C.lane])) + 0.2f;
        const bf16_t* oa = WSP(const bf16_t, WS_OA);
        const f32x4 g0 = *(const f32x4*)(C.in[11] + 8 * (C.lane & 15)), g1 = *(const f32x4*)(C.in[11] + 8 * (C.lane & 15) + 4);
        for (int m0 = gw; m0 < M; m0 += NGW) { const int m = XROW(m0); const u32x4 a = *(const u32x4*)(oa + (size_t)m * 1024 + 8 * C.lane), b2 = *(const u32x4*)(oa + (size_t)m * 1024 + 512 + 8 * C.lane);
            float v[8];
            v[0] = bf_lo(a.x) - lam * bf_lo(b2.x); v[1] = bf_hi(a.x) - lam * bf_hi(b2.x); v[2] = bf_lo(a.y) - lam * bf_lo(b2.y); v[3] = bf_hi(a.y) - lam * bf_hi(b2.y);
            v[4] = bf_lo(a.z) - lam * bf_lo(b2.z); v[5] = bf_hi(a.z) - lam * bf_hi(b2.z); v[6] = bf_lo(a.w) - lam * bf_lo(b2.w); v[7] = bf_hi(a.w) - lam * bf_hi(b2.w);
            float ss = 0.f;
#pragma unroll
            for (int k = 0; k < 8; ++k) ss += v[k] * v[k];
            ss += __shfl_xor(ss, 1); ss += __shfl_xor(ss, 2); ss += __shfl_xor(ss, 4); ss += __shfl_xor(ss, 8);
            const float r = 0.8f / sqrtf(ss * (1.0f / 128.0f) + RMS_EPS);
            u32x4 w; w.x = pk2(v[0] * r * g0[0], v[1] * r * g0[1]); w.y = pk2(v[2] * r * g0[2], v[3] * r * g0[3]); w.z = pk2(v[4] * r * g1[0], v[5] * r * g1[1]); w.w = pk2(v[6] * r * g1[2], v[7] * r * g1[3]);
            *(u32x4*)(y + (size_t)m * 1024 + 8 * C.lane) = w; }
    }
#endif
    for (int m0 = gw; m0 < M; m0 += NGW) { const int m = XROW(m0); const int h = C.lane >> 3, dch = C.lane & 7; const int own = (m & (SEQ - 1)) >> 8, nsel = own < 3 ? own : 3;
        const size_t s0 = ((size_t)m * 8 + h) * 4;
        float mm[4], ll[4]; u32x4 ov[4];
#pragma unroll
        for (int j = 0; j < 4; ++j) { const bool use = (j == 3) || (j < nsel);
            if (use) { const f32x2 ml = *(const f32x2*)(pml + (s0 + j) * 2); mm[j] = ml[0]; ll[j] = ml[1]; ov[j] = *(const u32x4*)(po + (s0 + j) * 64 + 8 * dch); }
            else { mm[j] = -INFINITY; ll[j] = 0.f; ov[j] = (u32x4){0u, 0u, 0u, 0u}; } }
        const float mx = fmaxf(fmaxf(mm[0], mm[1]), fmaxf(mm[2], mm[3]));
        float den = 0.f; float acc[8];
#pragma unroll
        for (int k = 0; k < 8; ++k) acc[k] = 0.f;
#pragma unroll
        for (int j = 0; j < 4; ++j) { const float w = __builtin_amdgcn_exp2f(mm[j] - mx); den += w * ll[j];
            acc[0] += w * bf_lo(ov[j].x); acc[1] += w * bf_hi(ov[j].x); acc[2] += w * bf_lo(ov[j].y); acc[3] += w * bf_hi(ov[j].y);
            acc[4] += w * bf_lo(ov[j].z); acc[5] += w * bf_hi(ov[j].z); acc[6] += w * bf_lo(ov[j].w); acc[7] += w * bf_hi(ov[j].w); }
        const float r = 1.0f / den;
        u32x4 w; w.x = pk2(acc[0] * r, acc[1] * r); w.y = pk2(acc[2] * r, acc[3] * r); w.z = pk2(acc[4] * r, acc[5] * r); w.w = pk2(acc[6] * r, acc[7] * r);
        *(u32x4*)(y + (size_t)m * 1024 + 512 + h * 64 + 8 * dch) = w; }
}
__device__ __forceinline__ void p8_router(const Ctx& C0) {
    PHASE_IDS();
    LAS float* MA = (LAS float*)(C.lds + LDSCTL_OFF + 2048); LAS float* MB = MA + 2048;
    LAS int* hist = (LAS int*)(C.lds + LDSCTL_OFF + 2048 + 16384);
    LAS float* xch = (LAS float*)(C.lds + LDSCTL_OFF + 2048 + 16384 + 256);
    for (int idx = C.tid; idx < 2048; idx += 512) { const int b = idx >> 10, col = idx & 1023; const float* af = WSP(const float, WS_ADAF) + b * 6144;
        MA[idx] = C.in[15][col] * (1.0f + af[4096 + col]); MB[idx] = af[3072 + col]; }
    if (C.tid < 32) hist[C.tid] = 0;
    __syncthreads();
    for (int blk = (C.G == 256 ? C.vcu : (int)blockIdx.x); blk < M / 64; blk += C.G) {
        const int r0 = 64 * blk, b = r0 >= SEQ;
        {
            u32x4 xr[8][2];
#pragma unroll
            for (int r = 0; r < 8; ++r)
#pragma unroll
                for (int j = 0; j < 2; ++j) xr[r][j] = *(const u32x4*)(WSP(const bf16_t, WS_X1) + (size_t)(r0 + 8 * C.wave + r) * D + 512 * j + 8 * C.lane);
#pragma unroll
            for (int r = 0; r < 8; ++r) { const int lr = 8 * C.wave + r, m = r0 + lr; const LAS float* ma = MA + b * 1024; const LAS float* mb = MB + b * 1024;
                float v[16]; float s = 0.f;
#pragma unroll
                for (int j = 0; j < 2; ++j) { const u32x4 w = xr[r][j];
                    v[8 * j + 0] = bf_lo(w.x); v[8 * j + 1] = bf_hi(w.x); v[8 * j + 2] = bf_lo(w.y); v[8 * j + 3] = bf_hi(w.y); v[8 * j + 4] = bf_lo(w.z); v[8 * j + 5] = bf_hi(w.z); v[8 * j + 6] = bf_lo(w.w); v[8 * j + 7] = bf_hi(w.w); }
#pragma unroll
                for (int k = 0; k < 16; ++k) s += v[k] * v[k];
                const float rstd = 1.0f / sqrtf(wave_sum(s) * (1.0f / D) + RMS_EPS);
                float am = 0.f;
#pragma unroll
                for (int j = 0; j < 2; ++j) { const LAS float* a = ma + 512 * j + 8 * C.lane; const LAS float* bb = mb + 512 * j + 8 * C.lane;
                    const f32x4 a0 = *(const LAS f32x4*)a, a1 = *(const LAS f32x4*)(a + 4), b0 = *(const LAS f32x4*)bb, b1 = *(const LAS f32x4*)(bb + 4);
#pragma unroll
                    for (int k = 0; k < 4; ++k) { v[8 * j + k] = v[8 * j + k] * rstd * a0[k] + b0[k]; v[8 * j + 4 + k] = v[8 * j + 4 + k] * rstd * a1[k] + b1[k]; }
#pragma unroll
                    for (int k = 0; k < 8; ++k) am = fmaxf(am, fabsf(v[8 * j + k]));
                    u32x4 w; w.x = pk2(v[8 * j + 0], v[8 * j + 1]); w.y = pk2(v[8 * j + 2], v[8 * j + 3]); w.z = pk2(v[8 * j + 4], v[8 * j + 5]); w.w = pk2(v[8 * j + 6], v[8 * j + 7]);
                    *(LAS u32x4*)(C.lds + lr * 2048 + (((64 * j + C.lane) ^ (lr & 15)) << 4)) = w; }
#pragma unroll
                for (int o = 1; o < 64; o <<= 1) am = fmaxf(am, __shfl_xor(am, o));
                const float inv = am > 0.f ? 127.0f / am : 0.f;
                if (C.lane == 0) WSP(float, WS_SA)[m] = am > 0.f ? am * (1.0f / 127.0f) : 1.0f;
                signed char* qrow = (signed char*)(C.ws + WS_H2Q) + (size_t)m * D;
#pragma unroll
                for (int j = 0; j < 2; ++j) { unsigned w2[2];
#pragma unroll
                    for (int d = 0; d < 2; ++d) { int b4[4];
#pragma unroll
                        for (int k = 0; k < 4; ++k) b4[k] = (int)fminf(fmaxf(__builtin_rintf(v[8 * j + 4 * d + k] * inv), -127.0f), 127.0f);
                        w2[d] = (unsigned)(b4[0] & 255) | ((unsigned)(b4[1] & 255) << 8) | ((unsigned)(b4[2] & 255) << 16) | ((unsigned)b4[3] << 24); }
                    *(u32x2*)(qrow + 512 * j + 8 * C.lane) = (u32x2){w2[0], w2[1]}; } }
        }
        __syncthreads();
        const int lane = C.lane, c = lane & 15, g = lane >> 4, rq = C.wave & 3, kh = C.wave >> 2; const int rb = r0 + 16 * rq;
        f32x4 lg[2]; lg[0] = (f32x4){0.f, 0.f, 0.f, 0.f}; lg[1] = lg[0];
        { const bf16_t* wt = WSP(const bf16_t, WS_WRT) + (size_t)c * 1024 + 8 * g + 512 * kh; const LAS unsigned char* arow = C.lds + (16 * rq + c) * 2048;
#pragma unroll 8
            for (int ks = 0; ks < 16; ++ks) { const bf16x8 a = *(const LAS bf16x8*)(arow + ((((64 * kh + 4 * ks + g)) ^ c) << 4));
#pragma unroll
                for (int nt = 0; nt < 2; ++nt) { const bf16x8 w = *(const bf16x8*)(wt + (size_t)nt * 16 * 1024 + 32 * ks);
                    lg[nt] = __builtin_amdgcn_mfma_f32_16x16x32_bf16(a, w, lg[nt], 0, 0, 0); } } }
        if (kh == 1) { *(LAS f32x4*)(xch + (rq * 64 + lane) * 8) = lg[0]; *(LAS f32x4*)(xch + (rq * 64 + lane) * 8 + 4) = lg[1]; }
        __syncthreads();
        if (kh == 0) { lg[0] += *(const LAS f32x4*)(xch + (rq * 64 + lane) * 8); lg[1] += *(const LAS f32x4*)(xch + (rq * 64 + lane) * 8 + 4);
            const float br0 = C.in[17][c], br1 = C.in[17][16 + c];
#pragma unroll
            for (int i = 0; i < 4; ++i) { float a0 = lg[0][i] + br0, a1 = lg[1][i] + br1; float tv[4]; int ti[4];
#pragma unroll
                for (int k = 0; k < 4; ++k) { float bv; int bi; if (a1 > a0) { bv = a1; bi = 16 + c; } else { bv = a0; bi = c; }
#pragma unroll
                    for (int o = 1; o < 16; o <<= 1) { const float ov = __shfl_xor(bv, o); const int oi = __shfl_xor(bi, o); if (ov > bv || (ov == bv && oi < bi)) { bv = ov; bi = oi; } }
                    tv[k] = bv; ti[k] = bi; if (bi == c) a0 = -INFINITY; if (bi == 16 + c) a1 = -INFINITY; }
                if (c == 0) { const int row = rb + 4 * g + i; const float e1 = __expf(tv[1] - tv[0]), e2 = __expf(tv[2] - tv[0]), e3 = __expf(tv[3] - tv[0]); const float inv = 1.0f / (1.0f + e1 + e2 + e3);
                    *(int4*)(WSP(int, WS_TOPI) + (size_t)row * 4) = make_int4(ti[0], ti[1], ti[2], ti[3]);
                    *(f32x4*)(WSP(float, WS_TOPW) + (size_t)row * 4) = (f32x4){inv, e1 * inv, e2 * inv, e3 * inv};
                    atomicAdd((int*)(hist + ti[0]), 1); atomicAdd((int*)(hist + ti[1]), 1); atomicAdd((int*)(hist + ti[2]), 1); atomicAdd((int*)(hist + ti[3]), 1); } }
        }
        __syncthreads();
        if (C.tid < 32) { WSP(int, WS_HIST)[blk * 32 + C.tid] = hist[C.tid]; hist[C.tid] = 0; }
        __syncthreads();
    }
}
__device__ __forceinline__ void p9_slots(const Ctx& C0) {
    PHASE_IDS();
    LAS int* tot = (LAS int*)C.lds;
    LAS int* off = tot + 32;
    LAS int* cur = off + 40;
    const int* hist = WSP(const int, WS_HIST);
    for (int blk = blockIdx.x; blk < M / 64; blk += C.G) {
        __syncthreads();
        {
            LAS int* part = cur + 40;
            const int e = C.tid & 31, r = C.tid >> 5; int t = 0, p = 0;
#pragma unroll
            for (int k = 0; k < (M / 64) / 16; ++k) { const int w = r + 16 * k; const int v = hist[w * 32 + e]; t += v; p += (w < blk) ? v : 0; }
            part[r * 32 + e] = t; part[512 + r * 32 + e] = p;
            __syncthreads();
            if (C.tid < 32) { int ts = 0, ps = 0;
#pragma unroll
                for (int k = 0; k < 16; ++k) { ts += part[k * 32 + C.tid]; ps += part[512 + k * 32 + C.tid]; }
                tot[C.tid] = ts; cur[C.tid] = ps; } }
        __syncthreads();
        if (C.tid == 0) { int o = 0; for (int e = 0; e < 32; ++e) { off[e] = o; o += (tot[e] + 255) & ~255; } off[32] = o; }
        __syncthreads();
        if (C.tid < 32) cur[C.tid] += off[C.tid];
        __syncthreads();
        if (C.tid < 256) { const int token = 64 * blk + (C.tid >> 2), k = C.tid & 3; const int e = WSP(const int, WS_TOPI)[token * 4 + k];
            const int slot = atomicAdd((int*)(cur + e), 1);
            WSP(int, WS_SLOTTOK)[slot] = token; WSP(float, WS_SLOTW)[slot] = WSP(const float, WS_TOPW)[token * 4 + k]; WSP(int, WS_TOKSLOT)[token * 4 + k] = slot; WSP(float, WS_SLOTSA)[slot] = WSP(const float, WS_SA)[token]; }
        if (blk < 32) { const int e = blk; for (int s = off[e] + tot[e] + C.tid; s < off[e + 1]; s += 512) { WSP(int, WS_SLOTTOK)[s] = 0; WSP(float, WS_SLOTW)[s] = 0.f; WSP(float, WS_SLOTSA)[s] = 0.f; } }
        if (blk == 0 && C.tid < 33) WSP(int, WS_EOFF)[C.tid] = off[C.tid];
    }
    __syncthreads();
}
__device__ __forceinline__ void p12_final(const Ctx& C0) {
    PHASE_IDS();
    const int gw = C.vcu * NWAVES + C.wave, NGW = C.G * NWAVES;
    const bf16_t* so = WSP(const bf16_t, WS_SOUT); const bf16_t* x1 = WSP(const bf16_t, WS_X1); const int* ts = WSP(const int, WS_TOKSLOT);
    for (int m = gw; m < M; m += NGW) { const float* gt = WSP(const float, WS_ADAF) + (m >= SEQ ? 6144 : 0) + 5120;
        const int4 sl = *(const int4*)(ts + (size_t)m * 4);
        f32x4 v[4]; float s = 0.f;
#pragma unroll
        for (int j = 0; j < 4; ++j) { const int col = 4 * C.lane + 256 * j; f32x4 a = (f32x4){0.f, 0.f, 0.f, 0.f};
            { const u32x2 w = *(const u32x2*)(so + (size_t)sl.x * 1024 + col); a[0] += bf_lo(w.x); a[1] += bf_hi(w.x); a[2] += bf_lo(w.y); a[3] += bf_hi(w.y); }
            { const u32x2 w = *(const u32x2*)(so + (size_t)sl.y * 1024 + col); a[0] += bf_lo(w.x); a[1] += bf_hi(w.x); a[2] += bf_lo(w.y); a[3] += bf_hi(w.y); }
            { const u32x2 w = *(const u32x2*)(so + (size_t)sl.z * 1024 + col); a[0] += bf_lo(w.x); a[1] += bf_hi(w.x); a[2] += bf_lo(w.y); a[3] += bf_hi(w.y); }
            { const u32x2 w = *(const u32x2*)(so + (size_t)sl.w * 1024 + col); a[0] += bf_lo(w.x); a[1] += bf_hi(w.x); a[2] += bf_lo(w.y); a[3] += bf_hi(w.y); }
            { const u32x2 xw = *(const u32x2*)(x1 + (size_t)m * D + col); const f32x4 xv = (f32x4){bf_lo(xw.x), bf_hi(xw.x), bf_lo(xw.y), bf_hi(xw.y)}; v[j] = xv + *(const f32x4*)(gt + col) * a; }
            s += (v[j][0] * v[j][0] + v[j][1] * v[j][1]) + (v[j][2] * v[j][2] + v[j][3] * v[j][3]); }
        const float rstd = 1.0f / sqrtf(wave_sum(s) * (1.0f / D) + RMS_EPS);
#pragma unroll
        for (int j = 0; j < 4; ++j) { const int col = 4 * C.lane + 256 * j; *(f32x4*)(C.out + (size_t)m * D + col) = v[j] * rstd * *(const f32x4*)(C.in[22] + col); } }
}

constexpr int CW_GRP = 118000;
__device__ __forceinline__ void grp_barrier(const XcdBarrier& b, unsigned* gwd, unsigned n, volatile LAS unsigned* mode) {
    asm volatile("s_waitcnt vmcnt(0)" ::: "memory");
    __syncthreads();
    if (threadIdx.x == 0) {
        __builtin_amdgcn_s_waitcnt(0);
        unsigned md = mode[0];
        if (md == 0u) { md = (xb_ld(gwd + 128) + xb_ld(gwd + 192) == 17u) ? 1u : 2u; mode[0] = md; }
        if (md != 1u) { __builtin_amdgcn_fence(__ATOMIC_RELEASE, "agent"); asm volatile("s_waitcnt vmcnt(0)" ::: "memory"); }
        const unsigned old = xb_add(gwd, 1u); const unsigned gen = old / n;
        if (old + 1u == (gen + 1u) * n) xb_add(gwd + 64, 1u);
        else XB_SPIN(xb_ld(gwd + 64) == gen, b.bar);
        __builtin_amdgcn_fence(__ATOMIC_ACQUIRE, "agent");
        asm volatile("s_waitcnt vmcnt(0)" ::: "memory");
    }
    __syncthreads();
}
struct Args { const float* in[23]; float* out; unsigned char* ws; int ph_lo, ph_hi, li, pad; };
constexpr int N_PHASES = 13;
#ifndef MK_N_LAUNCHES
#define MK_N_LAUNCHES 1
#endif

__global__ void __launch_bounds__(NWAVES * 64, 2) mega_fwd(Args args) {
    extern __shared__ __attribute__((aligned(16))) unsigned char lds_raw[];
    Ctx C;
    C.lds = (LAS unsigned char*)lds_raw; C.ldsg = (char*)lds_raw;
    C.tid = threadIdx.x; C.lane = C.tid & 63; C.wave = __builtin_amdgcn_readfirstlane(C.tid >> 6);
    C.G = gridDim.x; { const int bx = blockIdx.x; C.vcu = (C.G % 8 == 0) ? (bx % 8) * (C.G / 8) + bx / 8 : bx; }
#pragma unroll
    for (int i = 0; i < 23; ++i) C.in[i] = args.in[i];
    C.out = args.out; C.ws = args.ws;
    volatile LAS unsigned* MISC = (volatile LAS unsigned*)(C.lds + MISC_OFF);
    for (int u = C.tid; u < (LDS_BYTES - LDSCTL_OFF) / 4; u += NWAVES * 64) ((LAS unsigned*)(C.lds + LDSCTL_OFF))[u] = 0u;
    __syncthreads();
    unsigned* ctl = (unsigned*)(C.ws + WS_CTL);
    XcdBarrier bar = xcd_barrier_post(ctl + CW_BAR + args.li * XCD_BAR_WORDS, MISC + 8);
    unsigned* gwd = ctl + CW_GRP + 256 * ((int)blockIdx.x & 7);
    if (threadIdx.x == 0) { const unsigned xc = xb_xcc_id(); __hip_atomic_fetch_max(gwd + 128, xc + 1u, __ATOMIC_RELAXED, __HIP_MEMORY_SCOPE_AGENT); __hip_atomic_fetch_max(gwd + 192, 16u - xc, __ATOMIC_RELAXED, __HIP_MEMORY_SCOPE_AGENT); }
    const bool gloc = (C.G == 256) && (MK_N_LAUNCHES == 1);
    const int lo = args.ph_lo, hi = args.ph_hi;
#define IN(k) (lo <= (k) && (k) < hi)
#define SEAM(k) do { if (IN(k) && IN((k) + 1)) xcd_barrier(bar); } while (0)
#define SEAMG(k) do { if (gloc) grp_barrier(bar, gwd, 32u, MISC + 12); else xcd_barrier(bar); } while (0)
#ifndef PROBE_REP
#define PROBE_REP -1
#endif
#define REPS(k) (((k) == PROBE_REP) ? 2 : 1)
#define DUP(k, ...) do { __VA_ARGS__; if (REPS(k) == 2) { __VA_ARGS__; } } while (0)

    if (IN(0)) { DUP(0, p0_prologue(C)); } SEAM(0);
    if (IN(1)) { DUP(30, p1_h1(C)); } SEAMG(1);
    if (IN(2)) {
        { pg8::DenseSched S; S.init(M, 1024, C.G, (int)blockIdx.x, WSP(bf16_t, WS_WIN), 1024); S.pn_base = 6; pg8::EpiProj E{WSP(bf16_t, WS_PROJ), WSP(float, WS_KMEAN)};
          DUP(2, pg8::gemm_phase<pg8::EpiProj, pg8::DenseSched, true>(C.lds, WSP(bf16_t, WS_H), 1024, 1024, 1024, S, E)); }
        { pg8::DenseSched S; S.init(M, INW - 1024, C.G, (int)blockIdx.x, C.ws + WS_WINQ, 512); S.pn_skip_at = 6; S.pn_skip = 4; pg8::EpiProjQ E{WSP(bf16_t, WS_PROJ), WSP(const float, WS_SA), WSP(const float, WS_SWIN)};
          DUP(2, pg8::gemm_phase<pg8::EpiProjQ, pg8::DenseSched, true, true>(C.lds, C.ws + WS_H2Q, 512, 512, 512, S, E)); }
    } if (IN(2) && IN(5)) xcd_barrier(bar);
    if (IN(5)) { p4_attention(C, 3 | (3 << 2), true); if (REPS(5) == 2) p4_attention(C, PROBE_SUB, false); } SEAM(5);
    if (IN(6)) { DUP(30, p5_ycombine(C)); } SEAMG(6);
    if (IN(7)) { pg8::DenseSched S; S.init(M, D, C.G, (int)blockIdx.x, WSP(bf16_t, WS_WBR), 1024); pg8::EpiBr E{WSP(const bf16_t, WS_PROJ + 3 * PROJ_STRIDE), WSP(const bf16_t, WS_PROJ + 4 * PROJ_STRIDE), WSP(bf16_t, WS_MERGED)};
        DUP(31, pg8::gemm_phase<pg8::EpiBr, pg8::DenseSched, true>(C.lds, WSP(bf16_t, WS_Y), 1024, 1024, 1024, S, E)); } SEAMG(7);
    if (IN(9)) { pg8::DenseSched S; S.init(M, D, C.G, (int)blockIdx.x, WSP(bf16_t, WS_WOUT), 1024); pg8::EpiOut E{C.in[0], WSP(const float, WS_ADAF), WSP(bf16_t, WS_X1)};
        DUP(32, pg8::gemm_phase<pg8::EpiOut, pg8::DenseSched, true>(C.lds, WSP(bf16_t, WS_MERGED), 1024, 1024, 1024, S, E)); } SEAMG(9);
    if (IN(10)) { DUP(30, p8_router(C)); } SEAM(10);
    if (IN(11)) { DUP(33, p9_slots(C)); } SEAM(11);
    if (IN(12)) {
        LAS int* te = (LAS int*)(C.lds + RING_BYTES + 64);
        if (C.tid < 33) te[C.tid] = WSP(const int, WS_EOFF)[C.tid] >> 8;
        __syncthreads();
        unsigned* tdone = (unsigned*)(C.ws + WS_CTL) + CW_TDONE; unsigned* tmo = (unsigned*)(C.ws + WS_CTL) + CW_TMO;
        { pg8::MoeSched<true, false, false> S{te, 8, C.G, (int)blockIdx.x, WSP(const int, WS_SLOTTOK), (const char*)(C.ws + WS_WGU), (size_t)2048 * 1024, (size_t)256 * 1024, tdone, tmo};
          pg8::EpiGUQ E{C.in[19], WSP(const float, WS_SW), WSP(const float, WS_SLOTSA), WSP(bf16_t, WS_ACT)};
          DUP(20, pg8::gemm_phase<pg8::EpiGUQ, pg8::MoeSched<true, false, false>, true, true>(C.lds, C.ws + WS_H2Q, 512, 512, 512, S, E)); }
        xcd_barrier(bar);
        { pg8::MoeSched<false, false, false, true> S{te, 4, C.G, (int)blockIdx.x, nullptr, (const char*)WSP(bf16_t, WS_WD), (size_t)1024 * 1024 * 2, (size_t)256 * 1024 * 2, tdone, tmo};
          pg8::EpiDown E{C.in[21], WSP(const float, WS_SLOTW), WSP(bf16_t, WS_SOUT)};
          DUP(21, pg8::gemm_phase<pg8::EpiDown, pg8::MoeSched<false, false, false, true>, true>(C.lds, WSP(bf16_t, WS_ACT), 1024, 1024, 1024, S, E)); }
        xcd_barrier(bar);
        DUP(30, p12_final(C));
    }
#undef IN
#undef SEAM
}

extern "C" void kernel_launch(void* const* d_in, const int* in_sizes, int n_in, void* d_out, int out_size, void* d_ws, size_t ws_size, hipStream_t stream) {
    static int grid = 0;
    if (grid == 0) {
        if (n_in != 23 || in_sizes[0] != M * D || out_size != M * D || ws_size < WS_END) { fprintf(stderr, "kernel_launch: unexpected shapes (n_in %d, in0 %d, out %d, ws %zu); nothing launched\n", n_in, n_in > 0 ? in_sizes[0] : -1, out_size, ws_size); grid = -1; return; }
        int dev = 0, cus = 0, per_cu = 0;
        if (hipGetDevice(&dev) != hipSuccess || hipDeviceGetAttribute(&cus, hipDeviceAttributeMultiprocessorCount, dev) != hipSuccess) { grid = -1; return; }
        if (hipFuncSetAttribute((const void*)mega_fwd, hipFuncAttributeMaxDynamicSharedMemorySize, LDS_BYTES) != hipSuccess) { fprintf(stderr, "kernel_launch: hipFuncSetAttribute failed\n"); grid = -1; return; }
        if (hipOccupancyMaxActiveBlocksPerMultiprocessor(&per_cu, (const void*)mega_fwd, NWAVES * 64, LDS_BYTES) != hipSuccess || per_cu < 1) { fprintf(stderr, "kernel_launch: occupancy query reports %d workgroups per CU\n", per_cu); }
        (void)hipGetLastError();
        grid = cus;
    }
    if (grid < 0) return;
    if (hipMemsetAsync((char*)d_ws + WS_CTL, 0, CTL_ZERO_BYTES, stream) != hipSuccess) { fprintf(stderr, "kernel_launch: memset failed\n"); return; }
    Args a{};
    for (int i = 0; i < 23; ++i) a.in[i] = (const float*)d_in[i];
    a.out = (float*)d_out; a.ws = (unsigned char*)d_ws;
    constexpr int NL = MK_N_LAUNCHES;
    for (int li = 0; li < NL; ++li) {
        a.ph_lo = (NL == 1) ? 0 : li; a.ph_hi = (NL == 1) ? N_PHASES : li + 1; a.li = (NL == 1) ? 0 : li; a.pad = 0;
        hipLaunchKernelGGL(mega_fwd, dim3(grid), dim3(NWAVES * 64), LDS_BYTES, stream, a);
        const hipError_t le = hipPeekAtLastError();
        if (le != hipSuccess) { fprintf(stderr, "kernel_launch: launch %d failed: %s\n", li, hipGetErrorName(le)); break; }
    }
}
```

```cpp
#include <hip/hip_runtime.h>
#include <cstdio>
#include <cstdint>
#ifndef SIMPLE_DIFF
#define SIMPLE_DIFF 0
#endif
#ifndef NATIVE_DIFF
#define NATIVE_DIFF 1
#endif

#define GAS __attribute__((address_space(1)))
#define LAS __attribute__((address_space(3)))
typedef unsigned short bf16_t;
typedef short bf16x8 __attribute__((ext_vector_type(8)));
typedef short s16x4 __attribute__((ext_vector_type(4)));
typedef float f32x4 __attribute__((ext_vector_type(4)));
typedef float f32x2 __attribute__((ext_vector_type(2)));
typedef unsigned u32x4 __attribute__((ext_vector_type(4)));
typedef unsigned u32x2 __attribute__((ext_vector_type(2)));
typedef int i32x4 __attribute__((ext_vector_type(4)));
#define RLX_AGENT __ATOMIC_RELAXED, __HIP_MEMORY_SCOPE_AGENT
#define LDS_WAIT() asm volatile("s_waitcnt lgkmcnt(0)" ::: "memory")
#define VM_WAIT() asm volatile("s_waitcnt vmcnt(0)" ::: "memory")

constexpr int BATCH = 2, SEQ = 8192, M = BATCH * SEQ, D = 1024, INW = 5120;
constexpr int NE = 32, TOPK = 4;
constexpr int NWAVES = 8;
constexpr float RMS_EPS = 1e-5f;
constexpr float LOG2E = 1.4426950408889634f;
constexpr float C2 = 0.125f * LOG2E;
constexpr int SLOT_ROWS = M * TOPK + NE * 256;

constexpr size_t MiB = 1u << 20, KiB = 1u << 10;
constexpr size_t WS_CTL = 0, CTL_ZERO_BYTES = 1 * MiB;
constexpr size_t WS_ADAP = 1 * MiB;
constexpr size_t WS_ADAF = 1 * MiB + 896 * KiB;
constexpr size_t WS_KMEAN = 512 * KiB;
constexpr size_t WS_TOPI = 2 * MiB + 256 * KiB;
constexpr size_t WS_TOPW = 2 * MiB + 512 * KiB;
constexpr size_t WS_TOKSLOT = 2 * MiB + 768 * KiB;
constexpr size_t WS_SLOTTOK = 3 * MiB;
constexpr size_t WS_SLOTW = 3 * MiB + 512 * KiB;
constexpr size_t WS_HIST = 4 * MiB;
constexpr size_t WS_EOFF = 4 * MiB + 64 * KiB;
constexpr size_t WS_WRT = 4 * MiB + 128 * KiB;
constexpr size_t WS_SLOTSA = 4 * MiB + 256 * KiB;
constexpr size_t WS_SW = 5 * MiB;
constexpr size_t WS_SWIN = 5 * MiB + 640 * KiB;
constexpr size_t WS_SA = 5 * MiB + 512 * KiB;
constexpr size_t WS_LIST = 6 * MiB;
constexpr size_t WS_PML = 14 * MiB;
constexpr size_t WS_WIN = 18 * MiB, WS_WBR = 28 * MiB, WS_WOUT = 30 * MiB, WS_WGU = 32 * MiB, WS_WD = 160 * MiB;
constexpr size_t WS_H = 224 * MiB;
constexpr size_t WS_PROJ = 256 * MiB;
constexpr size_t PROJ_STRIDE = 32 * MiB;
constexpr size_t WS_Y = 416 * MiB;
constexpr size_t WS_PO = 448 * MiB;
constexpr size_t WS_H2Q = 512 * MiB;
constexpr size_t WS_MERGED = 576 * MiB;
constexpr size_t WS_X1 = 608 * MiB;
constexpr size_t WS_ACT = 672 * MiB;
constexpr size_t WS_SOUT = 816 * MiB;
constexpr size_t WS_OA = 960 * MiB;
constexpr size_t WS_WINQ = 992 * MiB;
constexpr size_t WS_END = 1000 * MiB;
constexpr int LIST_PER_BH = 126976;
constexpr int CW_TMO = 0, CW_CODE = 1, CW_BAR = 4096, CW_MCNT = 65536, CW_TDONE = 80000, CW_AQ = 110000, CW_GDONE = 121000;

constexpr int RING_BYTES = 131072, LDSCTL_OFF = RING_BYTES, MISC_OFF = LDSCTL_OFF + 320, LDS_BYTES = 163840;

__device__ __forceinline__ unsigned f2bf(float f) { unsigned u = __builtin_bit_cast(unsigned, f); return (u + 0x7fffu + ((u >> 16) & 1u)) >> 16; }
__device__ __forceinline__ unsigned pk2(float lo, float hi) { return f2bf(lo) | (f2bf(hi) << 16); }
__device__ __forceinline__ unsigned cvt_pk_bf16(float lo, float hi) { unsigned r; asm volatile("v_cvt_pk_bf16_f32 %0, %1, %2" : "=v"(r) : "v"(lo), "v"(hi)); return r; }
__device__ __forceinline__ float bf_lo(unsigned u) { return __builtin_bit_cast(float, u << 16); }
__device__ __forceinline__ float bf_hi(unsigned u) { return __builtin_bit_cast(float, u & 0xffff0000u); }
__device__ __forceinline__ float sigmoidf_fast(float v) { return __builtin_amdgcn_rcpf(1.0f + __builtin_amdgcn_exp2f(-v * LOG2E)); }
__device__ __forceinline__ float wave_sum(float v) {
#pragma unroll
    for (int o = 1; o < 64; o <<= 1) v += __shfl_xor(v, o);
    return v;
}

namespace pg8 {
constexpr int BM = 256, BK = 64, HALF = 128, HTB = HALF * BK * 2, STAGE_BYTES = 8 * HTB, NXCD = 8, WGM = 8;
__device__ __forceinline__ int lds_byte(int r, int c) { const int st = (r >> 4) * 2 + (c >> 5), rr = r & 15, cc = c & 31, ob = rr * 64 + cc * 2; return st * 1024 + (ob ^ (((ob >> 9) & 1) << 5)); }
__device__ __forceinline__ void stage_rc(int b, int& R, int& C) { const int st = b / 1024, sb = b % 1024, swz = sb ^ (((sb >> 9) & 1) << 5); R = (st >> 1) * 16 + swz / 64; C = (st & 1) * 32 + (swz % 64) / 2; }
__device__ __forceinline__ int perm32(int rho) { const int n = rho >> 4, i = rho & 15; return 8 * (i >> 2) + 4 * n + (i & 3); }

struct Unit { int row0; int pm, pn, e, half; const char* bptr; };

struct DenseSched {
    static constexpr bool HAS_READY = false, HAS_DONE = false;
    int nM, nN, nwg, G, c; const char* Bt; size_t btile;
    int pn_base = 0, pn_skip_at = 1 << 30, pn_skip = 0;
    __device__ __forceinline__ void init(int M_, int N_, int G_, int c_, const void* Bt_, int ldb) { nM = M_ / BM; nN = N_ / BM; nwg = nM * nN; G = G_; c = c_; Bt = (const char*)Bt_; btile = (size_t)BM * ldb * 2; }
    __device__ __forceinline__ bool next(int i, Unit& u) const {
        const long L = (long)i * G + c; if (L >= nwg) return false;
        int wgid = (int)L; { const int q = nwg / NXCD, r = nwg % NXCD, xcd = wgid % NXCD, off = wgid / NXCD; wgid = (xcd < r ? xcd * (q + 1) : r * (q + 1) + (xcd - r) * q) + off; }
        const int nig = WGM * nN, gid = wgid / nig, fm = gid * WGM, gsz = (nM - fm) < WGM ? (nM - fm) : WGM;
        u.pm = fm + ((wgid % nig) % gsz); { const int pl = (wgid % nig) / gsz; u.pn = pn_base + pl + (pl >= pn_skip_at ? pn_skip : 0); } u.row0 = u.pm * BM; u.e = 0; u.half = 0; u.bptr = Bt + (size_t)u.pn * btile; return true;
    }
    __device__ __forceinline__ int arow(const Unit& u, int r) const { return u.row0 + r; }
    __device__ __forceinline__ void a_ready(const Unit&) const {}
    __device__ __forceinline__ void done(int) const {}
};

template <bool I8> struct AccSel { typedef f32x4 T; };
template <> struct AccSel<true> { typedef i32x4 T; };
template <class Epi, class Sched, bool ALIGN_EPI, bool I8 = false>
__device__ __forceinline__ void gemm_phase(LAS unsigned char* lds, const void* Abase_, int lda, int ldb, int K, const Sched& S, const Epi& E) {
    int tid_ = threadIdx.x; asm volatile("" : "+v"(tid_));
    const int tid = tid_, wid = __builtin_amdgcn_readfirstlane(tid >> 6), lane = tid & 63, wr = wid >> 2, wc = wid & 3, fr = lane & 15, fq = lane >> 4;
    const int nt = K / BK;
    const char* Abase = (const char*)Abase_;
    int Rr[2], Cc[2]; unsigned voffB[2];
#pragma unroll
    for (int i = 0; i < 2; ++i) { stage_rc(tid * 16 + i * 8192, Rr[i], Cc[i]); const int Rb = Epi::PERM ? ((Rr[i] & ~31) + perm32(Rr[i] & 31)) : Rr[i]; voffB[i] = (unsigned)(Rb * ldb + Cc[i]) * 2u; }
    const size_t kstep = (size_t)(BK * 2);
    const size_t hstepB = (size_t)HALF * ldb * 2;
    const unsigned ldsw = (unsigned)wid * 1024u;
    const int aoff = lds_byte(wr * 64 + fr, fq * 8), boff = lds_byte(wc * 32 + fr, fq * 8);
#define PG8_SA(b, h) (((b) * 2 + (h)) * HTB)
#define PG8_SB(b, h) ((4 + (b) * 2 + (h)) * HTB)
#define PG8_STAGE(bufoff, gbase, voff) do { _Pragma("unroll") for (int _i = 0; _i < 2; ++_i) \
        __builtin_amdgcn_global_load_lds((const unsigned*)((const char*)(gbase) + (voff)[_i]), (LAS unsigned*)(lds + (bufoff) + ldsw + _i * 8192), 16, 0, 0); } while (0)
#define PG8_LDA(dst, b, h) do { _Pragma("unroll") for (int m = 0; m < 4; ++m) _Pragma("unroll") for (int k = 0; k < 2; ++k) dst[m][k] = *(const LAS bf16x8*)(lds + PG8_SA(b, h) + aoff + m * 2048 + k * 1024); } while (0)
#define PG8_LDB(dst, b, h) do { _Pragma("unroll") for (int n = 0; n < 2; ++n) _Pragma("unroll") for (int k = 0; k < 2; ++k) dst[n][k] = *(const LAS bf16x8*)(lds + PG8_SB(b, h) + boff + n * 2048 + k * 1024); } while (0)
#define PG8_MMA(ai, bj, At, Bt) do { __builtin_amdgcn_s_setprio(1); _Pragma("unroll") for (int m = 0; m < 4; ++m) _Pragma("unroll") for (int n = 0; n < 2; ++n) _Pragma("unroll") for (int k = 0; k < 2; ++k) { \
        if constexpr (I8) acc[ai][bj][m][n] = __builtin_amdgcn_mfma_i32_16x16x64_i8(__builtin_bit_cast(i32x4, Bt[n][k]), __builtin_bit_cast(i32x4, At[m][k]), acc[ai][bj][m][n], 0, 0, 0); \
        else acc[ai][bj][m][n] = __builtin_amdgcn_mfma_f32_16x16x32_bf16(Bt[n][k], At[m][k], acc[ai][bj][m][n], 0, 0, 0); } __builtin_amdgcn_s_setprio(0); } while (0)
#define PG8_WAIT_V(n) asm volatile("s_waitcnt vmcnt(" #n ")" ::: "memory")
#define PG8_WAIT_L(n) asm volatile("s_waitcnt lgkmcnt(" #n ")" ::: "memory")
#define PG8_BAR __builtin_amdgcn_s_barrier()
#define PG8_SCHED __builtin_amdgcn_sched_barrier(0)
#define PG8_ROWS(u, va) do { _Pragma("unroll") for (int _h = 0; _h < 2; ++_h) _Pragma("unroll") for (int _i = 0; _i < 2; ++_i) \
        va[_h][_i] = (unsigned)(S.arow(u, _h * HALF + Rr[_i]) * lda + Cc[_i]) * 2u; } while (0)
    Unit cur, nxt; int ui = 0; int prev_pm = -1;
    if (!S.next(0, cur)) return;
    unsigned vaC[2][2], vaN[2][2];
    PG8_ROWS(cur, vaC);
    typedef typename AccSel<I8>::T acc_t;
    acc_t acc[2][2][4][2];
#pragma unroll
    for (int a = 0; a < 2; ++a)
#pragma unroll
        for (int b = 0; b < 2; ++b)
#pragma unroll
            for (int m = 0; m < 4; ++m)
#pragma unroll
                for (int n = 0; n < 2; ++n) acc[a][b][m][n] = (acc_t){0, 0, 0, 0};
    bf16x8 At[4][2], B0[2][2], B1[2][2];
    const char* cB = cur.bptr;
    if constexpr (Sched::HAS_READY) S.a_ready(cur);
    PG8_STAGE(PG8_SB(0, 0), cB, voffB); PG8_STAGE(PG8_SB(0, 1), cB + hstepB, voffB); PG8_STAGE(PG8_SA(0, 0), Abase, vaC[0]); PG8_STAGE(PG8_SA(0, 1), Abase, vaC[1]);
    if (wr == 1) PG8_BAR;
    PG8_WAIT_V(2); PG8_BAR;
    PG8_STAGE(PG8_SB(1, 0), cB + kstep, voffB); PG8_STAGE(PG8_SA(1, 0), Abase + kstep, vaC[0]); PG8_STAGE(PG8_SB(1, 1), cB + hstepB + kstep, voffB);
    PG8_WAIT_V(6); PG8_BAR;
    for (;;) {
        const bool has_next = S.next(ui + 1, nxt);
        if (has_next) { PG8_ROWS(nxt, vaN); } else { nxt = cur;
#pragma unroll
            for (int h = 0; h < 2; ++h)
#pragma unroll
                for (int i = 0; i < 2; ++i) vaN[h][i] = vaC[h][i]; }
        const char* nB = nxt.bptr;
        for (int t = 0; t < nt; t += 2) {
            if constexpr (Epi::HAS_MID) { if (t == (nt >> 1)) E.mid(acc, cur, wr, wc, fr, fq); }
            const bool last = (t == nt - 2);
            if constexpr (Sched::HAS_DONE) { if (last && prev_pm >= 0) { S.done(prev_pm); prev_pm = -1; } }
            if constexpr (Sched::HAS_READY) { if (last && has_next) S.a_ready(nxt); }
            const char* a1 = Abase + (size_t)(t + 1) * kstep;
            const char* a2 = last ? Abase : Abase + (size_t)(t + 2) * kstep; const char* b2 = last ? nB : cB + (size_t)(t + 2) * kstep;
            const char* a3 = a2 + kstep; const char* b3 = b2 + kstep;
            unsigned v2[2][2];
#pragma unroll
            for (int h = 0; h < 2; ++h)
#pragma unroll
                for (int i = 0; i < 2; ++i) v2[h][i] = last ? vaN[h][i] : vaC[h][i];
            PG8_LDB(B0, 0, 0); PG8_LDB(B1, 0, 1); PG8_SCHED; PG8_LDA(At, 0, 0); PG8_STAGE(PG8_SA(1, 1), a1, vaC[1]);
            PG8_WAIT_V(8); PG8_WAIT_L(0); PG8_BAR; PG8_MMA(0, 0, At, B0); PG8_MMA(0, 1, At, B1); PG8_BAR; PG8_SCHED;
            PG8_LDA(At, 0, 1); PG8_STAGE(PG8_SB(0, 0), b2, voffB); PG8_STAGE(PG8_SB(0, 1), b2 + hstepB, voffB); PG8_STAGE(PG8_SA(0, 0), a2, v2[0]);
            PG8_WAIT_V(8); PG8_WAIT_L(0); PG8_BAR; if (!cur.half) { PG8_MMA(1, 0, At, B0); PG8_MMA(1, 1, At, B1); } PG8_BAR; PG8_SCHED;
            PG8_LDB(B0, 1, 0); PG8_LDB(B1, 1, 1); PG8_SCHED; PG8_LDA(At, 1, 0); PG8_STAGE(PG8_SA(0, 1), a2, v2[1]);
            PG8_WAIT_V(8); PG8_WAIT_L(0); PG8_BAR; PG8_MMA(0, 0, At, B0); PG8_MMA(0, 1, At, B1); PG8_BAR; PG8_SCHED;
            PG8_LDA(At, 1, 1); PG8_STAGE(PG8_SB(1, 0), b3, voffB); PG8_STAGE(PG8_SB(1, 1), b3 + hstepB, voffB); PG8_STAGE(PG8_SA(1, 0), a3, v2[0]);
            PG8_WAIT_V(8); PG8_WAIT_L(0); PG8_BAR; if (!cur.half) { PG8_MMA(1, 0, At, B0); PG8_MMA(1, 1, At, B1); } PG8_BAR; PG8_SCHED;
        }
        if constexpr (ALIGN_EPI) { if (wr == 0) PG8_BAR; }
        E(acc, cur, wr, wc, fr, fq); if constexpr (Sched::HAS_DONE) prev_pm = cur.pm;
        if (!has_next) break;
#pragma unroll
        for (int a = 0; a < 2; ++a)
#pragma unroll
            for (int b = 0; b < 2; ++b)
#pragma unroll
                for (int m = 0; m < 4; ++m)
#pragma unroll
                    for (int n = 0; n < 2; ++n) acc[a][b][m][n] = (acc_t){0, 0, 0, 0};
        cur = nxt; cB = nB; ++ui;
#pragma unroll
        for (int h = 0; h < 2; ++h)
#pragma unroll
            for (int i = 0; i < 2; ++i) vaC[h][i] = vaN[h][i];
        if constexpr (ALIGN_EPI) { if (wr == 1) PG8_BAR; }
    }
    PG8_WAIT_V(0);
    if constexpr (Sched::HAS_DONE) { if (prev_pm >= 0) S.done(prev_pm); }
    if constexpr (!ALIGN_EPI) { if (wr == 0) PG8_BAR; }
    PG8_BAR;
#undef PG8_SA
#undef PG8_SB
#undef PG8_STAGE
#undef PG8_LDA
#undef PG8_LDB
#undef PG8_MMA
#undef PG8_WAIT_V
#undef PG8_WAIT_L
#undef PG8_BAR
#undef PG8_SCHED
#undef PG8_ROWS
}
}
#define XB_TMO      128
#define XB_XCNT(j)  (256  + 64 * (j))
#define XB_XSUB(j)  (1280 + 64 * (j))
#define XB_XGEN(j)  (2304 + 64 * (j))
#define XB_TOP      3328
#define XB_TOPGEN   3392
#define XCD_BAR_WORDS 3456
#define XB_SPIN_CAP (1u << 18)

__device__ __forceinline__ unsigned xb_ld(unsigned* p)              { return __hip_atomic_load(p, __ATOMIC_RELAXED, __HIP_MEMORY_SCOPE_AGENT); }
__device__ __forceinline__ unsigned xb_add(unsigned* p, unsigned v) { return __hip_atomic_fetch_add(p, v, __ATOMIC_RELAXED, __HIP_MEMORY_SCOPE_AGENT); }
__device__ __forceinline__ unsigned xb_xcc_id() { return (unsigned)__builtin_amdgcn_s_getreg((3 << 11) | 20) & 0xFu; }
#define XB_SPIN(cond, bar) do { unsigned _sp = 0; while (cond) { __builtin_amdgcn_s_sleep(1); \
    if ((++_sp & 255u) == 0u) { if (xb_ld(&(bar)[XB_TMO])) break; if (_sp > XB_SPIN_CAP) { atomicAdd(&(bar)[XB_TMO], 1u); break; } } } } while (0)

struct XcdBarrier {
    unsigned* bar; unsigned x;
    volatile LAS unsigned* st;
};

__device__ __forceinline__ XcdBarrier xcd_barrier_post(unsigned* bar, volatile LAS unsigned* st) {
    XcdBarrier b; b.bar = bar; b.x = xb_xcc_id(); b.st = st;
    if (threadIdx.x == 0) (void)xb_add(&bar[XB_XCNT(b.x)], 1u);
    return b;
}
__device__ __forceinline__ void xcd_barrier_complete(unsigned* bar, unsigned x, unsigned& nloc, unsigned& nx) {
    const unsigned G = gridDim.x * gridDim.y * gridDim.z;
    unsigned sum, cnt, mine, sp = 0u;
    for (;;) {
        sum = 0u; cnt = 0u; mine = 0u;
#pragma unroll
        for (unsigned j = 0; j < 16; ++j) { const unsigned c = xb_ld(&bar[XB_XCNT(j)]); sum += c; cnt += (c > 0u) ? 1u : 0u; mine = (j == x) ? c : mine; }
        if (sum == G) break;
        __builtin_amdgcn_s_sleep(1);
        if ((++sp & 255u) == 0u) { if (xb_ld(&bar[XB_TMO])) break; if (sp > XB_SPIN_CAP) { atomicAdd(&bar[XB_TMO], 1u); break; } }
    }
    nloc = mine > 0u ? mine : 1u; nx = cnt > 0u ? cnt : 1u;
}

__device__ __forceinline__ void xcd_barrier(const XcdBarrier& b) {
    asm volatile("s_waitcnt vmcnt(0)" ::: "memory");
    __syncthreads();
    if (threadIdx.x == 0) {
        unsigned* bar = b.bar;
        __builtin_amdgcn_s_waitcnt(0);
        unsigned nloc = b.st[0], nx = b.st[1];
        if (nloc == 0u) { xcd_barrier_complete(bar, b.x, nloc, nx); b.st[0] = nloc; b.st[1] = nx; }
        const unsigned old = xb_add(&bar[XB_XSUB(b.x)], 1u);
        const unsigned gen = old / nloc;
        if (old + 1u == (gen + 1u) * nloc) {
            __builtin_amdgcn_fence(__ATOMIC_RELEASE, "agent");
            asm volatile("s_waitcnt vmcnt(0)" ::: "memory");
            const unsigned og = xb_add(&bar[XB_TOP], 1u);
            const unsigned tg = og / nx;
            if (og + 1u == (tg + 1u) * nx) xb_add(&bar[XB_TOPGEN], 1u);
            else XB_SPIN(xb_ld(&bar[XB_TOPGEN]) == tg, bar);
            __builtin_amdgcn_fence(__ATOMIC_ACQUIRE, "agent");
            xb_add(&bar[XB_XGEN(b.x)], 1u);
            asm volatile("s_waitcnt vmcnt(0)" ::: "memory");
        } else {
            XB_SPIN(xb_ld(&bar[XB_XGEN(b.x)]) == gen, bar);
            __builtin_amdgcn_fence(__ATOMIC_ACQUIRE, "agent");
            asm volatile("s_waitcnt vmcnt(0)" ::: "memory");
        }
    }
    __syncthreads();
}
namespace pg8 {
struct EpiProj {
    static constexpr bool PERM = true, HAS_MID = false;
    bf16_t* base; float* kmean;
    __device__ __forceinline__ void operator()(const f32x4 (&acc)[2][2][4][2], const Unit& u, int wr, int wc, int fr, int fq) const {
        if (u.pn == 8 || u.pn == 9) {
            const int b = u.pm >> 5, nblk = u.pm & 31;
#pragma unroll
            for (int bj = 0; bj < 2; ++bj)
#pragma unroll
                for (int n = 0; n < 2; ++n) { f32x4 s = (f32x4){0.f, 0.f, 0.f, 0.f};
#pragma unroll
                    for (int ai = 0; ai < 2; ++ai)
#pragma unroll
                        for (int m = 0; m < 4; ++m) s += acc[ai][bj][m][n];
#pragma unroll
                    for (int j = 0; j < 4; ++j) { float v = s[j]; v += __shfl_xor(v, 1); v += __shfl_xor(v, 2); v += __shfl_xor(v, 4); v += __shfl_xor(v, 8); s[j] = v; }
                    if (fr == 0) { const int col = (u.pn - 8) * 256 + bj * HALF + wc * 32 + 8 * fq + 4 * n; const int h = col >> 6, d = col & 63; float* kp = kmean + ((size_t)((b * 8 + h) * 32 + nblk)) * 64 + d;
#pragma unroll
                        for (int j = 0; j < 4; ++j) atomicAdd(kp + j, s[j] * (1.0f / 256.0f)); } }
        }
        const int buf = u.pn >> 2, colt = (u.pn & 3) * 256;
        const float sc = (u.pn < 2 || u.pn == 6 || u.pn == 7) ? C2 : 1.0f;
        bf16_t* dst = base + (size_t)buf * (PROJ_STRIDE / 2);
        const int row0 = u.row0 + wr * 64 + fr, col0 = colt + wc * 32 + 8 * fq;
#pragma unroll
        for (int ai = 0; ai < 2; ++ai)
#pragma unroll
            for (int m = 0; m < 4; ++m) { bf16_t* rowp = dst + (size_t)(row0 + ai * HALF + m * 16) * 1024 + col0;
#pragma unroll
                for (int bj = 0; bj < 2; ++bj) { const f32x4 v0 = acc[ai][bj][m][0] * sc, v1 = acc[ai][bj][m][1] * sc;
                    u32x4 w; w.x = cvt_pk_bf16(v0[0], v0[1]); w.y = cvt_pk_bf16(v0[2], v0[3]); w.z = cvt_pk_bf16(v1[0], v1[1]); w.w = cvt_pk_bf16(v1[2], v1[3]);
                    *(u32x4*)(rowp + bj * HALF) = w; } }
    }
};
struct EpiProjQ {
    static constexpr bool PERM = true, HAS_MID = false;
    bf16_t* base; const float* sa; const float* sw;
    __device__ __forceinline__ void operator()(const i32x4 (&acc)[2][2][4][2], const Unit& u, int wr, int wc, int fr, int fq) const {
        const int buf = u.pn >> 2, colt = (u.pn & 3) * 256;
        const float sc = (u.pn < 2) ? C2 : 1.0f;
        bf16_t* dst = base + (size_t)buf * (PROJ_STRIDE / 2);
        const int row0 = u.row0 + wr * 64 + fr, col0 = colt + wc * 32 + 8 * fq;
        const float* swp = sw + u.pn * 256 + wc * 32 + 8 * fq;
        f32x4 sv[2][2];
#pragma unroll
        for (int bj = 0; bj < 2; ++bj)
#pragma unroll
            for (int n = 0; n < 2; ++n) sv[bj][n] = *(const f32x4*)(swp + bj * HALF + 4 * n) * sc;
#pragma unroll
        for (int ai = 0; ai < 2; ++ai)
#pragma unroll
            for (int m = 0; m < 4; ++m) { const int row = row0 + ai * HALF + m * 16; const float ts = sa[row]; bf16_t* rowp = dst + (size_t)row * 1024 + col0;
#pragma unroll
                for (int bj = 0; bj < 2; ++bj) { const i32x4 a0 = acc[ai][bj][m][0], a1 = acc[ai][bj][m][1];
                    const f32x4 v0 = (f32x4){(float)a0[0], (float)a0[1], (float)a0[2], (float)a0[3]} * (sv[bj][0] * ts), v1 = (f32x4){(float)a1[0], (float)a1[1], (float)a1[2], (float)a1[3]} * (sv[bj][1] * ts);
                    u32x4 w; w.x = cvt_pk_bf16(v0[0], v0[1]); w.y = cvt_pk_bf16(v0[2], v0[3]); w.z = cvt_pk_bf16(v1[0], v1[1]); w.w = cvt_pk_bf16(v1[2], v1[3]);
                    *(u32x4*)(rowp + bj * HALF) = w; } }
    }
};
struct EpiBr {
    static constexpr bool PERM = true, HAS_MID = true;
    const bf16_t* gla; const bf16_t* glb; bf16_t* out;
    __device__ __forceinline__ void mid(f32x4 (&acc)[2][2][4][2], const Unit& u, int wr, int wc, int fr, int fq) const {
        int row0 = u.row0 + wr * 64 + fr, col0 = u.pn * 256 + wc * 32 + 8 * fq; asm volatile("" : "+v"(row0), "+v"(col0));
#pragma unroll
        for (int ai = 0; ai < 2; ++ai)
#pragma unroll
            for (int m = 0; m < 4; ++m) { const size_t ro = (size_t)(row0 + ai * HALF + m * 16) * 1024 + col0;
#pragma unroll
                for (int bj = 0; bj < 2; ++bj) { const u32x4 ga = *(const u32x4*)(gla + ro + bj * HALF), gb = *(const u32x4*)(glb + ro + bj * HALF);
                    f32x4 r0, r1;
#define RT2(R, I, GA, GB) do { f32x2 ea = (f32x2){bf_lo(GA), bf_hi(GA)} * (f32x2){-LOG2E, -LOG2E}, eb = (f32x2){bf_lo(GB), bf_hi(GB)} * (f32x2){-LOG2E, -LOG2E}; \
                        ea[0] = __builtin_amdgcn_exp2f(ea[0]); ea[1] = __builtin_amdgcn_exp2f(ea[1]); eb[0] = __builtin_amdgcn_exp2f(eb[0]); eb[1] = __builtin_amdgcn_exp2f(eb[1]); \
                        ea = ea + (f32x2){1.0f, 1.0f}; eb = eb + (f32x2){1.0f, 1.0f}; ea[0] = __builtin_amdgcn_rcpf(ea[0]); ea[1] = __builtin_amdgcn_rcpf(ea[1]); const f32x2 q_ = eb * ea; R[I] = q_[0]; R[I + 1] = q_[1]; } while (0)
                    RT2(r0, 0, ga.x, gb.x); RT2(r0, 2, ga.y, gb.y); RT2(r1, 0, ga.z, gb.z); RT2(r1, 2, ga.w, gb.w);
#undef RT2
                    acc[ai][bj][m][0] *= r0; acc[ai][bj][m][1] *= r1; } }
    }
    __device__ __forceinline__ void operator()(const f32x4 (&acc)[2][2][4][2], const Unit& u, int wr, int wc, int fr, int fq) const {
        int row0 = u.row0 + wr * 64 + fr, col0 = u.pn * 256 + wc * 32 + 8 * fq; asm volatile("" : "+v"(row0), "+v"(col0));
#pragma unroll
        for (int ai = 0; ai < 2; ++ai)
#pragma unroll
            for (int m = 0; m < 4; ++m) { const size_t ro = (size_t)(row0 + ai * HALF + m * 16) * 1024 + col0;
#pragma unroll
                for (int bj = 0; bj < 2; ++bj) { const u32x4 g = *(const u32x4*)(glb + ro + bj * HALF); const f32x4 v0 = acc[ai][bj][m][0], v1 = acc[ai][bj][m][1];
#define SG2(G, VA, VB) ({ f32x2 e_ = (f32x2){bf_lo(G), bf_hi(G)} * (f32x2){-LOG2E, -LOG2E}; e_[0] = __builtin_amdgcn_exp2f(e_[0]); e_[1] = __builtin_amdgcn_exp2f(e_[1]); e_ = e_ + (f32x2){1.0f, 1.0f}; \
                        e_[0] = __builtin_amdgcn_rcpf(e_[0]); e_[1] = __builtin_amdgcn_rcpf(e_[1]); e_ = e_ * (f32x2){VA, VB}; cvt_pk_bf16(e_[0], e_[1]); })
                    u32x4 w; w.x = SG2(g.x, v0[0], v0[1]); w.y = SG2(g.y, v0[2], v0[3]); w.z = SG2(g.z, v1[0], v1[1]); w.w = SG2(g.w, v1[2], v1[3]);
#undef SG2
                    *(u32x4*)(out + ro + bj * HALF) = w; } }
    }
};
struct EpiOut {
    static constexpr bool PERM = true, HAS_MID = false;
    const float* x; const float* adaf; bf16_t* x1;
    __device__ __forceinline__ void operator()(const f32x4 (&acc)[2][2][4][2], const Unit& u, int wr, int wc, int fr, int fq) const {
        const int row0 = u.row0 + wr * 64 + fr, col0 = u.pn * 256 + wc * 32 + 8 * fq;
        const float* gt = adaf + (u.row0 >= SEQ ? 6144 : 0) + 2048;
        f32x4 gv[2][2];
#pragma unroll
        for (int bj = 0; bj < 2; ++bj)
#pragma unroll
            for (int n = 0; n < 2; ++n) gv[bj][n] = *(const f32x4*)(gt + col0 + bj * HALF + 4 * n);
#pragma unroll
        for (int ai = 0; ai < 2; ++ai)
#pragma unroll
            for (int m = 0; m < 4; ++m) { const size_t ro = (size_t)(row0 + ai * HALF + m * 16) * 1024 + col0;
#pragma unroll
                for (int bj = 0; bj < 2; ++bj) { const f32x4 x0 = *(const f32x4*)(x + ro + bj * HALF), x4 = *(const f32x4*)(x + ro + bj * HALF + 4);
                    const f32x4 v0 = x0 + gv[bj][0] * acc[ai][bj][m][0], v1 = x4 + gv[bj][1] * acc[ai][bj][m][1];
                    u32x4 w; w.x = cvt_pk_bf16(v0[0], v0[1]); w.y = cvt_pk_bf16(v0[2], v0[3]); w.z = cvt_pk_bf16(v1[0], v1[1]); w.w = cvt_pk_bf16(v1[2], v1[3]);
                    *(u32x4*)(x1 + ro + bj * HALF) = w; } }
    }
};
struct EpiGU {
    static constexpr bool PERM = true, HAS_MID = false;
    const float* bgu; bf16_t* act;
    __device__ __forceinline__ void operator()(const f32x4 (&acc)[2][2][4][2], const Unit& u, int wr, int wc, int fr, int fq) const {
        const int row0 = u.row0 + wr * 64 + fr, col0 = u.pn * 128 + wc * 32 + 8 * fq;
        const float* bg = bgu + (size_t)u.e * 2048 + col0;
        f32x4 bgv[2], buv[2];
#pragma unroll
        for (int n = 0; n < 2; ++n) { bgv[n] = *(const f32x4*)(bg + 4 * n); buv[n] = *(const f32x4*)(bg + 1024 + 4 * n); }
#pragma unroll
        for (int ai = 0; ai < 2; ++ai)
#pragma unroll
            for (int m = 0; m < 4; ++m) { float r[8];
#pragma unroll
                for (int n = 0; n < 2; ++n)
#pragma unroll
                    for (int j = 0; j < 4; ++j) { const float gte = fminf(acc[ai][0][m][n][j] + bgv[n][j], 7.0f); const float up = fminf(fmaxf(acc[ai][1][m][n][j] + buv[n][j], -7.0f), 7.0f);
                        r[4 * n + j] = (up + 1.0f) * gte * sigmoidf_fast(1.702f * gte); }
                u32x4 w; w.x = cvt_pk_bf16(r[0], r[1]); w.y = cvt_pk_bf16(r[2], r[3]); w.z = cvt_pk_bf16(r[4], r[5]); w.w = cvt_pk_bf16(r[6], r[7]);
                *(u32x4*)(act + (size_t)(row0 + ai * HALF + m * 16) * 1024 + col0) = w; }
    }
};
struct EpiGUQ {
    static constexpr bool PERM = true, HAS_MID = false;
    const float* bgu; const float* sw; const float* slot_sa; bf16_t* act;
    __device__ __forceinline__ void operator()(const i32x4 (&acc)[2][2][4][2], const Unit& u, int wr, int wc, int fr, int fq) const {
        const int row0 = u.row0 + wr * 64 + fr, col0 = u.pn * 128 + wc * 32 + 8 * fq;
        const float* bg = bgu + (size_t)u.e * 2048 + col0; const float* sg = sw + (size_t)u.e * 2048 + col0;
        f32x4 bgv[2], buv[2], sgv[2], suv[2];
#pragma unroll
        for (int n = 0; n < 2; ++n) { bgv[n] = *(const f32x4*)(bg + 4 * n); buv[n] = *(const f32x4*)(bg + 1024 + 4 * n); sgv[n] = *(const f32x4*)(sg + 4 * n); suv[n] = *(const f32x4*)(sg + 1024 + 4 * n); }
#pragma unroll
        for (int ai = 0; ai < 2; ++ai)
#pragma unroll
            for (int m = 0; m < 4; ++m) { if (ai == 1 && u.half) continue; const int row = row0 + ai * HALF + m * 16; const float ts = slot_sa[row]; unsigned r[4];
#pragma unroll
                for (int n = 0; n < 2; ++n)
#pragma unroll
                    for (int h = 0; h < 2; ++h) { const int j = 2 * h;
                        const f32x2 ag = (f32x2){(float)acc[ai][0][m][n][j], (float)acc[ai][0][m][n][j + 1]}, au = (f32x2){(float)acc[ai][1][m][n][j], (float)acc[ai][1][m][n][j + 1]};
                        const f32x2 tsv = (f32x2){ts, ts};
                        f32x2 g = ag * ((f32x2){sgv[n][j], sgv[n][j + 1]} * tsv) + (f32x2){bgv[n][j], bgv[n][j + 1]};
                        f32x2 up = au * ((f32x2){suv[n][j], suv[n][j + 1]} * tsv) + (f32x2){buv[n][j], buv[n][j + 1]};
                        g[0] = fminf(g[0], 7.0f); g[1] = fminf(g[1], 7.0f); up[0] = fminf(fmaxf(up[0], -7.0f), 7.0f); up[1] = fminf(fmaxf(up[1], -7.0f), 7.0f);
                        f32x2 e = g * (f32x2){-1.702f * LOG2E, -1.702f * LOG2E};
                        e[0] = __builtin_amdgcn_exp2f(e[0]); e[1] = __builtin_amdgcn_exp2f(e[1]);
                        e = e + (f32x2){1.0f, 1.0f};
                        e[0] = __builtin_amdgcn_rcpf(e[0]); e[1] = __builtin_amdgcn_rcpf(e[1]);
                        const f32x2 o = (up + (f32x2){1.0f, 1.0f}) * (g * e);
                        r[2 * n + h] = cvt_pk_bf16(o[0], o[1]); }
                u32x4 w; w.x = r[0]; w.y = r[1]; w.z = r[2]; w.w = r[3];
                *(u32x4*)(act + (size_t)row * 1024 + col0) = w; }
    }
};
struct EpiDown {
    static constexpr bool PERM = true, HAS_MID = false;
    const float* bd; const float* slotw; bf16_t* out;
    __device__ __forceinline__ void operator()(const f32x4 (&acc)[2][2][4][2], const Unit& u, int wr, int wc, int fr, int fq) const {
        const int row0 = u.row0 + wr * 64 + fr, col0 = u.pn * 256 + wc * 32 + 8 * fq;
        const float* bp = bd + (size_t)u.e * 1024 + col0;
        f32x4 bv[2][2];
#pragma unroll
        for (int bj = 0; bj < 2; ++bj)
#pragma unroll
            for (int n = 0; n < 2; ++n) bv[bj][n] = *(const f32x4*)(bp + bj * HALF + 4 * n);
#pragma unroll
        for (int ai = 0; ai < 2; ++ai)
#pragma unroll
            for (int m = 0; m < 4; ++m) { if (ai == 1 && u.half) continue; const int row = row0 + ai * HALF + m * 16; const float w8 = slotw[row]; bf16_t* rowp = out + (size_t)row * 1024 + col0;
#pragma unroll
                for (int bj = 0; bj < 2; ++bj) { const f32x4 v0 = (acc[ai][bj][m][0] + bv[bj][0]) * w8, v1 = (acc[ai][bj][m][1] + bv[bj][1]) * w8;
                    u32x4 w; w.x = cvt_pk_bf16(v0[0], v0[1]); w.y = cvt_pk_bf16(v0[2], v0[3]); w.z = cvt_pk_bf16(v1[0], v1[1]); w.w = cvt_pk_bf16(v1[2], v1[3]);
                    *(u32x4*)(rowp + bj * HALF) = w; } }
    }
};
template <bool GATHER, bool WAIT, bool SIGNAL, bool SPLIT = false> struct MoeSched {
    static constexpr bool HAS_READY = WAIT, HAS_DONE = SIGNAL;
    const LAS int* te; int NP, G, c; const int* slot_tok; const char* W; size_t wstride, btile; unsigned* tdone; unsigned* tmo;
    __device__ __forceinline__ bool next(int i, Unit& u) const {
        const int ntl = te[32], nwg = ntl * NP;
        const int rounds = (nwg + G - 1) / G, rem = nwg - (rounds - 1) * G; const bool split = SPLIT && 2 * rem <= G;
        long L = (long)i * G + c; int half = 0, hsel = 0;
        if (split && i == rounds - 1) { if (c >= 2 * rem) return false; L = (long)i * G + (c >> 1); half = 1; hsel = c & 1; }
        if (L >= nwg) return false;
        int wgid = (int)L; { const int q = nwg / NXCD, r = nwg % NXCD, xcd = wgid % NXCD, off = wgid / NXCD; wgid = (xcd < r ? xcd * (q + 1) : r * (q + 1) + (xcd - r) * q) + off; }
        int e = 0;
        for (int k = 1; k < NE; ++k) e += (wgid >= te[k] * NP) ? 1 : 0;
        const int t0 = te[e], nte = te[e + 1] - t0, r_ = wgid - t0 * NP; const int pn = r_ / nte, t = t0 + r_ % nte;
        u.row0 = t * 256 + hsel * 128; u.pn = pn; u.pm = t; u.e = e; u.half = half; u.bptr = W + (size_t)e * wstride + (size_t)pn * btile; return true;
    }
    __device__ __forceinline__ int arow(const Unit& u, int r) const { if (u.half) r &= 127; if constexpr (GATHER) return slot_tok[u.row0 + r]; else return u.row0 + r; }
    __device__ __forceinline__ void a_ready(const Unit& u) const {
        if constexpr (WAIT) {
            if (threadIdx.x < 64) {
                const unsigned long long t0 = __builtin_amdgcn_s_memrealtime(); unsigned polls = 0;
                while ((unsigned)__builtin_amdgcn_readfirstlane(__hip_atomic_load(tdone + 64 * u.pm, __ATOMIC_RELAXED, __HIP_MEMORY_SCOPE_AGENT)) < 64u) {
                    if ((++polls & 255u) == 0u && __builtin_amdgcn_readfirstlane(__hip_atomic_load(tmo, __ATOMIC_RELAXED, __HIP_MEMORY_SCOPE_AGENT)) != 0u) break;
                    if (__builtin_amdgcn_s_memrealtime() - t0 > 2000000ull) { if (threadIdx.x == 0) __hip_atomic_store(tmo, 1u, __ATOMIC_RELAXED, __HIP_MEMORY_SCOPE_AGENT); break; }
                    __builtin_amdgcn_s_sleep(2); }
                __builtin_amdgcn_fence(__ATOMIC_ACQUIRE, "agent");
                asm volatile("s_waitcnt vmcnt(0)" ::: "memory");
            }
            asm volatile("" ::: "memory"); __builtin_amdgcn_s_barrier(); asm volatile("" ::: "memory");
        }
    }
    __device__ __forceinline__ void done(int pm) const {
        if constexpr (SIGNAL) {
            if ((threadIdx.x & 63) == 0) __hip_atomic_fetch_add(tdone + 64 * pm, 1u, __ATOMIC_RELAXED, __HIP_MEMORY_SCOPE_AGENT); }
    }
};
}

constexpr int BT_STR = 132;
constexpr int AT_BT = LDSCTL_OFF + 1024, AT_K = 0, AT_V = AT_K + 64 * 72 * 2, AT_MISC = LDSCTL_OFF + 8192;
typedef short v4i16_t __attribute__((ext_vector_type(4)));
__device__ __forceinline__ s16x4 tr16(const LAS unsigned char* p) { return __builtin_bit_cast(s16x4, __builtin_amdgcn_ds_read_tr16_b64_v4i16((LAS v4i16_t*)p)); }

template <int NDT>
__device__ __forceinline__ void attn_tile(const LAS unsigned char* lds, int lane, const bf16x8 (&qf)[2], f32x4 (&o)[NDT], float& m_run, float& l_run,
                                          int qpos, int kbase, bool causal, const LAS float* bt) {
    constexpr int VSTR = NDT * 16 + 8;
    const int c = lane & 15, g = lane >> 4;
    f32x4 s[4];
#pragma unroll
    for (int kt = 0; kt < 4; ++kt) { s[kt] = (f32x4){0.f, 0.f, 0.f, 0.f};
#pragma unroll
        for (int ks = 0; ks < 2; ++ks) { const bf16x8 a = *(const LAS bf16x8*)(lds + AT_K + ((16 * kt + c) * 72 + 32 * ks + 8 * g) * 2);
            s[kt] = __builtin_amdgcn_mfma_f32_16x16x32_bf16(a, qf[ks], s[kt], 0, 0, 0); } }
    if (__any((qpos - (kbase + 63)) < 128)) {
#pragma unroll
        for (int kt = 0; kt < 4; ++kt)
#pragma unroll
            for (int i = 0; i < 4; ++i) { const int dist = qpos - (kbase + 16 * kt + 4 * g + i); const int di = dist < 0 ? 0 : (dist > 127 ? 127 : dist);
                const float bv = bt[di]; float v = s[kt][i];
                if (dist >= 0 && dist < 128) v += bv;
                if (causal && dist < 0) v = -INFINITY;
                s[kt][i] = v; }
    }
    float mx = fmaxf(fmaxf(s[0][0], s[0][1]), fmaxf(s[0][2], s[0][3]));
#pragma unroll
    for (int kt = 1; kt < 4; ++kt) mx = fmaxf(mx, fmaxf(fmaxf(s[kt][0], s[kt][1]), fmaxf(s[kt][2], s[kt][3])));
    mx = fmaxf(mx, __shfl_xor(mx, 16)); mx = fmaxf(mx, __shfl_xor(mx, 32));
    const float m_new = fmaxf(m_run, mx), alpha = __builtin_amdgcn_exp2f(m_run - m_new);
    float psum = 0.f;
#pragma unroll
    for (int kt = 0; kt < 4; ++kt)
#pragma unroll
        for (int i = 0; i < 4; ++i) { const float p = __builtin_amdgcn_exp2f(s[kt][i] - m_new); s[kt][i] = p; psum += p; }
    l_run = l_run * alpha + psum; m_run = m_new;
#pragma unroll
    for (int i = 0; i < 4; ++i) { const float ai = __shfl(alpha, 4 * g + i);
#pragma unroll
        for (int dt = 0; dt < NDT; ++dt) o[dt][i] *= ai; }
    bf16x8 pa[2];
#pragma unroll
    for (int kk = 0; kk < 2; ++kk) { u32x4 w; w.x = cvt_pk_bf16(s[2 * kk][0], s[2 * kk][1]); w.y = cvt_pk_bf16(s[2 * kk][2], s[2 * kk][3]);
        w.z = cvt_pk_bf16(s[2 * kk + 1][0], s[2 * kk + 1][1]); w.w = cvt_pk_bf16(s[2 * kk + 1][2], s[2 * kk + 1][3]); pa[kk] = __builtin_bit_cast(bf16x8, w); }
    const LAS unsigned char* vb = lds + AT_V + ((4 * g + (c >> 2)) * VSTR + 4 * (c & 3)) * 2;
#pragma unroll
    for (int dt = 0; dt < NDT; ++dt)
#pragma unroll
        for (int kk = 0; kk < 2; ++kk) { const s16x4 lo = tr16(vb + (32 * kk * VSTR + 16 * dt) * 2), hi = tr16(vb + ((32 * kk + 16) * VSTR + 16 * dt) * 2);
            const bf16x8 b = (bf16x8){lo[0], lo[1], lo[2], lo[3], hi[0], hi[1], hi[2], hi[3]};
            o[dt] = __builtin_amdgcn_mfma_f32_16x16x32_bf16(pa[kk], b, o[dt], 0, 0, 0); }
}

template <int NV> struct TileRegs { u32x4 k; u32x4 v[NV]; };
template <int NV> __device__ __forceinline__ void tile_fetch(TileRegs<NV>& r, const bf16_t* kg, const bf16_t* vg, int tid) {
    const int row = tid >> 3, ch = tid & 7;
    r.k = *(const u32x4*)(kg + (size_t)row * 1024 + ch * 8);
#pragma unroll
    for (int i = 0; i < NV; ++i) r.v[i] = *(const u32x4*)(vg + (size_t)row * 1024 + (ch + 8 * i) * 8);
}
template <int NV> __device__ __forceinline__ void tile_store(const TileRegs<NV>& r, LAS unsigned char* lds, int tid) {
    constexpr int VSTR = NV * 64 + 8;
    const int row = tid >> 3, ch = tid & 7;
    *(LAS u32x4*)(lds + AT_K + (row * 72 + ch * 8) * 2) = r.k;
#pragma unroll
    for (int i = 0; i < NV; ++i) *(LAS u32x4*)(lds + AT_V + (row * VSTR + (ch + 8 * i) * 8) * 2) = r.v[i];
}
#include <hip/hip_bf16.h>
#include <cmath>
namespace attn_body {
using bf16=__hip_bfloat16;
using bf16x8=__attribute__((ext_vector_type(8)))short;
using s16x4=__attribute__((ext_vector_type(4)))short;
using f32x16=__attribute__((ext_vector_type(16)))float;
using u32x4=__attribute__((ext_vector_type(4)))unsigned;
constexpr int BATCH=2,NHEAD=16,SEQ=8192,D=64,DM=NHEAD*D;
constexpr int NW=8,QBLK=32,QB=QBLK*NW,KVBLK=64,NQB=SEQ/QB;
constexpr int ATTN_PITCH=DM, ATTN_UNIT_ROWS=QB;
__device__ __forceinline__ int crow(int r,int hi){return (r&3)+8*(r>>2)+4*hi;}
#define SBAR() __builtin_amdgcn_sched_barrier(0)
typedef const __attribute__((address_space(3))) float* lds_cfptr;
__device__ __forceinline__ void cbias(f32x16&p0,f32x16&p1,int jb,int qrel,int hi,lds_cfptr bt){
  const float NEG=-INFINITY; const int kb=64*jb+4*hi;
  #pragma unroll
  for(int r=0;r<16;++r){const int d0=qrel-(kb+(r&3)+8*(r>>2)),d1=d0-32;
    const unsigned c0=(unsigned)d0<128u?(unsigned)d0:128u,c1=(unsigned)d1<128u?(unsigned)d1:128u;
    const float v0=p0[r]+bt[c0],v1=p1[r]+bt[c1];
    p0[r]=d0<0?NEG:v0; p1[r]=d1<0?NEG:v1;}
}
constexpr int NSLOT=3, SLOTB=8192;
constexpr int LDS_K=0, LDS_V=NSLOT*SLOTB, LDS_WS=2*NSLOT*SLOTB, LDS_OST=LDS_WS+NW*64*4, LDS_BYTES=LDS_OST+NW*4096;
constexpr float C2=0.125f*1.4426950408889634f;
__device__ __forceinline__ void glds16(const void*gsrc,unsigned lds_dst){unsigned keep;
  asm volatile("s_mov_b32 %0, m0\n\ts_mov_b32 m0, %2\n\ts_nop 0\n\tglobal_load_lds_dwordx4 %1, off\n\ts_mov_b32 m0, %0":"=&s"(keep):"v"(gsrc),"s"(lds_dst):"memory");}
__device__ __forceinline__ float max3f(float a,float b,float c){float r;asm("v_max3_f32 %0, %1, %2, %3":"=v"(r):"v"(a),"v"(b),"v"(c));return r;}
__device__ __forceinline__ float max2f(float a,float b){float r;asm("v_max_f32_e32 %0, %1, %2":"=v"(r):"v"(a),"v"(b));return r;}
__device__ __forceinline__ float fadd_s(float a,float b){float r;asm("v_add_f32_e32 %0, %1, %2":"=v"(r):"v"(a),"v"(b));return r;}
__device__ __forceinline__ float fsub_s(float a,float b){float r;asm("v_sub_f32_e32 %0, %1, %2":"=v"(r):"v"(a),"v"(b));return r;}
typedef float f32x2_t __attribute__((ext_vector_type(2))); typedef __bf16 bf16x2_t __attribute__((ext_vector_type(2)));
__device__ __forceinline__ unsigned cvtpk_s(float lo,float hi){f32x2_t v={lo,hi};bf16x2_t b=__builtin_convertvector(v,bf16x2_t);return __builtin_bit_cast(unsigned,b);}
#define WAIT_BAR(N) asm volatile("s_waitcnt vmcnt(" #N ") lgkmcnt(0)\n\ts_barrier":::"memory")

__device__ __forceinline__ void qkt(f32x16&p0,f32x16&p1,const char*Kslot,const bf16x8*qr,const f32x16&negm,int r32,int hi){
  const char*kb=Kslot+hi*1024+r32*16;
  #pragma unroll
  for(int d0=0;d0<4;++d0){
    const bf16x8 b0=*reinterpret_cast<const bf16x8*>(kb+d0*2048);
    const bf16x8 b1=*reinterpret_cast<const bf16x8*>(kb+d0*2048+512);
    if(d0==0){p0=__builtin_amdgcn_mfma_f32_32x32x16_bf16(b0,qr[0],negm,0,0,0);p1=__builtin_amdgcn_mfma_f32_32x32x16_bf16(b1,qr[0],negm,0,0,0);}
    else{p0=__builtin_amdgcn_mfma_f32_32x32x16_bf16(b0,qr[d0],p0,0,0,0);p1=__builtin_amdgcn_mfma_f32_32x32x16_bf16(b1,qr[d0],p1,0,0,0);}}
}
typedef __attribute__((address_space(3))) const char* lds_cptr;
typedef short v4i16_t __attribute__((ext_vector_type(4)));
__device__ __forceinline__ void kload8(bf16x8*kf,lds_cptr kp){
  kf[0]=*(const __attribute__((address_space(3))) bf16x8*)(kp);      kf[1]=*(const __attribute__((address_space(3))) bf16x8*)(kp+512);
  kf[2]=*(const __attribute__((address_space(3))) bf16x8*)(kp+2048); kf[3]=*(const __attribute__((address_space(3))) bf16x8*)(kp+2560);
  kf[4]=*(const __attribute__((address_space(3))) bf16x8*)(kp+4096); kf[5]=*(const __attribute__((address_space(3))) bf16x8*)(kp+4608);
  kf[6]=*(const __attribute__((address_space(3))) bf16x8*)(kp+6144); kf[7]=*(const __attribute__((address_space(3))) bf16x8*)(kp+6656);
}
__device__ __forceinline__ void kload2(bf16x8*kf,lds_cptr kp,int j){ kf[2*j]=*(const __attribute__((address_space(3))) bf16x8*)(kp+j*2048); kf[2*j+1]=*(const __attribute__((address_space(3))) bf16x8*)(kp+j*2048+512); }
__device__ __forceinline__ s16x4 vtr(lds_cptr p){ return __builtin_bit_cast(s16x4,__builtin_amdgcn_ds_read_tr16_b64_v4i16((__attribute__((address_space(3))) v4i16_t*)p)); }
__device__ __forceinline__ float rowmax(const f32x16&p0,const f32x16&p1){
  float a=max3f(p0[0],p0[1],p1[0]),b=max3f(p0[2],p0[3],p1[1]);a=max3f(a,p1[2],p1[3]);
  #pragma unroll
  for(int r=4;r<16;r+=4){a=max3f(a,p0[r],p0[r+1]);b=max3f(b,p0[r+2],p0[r+3]);a=max3f(a,p1[r],p1[r+1]);b=max3f(b,p1[r+2],p1[r+3]);}
  const float m=max2f(a,b);
  auto rr=__builtin_amdgcn_permlane32_swap(__float_as_uint(m),__float_as_uint(m),false,false);
  return max2f(__uint_as_float(rr[0]),__uint_as_float(rr[1]));
}
__device__ __forceinline__ void pv(f32x16*o,int vb,bf16x8 pa0,bf16x8 pa1,bf16x8 pa2,bf16x8 pa3){
  #pragma unroll
  for(int d0=0;d0<2;++d0){s16x4 lo[4],hi[4];
    #pragma unroll
    for(int ks=0;ks<4;++ks){
      asm volatile("ds_read_b64_tr_b16 %0,%1 offset:%c2":"=&v"(lo[ks]):"v"(vb),"i"(d0*4096+ks*1024):"memory");
      asm volatile("ds_read_b64_tr_b16 %0,%1 offset:%c2":"=&v"(hi[ks]):"v"(vb),"i"(d0*4096+ks*1024+512):"memory");}
    asm volatile("s_waitcnt lgkmcnt(0)":::"memory");SBAR();
    #define PK(k) (bf16x8){lo[k][0],lo[k][1],lo[k][2],lo[k][3],hi[k][0],hi[k][1],hi[k][2],hi[k][3]}
    o[d0]=__builtin_amdgcn_mfma_f32_32x32x16_bf16(pa0,PK(0),o[d0],0,0,0);
    o[d0]=__builtin_amdgcn_mfma_f32_32x32x16_bf16(pa1,PK(1),o[d0],0,0,0);
    o[d0]=__builtin_amdgcn_mfma_f32_32x32x16_bf16(pa2,PK(2),o[d0],0,0,0);
    o[d0]=__builtin_amdgcn_mfma_f32_32x32x16_bf16(pa3,PK(3),o[d0],0,0,0);
    #undef PK
  }
}

#ifndef ATTN_STORE16
#define ATTN_STORE16(p,v) (*(u32x4*)(p)=(v))
#endif
template<int THRL> __device__ __forceinline__ void attn_unit(int b,int qb,const bf16*Q,const bf16*__restrict__ K,const bf16*__restrict__ V,bf16*O,int qc,int kc,int vc,int oc,lds_cfptr bt,char*shm){
  int tid_=threadIdx.x; asm volatile("":"+v"(tid_)); const int tid=tid_,lane=tid&63,r32=lane&31,hi=lane>>5; const int wid=__builtin_amdgcn_readfirstlane(tid>>6);
  const long rowbase=(long)b*SEQ; const int q0=qb*QB;
  const bf16*Qw=Q+(rowbase+q0+wid*QBLK)*DM+qc;
  const bf16*Kh=K+rowbase*DM+kc,*Vh=V+rowbase*DM+vc;
  const unsigned lds0=(unsigned)(uintptr_t)shm;
  float*wsf=(float*)(shm+LDS_WS)+wid*64;
  const bf16*ksrc=Kh+(long)lane*DM+wid*8;
  const bf16*vsrc=Vh+(long)(16*(wid&3)+(lane>>2))*DM+(wid>>2)*32+(lane&3)*8;
  const unsigned kdst=lds0+LDS_K+wid*1024, vdst=lds0+LDS_V+wid*1024;
  #define DMA_K(t,slot) glds16(ksrc+(long)(t)*KVBLK*DM,(unsigned)__builtin_amdgcn_readfirstlane(kdst+(slot)))
  #define DMA_V(t,slot) glds16(vsrc+(long)(t)*KVBLK*DM,(unsigned)__builtin_amdgcn_readfirstlane(vdst+(slot)))
  const int vb0=(int)(lds0+LDS_V)+((lane>>4)&1)*32+(lane&3)*8+(4*hi+((lane&15)>>2))*64;
  const char*Kbase=shm+LDS_K; bf16x8 kf[8];
  const lds_cptr shm3=(lds_cptr)shm; const lds_cptr kp0=shm3+LDS_K+hi*1024+r32*16; const lds_cptr vp0=shm3+LDS_V+((lane>>4)&1)*32+(lane&3)*8+(4*hi+((lane&15)>>2))*64;
  const int NT=(q0+QB)/KVBLK;
  DMA_K(0,0);DMA_V(0,0);DMA_K(1,SLOTB);
  bf16x8 qr[4];
  #pragma unroll
  for(int d0=0;d0<4;++d0)qr[d0]=*reinterpret_cast<const bf16x8*>(&Qw[(long)r32*DM+d0*16+hi*8]);
  float mhat=0.f,l_reg=0.f;f32x16 o[2],negm; { float z_=0.f; asm volatile("":"+v"(z_));
    _Pragma("unroll") for(int r=0;r<16;++r){o[0][r]=z_;o[1][r]=z_;negm[r]=z_;} } asm volatile("":"+v"(negm));
  const int qrel=wid*QBLK+r32;
  #define CMASK(P0,P1,t) do{int jb_=(t)-(NT-4); if(jb_>=-2 && (wid*QBLK-(64*jb_+63))<128)cbias(P0,P1,jb_,qrel,hi,bt);}while(0)
  bool resc=false;
  #define START(P0,P1) do{ const float rm=rowmax(P0,P1); resc=false; \
    { const float dl=rm; mhat=fadd_s(mhat,dl); \
      _Pragma("unroll") for(int r=0;r<16;++r){P0[r]=fsub_s(P0[r],dl);P1[r]=fsub_s(P1[r],dl);} \
      _Pragma("unroll") for(int r=0;r<16;++r)negm[r]=-mhat; asm volatile("":"+v"(negm)); } \
    _Pragma("unroll") for(int r=0;r<16;++r)P0[r]=__builtin_amdgcn_exp2f(P0[r]); }while(0)
  #define RESC() do{ if(resc){ asm volatile("s_waitcnt lgkmcnt(0)":::"memory"); \
      _Pragma("unroll") for(int d_=0;d_<2;++d_) _Pragma("unroll") for(int r=0;r<16;++r)o[d_][r]*=wsf[crow(r,hi)]; } }while(0)
  f32x16 pA0,pA1,pB0,pB1;
  int sl_prev=0,sl_cur=0,sl_next=SLOTB;
  #define ROT() do{sl_prev=sl_cur;sl_cur=sl_next;sl_next=(sl_next==(NSLOT-1)*SLOTB)?0:sl_next+SLOTB;}while(0)
  DMA_K(2,2*SLOTB);
  WAIT_BAR(3);
  qkt(pA0,pA1,Kbase,qr,negm,r32,hi);asm volatile("s_nop 15\n\ts_nop 7":"+v"(pA0),"+v"(pA1));CMASK(pA0,pA1,0);
  START(pA0,pA1);
  _Pragma("unroll") for(int r=0;r<16;++r)pA1[r]=__builtin_amdgcn_exp2f(pA1[r]);
  WAIT_BAR(0);
  DMA_K(3,0);DMA_V(1,SLOTB);
  ROT();
  kload8(kf,kp0+sl_cur);
  WAIT_BAR(2);
  s16x4 vlo[8],vhi[8]; u32x4 pw0,pw1,pw2,pw3;
  #define PKW(P,B) cvtpk_s(P[B],P[B+1])
  #define PAF(k) __builtin_bit_cast(bf16x8,pw##k)
  #define VFR(i) (bf16x8){vlo[i][0],vlo[i][1],vlo[i][2],vlo[i][3],vhi[i][0],vhi[i][1],vhi[i][2],vhi[i][3]}
  #define PIN(x) asm volatile("":"+v"(x))
  #define MX3(a,b,c) __builtin_fmaxf(__builtin_fmaxf((a),(b)),(c))
  #define GAPA(MF,A0,A1,A2,A3,W0,W1,PW) do{ MF; sacc+=A0; sacc+=A1; sacc+=A2; sacc+=A3; PIN(sacc); W0; W1; PIN(PW); SBAR(); }while(0)
  #define EX(v) __builtin_amdgcn_exp2f(v)
  #define GAPB(MF,X,B) do{ MF; X[B]=EX(X[B]); X[B+1]=EX(X[B+1]); X[B+2]=EX(X[B+2]); X[B+3]=EX(X[B+3]); PIN(X); SBAR(); }while(0)
  #define VRD(i) do{ vlo[i]=vtr(vp_+(((i)>>2)*4096+((i)&3)*1024)); vhi[i]=vtr(vp_+(((i)>>2)*4096+((i)&3)*1024+512)); }while(0)
  #define KRD(G,j) do{ if(G){ kload2(kf,kp0+sl_next,j); SBAR(); } }while(0)
  #define STEP(C0,C1,P0,P1,t,GK,GV,GL) do{ SBAR(); \
    const lds_cptr vp_=vp0+sl_prev; \
    VRD(0); SBAR(); float sacc=(P0[0]+P0[1]); \
    GAPA(C0=__builtin_amdgcn_mfma_f32_32x32x16_bf16(kf[0],qr[0],negm,0,0,0), P0[2],P0[3],P0[4],P0[5],     pw0[0]=PKW(P0,0), pw0[1]=PKW(P0,2), pw0); \
    VRD(4); SBAR(); GAPA(C1=__builtin_amdgcn_mfma_f32_32x32x16_bf16(kf[1],qr[0],negm,0,0,0), P0[6],P0[7],P0[8],P0[9],     pw0[2]=PKW(P0,4), pw0[3]=PKW(P0,6), pw0); \
    VRD(1); SBAR(); GAPA(C0=__builtin_amdgcn_mfma_f32_32x32x16_bf16(kf[2],qr[1],C0,0,0,0),   P0[10],P0[11],P0[12],P0[13], pw1[0]=PKW(P0,8), pw1[1]=PKW(P0,10), pw1); \
    VRD(5); SBAR(); GAPA(C1=__builtin_amdgcn_mfma_f32_32x32x16_bf16(kf[3],qr[1],C1,0,0,0),   P0[14],P0[15],P1[0],P1[1],   pw1[2]=PKW(P0,12),pw1[3]=PKW(P0,14), pw1); \
    VRD(2); SBAR(); GAPA(C0=__builtin_amdgcn_mfma_f32_32x32x16_bf16(kf[4],qr[2],C0,0,0,0),   P1[2],P1[3],P1[4],P1[5],     pw2[0]=PKW(P1,0), pw2[1]=PKW(P1,2), pw2); \
    VRD(6); SBAR(); GAPA(C1=__builtin_amdgcn_mfma_f32_32x32x16_bf16(kf[5],qr[2],C1,0,0,0),   P1[6],P1[7],P1[8],P1[9],     pw2[2]=PKW(P1,4), pw2[3]=PKW(P1,6), pw2); \
    VRD(3); SBAR(); GAPA(C0=__builtin_amdgcn_mfma_f32_32x32x16_bf16(kf[6],qr[3],C0,0,0,0),   P1[10],P1[11],P1[12],P1[13], pw3[0]=PKW(P1,8), pw3[1]=PKW(P1,10), pw3); \
    VRD(7); SBAR(); GAPA(C1=__builtin_amdgcn_mfma_f32_32x32x16_bf16(kf[7],qr[3],C1,0,0,0),   P1[14],P1[15],0.f,0.f,       pw3[2]=PKW(P1,12),pw3[3]=PKW(P1,14), pw3); \
    l_reg+=sacc; \
    if(GK){DMA_K((t)+3,sl_cur);} if(GV){DMA_V((t)+1,sl_next);} \
    CMASK(C0,C1,t); \
    { float a=MX3(C0[0],C0[1],C1[0]),b=MX3(C0[2],C0[3],C1[1]); a=MX3(a,C1[2],C1[3]); \
      _Pragma("unroll") for(int r=4;r<16;r+=4){a=MX3(a,C0[r],C0[r+1]);b=MX3(b,C0[r+2],C0[r+3]);a=MX3(a,C1[r],C1[r+1]);b=MX3(b,C1[r+2],C1[r+3]);} \
      float rm=__builtin_fmaxf(a,b); { auto rr=__builtin_amdgcn_permlane32_swap(__float_as_uint(rm),__float_as_uint(rm),false,false); rm=__builtin_fmaxf(__uint_as_float(rr[0]),__uint_as_float(rr[1])); } \
      resc=false; \
      if(__builtin_expect(__any(rm>(float)THRL),0)){ const float dl=__builtin_fmaxf(rm,0.f); mhat+=dl; \
        _Pragma("unroll") for(int r=0;r<16;++r){C0[r]-=dl;C1[r]-=dl;} \
        _Pragma("unroll") for(int r=0;r<16;++r)negm[r]=-mhat; asm volatile("":"+v"(negm)); \
        const float f=__builtin_amdgcn_exp2f(-dl); l_reg*=f; if(hi==0)wsf[r32]=f; resc=true; } } \
    SBAR(); \
    GAPB(o[0]=__builtin_amdgcn_mfma_f32_32x32x16_bf16(PAF(0),VFR(0),o[0],0,0,0), C0,0); \
    GAPB(o[1]=__builtin_amdgcn_mfma_f32_32x32x16_bf16(PAF(0),VFR(4),o[1],0,0,0), C0,4); \
    KRD(GL,0); GAPB(o[0]=__builtin_amdgcn_mfma_f32_32x32x16_bf16(PAF(1),VFR(1),o[0],0,0,0), C0,8); \
    KRD(GL,1); GAPB(o[1]=__builtin_amdgcn_mfma_f32_32x32x16_bf16(PAF(1),VFR(5),o[1],0,0,0), C0,12); \
    KRD(GL,2); GAPB(o[0]=__builtin_amdgcn_mfma_f32_32x32x16_bf16(PAF(2),VFR(2),o[0],0,0,0), C1,0); \
    KRD(GL,3); GAPB(o[1]=__builtin_amdgcn_mfma_f32_32x32x16_bf16(PAF(2),VFR(6),o[1],0,0,0), C1,4); \
    GAPB(o[0]=__builtin_amdgcn_mfma_f32_32x32x16_bf16(PAF(3),VFR(3),o[0],0,0,0), C1,8); \
    GAPB(o[1]=__builtin_amdgcn_mfma_f32_32x32x16_bf16(PAF(3),VFR(7),o[1],0,0,0), C1,12); \
    }while(0)
  int t=1;
  #undef CMASK
  #define CMASK(P0,P1,t) do{}while(0)
  for(;t+7<NT;t+=2){
    STEP(pB0,pB1,pA0,pA1,t,true,true,true);     WAIT_BAR(2); RESC(); ROT();
    STEP(pA0,pA1,pB0,pB1,t+1,true,true,true);   WAIT_BAR(2); RESC(); ROT();
  }
  #undef CMASK
  #define CMASK(P0,P1,t) do{int jb_=(t)-(NT-4); if(jb_>=-2 && (wid*QBLK-(64*jb_+63))<128)cbias(P0,P1,jb_,qrel,hi,bt);}while(0)
  #define ENDW(tt) do{ if((tt)+3<NT){WAIT_BAR(2);} else if((tt)+2<NT){WAIT_BAR(1);} else {WAIT_BAR(0);} }while(0)
  for(;t+1<NT;t+=2){
    STEP(pB0,pB1,pA0,pA1,t,(t+3<NT),(t+1<NT),(t+1<NT));       ENDW(t);   RESC(); ROT();
    STEP(pA0,pA1,pB0,pB1,t+1,(t+4<NT),(t+2<NT),(t+2<NT));     ENDW(t+1); RESC(); ROT();
  }
  STEP(pB0,pB1,pA0,pA1,NT-1,false,false,false); RESC();
  { float sacc=pB0[0]+pB0[1]; _Pragma("unroll") for(int r=2;r<16;++r)sacc+=pB0[r]; _Pragma("unroll") for(int r=0;r<16;++r)sacc+=pB1[r]; l_reg+=sacc;
    pw0=(u32x4){PKW(pB0,0),PKW(pB0,2),PKW(pB0,4),PKW(pB0,6)};pw1=(u32x4){PKW(pB0,8),PKW(pB0,10),PKW(pB0,12),PKW(pB0,14)};pw2=(u32x4){PKW(pB1,0),PKW(pB1,2),PKW(pB1,4),PKW(pB1,6)};pw3=(u32x4){PKW(pB1,8),PKW(pB1,10),PKW(pB1,12),PKW(pB1,14)};
    SBAR(); pv(o,vb0+sl_cur,PAF(0),PAF(1),PAF(2),PAF(3)); }
  #undef PKW
  #undef PAF
  #undef VFR
  #undef PIN
  #undef MX3
  #undef GAPA
  #undef GAPB
  #undef EX
  #undef VRD
  #undef KRD
  #undef STEP
  #undef ENDW
  {auto rr=__builtin_amdgcn_permlane32_swap(__float_as_uint(l_reg),__float_as_uint(l_reg),false,false);l_reg=__uint_as_float(rr[0])+__uint_as_float(rr[1]);}
  if(hi==0)wsf[32+r32]=l_reg;asm volatile("s_waitcnt lgkmcnt(0)":::"memory");
  float rli[16];
  #pragma unroll
  for(int r=0;r<16;++r)rli[r]=__builtin_amdgcn_rcpf(wsf[32+crow(r,hi)]);
  bf16*Ow=O+(rowbase+q0+wid*QBLK)*DM+oc;
  { bf16*stg=(bf16*)(shm+LDS_OST)+wid*2048;
    #pragma unroll
    for(int r=0;r<16;++r){const int orow=crow(r,hi);
      #pragma unroll
      for(int d0=0;d0<2;++d0)stg[orow*64+d0*32+r32]=__float2bfloat16(o[d0][r]*rli[r]);}
    asm volatile("s_waitcnt lgkmcnt(0)":::"memory");
    #pragma unroll
    for(int i=0;i<4;++i){const int row=i*8+(lane>>3),ch=lane&7; const u32x4 v=*(const u32x4*)(stg+row*64+ch*8); ATTN_STORE16(Ow+(long)row*DM+ch*8,v);} }
  asm volatile("s_waitcnt lgkmcnt(0)\n\ts_barrier":::"memory");
  #undef DMA_K
  #undef DMA_V
  #undef CMASK
  #undef START
  #undef RESC
  #undef ROT
}
constexpr int ATTN_LDS_BYTES=LDS_BYTES;
#undef SBAR
#undef WAIT_BAR
}
#include <hip/hip_bf16.h>
#include <cmath>
#ifndef ATTN_QLDS
#define ATTN_QLDS 1
#endif
namespace attn_nat {
using bf16=__hip_bfloat16;
using bf16x8=__attribute__((ext_vector_type(8)))short;
using s16x4=__attribute__((ext_vector_type(4)))short;
using f32x16=__attribute__((ext_vector_type(16)))float;
using u32x4=__attribute__((ext_vector_type(4)))unsigned;
constexpr int BATCH=2,NHEAD=16,SEQ=8192,D=64,DM=NHEAD*D;
constexpr int NW=8,QBLK=32,QB=QBLK*NW,KVBLK=64,NQB=SEQ/QB;
constexpr int ATTN_PITCH=DM, ATTN_UNIT_ROWS=QB;
__device__ __forceinline__ int crow(int r,int hi){return (r&3)+8*(r>>2)+4*hi;}
#define SBAR() __builtin_amdgcn_sched_barrier(0)
typedef const __attribute__((address_space(3))) float* lds_cfptr;
__device__ __forceinline__ void cbias(f32x16&p0,f32x16&p1,int jb,int qrel,int hi,lds_cfptr bt){
  const float NEG=-INFINITY; const int kb=64*jb+4*hi;
  #pragma unroll
  for(int r=0;r<16;++r){const int d0=qrel-(kb+(r&3)+8*(r>>2)),d1=d0-32;
    const unsigned c0=(unsigned)d0<128u?(unsigned)d0:128u,c1=(unsigned)d1<128u?(unsigned)d1:128u;
    const float v0=p0[r]+bt[c0],v1=p1[r]+bt[c1];
    p0[r]=d0<0?NEG:v0; p1[r]=d1<0?NEG:v1;
    if((r&3)==3)__builtin_amdgcn_sched_barrier(0);}
}
constexpr int NSLOT=3, SLOTB=8192;
constexpr int LDS_K=0, LDS_V=NSLOT*SLOTB, LDS_WS=3*NSLOT*SLOTB, LDS_OST=LDS_WS+NW*64*4, LDS_BYTES=LDS_OST+NW*4096;
constexpr float C2=0.125f*1.4426950408889634f;
__device__ __forceinline__ void glds16(const void*sbase,unsigned voff,unsigned lds_dst){unsigned keep;
  asm volatile("s_mov_b32 %0, m0\n\ts_mov_b32 m0, %3\n\ts_nop 0\n\tglobal_load_lds_dwordx4 %1, %2\n\ts_mov_b32 m0, %0":"=&s"(keep):"v"(voff),"s"(sbase),"s"(lds_dst):"memory");}
__device__ __forceinline__ float max3f(float a,float b,float c){float r;asm("v_max3_f32 %0, %1, %2, %3":"=v"(r):"v"(a),"v"(b),"v"(c));return r;}
__device__ __forceinline__ float max2f(float a,float b){float r;asm("v_max_f32_e32 %0, %1, %2":"=v"(r):"v"(a),"v"(b));return r;}
__device__ __forceinline__ float fadd_s(float a,float b){float r;asm("v_add_f32_e32 %0, %1, %2":"=v"(r):"v"(a),"v"(b));return r;}
__device__ __forceinline__ float fsub_s(float a,float b){float r;asm("v_sub_f32_e32 %0, %1, %2":"=v"(r):"v"(a),"v"(b));return r;}
typedef float f32x2_t __attribute__((ext_vector_type(2))); typedef __bf16 bf16x2_t __attribute__((ext_vector_type(2)));
__device__ __forceinline__ unsigned cvtpk_s(float lo,float hi){f32x2_t v={lo,hi};bf16x2_t b=__builtin_convertvector(v,bf16x2_t);return __builtin_bit_cast(unsigned,b);}
#define WAIT_BAR(N) asm volatile("s_waitcnt vmcnt(" #N ") lgkmcnt(0)\n\ts_barrier":::"memory")

__device__ __forceinline__ void qkt(f32x16&p0,f32x16&p1,const char*Kslot,const bf16x8*qr,const f32x16&negm,int r32,int hi){
  const char*kb=Kslot+hi*1024+r32*16;
  #pragma unroll
  for(int d0=0;d0<4;++d0){
    const bf16x8 b0=*reinterpret_cast<const bf16x8*>(kb+d0*2048);
    const bf16x8 b1=*reinterpret_cast<const bf16x8*>(kb+d0*2048+512);
    if(d0==0){p0=__builtin_amdgcn_mfma_f32_32x32x16_bf16(b0,qr[0],negm,0,0,0);p1=__builtin_amdgcn_mfma_f32_32x32x16_bf16(b1,qr[0],negm,0,0,0);}
    else{p0=__builtin_amdgcn_mfma_f32_32x32x16_bf16(b0,qr[d0],p0,0,0,0);p1=__builtin_amdgcn_mfma_f32_32x32x16_bf16(b1,qr[d0],p1,0,0,0);}}
}
typedef __attribute__((address_space(3))) const char* lds_cptr;
typedef short v4i16_t __attribute__((ext_vector_type(4)));
__device__ __forceinline__ void kload8(bf16x8*kf,lds_cptr kp){
  kf[0]=*(const __attribute__((address_space(3))) bf16x8*)(kp);      kf[1]=*(const __attribute__((address_space(3))) bf16x8*)(kp+512);
  kf[2]=*(const __attribute__((address_space(3))) bf16x8*)(kp+2048); kf[3]=*(const __attribute__((address_space(3))) bf16x8*)(kp+2560);
  kf[4]=*(const __attribute__((address_space(3))) bf16x8*)(kp+4096); kf[5]=*(const __attribute__((address_space(3))) bf16x8*)(kp+4608);
  kf[6]=*(const __attribute__((address_space(3))) bf16x8*)(kp+6144); kf[7]=*(const __attribute__((address_space(3))) bf16x8*)(kp+6656);
}
__device__ __forceinline__ void kload2(bf16x8*kf,lds_cptr kp,int j){ kf[2*j]=*(const __attribute__((address_space(3))) bf16x8*)(kp+j*2048); kf[2*j+1]=*(const __attribute__((address_space(3))) bf16x8*)(kp+j*2048+512); }
__device__ __forceinline__ s16x4 vtr(lds_cptr p){ return __builtin_bit_cast(s16x4,__builtin_amdgcn_ds_read_tr16_b64_v4i16((__attribute__((address_space(3))) v4i16_t*)p)); }
__device__ __forceinline__ float rowmax(const f32x16&p0,const f32x16&p1){
  float a=max3f(p0[0],p0[1],p1[0]),b=max3f(p0[2],p0[3],p1[1]);a=max3f(a,p1[2],p1[3]);
  #pragma unroll
  for(int r=4;r<16;r+=4){a=max3f(a,p0[r],p0[r+1]);b=max3f(b,p0[r+2],p0[r+3]);a=max3f(a,p1[r],p1[r+1]);b=max3f(b,p1[r+2],p1[r+3]);}
  const float m=max2f(a,b);
  auto rr=__builtin_amdgcn_permlane32_swap(__float_as_uint(m),__float_as_uint(m),false,false);
  return max2f(__uint_as_float(rr[0]),__uint_as_float(rr[1]));
}
__device__ __forceinline__ void pv(f32x16*o,int vb,bf16x8 pa0,bf16x8 pa1,bf16x8 pa2,bf16x8 pa3){
  #pragma unroll
  for(int d0=0;d0<4;++d0){s16x4 lo[4],hi[4];
    #pragma unroll
    for(int ks=0;ks<4;++ks){
      asm volatile("ds_read_b64_tr_b16 %0,%1 offset:%c2":"=&v"(lo[ks]):"v"(vb),"i"(d0*4096+ks*1024):"memory");
      asm volatile("ds_read_b64_tr_b16 %0,%1 offset:%c2":"=&v"(hi[ks]):"v"(vb),"i"(d0*4096+ks*1024+512):"memory");}
    asm volatile("s_waitcnt lgkmcnt(0)":::"memory");SBAR();
    #define PK(k) (bf16x8){lo[k][0],lo[k][1],lo[k][2],lo[k][3],hi[k][0],hi[k][1],hi[k][2],hi[k][3]}
    o[d0]=__builtin_amdgcn_mfma_f32_32x32x16_bf16(pa0,PK(0),o[d0],0,0,0);
    o[d0]=__builtin_amdgcn_mfma_f32_32x32x16_bf16(pa1,PK(1),o[d0],0,0,0);
    o[d0]=__builtin_amdgcn_mfma_f32_32x32x16_bf16(pa2,PK(2),o[d0],0,0,0);
    o[d0]=__builtin_amdgcn_mfma_f32_32x32x16_bf16(pa3,PK(3),o[d0],0,0,0);
    #undef PK
  }
}

#ifndef ATTN_STORE16
#define ATTN_STORE16(p,v) (*(u32x4*)(p)=(v))
#endif
template<int THRL> __device__ __forceinline__ void attn_unit(int b,int qb,const bf16*Q,const bf16*__restrict__ K,const bf16*__restrict__ V,bf16*O,int qc,int kc,int vc,int oc,lds_cfptr bt,char*shm){
  int tid_=threadIdx.x; asm volatile("":"+v"(tid_)); const int tid=tid_,lane=tid&63,r32=lane&31,hi=lane>>5; const int wid=__builtin_amdgcn_readfirstlane(tid>>6);
  const long rowbase=(long)b*SEQ; const int q0=qb*QB;
  const bf16*Qw=Q+(rowbase+q0+wid*QBLK)*DM+qc;
  const bf16*Kh=K+rowbase*DM+kc,*Vh=V+rowbase*DM+vc;
  const unsigned lds0=(unsigned)(uintptr_t)shm;
  float*wsf=(float*)(shm+LDS_WS)+wid*64;
  const unsigned koff=(unsigned)((lane*DM+wid*8)*2);
  const unsigned voff=(unsigned)(((16*(wid&3)+(lane>>2))*DM+(wid>>2)*32+(lane&3)*8)*2);
  const unsigned kdst=lds0+LDS_K+wid*1024, vdst=lds0+LDS_V+wid*1024;
  #define DMA_K(t,slot) glds16(Kh+(long)(t)*KVBLK*DM,koff,(unsigned)__builtin_amdgcn_readfirstlane(kdst+(slot)))
  #define DMA_V(t,slot) do{ glds16(Vh+(long)(t)*KVBLK*DM,voff,(unsigned)__builtin_amdgcn_readfirstlane(vdst+2*(slot))); glds16(Vh+(long)(t)*KVBLK*DM+64,voff,(unsigned)__builtin_amdgcn_readfirstlane(vdst+2*(slot)+8192)); }while(0)
  const char*Kbase=shm+LDS_K; bf16x8 kf[8];
  const lds_cptr shm3=(lds_cptr)shm; const lds_cptr kp0=shm3+LDS_K+hi*1024+r32*16; const lds_cptr vp0=shm3+LDS_V+((lane>>4)&1)*32+(lane&3)*8+(4*hi+((lane&15)>>2))*64;
  const int NT=(q0+QB)/KVBLK;
  DMA_K(0,0);DMA_V(0,0);DMA_K(1,SLOTB);
  bf16x8 qr[4];
  #pragma unroll
  for(int d0=0;d0<4;++d0)qr[d0]=*reinterpret_cast<const bf16x8*>(&Qw[(long)r32*DM+d0*16+hi*8]);
#if ATTN_QLDS
  const lds_cptr qst=shm3+LDS_OST+wid*4096+r32*128;
  #pragma unroll
  for(int d0=0;d0<4;++d0)*(__attribute__((address_space(3))) bf16x8*)(shm3+LDS_OST+wid*4096+r32*128+(((2*d0+hi)^(r32&7))<<4))=qr[d0];
  #define QF(d) (*(const __attribute__((address_space(3))) bf16x8*)(qst+(((2*(d)+hi)^(r32&7))<<4)))
#else
  #define QF(d) qr[d]
#endif
  float mhat=0.f,l_reg=0.f;f32x16 o[4]; { float z_=0.f; asm volatile("":"+v"(z_));
    _Pragma("unroll") for(int r=0;r<16;++r){o[0][r]=z_;o[1][r]=z_;o[2][r]=z_;o[3][r]=z_;} }
  const int qrel=wid*QBLK+r32;
  #define CMASK(P0,P1,t) do{int jb_=(t)-(NT-4); if(jb_>=-2 && (wid*QBLK-(64*jb_+63))<128)cbias(P0,P1,jb_,qrel,hi,bt);}while(0)
  bool resc=false;
  #define START(P0,P1) do{ const float rm=rowmax(P0,P1); resc=false; \
    { const float dl=rm; mhat=fadd_s(mhat,dl); \
      _Pragma("unroll") for(int r=0;r<16;++r){P0[r]=fsub_s(P0[r],dl);P1[r]=fsub_s(P1[r],dl);} } \
    _Pragma("unroll") for(int r=0;r<16;++r)P0[r]=__builtin_amdgcn_exp2f(P0[r]); }while(0)
  #define RESC() do{ if(resc){ asm volatile("s_waitcnt lgkmcnt(0)":::"memory"); \
      _Pragma("unroll") for(int d_=0;d_<4;++d_) _Pragma("unroll") for(int r=0;r<16;++r)o[d_][r]*=wsf[crow(r,hi)]; } }while(0)
  f32x16 pA0,pA1,pB0,pB1;
  int sl_prev=0,sl_cur=0,sl_next=SLOTB;
  #define ROT() do{sl_prev=sl_cur;sl_cur=sl_next;sl_next=(sl_next==(NSLOT-1)*SLOTB)?0:sl_next+SLOTB;}while(0)
  DMA_K(2,2*SLOTB);
  WAIT_BAR(4);
  qkt(pA0,pA1,Kbase,qr,f32x16{},r32,hi);asm volatile("s_nop 15\n\ts_nop 7":"+v"(pA0),"+v"(pA1));CMASK(pA0,pA1,0);
  START(pA0,pA1);
  _Pragma("unroll") for(int r=0;r<16;++r)pA1[r]=__builtin_amdgcn_exp2f(pA1[r]);
  WAIT_BAR(0);
  DMA_K(3,0);DMA_V(1,SLOTB);
  ROT();
  kload8(kf,kp0+sl_cur);
  WAIT_BAR(3);
  s16x4 vlo[8],vhi[8]; u32x4 pw0,pw1,pw2,pw3;
  #define PKW(P,B) cvtpk_s(P[B],P[B+1])
  #define PAF(k) __builtin_bit_cast(bf16x8,pw##k)
  #define VFR(i) (bf16x8){vlo[i][0],vlo[i][1],vlo[i][2],vlo[i][3],vhi[i][0],vhi[i][1],vhi[i][2],vhi[i][3]}
  #define PIN(x) asm volatile("":"+v"(x))
  #define MX3(a,b,c) __builtin_fmaxf(__builtin_fmaxf((a),(b)),(c))
  #define GAPA(MF,A0,A1,A2,A3,W0,W1,PW) do{ MF; sacc+=A0; sacc+=A1; sacc+=A2; sacc+=A3; PIN(sacc); W0; W1; PIN(PW); SBAR(); }while(0)
  #define EX(v) __builtin_amdgcn_exp2f(v)
  #define GAPB(MF,X,B) do{ MF; X[B]=EX(X[B]); X[B+1]=EX(X[B+1]); X[B+2]=EX(X[B+2]); X[B+3]=EX(X[B+3]); PIN(X); SBAR(); }while(0)
  #define GAPB2(MF,X,B) do{ MF; X[B]=EX(X[B]); X[B+1]=EX(X[B+1]); PIN(X); SBAR(); }while(0)
  #define VRD2(i) do{ vlo[i]=vtr(vp_+((2+((i)>>2))*4096+((i)&3)*1024)); vhi[i]=vtr(vp_+((2+((i)>>2))*4096+((i)&3)*1024+512)); SBAR(); }while(0)
  #define VRD(i) do{ vlo[i]=vtr(vp_+(((i)>>2)*4096+((i)&3)*1024)); vhi[i]=vtr(vp_+(((i)>>2)*4096+((i)&3)*1024+512)); }while(0)
  #define KRD(G,j) do{ if(G){ kload2(kf,kp0+sl_next,j); SBAR(); } }while(0)
  #define STEP(C0,C1,P0,P1,t,GK,GV,GL) do{ SBAR(); \
    const lds_cptr vp_=vp0+2*sl_prev; \
    VRD(0); SBAR(); float sacc=(P0[0]+P0[1]); \
    GAPA(C0=__builtin_amdgcn_mfma_f32_32x32x16_bf16(kf[0],QF(0),f32x16{},0,0,0), P0[2],P0[3],P0[4],P0[5],     pw0[0]=PKW(P0,0), pw0[1]=PKW(P0,2), pw0); \
    VRD(4); SBAR(); GAPA(C1=__builtin_amdgcn_mfma_f32_32x32x16_bf16(kf[1],QF(0),f32x16{},0,0,0), P0[6],P0[7],P0[8],P0[9],     pw0[2]=PKW(P0,4), pw0[3]=PKW(P0,6), pw0); \
    VRD(1); SBAR(); GAPA(C0=__builtin_amdgcn_mfma_f32_32x32x16_bf16(kf[2],QF(1),C0,0,0,0),   P0[10],P0[11],P0[12],P0[13], pw1[0]=PKW(P0,8), pw1[1]=PKW(P0,10), pw1); \
    VRD(5); SBAR(); GAPA(C1=__builtin_amdgcn_mfma_f32_32x32x16_bf16(kf[3],QF(1),C1,0,0,0),   P0[14],P0[15],P1[0],P1[1],   pw1[2]=PKW(P0,12),pw1[3]=PKW(P0,14), pw1); \
    VRD(2); SBAR(); GAPA(C0=__builtin_amdgcn_mfma_f32_32x32x16_bf16(kf[4],QF(2),C0,0,0,0),   P1[2],P1[3],P1[4],P1[5],     pw2[0]=PKW(P1,0), pw2[1]=PKW(P1,2), pw2); \
    VRD(6); SBAR(); GAPA(C1=__builtin_amdgcn_mfma_f32_32x32x16_bf16(kf[5],QF(2),C1,0,0,0),   P1[6],P1[7],P1[8],P1[9],     pw2[2]=PKW(P1,4), pw2[3]=PKW(P1,6), pw2); \
    VRD(3); SBAR(); GAPA(C0=__builtin_amdgcn_mfma_f32_32x32x16_bf16(kf[6],QF(3),C0,0,0,0),   P1[10],P1[11],P1[12],P1[13], pw3[0]=PKW(P1,8), pw3[1]=PKW(P1,10), pw3); \
    VRD(7); SBAR(); GAPA(C1=__builtin_amdgcn_mfma_f32_32x32x16_bf16(kf[7],QF(3),C1,0,0,0),   P1[14],P1[15],0.f,0.f,       pw3[2]=PKW(P1,12),pw3[3]=PKW(P1,14), pw3); \
    l_reg+=sacc; \
    if(GK){DMA_K((t)+3,sl_cur);} if(GV){DMA_V((t)+1,sl_next);} \
    _Pragma("unroll") for(int r=0;r<16;++r){C0[r]-=mhat;C1[r]-=mhat;} \
    SBAR(); CMASK(C0,C1,t); SBAR(); \
    { float a=MX3(C0[0],C0[1],C1[0]),b=MX3(C0[2],C0[3],C1[1]); a=MX3(a,C1[2],C1[3]); \
      _Pragma("unroll") for(int r=4;r<16;r+=4){a=MX3(a,C0[r],C0[r+1]);b=MX3(b,C0[r+2],C0[r+3]);a=MX3(a,C1[r],C1[r+1]);b=MX3(b,C1[r+2],C1[r+3]);} \
      float rm=__builtin_fmaxf(a,b); { auto rr=__builtin_amdgcn_permlane32_swap(__float_as_uint(rm),__float_as_uint(rm),false,false); rm=__builtin_fmaxf(__uint_as_float(rr[0]),__uint_as_float(rr[1])); } \
      resc=false; \
      if(__builtin_expect(__any(rm>(float)THRL),0)){ const float dl=__builtin_fmaxf(rm,0.f); mhat+=dl; \
        _Pragma("unroll") for(int r=0;r<16;++r){C0[r]-=dl;C1[r]-=dl;} \
        const float f=__builtin_amdgcn_exp2f(-dl); l_reg*=f; if(hi==0)wsf[r32]=f; resc=true; } } \
    SBAR(); \
    GAPB2(o[0]=__builtin_amdgcn_mfma_f32_32x32x16_bf16(PAF(0),VFR(0),o[0],0,0,0), C0,0);  VRD2(0); \
    GAPB2(o[1]=__builtin_amdgcn_mfma_f32_32x32x16_bf16(PAF(0),VFR(4),o[1],0,0,0), C0,2);  VRD2(4); \
    GAPB2(o[0]=__builtin_amdgcn_mfma_f32_32x32x16_bf16(PAF(1),VFR(1),o[0],0,0,0), C0,4);  VRD2(1); \
    GAPB2(o[1]=__builtin_amdgcn_mfma_f32_32x32x16_bf16(PAF(1),VFR(5),o[1],0,0,0), C0,6);  VRD2(5); \
    GAPB2(o[0]=__builtin_amdgcn_mfma_f32_32x32x16_bf16(PAF(2),VFR(2),o[0],0,0,0), C0,8);  VRD2(2); \
    GAPB2(o[1]=__builtin_amdgcn_mfma_f32_32x32x16_bf16(PAF(2),VFR(6),o[1],0,0,0), C0,10); VRD2(6); \
    GAPB2(o[0]=__builtin_amdgcn_mfma_f32_32x32x16_bf16(PAF(3),VFR(3),o[0],0,0,0), C0,12); VRD2(3); \
    GAPB2(o[1]=__builtin_amdgcn_mfma_f32_32x32x16_bf16(PAF(3),VFR(7),o[1],0,0,0), C0,14); VRD2(7); \
    GAPB2(o[2]=__builtin_amdgcn_mfma_f32_32x32x16_bf16(PAF(0),VFR(0),o[2],0,0,0), C1,0); \
    GAPB2(o[3]=__builtin_amdgcn_mfma_f32_32x32x16_bf16(PAF(0),VFR(4),o[3],0,0,0), C1,2); \
    KRD(GL,0); GAPB2(o[2]=__builtin_amdgcn_mfma_f32_32x32x16_bf16(PAF(1),VFR(1),o[2],0,0,0), C1,4); \
    GAPB2(o[3]=__builtin_amdgcn_mfma_f32_32x32x16_bf16(PAF(1),VFR(5),o[3],0,0,0), C1,6); \
    KRD(GL,1); GAPB2(o[2]=__builtin_amdgcn_mfma_f32_32x32x16_bf16(PAF(2),VFR(2),o[2],0,0,0), C1,8); \
    GAPB2(o[3]=__builtin_amdgcn_mfma_f32_32x32x16_bf16(PAF(2),VFR(6),o[3],0,0,0), C1,10); \
    KRD(GL,2); GAPB2(o[2]=__builtin_amdgcn_mfma_f32_32x32x16_bf16(PAF(3),VFR(3),o[2],0,0,0), C1,12); \
    GAPB2(o[3]=__builtin_amdgcn_mfma_f32_32x32x16_bf16(PAF(3),VFR(7),o[3],0,0,0), C1,14); \
    KRD(GL,3); \
    }while(0)
  int t=1;
  #undef CMASK
  #define CMASK(P0,P1,t) do{}while(0)
  for(;t+7<NT;t+=2){
    STEP(pB0,pB1,pA0,pA1,t,true,true,true);     WAIT_BAR(3); RESC(); ROT();
    STEP(pA0,pA1,pB0,pB1,t+1,true,true,true);   WAIT_BAR(3); RESC(); ROT();
  }
  #undef CMASK
  int tb_=threadIdx.x; asm volatile("":"+v"(tb_)); const int qrel_b=(tb_>>6)*QBLK+(tb_&31),hi_b=(tb_&63)>>5;
  #define CMASK(P0,P1,t) do{int jb_=(t)-(NT-4); if(jb_>=-2 && (wid*QBLK-(64*jb_+63))<128)cbias(P0,P1,jb_,qrel_b,hi_b,bt);}while(0)
  #define ENDW(tt) do{ if((tt)+3<NT){WAIT_BAR(3);} else if((tt)+2<NT){WAIT_BAR(2);} else {WAIT_BAR(0);} }while(0)
  for(;t+1<NT;t+=2){
    STEP(pB0,pB1,pA0,pA1,t,(t+3<NT),(t+1<NT),(t+1<NT));       ENDW(t);   RESC(); ROT();
    STEP(pA0,pA1,pB0,pB1,t+1,(t+4<NT),(t+2<NT),(t+2<NT));     ENDW(t+1); RESC(); ROT();
  }
  STEP(pB0,pB1,pA0,pA1,NT-1,false,false,false); RESC();
  { float sacc=pB0[0]+pB0[1]; _Pragma("unroll") for(int r=2;r<16;++r)sacc+=pB0[r]; _Pragma("unroll") for(int r=0;r<16;++r)sacc+=pB1[r]; l_reg+=sacc;
    pw0=(u32x4){PKW(pB0,0),PKW(pB0,2),PKW(pB0,4),PKW(pB0,6)};pw1=(u32x4){PKW(pB0,8),PKW(pB0,10),PKW(pB0,12),PKW(pB0,14)};pw2=(u32x4){PKW(pB1,0),PKW(pB1,2),PKW(pB1,4),PKW(pB1,6)};pw3=(u32x4){PKW(pB1,8),PKW(pB1,10),PKW(pB1,12),PKW(pB1,14)};
    SBAR(); { int td_=threadIdx.x; asm volatile("":"+v"(td_)); const int ld_=td_&63; const int vb0=(int)((unsigned)(uintptr_t)shm+LDS_V)+((ld_>>4)&1)*32+(ld_&3)*8+(4*(ld_>>5)+((ld_&15)>>2))*64;
      pv(o,vb0+2*sl_cur,PAF(0),PAF(1),PAF(2),PAF(3)); } }
  #undef PKW
  #undef PAF
  #undef VFR
  #undef PIN
  #undef MX3
  #undef GAPA
  #undef GAPB
  #undef GAPB2
  #undef VRD2
  #undef EX
  #undef VRD
  #undef KRD
  #undef STEP
  #undef ENDW
  { int te_=threadIdx.x; asm volatile("":"+v"(te_)); const int lane_e=te_&63,r32e=lane_e&31,hie=lane_e>>5; const int wide=__builtin_amdgcn_readfirstlane(te_>>6);
  float*wsfe=(float*)(shm+LDS_WS)+wide*64;
  {auto rr=__builtin_amdgcn_permlane32_swap(__float_as_uint(l_reg),__float_as_uint(l_reg),false,false);l_reg=__uint_as_float(rr[0])+__uint_as_float(rr[1]);}
  if(hie==0)wsfe[32+r32e]=l_reg;asm volatile("s_waitcnt lgkmcnt(0)":::"memory");
  float rli[16];
  #pragma unroll
  for(int r=0;r<16;++r)rli[r]=__builtin_amdgcn_rcpf(wsfe[32+crow(r,hie)]);
  bf16*Ow=O+((long)b*SEQ+qb*QB+wide*QBLK)*DM+oc;
  { bf16*stg=(bf16*)(shm+LDS_OST)+wide*2048;
    #pragma unroll
    for(int hf=0;hf<2;++hf){
      #pragma unroll
      for(int r=0;r<16;++r){const int orow=crow(r,hie);
        #pragma unroll
        for(int d0=0;d0<2;++d0)stg[orow*64+d0*32+r32e]=__float2bfloat16(o[2*hf+d0][r]*rli[r]);}
      asm volatile("s_waitcnt lgkmcnt(0)":::"memory");
      #pragma unroll
      for(int i=0;i<4;++i){const int row=i*8+(lane_e>>3),ch=lane_e&7; const u32x4 v=*(const u32x4*)(stg+row*64+ch*8); ATTN_STORE16(Ow+(long)row*DM+hf*64+ch*8,v);}
      asm volatile("s_waitcnt lgkmcnt(0)":::"memory"); } } }
  asm volatile("s_waitcnt lgkmcnt(0)\n\ts_barrier":::"memory");
  #undef DMA_K
  #undef DMA_V
  #undef CMASK
  #undef START
  #undef RESC
  #undef ROT
  #undef QF
}
constexpr int ATTN_LDS_BYTES=LDS_BYTES;
#undef SBAR
#undef WAIT_BAR
}
#define XROW(m0) ((C.G == 256) ? (((gw >> 8) << 11) + (gw & 255) + (((m0) - gw) >> 11) * 256) : (m0))
struct Ctx {
    LAS unsigned char* lds; char* ldsg; int tid, lane, wave, G, vcu;
    const float* in[23]; float* out; unsigned char* ws;
};
#define WSP(T, off) ((T*)(C.ws + (off)))
#define PHASE_IDS() Ctx C = C0; { int t_ = threadIdx.x; asm volatile("" : "+v"(t_)); C.tid = t_; C.lane = t_ & 63; C.wave = __builtin_amdgcn_readfirstlane(t_ >> 6); }

struct ConvDesc { const float* src; bf16_t* dst; int N, K; };
__device__ __forceinline__ ConvDesc conv_desc(const Ctx& C, int it) {
    constexpr int I_IN = 16 * 160, I_BR = 8 * 32, I_GU1 = 16 * 64, I_GU = NE * I_GU1, I_D1 = 16 * 32, I_D = NE * I_D1;
    const float* W; bf16_t* WT; int K, N, kb, nb, orow; int r = it;
    if (r < I_GU) { const int e = r / I_GU1, q = r % I_GU1; kb = q / 64; nb = q % 64; const int n0 = 32 * nb, half = n0 >> 10, rem = n0 & 1023;
        W = C.in[18] + (size_t)e * 1024 * 2048; WT = WSP(bf16_t, WS_WGU) + (size_t)e * 2048 * 1024; K = 1024; N = 2048; orow = (rem >> 7) * 256 + half * 128 + (rem & 127); }
    else if ((r -= I_GU) < I_D) { const int e = r / I_D1, q = r % I_D1; kb = q / 32; nb = q % 32; W = C.in[20] + (size_t)e * 1024 * 1024; WT = WSP(bf16_t, WS_WD) + (size_t)e * 1024 * 1024; K = 1024; N = 1024; orow = 32 * nb; }
    else if ((r -= I_D) < I_IN) { kb = r / 160; nb = r % 160; W = C.in[6]; WT = WSP(bf16_t, WS_WIN); K = 1024; N = INW; orow = 32 * nb; }
    else if ((r -= I_IN) < I_BR) { kb = r / 32; nb = r % 32; W = C.in[12]; WT = WSP(bf16_t, WS_WBR); K = 1024; N = 1024; orow = 32 * nb; }
    else if ((r -= I_BR) < I_BR) { kb = r / 32; nb = r % 32; W = C.in[13]; WT = WSP(bf16_t, WS_WBR) + 512; K = 1024; N = 1024; orow = 32 * nb; }
    else { r -= I_BR; kb = r / 32; nb = r % 32; W = C.in[14]; WT = WSP(bf16_t, WS_WOUT); K = 1024; N = 1024; orow = 32 * nb; }
    ConvDesc d; d.src = W + (size_t)(64 * kb) * N + 32 * nb; d.dst = WT + (size_t)orow * K + 64 * kb; d.N = N; d.K = K; return d;
}
__device__ __forceinline__ void conv_load(const ConvDesc& d, f32x4 (&v)[8], int lane) {
    const int kr = lane >> 3, nc = lane & 7;
#pragma unroll
    for (int i = 0; i < 8; ++i) v[i] = *(const f32x4*)(d.src + (size_t)(8 * i + kr) * d.N + 4 * nc);
}
__device__ __forceinline__ void conv_finish(const ConvDesc& d, const f32x4 (&v)[8], LAS float* scr, int lane) {
    const int kr = lane >> 3, nc = lane & 7;
#pragma unroll
    for (int i = 0; i < 8; ++i) { LAS float* s = scr + (8 * i + kr) * 33 + 4 * nc; s[0] = v[i][0]; s[1] = v[i][1]; s[2] = v[i][2]; s[3] = v[i][3]; }
    LDS_WAIT(); asm volatile("" ::: "memory");
    const int c = lane & 7;
#pragma unroll
    for (int j = 0; j < 4; ++j) { const int n = (lane >> 3) + 8 * j; const LAS float* s = scr + (8 * c) * 33 + n;
        u32x4 o; o.x = cvt_pk_bf16(s[0 * 33], s[1 * 33]); o.y = cvt_pk_bf16(s[2 * 33], s[3 * 33]); o.z = cvt_pk_bf16(s[4 * 33], s[5 * 33]); o.w = cvt_pk_bf16(s[6 * 33], s[7 * 33]);
        *(u32x4*)(d.dst + (size_t)n * d.K + 8 * c) = o; }
    LDS_WAIT(); asm volatile("" ::: "memory");
}
__device__ __forceinline__ void conv_range(const Ctx& C, int lo, int hi, int wi, int nw, LAS float* scr) {
    const int first = lo + wi;
    if (first < hi) {
        ConvDesc d0 = conv_desc(C, first), d1 = d0; f32x4 v0[8], v1[8]; conv_load(d0, v0, C.lane);
        for (int it = first; it < hi; it += 2 * nw) {
            const int n1 = it + nw, n2 = it + 2 * nw;
            d1 = conv_desc(C, n1 < hi ? n1 : it); conv_load(d1, v1, C.lane);
            conv_finish(d0, v0, scr, C.lane);
            if (n1 >= hi) break;
            d0 = conv_desc(C, n2 < hi ? n2 : it); conv_load(d0, v0, C.lane);
            conv_finish(d1, v1, scr, C.lane);
        }
    }
}
template <int MODE> __device__ __noinline__ void conv_q_blocks(const float* Wgu, unsigned char* ws, LAS unsigned char* lds, int wave, int first, int stride) {
    int lane_ = (int)__builtin_amdgcn_mbcnt_hi(~0u, __builtin_amdgcn_mbcnt_lo(~0u, 0u)); asm volatile("" : "+v"(lane_));
    const int lane = lane_, tid = wave * 64 + lane, lr = tid >> 3, c4 = tid & 7, n = tid & 31, kg = tid >> 5;
    LAS float* blk = (LAS float*)lds;
    LAS float* wmx = (LAS float*)(lds + LDSCTL_OFF + 14336);
    f32x4 v[16];
    constexpr int NBLK = MODE == 0 ? NE * 64 : 128, LDW = MODE == 0 ? 2048 : INW;
#define QB_SRC(b_) (MODE == 0 ? Wgu + (size_t)((b_) >> 6) * 1024 * 2048 + 32 * ((b_) & 63) : Wgu + 32 * ((b_) < 48 ? (b_) : (b_) + 32))
    if (first < NBLK) { const float* W = QB_SRC(first) + 4 * c4 + (size_t)lr * LDW;
#pragma unroll
        for (int i = 0; i < 16; ++i) v[i] = *(const f32x4*)(W + (size_t)(64 * i) * LDW); }
    for (int bk = first; bk < NBLK; bk += stride) { const int e = MODE == 0 ? bk >> 6 : 0, n0 = MODE == 0 ? 32 * (bk & 63) : 32 * (bk < 48 ? bk : bk + 32), hgu = n0 >> 10, rem = n0 & 1023, orow = MODE == 0 ? (rem >> 7) * 256 + hgu * 128 + (rem & 127) : n0;
        f32x4 mx = (f32x4){0.f, 0.f, 0.f, 0.f};
#pragma unroll
        for (int i = 0; i < 16; ++i) { *(LAS f32x4*)(blk + (64 * i + lr) * 32 + 4 * c4) = v[i]; mx = __builtin_elementwise_max(mx, __builtin_elementwise_abs(v[i])); }
#pragma unroll
        for (int j = 0; j < 4; ++j) { float t = mx[j]; t = fmaxf(t, __shfl_xor(t, 8)); t = fmaxf(t, __shfl_xor(t, 16)); t = fmaxf(t, __shfl_xor(t, 32)); mx[j] = t; }
        if (lane < 8) *(LAS f32x4*)(wmx + wave * 32 + 4 * lane) = mx;
        { const int nk = bk + stride < NBLK ? bk + stride : bk;
          const float* W = QB_SRC(nk) + 4 * c4 + (size_t)lr * LDW;
#pragma unroll
          for (int i = 0; i < 16; ++i) v[i] = *(const f32x4*)(W + (size_t)(64 * i) * LDW); }
        LDS_WAIT(); __builtin_amdgcn_s_barrier(); asm volatile("" ::: "memory");
        float cm = wmx[n];
#pragma unroll
        for (int w = 1; w < 8; ++w) cm = fmaxf(cm, wmx[w * 32 + n]);
        const float inv = cm > 0.f ? 127.0f / cm : 0.f;
        if (kg == 0) ((float*)(ws + (MODE == 0 ? WS_SW : WS_SWIN)))[(size_t)e * 2048 + n0 + n] = cm > 0.f ? cm * (1.0f / 127.0f) : 1.0f;
        signed char* dst = (signed char*)(ws + (MODE == 0 ? WS_WGU : WS_WINQ)) + ((size_t)e * 2048 + orow + n) * 1024 + 64 * kg;
        const LAS float* src = blk + (64 * kg) * 32 + n;
#pragma unroll
        for (int s = 0; s < 4; ++s) { unsigned w4[4];
#pragma unroll
            for (int d = 0; d < 4; ++d) { int b[4];
#pragma unroll
                for (int k = 0; k < 4; ++k) b[k] = (int)fminf(fmaxf(__builtin_rintf(src[(16 * s + 4 * d + k) * 32] * inv), -127.0f), 127.0f);
                w4[d] = (unsigned)(b[0] & 255) | ((unsigned)(b[1] & 255) << 8) | ((unsigned)(b[2] & 255) << 16) | ((unsigned)b[3] << 24); }
            *(u32x4*)(dst + 16 * s) = (u32x4){w4[0], w4[1], w4[2], w4[3]}; }
        LDS_WAIT(); __builtin_amdgcn_s_barrier(); asm volatile("" ::: "memory");
    }
}
#undef QB_SRC
constexpr int CONV_MOE_ITEMS = NE * 16 * 64 + NE * 16 * 32;
constexpr int CONV_ALL_ITEMS = CONV_MOE_ITEMS + 16 * 160 + 2 * 8 * 32 + 16 * 32;
#ifndef NCONV_
#define NCONV_ 13
#endif
constexpr int NCONV = NCONV_;
__device__ __forceinline__ void p0_prologue(const Ctx& C0) {
    PHASE_IDS();
    LAS float* scr = (LAS float*)(C.lds + C.wave * 8448);
    const int gw = C.vcu * NWAVES + C.wave, NGW = C.G * NWAVES;
    conv_q_blocks<1>(C.in[6], C.ws, C.lds, C.wave, (int)blockIdx.x, C.G);
    __syncthreads();
    for (int it = gw; it < 16 * 32; it += NGW) { const int kb = it >> 5, nb = 48 + (it & 31);
        ConvDesc d; d.src = C.in[6] + (size_t)(64 * kb) * INW + 32 * nb; d.dst = WSP(bf16_t, WS_WIN) + (size_t)(32 * nb) * 1024 + 64 * kb; d.N = INW; d.K = 1024;
        f32x4 v[8]; conv_load(d, v, C.lane); conv_finish(d, v, scr, C.lane); }
    conv_range(C, CONV_MOE_ITEMS + 16 * 160, CONV_ALL_ITEMS, gw, NGW, scr);
    const float* cvec = C.in[1]; const float* wada = C.in[3]; float* adap = WSP(float, WS_ADAP);
    for (int it = gw; it < 96 * 16; it += NGW) { const int cc = it % 96, ks = it / 96; const int n = 64 * cc + C.lane; float a0 = 0.f, a1 = 0.f;
#pragma unroll 16
        for (int k = 0; k < 64; ++k) { const int kk = 64 * ks + k; const float w = wada[(size_t)kk * 6144 + n]; a0 += cvec[kk] * w; a1 += cvec[1024 + kk] * w; }
        adap[(ks * 2 + 0) * 6144 + n] = a0; adap[(ks * 2 + 1) * 6144 + n] = a1; }
}
__device__ __forceinline__ float ada_val(const Ctx& C, int b, int n) {
    const float* adap = WSP(const float, WS_ADAP); float s = C.in[4][n];
#pragma unroll
    for (int ks = 0; ks < 16; ++ks) s += adap[(ks * 2 + b) * 6144 + n];
    return s;
}
__device__ __forceinline__ void rms_mod_row(const float* xrow, bf16_t* orow, const LAS float* MA, const LAS float* MB, int lane, signed char* qrow, float* qscale) {
    const f32x4* xr = (const f32x4*)xrow + lane;
    f32x4 v[4]; float s = 0.f;
#pragma unroll
    for (int j = 0; j < 4; ++j) { v[j] = xr[64 * j]; s += (v[j][0] * v[j][0] + v[j][1] * v[j][1]) + (v[j][2] * v[j][2] + v[j][3] * v[j][3]); }
    const float rstd = 1.0f / sqrtf(wave_sum(s) * (1.0f / D) + RMS_EPS);
    u32x2* o8 = (u32x2*)orow + lane;
#pragma unroll
    for (int j = 0; j < 4; ++j) { const f32x4 a = *(const LAS f32x4*)(MA + 4 * lane + 256 * j), b = *(const LAS f32x4*)(MB + 4 * lane + 256 * j);
        const f32x4 h = v[j] * rstd * a + b; u32x2 w; w.x = pk2(h[0], h[1]); w.y = pk2(h[2], h[3]); o8[64 * j] = w; v[j] = h; }
    if (qrow) {
        float am = 0.f;
#pragma unroll
        for (int j = 0; j < 4; ++j)
#pragma unroll
            for (int k = 0; k < 4; ++k) am = fmaxf(am, fabsf(v[j][k]));
#pragma unroll
        for (int o = 1; o < 64; o <<= 1) am = fmaxf(am, __shfl_xor(am, o));
        const float inv = am > 0.f ? 127.0f / am : 0.f;
        if (lane == 0) *qscale = am > 0.f ? am * (1.0f / 127.0f) : 1.0f;
#pragma unroll
        for (int j = 0; j < 4; ++j) { int b4[4];
#pragma unroll
            for (int k = 0; k < 4; ++k) b4[k] = (int)fminf(fmaxf(__builtin_rintf(v[j][k] * inv), -127.0f), 127.0f);
            ((unsigned*)qrow)[lane + 64 * j] = (unsigned)(b4[0] & 255) | ((unsigned)(b4[1] & 255) << 8) | ((unsigned)(b4[2] & 255) << 16) | ((unsigned)b4[3] << 24); } }
}
__device__ __forceinline__ void rms_mod_row_bf16(const bf16_t* xrow, bf16_t* orow, const LAS float* MA, const LAS float* MB, int lane, signed char* qrow, float* qscale) {
    float v[16]; float s = 0.f;
#pragma unroll
    for (int j = 0; j < 2; ++j) { const u32x4 w = *(const u32x4*)(xrow + 512 * j + 8 * lane);
        v[8 * j + 0] = bf_lo(w.x); v[8 * j + 1] = bf_hi(w.x); v[8 * j + 2] = bf_lo(w.y); v[8 * j + 3] = bf_hi(w.y); v[8 * j + 4] = bf_lo(w.z); v[8 * j + 5] = bf_hi(w.z); v[8 * j + 6] = bf_lo(w.w); v[8 * j + 7] = bf_hi(w.w); }
#pragma unroll
    for (int k = 0; k < 16; ++k) s += v[k] * v[k];
    const float rstd = 1.0f / sqrtf(wave_sum(s) * (1.0f / D) + RMS_EPS);
#pragma unroll
    for (int j = 0; j < 2; ++j) { const LAS float* a = MA + 512 * j + 8 * lane; const LAS float* b = MB + 512 * j + 8 * lane;
        const f32x4 a0 = *(const LAS f32x4*)a, a1 = *(const LAS f32x4*)(a + 4), b0 = *(const LAS f32x4*)b, b1 = *(const LAS f32x4*)(b + 4);
        u32x4 w; w.x = pk2(v[8 * j + 0] * rstd * a0[0] + b0[0], v[8 * j + 1] * rstd * a0[1] + b0[1]); w.y = pk2(v[8 * j + 2] * rstd * a0[2] + b0[2], v[8 * j + 3] * rstd * a0[3] + b0[3]);
        w.z = pk2(v[8 * j + 4] * rstd * a1[0] + b1[0], v[8 * j + 5] * rstd * a1[1] + b1[1]); w.w = pk2(v[8 * j + 6] * rstd * a1[2] + b1[2], v[8 * j + 7] * rstd * a1[3] + b1[3]);
        *(u32x4*)(orow + 512 * j + 8 * lane) = w; }
    if (qrow) {
        float hq[16]; float am = 0.f;
#pragma unroll
        for (int j = 0; j < 2; ++j) { const LAS float* a = MA + 512 * j + 8 * lane; const LAS float* b = MB + 512 * j + 8 * lane;
#pragma unroll
            for (int k = 0; k < 8; ++k) { hq[8 * j + k] = v[8 * j + k] * rstd * a[k] + b[k]; am = fmaxf(am, fabsf(hq[8 * j + k])); } }
#pragma unroll
        for (int o = 1; o < 64; o <<= 1) am = fmaxf(am, __shfl_xor(am, o));
        const float inv = am > 0.f ? 127.0f / am : 0.f;
        if (lane == 0) *qscale = am > 0.f ? am * (1.0f / 127.0f) : 1.0f;
#pragma unroll
        for (int j = 0; j < 2; ++j) { unsigned w2[2];
#pragma unroll
            for (int d = 0; d < 2; ++d) { int b4[4];
#pragma unroll
                for (int k = 0; k < 4; ++k) b4[k] = (int)fminf(fmaxf(__builtin_rintf(hq[8 * j + 4 * d + k] * inv), -127.0f), 127.0f);
                w2[d] = (unsigned)(b4[0] & 255) | ((unsigned)(b4[1] & 255) << 8) | ((unsigned)(b4[2] & 255) << 16) | ((unsigned)b4[3] << 24); }
            *(u32x2*)(qrow + 512 * j + 8 * lane) = (u32x2){w2[0], w2[1]}; } }
}
__device__ __forceinline__ void p1_h1(const Ctx& C0) {
    PHASE_IDS();
    LAS float* MA = (LAS float*)C.lds;
    LAS float* MB = MA + 2048;
    for (int idx = C.tid; idx < 2048; idx += 512) { const int b = idx >> 10, col = idx & 1023;
        const float sh = ada_val(C, b, col), sc = ada_val(C, b, 1024 + col);
        MA[idx] = C.in[5][col] * (1.0f + sc); MB[idx] = sh; }
    if (blockIdx.x < NE) { const int e = blockIdx.x; bf16_t* wrt = WSP(bf16_t, WS_WRT) + (size_t)e * 1024;
        for (int k = C.tid; k < 1024; k += 512) wrt[k] = (bf16_t)f2bf(C.in[16][(size_t)k * 32 + e]); }
    {
        const int per = (2 * 6144 + C.G - 1) / C.G;
        for (int i = C.tid; i < per; i += 512) { const int idx = blockIdx.x * per + i; if (idx < 2 * 6144) WSP(float, WS_ADAF)[idx] = ada_val(C, idx / 6144, idx % 6144); }
    }
    __syncthreads();
    const int gw = C.vcu * NWAVES + C.wave, NGW = C.G * NWAVES;
    for (int m0 = gw; m0 < M; m0 += NGW) { const int m = XROW(m0); const int b = m >= SEQ; rms_mod_row(C.in[0] + (size_t)m * D, WSP(bf16_t, WS_H) + (size_t)m * D, MA + b * 1024, MB + b * 1024, C.lane, (signed char*)(C.ws + WS_H2Q) + (size_t)m * D, WSP(float, WS_SA) + m); }
    __syncthreads();
}
__device__ __forceinline__ void p3a_kmean(const Ctx& C0) {
    PHASE_IDS();
    LAS float* red = (LAS float*)C.lds;
    const bf16_t* kb = WSP(const bf16_t, WS_PROJ + 2 * PROJ_STRIDE);
    for (int it = blockIdx.x; it < 64; it += C.G) { const int b = it >> 5, n = it & 31;
        float a[8];
#pragma unroll
        for (int j = 0; j < 8; ++j) a[j] = 0.f;
        const bf16_t* src = kb + (size_t)(b * SEQ + 256 * n + 32 * C.wave) * 1024 + 8 * C.lane;
#pragma unroll 8
        for (int r = 0; r < 32; ++r) { const u32x4 v = *(const u32x4*)(src + (size_t)r * 1024);
            a[0] += bf_lo(v.x); a[1] += bf_hi(v.x); a[2] += bf_lo(v.y); a[3] += bf_hi(v.y); a[4] += bf_lo(v.z); a[5] += bf_hi(v.z); a[6] += bf_lo(v.w); a[7] += bf_hi(v.w); }
        __syncthreads();
#pragma unroll
        for (int j = 0; j < 8; ++j) red[C.wave * 512 + 8 * C.lane + j] = a[j];
        __syncthreads();
        { const int col = C.tid; float s = 0.f;
#pragma unroll
            for (int w = 0; w < 8; ++w) s += red[w * 512 + col];
            const int h = col >> 6, d = col & 63; WSP(float, WS_KMEAN)[((b * 8 + h) * 32 + n) * 64 + d] = s * (1.0f / 256.0f); }
    }
    __syncthreads();
}
__device__ __forceinline__ void p3b_gate(const Ctx& C0) {
    PHASE_IDS();
    LAS float* km = (LAS float*)C.lds;
    const bf16_t* qb = WSP(const bf16_t, WS_PROJ + 1 * PROJ_STRIDE) + 512;
    unsigned* cnt = WSP(unsigned, WS_CTL) + CW_MCNT; unsigned* list = WSP(unsigned, WS_LIST);
    for (int it = blockIdx.x; it < 256; it += C.G) { const int bh = it >> 4, qc = it & 15, b = bh >> 3, h = bh & 7;
        __syncthreads();
        for (int i = C.tid; i < 2048; i += 512) km[i] = WSP(const float, WS_KMEAN)[bh * 2048 + i];
        __syncthreads();
        const int q = 512 * qc + C.tid, own = q >> 8;
        u32x4 qv[8];
        { const u32x4* qp = (const u32x4*)(qb + (size_t)(b * SEQ + q) * 1024 + h * 64);
#pragma unroll
            for (int j = 0; j < 8; ++j) qv[j] = qp[j]; }
        float v0 = -INFINITY, v1 = -INFINITY, v2 = -INFINITY; int i0 = 0, i1 = 0, i2 = 0;
        const int nmax = ((512 * qc + 511) >> 8);
        for (int n = 0; n < nmax; ++n) { const LAS f32x4* kr = (const LAS f32x4*)(km + n * 64); float s = 0.f;
#pragma unroll
            for (int j = 0; j < 8; ++j) { const f32x4 ka = kr[2 * j], kb2 = kr[2 * j + 1];
                s += bf_lo(qv[j].x) * ka[0] + bf_hi(qv[j].x) * ka[1] + bf_lo(qv[j].y) * ka[2] + bf_hi(qv[j].y) * ka[3]
                   + bf_lo(qv[j].z) * kb2[0] + bf_hi(qv[j].z) * kb2[1] + bf_lo(qv[j].w) * kb2[2] + bf_hi(qv[j].w) * kb2[3]; }
            if (n < own) {
                if (s > v0) { v2 = v1; i2 = i1; v1 = v0; i1 = i0; v0 = s; i0 = n; }
                else if (s > v1) { v2 = v1; i2 = i1; v1 = s; i1 = n; }
                else if (s > v2) { v2 = s; i2 = n; }
            } }
        const int nsel = own < 3 ? own : 3;
        LAS unsigned* lc = (LAS unsigned*)(C.lds + 8192);
        if (C.tid < 128) lc[C.tid] = 0u;
        __syncthreads();
        const int l0 = 2 * i0 + (i0 == own - 1 ? 1 : 0), l1 = 2 * i1 + (i1 == own - 1 ? 1 : 0), l2 = 2 * i2 + (i2 == own - 1 ? 1 : 0);
        unsigned lp0 = 0u, lp1 = 0u, lp2 = 0u;
        if (nsel > 0) lp0 = atomicAdd((unsigned*)(lc + l0), 1u);
        if (nsel > 1) lp1 = atomicAdd((unsigned*)(lc + l1), 1u);
        if (nsel > 2) lp2 = atomicAdd((unsigned*)(lc + l2), 1u);
        __syncthreads();
        if (C.tid < 64) { const unsigned c = lc[C.tid]; lc[64 + C.tid] = c ? atomicAdd(cnt + bh * 64 + C.tid, c) : 0u; }
        __syncthreads();
#pragma unroll
        for (int j = 0; j < 3; ++j) if (j < nsel) { const int n = j == 0 ? i0 : (j == 1 ? i1 : i2); const int l = j == 0 ? l0 : (j == 1 ? l1 : l2); const unsigned pos = lc[64 + l] + (j == 0 ? lp0 : (j == 1 ? lp1 : lp2));
            list[(size_t)bh * LIST_PER_BH + 256 * (31 * n - (n * (n - 1)) / 2) + ((l & 1) ? 0 : 256) + pos] = (unsigned)q | ((unsigned)j << 13); }
    }
    __syncthreads();
}
__device__ __forceinline__ void build_bias_tables(const Ctx& C) {
    LAS float* bt = (LAS float*)(C.lds + AT_BT);
    for (int idx = C.tid; idx < 12 * BT_STR; idx += 512) { const int hd = idx / BT_STR, n = idx % BT_STR;
        if (n >= 128) { bt[idx] = 0.f; continue; }
        int bk;
        if (n < 16) bk = n; else { const float nf = (float)n; int lg = 16 + (int)(logf(nf / 16.0f) / logf(8.0f) * 16.0f); bk = lg < 31 ? lg : 31; }
        bt[idx] = (C.in[2][bk * 12 + hd] - C.in[2][31 * 12 + hd]) * LOG2E; }
}
#if SIMPLE_DIFF
__device__ __forceinline__ void diff_unit(const Ctx& C, int b, int h, int qblk, float lam) {
    const int lane = C.lane, c = lane & 15, g = lane >> 4, wid = C.wave;
    const bf16_t* qka = WSP(const bf16_t, WS_PROJ);
    const bf16_t* va = WSP(const bf16_t, WS_PROJ + PROJ_STRIDE);
    const int q0 = qblk * 128, q = q0 + wid * 16 + c, NT = 2 * qblk + 2;
    const LAS float* bt = (const LAS float*)(C.lds + AT_BT) + h * 128;
    f32x4 o0[8];
    for (int map = 0; map < 2; ++map) {
        bf16x8 qf[2];
#pragma unroll
        for (int ks = 0; ks < 2; ++ks) qf[ks] = *(const bf16x8*)(qka + (size_t)(b * SEQ + q) * 1024 + h * 128 + map * 64 + 32 * ks + 8 * g);
        const bf16_t* kg = qka + (size_t)(b * SEQ) * 1024 + 512 + h * 128 + map * 64;
        const bf16_t* vg = va + (size_t)(b * SEQ) * 1024 + h * 128;
        float m_run = -1e30f, l_run = 0.f; f32x4 o[8];
#pragma unroll
        for (int dt = 0; dt < 8; ++dt) o[dt] = (f32x4){0.f, 0.f, 0.f, 0.f};
        TileRegs<2> tr; tile_fetch<2>(tr, kg, vg, C.tid);
        for (int t = 0; t < NT; ++t) {
            __syncthreads();
            tile_store<2>(tr, C.lds, C.tid);
            __syncthreads();
            if (t + 1 < NT) tile_fetch<2>(tr, kg + (size_t)(t + 1) * 64 * 1024, vg + (size_t)(t + 1) * 64 * 1024, C.tid);
            attn_tile<8>(C.lds, lane, qf, o, m_run, l_run, q, 64 * t, true, bt);
        }
        float lt = l_run; lt += __shfl_xor(lt, 16); lt += __shfl_xor(lt, 32);
        const float rl = 1.0f / lt;
#pragma unroll
        for (int i = 0; i < 4; ++i) { const float ri = __shfl(rl, 4 * g + i);
#pragma unroll
            for (int dt = 0; dt < 8; ++dt) { if (map == 0) o0[dt][i] = o[dt][i] * ri; else o0[dt][i] = o0[dt][i] - lam * (o[dt][i] * ri); } }
    }
    bf16_t* y = WSP(bf16_t, WS_Y);
#pragma unroll
    for (int i = 0; i < 4; ++i) { float ss = 0.f;
#pragma unroll
        for (int dt = 0; dt < 8; ++dt) ss += o0[dt][i] * o0[dt][i];
        ss += __shfl_xor(ss, 1); ss += __shfl_xor(ss, 2); ss += __shfl_xor(ss, 4); ss += __shfl_xor(ss, 8);
        const float rstd = 1.0f / sqrtf(ss * (1.0f / 128.0f) + RMS_EPS);
        bf16_t* yr = y + (size_t)(b * SEQ + q0 + wid * 16 + 4 * g + i) * 1024 + h * 128 + c;
#pragma unroll
        for (int dt = 0; dt < 8; ++dt) yr[16 * dt] = (bf16_t)f2bf(o0[dt][i] * rstd * C.in[11][16 * dt + c] * 0.8f); }
}
#endif
#if 0
__device__ __forceinline__ void moba_item(const Ctx& C, int b, int h, int n, bool own, int half, const unsigned* lst, int lcnt, int chunk) {
    const int lane = C.lane, c = lane & 15, g = lane >> 4, wid = C.wave;
    const bf16_t* qb = WSP(const bf16_t, WS_PROJ + PROJ_STRIDE) + 512;
    const bf16_t* kv = WSP(const bf16_t, WS_PROJ + 2 * PROJ_STRIDE);
    int qtok, jslot; bool valid;
    if (own) { qtok = 256 * n + 128 * half + wid * 16 + c; jslot = 3; valid = true; }
    else { const int idx = chunk * 128 + wid * 16 + c; valid = idx < lcnt; const unsigned e = lst[valid ? idx : 0]; qtok = (int)(e & 8191u); jslot = (int)(e >> 13); }
    bf16x8 qf[2];
#pragma unroll
    for (int ks = 0; ks < 2; ++ks) qf[ks] = *(const bf16x8*)(qb + (size_t)(b * SEQ + qtok) * 1024 + h * 64 + 32 * ks + 8 * g);
    const bf16_t* kg = kv + (size_t)(b * SEQ + 256 * n) * 1024 + h * 64;
    const bf16_t* vg = kg + 512;
    const LAS float* bt = (const LAS float*)(C.lds + AT_BT) + (4 + h) * 128;
    const int NT = own ? 2 * (half + 1) : 4;
    float m_run = -1e30f, l_run = 0.f; f32x4 o[4];
#pragma unroll
    for (int dt = 0; dt < 4; ++dt) o[dt] = (f32x4){0.f, 0.f, 0.f, 0.f};
    TileRegs<1> tr; tile_fetch<1>(tr, kg, vg, C.tid);
    for (int t = 0; t < NT; ++t) {
        __syncthreads();
        tile_store<1>(tr, C.lds, C.tid);
        __syncthreads();
        if (t + 1 < NT) tile_fetch<1>(tr, kg + (size_t)(t + 1) * 64 * 1024, vg + (size_t)(t + 1) * 64 * 1024, C.tid);
        attn_tile<4>(C.lds, lane, qf, o, m_run, l_run, qtok, 256 * n + 64 * t, own, bt);
    }
    float lt = l_run; lt += __shfl_xor(lt, 16); lt += __shfl_xor(lt, 32);
    const int slot = ((b * SEQ + qtok) * 8 + h) * 4 + jslot;
    if (g == 0 && valid) { f32x2 ml; ml[0] = m_run; ml[1] = lt; *(f32x2*)(WSP(float, WS_PML) + (size_t)slot * 2) = ml; }
    bf16_t* po = WSP(bf16_t, WS_PO);
#pragma unroll
    for (int i = 0; i < 4; ++i) { const int sl = __shfl(slot, 4 * g + i); const int vl = __shfl((int)valid, 4 * g + i);
        if (vl) {
#pragma unroll
            for (int dt = 0; dt < 4; ++dt) po[(size_t)sl * 64 + 16 * dt + c] = (bf16_t)f2bf(o[dt][i]); } }
}
#endif
constexpr int MB_BUF = 65536, MB_OST = LDSCTL_OFF + 14336;
struct MItem { int valid, b, h, n, own, half, near, lcnt, chunk, lbase; };
__device__ __forceinline__ MItem moba_decode(int it, int nitems, const LAS int* pre, const unsigned* cnt) {
    MItem m; m.valid = it < nitems ? 1 : 0; if (!m.valid) it = 0;
    if (it < 1024) { const int bh = it >> 6, r = it & 63; m.b = bh >> 3; m.h = bh & 7; m.n = r >> 1; m.own = 1; m.half = (r ^ (bh >> 2)) & 1; m.near = 0;
        m.lcnt = 128; m.chunk = 0; m.lbase = 0; }
    else { const int gi = it - 1024; int lo = 0, hi = 1023;
        while (lo < hi) { const int mid = (lo + hi + 1) >> 1; if (pre[mid] <= gi) lo = mid; else hi = mid - 1; }
        const int L = lo, bh = L >> 6, n = (L >> 1) & 31, near = L & 1;
        m.b = bh >> 3; m.h = bh & 7; m.n = n; m.own = 0; m.half = 0; m.near = near; m.lcnt = (int)__hip_atomic_load(cnt + L, RLX_AGENT); m.chunk = gi - pre[L];
        m.lbase = bh * LIST_PER_BH + 256 * (31 * n - (n * (n - 1)) / 2) + (near ? 0 : 256); }
    return m;
}
__device__ __forceinline__ unsigned moba_entry(const Ctx& C, const MItem& m) {
    const int c = C.lane & 15;
    if (m.own) return (unsigned)(256 * m.n + 128 * m.half + C.wave * 16 + c) | (3u << 13) | (1u << 15);
    const int idx = m.chunk * 128 + C.wave * 16 + c; const bool v = idx < m.lcnt;
    const unsigned e = WSP(const unsigned, WS_LIST)[(size_t)m.lbase + (v ? idx : 0)];
    return (e & 0x7fffu) | (v ? (1u << 15) : 0u);
}
__device__ __forceinline__ void moba_qload(const Ctx& C, const MItem& m, unsigned ent, bf16x8 (&qf)[2]) {
    const bf16_t* qb = WSP(const bf16_t, WS_PROJ + PROJ_STRIDE) + 512; const int g = C.lane >> 4;
#pragma unroll
    for (int ks = 0; ks < 2; ++ks) qf[ks] = *(const bf16x8*)(qb + (size_t)(m.b * SEQ + (int)(ent & 8191u)) * 1024 + m.h * 64 + 32 * ks + 8 * g);
}
__device__ __forceinline__ void moba_dma(const Ctx& C, const MItem& m, int bo) {
    const bf16_t* kg = WSP(const bf16_t, WS_PROJ + 2 * PROJ_STRIDE) + (size_t)(m.b * SEQ + 256 * m.n) * 1024 + m.h * 64;
    const int r8 = C.lane >> 3, sch = (C.lane & 7) ^ r8;
#pragma unroll
    for (int j = 0; j < 4; ++j) { const int p = C.wave * 4 + j; const bf16_t* src = kg + (size_t)(8 * p + r8) * 1024 + sch * 8;
        __builtin_amdgcn_global_load_lds((const unsigned*)src, (LAS unsigned*)(C.lds + bo + p * 1024), 16, 0, 0);
        __builtin_amdgcn_global_load_lds((const unsigned*)(src + 512), (LAS unsigned*)(C.lds + bo + 32768 + p * 1024), 16, 0, 0); }
}
constexpr int MB_STG = 2304;
__device__ __forceinline__ void moba_flush(const Ctx& C) {
    const LAS unsigned char* stg = C.lds + MB_OST + C.wave * MB_STG; const int lane = C.lane;
    const LAS int* sslot = (const LAS int*)(stg + 2176);
    bf16_t* po = WSP(bf16_t, WS_PO);
#pragma unroll
    for (int r = 0; r < 2; ++r) { const int row = (lane >> 3) + 8 * r, ch = lane & 7; const u32x4 v = *(const LAS u32x4*)(stg + row * 128 + ch * 16); const int sl = sslot[row];
        if (sl >= 0) *(u32x4*)(po + (size_t)sl * 64 + ch * 8) = v; }
    if (lane < 16) { const int sl = sslot[lane]; const f32x2 ml = *(const LAS f32x2*)(stg + 2048 + lane * 8); if (sl >= 0) *(f32x2*)(WSP(float, WS_PML) + (size_t)sl * 2) = ml; }
}
__device__ __forceinline__ void moba_compute(const Ctx& C, const MItem& m, unsigned ent, const bf16x8 (&qf)[2], int bo, int mode) {
    if (!(mode & 2)) return;
    const int lane = C.lane, c = lane & 15, g = lane >> 4, cx = c & 7;
    const int qtok = (int)(ent & 8191u), jslot = (int)((ent >> 13) & 3u), valid = (int)((ent >> 15) & 1u);
    const int nkt = m.own ? 8 * (m.half + 1) : 16;
    const LAS float* bt = (const LAS float*)(C.lds + AT_BT) + (4 + m.h) * BT_STR;
    const bool nearb = m.near && __any((qtok & 255) < 127);
    f32x4 s[16];
    const LAS unsigned char* kb = C.lds + bo + c * 128;
    const int kc0 = ((0 + g) ^ cx) << 4, kc1 = ((4 + g) ^ cx) << 4;
#define MB_BIAS(t4) do { if (m.own || (nearb && (t4) >= 2)) { const int kbase_ = 256 * m.n + 64 * (t4); \
            _Pragma("unroll") for (int k4 = 0; k4 < 4; ++k4) _Pragma("unroll") for (int i = 0; i < 4; ++i) { const int kt_ = 4 * (t4) + k4; const int dist = qtok - (kbase_ + 16 * k4 + 4 * g + i); \
                const unsigned di = (unsigned)dist < 128u ? (unsigned)dist : 128u; const float v = s[kt_][i] + bt[di]; s[kt_][i] = (m.own && dist < 0) ? -INFINITY : v; } } } while (0)
#pragma unroll
    for (int kt = 0; kt < 4; ++kt) { const bf16x8 a0 = *(const LAS bf16x8*)(kb + kt * 2048 + kc0), a1 = *(const LAS bf16x8*)(kb + kt * 2048 + kc1);
        f32x4 z = (f32x4){0.f, 0.f, 0.f, 0.f}; z = __builtin_amdgcn_mfma_f32_16x16x32_bf16(a0, qf[0], z, 0, 0, 0); s[kt] = __builtin_amdgcn_mfma_f32_16x16x32_bf16(a1, qf[1], z, 0, 0, 0); }
    MB_BIAS(0);
    float mx = fmaxf(fmaxf(s[0][0], s[0][1]), fmaxf(s[0][2], s[0][3]));
#pragma unroll
    for (int kt = 1; kt < 4; ++kt) mx = fmaxf(mx, fmaxf(fmaxf(s[kt][0], s[kt][1]), fmaxf(s[kt][2], s[kt][3])));
    mx = fmaxf(mx, __shfl_xor(mx, 16)); mx = fmaxf(mx, __shfl_xor(mx, 32));
    const f32x4 negm = (f32x4){-mx, -mx, -mx, -mx};
#pragma unroll
    for (int kt = 0; kt < 4; ++kt) s[kt] += negm;
#define MB_EXP4(t) do { s[t][0] = __builtin_amdgcn_exp2f(s[t][0]); s[t][1] = __builtin_amdgcn_exp2f(s[t][1]); s[t][2] = __builtin_amdgcn_exp2f(s[t][2]); s[t][3] = __builtin_amdgcn_exp2f(s[t][3]); } while (0)
#pragma unroll
    for (int kt = 4; kt < 16; ++kt) {
        if (kt < nkt) { const bf16x8 a0 = *(const LAS bf16x8*)(kb + kt * 2048 + kc0), a1 = *(const LAS bf16x8*)(kb + kt * 2048 + kc1);
            f32x4 z = __builtin_amdgcn_mfma_f32_16x16x32_bf16(a0, qf[0], negm, 0, 0, 0); s[kt] = __builtin_amdgcn_mfma_f32_16x16x32_bf16(a1, qf[1], z, 0, 0, 0); }
        else s[kt] = (f32x4){-INFINITY, -INFINITY, -INFINITY, -INFINITY};
        if (kt < 8) { MB_EXP4(kt - 4); asm volatile("" : "+v"(s[kt - 4])); }
        __builtin_amdgcn_sched_barrier(0);
    }
    if (4 < nkt) MB_BIAS(1);
    if (8 < nkt) { MB_BIAS(2); MB_BIAS(3); }
#undef MB_BIAS
    f32x4 o[4], osum = (f32x4){0.f, 0.f, 0.f, 0.f};
#pragma unroll
    for (int dt = 0; dt < 4; ++dt) o[dt] = (f32x4){0.f, 0.f, 0.f, 0.f};
    const short one = (c == 0) ? (short)0x3F80 : (short)0; const bf16x8 ones = (bf16x8){one, one, one, one, one, one, one, one};
    const int rv = 4 * g + (c >> 2), x7 = rv & 7, hb = (c & 3) >> 1;
    const LAS unsigned char* vb = C.lds + bo + 32768 + rv * 128 + 8 * (c & 1);
    int cv[4];
#pragma unroll
    for (int dt = 0; dt < 4; ++dt) cv[dt] = ((2 * dt + hb) ^ x7) << 4;
#pragma unroll
    for (int kk = 0; kk < 8; ++kk) {
        if (2 * kk < nkt) { u32x4 w; w.x = cvt_pk_bf16(s[2 * kk][0], s[2 * kk][1]); w.y = cvt_pk_bf16(s[2 * kk][2], s[2 * kk][3]);
            w.z = cvt_pk_bf16(s[2 * kk + 1][0], s[2 * kk + 1][1]); w.w = cvt_pk_bf16(s[2 * kk + 1][2], s[2 * kk + 1][3]); const bf16x8 pa = __builtin_bit_cast(bf16x8, w);
            osum = __builtin_amdgcn_mfma_f32_16x16x32_bf16(pa, ones, osum, 0, 0, 0);
#pragma unroll
            for (int dt = 0; dt < 4; ++dt) { const s16x4 lo = tr16(vb + (32 * kk) * 128 + cv[dt]), hi = tr16(vb + (32 * kk + 16) * 128 + cv[dt]);
                const bf16x8 bfr = (bf16x8){lo[0], lo[1], lo[2], lo[3], hi[0], hi[1], hi[2], hi[3]};
                o[dt] = __builtin_amdgcn_mfma_f32_16x16x32_bf16(pa, bfr, o[dt], 0, 0, 0); } }
        if (kk < 6 && 2 * kk + 4 < nkt) { MB_EXP4(2 * kk + 4); MB_EXP4(2 * kk + 5); asm volatile("" : "+v"(s[2 * kk + 4]), "+v"(s[2 * kk + 5])); }
        __builtin_amdgcn_sched_barrier(0);
    }
#undef MB_EXP4
    if (!(mode & 1)) return;
    LAS unsigned char* stg = C.lds + MB_OST + C.wave * MB_STG;
    LAS bf16_t* so = (LAS bf16_t*)stg;
#pragma unroll
    for (int i = 0; i < 4; ++i)
#pragma unroll
        for (int dt = 0; dt < 4; ++dt) so[(4 * g + i) * 64 + 16 * dt + c] = (bf16_t)f2bf(o[dt][i]);
    const int slot = valid ? ((m.b * SEQ + qtok) * 8 + m.h) * 4 + jslot : -1;
    if (g == 0) { ((LAS int*)(stg + 2176))[c] = slot; ((LAS float*)(stg + 2048))[2 * c] = mx; }
    if (c == 0) {
#pragma unroll
        for (int i = 0; i < 4; ++i) ((LAS float*)(stg + 2048))[2 * (4 * g + i) + 1] = osum[i]; }
}
__device__ __forceinline__ MItem moba_item_at(const LAS int* tab, int j) {
    MItem m; const int w0 = __builtin_amdgcn_readfirstlane(tab[4 * j]), w1 = __builtin_amdgcn_readfirstlane(tab[4 * j + 1]), w2 = __builtin_amdgcn_readfirstlane(tab[4 * j + 2]), w3 = __builtin_amdgcn_readfirstlane(tab[4 * j + 3]);
    m.valid = (j < 32 && w1 >= 0) ? 1 : 0; const int bh = w0 & 255; m.b = bh >> 3; m.h = bh & 7; m.n = (w0 >> 8) & 255; m.own = (w0 >> 16) & 1; m.half = (w0 >> 17) & 1; m.near = (w0 >> 18) & 1; m.lcnt = w1; m.chunk = w2; m.lbase = w3; return m;
}
__device__ __forceinline__ void moba_phase(const Ctx& C, const LAS int* pre, const unsigned* cnt, int mode) {
    const int nitems = 1024 + pre[1024]; const int G = C.G;
    LAS int* tab = (LAS int*)(C.lds + LDSCTL_OFF + 7424);
    if (C.tid < 33) { MItem m = moba_decode(C.vcu + C.tid * G, nitems, pre, cnt); if (C.tid == 32) m.valid = 0;
        tab[4 * C.tid] = (m.b * 8 + m.h) | (m.n << 8) | (m.own << 16) | (m.half << 17) | (m.near << 18); tab[4 * C.tid + 1] = m.valid ? m.lcnt : -1; tab[4 * C.tid + 2] = m.chunk; tab[4 * C.tid + 3] = m.lbase; }
    __syncthreads();
    int j = 0;
    MItem m0 = moba_item_at(tab, 0), m1 = moba_item_at(tab, 1);
    unsigned e0 = 0u, e1 = 0u; bf16x8 qf0[2];
    qf0[0] = (bf16x8){0, 0, 0, 0, 0, 0, 0, 0}; qf0[1] = qf0[0];
    if (m0.valid) { e0 = moba_entry(C, m0); moba_qload(C, m0, e0, qf0); moba_dma(C, m0, 0); }
    if (m1.valid) e1 = moba_entry(C, m1);
    int bo = 0; bool pending = false;
    while (m0.valid) {
        VM_WAIT(); __syncthreads();
        if (pending) moba_flush(C);
        bf16x8 qf1[2]; qf1[0] = qf0[0]; qf1[1] = qf0[1];
        if (m1.valid) moba_qload(C, m1, e1, qf1);
        const MItem m2 = moba_item_at(tab, j + 2 < 32 ? j + 2 : 32);
        unsigned e2 = 0u; if (m2.valid) e2 = moba_entry(C, m2);
        if (m1.valid) moba_dma(C, m1, bo ^ MB_BUF);
        moba_compute(C, m0, e0, qf0, bo, mode); pending = (mode & 3) == 3;
        m0 = m1; m1 = m2; e0 = e1; e1 = e2; qf0[0] = qf1[0]; qf0[1] = qf1[1]; bo ^= MB_BUF; ++j;
    }
    if (pending) { LDS_WAIT(); moba_flush(C); }
    VM_WAIT(); __syncthreads();
}
#ifndef PROBE_SUB
#define PROBE_SUB 3
#endif
__device__ __forceinline__ void p4_attention(const Ctx& C0, int sub, bool gate) {
    if (gate) { p3b_gate(C0);
        asm volatile("s_waitcnt vmcnt(0)" ::: "memory"); __syncthreads();
        if (threadIdx.x == 0) { __builtin_amdgcn_fence(__ATOMIC_RELEASE, "agent"); asm volatile("s_waitcnt vmcnt(0)" ::: "memory"); xb_add((unsigned*)(C0.ws + WS_CTL) + CW_GDONE, 1u); } }
    PHASE_IDS();
    __syncthreads();
    build_bias_tables(C);
    float lam;
    { const float a = wave_sum(C.in[7][C.lane] * C.in[8][C.lane]), b2 = wave_sum(C.in[9][C.lane] * C.in[10][C.lane]); lam = expf(a) - expf(b2) + 0.2f; }
    __syncthreads();
#if SIMPLE_DIFF
    if (sub & 1) for (int p = blockIdx.x; p < 256; p += C.G) { const int bh = p >> 5, qa = p & 31;
        diff_unit(C, bh >> 2, bh & 3, qa, lam); diff_unit(C, bh >> 2, bh & 3, 63 - qa, lam); }
#else
#if NATIVE_DIFF
    {
        const int grp = blockIdx.x & 7, rank = blockIdx.x >> 3;
        if ((sub & 1) && rank < NCONV) { LAS float* scr = (LAS float*)(C.lds + C.wave * 8448);
            const int wi = (rank * 8 + grp) * NWAVES + C.wave, nw = NCONV * 8 * NWAVES;
            conv_q_blocks<0>(C.in[18], C.ws, C.lds, C.wave, rank * 8 + grp, NCONV * 8);
            conv_range(C, NE * 16 * 64, CONV_MOE_ITEMS, wi, nw, scr); }
        unsigned* qctr = WSP(unsigned, WS_CTL) + CW_AQ + 64 * grp;
        LAS int* qslot = (LAS int*)(C.lds + LDSCTL_OFF + 512);
        const attn_nat::bf16* qk = (const attn_nat::bf16*)WSP(const bf16_t, WS_PROJ); const attn_nat::bf16* vv = (const attn_nat::bf16*)WSP(const bf16_t, WS_PROJ + PROJ_STRIDE);
        attn_nat::bf16* oa = (attn_nat::bf16*)WSP(bf16_t, WS_OA);
        if (sub & 1) for (;;) {
            __syncthreads();
            if (C.tid == 0) *qslot = (int)atomicAdd(qctr, 1u);
            __syncthreads();
            const int j = __builtin_amdgcn_readfirstlane(*qslot);
            if (j >= 64) break;
            const int qb = 31 - (j >> 1), st = grp + 8 * (j & 1), b = st >> 3, h = (st >> 1) & 3, mp = st & 1;
            const LAS float* bth = (const LAS float*)(C.lds + AT_BT) + h * BT_STR;
            attn_nat::attn_unit<8>(b, qb, qk, qk, vv, oa, h * 128 + mp * 64, 512 + h * 128 + mp * 64, h * 128, mp * 512 + h * 128, bth, C.ldsg); }
    }
#else
    if (sub & 1) for (int v = C.vcu; v < 256; v += C.G) { const int bvh = v >> 3, s = v & 7, b = bvh >> 4, vh = bvh & 15, h = vh >> 2, mp = (vh >> 1) & 1, vhf = vh & 1;
        const attn_body::bf16* qk = (const attn_body::bf16*)WSP(const bf16_t, WS_PROJ); const attn_body::bf16* vv = (const attn_body::bf16*)WSP(const bf16_t, WS_PROJ + PROJ_STRIDE);
        attn_body::bf16* oa = (attn_body::bf16*)WSP(bf16_t, WS_OA);
        const LAS float* bth = (const LAS float*)(C.lds + AT_BT) + h * BT_STR;
#pragma unroll 1
        for (int i = 0; i < 4; ++i) { const int qb = (i == 0) ? s : (i == 1) ? 15 - s : (i == 2) ? 16 + s : 31 - s;
            attn_body::attn_unit<8>(b, qb, qk, qk, vv, oa, h * 128 + mp * 64, 512 + h * 128 + mp * 64, h * 128 + vhf * 64, mp * 512 + h * 128 + vhf * 64, bth, C.ldsg); } }
#endif
#endif
    LAS int* pre = (LAS int*)(C.lds + AT_MISC);
    LAS int* wtot = pre + 1032;
    const unsigned* cnt = WSP(const unsigned, WS_CTL) + CW_MCNT;
    if (gate && C.tid == 0) { unsigned* gd = WSP(unsigned, WS_CTL) + CW_GDONE; unsigned* tmo = WSP(unsigned, WS_CTL) + CW_TMO; unsigned sp = 0u;
        while (xb_ld(gd) < (unsigned)C.G) { __builtin_amdgcn_s_sleep(2); if ((++sp & 255u) == 0u) { if (xb_ld(tmo)) break; if (sp > XB_SPIN_CAP) { atomicAdd(tmo, 1u); break; } } }
        __builtin_amdgcn_fence(__ATOMIC_ACQUIRE, "agent"); asm volatile("s_waitcnt vmcnt(0)" ::: "memory"); }
    __syncthreads();
    { const int L = 2 * C.tid; const int n0_ = ((int)__hip_atomic_load(cnt + L, RLX_AGENT) + 127) >> 7, n1_ = ((int)__hip_atomic_load(cnt + L + 1, RLX_AGENT) + 127) >> 7; const int nch = n0_ + n1_;
        int inc = nch;
#pragma unroll
        for (int o = 1; o < 64; o <<= 1) { const int t = __shfl_up(inc, o); if (C.lane >= o) inc += t; }
        if (C.lane == 63) wtot[C.wave] = inc;
        __syncthreads();
        int base = 0;
        for (int w = 0; w < C.wave; ++w) base += wtot[w];
        pre[L] = base + inc - nch; pre[L + 1] = base + inc - nch + n0_;
        if (C.tid == 511) pre[1024] = base + inc;
    }
    __syncthreads();
    if (sub & 2) moba_phase(C, pre, cnt, sub >> 2);
    __syncthreads();
}
__device__ __forceinline__ void p5_ycombine(const Ctx& C0) {
    PHASE_IDS();
    const int gw = C.vcu * NWAVES + C.wave, NGW = C.G * NWAVES;
    const bf16_t* po = WSP(const bf16_t, WS_PO); const float* pml = WSP(const float, WS_PML); bf16_t* y = WSP(bf16_t, WS_Y);
#if !SIMPLE_DIFF
    {
        const float lam = expf(wave_sum(C.in[7][C.lane] * C.in[8][C.lane])) - expf(wave_sum(C.in[9][C.lane] * C.in[10][C.lane])) + 0.2f;
        const bf16_t* oa = WSP(const bf16_t, WS_OA);
        const f32x4 g0 = *(const f32x4*)(C.in[11] + 8 * (C.lane & 15)), g1 = *(const f32x4*)(C.in[11] + 8 * (C.lane & 15) + 4);
        for (int m0 = gw; m0 < M; m0 += NGW) { const int m = XROW(m0); const u32x4 a = *(const u32x4*)(oa + (size_t)m * 1024 + 8 * C.lane), b2 = *(const u32x4*)(oa + (size_t)m * 1024 + 512 + 8 * C.lane);
            float v[8];
            v[0] = bf_lo(a.x) - lam * bf_lo(b2.x); v[1] = bf_hi(a.x) - lam * bf_hi(b2.x); v[2] = bf_lo(a.y) - lam * bf_lo(b2.y); v[3] = bf_hi(a.y) - lam * bf_hi(b2.y);
            v[4] = bf_lo(a.z) - lam * bf_lo(b2.z); v[5] = bf_hi(a.z) - lam * bf_hi(b2.z); v[6] = bf_lo(a.w) - lam * bf_lo(b2.w); v[7] = bf_hi(a.w) - lam * bf_hi(b2.w);
            float ss = 0.f;
#pragma unroll
            for (int k = 0; k < 8; ++k) ss += v[k] * v[k];
            ss += __shfl_xor(ss, 1); ss += __shfl_xor(ss, 2); ss += __shfl_xor(ss, 4); ss += __shfl_xor(ss, 8);
            const float r = 0.8f / sqrtf(ss * (1.0f / 128.0f) + RMS_EPS);
            u32x4 w; w.x = pk2(v[0] * r * g0[0], v[1] * r * g0[1]); w.y = pk2(v[2] * r * g0[2], v[3] * r * g0[3]); w.z = pk2(v[4] * r * g1[0], v[5] * r * g1[1]); w.w = pk2(v[6] * r * g1[2], v[7] * r * g1[3]);
            *(u32x4*)(y + (size_t)m * 1024 + 8 * C.lane) = w; }
    }
#endif
    for (int m0 = gw; m0 < M; m0 += NGW) { const int m = XROW(m0); const int h = C.lane >> 3, dch = C.lane & 7; const int own = (m & (SEQ - 1)) >> 8, nsel = own < 3 ? own : 3;
        const size_t s0 = ((size_t)m * 8 + h) * 4;
        float mm[4], ll[4]; u32x4 ov[4];
#pragma unroll
        for (int j = 0; j < 4; ++j) { const bool use = (j == 3) || (j < nsel);
            if (use) { const f32x2 ml = *(const f32x2*)(pml + (s0 + j) * 2); mm[j] = ml[0]; ll[j] = ml[1]; ov[j] = *(const u32x4*)(po + (s0 + j) * 64 + 8 * dch); }
            else { mm[j] = -INFINITY; ll[j] = 0.f; ov[j] = (u32x4){0u, 0u, 0u, 0u}; } }
        const float mx = fmaxf(fmaxf(mm[0], mm[1]), fmaxf(mm[2], mm[3]));
        float den = 0.f; float acc[8];
#pragma unroll
        for (int k = 0; k < 8; ++k) acc[k] = 0.f;
#pragma unroll
        for (int j = 0; j < 4; ++j) { const float w = __builtin_amdgcn_exp2f(mm[j] - mx); den += w * ll[j];
            acc[0] += w * bf_lo(ov[j].x); acc[1] += w * bf_hi(ov[j].x); acc[2] += w * bf_lo(ov[j].y); acc[3] += w * bf_hi(ov[j].y);
            acc[4] += w * bf_lo(ov[j].z); acc[5] += w * bf_hi(ov[j].z); acc[6] += w * bf_lo(ov[j].w); acc[7] += w * bf_hi(ov[j].w); }
        const float r = 1.0f / den;
        u32x4 w; w.x = pk2(acc[0] * r, acc[1] * r); w.y = pk2(acc[2] * r, acc[3] * r); w.z = pk2(acc[4] * r, acc[5] * r); w.w = pk2(acc[6] * r, acc[7] * r);
        *(u32x4*)(y + (size_t)m * 1024 + 512 + h * 64 + 8 * dch) = w; }
}
__device__ __forceinline__ void p8_router(const Ctx& C0) {
    PHASE_IDS();
    LAS float* MA = (LAS float*)(C.lds + LDSCTL_OFF + 2048); LAS float* MB = MA + 2048;
    LAS int* hist = (LAS int*)(C.lds + LDSCTL_OFF + 2048 + 16384);
    LAS float* xch = (LAS float*)(C.lds + LDSCTL_OFF + 2048 + 16384 + 256);
    for (int idx = C.tid; idx < 2048; idx += 512) { const int b = idx >> 10, col = idx & 1023; const float* af = WSP(const float, WS_ADAF) + b * 6144;
        MA[idx] = C.in[15][col] * (1.0f + af[4096 + col]); MB[idx] = af[3072 + col]; }
    if (C.tid < 32) hist[C.tid] = 0;
    __syncthreads();
    for (int blk = (C.G == 256 ? C.vcu : (int)blockIdx.x); blk < M / 64; blk += C.G) {
        const int r0 = 64 * blk, b = r0 >= SEQ;
        {
            u32x4 xr[8][2];
#pragma unroll
            for (int r = 0; r < 8; ++r)
#pragma unroll
                for (int j = 0; j < 2; ++j) xr[r][j] = *(const u32x4*)(WSP(const bf16_t, WS_X1) + (size_t)(r0 + 8 * C.wave + r) * D + 512 * j + 8 * C.lane);
#pragma unroll
            for (int r = 0; r < 8; ++r) { const int lr = 8 * C.wave + r, m = r0 + lr; const LAS float* ma = MA + b * 1024; const LAS float* mb = MB + b * 1024;
                float v[16]; float s = 0.f;
#pragma unroll
                for (int j = 0; j < 2; ++j) { const u32x4 w = xr[r][j];
                    v[8 * j + 0] = bf_lo(w.x); v[8 * j + 1] = bf_hi(w.x); v[8 * j + 2] = bf_lo(w.y); v[8 * j + 3] = bf_hi(w.y); v[8 * j + 4] = bf_lo(w.z); v[8 * j + 5] = bf_hi(w.z); v[8 * j + 6] = bf_lo(w.w); v[8 * j + 7] = bf_hi(w.w); }
#pragma unroll
                for (int k = 0; k < 16; ++k) s += v[k] * v[k];
                const float rstd = 1.0f / sqrtf(wave_sum(s) * (1.0f / D) + RMS_EPS);
                float am = 0.f;
#pragma unroll
                for (int j = 0; j < 2; ++j) { const LAS float* a = ma + 512 * j + 8 * C.lane; const LAS float* bb = mb + 512 * j + 8 * C.lane;
                    const f32x4 a0 = *(const LAS f32x4*)a, a1 = *(const LAS f32x4*)(a + 4), b0 = *(const LAS f32x4*)bb, b1 = *(const LAS f32x4*)(bb + 4);
#pragma unroll
                    for (int k = 0; k < 4; ++k) { v[8 * j + k] = v[8 * j + k] * rstd * a0[k] + b0[k]; v[8 * j + 4 + k] = v[8 * j + 4 + k] * rstd * a1[k] + b1[k]; }
#pragma unroll
                    for (int k = 0; k < 8; ++k) am = fmaxf(am, fabsf(v[8 * j + k]));
                    u32x4 w; w.x = pk2(v[8 * j + 0], v[8 * j + 1]); w.y = pk2(v[8 * j + 2], v[8 * j + 3]); w.z = pk2(v[8 * j + 4], v[8 * j + 5]); w.w = pk2(v[8 * j + 6], v[8 * j + 7]);
                    *(LAS u32x4*)(C.lds + lr * 2048 + (((64 * j + C.lane) ^ (lr & 15)) << 4)) = w; }
#pragma unroll
                for (int o = 1; o < 64; o <<= 1) am = fmaxf(am, __shfl_xor(am, o));
                const float inv = am > 0.f ? 127.0f / am : 0.f;
                if (C.lane == 0) WSP(float, WS_SA)[m] = am > 0.f ? am * (1.0f / 127.0f) : 1.0f;
                signed char* qrow = (signed char*)(C.ws + WS_H2Q) + (size_t)m * D;
#pragma unroll
                for (int j = 0; j < 2; ++j) { unsigned w2[2];
#pragma unroll
                    for (int d = 0; d < 2; ++d) { int b4[4];
#pragma unroll
                        for (int k = 0; k < 4; ++k) b4[k] = (int)fminf(fmaxf(__builtin_rintf(v[8 * j + 4 * d + k] * inv), -127.0f), 127.0f);
                        w2[d] = (unsigned)(b4[0] & 255) | ((unsigned)(b4[1] & 255) << 8) | ((unsigned)(b4[2] & 255) << 16) | ((unsigned)b4[3] << 24); }
                    *(u32x2*)(qrow + 512 * j + 8 * C.lane) = (u32x2){w2[0], w2[1]}; } }
        }
        __syncthreads();
        const int lane = C.lane, c = lane & 15, g = lane >> 4, rq = C.wave & 3, kh = C.wave >> 2; const int rb = r0 + 16 * rq;
        f32x4 lg[2]; lg[0] = (f32x4){0.f, 0.f, 0.f, 0.f}; lg[1] = lg[0];
        { const bf16_t* wt = WSP(const bf16_t, WS_WRT) + (size_t)c * 1024 + 8 * g + 512 * kh; const LAS unsigned char* arow = C.lds + (16 * rq + c) * 2048;
#pragma unroll 8
            for (int ks = 0; ks < 16; ++ks) { const bf16x8 a = *(const LAS bf16x8*)(arow + ((((64 * kh + 4 * ks + g)) ^ c) << 4));
#pragma unroll
                for (int nt = 0; nt < 2; ++nt) { const bf16x8 w = *(const bf16x8*)(wt + (size_t)nt * 16 * 1024 + 32 * ks);
                    lg[nt] = __builtin_amdgcn_mfma_f32_16x16x32_bf16(a, w, lg[nt], 0, 0, 0); } } }
        if (kh == 1) { *(LAS f32x4*)(xch + (rq * 64 + lane) * 8) = lg[0]; *(LAS f32x4*)(xch + (rq * 64 + lane) * 8 + 4) = lg[1]; }
        __syncthreads();
        if (kh == 0) { lg[0] += *(const LAS f32x4*)(xch + (rq * 64 + lane) * 8); lg[1] += *(const LAS f32x4*)(xch + (rq * 64 + lane) * 8 + 4);
            const float br0 = C.in[17][c], br1 = C.in[17][16 + c];
#pragma unroll
            for (int i = 0; i < 4; ++i) { float a0 = lg[0][i] + br0, a1 = lg[1][i] + br1; float tv[4]; int ti[4];
#pragma unroll
                for (int k = 0; k < 4; ++k) { float bv; int bi; if (a1 > a0) { bv = a1; bi = 16 + c; } else { bv = a0; bi = c; }
#pragma unroll
                    for (int o = 1; o < 16; o <<= 1) { const float ov = __shfl_xor(bv, o); const int oi = __shfl_xor(bi, o); if (ov > bv || (ov == bv && oi < bi)) { bv = ov; bi = oi; } }
                    tv[k] = bv; ti[k] = bi; if (bi == c) a0 = -INFINITY; if (bi == 16 + c) a1 = -INFINITY; }
                if (c == 0) { const int row = rb + 4 * g + i; const float e1 = __expf(tv[1] - tv[0]), e2 = __expf(tv[2] - tv[0]), e3 = __expf(tv[3] - tv[0]); const float inv = 1.0f / (1.0f + e1 + e2 + e3);
                    *(int4*)(WSP(int, WS_TOPI) + (size_t)row * 4) = make_int4(ti[0], ti[1], ti[2], ti[3]);
                    *(f32x4*)(WSP(float, WS_TOPW) + (size_t)row * 4) = (f32x4){inv, e1 * inv, e2 * inv, e3 * inv};
                    atomicAdd((int*)(hist + ti[0]), 1); atomicAdd((int*)(hist + ti[1]), 1); atomicAdd((int*)(hist + ti[2]), 1); atomicAdd((int*)(hist + ti[3]), 1); } }
        }
        __syncthreads();
        if (C.tid < 32) { WSP(int, WS_HIST)[blk * 32 + C.tid] = hist[C.tid]; hist[C.tid] = 0; }
        __syncthreads();
    }
}
__device__ __forceinline__ void p9_slots(const Ctx& C0) {
    PHASE_IDS();
    LAS int* tot = (LAS int*)C.lds;
    LAS int* off = tot + 32;
    LAS int* cur = off + 40;
    const int* hist = WSP(const int, WS_HIST);
    for (int blk = blockIdx.x; blk < M / 64; blk += C.G) {
        __syncthreads();
        int pe = 0; float pw = 0.f, psa = 0.f; const int ptoken = 64 * blk + (C.tid >> 2), pk = C.tid & 3;
        if (C.tid < 256) { pe = WSP(const int, WS_TOPI)[ptoken * 4 + pk]; pw = WSP(const float, WS_TOPW)[ptoken * 4 + pk]; psa = WSP(const float, WS_SA)[ptoken]; }
        {
            LAS int* part = cur + 40;
            const int e = C.tid & 31, r = C.tid >> 5; int t = 0, p = 0;
#pragma unroll
            for (int k = 0; k < (M / 64) / 16; ++k) { const int w = r + 16 * k; const int v = hist[w * 32 + e]; t += v; p += (w < blk) ? v : 0; }
            part[r * 32 + e] = t; part[512 + r * 32 + e] = p;
            __syncthreads();
            if (C.tid < 32) { int ts = 0, ps = 0;
#pragma unroll
                for (int k = 0; k < 16; ++k) { ts += part[k * 32 + C.tid]; ps += part[512 + k * 32 + C.tid]; }
                const int pad = (ts + 255) & ~255; int inc = pad;
#pragma unroll
                for (int o = 1; o < 32; o <<= 1) { const int u = __shfl_up(inc, o); if (C.lane >= o) inc += u; }
                tot[C.tid] = ts; off[C.tid] = inc - pad; cur[C.tid] = ps + inc - pad; if (C.tid == 31) off[32] = inc; } }
        __syncthreads();
        if (C.tid < 256) { const int slot = atomicAdd((int*)(cur + pe), 1);
            WSP(int, WS_SLOTTOK)[slot] = ptoken; WSP(float, WS_SLOTW)[slot] = pw; WSP(int, WS_TOKSLOT)[ptoken * 4 + pk] = slot; WSP(float, WS_SLOTSA)[slot] = psa; }
        if (blk < 32) { const int e = blk; for (int s = off[e] + tot[e] + C.tid; s < off[e + 1]; s += 512) { WSP(int, WS_SLOTTOK)[s] = 0; WSP(float, WS_SLOTW)[s] = 0.f; WSP(float, WS_SLOTSA)[s] = 0.f; } }
        if (blk == 0 && C.tid < 33) WSP(int, WS_EOFF)[C.tid] = off[C.tid];
    }
    __syncthreads();
}
__device__ __forceinline__ void p12_final(const Ctx& C0) {
    PHASE_IDS();
    const int gw = C.vcu * NWAVES + C.wave, NGW = C.G * NWAVES;
    const bf16_t* so = WSP(const bf16_t, WS_SOUT); const bf16_t* x1 = WSP(const bf16_t, WS_X1); const int* ts = WSP(const int, WS_TOKSLOT);
    for (int m = gw; m < M; m += NGW) { const float* gt = WSP(const float, WS_ADAF) + (m >= SEQ ? 6144 : 0) + 5120;
        const int4 sl = *(const int4*)(ts + (size_t)m * 4);
        f32x4 v[4]; float s = 0.f;
#pragma unroll
        for (int j = 0; j < 4; ++j) { const int col = 4 * C.lane + 256 * j; f32x4 a = (f32x4){0.f, 0.f, 0.f, 0.f};
            { const u32x2 w = *(const u32x2*)(so + (size_t)sl.x * 1024 + col); a[0] += bf_lo(w.x); a[1] += bf_hi(w.x); a[2] += bf_lo(w.y); a[3] += bf_hi(w.y); }
            { const u32x2 w = *(const u32x2*)(so + (size_t)sl.y * 1024 + col); a[0] += bf_lo(w.x); a[1] += bf_hi(w.x); a[2] += bf_lo(w.y); a[3] += bf_hi(w.y); }
            { const u32x2 w = *(const u32x2*)(so + (size_t)sl.z * 1024 + col); a[0] += bf_lo(w.x); a[1] += bf_hi(w.x); a[2] += bf_lo(w.y); a[3] += bf_hi(w.y); }
            { const u32x2 w = *(const u32x2*)(so + (size_t)sl.w * 1024 + col); a[0] += bf_lo(w.x); a[1] += bf_hi(w.x); a[2] += bf_lo(w.y); a[3] += bf_hi(w.y); }
            { const u32x2 xw = *(const u32x2*)(x1 + (size_t)m * D + col); const f32x4 xv = (f32x4){bf_lo(xw.x), bf_hi(xw.x), bf_lo(xw.y), bf_hi(xw.y)}; v[j] = xv + *(const f32x4*)(gt + col) * a; }
            s += (v[j][0] * v[j][0] + v[j][1] * v[j][1]) + (v[j][2] * v[j][2] + v[j][3] * v[j][3]); }
        const float rstd = 1.0f / sqrtf(wave_sum(s) * (1.0f / D) + RMS_EPS);
#pragma unroll
        for (int j = 0; j < 4; ++j) { const int col = 4 * C.lane + 256 * j; *(f32x4*)(C.out + (size_t)m * D + col) = v[j] * rstd * *(const f32x4*)(C.in[22] + col); } }
}

constexpr int CW_GRP = 118000;
__device__ __forceinline__ void grp_barrier(const XcdBarrier& b, unsigned* gwd, unsigned n, volatile LAS unsigned* mode) {
    asm volatile("s_waitcnt vmcnt(0)" ::: "memory");
    __syncthreads();
    if (threadIdx.x == 0) {
        __builtin_amdgcn_s_waitcnt(0);
        unsigned md = mode[0];
        if (md == 0u) { md = (xb_ld(gwd + 128) + xb_ld(gwd + 192) == 17u) ? 1u : 2u; mode[0] = md; }
        if (md != 1u) { __builtin_amdgcn_fence(__ATOMIC_RELEASE, "agent"); asm volatile("s_waitcnt vmcnt(0)" ::: "memory"); }
        const unsigned old = xb_add(gwd, 1u); const unsigned gen = old / n;
        if (old + 1u == (gen + 1u) * n) xb_add(gwd + 64, 1u);
        else XB_SPIN(xb_ld(gwd + 64) == gen, b.bar);
        __builtin_amdgcn_fence(__ATOMIC_ACQUIRE, "agent");
        asm volatile("s_waitcnt vmcnt(0)" ::: "memory");
    }
    __syncthreads();
}
struct Args { const float* in[23]; float* out; unsigned char* ws; int ph_lo, ph_hi, li, pad; };
constexpr int N_PHASES = 13;
#ifndef MK_N_LAUNCHES
#define MK_N_LAUNCHES 1
#endif

__global__ void __launch_bounds__(NWAVES * 64, 2) mega_fwd(Args args) {
    extern __shared__ __attribute__((aligned(16))) unsigned char lds_raw[];
    Ctx C;
    C.lds = (LAS unsigned char*)lds_raw; C.ldsg = (char*)lds_raw;
    C.tid = threadIdx.x; C.lane = C.tid & 63; C.wave = __builtin_amdgcn_readfirstlane(C.tid >> 6);
    C.G = gridDim.x; { const int bx = blockIdx.x; C.vcu = (C.G % 8 == 0) ? (bx % 8) * (C.G / 8) + bx / 8 : bx; }
#pragma unroll
    for (int i = 0; i < 23; ++i) C.in[i] = args.in[i];
    C.out = args.out; C.ws = args.ws;
    volatile LAS unsigned* MISC = (volatile LAS unsigned*)(C.lds + MISC_OFF);
    for (int u = C.tid; u < (LDS_BYTES - LDSCTL_OFF) / 4; u += NWAVES * 64) ((LAS unsigned*)(C.lds + LDSCTL_OFF))[u] = 0u;
    __syncthreads();
    unsigned* ctl = (unsigned*)(C.ws + WS_CTL);
    XcdBarrier bar = xcd_barrier_post(ctl + CW_BAR + args.li * XCD_BAR_WORDS, MISC + 8);
    unsigned* gwd = ctl + CW_GRP + 256 * ((int)blockIdx.x & 7);
    if (threadIdx.x == 0) { const unsigned xc = xb_xcc_id(); __hip_atomic_fetch_max(gwd + 128, xc + 1u, __ATOMIC_RELAXED, __HIP_MEMORY_SCOPE_AGENT); __hip_atomic_fetch_max(gwd + 192, 16u - xc, __ATOMIC_RELAXED, __HIP_MEMORY_SCOPE_AGENT); }
    const bool gloc = (C.G == 256) && (MK_N_LAUNCHES == 1);
    const int lo = args.ph_lo, hi = args.ph_hi;
#define IN(k) (lo <= (k) && (k) < hi)
#define SEAM(k) do { if (IN(k) && IN((k) + 1)) xcd_barrier(bar); } while (0)
#define SEAMG(k) do { if (gloc) grp_barrier(bar, gwd, 32u, MISC + 12); else xcd_barrier(bar); } while (0)
#ifndef PROBE_REP
#define PROBE_REP -1
#endif
#define REPS(k) (((k) == PROBE_REP) ? 2 : 1)
#define DUP(k, ...) do { __VA_ARGS__; if (REPS(k) == 2) { __VA_ARGS__; } } while (0)

    if (IN(0)) { DUP(0, p0_prologue(C)); } SEAM(0);
    if (IN(1)) { DUP(30, p1_h1(C)); } SEAMG(1);
    if (IN(2)) {
        { pg8::DenseSched S; S.init(M, 1024, C.G, (int)blockIdx.x, WSP(bf16_t, WS_WIN), 1024); S.pn_base = 6; pg8::EpiProj E{WSP(bf16_t, WS_PROJ), WSP(float, WS_KMEAN)};
          DUP(2, pg8::gemm_phase<pg8::EpiProj, pg8::DenseSched, true>(C.lds, WSP(bf16_t, WS_H), 1024, 1024, 1024, S, E)); }
        { pg8::DenseSched S; S.init(M, INW - 1024, C.G, (int)blockIdx.x, C.ws + WS_WINQ, 512); S.pn_skip_at = 6; S.pn_skip = 4; pg8::EpiProjQ E{WSP(bf16_t, WS_PROJ), WSP(const float, WS_SA), WSP(const float, WS_SWIN)};
          DUP(2, pg8::gemm_phase<pg8::EpiProjQ, pg8::DenseSched, true, true>(C.lds, C.ws + WS_H2Q, 512, 512, 512, S, E)); }
    } if (IN(2) && IN(5)) xcd_barrier(bar);
    if (IN(5)) { p4_attention(C, 3 | (3 << 2), true); if (REPS(5) == 2) p4_attention(C, PROBE_SUB, false); } SEAM(5);
    if (IN(6)) { DUP(30, p5_ycombine(C)); } SEAMG(6);
    if (IN(7)) { pg8::DenseSched S; S.init(M, D, C.G, (int)blockIdx.x, WSP(bf16_t, WS_WBR), 1024); pg8::EpiBr E{WSP(const bf16_t, WS_PROJ + 3 * PROJ_STRIDE), WSP(const bf16_t, WS_PROJ + 4 * PROJ_STRIDE), WSP(bf16_t, WS_MERGED)};
        DUP(31, pg8::gemm_phase<pg8::EpiBr, pg8::DenseSched, true>(C.lds, WSP(bf16_t, WS_Y), 1024, 1024, 1024, S, E)); } SEAMG(7);
    if (IN(9)) { pg8::DenseSched S; S.init(M, D, C.G, (int)blockIdx.x, WSP(bf16_t, WS_WOUT), 1024); pg8::EpiOut E{C.in[0], WSP(const float, WS_ADAF), WSP(bf16_t, WS_X1)};
        DUP(32, pg8::gemm_phase<pg8::EpiOut, pg8::DenseSched, true>(C.lds, WSP(bf16_t, WS_MERGED), 1024, 1024, 1024, S, E)); } SEAMG(9);
    if (IN(10)) { DUP(30, p8_router(C)); } SEAM(10);
    if (IN(11)) { DUP(33, p9_slots(C)); } SEAM(11);
    if (IN(12)) {
        LAS int* te = (LAS int*)(C.lds + RING_BYTES + 64);
        if (C.tid < 33) te[C.tid] = WSP(const int, WS_EOFF)[C.tid] >> 8;
        __syncthreads();
        unsigned* tdone = (unsigned*)(C.ws + WS_CTL) + CW_TDONE; unsigned* tmo = (unsigned*)(C.ws + WS_CTL) + CW_TMO;
        { pg8::MoeSched<true, false, false> S{te, 8, C.G, (int)blockIdx.x, WSP(const int, WS_SLOTTOK), (const char*)(C.ws + WS_WGU), (size_t)2048 * 1024, (size_t)256 * 1024, tdone, tmo};
          pg8::EpiGUQ E{C.in[19], WSP(const float, WS_SW), WSP(const float, WS_SLOTSA), WSP(bf16_t, WS_ACT)};
          DUP(20, pg8::gemm_phase<pg8::EpiGUQ, pg8::MoeSched<true, false, false>, true, true>(C.lds, C.ws + WS_H2Q, 512, 512, 512, S, E)); }
        xcd_barrier(bar);
        { pg8::MoeSched<false, false, false, true> S{te, 4, C.G, (int)blockIdx.x, nullptr, (const char*)WSP(bf16_t, WS_WD), (size_t)1024 * 1024 * 2, (size_t)256 * 1024 * 2, tdone, tmo};
          pg8::EpiDown E{C.in[21], WSP(const float, WS_SLOTW), WSP(bf16_t, WS_SOUT)};
          DUP(21, pg8::gemm_phase<pg8::EpiDown, pg8::MoeSched<false, false, false, true>, true>(C.lds, WSP(bf16_t, WS_ACT), 1024, 1024, 1024, S, E)); }
        xcd_barrier(bar);
        DUP(30, p12_final(C));
    }
#undef IN
#undef SEAM
}

extern "C" void kernel_launch(void* const* d_in, const int* in_sizes, int n_in, void* d_out, int out_size, void* d_ws, size_t ws_size, hipStream_t stream) {
    static int grid = 0;
    if (grid == 0) {
        if (n_in != 23 || in_sizes[0] != M * D || out_size != M * D || ws_size < WS_END) { fprintf(stderr, "kernel_launch: unexpected shapes (n_in %d, in0 %d, out %d, ws %zu); nothing launched\n", n_in, n_in > 0 ? in_sizes[0] : -1, out_size, ws_size); grid = -1; return; }
        int dev = 0, cus = 0, per_cu = 0;
        if (hipGetDevice(&dev) != hipSuccess || hipDeviceGetAttribute(&cus, hipDeviceAttributeMultiprocessorCount, dev) != hipSuccess) { grid = -1; return; }
        if (hipFuncSetAttribute((const void*)mega_fwd, hipFuncAttributeMaxDynamicSharedMemorySize, LDS_BYTES) != hipSuccess) { fprintf(stderr, "kernel_launch: hipFuncSetAttribute failed\n"); grid = -1; return; }
        if (hipOccupancyMaxActiveBlocksPerMultiprocessor(&per_cu, (const void*)mega_fwd, NWAVES * 64, LDS_BYTES) != hipSuccess || per_cu < 1) { fprintf(stderr, "kernel_launch: occupancy query reports %d workgroups per CU\n", per_cu); }
        (void)hipGetLastError();
        grid = cus;
    }
    if (grid < 0) return;
    if (hipMemsetAsync((char*)d_ws + WS_CTL, 0, CTL_ZERO_BYTES, stream) != hipSuccess) { fprintf(stderr, "kernel_launch: memset failed\n"); return; }
    Args a{};
    for (int i = 0; i < 23; ++i) a.in[i] = (const float*)d_in[i];
    a.out = (float*)d_out; a.ws = (unsigned char*)d_ws;
    constexpr int NL = MK_N_LAUNCHES;
    for (int li = 0; li < NL; ++li) {
        a.ph_lo = (NL == 1) ? 0 : li; a.ph_hi = (NL == 1) ? N_PHASES : li + 1; a.li = (NL == 1) ? 0 : li; a.pad = 0;
        hipLaunchKernelGGL(mega_fwd, dim3(grid), dim3(NWAVES * 64), LDS_BYTES, stream, a);
        const hipError_t le = hipPeekAtLastError();
        if (le != hipSuccess) { fprintf(stderr, "kernel_launch: launch %d failed: %s\n", li, hipGetErrorName(le)); break; }
    }
}
```
